# Optimizing an MI355X kernel written in HIP

```python
import math
import jax, jax.numpy as jnp
from jax import lax
import numpy as np

D_MODEL = 1024
BATCH = 4
SEQ = 8192
DEPTH = 2

GRID_W = 64
CTX_LEN = 256

H_A = 8
KV_A = 2
G_A = H_A // KV_A
DH_A = 64
WINDOW = 128
BLOCK = 128
BAND = BLOCK + 2 * WINDOW

H_B = 8
NOPE_B = 64
ROPE_B = 32
V_B = 64
Q_RANK = 384
KV_RANK = 256
MLA_SCALE = (NOPE_B + ROPE_B) ** -0.5

W_QA = H_A * DH_A
W_KA = KV_A * DH_A
W_VA = KV_A * DH_A
IN_WIDTHS = (W_QA, W_KA, W_VA, Q_RANK, KV_RANK, ROPE_B)
IN_DIM = sum(IN_WIDTHS)
SPLIT_POINTS = tuple(int(v) for v in np.cumsum(IN_WIDTHS)[:-1])
MIX_DIM = H_A * DH_A + H_B * V_B

N_EXPERTS = 16
CAP_FACTOR = 2
D_FF = 512

ROPE_BASE = 10000.0
EPS = 1e-6

kernel_name = "hybrid_swa_mla_ec_moe_dit"


def rmsnorm(x, w):
    xf = x.astype(jnp.float32)
    y = xf * lax.rsqrt(jnp.mean(xf * xf, axis=-1, keepdims=True) + EPS)
    return (y * w.astype(jnp.float32)).astype(x.dtype)


def modulate(h, shift, scale):
    return h * (1 + scale) + shift


def axial_rope(x, rows, cols):
    d = x.shape[-1]
    da = d // 2
    nf = da // 2
    inv = ROPE_BASE ** (-jnp.arange(nf, dtype=jnp.float32) / nf)

    def rot(xa, pos):
        ang = pos.astype(jnp.float32)[:, None] * inv[None, :]
        cos = jnp.cos(ang)[None, :, None, :]
        sin = jnp.sin(ang)[None, :, None, :]
        x1, x2 = xa[..., :nf], xa[..., nf:]
        return jnp.concatenate([x1 * cos - x2 * sin, x1 * sin + x2 * cos], axis=-1)

    xf = x.astype(jnp.float32)
    out = jnp.concatenate([rot(xf[..., :da], rows), rot(xf[..., da:], cols)], axis=-1)
    return out.astype(x.dtype)


def gqa_sink_attend(qb, keys, vals, bias, sink_g):
    s = jnp.einsum('bqkgd,bskd->bkgqs', qb, keys, preferred_element_type=jnp.float32) * (DH_A ** -0.5)
    if bias is not None:
        s = s + bias
    b, q = qb.shape[0], qb.shape[1]
    s_sink = jnp.broadcast_to(sink_g.astype(jnp.float32)[None, :, :, None, None], (b, KV_A, G_A, q, 1))
    p = jax.nn.softmax(jnp.concatenate([s, s_sink], axis=-1), axis=-1)[..., :-1]
    o = jnp.einsum('bkgqs,bskd->bqkgd', p.astype(vals.dtype), vals)
    return o.reshape(b, q, H_A * DH_A)


def window_attention_latent(q, k, v, kc, vc, sink_g):
    b, s_len = q.shape[:2]
    lc = kc.shape[1]
    nb = s_len // BLOCK
    qg = q.reshape(b, s_len, KV_A, G_A, DH_A)
    pad = ((0, 0), (WINDOW, WINDOW), (0, 0), (0, 0))
    kp = jnp.pad(k, pad)
    vp = jnp.pad(v, pad)
    ctx_bias = jnp.zeros((BLOCK, lc), jnp.float32)

    def block(i):
        start = i * BLOCK
        qb = lax.dynamic_slice_in_dim(qg, start, BLOCK, axis=1)
        kb = lax.dynamic_slice_in_dim(kp, start, BAND, axis=1)
        vb = lax.dynamic_slice_in_dim(vp, start, BAND, axis=1)
        tq = start + jnp.arange(BLOCK)
        ts = start - WINDOW + jnp.arange(BAND)
        valid = (jnp.abs(tq[:, None] - ts[None, :]) <= WINDOW) & (ts[None, :] >= 0) & (ts[None, :] < s_len)
        band_bias = jnp.where(valid, 0.0, -jnp.inf).astype(jnp.float32)
        keys = jnp.concatenate([kc, kb], axis=1)
        vals = jnp.concatenate([vc, vb], axis=1)
        bias = jnp.concatenate([ctx_bias, band_bias], axis=1)
        return gqa_sink_attend(qb, keys, vals, bias, sink_g)

    out = lax.map(block, jnp.arange(nb))
    return jnp.transpose(out, (1, 0, 2, 3)).reshape(b, s_len, H_A * DH_A)


def mla_attend(qn, qr, kn, kr, v):
    s = (jnp.einsum('bqhd,bkhd->bhqk', qn, kn, preferred_element_type=jnp.float32)
         + jnp.einsum('bqhr,bkr->bhqk', qr, kr, preferred_element_type=jnp.float32)) * MLA_SCALE
    p = jax.nn.softmax(s, axis=-1)
    o = jnp.einsum('bhqk,bkhd->bqhd', p.astype(v.dtype), v)
    return o.reshape(qn.shape[0], qn.shape[1], H_B * V_B)


def mla_latent(qn, qr, kn, kr, v):
    b, s_len = qn.shape[:2]
    nb = s_len // BLOCK

    def block(i):
        start = i * BLOCK
        qnb = lax.dynamic_slice_in_dim(qn, start, BLOCK, axis=1)
        qrb = lax.dynamic_slice_in_dim(qr, start, BLOCK, axis=1)
        return mla_attend(qnb, qrb, kn, kr, v)

    out = lax.map(block, jnp.arange(nb))
    return jnp.transpose(out, (1, 0, 2, 3)).reshape(b, s_len, H_B * V_B)


def project_groups(t, w_in, q_norm, kv_norm, w_q_up, w_kv_up):
    bt, n = t.shape[:2]
    p = jnp.einsum('bsd,de->bse', t, w_in)
    qa, ka, va, cq, ckv, kr = jnp.split(p, SPLIT_POINTS, axis=-1)
    qa = qa.reshape(bt, n, H_A, DH_A)
    ka = ka.reshape(bt, n, KV_A, DH_A)
    va = va.reshape(bt, n, KV_A, DH_A)
    qb = jnp.einsum('bsr,re->bse', rmsnorm(cq, q_norm), w_q_up).reshape(bt, n, H_B, NOPE_B + ROPE_B)
    kvb = jnp.einsum('bsr,re->bse', rmsnorm(ckv, kv_norm), w_kv_up).reshape(bt, n, H_B, NOPE_B + V_B)
    return (qa, ka, va, qb[..., :NOPE_B], qb[..., NOPE_B:], kr,
            kvb[..., :NOPE_B], kvb[..., NOPE_B:])


def token_mixers(h, hc, rows, cols, w_in, sink, q_norm, kv_norm, w_q_up, w_kv_up, w_out, with_ctx_out):
    sink_g = sink.reshape(KV_A, G_A)
    qa, ka, va, qbn, qbr, kr, kbn, vb = project_groups(h, w_in, q_norm, kv_norm, w_q_up, w_kv_up)
    qa_c, ka_c, va_c, qbn_c, qbr_c, kr_c, kbn_c, vb_c = project_groups(hc, w_in, q_norm, kv_norm, w_q_up, w_kv_up)
    qa = axial_rope(qa, rows, cols)
    ka = axial_rope(ka, rows, cols)
    qbr = axial_rope(qbr, rows, cols)
    kr = axial_rope(kr[:, :, None, :], rows, cols)[:, :, 0, :]
    o_a = window_attention_latent(qa, ka, va, ka_c, va_c, sink_g)
    o_b = mla_latent(qbn, qbr,
                     jnp.concatenate([kbn_c, kbn], axis=1),
                     jnp.concatenate([kr_c, kr], axis=1),
                     jnp.concatenate([vb_c, vb], axis=1))
    out = jnp.einsum('bse,ed->bsd', jnp.concatenate([o_a, o_b], axis=-1), w_out)
    if not with_ctx_out:
        return out, None
    lc = hc.shape[1]
    o_a_c = gqa_sink_attend(qa_c.reshape(hc.shape[0], lc, KV_A, G_A, DH_A), ka_c, va_c, None, sink_g)
    o_b_c = mla_attend(qbn_c, qbr_c, kbn_c, kr_c, vb_c)
    out_c = jnp.einsum('bse,ed->bsd', jnp.concatenate([o_a_c, o_b_c], axis=-1), w_out)
    return out, out_c


def ec_moe(h, w_router, w_gate, w_up, w_down):
    n = h.shape[1]
    cap = CAP_FACTOR * n // N_EXPERTS
    aff = jax.nn.softmax(jnp.einsum('bnd,de->bne', h, w_router, preferred_element_type=jnp.float32), axis=-1)
    vals, idx = lax.top_k(jnp.swapaxes(aff, 1, 2), cap)

    def per_sample(hs, idx_s, val_s):
        xs = hs[idx_s]
        a = jnp.einsum('ecd,edf->ecf', xs, w_gate)
        u = jnp.einsum('ecd,edf->ecf', xs, w_up)
        y = jnp.einsum('ecf,efd->ecd', jax.nn.silu(a) * u, w_down) * val_s[..., None].astype(hs.dtype)
        return jnp.zeros_like(hs).at[idx_s.reshape(-1)].add(y.reshape(-1, hs.shape[-1]).astype(hs.dtype))

    return jax.vmap(per_sample)(h, idx, vals)


def setup_inputs(seed: int = 0) -> dict:
    key = jax.random.key(seed)
    ks = jax.random.split(key, 20)
    f32 = jnp.float32
    L = DEPTH

    def nrm(k, shape, scale):
        return jax.random.normal(k, shape, f32) * scale

    return {
        "x": nrm(ks[0], (BATCH, SEQ, D_MODEL), 1.0),
        "c": nrm(ks[1], (BATCH, D_MODEL), 1.0),
        "ctx": nrm(ks[2], (BATCH, CTX_LEN, D_MODEL), 1.0),
        "c_ctx": nrm(ks[3], (D_MODEL,), 1.0),
        "w_mod": nrm(ks[4], (L, D_MODEL, 6 * D_MODEL), 0.5 * D_MODEL ** -0.5),
        "b_mod": nrm(ks[5], (L, 6 * D_MODEL), 0.01),
        "norm_attn": 1.0 + nrm(ks[6], (L, D_MODEL), 0.02),
        "norm_ffn": 1.0 + nrm(ks[7], (L, D_MODEL), 0.02),
        "w_in": nrm(ks[8], (L, D_MODEL, IN_DIM), D_MODEL ** -0.5),
        "sink": nrm(ks[9], (L, H_A), 0.5),
        "q_norm": 1.0 + nrm(ks[10], (L, Q_RANK), 0.02),
        "kv_norm": 1.0 + nrm(ks[11], (L, KV_RANK), 0.02),
        "w_q_up": nrm(ks[12], (L, Q_RANK, H_B * (NOPE_B + ROPE_B)), Q_RANK ** -0.5),
        "w_kv_up": nrm(ks[13], (L, KV_RANK, H_B * (NOPE_B + V_B)), KV_RANK ** -0.5),
        "w_out": nrm(ks[14], (L, MIX_DIM, D_MODEL), MIX_DIM ** -0.5),
        "w_router": nrm(ks[15], (L, D_MODEL, N_EXPERTS), D_MODEL ** -0.5),
        "w_gate": nrm(ks[16], (L, N_EXPERTS, D_MODEL, D_FF), D_MODEL ** -0.5),
        "w_up": nrm(ks[17], (L, N_EXPERTS, D_MODEL, D_FF), D_MODEL ** -0.5),
        "w_down": nrm(ks[18], (L, N_EXPERTS, D_FF, D_MODEL), D_FF ** -0.5),
        "norm_final": 1.0 + nrm(ks[19], (D_MODEL,), 0.02),
    }


def reference(x, c, ctx, c_ctx, w_mod, b_mod, norm_attn, norm_ffn, w_in, sink, q_norm, kv_norm,
              w_q_up, w_kv_up, w_out, w_router, w_gate, w_up, w_down, norm_final):
    n_lat = x.shape[1]
    ROWS = n_lat // GRID_W
    rows = jnp.repeat(jnp.arange(ROWS, dtype=jnp.int32), GRID_W)
    cols = jnp.tile(jnp.arange(GRID_W, dtype=jnp.int32), ROWS)
    xc = ctx
    for l in range(DEPTH):
        last = l == DEPTH - 1
        mod = jnp.einsum('bd,de->be', jax.nn.silu(c), w_mod[l]) + b_mod[l]
        mod_c = jnp.einsum('d,de->e', jax.nn.silu(c_ctx), w_mod[l]) + b_mod[l]
        sh_a, sc_a, g_a, sh_f, sc_f, g_f = [m[:, None, :] for m in jnp.split(mod, 6, axis=-1)]
        csh_a, csc_a, cg_a, csh_f, csc_f, cg_f = jnp.split(mod_c, 6, axis=-1)

        h = modulate(rmsnorm(x, norm_attn[l]), sh_a, sc_a)
        hc = modulate(rmsnorm(xc, norm_attn[l]), csh_a, csc_a)
        mix, mix_c = token_mixers(h, hc, rows, cols, w_in[l], sink[l], q_norm[l], kv_norm[l],
                                  w_q_up[l], w_kv_up[l], w_out[l], not last)
        x = x + g_a * mix
        h2 = modulate(rmsnorm(x, norm_ffn[l]), sh_f, sc_f)
        x = x + g_f * ec_moe(h2, w_router[l], w_gate[l], w_up[l], w_down[l])

        if not last:
            xc = xc + cg_a * mix_c
            h2c = modulate(rmsnorm(xc, norm_ffn[l]), csh_f, csc_f)
            xc = xc + cg_f * ec_moe(h2c, w_router[l], w_gate[l], w_up[l], w_down[l])
    return rmsnorm(x, norm_final)
```

```cpp
#include <hip/hip_runtime.h>
#include <hip/hip_cooperative_groups.h>
#include <cstdint>
#include <cstdio>
namespace cg = cooperative_groups;

#ifndef MK_SPLIT
#define MK_SPLIT 0
#endif
#ifndef FAST_GEMM
#define FAST_GEMM 1
#endif
#ifndef FAST_ATTN
#define FAST_ATTN 1
#endif

typedef unsigned short bf16_t;
typedef short bf16x8 __attribute__((ext_vector_type(8)));
typedef float f32x4 __attribute__((ext_vector_type(4)));
typedef float f32x16 __attribute__((ext_vector_type(16)));
typedef unsigned u32x4 __attribute__((ext_vector_type(4)));
typedef unsigned u32x2 __attribute__((ext_vector_type(2)));

constexpr int NTHR = 512, NWAVE = 8;
constexpr int NB = 4, SEQ = 8192, LC = 256, TT = SEQ + LC, MR = NB * TT, DM = 1024, DEPTH = 2;
constexpr int NIN = 1440, NINP = 1536, QRK = 384, KVRK = 256, NQB = 768, NKVB = 1024;
constexpr int NE = 16, DFF = 512, CAPL = 1024, CAPC = 32;
constexpr int NSLOT = NB * NE * CAPL + NE * 256;
constexpr float EPS = 1e-6f;
constexpr float LOG2E = 1.4426950408889634f;
constexpr float SCALE_A = 0.125f * LOG2E;
constexpr float SCALE_B = 0.10206207261596575f * LOG2E;

constexpr size_t al256(size_t v) { return (v + 255) / 256 * 256; }
constexpr size_t OFF_CTL = 0;
constexpr size_t OFF_MOD = 1u << 20;
constexpr size_t OFF_ROPE = OFF_MOD + al256((size_t)2 * 5 * 6144 * 4);
constexpr size_t OFF_SSQQ = OFF_ROPE + al256((size_t)(2 * 2048 + 2 * 1024) * 4);
constexpr size_t OFF_SSQK = OFF_SSQQ + al256((size_t)MR * 4);
constexpr size_t OFF_AFF = OFF_SSQK + al256((size_t)MR * 4);
constexpr size_t OFF_INV = OFF_AFF + al256((size_t)MR * 16 * 4);
constexpr size_t OFF_IDX = OFF_INV + al256((size_t)MR * 16 * 4);
constexpr size_t OFF_VAL = OFF_IDX + al256((size_t)NSLOT * 4);
constexpr size_t OFF_KR = OFF_VAL + al256((size_t)NSLOT * 4);
constexpr size_t SZ_WIN = (size_t)NINP * DM * 2, SZ_WQ = (size_t)NQB * QRK * 2, SZ_WKV = (size_t)NKVB * KVRK * 2, SZ_WO = (size_t)DM * DM * 2;
constexpr size_t SZ_WL = SZ_WIN + SZ_WQ + SZ_WKV + SZ_WO;
constexpr size_t OFF_W = OFF_KR + al256((size_t)MR * 32 * 2);
constexpr size_t OFF_WGU = OFF_W + 2 * SZ_WL;
constexpr size_t OFF_WD = OFF_WGU + (size_t)NE * 1024 * 1024 * 2;
constexpr size_t OFF_X = OFF_WD + (size_t)NE * 1024 * 512 * 2;
constexpr size_t OFF_R = OFF_X + (size_t)MR * DM * 4;
constexpr size_t R_H = 0;
constexpr size_t R_QA = R_H + (size_t)MR * DM * 2;
constexpr size_t R_KA = R_QA + (size_t)MR * 512 * 2;
constexpr size_t R_VA = R_KA + (size_t)MR * 128 * 2;
constexpr size_t R_QB = R_VA + (size_t)MR * 128 * 2;
constexpr size_t R_KB = R_QB + (size_t)MR * 768 * 2;
constexpr size_t R_VB = R_KB + (size_t)MR * 512 * 2;
constexpr size_t R_CQ = R_VB + (size_t)MR * 512 * 2;
constexpr size_t R_CKV = R_CQ + (size_t)MR * QRK * 2;
constexpr size_t R_END = R_CKV + (size_t)MR * KVRK * 2;
constexpr size_t R_MIXG = R_QA;
constexpr size_t R_ACT = R_QA;
constexpr size_t R_Y = R_ACT + (size_t)NSLOT * DFF * 2;
static_assert(R_Y + (size_t)NSLOT * DM * 2 <= R_END, "moe overlay fits");
constexpr size_t WS_END = OFF_R + R_END;

struct Prm {
  const float *x, *c, *ctx, *c_ctx, *w_mod, *b_mod, *norm_attn, *norm_ffn, *w_in, *sink, *q_norm, *kv_norm, *w_q_up, *w_kv_up, *w_out, *w_router, *w_gate, *w_up,
      *w_down, *norm_final;
  float* out;
  unsigned char* ws;
};

__device__ __forceinline__ float bf2f(bf16_t v) { return __uint_as_float((unsigned)v << 16); }
__device__ __forceinline__ bf16_t f2bf(float f) { unsigned u = __float_as_uint(f); return (bf16_t)((u + 0x7fffu + ((u >> 16) & 1u)) >> 16); }
__device__ __forceinline__ unsigned pk2(float lo, float hi) { return (unsigned)f2bf(lo) | ((unsigned)f2bf(hi) << 16); }
template <int CTRL> __device__ __forceinline__ float dpp_mov(float x) { return __int_as_float(__builtin_amdgcn_update_dpp(0, __float_as_int(x), CTRL, 0xF, 0xF, true)); }
__device__ __forceinline__ float xor1(float x) { return dpp_mov<0xB1>(x); }
__device__ __forceinline__ float xor2(float x) { return dpp_mov<0x4E>(x); }
__device__ __forceinline__ float hmir(float x) { return dpp_mov<0x141>(x); }
__device__ __forceinline__ float xor8(float x) { return dpp_mov<0x128>(x); }
__device__ __forceinline__ float sum16sw(float x) { auto r = __builtin_amdgcn_permlane16_swap(__float_as_uint(x), __float_as_uint(x), false, false); return __uint_as_float(r[0]) + __uint_as_float(r[1]); }
__device__ __forceinline__ float sum32sw(float x) { auto r = __builtin_amdgcn_permlane32_swap(__float_as_uint(x), __float_as_uint(x), false, false); return __uint_as_float(r[0]) + __uint_as_float(r[1]); }
__device__ __forceinline__ float max16sw(float x) { auto r = __builtin_amdgcn_permlane16_swap(__float_as_uint(x), __float_as_uint(x), false, false); return fmaxf(__uint_as_float(r[0]), __uint_as_float(r[1])); }
__device__ __forceinline__ float max32sw(float x) { auto r = __builtin_amdgcn_permlane32_swap(__float_as_uint(x), __float_as_uint(x), false, false); return fmaxf(__uint_as_float(r[0]), __uint_as_float(r[1])); }
__device__ __forceinline__ float wave_sum(float v) {
  v += xor1(v); v += xor2(v); v += hmir(v); v += xor8(v); v = sum16sw(v); v = sum32sw(v);
  return v;
}
__device__ __forceinline__ float silu_f(float v) { return v / (1.f + __expf(-v)); }
__device__ __forceinline__ float silu_fast(float v) { return v * __builtin_amdgcn_rcpf(1.f + __builtin_amdgcn_exp2f(-1.4426950408889634f * v)); }
__device__ __forceinline__ unsigned cvtpk_e(float lo, float hi) { unsigned r; asm volatile("v_cvt_pk_bf16_f32 %0, %1, %2" : "=v"(r) : "v"(lo), "v"(hi)); return r; }
__device__ __forceinline__ int row_mi(int r) { const int b = r / TT, t = r - b * TT; return t < LC ? 4 : b; }

__device__ __forceinline__ int opaque_tid() { int t = __builtin_amdgcn_workitem_id_x(); asm volatile("" : "+v"(t)); return t; }
#define TIDX opaque_tid()
#define WSP(T, off) ((T*)(p.ws + (off)))

__device__ __forceinline__ void ph_mod(const Prm& p, int l, unsigned char* lds, int bid, int nb) {
  float* sc = (float*)lds;
  float* red = sc + 5 * 1024;
  const int tid = TIDX;
  for (int i = tid; i < 5 * 1024; i += NTHR) { const int mi = i >> 10, d = i & 1023; const float v = mi < 4 ? p.c[mi * 1024 + d] : p.c_ctx[d]; sc[i] = silu_f(v); }
  __syncthreads();
  float* MOD = WSP(float, OFF_MOD);
  const int cl = tid & 31, kg = tid >> 5;
  for (int it = bid; it < 192; it += nb) {
    const int e0 = it * 32;
    const float* w = p.w_mod + (size_t)l * 1024 * 6144 + e0 + cl;
    float a0 = 0, a1 = 0, a2 = 0, a3 = 0, a4 = 0;
    for (int kk = 0; kk < 64; ++kk) { const int d = kg * 64 + kk; const float wv = w[(size_t)d * 6144];
      a0 += sc[d] * wv; a1 += sc[1024 + d] * wv; a2 += sc[2048 + d] * wv; a3 += sc[3072 + d] * wv; a4 += sc[4096 + d] * wv; }
    float* rr = red + (kg * 32 + cl) * 5; rr[0] = a0; rr[1] = a1; rr[2] = a2; rr[3] = a3; rr[4] = a4;
    __syncthreads();
    if (tid < 160) { const int c2 = tid & 31, mi = tid >> 5; float s = 0; for (int g = 0; g < 16; ++g) s += red[(g * 32 + c2) * 5 + mi];
      MOD[(size_t)(l * 5 + mi) * 6144 + e0 + c2] = s + p.b_mod[l * 6144 + e0 + c2]; }
    __syncthreads();
  }
}

template <class Src>
__device__ __forceinline__ void tr_tile(const Src& src, bf16_t* dst, int K, int k0, int n0, float* tl  ) {
  const int tid = TIDX;
#pragma unroll
  for (int i = 0; i < 8; ++i) { const int e = tid + i * NTHR, kk = e >> 6, nn = e & 63; tl[kk * 65 + nn] = src(k0 + kk, n0 + nn); }
  __syncthreads();
#pragma unroll
  for (int i = 0; i < 2; ++i) { const int e = tid + i * NTHR, nn = e >> 4, kc = (e & 15) * 4;
    u32x2 o; o.x = pk2(tl[(kc + 0) * 65 + nn], tl[(kc + 1) * 65 + nn]); o.y = pk2(tl[(kc + 2) * 65 + nn], tl[(kc + 3) * 65 + nn]);
    *(u32x2*)(dst + (size_t)(n0 + nn) * K + k0 + kc) = o; }
  __syncthreads();
}
struct SrcIn { const float* w; __device__ float operator()(int k, int n) const { return n < NIN ? w[(size_t)k * NIN + n] : 0.f; } };
struct SrcScaled { const float* w; const float* nv; int N; __device__ float operator()(int k, int n) const { return w[(size_t)k * N + n] * nv[k]; } };
struct SrcPlain { const float* w; int N; __device__ float operator()(int k, int n) const { return w[(size_t)k * N + n]; } };
#if FAST_GEMM
struct SrcGU { const float* g; const float* u; __device__ float operator()(int k, int n) const { const int t = n >> 8, w = n & 255; return w < 128 ? g[(size_t)k * DFF + t * 128 + w] : u[(size_t)k * DFF + t * 128 + w - 128]; } };
#else
struct SrcGU { const float* g; const float* u; __device__ float operator()(int k, int n) const { const int t = n >> 6, w = n & 63; return w < 32 ? g[(size_t)k * DFF + t * 32 + w] : u[(size_t)k * DFF + t * 32 + w - 32]; } };
#endif

__device__ __forceinline__ void ph_wconv_dense(const Prm& p, int l, unsigned char* lds, int bid, int nb) {
  float* tl = (float*)lds;
  constexpr int T_IN = (DM / 64) * (NINP / 64), T_Q = (QRK / 64) * (NQB / 64), T_KV = (KVRK / 64) * (NKVB / 64), T_O = (DM / 64) * (DM / 64), T_L = T_IN + T_Q + T_KV + T_O;
  for (int it = bid; it < T_L; it += nb) {
    int r = it;
    bf16_t* wb = (bf16_t*)(p.ws + OFF_W + (size_t)l * SZ_WL);
    if (r < T_IN) { const int kt = r / (NINP / 64), nt = r % (NINP / 64); tr_tile(SrcIn{p.w_in + (size_t)l * DM * NIN}, wb, DM, kt * 64, nt * 64, tl); continue; } r -= T_IN;
    if (r < T_Q) { const int kt = r / (NQB / 64), nt = r % (NQB / 64); tr_tile(SrcScaled{p.w_q_up + (size_t)l * QRK * NQB, p.q_norm + l * QRK, NQB}, (bf16_t*)((unsigned char*)wb + SZ_WIN), QRK, kt * 64, nt * 64, tl); continue; } r -= T_Q;
    if (r < T_KV) { const int kt = r / (NKVB / 64), nt = r % (NKVB / 64); tr_tile(SrcScaled{p.w_kv_up + (size_t)l * KVRK * NKVB, p.kv_norm + l * KVRK, NKVB}, (bf16_t*)((unsigned char*)wb + SZ_WIN + SZ_WQ), KVRK, kt * 64, nt * 64, tl); continue; } r -= T_KV;
    { const int kt = r / (DM / 64), nt = r % (DM / 64); tr_tile(SrcPlain{p.w_out + (size_t)l * DM * DM, DM}, (bf16_t*)((unsigned char*)wb + SZ_WIN + SZ_WQ + SZ_WKV), DM, kt * 64, nt * 64, tl); }
  }
}
constexpr int WCB = 4;
struct WcItem { const float* sp; int ss; bf16_t* dp; int dK; };
__device__ __forceinline__ WcItem wc_item(const Prm& p, int l, int it) {
  constexpr int T_GU = (DM / 64) * (1024 / 64), T_D = (DFF / 64) * (DM / 64), T_E = T_GU + T_D;
  const int e = it / T_E; int r = it % T_E; WcItem w;
  if (r < T_GU) { const int kt = r >> 4, nt = r & 15, n0 = nt * 64, t = n0 >> 8, wq = n0 & 255;
    const float* src = (wq < 128 ? p.w_gate : p.w_up) + ((size_t)l * NE + e) * DM * DFF;
    w.sp = src + (size_t)(kt * 64) * DFF + t * 128 + (wq & 127); w.ss = DFF; w.dp = WSP(bf16_t, OFF_WGU) + (size_t)e * 1024 * 1024 + (size_t)n0 * DM + kt * 64; w.dK = DM; }
  else { r -= T_GU; const int kt = r >> 4, nt = r & 15;
    w.sp = p.w_down + ((size_t)l * NE + e) * DFF * DM + (size_t)(kt * 64) * DM + nt * 64; w.ss = DM; w.dp = WSP(bf16_t, OFF_WD) + (size_t)e * 1024 * 512 + (size_t)(nt * 64) * DFF + kt * 64; w.dK = DFF; }
  return w;
}
__device__ __forceinline__ void ph_wconv_moe(const Prm& p, int l, unsigned char* lds, int rank, int nranks) {
  float* tl = (float*)lds;
  constexpr int T_GU = (DM / 64) * (1024 / 64), T_D = (DFF / 64) * (DM / 64), T_E = T_GU + T_D, NIT = NE * T_E;
  const int tid = TIDX;
  for (int base = rank; base < NIT; base += nranks * WCB) {
    f32x4 rg[WCB][2];
#pragma unroll
    for (int d = 0; d < WCB; ++d) { const int it = base + d * nranks;
      if (it < NIT) { const WcItem w = wc_item(p, l, it);
#pragma unroll
        for (int i = 0; i < 2; ++i) { const int e = tid + i * NTHR, kk = e >> 4, n4 = (e & 15) * 4; rg[d][i] = __builtin_nontemporal_load((const f32x4*)(w.sp + (size_t)kk * w.ss + n4)); } } }
#pragma unroll
    for (int d = 0; d < WCB; ++d) { const int it = base + d * nranks;
      if (it < NIT) { const WcItem w = wc_item(p, l, it); float* t = tl + (d & 1) * (64 * 65);
#pragma unroll
        for (int i = 0; i < 2; ++i) { const int e = tid + i * NTHR, kk = e >> 4, n4 = (e & 15) * 4;
#pragma unroll
          for (int j = 0; j < 4; ++j) t[kk * 65 + n4 + j] = rg[d][i][j]; }
        __syncthreads();
#pragma unroll
        for (int i = 0; i < 2; ++i) { const int e = tid + i * NTHR, nn = e >> 4, kc = (e & 15) * 4;
          u32x2 o; o.x = pk2(t[(kc + 0) * 65 + nn], t[(kc + 1) * 65 + nn]); o.y = pk2(t[(kc + 2) * 65 + nn], t[(kc + 3) * 65 + nn]);
          *(u32x2*)(w.dp + (size_t)nn * w.dK + kc) = o; } } }
  }
  __syncthreads();
}

typedef int i32x4 __attribute__((ext_vector_type(4)));
__device__ __forceinline__ void y_acc(f32x4 (&s)[4], const u32x2 (&y)[4]) {
#pragma unroll
  for (int j = 0; j < 4; ++j) { s[j][0] += __uint_as_float(y[j].x << 16); s[j][1] += __uint_as_float(y[j].x & 0xffff0000u); s[j][2] += __uint_as_float(y[j].y << 16); s[j][3] += __uint_as_float(y[j].y & 0xffff0000u); }
}
struct RowLd { f32x4 x[4]; i32x4 q[4]; };
__device__ __forceinline__ void row_issue(const Prm& p, int l, int r, int lane, RowLd& R) {
  const int b = r / TT, t = r - b * TT;
  if (l == 0) { const float* src = t < LC ? p.ctx + ((size_t)b * LC + t) * DM : p.x + ((size_t)b * SEQ + (t - LC)) * DM;
#pragma unroll
    for (int j = 0; j < 4; ++j) R.x[j] = *(const f32x4*)(src + 4 * lane + 256 * j);
  } else { int zv = 0; asm volatile("" : "+v"(zv));
    const float* X = WSP(float, OFF_X) + (size_t)r * DM; const i32x4* inv = (const i32x4*)(WSP(int, OFF_INV) + (size_t)r * 16 + zv);
#pragma unroll
    for (int j = 0; j < 4; ++j) { R.x[j] = *(const f32x4*)(X + 4 * lane + 256 * j); R.q[j] = inv[j]; } }
}
__device__ __forceinline__ void row_finish(const Prm& p, int l, int r, int lane, RowLd& R, f32x4 (&v)[4]) {
  if (l == 0) {
#pragma unroll
    for (int j = 0; j < 4; ++j) v[j] = R.x[j];
    return; }
  const int b = r / TT, t = r - b * TT;
  const bf16_t* Y = (const bf16_t*)(p.ws + OFF_R + R_Y) + 4 * lane;
  int c0 = 0, c1 = 0, c2 = 0, c3 = 0, cnt = 0;
#pragma unroll
  for (int e = 0; e < 16; ++e) { const int sv = __builtin_amdgcn_readfirstlane(R.q[e >> 2][e & 3]);
    if (sv >= 0) { c0 = cnt == 0 ? sv : c0; c1 = cnt == 1 ? sv : c1; c2 = cnt == 2 ? sv : c2; c3 = cnt == 3 ? sv : c3; ++cnt; } }
  u32x2 y0[4], y1[4], y2[4], y3[4];
#pragma unroll
  for (int j = 0; j < 4; ++j) { y0[j] = (u32x2){0u, 0u}; y1[j] = y0[j]; y2[j] = y0[j]; y3[j] = y0[j]; }
  if (cnt > 0) {
#pragma unroll
    for (int j = 0; j < 4; ++j) y0[j] = *(const u32x2*)(Y + (size_t)c0 * DM + 256 * j); }
  if (cnt > 1) {
#pragma unroll
    for (int j = 0; j < 4; ++j) y1[j] = *(const u32x2*)(Y + (size_t)c1 * DM + 256 * j); }
  if (cnt > 2) {
#pragma unroll
    for (int j = 0; j < 4; ++j) y2[j] = *(const u32x2*)(Y + (size_t)c2 * DM + 256 * j); }
  if (cnt > 3) {
#pragma unroll
    for (int j = 0; j < 4; ++j) y3[j] = *(const u32x2*)(Y + (size_t)c3 * DM + 256 * j); }
  f32x4 s[4];
#pragma unroll
  for (int j = 0; j < 4; ++j) s[j] = (f32x4){0.f, 0.f, 0.f, 0.f};
  y_acc(s, y0); y_acc(s, y1); y_acc(s, y2); y_acc(s, y3);
  if (cnt > 4) { int k = 0;
#pragma unroll
    for (int e = 0; e < 16; ++e) { const int sv = __builtin_amdgcn_readfirstlane(R.q[e >> 2][e & 3]);
      if (sv >= 0) { if (k >= 4) { u32x2 yy[4];
#pragma unroll
          for (int j = 0; j < 4; ++j) yy[j] = *(const u32x2*)(Y + (size_t)sv * DM + 256 * j);
          y_acc(s, yy); }
        ++k; } } }
  const float* gf = WSP(float, OFF_MOD) + (size_t)((l - 1) * 5 + (t < LC ? 4 : b)) * 6144 + 5 * 1024;
#pragma unroll
  for (int j = 0; j < 4; ++j) { const f32x4 g = *(const f32x4*)(gf + 4 * lane + 256 * j); v[j] = R.x[j] + g * s[j]; }
}
__device__ __forceinline__ float row_ssq(const f32x4 (&v)[4]) { float ss = 0.f;
#pragma unroll
  for (int j = 0; j < 4; ++j) ss += v[j][0] * v[j][0] + v[j][1] * v[j][1] + v[j][2] * v[j][2] + v[j][3] * v[j][3];
  return wave_sum(ss); }
__device__ __forceinline__ void norm_a_store(const Prm& p, int l, int r, int lane, const f32x4 (&v)[4]) {
  const float rs = rsqrtf(row_ssq(v) * (1.f / DM) + EPS);
  const float* md = WSP(float, OFF_MOD) + (size_t)(l * 5 + row_mi(r)) * 6144;
  float* X = WSP(float, OFF_X) + (size_t)r * DM; bf16_t* H = (bf16_t*)(p.ws + OFF_R + R_H) + (size_t)r * DM;
  if (lane == 0) { WSP(float, OFF_SSQQ)[r] = 0.f; WSP(float, OFF_SSQK)[r] = 0.f; }
#pragma unroll
  for (int j = 0; j < 4; ++j) { const int c = 4 * lane + 256 * j;
    *(f32x4*)(X + c) = v[j];
    const f32x4 nw = *(const f32x4*)(p.norm_attn + l * DM + c), sh = *(const f32x4*)(md + c), scl = *(const f32x4*)(md + 1024 + c);
    const f32x4 h = v[j] * rs * nw * (scl + 1.f) + sh;
    u32x2 o; o.x = pk2(h[0], h[1]); o.y = pk2(h[2], h[3]); *(u32x2*)(H + c) = o; }
}
constexpr int RPI = 4, RPA = 2;
#define ROWPIPE(R0, R1, ROWOF, LAYER, STORE) do { \
    RowLd A0, A1, B0, B1; f32x4 va[4], vb[4]; \
    int r = (R0); \
    if (r < (R1)) row_issue(p, LAYER, ROWOF(r), lane, A0); if (r + 1 < (R1)) row_issue(p, LAYER, ROWOF(r + 1), lane, A1); \
    for (; r < (R1); r += 4) { \
      if (r + 2 < (R1)) row_issue(p, LAYER, ROWOF(r + 2), lane, B0); if (r + 3 < (R1)) row_issue(p, LAYER, ROWOF(r + 3), lane, B1); \
      row_finish(p, LAYER, ROWOF(r), lane, A0, va); if (r + 1 < (R1)) row_finish(p, LAYER, ROWOF(r + 1), lane, A1, vb); \
      STORE(r, va); if (r + 1 < (R1)) STORE(r + 1, vb); \
      if (r + 2 >= (R1)) break; \
      if (r + 4 < (R1)) row_issue(p, LAYER, ROWOF(r + 4), lane, A0); if (r + 5 < (R1)) row_issue(p, LAYER, ROWOF(r + 5), lane, A1); \
      row_finish(p, LAYER, ROWOF(r + 2), lane, B0, va); if (r + 3 < (R1)) row_finish(p, LAYER, ROWOF(r + 3), lane, B1, vb); \
      STORE(r + 2, va); if (r + 3 < (R1)) STORE(r + 3, vb); \
    } } while (0)
__device__ __forceinline__ void ph_norm_a(const Prm& p, int l, int bid, int nb) {
  const int lane = TIDX & 63, wv = __builtin_amdgcn_readfirstlane(TIDX >> 6);
  const int nw = nb * NWAVE, rpw = (MR + nw - 1) / nw, gw = bid * NWAVE + wv;
  const int r0 = gw * rpw, r1 = min(MR, r0 + rpw);
#define ROWID(x) (x)
#define NA_STORE(x, v) norm_a_store(p, l, (x), lane, v)
  ROWPIPE(r0, r1, ROWID, l, NA_STORE);
#undef ROWID
#undef NA_STORE
}
__device__ __forceinline__ void final_store(const Prm& p, int q, int lane, const f32x4 (&v)[4]) {
  const float rs = rsqrtf(row_ssq(v) * (1.f / DM) + EPS); float* o = p.out + (size_t)q * DM;
#pragma unroll
  for (int j = 0; j < 4; ++j) { const int c = 4 * lane + 256 * j; *(f32x4*)(o + c) = v[j] * rs * *(const f32x4*)(p.norm_final + c); }
}
__device__ __forceinline__ void ph_final(const Prm& p, int bid, int nb) {
  const int lane = TIDX & 63, wv = __builtin_amdgcn_readfirstlane(TIDX >> 6);
  const int nw = nb * NWAVE, NQ = NB * SEQ, rpw = (NQ + nw - 1) / nw, gw = bid * NWAVE + wv;
  const int q0 = gw * rpw, q1 = min(NQ, q0 + rpw);
#define ROWQ(x) (((x) / SEQ) * TT + LC + ((x) % SEQ))
#define FIN_STORE(x, v) final_store(p, (x), lane, v)
  ROWPIPE(q0, q1, ROWQ, DEPTH, FIN_STORE);
#undef ROWQ
#undef FIN_STORE
}
template <bool ROUTER>
__device__ __forceinline__ void norm_b_row(const Prm& p, int l, int r, int lane, const f32x4 (&v)[4], const float* wl) {
  const int b = r / TT, t = r - b * TT;
  const float rs = rsqrtf(row_ssq(v) * (1.f / DM) + EPS);
  const float* md = WSP(float, OFF_MOD) + (size_t)(l * 5 + (t < LC ? 4 : b)) * 6144;
  bf16_t* H = (bf16_t*)(p.ws + OFF_R + R_H) + (size_t)r * DM;
  float lg[NE];
#pragma unroll
  for (int e = 0; e < NE; ++e) lg[e] = 0.f;
#pragma unroll
  for (int j = 0; j < 4; ++j) { const int c = 4 * lane + 256 * j;
    const f32x4 nw = *(const f32x4*)(p.norm_ffn + l * DM + c), sh = *(const f32x4*)(md + 3 * 1024 + c), scl = *(const f32x4*)(md + 4 * 1024 + c);
    const f32x4 h = v[j] * rs * nw * (scl + 1.f) + sh;
    u32x2 o; o.x = pk2(h[0], h[1]); o.y = pk2(h[2], h[3]); *(u32x2*)(H + c) = o;
    if (ROUTER)
#pragma unroll
    for (int ip = 0; ip < 2; ++ip) {
      f32x4 w8[2][4];
#pragma unroll
      for (int i2 = 0; i2 < 2; ++i2)
#pragma unroll
        for (int e4 = 0; e4 < 4; ++e4) w8[i2][e4] = *(const f32x4*)(wl + ((((j * 4 + ip * 2 + i2) * 4 + e4) * 64 + lane) << 2));
      __builtin_amdgcn_sched_barrier(0);
#pragma unroll
      for (int i2 = 0; i2 < 2; ++i2)
#pragma unroll
        for (int e4 = 0; e4 < 4; ++e4) { const float hv = h[ip * 2 + i2]; const f32x4 w4 = w8[i2][e4];
          lg[4 * e4] += hv * w4[0]; lg[4 * e4 + 1] += hv * w4[1]; lg[4 * e4 + 2] += hv * w4[2]; lg[4 * e4 + 3] += hv * w4[3]; }
      __builtin_amdgcn_sched_barrier(0);
    } }
  if (!ROUTER) return;
#pragma unroll
  for (int e = 0; e < NE; ++e) { lg[e] += xor1(lg[e]); lg[e] += xor2(lg[e]); }
  float t8[8], t4[4], t2[2], t1;
#pragma unroll
  for (int i = 0; i < 8; ++i) { auto rr = __builtin_amdgcn_permlane32_swap(__float_as_uint(lg[i]), __float_as_uint(lg[i + 8]), false, false); t8[i] = __uint_as_float(rr[0]) + __uint_as_float(rr[1]); }
#pragma unroll
  for (int i = 0; i < 4; ++i) { auto rr = __builtin_amdgcn_permlane16_swap(__float_as_uint(t8[i]), __float_as_uint(t8[i + 4]), false, false); t4[i] = __uint_as_float(rr[0]) + __uint_as_float(rr[1]); }
  { const bool hb = lane & 8;
#pragma unroll
    for (int i = 0; i < 2; ++i) { const float snd = hb ? t4[i] : t4[i + 2], kp = hb ? t4[i + 2] : t4[i]; t2[i] = kp + xor8(snd); } }
  { const bool hb = lane & 4; const float snd = hb ? t2[0] : t2[1], kp = hb ? t2[1] : t2[0]; t1 = kp + hmir(snd); }
  float mx = t1;
  mx = fmaxf(mx, hmir(mx)); mx = fmaxf(mx, xor8(mx)); mx = max16sw(mx); mx = max32sw(mx);
  const float ex = __expf(t1 - mx); float sm = ex;
  sm += hmir(sm); sm += xor8(sm); sm = sum16sw(sm); sm = sum32sw(sm);
  if ((lane & 3) == 0) WSP(float, OFF_AFF)[(size_t)r * NE + (lane >> 2)] = ex / sm;
}
template <bool ROUTER>
__device__ __forceinline__ void ph_norm_b(const Prm& p, int l, unsigned char* lds, int bid, int nb) {
  const int tid = TIDX, lane = tid & 63, wv = __builtin_amdgcn_readfirstlane(tid >> 6);
  float* wl = (float*)lds;
  { const float* wr = p.w_router + (size_t)l * DM * NE;
    for (int idx = tid; idx < DM * NE; idx += NTHR) { const int d = idx >> 4, e = idx & 15, j = d >> 8, ln = (d >> 2) & 63, i = d & 3;
      wl[((((j * 4 + i) * 4 + (e >> 2)) * 64 + ln) << 2) + (e & 3)] = wr[idx]; } }
  __syncthreads();
  const int nw = nb * NWAVE, rpw = (MR + nw - 1) / nw, gw = bid * NWAVE + wv;
  const int r0 = gw * rpw, r1 = min(MR, r0 + rpw);
  for (int r = r0; r < r1; r += RPI) {
    f32x4 v[RPI][4]; u32x2 mg[RPI][4]; bool sk[RPI];
#pragma unroll
    for (int i = 0; i < RPI; ++i) { sk[i] = (r + i >= r1) || ((l == DEPTH - 1) && ((r + i) % TT) < LC);
      if (!sk[i]) { const float* X = WSP(float, OFF_X) + (size_t)(r + i) * DM; const bf16_t* MG = (const bf16_t*)(p.ws + OFF_R + R_MIXG) + (size_t)(r + i) * DM;
#pragma unroll
        for (int j = 0; j < 4; ++j) { v[i][j] = *(const f32x4*)(X + 4 * lane + 256 * j); mg[i][j] = *(const u32x2*)(MG + 4 * lane + 256 * j); } } }
#pragma unroll
    for (int i = 0; i < RPI; ++i) if (!sk[i]) {
      float* X = WSP(float, OFF_X) + (size_t)(r + i) * DM;
#pragma unroll
      for (int j = 0; j < 4; ++j) { v[i][j][0] += __uint_as_float(mg[i][j].x << 16); v[i][j][1] += __uint_as_float(mg[i][j].x & 0xffff0000u); v[i][j][2] += __uint_as_float(mg[i][j].y << 16); v[i][j][3] += __uint_as_float(mg[i][j].y & 0xffff0000u);
        *(f32x4*)(X + 4 * lane + 256 * j) = v[i][j]; }
      norm_b_row<ROUTER>(p, l, r + i, lane, v[i], wl); }
  }
  __syncthreads();
}

__device__ __forceinline__ void ph_topk(const Prm& p, int l, unsigned char* lds, int bid, int nb) {
  unsigned* keys = (unsigned*)lds;
  unsigned* hist = keys + 8192;
  unsigned* scan = hist + 8 * 256;
  unsigned* misc = scan + 512;
  const int tid = TIDX;
  const float* AFF = WSP(float, OFF_AFF);
  int* IDX = WSP(int, OFF_IDX); float* VAL = WSP(float, OFF_VAL); int* INV = WSP(int, OFF_INV);
  const int ngroups = (l == DEPTH - 1) ? 64 : 128;
  for (int g = bid; g < ngroups; g += nb) {
    const bool isctx = g >= 64; const int b = (g & 63) >> 4, e = g & 15;
    const int n = isctx ? LC : SEQ, cap = isctx ? CAPC : CAPL, r0 = b * TT + (isctx ? 0 : LC);
    const int sbase = isctx ? (NB * NE * CAPL + e * 256 + b * 32) : ((b * NE + e) * CAPL);
    for (int i = tid; i < n; i += NTHR) keys[i] = __float_as_uint(AFF[(size_t)(r0 + i) * NE + e]);
    if (tid == 0) misc[2] = 0;
    __syncthreads();
    unsigned prefix = 0, kk = cap;
    for (int pass = 3; pass >= 0; --pass) {
      for (int i = tid; i < 8 * 256; i += NTHR) hist[i] = 0;
      __syncthreads();
      const int sh = pass * 8; const unsigned hm = pass == 3 ? 0u : (0xffffffffu << (sh + 8));
      unsigned* myh = hist + (tid >> 6) * 256;
      for (int i = tid; i < n; i += NTHR) { const unsigned k = keys[i]; if ((k & hm) == (prefix & hm)) atomicAdd(&myh[(k >> sh) & 255u], 1u); }
      __syncthreads();
      if (tid < 256) { unsigned t_ = 0;
#pragma unroll
        for (int w = 0; w < 8; ++w) t_ += hist[w * 256 + tid];
        hist[tid] = t_; }
      __syncthreads();
      if (tid < 256) { unsigned cum = 0; for (int bk = tid + 1; bk < 256; ++bk) cum += hist[bk];
        const unsigned mine = hist[tid]; if (cum < kk && kk <= cum + mine) { misc[0] = (unsigned)tid; misc[1] = kk - cum; } }
      __syncthreads();
      prefix |= misc[0] << sh; kk = misc[1];
      __syncthreads();
    }
    const int chunk = (n + NTHR - 1) / NTHR; const int i0 = tid * chunk, i1 = min(n, i0 + chunk);
    unsigned eq = 0; for (int i = i0; i < i1; ++i) eq += (keys[i] == prefix) ? 1u : 0u;
    scan[tid] = eq; __syncthreads();
    for (int o = 1; o < NTHR; o <<= 1) { const unsigned a = tid >= o ? scan[tid - o] : 0u; __syncthreads(); scan[tid] += a; __syncthreads(); }
    unsigned erank = scan[tid] - eq;
    const unsigned ngt = cap - kk;
    for (int i = i0; i < i1; ++i) { const unsigned k = keys[i]; int slot = -1;
      if (k > prefix) slot = (int)atomicAdd(&misc[2], 1u);
      else if (k == prefix) { if (erank < kk) slot = (int)(ngt + erank); ++erank; }
      const int row = r0 + i;
      if (slot >= 0) { IDX[sbase + slot] = row; VAL[sbase + slot] = __uint_as_float(k); INV[(size_t)row * NE + e] = sbase + slot; }
      else INV[(size_t)row * NE + e] = -1; }
    if (isctx && tid < 32) { IDX[NB * NE * CAPL + e * 256 + 128 + b * 32 + tid] = 0; VAL[NB * NE * CAPL + e * 256 + 128 + b * 32 + tid] = 0.f; }
    __syncthreads();
  }
}

template <int NF, class AP, class Epi>
__device__ __forceinline__ void sgemm_wave(const AP& ap, const bf16_t* __restrict__ Bt, int K, int m0, int n0, const Epi& epi) {
  const int lane = TIDX & 63, fr = lane & 15, fq = lane >> 4;
  f32x4 acc[4][NF];
#pragma unroll
  for (int i = 0; i < 4; ++i)
#pragma unroll
    for (int j = 0; j < NF; ++j) acc[i][j] = (f32x4){0.f, 0.f, 0.f, 0.f};
  const bf16_t* a_[4]; const bf16_t* b_[NF];
#pragma unroll
  for (int i = 0; i < 4; ++i) a_[i] = ap.row(m0 + 16 * i + fr) + fq * 8;
#pragma unroll
  for (int j = 0; j < NF; ++j) b_[j] = Bt + (size_t)(n0 + 16 * j + fr) * K + fq * 8;
#pragma unroll 2
  for (int k0 = 0; k0 < K; k0 += 32) {
    bf16x8 av[4], bv[NF];
#pragma unroll
    for (int i = 0; i < 4; ++i) av[i] = *(const bf16x8*)(a_[i] + k0);
#pragma unroll
    for (int j = 0; j < NF; ++j) bv[j] = *(const bf16x8*)(b_[j] + k0);
#pragma unroll
    for (int i = 0; i < 4; ++i)
#pragma unroll
      for (int j = 0; j < NF; ++j) acc[i][j] = __builtin_amdgcn_mfma_f32_16x16x32_bf16(av[i], bv[j], acc[i][j], 0, 0, 0);
  }
  epi(acc, m0, n0, fr, fq);
}
struct APDense { const bf16_t* A; int lda; __device__ __forceinline__ const bf16_t* row(int r) const { return A + (size_t)r * lda; } };
struct APGather { const bf16_t* A; const int* idx; __device__ __forceinline__ const bf16_t* row(int r) const { return A + (size_t)idx[r] * DM; } };

__device__ __forceinline__ void rope_pos(int row, bool& lat, int& rp, int& cp) { const int b = row / TT, t = row - b * TT; lat = t >= LC; const int pos = t - LC; rp = pos >> 6; cp = pos & 63; }

struct EpiIn {
  const Prm* pp;
  __device__ __forceinline__ void operator()(f32x4 (&acc)[4][4], int m0, int n0, int fr, int fq) const {
    const Prm& p = *pp; const float* RT = WSP(float, OFF_ROPE);
    if (n0 >= 1472) return;
#pragma unroll
    for (int mf = 0; mf < 4; ++mf)
#pragma unroll
      for (int j = 0; j < 4; ++j) {
        const int row = m0 + 16 * mf + 4 * fq + j; bool lat; int rp, cp; rope_pos(row, lat, rp, cp);
        float v[4] = {acc[mf][0][j], acc[mf][1][j], acc[mf][2][j], acc[mf][3][j]};
        if (n0 < 640) {
          if (lat) { const float c0 = RT[rp * 16 + fr], s0 = RT[2048 + rp * 16 + fr], c1 = RT[cp * 16 + fr], s1 = RT[2048 + cp * 16 + fr];
            const float a = v[0] * c0 - v[1] * s0, bq = v[0] * s0 + v[1] * c0, cq = v[2] * c1 - v[3] * s1, dq = v[2] * s1 + v[3] * c1; v[0] = a; v[1] = bq; v[2] = cq; v[3] = dq; }
          if (n0 < 512) { bf16_t* o = (bf16_t*)(p.ws + OFF_R + R_QA) + (size_t)row * 512 + n0 + fr;
#pragma unroll
            for (int nf = 0; nf < 4; ++nf) o[16 * nf] = f2bf(v[nf] * SCALE_A); }
          else { bf16_t* o = (bf16_t*)(p.ws + OFF_R + R_KA) + (size_t)row * 128 + (n0 - 512) + fr;
#pragma unroll
            for (int nf = 0; nf < 4; ++nf) o[16 * nf] = f2bf(v[nf]); }
        } else if (n0 < 768) { bf16_t* o = (bf16_t*)(p.ws + OFF_R + R_VA) + (size_t)row * 128 + (n0 - 640) + fr;
#pragma unroll
          for (int nf = 0; nf < 4; ++nf) o[16 * nf] = f2bf(v[nf]);
        } else if (n0 < 1152) { bf16_t* o = (bf16_t*)(p.ws + OFF_R + R_CQ) + (size_t)row * QRK + (n0 - 768) + fr;
#pragma unroll
          for (int nf = 0; nf < 4; ++nf) o[16 * nf] = f2bf(v[nf]);
        } else if (n0 < 1408) { bf16_t* o = (bf16_t*)(p.ws + OFF_R + R_CKV) + (size_t)row * KVRK + (n0 - 1152) + fr;
#pragma unroll
          for (int nf = 0; nf < 4; ++nf) o[16 * nf] = f2bf(v[nf]);
        } else {
          const float pr0 = __shfl_xor(v[0], 8), pr1 = __shfl_xor(v[1], 8);
          if (lat) { const int f = fr & 7; const float c0 = RT[4096 + rp * 8 + f], s0 = RT[5120 + rp * 8 + f], c1 = RT[4096 + cp * 8 + f], s1 = RT[5120 + cp * 8 + f];
            v[0] = fr < 8 ? v[0] * c0 - pr0 * s0 : pr0 * s0 + v[0] * c0; v[1] = fr < 8 ? v[1] * c1 - pr1 * s1 : pr1 * s1 + v[1] * c1; }
          bf16_t* o = WSP(bf16_t, OFF_KR) + (size_t)row * 32 + fr; o[0] = f2bf(v[0]); o[16] = f2bf(v[1]);
        }
      }
  }
};
struct EpiQup {
  const Prm* pp;
  __device__ __forceinline__ void operator()(f32x4 (&acc)[4][6], int m0, int n0, int fr, int fq) const {
    const Prm& p = *pp; const float* RT = WSP(float, OFF_ROPE); const float* ssq = WSP(float, OFF_SSQQ);
#pragma unroll
    for (int mf = 0; mf < 4; ++mf)
#pragma unroll
      for (int j = 0; j < 4; ++j) {
        const int row = m0 + 16 * mf + 4 * fq + j; bool lat; int rp, cp; rope_pos(row, lat, rp, cp);
        const float rs = rsqrtf(ssq[row] * (1.f / QRK) + EPS) * SCALE_B;
        float v[6];
#pragma unroll
        for (int nf = 0; nf < 6; ++nf) v[nf] = acc[mf][nf][j] * rs;
        const float pr0 = __shfl_xor(v[4], 8), pr1 = __shfl_xor(v[5], 8);
        if (lat) { const int f = fr & 7; const float c0 = RT[4096 + rp * 8 + f], s0 = RT[5120 + rp * 8 + f], c1 = RT[4096 + cp * 8 + f], s1 = RT[5120 + cp * 8 + f];
          v[4] = fr < 8 ? v[4] * c0 - pr0 * s0 : pr0 * s0 + v[4] * c0; v[5] = fr < 8 ? v[5] * c1 - pr1 * s1 : pr1 * s1 + v[5] * c1; }
        bf16_t* o = (bf16_t*)(p.ws + OFF_R + R_QB) + (size_t)row * NQB + n0 + fr;
#pragma unroll
        for (int nf = 0; nf < 6; ++nf) o[16 * nf] = f2bf(v[nf]);
      }
  }
};
struct EpiKVup {
  const Prm* pp;
  __device__ __forceinline__ void operator()(f32x4 (&acc)[4][4], int m0, int n0, int fr, int fq) const {
    const Prm& p = *pp; const float* ssq = WSP(float, OFF_SSQK);
    const int hd = n0 >> 7, part = (n0 >> 6) & 1;
    bf16_t* base = (bf16_t*)(p.ws + OFF_R + (part ? R_VB : R_KB));
#pragma unroll
    for (int mf = 0; mf < 4; ++mf)
#pragma unroll
      for (int j = 0; j < 4; ++j) {
        const int row = m0 + 16 * mf + 4 * fq + j; const float rs = rsqrtf(ssq[row] * (1.f / KVRK) + EPS);
        bf16_t* o = base + (size_t)row * 512 + hd * 64 + fr;
#pragma unroll
        for (int nf = 0; nf < 4; ++nf) o[16 * nf] = f2bf(acc[mf][nf][j] * rs);
      }
  }
};
struct EpiOut {
  const Prm* pp; int l;
  __device__ __forceinline__ void operator()(f32x4 (&acc)[4][4], int m0, int n0, int fr, int fq) const {
    const Prm& p = *pp; const float* MOD = WSP(float, OFF_MOD);
#pragma unroll
    for (int mf = 0; mf < 4; ++mf)
#pragma unroll
      for (int j = 0; j < 4; ++j) {
        const int row = m0 + 16 * mf + 4 * fq + j; const float* ga = MOD + (size_t)(l * 5 + row_mi(row)) * 6144 + 2 * 1024 + n0 + fr;
        float* X = WSP(float, OFF_X) + (size_t)row * DM + n0 + fr;
#pragma unroll
        for (int nf = 0; nf < 4; ++nf) X[16 * nf] += ga[16 * nf] * acc[mf][nf][j];
      }
  }
};
struct EpiMoeUp {
  const Prm* pp;
  __device__ __forceinline__ void operator()(f32x4 (&acc)[4][4], int m0, int n0, int fr, int fq) const {
    const Prm& p = *pp; const int j0 = n0 >> 1;
#pragma unroll
    for (int mf = 0; mf < 4; ++mf)
#pragma unroll
      for (int j = 0; j < 4; ++j) {
        const int slot = m0 + 16 * mf + 4 * fq + j;
        bf16_t* o = (bf16_t*)(p.ws + OFF_R + R_ACT) + (size_t)slot * DFF + j0 + fr;
        o[0] = f2bf(silu_f(acc[mf][0][j]) * acc[mf][2][j]); o[16] = f2bf(silu_f(acc[mf][1][j]) * acc[mf][3][j]);
      }
  }
};
struct EpiMoeDown {
  const Prm* pp;
  __device__ __forceinline__ void operator()(f32x4 (&acc)[4][4], int m0, int n0, int fr, int fq) const {
    const Prm& p = *pp; const float* VAL = WSP(float, OFF_VAL);
#pragma unroll
    for (int mf = 0; mf < 4; ++mf)
#pragma unroll
      for (int j = 0; j < 4; ++j) {
        const int slot = m0 + 16 * mf + 4 * fq + j; const float vv = VAL[slot];
        bf16_t* o = (bf16_t*)(p.ws + OFF_R + R_Y) + (size_t)slot * DM + n0 + fr;
#pragma unroll
        for (int nf = 0; nf < 4; ++nf) o[16 * nf] = f2bf(acc[mf][nf][j] * vv);
      }
  }
};

__device__ __forceinline__ void ph_gemm_in(const Prm& p, int l, int bid, int nb) {
  const int wv = TIDX >> 6, wm = wv >> 1, wn = wv & 1;
  const bf16_t* Bt = (const bf16_t*)(p.ws + OFF_W + (size_t)l * SZ_WL);
  APDense ap{(const bf16_t*)(p.ws + OFF_R + R_H), DM}; EpiIn epi{&p};
  constexpr int NCT = NINP / 128;
  for (int it = bid; it < (MR / 256) * NCT; it += nb) { const int rt = it / NCT, ct = it % NCT;
    sgemm_wave<4>(ap, Bt, DM, rt * 256 + wm * 64, ct * 128 + wn * 64, epi); }
}
__device__ __forceinline__ void ph_ssq(const Prm& p, int bid, int nb) {
  const int lane = TIDX & 63, wv = TIDX >> 6;
  for (int r = bid * NWAVE + wv; r < MR; r += nb * NWAVE) {
    const bf16_t* cq = (const bf16_t*)(p.ws + OFF_R + R_CQ) + (size_t)r * QRK; const bf16_t* ck = (const bf16_t*)(p.ws + OFF_R + R_CKV) + (size_t)r * KVRK;
    float s = 0.f; for (int i = lane; i < QRK; i += 64) { const float v = bf2f(cq[i]); s += v * v; }
    float s2 = 0.f; for (int i = lane; i < KVRK; i += 64) { const float v = bf2f(ck[i]); s2 += v * v; }
    s = wave_sum(s); s2 = wave_sum(s2);
    if (lane == 0) { WSP(float, OFF_SSQQ)[r] = s; WSP(float, OFF_SSQK)[r] = s2; }
  }
}
__device__ __forceinline__ void ph_gemm_up(const Prm& p, int l, int bid, int nb) {
  const int wv = TIDX >> 6, wm = wv >> 1, wn = wv & 1;
  const bf16_t* WQ = (const bf16_t*)(p.ws + OFF_W + (size_t)l * SZ_WL + SZ_WIN);
  const bf16_t* WKV = (const bf16_t*)(p.ws + OFF_W + (size_t)l * SZ_WL + SZ_WIN + SZ_WQ);
  constexpr int IQ = (MR / 256) * 4, IKV = (MR / 256) * 8;
  for (int it = bid; it < IQ + IKV; it += nb) {
    if (it < IQ) { const int rt = it / 4, ct = it % 4; APDense ap{(const bf16_t*)(p.ws + OFF_R + R_CQ), QRK}; EpiQup epi{&p};
      sgemm_wave<6>(ap, WQ, QRK, rt * 256 + wm * 64, ct * 192 + wn * 96, epi); }
    else { const int i2 = it - IQ, rt = i2 / 8, ct = i2 % 8; APDense ap{(const bf16_t*)(p.ws + OFF_R + R_CKV), KVRK}; EpiKVup epi{&p};
      sgemm_wave<4>(ap, WKV, KVRK, rt * 256 + wm * 64, ct * 128 + wn * 64, epi); }
  }
}
__device__ __forceinline__ void ph_gemm_out(const Prm& p, int l, int bid, int nb) {
  const int wv = TIDX >> 6, wm = wv >> 1, wn = wv & 1;
  const bf16_t* Bt = (const bf16_t*)(p.ws + OFF_W + (size_t)l * SZ_WL + SZ_WIN + SZ_WQ + SZ_WKV);
  APDense ap{(const bf16_t*)(p.ws + OFF_R + R_H), DM}; EpiOut epi{&p, l};
  for (int it = bid; it < (MR / 256) * 8; it += nb) { const int rt = it / 8, ct = it % 8;
    sgemm_wave<4>(ap, Bt, DM, rt * 256 + wm * 64, ct * 128 + wn * 64, epi); }
}
__device__ __forceinline__ void ph_moe_up(const Prm& p, int l, int bid, int nb) {
  const int wv = TIDX >> 6, wm = wv >> 1, wn = wv & 1;
  const int nrt = (l == DEPTH - 1) ? 256 : 272;
  APGather ap{(const bf16_t*)(p.ws + OFF_R + R_H), WSP(int, OFF_IDX)}; EpiMoeUp epi{&p};
  for (int it = bid; it < nrt * 8; it += nb) { const int rt = it / 8, ct = it % 8; const int e = rt < 256 ? ((rt >> 2) & 15) : rt - 256;
    sgemm_wave<4>(ap, WSP(bf16_t, OFF_WGU) + (size_t)e * 1024 * 1024, DM, rt * 256 + wm * 64, ct * 128 + wn * 64, epi); }
}
__device__ __forceinline__ void ph_moe_down(const Prm& p, int l, int bid, int nb) {
  const int wv = TIDX >> 6, wm = wv >> 1, wn = wv & 1;
  const int nrt = (l == DEPTH - 1) ? 256 : 272;
  APDense ap{(const bf16_t*)(p.ws + OFF_R + R_ACT), DFF}; EpiMoeDown epi{&p};
  for (int it = bid; it < nrt * 8; it += nb) { const int rt = it / 8, ct = it % 8; const int e = rt < 256 ? ((rt >> 2) & 15) : rt - 256;
    sgemm_wave<4>(ap, WSP(bf16_t, OFF_WD) + (size_t)e * 1024 * 512, DFF, rt * 256 + wm * 64, ct * 128 + wn * 64, epi); }
}

namespace pg8 {
#define PG8_LAS __attribute__((address_space(3)))
constexpr int BM = 256, BK = 64, HALF = 128, HTB = HALF * BK * 2, STAGE_BYTES = 8 * HTB;
__device__ __forceinline__ int lds_byte(int r, int c) { const int st = (r >> 4) * 2 + (c >> 5), rr = r & 15, cc = c & 31, ob = rr * 64 + cc * 2; return st * 1024 + (ob ^ (((ob >> 9) & 1) << 5)); }
__device__ __forceinline__ void stage_rc(int b, int& R, int& C) { const int st = b / 1024, sb = b % 1024, swz = sb ^ (((sb >> 9) & 1) << 5); R = (st >> 1) * 16 + swz / 64; C = (st & 1) * 32 + (swz % 64) / 2; }
struct Unit { int pm, pn; size_t boff; int r0; };
struct Gemm { const bf16_t* A; const bf16_t* Bt; int K; const int* idx; };
template <bool GATHER, bool HALFM = false, class Epi, class Sched>
__device__ __forceinline__ void gemm_phase(PG8_LAS unsigned char* lds, const Gemm g, const Sched& S, const Epi& E) {
    const int tid = TIDX, wid = __builtin_amdgcn_readfirstlane(tid >> 6), lane = tid & 63, wr = wid >> 2, wc = wid & 3, fr = lane & 15, fq = lane >> 4;
    const int K = g.K, nt = K / BK;
    int RA[2], CA[2]; unsigned voffB[2], voffA[2];
#pragma unroll
    for (int i = 0; i < 2; ++i) { int R, C; stage_rc(tid * 16 + i * 8192, R, C); RA[i] = R; CA[i] = C; voffA[i] = (unsigned)(R * K + C) * 2u; voffB[i] = voffA[i]; }
    const size_t kstep = (size_t)(BK * 2);
    const size_t hstep = (size_t)HALF * K * 2;
    const size_t tstep = 2 * hstep;
    const unsigned ldsw = (unsigned)wid * 1024u;
    const int aoff = lds_byte(wr * 64 + fr, fq * 8), boff = lds_byte(wc * 32 + fr, fq * 8);
#define PG8_SA(b, h) (((b) * 2 + (h)) * HTB)
#define PG8_SB(b, h) ((4 + (b) * 2 + (h)) * HTB)
#define PG8_STAGE(bufoff, gbase, voff) do { _Pragma("unroll") for (int _i = 0; _i < 2; ++_i) \
        __builtin_amdgcn_global_load_lds((const unsigned*)((const char*)(gbase) + (voff)[_i]), (PG8_LAS unsigned*)(lds + (bufoff) + ldsw + _i * 8192), 16, 0, 0); } while (0)
#define PG8_LDA(dst, b, h) do { _Pragma("unroll") for (int m = 0; m < 4; ++m) _Pragma("unroll") for (int k = 0; k < 2; ++k) dst[m][k] = *(const PG8_LAS bf16x8*)(lds + PG8_SA(b, h) + aoff + m * 2048 + k * 1024); } while (0)
#define PG8_LDB(dst, b, h) do { _Pragma("unroll") for (int n = 0; n < 2; ++n) _Pragma("unroll") for (int k = 0; k < 2; ++k) dst[n][k] = *(const PG8_LAS bf16x8*)(lds + PG8_SB(b, h) + boff + n * 2048 + k * 1024); } while (0)
#define PG8_MMA(ai, bj, At, Bt) do { __builtin_amdgcn_s_setprio(1); _Pragma("unroll") for (int m = 0; m < 4; ++m) _Pragma("unroll") for (int n = 0; n < 2; ++n) _Pragma("unroll") for (int k = 0; k < 2; ++k) \
        acc[ai][bj][m][n] = __builtin_amdgcn_mfma_f32_16x16x32_bf16(Bt[n][k], At[m][k], acc[ai][bj][m][n], 0, 0, 0); __builtin_amdgcn_s_setprio(0); } while (0)
#define PG8_WAIT_V(n) asm volatile("s_waitcnt vmcnt(" #n ")" ::: "memory")
#define PG8_WAIT_L(n) asm volatile("s_waitcnt lgkmcnt(" #n ")" ::: "memory")
#define PG8_BAR __builtin_amdgcn_s_barrier()
#define PG8_SCHED __builtin_amdgcn_sched_barrier(0)
    Unit cur, nxt; int ui = 0;
    if (!S.next(0, cur)) return;
    f32x4 acc[2][2][4][2];
#pragma unroll
    for (int a = 0; a < 2; ++a)
#pragma unroll
        for (int b = 0; b < 2; ++b)
#pragma unroll
            for (int m = 0; m < 4; ++m)
#pragma unroll
                for (int n = 0; n < 2; ++n) acc[a][b][m][n] = (f32x4){0.f, 0.f, 0.f, 0.f};
    bf16x8 At[4][2], B0[2][2], B1[2][2];
    unsigned oc0[2], oc1[2], on0[2], on1[2];
    auto set_off = [&](const Unit& u, unsigned (&o0)[2], unsigned (&o1)[2]) {
        if constexpr (GATHER) {
#pragma unroll
            for (int i = 0; i < 2; ++i) { const int r0 = g.idx[u.r0 + RA[i]], r1 = g.idx[u.r0 + HALF + RA[i]]; o0[i] = (unsigned)(r0 * K + CA[i]) * 2u; o1[i] = (unsigned)(r1 * K + CA[i]) * 2u; }
        } else {
#pragma unroll
            for (int i = 0; i < 2; ++i) { o0[i] = voffA[i]; o1[i] = voffA[i] + (unsigned)hstep; }
        }
    };
    auto a_base = [&](const Unit& u) -> const char* { if constexpr (GATHER) return (const char*)g.A; else return (const char*)g.A + (size_t)u.r0 * (size_t)(K * 2); };
    const char* cA = a_base(cur); const char* cB = (const char*)g.Bt + cur.boff + (size_t)cur.pn * tstep;
    set_off(cur, oc0, oc1);
    PG8_STAGE(PG8_SB(0, 0), cB, voffB); PG8_STAGE(PG8_SB(0, 1), cB + hstep, voffB); PG8_STAGE(PG8_SA(0, 0), cA, oc0); PG8_STAGE(PG8_SA(0, 1), cA, oc1);
    if (wr == 1) PG8_BAR;
    PG8_WAIT_V(2); PG8_BAR;
    PG8_STAGE(PG8_SB(1, 0), cB + kstep, voffB); PG8_STAGE(PG8_SA(1, 0), cA + kstep, oc0); PG8_STAGE(PG8_SB(1, 1), cB + hstep + kstep, voffB);
    PG8_WAIT_V(6); PG8_BAR;
    for (;;) {
        const bool has_next = S.next(ui + 1, nxt);
        const char* nA = has_next ? a_base(nxt) : cA; const char* nB = has_next ? (const char*)g.Bt + nxt.boff + (size_t)nxt.pn * tstep : cB;
        if (has_next) set_off(nxt, on0, on1); else {
#pragma unroll
            for (int i = 0; i < 2; ++i) { on0[i] = oc0[i]; on1[i] = oc1[i]; } }
#pragma unroll 1
        for (int t = 0; t < nt; t += 2) {
            const bool last = (t == nt - 2);
            const char* a1 = cA + (size_t)(t + 1) * kstep;
            const char* a2 = last ? nA : cA + (size_t)(t + 2) * kstep; const char* b2 = last ? nB : cB + (size_t)(t + 2) * kstep;
            const char* a3 = a2 + kstep; const char* b3 = b2 + kstep;
            unsigned o20[2], o21[2];
#pragma unroll
            for (int i = 0; i < 2; ++i) { o20[i] = last ? on0[i] : oc0[i]; o21[i] = last ? on1[i] : oc1[i]; }
            PG8_LDB(B0, 0, 0); PG8_LDB(B1, 0, 1); PG8_SCHED; PG8_LDA(At, 0, 0); PG8_STAGE(PG8_SA(1, 1), a1, oc1);
            PG8_WAIT_V(8); PG8_WAIT_L(0); PG8_BAR; PG8_MMA(0, 0, At, B0); PG8_MMA(0, 1, At, B1); PG8_BAR; PG8_SCHED;
            if constexpr (!HALFM) { PG8_LDA(At, 0, 1); } PG8_STAGE(PG8_SB(0, 0), b2, voffB); PG8_STAGE(PG8_SB(0, 1), b2 + hstep, voffB); PG8_STAGE(PG8_SA(0, 0), a2, o20);
            PG8_WAIT_V(8); PG8_WAIT_L(0); PG8_BAR; if constexpr (!HALFM) { PG8_MMA(1, 0, At, B0); PG8_MMA(1, 1, At, B1); } PG8_BAR; PG8_SCHED;
            PG8_LDB(B0, 1, 0); PG8_LDB(B1, 1, 1); PG8_SCHED; PG8_LDA(At, 1, 0); PG8_STAGE(PG8_SA(0, 1), a2, o21);
            PG8_WAIT_V(8); PG8_WAIT_L(0); PG8_BAR; PG8_MMA(0, 0, At, B0); PG8_MMA(0, 1, At, B1); PG8_BAR; PG8_SCHED;
            if constexpr (!HALFM) { PG8_LDA(At, 1, 1); } PG8_STAGE(PG8_SB(1, 0), b3, voffB); PG8_STAGE(PG8_SB(1, 1), b3 + hstep, voffB); PG8_STAGE(PG8_SA(1, 0), a3, o20);
            PG8_WAIT_V(8); PG8_WAIT_L(0); PG8_BAR; if constexpr (!HALFM) { PG8_MMA(1, 0, At, B0); PG8_MMA(1, 1, At, B1); } PG8_BAR; PG8_SCHED;
        }
        if (wr == 0) PG8_BAR;
        E.template run<HALFM>(acc, cur, wr, wc, fr, fq, lds, tid);
        if (!has_next) break;
#pragma unroll
        for (int a = 0; a < 2; ++a)
#pragma unroll
            for (int b = 0; b < 2; ++b)
#pragma unroll
                for (int m = 0; m < 4; ++m)
#pragma unroll
                    for (int n = 0; n < 2; ++n) acc[a][b][m][n] = (f32x4){0.f, 0.f, 0.f, 0.f};
        cur = nxt; cA = nA; cB = nB; ++ui;
#pragma unroll
        for (int i = 0; i < 2; ++i) { oc0[i] = on0[i]; oc1[i] = on1[i]; }
        if (wr == 1) PG8_BAR;
    }
    PG8_WAIT_V(0);
    PG8_BAR;
#undef PG8_SA
#undef PG8_SB
#undef PG8_STAGE
#undef PG8_LDA
#undef PG8_LDB
#undef PG8_MMA
#undef PG8_WAIT_V
#undef PG8_WAIT_L
#undef PG8_BAR
#undef PG8_SCHED
}
}

__device__ __forceinline__ int vcu_of(int bid, int nb) { return (nb % 8 == 0) ? (bid % 8) * (nb / 8) + bid / 8 : bid; }
struct SchedDense { int nM, nN, G, c; bool rev; bool skipctx; int lim;
  __device__ __forceinline__ bool next(int i, pg8::Unit& u) const { const int L = i * G + (rev ? G - 1 - c : c); if (L >= lim) return false; int pm = L / nN; u.pn = L % nN;
    if (skipctx) pm = pm + pm / 32 + 1; u.pm = pm; u.r0 = pm * 256; u.boff = 0; return true; } };
struct SchedDenseTail { int nN, base, nh, c;
  __device__ __forceinline__ bool next(int i, pg8::Unit& u) const { if (i > 0 || c >= nh) return false; const int L = base + (c >> 1); u.pm = L / nN; u.pn = L % nN;
    u.r0 = u.pm * 256 + (c & 1) * 128; u.boff = 0; return true; } };
struct SchedMoe { int nrt, G, c; size_t estride;
  __device__ __forceinline__ bool next(int i, pg8::Unit& u) const { const int L = i * G + c; if (L >= nrt * 4) return false; u.pm = L >> 2; u.pn = L & 3; u.r0 = u.pm * 256;
    const int e = u.pm < 256 ? ((u.pm >> 2) & 15) : u.pm - 256; u.boff = (size_t)e * estride; return true; } };
struct SchedMoeTail { int c; size_t estride;
  __device__ __forceinline__ bool next(int i, pg8::Unit& u) const { if (i > 0 || (c & 15) >= 4 || (c >> 4) >= NE) return false; const int e = c >> 4; u.pm = 256 + e; u.pn = c & 15;
    u.r0 = u.pm * 256; u.boff = (size_t)e * estride; return true; } };

__device__ __forceinline__ f32x4 shfl32(f32x4 v) { f32x4 r;
#pragma unroll
  for (int i = 0; i < 4; ++i) { auto x = __builtin_amdgcn_permlane32_swap(__float_as_uint(v[i]), __float_as_uint(v[i]), false, false); r[i] = __uint_as_float((TIDX & 32) ? x[0] : x[1]); }
  return r; }
__device__ __forceinline__ void rope32_grp(f32x4& v0, f32x4& v1, const float* RT, int rp, int cp, int fq) {
  const f32x4 p0 = shfl32(v0), p1 = shfl32(v1); const int f = 4 * (fq & 1);
  const f32x4 c0 = *(const f32x4*)(RT + 4096 + rp * 8 + f), s0 = *(const f32x4*)(RT + 5120 + rp * 8 + f), c1 = *(const f32x4*)(RT + 4096 + cp * 8 + f), s1 = *(const f32x4*)(RT + 5120 + cp * 8 + f);
  if (fq < 2) { v0 = v0 * c0 - p0 * s0; v1 = v1 * c1 - p1 * s1; } else { v0 = p0 * s0 + v0 * c0; v1 = p1 * s1 + v1 * c1; }
}
constexpr int ROPE_TAB_OFF = 131072 + 16384 + 128;
constexpr int STG_OFF = 131072, STG_OFF2 = 3 * 16384  , STG_RS = 512;
#define WSE(T, off) ((T*)(ws + (off)))
template <bool HM, class Epi>
__device__ __forceinline__ void epi_staged(const Epi& E, f32x4 (&acc)[2][2][4][2], const pg8::Unit& u, int wr, int wc, int fr, int fq, PG8_LAS unsigned char* lds, int tid) {
  constexpr int NCH = Epi::NCOL / 8, NPASS = 32 * NCH / NTHR;
  typename Epi::Ctx ctx; E.begin(ctx, u, wr, wc, fr, fq);
  const PG8_LAS float* rtab = (const PG8_LAS float*)(lds + ROPE_TAB_OFF);
  unsigned wofs[2][2], rofs[NPASS], gofs[NPASS], gld[NPASS]; bool gval[NPASS];
#pragma unroll
  for (int bj = 0; bj < 2; ++bj)
#pragma unroll
    for (int n = 0; n < 2; ++n) { const unsigned chunk = bj * 16 + wc * 4 + n * 2 + (fq >> 1); wofs[bj][n] = Epi::LEAN ? 0u : (unsigned)(wr * 16 + fr) * STG_RS + ((chunk ^ (unsigned)fr) << 4) + (fq & 1) * 8; }
#pragma unroll
  for (int ps = 0; ps < NPASS; ++ps) { const unsigned c = (unsigned)tid + NTHR * ps, rl = c / NCH, ch = c % NCH;
    rofs[ps] = rl * STG_RS + ((ch ^ (rl & 15u)) << 4);
    E.dst(u, (int)((rl >> 4) * 64 + (rl & 15u)), (int)(ch * 8), gofs[ps], gld[ps], gval[ps]); }
#pragma unroll
  for (int ai = 0; ai < (HM ? 1 : 2); ++ai)
#pragma unroll
    for (int m = 0; m < 4; ++m) {
      PG8_LAS unsigned char* stg = lds + ((m & 1) ? STG_OFF2 : STG_OFF);
      f32x4 v[2][2] = {{acc[ai][0][m][0], acc[ai][0][m][1]}, {acc[ai][1][m][0], acc[ai][1][m][1]}};
      E.pre(v, ai * 128 + m * 16, ai, m, ctx, u, wc, fr, fq, rtab);
#pragma unroll
      for (int bj = 0; bj < Epi::NCOL / 128; ++bj)
#pragma unroll
        for (int n = 0; n < 2; ++n) { u32x2 w; w.x = cvtpk_e(v[bj][n][0], v[bj][n][1]); w.y = cvtpk_e(v[bj][n][2], v[bj][n][3]);
          unsigned wo = wofs[bj][n];
          if (Epi::LEAN) { int frl = fr; asm volatile("" : "+v"(frl)); const unsigned chunk = bj * 16 + wc * 4 + n * 2 + (fq >> 1); wo = (unsigned)(wr * 16 + frl) * STG_RS + ((chunk ^ (unsigned)frl) << 4) + (fq & 1) * 8; }
          *(PG8_LAS u32x2*)(stg + wo) = w; }
      asm volatile("s_waitcnt lgkmcnt(0)" ::: "memory"); __builtin_amdgcn_s_barrier(); asm volatile("" ::: "memory");
#pragma unroll
      for (int ps = 0; ps < NPASS; ++ps) {
        const u32x4 val = *(const PG8_LAS u32x4*)(stg + rofs[ps]);
        unsigned go = gofs[ps]; asm volatile("" : "+v"(go));
        if (gval[ps]) __builtin_nontemporal_store(val, (u32x4*)(E.ws + (size_t)(go + (unsigned)(ai * 128 + m * 16) * gld[ps]))); }
    }
  asm volatile("s_waitcnt lgkmcnt(0)" ::: "memory"); __builtin_amdgcn_s_barrier(); asm volatile("" ::: "memory");
}
#define EPI_RUN   template <bool HM> __device__ __forceinline__ void run(f32x4 (&acc)[2][2][4][2], const pg8::Unit& u, int wr, int wc, int fr, int fq, PG8_LAS unsigned char* lds, int tid) const { epi_staged<HM>(*this, acc, u, wr, wc, fr, fq, lds, tid); }
__device__ __forceinline__ void rot4(f32x4& x1, f32x4& x2, int pos, const f32x4& w) {
  f32x4 c, sn;
#pragma unroll
  for (int j = 0; j < 4; ++j) { const float a = __builtin_amdgcn_fractf((float)pos * w[j]); c[j] = __builtin_amdgcn_cosf(a); sn[j] = __builtin_amdgcn_sinf(a); }
  const f32x4 a = x1 * c - x2 * sn, b = x1 * sn + x2 * c; x1 = a; x2 = b;
}
__device__ __forceinline__ f32x4 rope_w(int i0, float nf) { f32x4 w;
#pragma unroll
  for (int j = 0; j < 4; ++j) w[j] = exp2f(-(float)(i0 + j) * (13.287712379549449f / nf)) * 0.15915494309189535f;
  return w; }
__device__ __forceinline__ void rope32_hw(f32x4& v0, f32x4& v1, int rp, int cp, int fq, const f32x4& w32) {
  const f32x4 p0 = shfl32(v0), p1 = shfl32(v1);
  f32x4 c0, s0, c1, s1;
#pragma unroll
  for (int j = 0; j < 4; ++j) { const float a = __builtin_amdgcn_fractf((float)rp * w32[j]), bq = __builtin_amdgcn_fractf((float)cp * w32[j]);
    c0[j] = __builtin_amdgcn_cosf(a); s0[j] = __builtin_amdgcn_sinf(a); c1[j] = __builtin_amdgcn_cosf(bq); s1[j] = __builtin_amdgcn_sinf(bq); }
  if (fq < 2) { v0 = v0 * c0 - p0 * s0; v1 = v1 * c1 - p1 * s1; } else { v0 = p0 * s0 + v0 * c0; v1 = p1 * s1 + v1 * c1; }
}
__device__ __forceinline__ void tile_pos(int pm, bool& lat, int& pos0) { const int tb = pm % 33; lat = tb != 0; pos0 = (tb - 1) * 256; }
struct Epi2In {
  static constexpr int NCOL = 256; static constexpr bool LEAN = true;
  EPI_RUN
  unsigned char* ws;
  struct Ctx { int pos0, rloc; bool lat; };
  __device__ __forceinline__ void begin(Ctx& c, const pg8::Unit& u, int wr, int wc, int fr, int fq) const {
    c.rloc = wr * 64 + fr; tile_pos(u.pm, c.lat, c.pos0); c.pos0 += c.rloc + (u.r0 - u.pm * 256); }
  __device__ __forceinline__ void dst(const pg8::Unit& u, int rsub, int col, unsigned& gofs, unsigned& gld, bool& gval) const {
    const int gc = u.pn * 256 + col; const unsigned row = (unsigned)(u.r0 + rsub);
    const unsigned ld = gc < 512 ? 512u : gc < 768 ? 128u : gc < 1152 ? (unsigned)QRK : gc < 1408 ? (unsigned)KVRK : 32u;
    const unsigned base = gc < 512 ? (unsigned)(OFF_R + R_QA) : gc < 640 ? (unsigned)(OFF_R + R_KA) : gc < 768 ? (unsigned)(OFF_R + R_VA) : gc < 1152 ? (unsigned)(OFF_R + R_CQ) : gc < 1408 ? (unsigned)(OFF_R + R_CKV) : (unsigned)OFF_KR;
    const unsigned c0 = gc < 512 ? 0u : gc < 640 ? 512u : gc < 768 ? 640u : gc < 1152 ? 768u : gc < 1408 ? 1152u : 1408u;
    gval = gc < 1440; gld = ld * 2; gofs = base + row * gld + ((unsigned)gc - c0) * 2;
  }
  __device__ __forceinline__ void pre(f32x4 (&v)[2][2], int rowstep, int ai, int m, const Ctx& c, const pg8::Unit& u, int wc, int fr, int fq, const PG8_LAS float* rtab) const {
    int pos = c.pos0 + rowstep; asm volatile("" : "+v"(pos));
    const int rp = pos >> 6, cp = pos & 63; const bool lat = c.lat;
#pragma unroll
    for (int bj = 0; bj < 2; ++bj) {
      const int cg = u.pn * 256 + bj * 128 + wc * 32, g32 = cg >> 5;
      f32x4& v0 = v[bj][0]; f32x4& v1 = v[bj][1];
      if (g32 < 20) {
        if (lat) { const f32x4 w64 = *(const PG8_LAS f32x4*)(rtab + 4 * fq); rot4(v0, v1, (g32 & 1) ? cp : rp, w64); }
        if (g32 < 16) { v0 = v0 * SCALE_A; v1 = v1 * SCALE_A; }
      } else if (g32 >= 24 && g32 < 44) {
        float sq = v0[0] * v0[0] + v0[1] * v0[1] + v0[2] * v0[2] + v0[3] * v0[3] + v1[0] * v1[0] + v1[1] * v1[1] + v1[2] * v1[2] + v1[3] * v1[3];
        sq = sum16sw(sq); sq = sum32sw(sq);
        if (fq == 0) atomicAdd(WSE(float, g32 < 36 ? OFF_SSQQ : OFF_SSQK) + (u.r0 + rowstep + c.rloc), sq);
      } else if (g32 == 44) { if (lat) { const f32x4 w32 = *(const PG8_LAS f32x4*)(rtab + 16 + 4 * (fq & 1)); rope32_hw(v0, v1, rp, cp, fq, w32); } }
    }
  }
};
struct Epi2Qup {
  static constexpr int NCOL = 256; static constexpr bool LEAN = false;
  EPI_RUN
  unsigned char* ws;
  struct Ctx { float rs[2][4]; int pos0; bool lat; };
  __device__ __forceinline__ void begin(Ctx& c, const pg8::Unit& u, int wr, int wc, int fr, int fq) const {
    tile_pos(u.pm, c.lat, c.pos0); c.pos0 += wr * 64 + fr + (u.r0 - u.pm * 256);
#pragma unroll
    for (int ai = 0; ai < 2; ++ai)
#pragma unroll
      for (int m = 0; m < 4; ++m) c.rs[ai][m] = WSE(float, OFF_SSQQ)[u.r0 + ai * 128 + wr * 64 + m * 16 + fr];
#pragma unroll
    for (int ai = 0; ai < 2; ++ai)
#pragma unroll
      for (int m = 0; m < 4; ++m) c.rs[ai][m] = rsqrtf(c.rs[ai][m] * (1.f / QRK) + EPS) * SCALE_B; }
  __device__ __forceinline__ void dst(const pg8::Unit& u, int rsub, int col, unsigned& gofs, unsigned& gld, bool& gval) const {
    gld = NQB * 2; gofs = (unsigned)(OFF_R + R_QB) + (unsigned)(u.r0 + rsub) * gld + (u.pn * 256 + col) * 2; gval = true; }
  __device__ __forceinline__ void pre(f32x4 (&v)[2][2], int rowstep, int ai, int m, const Ctx& c, const pg8::Unit& u, int wc, int fr, int fq, const PG8_LAS float* rtab) const {
    int pos = c.pos0 + rowstep; asm volatile("" : "+v"(pos));
    const int rp = pos >> 6, cp = pos & 63; const float rs = c.rs[ai][m];
#pragma unroll
    for (int bj = 0; bj < 2; ++bj) { const int g32 = (u.pn * 256 + bj * 128 + wc * 32) >> 5;
      v[bj][0] = v[bj][0] * rs; v[bj][1] = v[bj][1] * rs;
      if ((g32 % 3) == 2) { if (c.lat) { const f32x4 w32 = *(const PG8_LAS f32x4*)(rtab + 16 + 4 * (fq & 1)); rope32_hw(v[bj][0], v[bj][1], rp, cp, fq, w32); } } }
  }
};
struct Epi2KV {
  static constexpr int NCOL = 256; static constexpr bool LEAN = false;
  EPI_RUN
  unsigned char* ws;
  struct Ctx { float rs[2][4]; };
  __device__ __forceinline__ void begin(Ctx& c, const pg8::Unit& u, int wr, int wc, int fr, int fq) const {
#pragma unroll
    for (int ai = 0; ai < 2; ++ai)
#pragma unroll
      for (int m = 0; m < 4; ++m) c.rs[ai][m] = WSE(float, OFF_SSQK)[u.r0 + ai * 128 + wr * 64 + m * 16 + fr];
#pragma unroll
    for (int ai = 0; ai < 2; ++ai)
#pragma unroll
      for (int m = 0; m < 4; ++m) c.rs[ai][m] = rsqrtf(c.rs[ai][m] * (1.f / KVRK) + EPS); }
  __device__ __forceinline__ void dst(const pg8::Unit& u, int rsub, int col, unsigned& gofs, unsigned& gld, bool& gval) const {
    const int gc = u.pn * 256 + col, hd = gc >> 7, sub = (gc >> 6) & 1;
    gld = 512 * 2; gofs = (unsigned)(OFF_R + (sub ? R_VB : R_KB)) + (unsigned)(u.r0 + rsub) * gld + (hd * 64 + (gc & 63)) * 2; gval = true; }
  __device__ __forceinline__ void pre(f32x4 (&v)[2][2], int rowstep, int ai, int m, const Ctx& c, const pg8::Unit& u, int wc, int fr, int fq, const PG8_LAS float* rtab) const {
    const float rs = c.rs[ai][m];
#pragma unroll
    for (int bj = 0; bj < 2; ++bj) { v[bj][0] = v[bj][0] * rs; v[bj][1] = v[bj][1] * rs; }
  }
};
struct Epi2Out {
  static constexpr int NCOL = 256; static constexpr bool LEAN = false;
  EPI_RUN
  unsigned char* ws; int l;
  struct Ctx { f32x4 ga[2][2]; };
  __device__ __forceinline__ void begin(Ctx& c, const pg8::Unit& u, int wr, int wc, int fr, int fq) const {
    const float* ga = WSE(float, OFF_MOD) + (size_t)(l * 5 + row_mi(u.pm * 256)) * 6144 + 2 * 1024 + u.pn * 256 + wc * 32 + 4 * fq;
#pragma unroll
    for (int bj = 0; bj < 2; ++bj)
#pragma unroll
      for (int n = 0; n < 2; ++n) c.ga[bj][n] = *(const f32x4*)(ga + bj * 128 + n * 16); }
  __device__ __forceinline__ void dst(const pg8::Unit& u, int rsub, int col, unsigned& gofs, unsigned& gld, bool& gval) const {
    gld = DM * 2; gofs = (unsigned)(OFF_R + R_MIXG) + (unsigned)(u.r0 + rsub) * gld + (u.pn * 256 + col) * 2; gval = true; }
  __device__ __forceinline__ void pre(f32x4 (&v)[2][2], int rowstep, int ai, int m, const Ctx& c, const pg8::Unit& u, int wc, int fr, int fq, const PG8_LAS float* rtab) const {
#pragma unroll
    for (int bj = 0; bj < 2; ++bj)
#pragma unroll
      for (int n = 0; n < 2; ++n) v[bj][n] = v[bj][n] * c.ga[bj][n];
  }
};
struct Epi2MoeUp {
  static constexpr int NCOL = 128; static constexpr bool LEAN = false;
  EPI_RUN
  unsigned char* ws;
  struct Ctx { };
  __device__ __forceinline__ void begin(Ctx& c, const pg8::Unit& u, int wr, int wc, int fr, int fq) const { }
  __device__ __forceinline__ void dst(const pg8::Unit& u, int rsub, int col, unsigned& gofs, unsigned& gld, bool& gval) const {
    gld = DFF * 2; gofs = (unsigned)(OFF_R + R_ACT) + (unsigned)(u.r0 + rsub) * gld + (u.pn * 128 + col) * 2; gval = true; }
  __device__ __forceinline__ void pre(f32x4 (&v)[2][2], int rowstep, int ai, int m, const Ctx& c, const pg8::Unit& u, int wc, int fr, int fq, const PG8_LAS float* rtab) const {
#pragma unroll
    for (int n = 0; n < 2; ++n)
#pragma unroll
      for (int j = 0; j < 4; ++j) v[0][n][j] = silu_fast(v[0][n][j]) * v[1][n][j];
  }
};
struct Epi2MoeDown {
  static constexpr int NCOL = 256; static constexpr bool LEAN = false;
  EPI_RUN
  unsigned char* ws;
  struct Ctx { float vv[2][4]; };
  __device__ __forceinline__ void begin(Ctx& c, const pg8::Unit& u, int wr, int wc, int fr, int fq) const {
#pragma unroll
    for (int ai = 0; ai < 2; ++ai)
#pragma unroll
      for (int m = 0; m < 4; ++m) c.vv[ai][m] = WSE(float, OFF_VAL)[u.r0 + ai * 128 + wr * 64 + m * 16 + fr]; }
  __device__ __forceinline__ void dst(const pg8::Unit& u, int rsub, int col, unsigned& gofs, unsigned& gld, bool& gval) const {
    gld = DM * 2; gofs = (unsigned)(OFF_R + R_Y) + (unsigned)(u.r0 + rsub) * gld + (u.pn * 256 + col) * 2; gval = true; }
  __device__ __forceinline__ void pre(f32x4 (&v)[2][2], int rowstep, int ai, int m, const Ctx& c, const pg8::Unit& u, int wc, int fr, int fq, const PG8_LAS float* rtab) const {
    const float vv = c.vv[ai][m];
#pragma unroll
    for (int bj = 0; bj < 2; ++bj) { v[bj][0] = v[bj][0] * vv; v[bj][1] = v[bj][1] * vv; }
  }
};
#define LDS3 ((PG8_LAS unsigned char*)lds)
__device__ __forceinline__ void ph2_gemm_in(const Prm& p, int l, unsigned char* lds, int bid, int nb) {
  pg8::Gemm g{(const bf16_t*)(p.ws + OFF_R + R_H), (const bf16_t*)(p.ws + OFF_W + (size_t)l * SZ_WL), DM, nullptr};
  const int vcu = vcu_of(bid, nb);
  const int nun = (MR / 256) * (NINP / 256), extra = nun % nb;
  const bool halftail = extra > 0 && 2 * extra <= nb;
  SchedDense S{MR / 256, NINP / 256, nb, vcu, false, false, halftail ? nun - extra : nun}; Epi2In E{p.ws};
  pg8::gemm_phase<false>(LDS3, g, S, E);
  if (halftail) { SchedDenseTail T{NINP / 256, nun - extra, 2 * extra, vcu}; pg8::gemm_phase<false, true>(LDS3, g, T, E);
    if (vcu >= 2 * extra) ph_wconv_moe(p, l, lds, vcu - 2 * extra, nb - 2 * extra); }
  else if (extra == 0) ph_wconv_moe(p, l, lds, vcu, nb); else if (vcu >= extra) ph_wconv_moe(p, l, lds, vcu - extra, nb - extra);
}
__device__ __forceinline__ void ph2_gemm_qup(const Prm& p, int l, unsigned char* lds, int bid, int nb) {
  pg8::Gemm g{(const bf16_t*)(p.ws + OFF_R + R_CQ), (const bf16_t*)(p.ws + OFF_W + (size_t)l * SZ_WL + SZ_WIN), QRK, nullptr};
  const bool lastl = (l == DEPTH - 1); SchedDense S{lastl ? MR / 256 - NB : MR / 256, NQB / 256, nb, vcu_of(bid, nb), false, lastl, (lastl ? MR / 256 - NB : MR / 256) * (NQB / 256)}; Epi2Qup E{p.ws}; pg8::gemm_phase<false>(LDS3, g, S, E);
}
__device__ __forceinline__ void ph2_gemm_kvup(const Prm& p, int l, unsigned char* lds, int bid, int nb) {
  pg8::Gemm g{(const bf16_t*)(p.ws + OFF_R + R_CKV), (const bf16_t*)(p.ws + OFF_W + (size_t)l * SZ_WL + SZ_WIN + SZ_WQ), KVRK, nullptr};
  SchedDense S{MR / 256, NKVB / 256, nb, vcu_of(bid, nb), true, false, (MR / 256) * (NKVB / 256)}; Epi2KV E{p.ws}; pg8::gemm_phase<false>(LDS3, g, S, E);
}
__device__ __forceinline__ void ph2_gemm_out(const Prm& p, int l, unsigned char* lds, int bid, int nb) {
  pg8::Gemm g{(const bf16_t*)(p.ws + OFF_R + R_H), (const bf16_t*)(p.ws + OFF_W + (size_t)l * SZ_WL + SZ_WIN + SZ_WQ + SZ_WKV), DM, nullptr};
  const bool lastl = (l == DEPTH - 1); const int vcu = vcu_of(bid, nb);
  const int nun = (lastl ? MR / 256 - NB : MR / 256) * (DM / 256), extra = nun % nb;
  const bool halftail = !lastl && extra > 0 && 2 * extra <= nb;
  SchedDense S{lastl ? MR / 256 - NB : MR / 256, DM / 256, nb, vcu, false, lastl, halftail ? nun - extra : nun}; Epi2Out E{p.ws, l};
  pg8::gemm_phase<false>(LDS3, g, S, E);
  if (halftail) { SchedDenseTail T{DM / 256, nun - extra, 2 * extra, vcu}; pg8::gemm_phase<false, true>(LDS3, g, T, E); }
  if (l + 1 < DEPTH) {
    const int busy = halftail ? 2 * extra : extra;
    if (busy == 0) { ph_mod(p, l + 1, lds, vcu, nb); ph_wconv_dense(p, l + 1, lds, vcu, nb); }
    else if (vcu >= busy) { ph_mod(p, l + 1, lds, vcu - busy, nb - busy); ph_wconv_dense(p, l + 1, lds, vcu - busy, nb - busy); }
  }
}
__device__ __forceinline__ void ph2_moe_up(const Prm& p, int l, unsigned char* lds, int bid, int nb) {
  pg8::Gemm g{(const bf16_t*)(p.ws + OFF_R + R_H), WSP(bf16_t, OFF_WGU), DM, WSP(int, OFF_IDX)};
  const bool halftail = (l != DEPTH - 1) && nb >= 256;
  SchedMoe S{(l == DEPTH - 1 || halftail) ? 256 : 272, nb, vcu_of(bid, nb), (size_t)1024 * 1024 * 2}; Epi2MoeUp E{p.ws};
  pg8::gemm_phase<true>(LDS3, g, S, E);
  if (halftail) { SchedMoeTail T{vcu_of(bid, nb), (size_t)1024 * 1024 * 2}; pg8::gemm_phase<true, true>(LDS3, g, T, E); }
}
__device__ __forceinline__ void ph2_moe_down(const Prm& p, int l, unsigned char* lds, int bid, int nb) {
  pg8::Gemm g{(const bf16_t*)(p.ws + OFF_R + R_ACT), WSP(bf16_t, OFF_WD), DFF, nullptr};
  const bool halftail = (l != DEPTH - 1) && nb >= 256;
  SchedMoe S{(l == DEPTH - 1 || halftail) ? 256 : 272, nb, vcu_of(bid, nb), (size_t)1024 * 512 * 2}; Epi2MoeDown E{p.ws};
  pg8::gemm_phase<false>(LDS3, g, S, E);
  if (halftail) { SchedMoeTail T{vcu_of(bid, nb), (size_t)1024 * 512 * 2}; pg8::gemm_phase<false, true>(LDS3, g, T, E); }
}

template <int DQK>
__device__ __forceinline__ void attn_naive_unit(const Prm& p, int l, int kind, int b, int hd, int qblk, unsigned char* lds) {
  float* Ks = (float*)lds;
  float* Vs = Ks + 32 * DQK;
  const int tid = TIDX;
  const bool isB = (kind == 0 || kind == 2), isctx = kind >= 2;
  const int nq = isctx ? LC : SEQ; const int qi = qblk * NTHR + tid; const bool qvalid = qi < nq;
  const int qrow = b * TT + (isctx ? 0 : LC) + (qvalid ? qi : 0);
  float q[DQK];
  { const bf16_t* qp = isB ? (const bf16_t*)(p.ws + OFF_R + R_QB) + (size_t)qrow * NQB + hd * 96 : (const bf16_t*)(p.ws + OFF_R + R_QA) + (size_t)qrow * 512 + hd * 64;
#pragma unroll
    for (int d = 0; d < DQK; ++d) q[d] = bf2f(qp[d]); }
  float m = -1e30f, lsum = 0.f, o[64];
#pragma unroll
  for (int d = 0; d < 64; ++d) o[d] = 0.f;
  const int q0 = qblk * NTHR;
  int klo = 0, khi = LC;
  if (!isctx) { if (isB) khi = TT; else { klo = max(0, q0 - 128); khi = min(SEQ, q0 + NTHR + 128); } }
  const int kvh = hd >> 2;
  for (int seg = 0; seg < 2; ++seg) {
    int t0, t1; if (seg == 0) { t0 = 0; t1 = LC; } else { if (isctx) break; if (isB) { t0 = LC; t1 = TT; } else { t0 = LC + klo; t1 = LC + khi; } }
    for (int tb = t0; tb < t1; tb += 32) {
      __syncthreads();
      {
        for (int i = tid; i < 32 * DQK; i += NTHR) { const int kk = i / DQK, d = i % DQK; const size_t kr = (size_t)(b * TT + tb + kk);
          float v;
          if (isB) v = d < 64 ? bf2f(((const bf16_t*)(p.ws + OFF_R + R_KB))[kr * 512 + hd * 64 + d]) : bf2f(WSP(bf16_t, OFF_KR)[kr * 32 + d - 64]);
          else v = bf2f(((const bf16_t*)(p.ws + OFF_R + R_KA))[kr * 128 + kvh * 64 + d]);
          Ks[i] = v; }
        for (int i = tid; i < 32 * 64; i += NTHR) { const int kk = i >> 6, d = i & 63; const size_t kr = (size_t)(b * TT + tb + kk);
          Vs[i] = isB ? bf2f(((const bf16_t*)(p.ws + OFF_R + R_VB))[kr * 512 + hd * 64 + d]) : bf2f(((const bf16_t*)(p.ws + OFF_R + R_VA))[kr * 128 + kvh * 64 + d]); }
      }
      __syncthreads();
      if (qvalid) {
        for (int kk = 0; kk < 32; ++kk) {
          if (!isB && seg == 1) { const int ts = tb + kk - LC; const int dlt = qi - ts; if (dlt > 128 || dlt < -128) continue; }
          float s = 0.f;
#pragma unroll
          for (int d = 0; d < DQK; ++d) s += q[d] * Ks[kk * DQK + d];
          if (s > m) { const float al = exp2f(m - s); lsum *= al;
#pragma unroll
            for (int d = 0; d < 64; ++d) o[d] *= al;
            m = s; }
          const float pe = exp2f(s - m); lsum += pe;
#pragma unroll
          for (int d = 0; d < 64; ++d) o[d] += pe * Vs[kk * 64 + d];
        }
      }
    }
  }
  if (qvalid) {
    if (!isB) { const float sk = p.sink[l * 8 + hd] * LOG2E; if (sk > m) { const float al = exp2f(m - sk); lsum = lsum * al + 1.f;
#pragma unroll
        for (int d = 0; d < 64; ++d) o[d] *= al; } else lsum += exp2f(sk - m); }
    const float il = 1.f / lsum;
    bf16_t* op = (bf16_t*)(p.ws + OFF_R + R_H) + (size_t)qrow * DM + (isB ? 512 : 0) + hd * 64;
#pragma unroll
    for (int d = 0; d < 64; ++d) op[d] = f2bf(o[d] * il);
  }
}
__device__ __forceinline__ void ph_attn_naive(const Prm& p, int l, unsigned char* lds, int bid, int nb) {
  const int nun = 1024 + (l == DEPTH - 1 ? 0 : 64);
  for (int u = bid; u < nun; u += nb) {
    int kind, b, hd, qb;
    if (u < 1024) { kind = u & 1; int r = u >> 1; qb = r & 15; r >>= 4; hd = r & 7; b = r >> 3; }
    else { const int r = u - 1024; kind = 2 + (r & 1); hd = (r >> 1) & 7; b = r >> 4; qb = 0; }
    if (kind == 0 || kind == 2) attn_naive_unit<96>(p, l, kind, b, hd, qb, lds); else attn_naive_unit<64>(p, l, kind, b, hd, qb, lds);
    __syncthreads();
  }
}

#define SBAR() __builtin_amdgcn_sched_barrier(0)
typedef short s16x4 __attribute__((ext_vector_type(4)));
__device__ __forceinline__ int crow(int r, int hi) { return (r & 3) + 8 * (r >> 2) + 4 * hi; }
__device__ __forceinline__ unsigned cvtpk(float lo, float hi) { unsigned r; asm volatile("v_cvt_pk_bf16_f32 %0, %1, %2" : "=v"(r) : "v"(lo), "v"(hi)); return r; }
constexpr float ATHR = 8.f;
__device__ __forceinline__ void partialSM(f32x16& p0, f32x16& p1, float& m_reg, float& alpha) {
  float pmax = p0[0];
#pragma unroll
  for (int r = 1; r < 16; ++r) pmax = fmaxf(pmax, p0[r]);
#pragma unroll
  for (int r = 0; r < 16; ++r) pmax = fmaxf(pmax, p1[r]);
  { auto rr = __builtin_amdgcn_permlane32_swap(__float_as_uint(pmax), __float_as_uint(pmax), false, false); pmax = fmaxf(__uint_as_float(rr[0]), __uint_as_float(rr[1])); }
  float mn;
  if (__builtin_expect(__all(pmax - m_reg <= ATHR), 1)) { mn = m_reg; alpha = 1.f; }
  else { mn = fmaxf(m_reg, pmax); alpha = __builtin_amdgcn_exp2f(m_reg - mn); m_reg = mn; }
#pragma unroll
  for (int r = 0; r < 16; ++r) { p0[r] -= mn; p1[r] -= mn; }
#pragma unroll
  for (int r = 0; r < 16; ++r) p0[r] = __builtin_amdgcn_exp2f(p0[r]);
}
__device__ __forceinline__ void finishSM(f32x16& p0, f32x16& p1, float alpha, float& l_reg, bf16x8& pa0, bf16x8& pa1, bf16x8& pa2, bf16x8& pa3) {
#pragma unroll
  for (int r = 0; r < 16; ++r) p1[r] = __builtin_amdgcn_exp2f(p1[r]);
  float ps = 0.f;
#pragma unroll
  for (int r = 0; r < 16; ++r) ps += p0[r];
#pragma unroll
  for (int r = 0; r < 16; ++r) ps += p1[r];
  { auto rr = __builtin_amdgcn_permlane32_swap(__float_as_uint(ps), __float_as_uint(ps), false, false); ps = __uint_as_float(rr[0]) + __uint_as_float(rr[1]); }
  l_reg = l_reg * alpha + ps;
#define PK4(P, BASE, OUT) do { unsigned a0 = cvtpk(P[BASE + 0], P[BASE + 1]), a1 = cvtpk(P[BASE + 2], P[BASE + 3]);   \
    unsigned b0 = cvtpk(P[BASE + 4], P[BASE + 5]), b1 = cvtpk(P[BASE + 6], P[BASE + 7]);                              \
    auto r0 = __builtin_amdgcn_permlane32_swap(a0, b0, false, false); auto r1 = __builtin_amdgcn_permlane32_swap(a1, b1, false, false); \
    u32x4 w = {r0[0], r1[0], r0[1], r1[1]}; OUT = *reinterpret_cast<bf16x8*>(&w); } while (0)
  PK4(p0, 0, pa0); PK4(p0, 8, pa1); PK4(p1, 0, pa2); PK4(p1, 8, pa3);
#undef PK4
}
template <int DQK>
__device__ __forceinline__ void qkt(f32x16& p0, f32x16& p1, const char* Ks, const bf16x8* qr, int r32, int hi) {
  constexpr int KST = DQK * 2 + 16;
  p0 = f32x16{}; p1 = f32x16{};
#pragma unroll
  for (int d0 = 0; d0 < DQK / 16; ++d0) { const int cb = (d0 * 16 + hi * 8) * 2;
    const bf16x8 b0 = *reinterpret_cast<const bf16x8*>(Ks + r32 * KST + cb);
    const bf16x8 b1 = *reinterpret_cast<const bf16x8*>(Ks + (32 + r32) * KST + cb);
    p0 = __builtin_amdgcn_mfma_f32_32x32x16_bf16(b0, qr[d0], p0, 0, 0, 0);
    p1 = __builtin_amdgcn_mfma_f32_32x32x16_bf16(b1, qr[d0], p1, 0, 0, 0); }
}
__device__ __forceinline__ int v_st(int k, int c) { const int kk = (k & ~0xC) | ((k & 4) << 1) | ((k & 8) >> 1); return ((kk >> 3) * 2 + (c >> 5)) * 512 + ((kk & 7) * 32 + (c & 31)) * 2; }
__device__ __forceinline__ int v_rd_base(int lane) { return ((lane & 3) << 3) | (((lane >> 2) & 3) << 6) | (((lane >> 4) & 1) << 5) | (((lane >> 5) & 1) << 8); }
constexpr int v_rd_off(int d0, int ks, int half) { return d0 * 512 + ks * 2048 + half * 1024; }
template <int OFF> __device__ __forceinline__ s16x4 tr_read(int vb) { s16x4 r; asm volatile("ds_read_b64_tr_b16 %0, %1 offset:%2" : "=&v"(r) : "v"(vb), "i"(OFF) : "memory"); return r; }
template <int D0> __device__ __forceinline__ void pv_one(f32x16& od, int vb, bf16x8 pa0, bf16x8 pa1, bf16x8 pa2, bf16x8 pa3) {
  const s16x4 l0 = tr_read<v_rd_off(D0, 0, 0)>(vb), h0 = tr_read<v_rd_off(D0, 0, 1)>(vb), l1 = tr_read<v_rd_off(D0, 1, 0)>(vb), h1 = tr_read<v_rd_off(D0, 1, 1)>(vb);
  const s16x4 l2 = tr_read<v_rd_off(D0, 2, 0)>(vb), h2 = tr_read<v_rd_off(D0, 2, 1)>(vb), l3 = tr_read<v_rd_off(D0, 3, 0)>(vb), h3 = tr_read<v_rd_off(D0, 3, 1)>(vb);
  asm volatile("s_waitcnt lgkmcnt(0)" ::: "memory"); SBAR();
#define PK(L, H) (bf16x8){L[0], L[1], L[2], L[3], H[0], H[1], H[2], H[3]}
  od = __builtin_amdgcn_mfma_f32_32x32x16_bf16(pa0, PK(l0, h0), od, 0, 0, 0);
  od = __builtin_amdgcn_mfma_f32_32x32x16_bf16(pa1, PK(l1, h1), od, 0, 0, 0);
  od = __builtin_amdgcn_mfma_f32_32x32x16_bf16(pa2, PK(l2, h2), od, 0, 0, 0);
  od = __builtin_amdgcn_mfma_f32_32x32x16_bf16(pa3, PK(l3, h3), od, 0, 0, 0);
#undef PK
}
__device__ __forceinline__ void pv_all(f32x16* o, int vb, bf16x8 pa0, bf16x8 pa1, bf16x8 pa2, bf16x8 pa3) { pv_one<0>(o[0], vb, pa0, pa1, pa2, pa3); pv_one<1>(o[1], vb, pa0, pa1, pa2, pa3); }

template <int KIND>
__device__ __forceinline__ void attn_fast_unit(const Prm& p, int l, bool isctx, int b, int hd, int qb, unsigned char* ldsu) {
  constexpr int DQK = KIND == 0 ? 96 : 64, KST = DQK * 2 + 16, SHM_K = 64 * KST, SHM_V = 8192, LPT = KIND == 0 ? 3 : 2;
  char* lds = (char*)ldsu;
  const int tid = TIDX, wid = tid >> 6, lane = tid & 63, r32 = lane & 31, hi = lane >> 5;
  char* V_lds = lds; char* K_lds = lds + 2 * SHM_V;
  float* ws = (float*)(lds + 2 * SHM_V + 2 * SHM_K) + wid * 64; float* li_l = ws; float* al_l = ws + 32;
  const int q0 = qb * 256;
  const size_t rowq0 = (size_t)b * TT + (isctx ? 0 : LC) + q0;
  const bf16_t *Qp, *Kp, *Vp; const bf16_t* KRp = WSP(bf16_t, OFF_KR); int ldq, ldk; int ocol;
  if (KIND == 0) { Qp = (const bf16_t*)(p.ws + OFF_R + R_QB) + hd * 96; ldq = NQB; Kp = (const bf16_t*)(p.ws + OFF_R + R_KB) + hd * 64; Vp = (const bf16_t*)(p.ws + OFF_R + R_VB) + hd * 64; ldk = 512; ocol = 512 + hd * 64; }
  else { Qp = (const bf16_t*)(p.ws + OFF_R + R_QA) + hd * 64; ldq = 512; Kp = (const bf16_t*)(p.ws + OFF_R + R_KA) + (hd >> 2) * 64; Vp = (const bf16_t*)(p.ws + OFF_R + R_VA) + (hd >> 2) * 64; ldk = 128; ocol = hd * 64; }
  int NT, kshift = 0; bool domask = false;
  if (isctx) NT = 4; else if (KIND == 0) NT = TT / 64; else { const int ks = max(0, q0 - 128), ke = min(SEQ, q0 + 384); NT = 4 + (ke - ks) / 64; kshift = ks; domask = true; }
  const size_t kb0 = (size_t)b * TT;
  float m_reg = -1e30f, l_reg = 0.f; f32x16 o[2] = {}; bf16x8 qr[DQK / 16];
  { const bf16_t* Qw = Qp + (rowq0 + wid * 32 + r32) * ldq + hi * 8;
#pragma unroll
    for (int d0 = 0; d0 < DQK / 16; ++d0) qr[d0] = *reinterpret_cast<const bf16x8*>(Qw + d0 * 16); }
  const int sr = tid >> 3, sc = (tid & 7) * 8, vst = v_st(sr, sc), kst = sr * KST + sc * 2;
  const int rr_ = (tid & 255) >> 2, rc_ = (tid & 3) * 8, krst = rr_ * KST + 128 + rc_ * 2;
  const int vb0 = (int)(uintptr_t)V_lds + v_rd_base(lane);
  struct { bf16x8 v, k, kr; } st_[2];
#define KROW(j) (kb0 + (size_t)(j) * 64 + ((j) >= 4 ? kshift : 0))
#define SLOAD(i, j) do { const size_t kr0_ = KROW(j); st_[i].v = *reinterpret_cast<const bf16x8*>(Vp + (kr0_ + sr) * ldk + sc); st_[i].k = *reinterpret_cast<const bf16x8*>(Kp + (kr0_ + sr) * ldk + sc); \
    if (KIND == 0) st_[i].kr = *reinterpret_cast<const bf16x8*>(KRp + (kr0_ + rr_) * 32 + rc_); } while (0)
#define SWRITE(bf, i) do { *(bf16x8*)(V_lds + (bf) * SHM_V + vst) = st_[i].v; *(bf16x8*)(K_lds + (bf) * SHM_K + kst) = st_[i].k; \
    if (KIND == 0) { if (tid < 256) *(bf16x8*)(K_lds + (bf) * SHM_K + krst) = st_[i].kr; } } while (0)
#define SWAIT() do { if (LPT == 3) asm volatile("s_waitcnt vmcnt(3)" ::: "memory"); else asm volatile("s_waitcnt vmcnt(2)" ::: "memory"); } while (0)
#define RESC(a) do { if (__any((a) < 1.f)) { if (hi == 0) al_l[r32] = (a); asm volatile("s_waitcnt lgkmcnt(0)" ::: "memory"); \
    _Pragma("unroll") for (int d = 0; d < 2; ++d) _Pragma("unroll") for (int r = 0; r < 16; ++r) o[d][r] *= al_l[crow(r, hi)]; } } while (0)
#define AMASK(P0, P1, j) do { if (KIND == 1) { if (domask && (j) >= 4) { const int tq_ = q0 + wid * 32 + r32; const int tk_ = kshift + ((j) - 4) * 64 + 4 * hi; \
    _Pragma("unroll") for (int r = 0; r < 16; ++r) { const int d_ = tq_ - (tk_ + (r & 3) + 8 * (r >> 2)); if (d_ > 128 || d_ < -128) P0[r] = -INFINITY; if (d_ - 32 > 128 || d_ - 32 < -128) P1[r] = -INFINITY; } } } } while (0)
  f32x16 pA0, pA1, pB0, pB1; float alA, alB; bf16x8 pa0, pa1, pa2, pa3;
  SLOAD(0, 0); asm volatile("s_waitcnt vmcnt(0)" ::: "memory"); SWRITE(0, 0); __syncthreads();
  qkt<DQK>(pA0, pA1, K_lds, qr, r32, hi); AMASK(pA0, pA1, 0); partialSM(pA0, pA1, m_reg, alA);
  SLOAD(1, 1); if (2 < NT) SLOAD(0, 2);
  SWAIT(); SWRITE(1, 1); __syncthreads();
  for (int j = 1; j + 1 < NT; j += 2) {
    SBAR(); qkt<DQK>(pB0, pB1, K_lds + SHM_K, qr, r32, hi);
    finishSM(pA0, pA1, alA, l_reg, pa0, pa1, pa2, pa3); SBAR();
    SLOAD(1, j + 2); SBAR();
    pv_all(o, vb0, pa0, pa1, pa2, pa3); AMASK(pB0, pB1, j); partialSM(pB0, pB1, m_reg, alB);
    __syncthreads(); SWAIT(); SWRITE(0, 0);
    RESC(alB); __syncthreads();
    SBAR(); qkt<DQK>(pA0, pA1, K_lds, qr, r32, hi);
    finishSM(pB0, pB1, alB, l_reg, pa0, pa1, pa2, pa3); SBAR();
    if (j + 3 < NT) SLOAD(0, j + 3); SBAR();
    pv_all(o, vb0 + SHM_V, pa0, pa1, pa2, pa3); AMASK(pA0, pA1, j + 1); partialSM(pA0, pA1, m_reg, alA);
    __syncthreads(); SWAIT(); SWRITE(1, 1);
    RESC(alA); __syncthreads();
  }
  SBAR(); qkt<DQK>(pB0, pB1, K_lds + SHM_K, qr, r32, hi);
  finishSM(pA0, pA1, alA, l_reg, pa0, pa1, pa2, pa3); SBAR();
  pv_all(o, vb0, pa0, pa1, pa2, pa3); AMASK(pB0, pB1, NT - 1); partialSM(pB0, pB1, m_reg, alB);
  __syncthreads(); RESC(alB);
  finishSM(pB0, pB1, alB, l_reg, pa0, pa1, pa2, pa3); SBAR();
  pv_all(o, vb0 + SHM_V, pa0, pa1, pa2, pa3);
  if (KIND == 1) l_reg += __builtin_amdgcn_exp2f(p.sink[l * 8 + hd] * LOG2E - m_reg);
  if (hi == 0) li_l[r32] = l_reg; asm volatile("s_waitcnt lgkmcnt(0)" ::: "memory");
  float rli[16];
#pragma unroll
  for (int r = 0; r < 16; ++r) rli[r] = __builtin_amdgcn_rcpf(li_l[crow(r, hi)]);
  bf16_t* Ow = (bf16_t*)(p.ws + OFF_R + R_H) + (rowq0 + wid * 32) * DM + ocol;
#pragma unroll
  for (int r = 0; r < 16; ++r) { const int orow = crow(r, hi);
#pragma unroll
    for (int d0 = 0; d0 < 2; ++d0) Ow[(size_t)orow * DM + d0 * 32 + r32] = f2bf(o[d0][r] * rli[r]); }
  __syncthreads();
#undef KROW
#undef SLOAD
#undef SWRITE
#undef SWAIT
#undef RESC
#undef AMASK
}
__device__ __forceinline__ float max3f_(float a, float b, float c) { return fmaxf(fmaxf(a, b), c); }
template <bool FIRST>
__device__ __forceinline__ void psm2(f32x16& p0, f32x16& p1, float& mhat, f32x16& negm, float& alpha) {
  float a = max3f_(p0[0], p0[1], p1[0]), b = max3f_(p0[2], p0[3], p1[1]); a = max3f_(a, p1[2], p1[3]);
#pragma unroll
  for (int r = 4; r < 16; r += 4) { a = max3f_(a, p0[r], p0[r + 1]); b = max3f_(b, p0[r + 2], p0[r + 3]); a = max3f_(a, p1[r], p1[r + 1]); b = max3f_(b, p1[r + 2], p1[r + 3]); }
  float rm = fmaxf(a, b);
  { auto rr = __builtin_amdgcn_permlane32_swap(__float_as_uint(rm), __float_as_uint(rm), false, false); rm = fmaxf(__uint_as_float(rr[0]), __uint_as_float(rr[1])); }
  alpha = 1.f;
  if (FIRST || __builtin_expect(__any(rm > ATHR), 0)) {
    const float dl = FIRST ? rm : fmaxf(rm, 0.f);
    mhat += dl;
#pragma unroll
    for (int r = 0; r < 16; ++r) { p0[r] -= dl; p1[r] -= dl; }
    const float nm = -mhat;
#pragma unroll
    for (int r = 0; r < 16; ++r) negm[r] = nm;
    alpha = __builtin_amdgcn_exp2f(-dl);
  }
#pragma unroll
  for (int r = 0; r < 16; ++r) p0[r] = __builtin_amdgcn_exp2f(p0[r]);
}
template <bool FIRST>
__device__ __forceinline__ void psm2q(f32x16& p0, f32x16& p1, float& mhat, f32x16& negm, float& alpha, float& lsum) {
  float a = max3f_(p0[0], p0[1], p1[0]), b = max3f_(p0[2], p0[3], p1[1]); a = max3f_(a, p1[2], p1[3]);
#pragma unroll
  for (int r = 4; r < 16; r += 4) { a = max3f_(a, p0[r], p0[r + 1]); b = max3f_(b, p0[r + 2], p0[r + 3]); a = max3f_(a, p1[r], p1[r + 1]); b = max3f_(b, p1[r + 2], p1[r + 3]); }
  float rm = fmaxf(a, b);
  { auto rr = __builtin_amdgcn_permlane32_swap(__float_as_uint(rm), __float_as_uint(rm), false, false); rm = fmaxf(__uint_as_float(rr[0]), __uint_as_float(rr[1])); }
  alpha = 1.f;
  if (FIRST || __builtin_expect(__any(rm > ATHR), 0)) {
    const float dl = FIRST ? rm : fmaxf(rm, 0.f);
    mhat += dl;
#pragma unroll
    for (int r = 0; r < 16; ++r) { p0[r] -= dl; p1[r] -= dl; }
    const float nm = -mhat;
#pragma unroll
    for (int r = 0; r < 16; ++r) negm[r] = nm;
    alpha = __builtin_amdgcn_exp2f(-dl);
  }
  float s0 = 0.f, s1 = 0.f;
#pragma unroll
  for (int r = 0; r < 16; r += 2) { p0[r] = __builtin_amdgcn_exp2f(p0[r]); s0 += p0[r]; p0[r + 1] = __builtin_amdgcn_exp2f(p0[r + 1]); s1 += p0[r + 1]; }
  lsum = FIRST ? (s0 + s1) : lsum * alpha + (s0 + s1);
}
__device__ __forceinline__ void fsm2(f32x16& p0, f32x16& p1, bf16x8& pa0, bf16x8& pa1, bf16x8& pa2, bf16x8& pa3) {
#pragma unroll
  for (int r = 0; r < 16; ++r) p1[r] = __builtin_amdgcn_exp2f(p1[r]);
#define PK4(P, BASE, OUT) do { unsigned a0 = cvtpk(P[BASE + 0], P[BASE + 1]), a1 = cvtpk(P[BASE + 2], P[BASE + 3]);   \
    unsigned b0 = cvtpk(P[BASE + 4], P[BASE + 5]), b1 = cvtpk(P[BASE + 6], P[BASE + 7]);                              \
    auto r0 = __builtin_amdgcn_permlane32_swap(a0, b0, false, false); auto r1 = __builtin_amdgcn_permlane32_swap(a1, b1, false, false); \
    u32x4 w = {r0[0], r1[0], r0[1], r1[1]}; OUT = *reinterpret_cast<bf16x8*>(&w); } while (0)
  PK4(p0, 0, pa0); PK4(p0, 8, pa1); PK4(p1, 0, pa2); PK4(p1, 8, pa3);
#undef PK4
}
template <int DQK>
__device__ __forceinline__ void qkt2(f32x16& p0, f32x16& p1, const char* Ks, const bf16x8* qr, const f32x16& negm, int r32, int hi) {
  constexpr int KST = DQK * 2 + 16, ND = DQK / 16;
  bf16x8 kb0[ND], kb1[ND];
#pragma unroll
  for (int d0 = 0; d0 < ND; ++d0) { const int cb = (d0 * 16 + hi * 8) * 2;
    kb0[d0] = *reinterpret_cast<const bf16x8*>(Ks + r32 * KST + cb); kb1[d0] = *reinterpret_cast<const bf16x8*>(Ks + (32 + r32) * KST + cb); }
#pragma unroll
  for (int d0 = 0; d0 < ND; ++d0) {
    if (d0 == 0) { p0 = __builtin_amdgcn_mfma_f32_32x32x16_bf16(kb0[0], qr[0], negm, 0, 0, 0); p1 = __builtin_amdgcn_mfma_f32_32x32x16_bf16(kb1[0], qr[0], negm, 0, 0, 0); }
    else { p0 = __builtin_amdgcn_mfma_f32_32x32x16_bf16(kb0[d0], qr[d0], p0, 0, 0, 0); p1 = __builtin_amdgcn_mfma_f32_32x32x16_bf16(kb1[d0], qr[d0], p1, 0, 0, 0); } }
}
__device__ __forceinline__ void pv_all2(f32x16* o, int vb, bf16x8 pa0, bf16x8 pa1, bf16x8 pa2, bf16x8 pa3) {
  pv_one<0>(o[0], vb, pa0, pa1, pa2, pa3); pv_one<1>(o[1], vb, pa0, pa1, pa2, pa3);
  const bf16x8 ones = {16256, 16256, 16256, 16256, 16256, 16256, 16256, 16256};
  o[2] = __builtin_amdgcn_mfma_f32_32x32x16_bf16(pa0, ones, o[2], 0, 0, 0); o[2] = __builtin_amdgcn_mfma_f32_32x32x16_bf16(pa1, ones, o[2], 0, 0, 0);
  o[2] = __builtin_amdgcn_mfma_f32_32x32x16_bf16(pa2, ones, o[2], 0, 0, 0); o[2] = __builtin_amdgcn_mfma_f32_32x32x16_bf16(pa3, ones, o[2], 0, 0, 0);
}
template <int KIND>
__device__ __forceinline__ void attn_fast_unit2(const Prm& p, int l, bool isctx, int b, int hd, int qb, unsigned char* ldsu) {
  constexpr int DQK = KIND == 0 ? 96 : 64, KST = DQK * 2 + 16, SHM_K = 64 * KST, SHM_V = 8192, LPT = KIND == 0 ? 3 : 2;
  char* lds = (char*)ldsu;
  const int tid = TIDX, wid = tid >> 6, lane = tid & 63, r32 = lane & 31, hi = lane >> 5;
  char* V_lds = lds; char* K_lds = lds + 2 * SHM_V;
  float* ws = (float*)(lds + 2 * SHM_V + 2 * SHM_K) + wid * 64; float* li_l = ws; float* al_l = ws + 32;
  const int q0 = qb * 256;
  const size_t rowq0 = (size_t)b * TT + (isctx ? 0 : LC) + q0;
  const bf16_t *Qp, *Kp, *Vp; const bf16_t* KRp = WSP(bf16_t, OFF_KR); int ldq, ldk; int ocol;
  if (KIND == 0) { Qp = (const bf16_t*)(p.ws + OFF_R + R_QB) + hd * 96; ldq = NQB; Kp = (const bf16_t*)(p.ws + OFF_R + R_KB) + hd * 64; Vp = (const bf16_t*)(p.ws + OFF_R + R_VB) + hd * 64; ldk = 512; ocol = 512 + hd * 64; }
  else { Qp = (const bf16_t*)(p.ws + OFF_R + R_QA) + hd * 64; ldq = 512; Kp = (const bf16_t*)(p.ws + OFF_R + R_KA) + (hd >> 2) * 64; Vp = (const bf16_t*)(p.ws + OFF_R + R_VA) + (hd >> 2) * 64; ldk = 128; ocol = hd * 64; }
  int NT, kshift = 0; bool domask = false;
  if (isctx) NT = 4; else if (KIND == 0) NT = TT / 64; else { const int ks = max(0, q0 - 128), ke = min(SEQ, q0 + 384); NT = 4 + (ke - ks) / 64; kshift = ks; domask = true; }
  const size_t kb0 = (size_t)b * TT;
  float mhat = 0.f; f32x16 o[3] = {}; f32x16 negm = {}; bf16x8 qr[DQK / 16];
  { const bf16_t* Qw = Qp + (rowq0 + wid * 32 + r32) * ldq + hi * 8;
#pragma unroll
    for (int d0 = 0; d0 < DQK / 16; ++d0) qr[d0] = *reinterpret_cast<const bf16x8*>(Qw + d0 * 16); }
  const int sr = tid >> 3, sc = (tid & 7) * 8, vst = v_st(sr, sc), kst = sr * KST + sc * 2;
  const int rr_ = (tid & 255) >> 2, rc_ = (tid & 3) * 8, krst = rr_ * KST + 128 + rc_ * 2;
  const int vb0 = (int)(uintptr_t)V_lds + v_rd_base(lane);
  struct { bf16x8 v, k, kr; } st_[1];
#define KROW(j) (kb0 + (size_t)(j) * 64 + ((j) >= 4 ? kshift : 0))
  const unsigned voffs = (unsigned)(sr * ldk + sc) * 2u, kroffs = (unsigned)(rr_ * 32 + rc_) * 2u;
#define SLOAD(i, j) do { const size_t kr0_ = KROW(j); const char* vb_ = (const char*)(Vp + kr0_ * ldk); const char* kb_ = (const char*)(Kp + kr0_ * ldk); \
    st_[i].v = *reinterpret_cast<const bf16x8*>(vb_ + voffs); st_[i].k = *reinterpret_cast<const bf16x8*>(kb_ + voffs); \
    if (KIND == 0) { const char* rb_ = (const char*)(KRp + kr0_ * 32); st_[i].kr = *reinterpret_cast<const bf16x8*>(rb_ + kroffs); } } while (0)
#define SWRITE(bf, i) do { *(bf16x8*)(V_lds + (bf) * SHM_V + vst) = st_[i].v; *(bf16x8*)(K_lds + (bf) * SHM_K + kst) = st_[i].k; \
    if (KIND == 0) { if (tid < 256) *(bf16x8*)(K_lds + (bf) * SHM_K + krst) = st_[i].kr; } } while (0)
#define SWAIT() do { if (LPT == 3) asm volatile("s_waitcnt vmcnt(3)" ::: "memory"); else asm volatile("s_waitcnt vmcnt(2)" ::: "memory"); } while (0)
#define RESC(a) do { if (__any((a) < 1.f)) { if (hi == 0) al_l[r32] = (a); asm volatile("s_waitcnt lgkmcnt(0)" ::: "memory"); \
    _Pragma("unroll") for (int d = 0; d < 3; ++d) _Pragma("unroll") for (int r = 0; r < 16; ++r) o[d][r] *= al_l[crow(r, hi)]; } } while (0)
#define AMASK(P0, P1, j) do { if (KIND == 1) { if (domask && (j) >= 4) { const int tq_ = q0 + wid * 32 + r32; const int tk_ = kshift + ((j) - 4) * 64 + 4 * hi; \
    _Pragma("unroll") for (int r = 0; r < 16; ++r) { const int d_ = tq_ - (tk_ + (r & 3) + 8 * (r >> 2)); if (d_ > 128 || d_ < -128) P0[r] = -INFINITY; if (d_ - 32 > 128 || d_ - 32 < -128) P1[r] = -INFINITY; } } } } while (0)
  if (__builtin_amdgcn_readfirstlane(wid) >= 4) __builtin_amdgcn_s_setprio(1);
  f32x16 pA0, pA1, pB0, pB1; float alA, alB; bf16x8 pa0, pa1, pa2, pa3;
  const int wq0_ = q0 + __builtin_amdgcn_readfirstlane(wid) * 32;
#define TACT(j) (KIND != 1 || !domask || (j) < 4 || (kshift + ((j) - 4) * 64 + 63 >= wq0_ - 128 && kshift + ((j) - 4) * 64 <= wq0_ + 31 + 128))
  bool actA, actB;
  SLOAD(0, 0); asm volatile("s_waitcnt vmcnt(0)" ::: "memory"); SWRITE(0, 0); __syncthreads();
  actA = true; qkt2<DQK>(pA0, pA1, K_lds, qr, negm, r32, hi); AMASK(pA0, pA1, 0); psm2<true>(pA0, pA1, mhat, negm, alA);
  SLOAD(0, 1);
  SWRITE(1, 0); __syncthreads();
  for (int j = 1; j + 1 < NT; j += 2) {
    actB = TACT(j);
    SBAR(); if (actB) qkt2<DQK>(pB0, pB1, K_lds + SHM_K, qr, negm, r32, hi);
    if (actA) fsm2(pA0, pA1, pa0, pa1, pa2, pa3); SBAR();
    SLOAD(0, j + 1); SBAR();
    if (actA) pv_all2(o, vb0, pa0, pa1, pa2, pa3); if (actB) { AMASK(pB0, pB1, j); psm2<false>(pB0, pB1, mhat, negm, alB); } else alB = 1.f;
    __syncthreads(); SWRITE(0, 0);
    RESC(alB); __syncthreads();
    actA = TACT(j + 1);
    SBAR(); if (actA) qkt2<DQK>(pA0, pA1, K_lds, qr, negm, r32, hi);
    if (actB) fsm2(pB0, pB1, pa0, pa1, pa2, pa3); SBAR();
    SLOAD(0, j + 2); SBAR();
    if (actB) pv_all2(o, vb0 + SHM_V, pa0, pa1, pa2, pa3); if (actA) { AMASK(pA0, pA1, j + 1); psm2<false>(pA0, pA1, mhat, negm, alA); } else alA = 1.f;
    __syncthreads(); SWRITE(1, 0);
    RESC(alA); __syncthreads();
  }
  actB = TACT(NT - 1);
  SBAR(); if (actB) qkt2<DQK>(pB0, pB1, K_lds + SHM_K, qr, negm, r32, hi);
  if (actA) fsm2(pA0, pA1, pa0, pa1, pa2, pa3); SBAR();
  if (actA) pv_all2(o, vb0, pa0, pa1, pa2, pa3); if (actB) { AMASK(pB0, pB1, NT - 1); psm2<false>(pB0, pB1, mhat, negm, alB); } else alB = 1.f;
  __syncthreads(); RESC(alB);
  if (actB) { fsm2(pB0, pB1, pa0, pa1, pa2, pa3); SBAR();
    pv_all2(o, vb0 + SHM_V, pa0, pa1, pa2, pa3); }
  __builtin_amdgcn_s_setprio(0);
  float rli[16];
  if (KIND == 1) { if (hi == 0) li_l[r32] = mhat; asm volatile("s_waitcnt lgkmcnt(0)" ::: "memory"); const float sk2 = p.sink[l * 8 + hd] * LOG2E;
#pragma unroll
    for (int r = 0; r < 16; ++r) rli[r] = __builtin_amdgcn_rcpf(o[2][r] + __builtin_amdgcn_exp2f(sk2 - li_l[crow(r, hi)])); }
  else {
#pragma unroll
    for (int r = 0; r < 16; ++r) rli[r] = __builtin_amdgcn_rcpf(o[2][r]); }
  bf16_t* Ow = (bf16_t*)(p.ws + OFF_R + R_H) + (rowq0 + wid * 32) * DM + ocol;
#pragma unroll
  for (int r = 0; r < 16; ++r) { const int orow = crow(r, hi);
#pragma unroll
    for (int d0 = 0; d0 < 2; ++d0) Ow[(size_t)orow * DM + d0 * 32 + r32] = f2bf(o[d0][r] * rli[r]); }
  __syncthreads();
#undef KROW
#undef SLOAD
#undef SWRITE
#undef SWAIT
#undef RESC
#undef AMASK
#undef TACT
}
#ifdef DBG_ATTN_PROBE
template <int KIND, int VAR>
__device__ __forceinline__ void attn_probe_unit(const Prm& p, int l, bool isctx, int b, int hd, int qb, unsigned char* ldsu) {
  constexpr int DQK = KIND == 0 ? 96 : 64, KST = DQK * 2 + 16, SHM_K = 64 * KST, SHM_V = 8192, LPT = KIND == 0 ? 3 : 2;
  char* lds = (char*)ldsu;
  const int tid = TIDX, wid = tid >> 6, lane = tid & 63, r32 = lane & 31, hi = lane >> 5;
  char* V_lds = lds; char* K_lds = lds + 2 * SHM_V;
  float* ws = (float*)(lds + 2 * SHM_V + 2 * SHM_K) + wid * 64; float* li_l = ws; float* al_l = ws + 32;
  const int q0 = qb * 256;
  const size_t rowq0 = (size_t)b * TT + (isctx ? 0 : LC) + q0;
  const bf16_t *Qp, *Kp, *Vp; const bf16_t* KRp = WSP(bf16_t, OFF_KR); int ldq, ldk; int ocol;
  if (KIND == 0) { Qp = (const bf16_t*)(p.ws + OFF_R + R_QB) + hd * 96; ldq = NQB; Kp = (const bf16_t*)(p.ws + OFF_R + R_KB) + hd * 64; Vp = (const bf16_t*)(p.ws + OFF_R + R_VB) + hd * 64; ldk = 512; ocol = 512 + hd * 64; }
  else { Qp = (const bf16_t*)(p.ws + OFF_R + R_QA) + hd * 64; ldq = 512; Kp = (const bf16_t*)(p.ws + OFF_R + R_KA) + (hd >> 2) * 64; Vp = (const bf16_t*)(p.ws + OFF_R + R_VA) + (hd >> 2) * 64; ldk = 128; ocol = hd * 64; }
  int NT, kshift = 0; bool domask = false;
  if (isctx) NT = 4; else if (KIND == 0) NT = TT / 64; else { const int ks = max(0, q0 - 128), ke = min(SEQ, q0 + 384); NT = 4 + (ke - ks) / 64; kshift = ks; domask = true; }
  const size_t kb0 = (size_t)b * TT;
  float mhat = 0.f; f32x16 o[3] = {}; f32x16 negm = {}; bf16x8 qr[DQK / 16];
  { const bf16_t* Qw = Qp + (rowq0 + wid * 32 + r32) * ldq + hi * 8;
#pragma unroll
    for (int d0 = 0; d0 < DQK / 16; ++d0) qr[d0] = *reinterpret_cast<const bf16x8*>(Qw + d0 * 16); }
  const int sr = tid >> 3, sc = (tid & 7) * 8, vst = v_st(sr, sc), kst = sr * KST + sc * 2;
  const int rr_ = (tid & 255) >> 2, rc_ = (tid & 3) * 8, krst = rr_ * KST + 128 + rc_ * 2;
  const int vb0 = (int)(uintptr_t)V_lds + v_rd_base(lane);
  struct { bf16x8 v, k, kr; } st_[1];
#define KROW(j) (kb0 + (size_t)(j) * 64 + ((j) >= 4 ? kshift : 0))
#define SLOAD(i, j) do { if (VAR & 4) break; const size_t kr0_ = KROW(j); st_[i].v = *reinterpret_cast<const bf16x8*>(Vp + (kr0_ + sr) * ldk + sc); st_[i].k = *reinterpret_cast<const bf16x8*>(Kp + (kr0_ + sr) * ldk + sc); \
    if (KIND == 0) st_[i].kr = *reinterpret_cast<const bf16x8*>(KRp + (kr0_ + rr_) * 32 + rc_); } while (0)
#define SWRITE(bf, i) do { if (VAR & 4) break; *(bf16x8*)(V_lds + (bf) * SHM_V + vst) = st_[i].v; *(bf16x8*)(K_lds + (bf) * SHM_K + kst) = st_[i].k; \
    if (KIND == 0) { if (tid < 256) *(bf16x8*)(K_lds + (bf) * SHM_K + krst) = st_[i].kr; } } while (0)
#define SWAIT() do { if (LPT == 3) asm volatile("s_waitcnt vmcnt(3)" ::: "memory"); else asm volatile("s_waitcnt vmcnt(2)" ::: "memory"); } while (0)
#define RESC(a) do { if (__any((a) < 1.f)) { if (hi == 0) al_l[r32] = (a); asm volatile("s_waitcnt lgkmcnt(0)" ::: "memory"); \
    _Pragma("unroll") for (int d = 0; d < 3; ++d) _Pragma("unroll") for (int r = 0; r < 16; ++r) o[d][r] *= al_l[crow(r, hi)]; } } while (0)
#define AMASK(P0, P1, j) do { if (KIND == 1) { if (domask && (j) >= 4) { const int tq_ = q0 + wid * 32 + r32; const int tk_ = kshift + ((j) - 4) * 64 + 4 * hi; \
    _Pragma("unroll") for (int r = 0; r < 16; ++r) { const int d_ = tq_ - (tk_ + (r & 3) + 8 * (r >> 2)); if (d_ > 128 || d_ < -128) P0[r] = -INFINITY; if (d_ - 32 > 128 || d_ - 32 < -128) P1[r] = -INFINITY; } } } } while (0)
  f32x16 pA0, pA1, pB0, pB1; float alA, alB; bf16x8 pa0, pa1, pa2, pa3;
  const int wq0_ = q0 + __builtin_amdgcn_readfirstlane(wid) * 32;
#define TACT(j) (KIND != 1 || !domask || (j) < 4 || (kshift + ((j) - 4) * 64 + 63 >= wq0_ - 128 && kshift + ((j) - 4) * 64 <= wq0_ + 31 + 128))
  bool actA, actB;
  SLOAD(0, 0); asm volatile("s_waitcnt vmcnt(0)" ::: "memory"); SWRITE(0, 0); do { if (!(VAR & 1)) __syncthreads(); } while (0);
  do { if (!(VAR & 16)) qkt2<DQK>(pA0, pA1, K_lds, qr, negm, r32, hi); else { pA0 = negm; pA1 = negm; asm volatile("" : "+v"(pA0), "+v"(pA1)); } } while (0); AMASK(pA0, pA1, 0); do { if (!(VAR & 2)) psm2<true>(pA0, pA1, mhat, negm, alA); else alA = 1.f; } while (0);
  SLOAD(0, 1);
  SWRITE(1, 0); do { if (!(VAR & 1)) __syncthreads(); } while (0);
  for (int j = 1; j + 1 < NT; j += 2) {
    SBAR(); do { if (!(VAR & 16)) qkt2<DQK>(pB0, pB1, K_lds + SHM_K, qr, negm, r32, hi); else { pB0 = negm; pB1 = negm; asm volatile("" : "+v"(pB0), "+v"(pB1)); } } while (0);
    do { if (!(VAR & 2)) fsm2(pA0, pA1, pa0, pa1, pa2, pa3); else { pa0 = __builtin_bit_cast(bf16x8, (f32x4){pA0[0], pA0[1], pA0[2], pA0[3]}); pa1 = __builtin_bit_cast(bf16x8, (f32x4){pA0[4], pA0[5], pA0[6], pA0[7]}); pa2 = __builtin_bit_cast(bf16x8, (f32x4){pA1[0], pA1[1], pA1[2], pA1[3]}); pa3 = __builtin_bit_cast(bf16x8, (f32x4){pA1[4], pA1[5], pA1[6], pA1[7]}); } } while (0); SBAR();
    SLOAD(0, j + 1); SBAR();
    do { if (!(VAR & 8)) pv_all2(o, vb0, pa0, pa1, pa2, pa3); else { asm volatile("" :: "v"(pa0), "v"(pa1), "v"(pa2), "v"(pa3)); } } while (0); AMASK(pB0, pB1, j); do { if (!(VAR & 2)) psm2<false>(pB0, pB1, mhat, negm, alB); else alB = 1.f; } while (0);
    do { if (!(VAR & 1)) __syncthreads(); } while (0); SWRITE(0, 0);
    RESC(alB); do { if (!(VAR & 1)) __syncthreads(); } while (0);
    SBAR(); do { if (!(VAR & 16)) qkt2<DQK>(pA0, pA1, K_lds, qr, negm, r32, hi); else { pA0 = negm; pA1 = negm; asm volatile("" : "+v"(pA0), "+v"(pA1)); } } while (0);
    do { if (!(VAR & 2)) fsm2(pB0, pB1, pa0, pa1, pa2, pa3); else { pa0 = __builtin_bit_cast(bf16x8, (f32x4){pB0[0], pB0[1], pB0[2], pB0[3]}); pa1 = __builtin_bit_cast(bf16x8, (f32x4){pB0[4], pB0[5], pB0[6], pB0[7]}); pa2 = __builtin_bit_cast(bf16x8, (f32x4){pB1[0], pB1[1], pB1[2], pB1[3]}); pa3 = __builtin_bit_cast(bf16x8, (f32x4){pB1[4], pB1[5], pB1[6], pB1[7]}); } } while (0); SBAR();
    SLOAD(0, j + 2); SBAR();
    do { if (!(VAR & 8)) pv_all2(o, vb0 + SHM_V, pa0, pa1, pa2, pa3); else { asm volatile("" :: "v"(pa0), "v"(pa1), "v"(pa2), "v"(pa3)); } } while (0); AMASK(pA0, pA1, j + 1); do { if (!(VAR & 2)) psm2<false>(pA0, pA1, mhat, negm, alA); else alA = 1.f; } while (0);
    do { if (!(VAR & 1)) __syncthreads(); } while (0); SWRITE(1, 0);
    RESC(alA); do { if (!(VAR & 1)) __syncthreads(); } while (0);
  }
  SBAR(); do { if (!(VAR & 16)) qkt2<DQK>(pB0, pB1, K_lds + SHM_K, qr, negm, r32, hi); else { pB0 = negm; pB1 = negm; asm volatile("" : "+v"(pB0), "+v"(pB1)); } } while (0);
  do { if (!(VAR & 2)) fsm2(pA0, pA1, pa0, pa1, pa2, pa3); else { pa0 = __builtin_bit_cast(bf16x8, (f32x4){pA0[0], pA0[1], pA0[2], pA0[3]}); pa1 = __builtin_bit_cast(bf16x8, (f32x4){pA0[4], pA0[5], pA0[6], pA0[7]}); pa2 = __builtin_bit_cast(bf16x8, (f32x4){pA1[0], pA1[1], pA1[2], pA1[3]}); pa3 = __builtin_bit_cast(bf16x8, (f32x4){pA1[4], pA1[5], pA1[6], pA1[7]}); } } while (0); SBAR();
  do { if (!(VAR & 8)) pv_all2(o, vb0, pa0, pa1, pa2, pa3); else { asm volatile("" :: "v"(pa0), "v"(pa1), "v"(pa2), "v"(pa3)); } } while (0); AMASK(pB0, pB1, NT - 1); do { if (!(VAR & 2)) psm2<false>(pB0, pB1, mhat, negm, alB); else alB = 1.f; } while (0);
  do { if (!(VAR & 1)) __syncthreads(); } while (0); RESC(alB);
  do { if (!(VAR & 2)) fsm2(pB0, pB1, pa0, pa1, pa2, pa3); else { pa0 = __builtin_bit_cast(bf16x8, (f32x4){pB0[0], pB0[1], pB0[2], pB0[3]}); pa1 = __builtin_bit_cast(bf16x8, (f32x4){pB0[4], pB0[5], pB0[6], pB0[7]}); pa2 = __builtin_bit_cast(bf16x8, (f32x4){pB1[0], pB1[1], pB1[2], pB1[3]}); pa3 = __builtin_bit_cast(bf16x8, (f32x4){pB1[4], pB1[5], pB1[6], pB1[7]}); } } while (0); SBAR();
  do { if (!(VAR & 8)) pv_all2(o, vb0 + SHM_V, pa0, pa1, pa2, pa3); else { asm volatile("" :: "v"(pa0), "v"(pa1), "v"(pa2), "v"(pa3)); } } while (0);
  float rli[16];
  if (KIND == 1) { if (hi == 0) li_l[r32] = mhat; asm volatile("s_waitcnt lgkmcnt(0)" ::: "memory"); const float sk2 = p.sink[l * 8 + hd] * LOG2E;
#pragma unroll
    for (int r = 0; r < 16; ++r) rli[r] = __builtin_amdgcn_rcpf(o[2][r] + __builtin_amdgcn_exp2f(sk2 - li_l[crow(r, hi)])); }
  else {
#pragma unroll
    for (int r = 0; r < 16; ++r) rli[r] = __builtin_amdgcn_rcpf(o[2][r]); }
  bf16_t* Ow = (bf16_t*)(p.ws + OFF_R + R_CQ) + ((rowq0 + wid * 32) & 16383) * DM + ocol;
#pragma unroll
  for (int r = 0; r < 16; ++r) { const int orow = crow(r, hi);
#pragma unroll
    for (int d0 = 0; d0 < 2; ++d0) Ow[(size_t)orow * DM + d0 * 32 + r32] = f2bf(o[d0][r] * rli[r]); }
  do { if (!(VAR & 1)) __syncthreads(); } while (0);
#undef KROW
#undef SLOAD
#undef SWRITE
#undef SWAIT
#undef RESC
#undef AMASK
#undef TACT
}

template <int VAR>
__device__ __forceinline__ void ph_attn_probe(const Prm& p, int l, unsigned char* lds, int bid, int nb) {
  const int nrounds = (1024 + nb - 1) / nb;
  for (int rd = 0; rd < nrounds; ++rd) { const int pair = rd * 8 + (bid & 7), qb = bid >> 3, u = pair * 32 + qb;
    if (u < 1024) attn_probe_unit<0, VAR>(p, l, false, u >> 8, (u >> 5) & 7, u & 31, lds); }
}
#endif
__device__ __forceinline__ int v_st_p(int k, int c) { return (c >> 5) * 4096 + (k >> 4) * 1024 + (k & 15) * 64 + (c & 31) * 2; }
__device__ __forceinline__ int v_rd_base_p(int lane) { return ((lane >> 4) & 1) * 32 + (lane & 3) * 8 + (4 * (lane >> 5) + ((lane & 15) >> 2)) * 64; }
constexpr int v_rd_off_p(int d0, int ks, int half) { return d0 * 4096 + ks * 1024 + half * 512; }
template <int D0> __device__ __forceinline__ void pv_one_p(f32x16& od, int vb, bf16x8 pa0, bf16x8 pa1, bf16x8 pa2, bf16x8 pa3) {
  const s16x4 l0 = tr_read<v_rd_off_p(D0, 0, 0)>(vb), h0 = tr_read<v_rd_off_p(D0, 0, 1)>(vb), l1 = tr_read<v_rd_off_p(D0, 1, 0)>(vb), h1 = tr_read<v_rd_off_p(D0, 1, 1)>(vb);
  const s16x4 l2 = tr_read<v_rd_off_p(D0, 2, 0)>(vb), h2 = tr_read<v_rd_off_p(D0, 2, 1)>(vb), l3 = tr_read<v_rd_off_p(D0, 3, 0)>(vb), h3 = tr_read<v_rd_off_p(D0, 3, 1)>(vb);
  asm volatile("s_waitcnt lgkmcnt(0)" ::: "memory"); SBAR();
#define PK(L, H) (bf16x8){L[0], L[1], L[2], L[3], H[0], H[1], H[2], H[3]}
  od = __builtin_amdgcn_mfma_f32_32x32x16_bf16(pa0, PK(l0, h0), od, 0, 0, 0);
  od = __builtin_amdgcn_mfma_f32_32x32x16_bf16(pa1, PK(l1, h1), od, 0, 0, 0);
  od = __builtin_amdgcn_mfma_f32_32x32x16_bf16(pa2, PK(l2, h2), od, 0, 0, 0);
  od = __builtin_amdgcn_mfma_f32_32x32x16_bf16(pa3, PK(l3, h3), od, 0, 0, 0);
#undef PK
}
__device__ __forceinline__ void pv_all2p(f32x16* o, int vb, bf16x8 pa0, bf16x8 pa1, bf16x8 pa2, bf16x8 pa3) {
  const s16x4 a0 = tr_read<v_rd_off_p(0, 0, 0)>(vb), b0 = tr_read<v_rd_off_p(0, 0, 1)>(vb), a1 = tr_read<v_rd_off_p(0, 1, 0)>(vb), b1 = tr_read<v_rd_off_p(0, 1, 1)>(vb);
  const s16x4 a2 = tr_read<v_rd_off_p(0, 2, 0)>(vb), b2 = tr_read<v_rd_off_p(0, 2, 1)>(vb), a3 = tr_read<v_rd_off_p(0, 3, 0)>(vb), b3 = tr_read<v_rd_off_p(0, 3, 1)>(vb);
  const s16x4 c0 = tr_read<v_rd_off_p(1, 0, 0)>(vb), d0 = tr_read<v_rd_off_p(1, 0, 1)>(vb), c1 = tr_read<v_rd_off_p(1, 1, 0)>(vb), d1 = tr_read<v_rd_off_p(1, 1, 1)>(vb);
  const s16x4 c2 = tr_read<v_rd_off_p(1, 2, 0)>(vb), d2 = tr_read<v_rd_off_p(1, 2, 1)>(vb), c3 = tr_read<v_rd_off_p(1, 3, 0)>(vb), d3 = tr_read<v_rd_off_p(1, 3, 1)>(vb);
  asm volatile("s_waitcnt lgkmcnt(0)" ::: "memory"); SBAR();
#define PK(L, H) (bf16x8){L[0], L[1], L[2], L[3], H[0], H[1], H[2], H[3]}
  const bf16x8 ones = {16256, 16256, 16256, 16256, 16256, 16256, 16256, 16256};
  o[0] = __builtin_amdgcn_mfma_f32_32x32x16_bf16(pa0, PK(a0, b0), o[0], 0, 0, 0); o[1] = __builtin_amdgcn_mfma_f32_32x32x16_bf16(pa0, PK(c0, d0), o[1], 0, 0, 0); o[2] = __builtin_amdgcn_mfma_f32_32x32x16_bf16(pa0, ones, o[2], 0, 0, 0);
  o[0] = __builtin_amdgcn_mfma_f32_32x32x16_bf16(pa1, PK(a1, b1), o[0], 0, 0, 0); o[1] = __builtin_amdgcn_mfma_f32_32x32x16_bf16(pa1, PK(c1, d1), o[1], 0, 0, 0); o[2] = __builtin_amdgcn_mfma_f32_32x32x16_bf16(pa1, ones, o[2], 0, 0, 0);
  o[0] = __builtin_amdgcn_mfma_f32_32x32x16_bf16(pa2, PK(a2, b2), o[0], 0, 0, 0); o[1] = __builtin_amdgcn_mfma_f32_32x32x16_bf16(pa2, PK(c2, d2), o[1], 0, 0, 0); o[2] = __builtin_amdgcn_mfma_f32_32x32x16_bf16(pa2, ones, o[2], 0, 0, 0);
  o[0] = __builtin_amdgcn_mfma_f32_32x32x16_bf16(pa3, PK(a3, b3), o[0], 0, 0, 0); o[1] = __builtin_amdgcn_mfma_f32_32x32x16_bf16(pa3, PK(c3, d3), o[1], 0, 0, 0); o[2] = __builtin_amdgcn_mfma_f32_32x32x16_bf16(pa3, ones, o[2], 0, 0, 0);
#undef PK
}
__device__ __forceinline__ void fsm2p(f32x16& p0, f32x16& p1, bf16x8& pa0, bf16x8& pa1, bf16x8& pa2, bf16x8& pa3) {
#pragma unroll
  for (int r = 0; r < 16; ++r) p1[r] = __builtin_amdgcn_exp2f(p1[r]);
#define PK8(P, BASE, OUT) do { u32x4 w = {cvtpk(P[BASE + 0], P[BASE + 1]), cvtpk(P[BASE + 2], P[BASE + 3]), cvtpk(P[BASE + 4], P[BASE + 5]), cvtpk(P[BASE + 6], P[BASE + 7])}; OUT = *reinterpret_cast<bf16x8*>(&w); } while (0)
  PK8(p0, 0, pa0); PK8(p0, 8, pa1); PK8(p1, 0, pa2); PK8(p1, 8, pa3);
#undef PK8
}
__device__ __forceinline__ void pv_all2q(f32x16* o, int vb, bf16x8 pa0, bf16x8 pa1, bf16x8 pa2, bf16x8 pa3) {
  const s16x4 a0 = tr_read<v_rd_off_p(0, 0, 0)>(vb), b0 = tr_read<v_rd_off_p(0, 0, 1)>(vb), a1 = tr_read<v_rd_off_p(0, 1, 0)>(vb), b1 = tr_read<v_rd_off_p(0, 1, 1)>(vb);
  const s16x4 a2 = tr_read<v_rd_off_p(0, 2, 0)>(vb), b2 = tr_read<v_rd_off_p(0, 2, 1)>(vb), a3 = tr_read<v_rd_off_p(0, 3, 0)>(vb), b3 = tr_read<v_rd_off_p(0, 3, 1)>(vb);
  const s16x4 c0 = tr_read<v_rd_off_p(1, 0, 0)>(vb), d0 = tr_read<v_rd_off_p(1, 0, 1)>(vb), c1 = tr_read<v_rd_off_p(1, 1, 0)>(vb), d1 = tr_read<v_rd_off_p(1, 1, 1)>(vb);
  const s16x4 c2 = tr_read<v_rd_off_p(1, 2, 0)>(vb), d2 = tr_read<v_rd_off_p(1, 2, 1)>(vb), c3 = tr_read<v_rd_off_p(1, 3, 0)>(vb), d3 = tr_read<v_rd_off_p(1, 3, 1)>(vb);
  asm volatile("s_waitcnt lgkmcnt(0)" ::: "memory"); SBAR();
#define PK(L, H) (bf16x8){L[0], L[1], L[2], L[3], H[0], H[1], H[2], H[3]}
  o[0] = __builtin_amdgcn_mfma_f32_32x32x16_bf16(pa0, PK(a0, b0), o[0], 0, 0, 0); o[1] = __builtin_amdgcn_mfma_f32_32x32x16_bf16(pa0, PK(c0, d0), o[1], 0, 0, 0);
  o[0] = __builtin_amdgcn_mfma_f32_32x32x16_bf16(pa1, PK(a1, b1), o[0], 0, 0, 0); o[1] = __builtin_amdgcn_mfma_f32_32x32x16_bf16(pa1, PK(c1, d1), o[1], 0, 0, 0);
  o[0] = __builtin_amdgcn_mfma_f32_32x32x16_bf16(pa2, PK(a2, b2), o[0], 0, 0, 0); o[1] = __builtin_amdgcn_mfma_f32_32x32x16_bf16(pa2, PK(c2, d2), o[1], 0, 0, 0);
  o[0] = __builtin_amdgcn_mfma_f32_32x32x16_bf16(pa3, PK(a3, b3), o[0], 0, 0, 0); o[1] = __builtin_amdgcn_mfma_f32_32x32x16_bf16(pa3, PK(c3, d3), o[1], 0, 0, 0);
#undef PK
}
__device__ __forceinline__ void fsm2q(f32x16& p0, f32x16& p1, bf16x8& pa0, bf16x8& pa1, bf16x8& pa2, bf16x8& pa3, float& lsum) {
#pragma unroll
  for (int r = 0; r < 16; r += 2) { p1[r] = __builtin_amdgcn_exp2f(p1[r]); lsum += p1[r]; p1[r + 1] = __builtin_amdgcn_exp2f(p1[r + 1]); lsum += p1[r + 1]; }
#define PK8(P, BASE, OUT) do { u32x4 w = {cvtpk(P[BASE + 0], P[BASE + 1]), cvtpk(P[BASE + 2], P[BASE + 3]), cvtpk(P[BASE + 4], P[BASE + 5]), cvtpk(P[BASE + 6], P[BASE + 7])}; OUT = *reinterpret_cast<bf16x8*>(&w); } while (0)
  PK8(p0, 0, pa0); PK8(p0, 8, pa1); PK8(p1, 0, pa2); PK8(p1, 8, pa3);
#undef PK8
}
template <int KIND>
__device__ __forceinline__ void attn_fast_unit2p(const Prm& p, int l, bool isctx, int b, int hd, int qb, unsigned char* ldsu) {
  constexpr int DQK = KIND == 0 ? 96 : 64, KST = DQK * 2 + 16, SHM_K = 64 * KST, SHM_V = 8192, LPT = KIND == 0 ? 3 : 2;
  char* lds = (char*)ldsu;
  const int tid = TIDX, wid = tid >> 6, lane = tid & 63, r32 = lane & 31, hi = lane >> 5;
  char* V_lds = lds; char* K_lds = lds + 2 * SHM_V;
  float* ws = (float*)(lds + 2 * SHM_V + 2 * SHM_K) + wid * 64; float* li_l = ws; float* al_l = ws + 32;
  const int q0 = qb * 256;
  const size_t rowq0 = (size_t)b * TT + (isctx ? 0 : LC) + q0;
  const bf16_t *Qp, *Kp, *Vp; const bf16_t* KRp = WSP(bf16_t, OFF_KR); int ldq, ldk; int ocol;
  if (KIND == 0) { Qp = (const bf16_t*)(p.ws + OFF_R + R_QB) + hd * 96; ldq = NQB; Kp = (const bf16_t*)(p.ws + OFF_R + R_KB) + hd * 64; Vp = (const bf16_t*)(p.ws + OFF_R + R_VB) + hd * 64; ldk = 512; ocol = 512 + hd * 64; }
  else { Qp = (const bf16_t*)(p.ws + OFF_R + R_QA) + hd * 64; ldq = 512; Kp = (const bf16_t*)(p.ws + OFF_R + R_KA) + (hd >> 2) * 64; Vp = (const bf16_t*)(p.ws + OFF_R + R_VA) + (hd >> 2) * 64; ldk = 128; ocol = hd * 64; }
  int NT, kshift = 0; bool domask = false;
  if (isctx) NT = 4; else if (KIND == 0) NT = TT / 64; else { const int ks = max(0, q0 - 128), ke = min(SEQ, q0 + 384); NT = 4 + (ke - ks) / 64; kshift = ks; domask = true; }
  const size_t kb0 = (size_t)b * TT;
  float mhat = 0.f, lsum = 0.f; f32x16 o[2] = {}; f32x16 negm = {}; bf16x8 qr[DQK / 16];
  { const bf16_t* Qw = Qp + (rowq0 + wid * 32 + r32) * ldq + hi * 8;
#pragma unroll
    for (int d0 = 0; d0 < DQK / 16; ++d0) qr[d0] = *reinterpret_cast<const bf16x8*>(Qw + d0 * 16); }
  const int sr = tid >> 3, sc = (tid & 7) * 8, vst = v_st_p(sr, sc), kst = sr * KST + sc * 2;
  const int rr_ = (tid & 255) >> 2, rc_ = (tid & 3) * 8, krst = rr_ * KST + 128 + rc_ * 2;
  const int vb0 = (int)(uintptr_t)V_lds + v_rd_base_p(lane);
  struct { bf16x8 v, k, kr; } st_[1];
#define KROW(j) (kb0 + (size_t)(j) * 64 + ((j) >= 4 ? kshift : 0))
  const unsigned voffs = (unsigned)(sr * ldk + sc) * 2u, kroffs = (unsigned)(rr_ * 32 + rc_) * 2u;
#define SLOAD(i, j) do { const size_t kr0_ = KROW(j); const char* vb_ = (const char*)(Vp + kr0_ * ldk); const char* kb_ = (const char*)(Kp + kr0_ * ldk); \
    st_[i].v = *reinterpret_cast<const bf16x8*>(vb_ + voffs); st_[i].k = *reinterpret_cast<const bf16x8*>(kb_ + voffs); \
    if (KIND == 0) { const char* rb_ = (const char*)(KRp + kr0_ * 32); st_[i].kr = *reinterpret_cast<const bf16x8*>(rb_ + kroffs); } } while (0)
#define SWRITE(bf, i) do { *(bf16x8*)(V_lds + (bf) * SHM_V + vst) = st_[i].v; *(bf16x8*)(K_lds + (bf) * SHM_K + kst) = st_[i].k; \
    if (KIND == 0) { if (tid < 256) *(bf16x8*)(K_lds + (bf) * SHM_K + krst) = st_[i].kr; } } while (0)
#define SWAIT() do { if (LPT == 3) asm volatile("s_waitcnt vmcnt(3)" ::: "memory"); else asm volatile("s_waitcnt vmcnt(2)" ::: "memory"); } while (0)
#define RESC(a) do { if (__any((a) < 1.f)) { if (hi == 0) al_l[r32] = (a); asm volatile("s_waitcnt lgkmcnt(0)" ::: "memory"); \
    _Pragma("unroll") for (int d = 0; d < 2; ++d) _Pragma("unroll") for (int r = 0; r < 16; ++r) o[d][r] *= al_l[crow(r, hi)]; } } while (0)
#define AMASK(P0, P1, j) do { if (KIND == 1) { if (domask && (j) >= 4) { const int tq_ = q0 + wid * 32 + r32; const int tk_ = kshift + ((j) - 4) * 64 + 4 * hi; \
    _Pragma("unroll") for (int r = 0; r < 16; ++r) { const int d_ = tq_ - (tk_ + (r & 3) + 8 * (r >> 2)); if (d_ > 128 || d_ < -128) P0[r] = -INFINITY; if (d_ - 32 > 128 || d_ - 32 < -128) P1[r] = -INFINITY; } } } } while (0)
  if (__builtin_amdgcn_readfirstlane(wid) >= 4) __builtin_amdgcn_s_setprio(1);
  f32x16 pA0, pA1, pB0, pB1; float alA, alB; bf16x8 pa0, pa1, pa2, pa3;
  const int wq0_ = q0 + __builtin_amdgcn_readfirstlane(wid) * 32;
#define TACT(j) (KIND != 1 || !domask || (j) < 4 || (kshift + ((j) - 4) * 64 + 63 >= wq0_ - 128 && kshift + ((j) - 4) * 64 <= wq0_ + 31 + 128))
  bool actA, actB;
  SLOAD(0, 0); asm volatile("s_waitcnt vmcnt(0)" ::: "memory"); SWRITE(0, 0); __syncthreads();
  actA = true; qkt2<DQK>(pA0, pA1, K_lds, qr, negm, r32, hi); AMASK(pA0, pA1, 0); psm2q<true>(pA0, pA1, mhat, negm, alA, lsum);
  SLOAD(0, 1);
  SWRITE(1, 0); __syncthreads();
  for (int j = 1; j + 1 < NT; j += 2) {
    actB = TACT(j);
    SBAR(); SLOAD(0, j + 1); SBAR();
    if (actB) qkt2<DQK>(pB0, pB1, K_lds + SHM_K, qr, negm, r32, hi);
    if (actA) fsm2q(pA0, pA1, pa0, pa1, pa2, pa3, lsum); SBAR();
    if (actA) pv_all2q(o, vb0, pa0, pa1, pa2, pa3); if (actB) { AMASK(pB0, pB1, j); psm2q<false>(pB0, pB1, mhat, negm, alB, lsum); } else alB = 1.f;
    __syncthreads(); SWRITE(0, 0);
    RESC(alB); __syncthreads();
    actA = TACT(j + 1);
    SBAR(); SLOAD(0, j + 2); SBAR();
    if (actA) qkt2<DQK>(pA0, pA1, K_lds, qr, negm, r32, hi);
    if (actB) fsm2q(pB0, pB1, pa0, pa1, pa2, pa3, lsum); SBAR();
    if (actB) pv_all2q(o, vb0 + SHM_V, pa0, pa1, pa2, pa3); if (actA) { AMASK(pA0, pA1, j + 1); psm2q<false>(pA0, pA1, mhat, negm, alA, lsum); } else alA = 1.f;
    __syncthreads(); SWRITE(1, 0);
    RESC(alA); __syncthreads();
  }
  actB = TACT(NT - 1);
  SBAR(); if (actB) qkt2<DQK>(pB0, pB1, K_lds + SHM_K, qr, negm, r32, hi);
  if (actA) fsm2q(pA0, pA1, pa0, pa1, pa2, pa3, lsum); SBAR();
  if (actA) pv_all2q(o, vb0, pa0, pa1, pa2, pa3); if (actB) { AMASK(pB0, pB1, NT - 1); psm2q<false>(pB0, pB1, mhat, negm, alB, lsum); } else alB = 1.f;
  __syncthreads(); RESC(alB);
  if (actB) { fsm2q(pB0, pB1, pa0, pa1, pa2, pa3, lsum); SBAR();
    pv_all2q(o, vb0 + SHM_V, pa0, pa1, pa2, pa3); }
  __builtin_amdgcn_s_setprio(0);
  const int lanee = TIDX & 63, r32e = lanee & 31, hie = lanee >> 5;
  float rli[16];
  { auto rr = __builtin_amdgcn_permlane32_swap(__float_as_uint(lsum), __float_as_uint(lsum), false, false); lsum = __uint_as_float(rr[0]) + __uint_as_float(rr[1]); }
  if (hie == 0) { al_l[r32e] = lsum; if (KIND == 1) li_l[r32e] = mhat; } asm volatile("s_waitcnt lgkmcnt(0)" ::: "memory");
  if (KIND == 1) { const float sk2 = p.sink[l * 8 + hd] * LOG2E;
#pragma unroll
    for (int r = 0; r < 16; ++r) rli[r] = __builtin_amdgcn_rcpf(al_l[crow(r, hie)] + __builtin_amdgcn_exp2f(sk2 - li_l[crow(r, hie)])); }
  else {
#pragma unroll
    for (int r = 0; r < 16; ++r) rli[r] = __builtin_amdgcn_rcpf(al_l[crow(r, hie)]); }
  bf16_t* Ow = (bf16_t*)(p.ws + OFF_R + R_H) + (rowq0 + wid * 32) * DM + ocol;
#pragma unroll
  for (int r = 0; r < 16; ++r) { const int orow = crow(r, hie);
#pragma unroll
    for (int d0 = 0; d0 < 2; ++d0) Ow[(size_t)orow * DM + d0 * 32 + r32e] = f2bf(o[d0][r] * rli[r]); }
  __syncthreads();
#undef KROW
#undef SLOAD
#undef SWRITE
#undef SWAIT
#undef RESC
#undef AMASK
#undef TACT
}
#ifdef DBG_ATTN_PROBE
template <int KIND, int VAR>
__device__ __forceinline__ void attn_probe_unit(const Prm& p, int l, bool isctx, int b, int hd, int qb, unsigned char* ldsu) {
  constexpr int DQK = KIND == 0 ? 96 : 64, KST = DQK * 2 + 16, SHM_K = 64 * KST, SHM_V = 8192, LPT = KIND == 0 ? 3 : 2;
  char* lds = (char*)ldsu;
  const int tid = TIDX, wid = tid >> 6, lane = tid & 63, r32 = lane & 31, hi = lane >> 5;
  char* V_lds = lds; char* K_lds = lds + 2 * SHM_V;
  float* ws = (float*)(lds + 2 * SHM_V + 2 * SHM_K) + wid * 64; float* li_l = ws; float* al_l = ws + 32;
  const int q0 = qb * 256;
  const size_t rowq0 = (size_t)b * TT + (isctx ? 0 : LC) + q0;
  const bf16_t *Qp, *Kp, *Vp; const bf16_t* KRp = WSP(bf16_t, OFF_KR); int ldq, ldk; int ocol;
  if (KIND == 0) { Qp = (const bf16_t*)(p.ws + OFF_R + R_QB) + hd * 96; ldq = NQB; Kp = (const bf16_t*)(p.ws + OFF_R + R_KB) + hd * 64; Vp = (const bf16_t*)(p.ws + OFF_R + R_VB) + hd * 64; ldk = 512; ocol = 512 + hd * 64; }
  else { Qp = (const bf16_t*)(p.ws + OFF_R + R_QA) + hd * 64; ldq = 512; Kp = (const bf16_t*)(p.ws + OFF_R + R_KA) + (hd >> 2) * 64; Vp = (const bf16_t*)(p.ws + OFF_R + R_VA) + (hd >> 2) * 64; ldk = 128; ocol = hd * 64; }
  int NT, kshift = 0; bool domask = false;
  if (isctx) NT = 4; else if (KIND == 0) NT = TT / 64; else { const int ks = max(0, q0 - 128), ke = min(SEQ, q0 + 384); NT = 4 + (ke - ks) / 64; kshift = ks; domask = true; }
  const size_t kb0 = (size_t)b * TT;
  float mhat = 0.f; f32x16 o[3] = {}; f32x16 negm = {}; bf16x8 qr[DQK / 16];
  { const bf16_t* Qw = Qp + (rowq0 + wid * 32 + r32) * ldq + hi * 8;
#pragma unroll
    for (int d0 = 0; d0 < DQK / 16; ++d0) qr[d0] = *reinterpret_cast<const bf16x8*>(Qw + d0 * 16); }
  const int sr = tid >> 3, sc = (tid & 7) * 8, vst = v_st_p(sr, sc), kst = sr * KST + sc * 2;
  const int rr_ = (tid & 255) >> 2, rc_ = (tid & 3) * 8, krst = rr_ * KST + 128 + rc_ * 2;
  const int vb0 = (int)(uintptr_t)V_lds + v_rd_base_p(lane);
  struct { bf16x8 v, k, kr; } st_[1];
#define KROW(j) (kb0 + (size_t)(j) * 64 + ((j) >= 4 ? kshift : 0))
#define SLOAD(i, j) do { if (VAR & 4) break; const size_t kr0_ = KROW(j); st_[i].v = *reinterpret_cast<const bf16x8*>(Vp + (kr0_ + sr) * ldk + sc); st_[i].k = *reinterpret_cast<const bf16x8*>(Kp + (kr0_ + sr) * ldk + sc); \
    if (KIND == 0) st_[i].kr = *reinterpret_cast<const bf16x8*>(KRp + (kr0_ + rr_) * 32 + rc_); } while (0)
#define SWRITE(bf, i) do { if (VAR & 4) break; *(bf16x8*)(V_lds + (bf) * SHM_V + vst) = st_[i].v; *(bf16x8*)(K_lds + (bf) * SHM_K + kst) = st_[i].k; \
    if (KIND == 0) { if (tid < 256) *(bf16x8*)(K_lds + (bf) * SHM_K + krst) = st_[i].kr; } } while (0)
#define SWAIT() do { if (LPT == 3) asm volatile("s_waitcnt vmcnt(3)" ::: "memory"); else asm volatile("s_waitcnt vmcnt(2)" ::: "memory"); } while (0)
#define RESC(a) do { if (__any((a) < 1.f)) { if (hi == 0) al_l[r32] = (a); asm volatile("s_waitcnt lgkmcnt(0)" ::: "memory"); \
    _Pragma("unroll") for (int d = 0; d < 3; ++d) _Pragma("unroll") for (int r = 0; r < 16; ++r) o[d][r] *= al_l[crow(r, hi)]; } } while (0)
#define AMASK(P0, P1, j) do { if (KIND == 1) { if (domask && (j) >= 4) { const int tq_ = q0 + wid * 32 + r32; const int tk_ = kshift + ((j) - 4) * 64 + 4 * hi; \
    _Pragma("unroll") for (int r = 0; r < 16; ++r) { const int d_ = tq_ - (tk_ + (r & 3) + 8 * (r >> 2)); if (d_ > 128 || d_ < -128) P0[r] = -INFINITY; if (d_ - 32 > 128 || d_ - 32 < -128) P1[r] = -INFINITY; } } } } while (0)
  f32x16 pA0, pA1, pB0, pB1; float alA, alB; bf16x8 pa0, pa1, pa2, pa3;
  const int wq0_ = q0 + __builtin_amdgcn_readfirstlane(wid) * 32;
#define TACT(j) (KIND != 1 || !domask || (j) < 4 || (kshift + ((j) - 4) * 64 + 63 >= wq0_ - 128 && kshift + ((j) - 4) * 64 <= wq0_ + 31 + 128))
  bool actA, actB;
  SLOAD(0, 0); asm volatile("s_waitcnt vmcnt(0)" ::: "memory"); SWRITE(0, 0); do { if (!(VAR & 1)) __syncthreads(); } while (0);
  do { if (!(VAR & 16)) qkt2<DQK>(pA0, pA1, K_lds, qr, negm, r32, hi); else { pA0 = negm; pA1 = negm; asm volatile("" : "+v"(pA0), "+v"(pA1)); } } while (0); AMASK(pA0, pA1, 0); do { if (!(VAR & 2)) psm2<true>(pA0, pA1, mhat, negm, alA); else alA = 1.f; } while (0);
  SLOAD(0, 1);
  SWRITE(1, 0); do { if (!(VAR & 1)) __syncthreads(); } while (0);
  for (int j = 1; j + 1 < NT; j += 2) {
    SBAR(); do { if (!(VAR & 16)) qkt2<DQK>(pB0, pB1, K_lds + SHM_K, qr, negm, r32, hi); else { pB0 = negm; pB1 = negm; asm volatile("" : "+v"(pB0), "+v"(pB1)); } } while (0);
    do { if (!(VAR & 2)) fsm2p(pA0, pA1, pa0, pa1, pa2, pa3); else { pa0 = __builtin_bit_cast(bf16x8, (f32x4){pA0[0], pA0[1], pA0[2], pA0[3]}); pa1 = __builtin_bit_cast(bf16x8, (f32x4){pA0[4], pA0[5], pA0[6], pA0[7]}); pa2 = __builtin_bit_cast(bf16x8, (f32x4){pA1[0], pA1[1], pA1[2], pA1[3]}); pa3 = __builtin_bit_cast(bf16x8, (f32x4){pA1[4], pA1[5], pA1[6], pA1[7]}); } } while (0); SBAR();
    SLOAD(0, j + 1); SBAR();
    do { if (!(VAR & 8)) pv_all2p(o, vb0, pa0, pa1, pa2, pa3); else { asm volatile("" :: "v"(pa0), "v"(pa1), "v"(pa2), "v"(pa3)); } } while (0); AMASK(pB0, pB1, j); do { if (!(VAR & 2)) psm2<false>(pB0, pB1, mhat, negm, alB); else alB = 1.f; } while (0);
    do { if (!(VAR & 1)) __syncthreads(); } while (0); SWRITE(0, 0);
    RESC(alB); do { if (!(VAR & 1)) __syncthreads(); } while (0);
    SBAR(); do { if (!(VAR & 16)) qkt2<DQK>(pA0, pA1, K_lds, qr, negm, r32, hi); else { pA0 = negm; pA1 = negm; asm volatile("" : "+v"(pA0), "+v"(pA1)); } } while (0);
    do { if (!(VAR & 2)) fsm2p(pB0, pB1, pa0, pa1, pa2, pa3); else { pa0 = __builtin_bit_cast(bf16x8, (f32x4){pB0[0], pB0[1], pB0[2], pB0[3]}); pa1 = __builtin_bit_cast(bf16x8, (f32x4){pB0[4], pB0[5], pB0[6], pB0[7]}); pa2 = __builtin_bit_cast(bf16x8, (f32x4){pB1[0], pB1[1], pB1[2], pB1[3]}); pa3 = __builtin_bit_cast(bf16x8, (f32x4){pB1[4], pB1[5], pB1[6], pB1[7]}); } } while (0); SBAR();
    SLOAD(0, j + 2); SBAR();
    do { if (!(VAR & 8)) pv_all2p(o, vb0 + SHM_V, pa0, pa1, pa2, pa3); else { asm volatile("" :: "v"(pa0), "v"(pa1), "v"(pa2), "v"(pa3)); } } while (0); AMASK(pA0, pA1, j + 1); do { if (!(VAR & 2)) psm2<false>(pA0, pA1, mhat, negm, alA); else alA = 1.f; } while (0);
    do { if (!(VAR & 1)) __syncthreads(); } while (0); SWRITE(1, 0);
    RESC(alA); do { if (!(VAR & 1)) __syncthreads(); } while (0);
  }
  SBAR(); do { if (!(VAR & 16)) qkt2<DQK>(pB0, pB1, K_lds + SHM_K, qr, negm, r32, hi); else { pB0 = negm; pB1 = negm; asm volatile("" : "+v"(pB0), "+v"(pB1)); } } while (0);
  do { if (!(VAR & 2)) fsm2p(pA0, pA1, pa0, pa1, pa2, pa3); else { pa0 = __builtin_bit_cast(bf16x8, (f32x4){pA0[0], pA0[1], pA0[2], pA0[3]}); pa1 = __builtin_bit_cast(bf16x8, (f32x4){pA0[4], pA0[5], pA0[6], pA0[7]}); pa2 = __builtin_bit_cast(bf16x8, (f32x4){pA1[0], pA1[1], pA1[2], pA1[3]}); pa3 = __builtin_bit_cast(bf16x8, (f32x4){pA1[4], pA1[5], pA1[6], pA1[7]}); } } while (0); SBAR();
  do { if (!(VAR & 8)) pv_all2p(o, vb0, pa0, pa1, pa2, pa3); else { asm volatile("" :: "v"(pa0), "v"(pa1), "v"(pa2), "v"(pa3)); } } while (0); AMASK(pB0, pB1, NT - 1); do { if (!(VAR & 2)) psm2<false>(pB0, pB1, mhat, negm, alB); else alB = 1.f; } while (0);
  do { if (!(VAR & 1)) __syncthreads(); } while (0); RESC(alB);
  do { if (!(VAR & 2)) fsm2p(pB0, pB1, pa0, pa1, pa2, pa3); else { pa0 = __builtin_bit_cast(bf16x8, (f32x4){pB0[0], pB0[1], pB0[2], pB0[3]}); pa1 = __builtin_bit_cast(bf16x8, (f32x4){pB0[4], pB0[5], pB0[6], pB0[7]}); pa2 = __builtin_bit_cast(bf16x8, (f32x4){pB1[0], pB1[1], pB1[2], pB1[3]}); pa3 = __builtin_bit_cast(bf16x8, (f32x4){pB1[4], pB1[5], pB1[6], pB1[7]}); } } while (0); SBAR();
  do { if (!(VAR & 8)) pv_all2p(o, vb0 + SHM_V, pa0, pa1, pa2, pa3); else { asm volatile("" :: "v"(pa0), "v"(pa1), "v"(pa2), "v"(pa3)); } } while (0);
  float rli[16];
  if (KIND == 1) { if (hi == 0) li_l[r32] = mhat; asm volatile("s_waitcnt lgkmcnt(0)" ::: "memory"); const float sk2 = p.sink[l * 8 + hd] * LOG2E;
#pragma unroll
    for (int r = 0; r < 16; ++r) rli[r] = __builtin_amdgcn_rcpf(o[2][r] + __builtin_amdgcn_exp2f(sk2 - li_l[crow(r, hi)])); }
  else {
#pragma unroll
    for (int r = 0; r < 16; ++r) rli[r] = __builtin_amdgcn_rcpf(o[2][r]); }
  bf16_t* Ow = (bf16_t*)(p.ws + OFF_R + R_CQ) + ((rowq0 + wid * 32) & 16383) * DM + ocol;
#pragma unroll
  for (int r = 0; r < 16; ++r) { const int orow = crow(r, hi);
#pragma unroll
    for (int d0 = 0; d0 < 2; ++d0) Ow[(size_t)orow * DM + d0 * 32 + r32] = f2bf(o[d0][r] * rli[r]); }
  do { if (!(VAR & 1)) __syncthreads(); } while (0);
#undef KROW
#undef SLOAD
#undef SWRITE
#undef SWAIT
#undef RESC
#undef AMASK
#undef TACT
}

template <int VAR>
__device__ __forceinline__ void ph_attn_probe(const Prm& p, int l, unsigned char* lds, int bid, int nb) {
  const int nrounds = (1024 + nb - 1) / nb;
  for (int rd = 0; rd < nrounds; ++rd) { const int pair = rd * 8 + (bid & 7), qb = bid >> 3, u = pair * 32 + qb;
    if (u < 1024) attn_probe_unit<0, VAR>(p, l, false, u >> 8, (u >> 5) & 7, u & 31, lds); }
}
#endif
template <int KIND>
__device__ __forceinline__ void attn_fast_unit3(const Prm& p, int l, bool isctx, int b, int hd, int qb, unsigned char* ldsu) {
  constexpr int DQK = KIND == 0 ? 96 : 64, KST = DQK * 2 + 16, SHM_K = 64 * KST, SHM_V = 8192, LPT = KIND == 0 ? 3 : 2;
  char* lds = (char*)ldsu;
  const int tid = TIDX, wid = tid >> 6, lane = tid & 63, r32 = lane & 31, hi = lane >> 5;
  char* V_lds = lds; char* K_lds = lds + 3 * SHM_V;
  float* ws = (float*)(lds + 3 * SHM_V + 3 * SHM_K) + wid * 64; float* li_l = ws; float* al_l = ws + 32;
  const int q0 = qb * 256;
  const size_t rowq0 = (size_t)b * TT + (isctx ? 0 : LC) + q0;
  const bf16_t *Qp, *Kp, *Vp; const bf16_t* KRp = WSP(bf16_t, OFF_KR); int ldq, ldk; int ocol;
  if (KIND == 0) { Qp = (const bf16_t*)(p.ws + OFF_R + R_QB) + hd * 96; ldq = NQB; Kp = (const bf16_t*)(p.ws + OFF_R + R_KB) + hd * 64; Vp = (const bf16_t*)(p.ws + OFF_R + R_VB) + hd * 64; ldk = 512; ocol = 512 + hd * 64; }
  else { Qp = (const bf16_t*)(p.ws + OFF_R + R_QA) + hd * 64; ldq = 512; Kp = (const bf16_t*)(p.ws + OFF_R + R_KA) + (hd >> 2) * 64; Vp = (const bf16_t*)(p.ws + OFF_R + R_VA) + (hd >> 2) * 64; ldk = 128; ocol = hd * 64; }
  int NT, kshift = 0; bool domask = false;
  if (isctx) NT = 4; else if (KIND == 0) NT = TT / 64; else { const int ks = max(0, q0 - 128), ke = min(SEQ, q0 + 384); NT = 4 + (ke - ks) / 64; kshift = ks; domask = true; }
  const size_t kb0 = (size_t)b * TT;
  float mhat = 0.f; f32x16 o[3] = {}; f32x16 negm = {}; bf16x8 qr[DQK / 16];
  { const bf16_t* Qw = Qp + (rowq0 + wid * 32 + r32) * ldq + hi * 8;
#pragma unroll
    for (int d0 = 0; d0 < DQK / 16; ++d0) qr[d0] = *reinterpret_cast<const bf16x8*>(Qw + d0 * 16); }
  const int sr = tid >> 3, sc = (tid & 7) * 8, vst = v_st(sr, sc), kst = sr * KST + sc * 2;
  const int rr_ = (tid & 255) >> 2, rc_ = (tid & 3) * 8, krst = rr_ * KST + 128 + rc_ * 2;
  const int vb0 = (int)(uintptr_t)V_lds + v_rd_base(lane);
  struct { bf16x8 v, k, kr; } st_[1];
#define KROW(j) (kb0 + (size_t)(j) * 64 + ((j) >= 4 ? kshift : 0))
#define SLOAD(i, j) do { const size_t kr0_ = KROW(j); st_[i].v = *reinterpret_cast<const bf16x8*>(Vp + (kr0_ + sr) * ldk + sc); st_[i].k = *reinterpret_cast<const bf16x8*>(Kp + (kr0_ + sr) * ldk + sc); \
    if (KIND == 0) st_[i].kr = *reinterpret_cast<const bf16x8*>(KRp + (kr0_ + rr_) * 32 + rc_); } while (0)
#define SWRITE(bf, i) do { *(bf16x8*)(V_lds + (bf) * SHM_V + vst) = st_[i].v; *(bf16x8*)(K_lds + (bf) * SHM_K + kst) = st_[i].k; \
    if (KIND == 0) { if (tid < 256) *(bf16x8*)(K_lds + (bf) * SHM_K + krst) = st_[i].kr; } } while (0)
#define SWAIT() do { if (LPT == 3) asm volatile("s_waitcnt vmcnt(3)" ::: "memory"); else asm volatile("s_waitcnt vmcnt(2)" ::: "memory"); } while (0)
#define RESC(a) do { if (__any((a) < 1.f)) { if (hi == 0) al_l[r32] = (a); asm volatile("s_waitcnt lgkmcnt(0)" ::: "memory"); \
    _Pragma("unroll") for (int d = 0; d < 3; ++d) _Pragma("unroll") for (int r = 0; r < 16; ++r) o[d][r] *= al_l[crow(r, hi)]; } } while (0)
#define AMASK(P0, P1, j) do { if (KIND == 1) { if (domask && (j) >= 4) { const int tq_ = q0 + wid * 32 + r32; const int tk_ = kshift + ((j) - 4) * 64 + 4 * hi; \
    _Pragma("unroll") for (int r = 0; r < 16; ++r) { const int d_ = tq_ - (tk_ + (r & 3) + 8 * (r >> 2)); if (d_ > 128 || d_ < -128) P0[r] = -INFINITY; if (d_ - 32 > 128 || d_ - 32 < -128) P1[r] = -INFINITY; } } } } while (0)
  f32x16 pA0, pA1, pB0, pB1; float alA, alB; bf16x8 pa0, pa1, pa2, pa3;
  SLOAD(0, 0); SWRITE(0, 0); SLOAD(0, 1); SWRITE(1, 0); __syncthreads();
  qkt2<DQK>(pA0, pA1, K_lds, qr, negm, r32, hi); AMASK(pA0, pA1, 0); psm2<true>(pA0, pA1, mhat, negm, alA);
  int r0 = 0, r1 = 1, r2 = 2;
#define ITER(PP0, PP1, PC0, PC1, ALC, j) do { \
    if ((j) + 2 < NT) SLOAD(0, (j) + 2); \
    SBAR(); qkt2<DQK>(PC0, PC1, K_lds + r1 * SHM_K, qr, negm, r32, hi); \
    fsm2(PP0, PP1, pa0, pa1, pa2, pa3); SBAR(); \
    pv_all2(o, vb0 + r0 * SHM_V, pa0, pa1, pa2, pa3); AMASK(PC0, PC1, (j) + 1); psm2<false>(PC0, PC1, mhat, negm, ALC); \
    RESC(ALC); \
    if ((j) + 2 < NT) SWRITE(r2, 0); \
    __syncthreads(); \
    { const int t_ = r0; r0 = r1; r1 = r2; r2 = t_; } } while (0)
  int j = 0;
  for (; j + 2 < NT; j += 2) { ITER(pA0, pA1, pB0, pB1, alB, j); ITER(pB0, pB1, pA0, pA1, alA, j + 1); }
  ITER(pA0, pA1, pB0, pB1, alB, j);
  fsm2(pB0, pB1, pa0, pa1, pa2, pa3); SBAR();
  pv_all2(o, vb0 + r0 * SHM_V, pa0, pa1, pa2, pa3);
#undef ITER
  float rli[16];
  if (KIND == 1) { if (hi == 0) li_l[r32] = mhat; asm volatile("s_waitcnt lgkmcnt(0)" ::: "memory"); const float sk2 = p.sink[l * 8 + hd] * LOG2E;
#pragma unroll
    for (int r = 0; r < 16; ++r) rli[r] = __builtin_amdgcn_rcpf(o[2][r] + __builtin_amdgcn_exp2f(sk2 - li_l[crow(r, hi)])); }
  else {
#pragma unroll
    for (int r = 0; r < 16; ++r) rli[r] = __builtin_amdgcn_rcpf(o[2][r]); }
  bf16_t* Ow = (bf16_t*)(p.ws + OFF_R + R_H) + (rowq0 + wid * 32) * DM + ocol;
#pragma unroll
  for (int r = 0; r < 16; ++r) { const int orow = crow(r, hi);
#pragma unroll
    for (int d0 = 0; d0 < 2; ++d0) Ow[(size_t)orow * DM + d0 * 32 + r32] = f2bf(o[d0][r] * rli[r]); }
  __syncthreads();
#undef KROW
#undef SLOAD
#undef SWRITE
#undef SWAIT
#undef RESC
#undef AMASK
}
#ifndef ATTN_V2
#define ATTN_V2 1
#endif
#ifndef ATTN_V3
#define ATTN_V3 0
#endif
#ifndef ATTN_V2P
#define ATTN_V2P 1
#endif
#if ATTN_V2P
#define ATTN_UNIT attn_fast_unit2p
#elif ATTN_V3
#define ATTN_UNIT attn_fast_unit3
#elif ATTN_V2
#define ATTN_UNIT attn_fast_unit2
#else
#define ATTN_UNIT attn_fast_unit
#endif
__device__ __forceinline__ void ph_attn_fast(const Prm& p, int l, unsigned char* lds, int bid, int nb) {
  const int nrounds = (1024 + nb - 1) / nb;
  for (int rd = 0; rd < nrounds; ++rd) { int u;
    if ((nb & 7) == 0 && (nb >> 3) == 32) { const int pair = rd * 8 + (bid & 7), qb = bid >> 3; u = pair * 32 + qb; } else u = rd * nb + bid;
    if (u < 1024) ATTN_UNIT<0>(p, l, false, u >> 8, (u >> 5) & 7, u & 31, lds); }
  for (int rd = 0; rd < nrounds; ++rd) { int u;
    if ((nb & 7) == 0 && (nb >> 3) == 32) { const int pair = rd * 8 + (bid & 7), qb = bid >> 3; u = pair * 32 + qb; } else u = rd * nb + bid;
    if (u < 1024) ATTN_UNIT<1>(p, l, false, u >> 8, (u >> 5) & 7, u & 31, lds); }
  if (l != DEPTH - 1) for (int u = bid; u < 64; u += nb) { const int kind = u & 1, hd = (u >> 1) & 7, b = u >> 4;
      if (kind == 0) ATTN_UNIT<0>(p, l, true, b, hd, 0, lds); else ATTN_UNIT<1>(p, l, true, b, hd, 0, lds); }
}

#define XB_TMO      128
#define XB_XCNT(j)  (256  + 64 * (j))
#define XB_XSUB(j)  (1280 + 64 * (j))
#define XB_XGEN(j)  (2304 + 64 * (j))
#define XB_TOP      3328
#define XB_TOPGEN   3392
#define XCD_BAR_WORDS 3456
#define XB_SPIN_CAP (1u << 22)
#define LAS __attribute__((address_space(3)))
__device__ __forceinline__ unsigned xb_ld(unsigned* p)              { return __hip_atomic_load(p, __ATOMIC_RELAXED, __HIP_MEMORY_SCOPE_AGENT); }
__device__ __forceinline__ unsigned xb_add(unsigned* p, unsigned v) { return __hip_atomic_fetch_add(p, v, __ATOMIC_RELAXED, __HIP_MEMORY_SCOPE_AGENT); }
__device__ __forceinline__ unsigned xb_xcc_id() { return (unsigned)__builtin_amdgcn_s_getreg((3 << 11) | 20) & 0xFu; }
#define XB_SPIN(cond, bar) do { unsigned _sp = 0; while (cond) { __builtin_amdgcn_s_sleep(1); \
    if ((++_sp & 255u) == 0u) { if (xb_ld(&(bar)[XB_TMO])) break; if (_sp > XB_SPIN_CAP) { atomicAdd(&(bar)[XB_TMO], 1u); break; } } } } while (0)
struct XcdBarrier { unsigned* bar; unsigned x; volatile LAS unsigned* st; };
__device__ __forceinline__ XcdBarrier xcd_barrier_post(unsigned* bar, volatile LAS unsigned* st) {
    XcdBarrier b; b.bar = bar; b.x = xb_xcc_id(); b.st = st;
    if (TIDX == 0) (void)xb_add(&bar[XB_XCNT(b.x)], 1u);
    return b;
}
__device__ __forceinline__ void xcd_barrier_complete(unsigned* bar, unsigned x, unsigned& nloc, unsigned& nx) {
    const unsigned G = gridDim.x * gridDim.y * gridDim.z;
    unsigned sum, cnt, mine, sp = 0u;
    for (;;) {
        sum = 0u; cnt = 0u; mine = 0u;
#pragma unroll
        for (unsigned j = 0; j < 16; ++j) { const unsigned c = xb_ld(&bar[XB_XCNT(j)]); sum += c; cnt += (c > 0u) ? 1u : 0u; mine = (j == x) ? c : mine; }
        if (sum == G) break;
        __builtin_amdgcn_s_sleep(1);
        if ((++sp & 255u) == 0u) { if (xb_ld(&bar[XB_TMO])) break; if (sp > XB_SPIN_CAP) { atomicAdd(&bar[XB_TMO], 1u); break; } }
    }
    nloc = mine > 0u ? mine : 1u; nx = cnt > 0u ? cnt : 1u;
}
__device__ __forceinline__ void xcd_barrier(const XcdBarrier& b) {
    asm volatile("s_waitcnt vmcnt(0)" ::: "memory");
    __syncthreads();
    if (TIDX == 0) {
        unsigned* bar = b.bar;
        __builtin_amdgcn_s_waitcnt(0);
        unsigned nloc = b.st[0], nx = b.st[1];
        if (nloc == 0u) { xcd_barrier_complete(bar, b.x, nloc, nx); b.st[0] = nloc; b.st[1] = nx; }
        const unsigned old = xb_add(&bar[XB_XSUB(b.x)], 1u);
        const unsigned gen = old / nloc;
        if (old + 1u == (gen + 1u) * nloc) {
            __builtin_amdgcn_fence(__ATOMIC_RELEASE, "agent");
            asm volatile("s_waitcnt vmcnt(0)" ::: "memory");
            const unsigned og = xb_add(&bar[XB_TOP], 1u);
            const unsigned tg = og / nx;
            if (og + 1u == (tg + 1u) * nx) xb_add(&bar[XB_TOPGEN], 1u);
            else XB_SPIN(xb_ld(&bar[XB_TOPGEN]) == tg, bar);
            __builtin_amdgcn_fence(__ATOMIC_ACQUIRE, "agent");
            xb_add(&bar[XB_XGEN(b.x)], 1u);
            asm volatile("s_waitcnt vmcnt(0)" ::: "memory");
        } else {
            XB_SPIN(xb_ld(&bar[XB_XGEN(b.x)]) == gen, bar);
            __builtin_amdgcn_fence(__ATOMIC_ACQUIRE, "agent");
            asm volatile("s_waitcnt vmcnt(0)" ::: "memory");
        }
    }
    __syncthreads();
}

constexpr int NPHASE = 22;
__device__ __forceinline__ void run_phase1(const Prm& p, int ph, unsigned char* lds, int bid, int nb) {
  if (ph == 0) { ph_mod(p, 0, lds, bid, nb); ph_wconv_dense(p, 0, lds, bid, nb); return; }
  if (ph == 21) { ph_final(p, bid, nb); return; }
  const int alt = ph >= 100 ? 10 : 0; if (alt) ph -= 100;
  const int l = (ph - 1) / 10, s = (ph - 1) % 10 + alt;
  switch (s) {
    case 0: ph_norm_a(p, l, bid, nb); break;
#if FAST_GEMM
#if !defined(DBG_ONLY) || DBG_ONLY == 1
    case 1: ph2_gemm_in(p, l, lds, bid, nb); break;
#endif
#if !defined(DBG_ONLY) || DBG_ONLY == 2
    case 2: ph2_gemm_qup(p, l, lds, bid, nb); ph2_gemm_kvup(p, l, lds, bid, nb); break;
#endif
#if !defined(DBG_ONLY) || DBG_ONLY == 3
    case 3: break;
#endif
#else
    case 1: ph_gemm_in(p, l, bid, nb); break;
    case 2: ph_ssq(p, bid, nb); break;
    case 3: ph_gemm_up(p, l, bid, nb); break;
#endif
#if FAST_ATTN
    case 4: ph_attn_fast(p, l, lds, bid, nb); break;
#else
    case 4: ph_attn_naive(p, l, lds, bid, nb); break;
#endif
#if FAST_GEMM
#if !defined(DBG_ONLY) || DBG_ONLY == 5
    case 5: ph2_gemm_out(p, l, lds, bid, nb); break;
#endif
#else
    case 5: ph_gemm_out(p, l, bid, nb); break;
#endif
    case 6: ph_norm_b<true>(p, l, lds, bid, nb); break;
#ifdef DBG_NB
    case 16: ph_norm_b<false>(p, l, lds, bid, nb); break;
#endif
#ifdef DBG_ATTN_PROBE
    case 14: ph_attn_probe<DBG_ATTN_PROBE>(p, l, lds, bid, nb); break;
#endif
    case 7: ph_topk(p, l, lds, bid, nb); break;
#if FAST_GEMM
#if !defined(DBG_ONLY) || DBG_ONLY == 8
    case 8: ph2_moe_up(p, l, lds, bid, nb); break;
#endif
#if !defined(DBG_ONLY) || DBG_ONLY == 9
    case 9: ph2_moe_down(p, l, lds, bid, nb); break;
#endif
#else
    case 8: ph_moe_up(p, l, bid, nb); break;
    case 9: ph_moe_down(p, l, bid, nb); break;
#endif
  }
}

#ifndef DBG_TWICE
#define DBG_TWICE 0
#endif
#ifndef DBG_ALT
#define DBG_ALT 0
#endif
#ifndef DBG_PRE
#define DBG_PRE 0
#endif
__device__ __forceinline__ void run_phase(const Prm& p, int ph, unsigned char* lds, int bid, int nb) {
  if (DBG_PRE) { if (ph >= 1 && ph <= 20 && (ph - 1) % 10 == 0) { run_phase1(p, ph + DBG_PRE, lds, bid, nb); __syncthreads(); } }
  run_phase1(p, ph, lds, bid, nb);
  if (DBG_TWICE) { const int s = ph == 0 ? 10 : (ph == 21 ? 11 : (ph - 1) % 10); if ((DBG_TWICE >> s) & 1) { __syncthreads(); run_phase1(p, ph + DBG_ALT, lds, bid, nb); } }
}
constexpr int LDS_BYTES = FAST_GEMM ? 131072 + 16384 + 128 + 128 : 65536;
#if MK_SPLIT
__global__ void __launch_bounds__(NTHR, 2) k_phase(Prm p, int ph) {
  extern __shared__ __attribute__((aligned(16))) unsigned char lds[];
  run_phase(p, ph, lds, blockIdx.x, gridDim.x);
}
#endif
#if !MK_SPLIT
__global__ void __launch_bounds__(NTHR, 2) k_mega(Prm p) {
  extern __shared__ __attribute__((aligned(16))) unsigned char lds[];
  cg::grid_group grid = cg::this_grid();
  if (p.out == nullptr) grid.sync();
  volatile LAS unsigned* st = (volatile LAS unsigned*)((LAS unsigned char*)lds + 131072 + 16384 + 64);
  if (TIDX < 2) st[TIDX] = 0u;
  if (TIDX < 24) { const int i = TIDX; ((LAS float*)((LAS unsigned char*)lds + ROPE_TAB_OFF))[i] = (i < 16 ? exp2f(-(float)i * (13.287712379549449f / 16.f)) : exp2f(-(float)(i - 16) * (13.287712379549449f / 8.f))) * 0.15915494309189535f; }
  __syncthreads();
  XcdBarrier xb = xcd_barrier_post((unsigned*)(p.ws + OFF_CTL) + 1024, st);
#pragma unroll 1
  for (int ph = 0; ph < NPHASE; ++ph) { int phv = ph; asm volatile("" : "+s"(phv));
    run_phase(p, phv, lds, blockIdx.x, gridDim.x);
    if (ph + 1 < NPHASE && (ph % 10) != 4) xcd_barrier(xb); }
}
#define K_MAIN k_mega
#else
#define K_MAIN k_phase
#endif

extern "C" void kernel_launch(void* const* d_in, const int* in_sizes, int n_in, void* d_out, int out_size, void* d_ws, size_t ws_size, hipStream_t stream) {
  static int grid = 0;
  if (grid == 0) {
    if (n_in != 20 || ws_size < WS_END || out_size != NB * SEQ * DM) { fprintf(stderr, "kernel_launch: bad shapes n_in %d ws %zu (need %zu) out %d\n", n_in, ws_size, (size_t)WS_END, out_size); grid = -1; return; }
    int dev = 0, cus = 0, per = 0;
    (void)hipGetDevice(&dev); (void)hipDeviceGetAttribute(&cus, hipDeviceAttributeMultiprocessorCount, dev);
    (void)hipFuncSetAttribute((const void*)K_MAIN, hipFuncAttributeMaxDynamicSharedMemorySize, LDS_BYTES);
    (void)hipOccupancyMaxActiveBlocksPerMultiprocessor(&per, (const void*)K_MAIN, NTHR, LDS_BYTES);
    if (per < 1) per = 1;
    if (per > 1) per = 1;
    grid = cus * per;
    (void)hipGetLastError();
  }
  if (grid < 0) return;
  Prm p{};
  const float** pf = (const float**)&p;
  for (int i = 0; i < 20; ++i) pf[i] = (const float*)d_in[i];
  p.out = (float*)d_out; p.ws = (unsigned char*)d_ws;
#if MK_SPLIT
  for (int ph = 0; ph < NPHASE; ++ph) hipLaunchKernelGGL(k_phase, dim3(1024), dim3(NTHR), LDS_BYTES, stream, p, ph);
#else
  (void)hipMemsetAsync((char*)d_ws + OFF_CTL, 0, 65536, stream);
  void* args[] = {&p};
  hipError_t e = hipLaunchCooperativeKernel((const void*)k_mega, dim3(grid), dim3(NTHR), args, LDS_BYTES, stream);
  if (e != hipSuccess) fprintf(stderr, "cooperative launch failed: %s (grid %d)\n", hipGetErrorString(e), grid);
#endif
}
```

```cpp
#include <hip/hip_runtime.h>
#include <hip/hip_cooperative_groups.h>
#include <cstdint>
#include <cstdio>
namespace cg = cooperative_groups;

#ifndef MK_SPLIT
#define MK_SPLIT 0
#endif
#ifndef FAST_GEMM
#define FAST_GEMM 1
#endif
#ifndef FAST_ATTN
#define FAST_ATTN 1
#endif

typedef unsigned short bf16_t;
typedef short bf16x8 __attribute__((ext_vector_type(8)));
typedef float f32x4 __attribute__((ext_vector_type(4)));
typedef float f32x16 __attribute__((ext_vector_type(16)));
typedef unsigned u32x4 __attribute__((ext_vector_type(4)));
typedef unsigned u32x2 __attribute__((ext_vector_type(2)));

constexpr int NTHR = 512, NWAVE = 8;
constexpr int NB = 4, SEQ = 8192, LC = 256, TT = SEQ + LC, MR = NB * TT, DM = 1024, DEPTH = 2;
constexpr int NIN = 1440, NINP = 1536, QRK = 384, KVRK = 256, NQB = 768, NKVB = 1024;
constexpr int NE = 16, DFF = 512, CAPL = 1024, CAPC = 32;
constexpr int NSLOT = NB * NE * CAPL + NE * 256;
constexpr float EPS = 1e-6f;
constexpr float LOG2E = 1.4426950408889634f;
constexpr float SCALE_A = 0.125f * LOG2E;
constexpr float SCALE_B = 0.10206207261596575f * LOG2E;

constexpr size_t al256(size_t v) { return (v + 255) / 256 * 256; }
constexpr size_t OFF_CTL = 0;
constexpr size_t OFF_MOD = 1u << 20;
constexpr size_t OFF_ROPE = OFF_MOD + al256((size_t)2 * 5 * 6144 * 4);
constexpr size_t OFF_SSQQ = OFF_ROPE + al256((size_t)(2 * 2048 + 2 * 1024) * 4);
constexpr size_t OFF_SSQK = OFF_SSQQ + al256((size_t)MR * 4);
constexpr size_t OFF_AFF = OFF_SSQK + al256((size_t)MR * 4);
constexpr size_t OFF_INV = OFF_AFF + al256((size_t)MR * 16 * 4);
constexpr size_t OFF_IDX = OFF_INV + al256((size_t)MR * 16 * 4);
constexpr size_t OFF_VAL = OFF_IDX + al256((size_t)NSLOT * 4);
constexpr size_t OFF_KR = OFF_VAL + al256((size_t)NSLOT * 4);
constexpr size_t SZ_WIN = (size_t)NINP * DM * 2, SZ_WQ = (size_t)NQB * QRK * 2, SZ_WKV = (size_t)NKVB * KVRK * 2, SZ_WO = (size_t)DM * DM * 2;
constexpr size_t SZ_WL = SZ_WIN + SZ_WQ + SZ_WKV + SZ_WO;
constexpr size_t OFF_W = OFF_KR + al256((size_t)MR * 32 * 2);
constexpr size_t OFF_WGU = OFF_W + 2 * SZ_WL;
constexpr size_t OFF_WD = OFF_WGU + (size_t)NE * 1024 * 1024 * 2;
constexpr size_t OFF_X = OFF_WD + (size_t)NE * 1024 * 512 * 2;
constexpr size_t OFF_R = OFF_X + (size_t)MR * DM * 4;
constexpr size_t R_H = 0;
constexpr size_t R_QA = R_H + (size_t)MR * DM * 2;
constexpr size_t R_KA = R_QA + (size_t)MR * 512 * 2;
constexpr size_t R_VA = R_KA + (size_t)MR * 128 * 2;
constexpr size_t R_QB = R_VA + (size_t)MR * 128 * 2;
constexpr size_t R_KB = R_QB + (size_t)MR * 768 * 2;
constexpr size_t R_VB = R_KB + (size_t)MR * 512 * 2;
constexpr size_t R_CQ = R_VB + (size_t)MR * 512 * 2;
constexpr size_t R_CKV = R_CQ + (size_t)MR * QRK * 2;
constexpr size_t R_END = R_CKV + (size_t)MR * KVRK * 2;
constexpr size_t R_MIXG = R_QA;
constexpr size_t R_ACT = R_QA;
constexpr size_t R_Y = R_ACT + (size_t)NSLOT * DFF * 2;
static_assert(R_Y + (size_t)NSLOT * DM * 2 <= R_END, "moe overlay fits");
constexpr size_t WS_END = OFF_R + R_END;

struct Prm {
  const float *x, *c, *ctx, *c_ctx, *w_mod, *b_mod, *norm_attn, *norm_ffn, *w_in, *sink, *q_norm, *kv_norm, *w_q_up, *w_kv_up, *w_out, *w_router, *w_gate, *w_up,
      *w_down, *norm_final;
  float* out;
  unsigned char* ws;
};

__device__ __forceinline__ float bf2f(bf16_t v) { return __uint_as_float((unsigned)v << 16); }
__device__ __forceinline__ bf16_t f2bf(float f) { unsigned u = __float_as_uint(f); return (bf16_t)((u + 0x7fffu + ((u >> 16) & 1u)) >> 16); }
__device__ __forceinline__ unsigned pk2(float lo, float hi) { return (unsigned)f2bf(lo) | ((unsigned)f2bf(hi) << 16); }
template <int CTRL> __device__ __forceinline__ float dpp_mov(float x) { return __int_as_float(__builtin_amdgcn_update_dpp(0, __float_as_int(x), CTRL, 0xF, 0xF, true)); }
__device__ __forceinline__ float xor1(float x) { return dpp_mov<0xB1>(x); }
__device__ __forceinline__ float xor2(float x) { return dpp_mov<0x4E>(x); }
__device__ __forceinline__ float hmir(float x) { return dpp_mov<0x141>(x); }
__device__ __forceinline__ float xor8(float x) { return dpp_mov<0x128>(x); }
__device__ __forceinline__ float sum16sw(float x) { auto r = __builtin_amdgcn_permlane16_swap(__float_as_uint(x), __float_as_uint(x), false, false); return __uint_as_float(r[0]) + __uint_as_float(r[1]); }
__device__ __forceinline__ float sum32sw(float x) { auto r = __builtin_amdgcn_permlane32_swap(__float_as_uint(x), __float_as_uint(x), false, false); return __uint_as_float(r[0]) + __uint_as_float(r[1]); }
__device__ __forceinline__ float max16sw(float x) { auto r = __builtin_amdgcn_permlane16_swap(__float_as_uint(x), __float_as_uint(x), false, false); return fmaxf(__uint_as_float(r[0]), __uint_as_float(r[1])); }
__device__ __forceinline__ float max32sw(float x) { auto r = __builtin_amdgcn_permlane32_swap(__float_as_uint(x), __float_as_uint(x), false, false); return fmaxf(__uint_as_float(r[0]), __uint_as_float(r[1])); }
__device__ __forceinline__ float wave_sum(float v) {
  v += xor1(v); v += xor2(v); v += hmir(v); v += xor8(v); v = sum16sw(v); v = sum32sw(v);
  return v;
}
__device__ __forceinline__ float silu_f(float v) { return v / (1.f + __expf(-v)); }
__device__ __forceinline__ float silu_fast(float v) { return v * __builtin_amdgcn_rcpf(1.f + __builtin_amdgcn_exp2f(-1.4426950408889634f * v)); }
__device__ __forceinline__ unsigned cvtpk_e(float lo, float hi) { unsigned r; asm volatile("v_cvt_pk_bf16_f32 %0, %1, %2" : "=v"(r) : "v"(lo), "v"(hi)); return r; }
__device__ __forceinline__ int row_mi(int r) { const int b = r / TT, t = r - b * TT; return t < LC ? 4 : b; }

__device__ __forceinline__ int opaque_tid() { int t = __builtin_amdgcn_workitem_id_x(); asm volatile("" : "+v"(t)); return t; }
#define TIDX opaque_tid()
#define WSP(T, off) ((T*)(p.ws + (off)))

__device__ __forceinline__ void ph_mod(const Prm& p, int l, unsigned char* lds, int bid, int nb) {
  float* sc = (float*)lds;
  float* red = sc + 5 * 1024;
  const int tid = TIDX;
  for (int i = tid; i < 5 * 1024; i += NTHR) { const int mi = i >> 10, d = i & 1023; const float v = mi < 4 ? p.c[mi * 1024 + d] : p.c_ctx[d]; sc[i] = silu_f(v); }
  __syncthreads();
  float* MOD = WSP(float, OFF_MOD);
  const int cl = tid & 31, kg = tid >> 5;
  for (int it = bid; it < 192; it += nb) {
    const int e0 = it * 32;
    const float* w = p.w_mod + (size_t)l * 1024 * 6144 + e0 + cl;
    float a0 = 0, a1 = 0, a2 = 0, a3 = 0, a4 = 0;
#pragma unroll
    for (int k0 = 0; k0 < 64; k0 += 16) { float wv[16];
#pragma unroll
      for (int j = 0; j < 16; ++j) wv[j] = w[(size_t)(kg * 64 + k0 + j) * 6144];
#pragma unroll
      for (int j = 0; j < 16; ++j) { const int d = kg * 64 + k0 + j;
        a0 += sc[d] * wv[j]; a1 += sc[1024 + d] * wv[j]; a2 += sc[2048 + d] * wv[j]; a3 += sc[3072 + d] * wv[j]; a4 += sc[4096 + d] * wv[j]; } }
    float* rr = red + (kg * 32 + cl) * 5; rr[0] = a0; rr[1] = a1; rr[2] = a2; rr[3] = a3; rr[4] = a4;
    __syncthreads();
    if (tid < 160) { const int c2 = tid & 31, mi = tid >> 5; float s = 0; for (int g = 0; g < 16; ++g) s += red[(g * 32 + c2) * 5 + mi];
      MOD[(size_t)(l * 5 + mi) * 6144 + e0 + c2] = s + p.b_mod[l * 6144 + e0 + c2]; }
    __syncthreads();
  }
}

template <class Src>
__device__ __forceinline__ void tr_tile(const Src& src, bf16_t* dst, int K, int k0, int n0, float* tl  ) {
  const int tid = TIDX;
#pragma unroll
  for (int i = 0; i < 8; ++i) { const int e = tid + i * NTHR, kk = e >> 6, nn = e & 63; tl[kk * 65 + nn] = src(k0 + kk, n0 + nn); }
  __syncthreads();
#pragma unroll
  for (int i = 0; i < 2; ++i) { const int e = tid + i * NTHR, nn = e >> 4, kc = (e & 15) * 4;
    u32x2 o; o.x = pk2(tl[(kc + 0) * 65 + nn], tl[(kc + 1) * 65 + nn]); o.y = pk2(tl[(kc + 2) * 65 + nn], tl[(kc + 3) * 65 + nn]);
    *(u32x2*)(dst + (size_t)(n0 + nn) * K + k0 + kc) = o; }
  __syncthreads();
}
struct SrcIn { const float* w; __device__ float operator()(int k, int n) const { return n < NIN ? w[(size_t)k * NIN + n] : 0.f; } };
struct SrcScaled { const float* w; const float* nv; int N; __device__ float operator()(int k, int n) const { return w[(size_t)k * N + n] * nv[k]; } };
struct SrcPlain { const float* w; int N; __device__ float operator()(int k, int n) const { return w[(size_t)k * N + n]; } };
#if FAST_GEMM
struct SrcGU { const float* g; const float* u; __device__ float operator()(int k, int n) const { const int t = n >> 8, w = n & 255; return w < 128 ? g[(size_t)k * DFF + t * 128 + w] : u[(size_t)k * DFF + t * 128 + w - 128]; } };
#else
struct SrcGU { const float* g; const float* u; __device__ float operator()(int k, int n) const { const int t = n >> 6, w = n & 63; return w < 32 ? g[(size_t)k * DFF + t * 32 + w] : u[(size_t)k * DFF + t * 32 + w - 32]; } };
#endif

constexpr int WCB = 4;
struct WcItem { const float* sp; int ss; bf16_t* dp; int dK; const float* nv; int ncol; };
template <class F>
__device__ __forceinline__ void wconv_run(const F& item, int NIT, unsigned char* lds, int rank, int nranks) {
  float* tl = (float*)lds;
  const int tid = TIDX;
  for (int base = rank; base < NIT; base += nranks * WCB) {
    f32x4 rg[WCB][2]; float sc[WCB][2];
#pragma unroll
    for (int d = 0; d < WCB; ++d) { const int it = base + d * nranks;
      if (it < NIT) { const WcItem w = item(it);
#pragma unroll
        for (int i = 0; i < 2; ++i) { const int e = tid + i * NTHR, kk = e >> 4, n4 = (e & 15) * 4;
          rg[d][i] = n4 < w.ncol ? __builtin_nontemporal_load((const f32x4*)(w.sp + (size_t)kk * w.ss + n4)) : (f32x4){0.f, 0.f, 0.f, 0.f};
          sc[d][i] = w.nv ? w.nv[kk] : 1.f; } } }
#pragma unroll
    for (int d = 0; d < WCB; ++d) { const int it = base + d * nranks;
      if (it < NIT) { const WcItem w = item(it); float* t = tl + (d & 1) * (64 * 65);
#pragma unroll
        for (int i = 0; i < 2; ++i) { const int e = tid + i * NTHR, kk = e >> 4, n4 = (e & 15) * 4;
#pragma unroll
          for (int j = 0; j < 4; ++j) t[kk * 65 + n4 + j] = rg[d][i][j] * sc[d][i]; }
        __syncthreads();
#pragma unroll
        for (int i = 0; i < 2; ++i) { const int e = tid + i * NTHR, nn = e >> 4, kc = (e & 15) * 4;
          u32x2 o; o.x = pk2(t[(kc + 0) * 65 + nn], t[(kc + 1) * 65 + nn]); o.y = pk2(t[(kc + 2) * 65 + nn], t[(kc + 3) * 65 + nn]);
          *(u32x2*)(w.dp + (size_t)nn * w.dK + kc) = o; } } }
  }
  __syncthreads();
}
__device__ __forceinline__ void ph_wconv_dense(const Prm& p, int l, unsigned char* lds, int bid, int nb) {
  constexpr int T_IN = (DM / 64) * (NINP / 64), T_Q = (QRK / 64) * (NQB / 64), T_KV = (KVRK / 64) * (NKVB / 64), T_O = (DM / 64) * (DM / 64), T_L = T_IN + T_Q + T_KV + T_O;
  wconv_run([&p, l](int it) __attribute__((always_inline)) -> WcItem { int r = it; WcItem w;
    bf16_t* wb = (bf16_t*)(p.ws + OFF_W + (size_t)l * SZ_WL);
    if (r < T_IN) { const int kt = r / (NINP / 64), nt = r % (NINP / 64), n0 = nt * 64;
      w.sp = p.w_in + (size_t)l * DM * NIN + (size_t)(kt * 64) * NIN + n0; w.ss = NIN; w.dp = wb + (size_t)n0 * DM + kt * 64; w.dK = DM; w.nv = nullptr; w.ncol = NIN - n0; return w; } r -= T_IN;
    if (r < T_Q) { const int kt = r / (NQB / 64), nt = r % (NQB / 64);
      w.sp = p.w_q_up + (size_t)l * QRK * NQB + (size_t)(kt * 64) * NQB + nt * 64; w.ss = NQB; w.dp = (bf16_t*)((unsigned char*)wb + SZ_WIN) + (size_t)(nt * 64) * QRK + kt * 64; w.dK = QRK;
      w.nv = p.q_norm + l * QRK + kt * 64; w.ncol = 64; return w; } r -= T_Q;
    if (r < T_KV) { const int kt = r / (NKVB / 64), nt = r % (NKVB / 64);
      w.sp = p.w_kv_up + (size_t)l * KVRK * NKVB + (size_t)(kt * 64) * NKVB + nt * 64; w.ss = NKVB; w.dp = (bf16_t*)((unsigned char*)wb + SZ_WIN + SZ_WQ) + (size_t)(nt * 64) * KVRK + kt * 64; w.dK = KVRK;
      w.nv = p.kv_norm + l * KVRK + kt * 64; w.ncol = 64; return w; } r -= T_KV;
    { const int kt = r / (DM / 64), nt = r % (DM / 64);
      w.sp = p.w_out + (size_t)l * DM * DM + (size_t)(kt * 64) * DM + nt * 64; w.ss = DM; w.dp = (bf16_t*)((unsigned char*)wb + SZ_WIN + SZ_WQ + SZ_WKV) + (size_t)(nt * 64) * DM + kt * 64; w.dK = DM;
      w.nv = nullptr; w.ncol = 64; return w; } }, T_L, lds, bid, nb);
}
__device__ __forceinline__ void ph_wconv_moe(const Prm& p, int l, unsigned char* lds, int rank, int nranks) {
  constexpr int T_GU = (DM / 64) * (1024 / 64), T_D = (DFF / 64) * (DM / 64), T_E = T_GU + T_D;
  wconv_run([&p, l](int it) __attribute__((always_inline)) -> WcItem { const int e = it / T_E; int r = it % T_E; WcItem w; w.nv = nullptr; w.ncol = 64;
    if (r < T_GU) { const int kt = r >> 4, nt = r & 15, n0 = nt * 64, t = n0 >> 8, wq = n0 & 255;
      const float* src = (wq < 128 ? p.w_gate : p.w_up) + ((size_t)l * NE + e) * DM * DFF;
      w.sp = src + (size_t)(kt * 64) * DFF + t * 128 + (wq & 127); w.ss = DFF; w.dp = WSP(bf16_t, OFF_WGU) + (size_t)e * 1024 * 1024 + (size_t)n0 * DM + kt * 64; w.dK = DM; }
    else { r -= T_GU; const int kt = r >> 4, nt = r & 15;
      w.sp = p.w_down + ((size_t)l * NE + e) * DFF * DM + (size_t)(kt * 64) * DM + nt * 64; w.ss = DM; w.dp = WSP(bf16_t, OFF_WD) + (size_t)e * 1024 * 512 + (size_t)(nt * 64) * DFF + kt * 64; w.dK = DFF; }
    return w; }, NE * T_E, lds, rank, nranks);
}

typedef int i32x4 __attribute__((ext_vector_type(4)));
__device__ __forceinline__ void y_acc(f32x4 (&s)[4], const u32x2 (&y)[4]) {
#pragma unroll
  for (int j = 0; j < 4; ++j) { s[j][0] += __uint_as_float(y[j].x << 16); s[j][1] += __uint_as_float(y[j].x & 0xffff0000u); s[j][2] += __uint_as_float(y[j].y << 16); s[j][3] += __uint_as_float(y[j].y & 0xffff0000u); }
}
struct RowLd { f32x4 x[4]; i32x4 q[4]; };
__device__ __forceinline__ void row_issue(const Prm& p, int l, int r, int lane, RowLd& R) {
  const int b = r / TT, t = r - b * TT;
  if (l == 0) { const float* src = t < LC ? p.ctx + ((size_t)b * LC + t) * DM : p.x + ((size_t)b * SEQ + (t - LC)) * DM;
#pragma unroll
    for (int j = 0; j < 4; ++j) R.x[j] = *(const f32x4*)(src + 4 * lane + 256 * j);
  } else { int zv = 0; asm volatile("" : "+v"(zv));
    const float* X = WSP(float, OFF_X) + (size_t)r * DM; const i32x4* inv = (const i32x4*)(WSP(int, OFF_INV) + (size_t)r * 16 + zv);
#pragma unroll
    for (int j = 0; j < 4; ++j) { R.x[j] = *(const f32x4*)(X + 4 * lane + 256 * j); R.q[j] = inv[j]; } }
}
__device__ __forceinline__ void row_finish(const Prm& p, int l, int r, int lane, RowLd& R, f32x4 (&v)[4]) {
  if (l == 0) {
#pragma unroll
    for (int j = 0; j < 4; ++j) v[j] = R.x[j];
    return; }
  const int b = r / TT, t = r - b * TT;
  const bf16_t* Y = (const bf16_t*)(p.ws + OFF_R + R_Y) + 4 * lane;
  int c0 = 0, c1 = 0, c2 = 0, c3 = 0, cnt = 0;
#pragma unroll
  for (int e = 0; e < 16; ++e) { const int sv = __builtin_amdgcn_readfirstlane(R.q[e >> 2][e & 3]);
    if (sv >= 0) { c0 = cnt == 0 ? sv : c0; c1 = cnt == 1 ? sv : c1; c2 = cnt == 2 ? sv : c2; c3 = cnt == 3 ? sv : c3; ++cnt; } }
  u32x2 y0[4], y1[4], y2[4], y3[4];
#pragma unroll
  for (int j = 0; j < 4; ++j) { y0[j] = (u32x2){0u, 0u}; y1[j] = y0[j]; y2[j] = y0[j]; y3[j] = y0[j]; }
  if (cnt > 0) {
#pragma unroll
    for (int j = 0; j < 4; ++j) y0[j] = *(const u32x2*)(Y + (size_t)c0 * DM + 256 * j); }
  if (cnt > 1) {
#pragma unroll
    for (int j = 0; j < 4; ++j) y1[j] = *(const u32x2*)(Y + (size_t)c1 * DM + 256 * j); }
  if (cnt > 2) {
#pragma unroll
    for (int j = 0; j < 4; ++j) y2[j] = *(const u32x2*)(Y + (size_t)c2 * DM + 256 * j); }
  if (cnt > 3) {
#pragma unroll
    for (int j = 0; j < 4; ++j) y3[j] = *(const u32x2*)(Y + (size_t)c3 * DM + 256 * j); }
  f32x4 s[4];
#pragma unroll
  for (int j = 0; j < 4; ++j) s[j] = (f32x4){0.f, 0.f, 0.f, 0.f};
  y_acc(s, y0); y_acc(s, y1); y_acc(s, y2); y_acc(s, y3);
  if (cnt > 4) { int k = 0;
#pragma unroll
    for (int e = 0; e < 16; ++e) { const int sv = __builtin_amdgcn_readfirstlane(R.q[e >> 2][e & 3]);
      if (sv >= 0) { if (k >= 4) { u32x2 yy[4];
#pragma unroll
          for (int j = 0; j < 4; ++j) yy[j] = *(const u32x2*)(Y + (size_t)sv * DM + 256 * j);
          y_acc(s, yy); }
        ++k; } } }
  const float* gf = WSP(float, OFF_MOD) + (size_t)((l - 1) * 5 + (t < LC ? 4 : b)) * 6144 + 5 * 1024;
#pragma unroll
  for (int j = 0; j < 4; ++j) { const f32x4 g = *(const f32x4*)(gf + 4 * lane + 256 * j); v[j] = R.x[j] + g * s[j]; }
}
__device__ __forceinline__ float row_ssq(const f32x4 (&v)[4]) { float ss = 0.f;
#pragma unroll
  for (int j = 0; j < 4; ++j) ss += v[j][0] * v[j][0] + v[j][1] * v[j][1] + v[j][2] * v[j][2] + v[j][3] * v[j][3];
  return wave_sum(ss); }
__device__ __forceinline__ void norm_a_store(const Prm& p, int l, int r, int lane, const f32x4 (&v)[4]) {
  const float rs = rsqrtf(row_ssq(v) * (1.f / DM) + EPS);
  const float* md = WSP(float, OFF_MOD) + (size_t)(l * 5 + row_mi(r)) * 6144;
  float* X = WSP(float, OFF_X) + (size_t)r * DM; bf16_t* H = (bf16_t*)(p.ws + OFF_R + R_H) + (size_t)r * DM;
  if (lane == 0) { WSP(float, OFF_SSQQ)[r] = 0.f; WSP(float, OFF_SSQK)[r] = 0.f; }
#pragma unroll
  for (int j = 0; j < 4; ++j) { const int c = 4 * lane + 256 * j;
    *(f32x4*)(X + c) = v[j];
    const f32x4 nw = *(const f32x4*)(p.norm_attn + l * DM + c), sh = *(const f32x4*)(md + c), scl = *(const f32x4*)(md + 1024 + c);
    const f32x4 h = v[j] * rs * nw * (scl + 1.f) + sh;
    u32x2 o; o.x = pk2(h[0], h[1]); o.y = pk2(h[2], h[3]); *(u32x2*)(H + c) = o; }
}
constexpr int RPI = 4, RPA = 2;
#define ROWPIPE(R0, R1, ROWOF, LAYER, STORE) do { \
    RowLd A0, A1, B0, B1; f32x4 va[4], vb[4]; \
    int r = (R0); \
    if (r < (R1)) row_issue(p, LAYER, ROWOF(r), lane, A0); if (r + 1 < (R1)) row_issue(p, LAYER, ROWOF(r + 1), lane, A1); \
    for (; r < (R1); r += 4) { \
      if (r + 2 < (R1)) row_issue(p, LAYER, ROWOF(r + 2), lane, B0); if (r + 3 < (R1)) row_issue(p, LAYER, ROWOF(r + 3), lane, B1); \
      row_finish(p, LAYER, ROWOF(r), lane, A0, va); if (r + 1 < (R1)) row_finish(p, LAYER, ROWOF(r + 1), lane, A1, vb); \
      STORE(r, va); if (r + 1 < (R1)) STORE(r + 1, vb); \
      if (r + 2 >= (R1)) break; \
      if (r + 4 < (R1)) row_issue(p, LAYER, ROWOF(r + 4), lane, A0); if (r + 5 < (R1)) row_issue(p, LAYER, ROWOF(r + 5), lane, A1); \
      row_finish(p, LAYER, ROWOF(r + 2), lane, B0, va); if (r + 3 < (R1)) row_finish(p, LAYER, ROWOF(r + 3), lane, B1, vb); \
      STORE(r + 2, va); if (r + 3 < (R1)) STORE(r + 3, vb); \
    } } while (0)
__device__ __forceinline__ void ph_norm_a(const Prm& p, int l, int bid, int nb) {
  const int lane = TIDX & 63, wv = __builtin_amdgcn_readfirstlane(TIDX >> 6);
  const int nw = nb * NWAVE, rpw = (MR + nw - 1) / nw, gw = bid * NWAVE + wv;
  const int r0 = gw * rpw, r1 = min(MR, r0 + rpw);
#define ROWID(x) (x)
#define NA_STORE(x, v) norm_a_store(p, l, (x), lane, v)
  ROWPIPE(r0, r1, ROWID, l, NA_STORE);
#undef ROWID
#undef NA_STORE
}
__device__ __forceinline__ void final_store(const Prm& p, int q, int lane, const f32x4 (&v)[4]) {
  const float rs = rsqrtf(row_ssq(v) * (1.f / DM) + EPS); float* o = p.out + (size_t)q * DM;
#pragma unroll
  for (int j = 0; j < 4; ++j) { const int c = 4 * lane + 256 * j; *(f32x4*)(o + c) = v[j] * rs * *(const f32x4*)(p.norm_final + c); }
}
__device__ __forceinline__ void ph_final(const Prm& p, int bid, int nb) {
  const int lane = TIDX & 63, wv = __builtin_amdgcn_readfirstlane(TIDX >> 6);
  const int nw = nb * NWAVE, NQ = NB * SEQ, rpw = (NQ + nw - 1) / nw, gw = bid * NWAVE + wv;
  const int q0 = gw * rpw, q1 = min(NQ, q0 + rpw);
#define ROWQ(x) (((x) / SEQ) * TT + LC + ((x) % SEQ))
#define FIN_STORE(x, v) final_store(p, (x), lane, v)
  ROWPIPE(q0, q1, ROWQ, DEPTH, FIN_STORE);
#undef ROWQ
#undef FIN_STORE
}
template <bool ROUTER>
__device__ __forceinline__ void norm_b_row(const Prm& p, int l, int r, int lane, const f32x4 (&v)[4], const float* wl) {
  const int b = r / TT, t = r - b * TT;
  const float rs = rsqrtf(row_ssq(v) * (1.f / DM) + EPS);
  const float* md = WSP(float, OFF_MOD) + (size_t)(l * 5 + (t < LC ? 4 : b)) * 6144;
  bf16_t* H = (bf16_t*)(p.ws + OFF_R + R_H) + (size_t)r * DM;
  float lg[NE];
#pragma unroll
  for (int e = 0; e < NE; ++e) lg[e] = 0.f;
#pragma unroll
  for (int j = 0; j < 4; ++j) { const int c = 4 * lane + 256 * j;
    const f32x4 nw = *(const f32x4*)(p.norm_ffn + l * DM + c), sh = *(const f32x4*)(md + 3 * 1024 + c), scl = *(const f32x4*)(md + 4 * 1024 + c);
    const f32x4 h = v[j] * rs * nw * (scl + 1.f) + sh;
    u32x2 o; o.x = pk2(h[0], h[1]); o.y = pk2(h[2], h[3]); *(u32x2*)(H + c) = o;
    if (ROUTER)
#pragma unroll
    for (int ip = 0; ip < 2; ++ip) {
      f32x4 w8[2][4];
#pragma unroll
      for (int i2 = 0; i2 < 2; ++i2)
#pragma unroll
        for (int e4 = 0; e4 < 4; ++e4) w8[i2][e4] = *(const f32x4*)(wl + ((((j * 4 + ip * 2 + i2) * 4 + e4) * 64 + lane) << 2));
      __builtin_amdgcn_sched_barrier(0);
#pragma unroll
      for (int i2 = 0; i2 < 2; ++i2)
#pragma unroll
        for (int e4 = 0; e4 < 4; ++e4) { const float hv = h[ip * 2 + i2]; const f32x4 w4 = w8[i2][e4];
          lg[4 * e4] += hv * w4[0]; lg[4 * e4 + 1] += hv * w4[1]; lg[4 * e4 + 2] += hv * w4[2]; lg[4 * e4 + 3] += hv * w4[3]; }
      __builtin_amdgcn_sched_barrier(0);
    } }
  if (!ROUTER) return;
#pragma unroll
  for (int e = 0; e < NE; ++e) { lg[e] += xor1(lg[e]); lg[e] += xor2(lg[e]); }
  float t8[8], t4[4], t2[2], t1;
#pragma unroll
  for (int i = 0; i < 8; ++i) { auto rr = __builtin_amdgcn_permlane32_swap(__float_as_uint(lg[i]), __float_as_uint(lg[i + 8]), false, false); t8[i] = __uint_as_float(rr[0]) + __uint_as_float(rr[1]); }
#pragma unroll
  for (int i = 0; i < 4; ++i) { auto rr = __builtin_amdgcn_permlane16_swap(__float_as_uint(t8[i]), __float_as_uint(t8[i + 4]), false, false); t4[i] = __uint_as_float(rr[0]) + __uint_as_float(rr[1]); }
  { const bool hb = lane & 8;
#pragma unroll
    for (int i = 0; i < 2; ++i) { const float snd = hb ? t4[i] : t4[i + 2], kp = hb ? t4[i + 2] : t4[i]; t2[i] = kp + xor8(snd); } }
  { const bool hb = lane & 4; const float snd = hb ? t2[0] : t2[1], kp = hb ? t2[1] : t2[0]; t1 = kp + hmir(snd); }
  float mx = t1;
  mx = fmaxf(mx, hmir(mx)); mx = fmaxf(mx, xor8(mx)); mx = max16sw(mx); mx = max32sw(mx);
  const float ex = __expf(t1 - mx); float sm = ex;
  sm += hmir(sm); sm += xor8(sm); sm = sum16sw(sm); sm = sum32sw(sm);
  if ((lane & 3) == 0) WSP(float, OFF_AFF)[(size_t)r * NE + (lane >> 2)] = ex / sm;
}
template <bool ROUTER>
__device__ __forceinline__ void ph_norm_b(const Prm& p, int l, unsigned char* lds, int bid, int nb) {
  const int tid = TIDX, lane = tid & 63, wv = __builtin_amdgcn_readfirstlane(tid >> 6);
  float* wl = (float*)lds;
  { const float* wr = p.w_router + (size_t)l * DM * NE;
    for (int idx = tid; idx < DM * NE; idx += NTHR) { const int d = idx >> 4, e = idx & 15, j = d >> 8, ln = (d >> 2) & 63, i = d & 3;
      wl[((((j * 4 + i) * 4 + (e >> 2)) * 64 + ln) << 2) + (e & 3)] = wr[idx]; } }
  __syncthreads();
  const int nw = nb * NWAVE, rpw = (MR + nw - 1) / nw, gw = bid * NWAVE + wv;
  const int r0 = gw * rpw, r1 = min(MR, r0 + rpw);
  for (int r = r0; r < r1; r += RPI) {
    f32x4 v[RPI][4]; u32x2 mg[RPI][4]; bool sk[RPI];
#pragma unroll
    for (int i = 0; i < RPI; ++i) { sk[i] = (r + i >= r1) || ((l == DEPTH - 1) && ((r + i) % TT) < LC);
      if (!sk[i]) { const float* X = WSP(float, OFF_X) + (size_t)(r + i) * DM; const bf16_t* MG = (const bf16_t*)(p.ws + OFF_R + R_MIXG) + (size_t)(r + i) * DM;
#pragma unroll
        for (int j = 0; j < 4; ++j) { v[i][j] = *(const f32x4*)(X + 4 * lane + 256 * j); mg[i][j] = *(const u32x2*)(MG + 4 * lane + 256 * j); } } }
#pragma unroll
    for (int i = 0; i < RPI; ++i) if (!sk[i]) {
      float* X = WSP(float, OFF_X) + (size_t)(r + i) * DM;
#pragma unroll
      for (int j = 0; j < 4; ++j) { v[i][j][0] += __uint_as_float(mg[i][j].x << 16); v[i][j][1] += __uint_as_float(mg[i][j].x & 0xffff0000u); v[i][j][2] += __uint_as_float(mg[i][j].y << 16); v[i][j][3] += __uint_as_float(mg[i][j].y & 0xffff0000u);
        *(f32x4*)(X + 4 * lane + 256 * j) = v[i][j]; }
      norm_b_row<ROUTER>(p, l, r + i, lane, v[i], wl); }
  }
  __syncthreads();
}

__device__ __forceinline__ void ph_topk(const Prm& p, int l, unsigned char* lds, int bid, int nb) {
  unsigned* keys = (unsigned*)lds;
  unsigned* hist = keys + 8192;
  unsigned* scan = hist + 8 * 256;
  unsigned* misc = scan + 512;
  const int tid = TIDX;
  const float* AFF = WSP(float, OFF_AFF);
  int* IDX = WSP(int, OFF_IDX); float* VAL = WSP(float, OFF_VAL); int* INV = WSP(int, OFF_INV);
  const int ngroups = (l == DEPTH - 1) ? 64 : 128;
  for (int g = bid; g < ngroups; g += nb) {
    const bool isctx = g >= 64; const int b = (g & 63) >> 4, e = g & 15;
    const int n = isctx ? LC : SEQ, cap = isctx ? CAPC : CAPL, r0 = b * TT + (isctx ? 0 : LC);
    const int sbase = isctx ? (NB * NE * CAPL + e * 256 + b * 32) : ((b * NE + e) * CAPL);
    for (int i = tid; i < n; i += NTHR) keys[i] = __float_as_uint(AFF[(size_t)(r0 + i) * NE + e]);
    if (tid == 0) misc[2] = 0;
    __syncthreads();
    unsigned prefix = 0, kk = cap;
    for (int pass = 3; pass >= 0; --pass) {
      for (int i = tid; i < 8 * 256; i += NTHR) hist[i] = 0;
      __syncthreads();
      const int sh = pass * 8; const unsigned hm = pass == 3 ? 0u : (0xffffffffu << (sh + 8));
      unsigned* myh = hist + (tid >> 6) * 256;
      for (int i = tid; i < n; i += NTHR) { const unsigned k = keys[i]; if ((k & hm) == (prefix & hm)) atomicAdd(&myh[(k >> sh) & 255u], 1u); }
      __syncthreads();
      if (tid < 256) { unsigned t_ = 0;
#pragma unroll
        for (int w = 0; w < 8; ++w) t_ += hist[w * 256 + tid];
        hist[tid] = t_; }
      __syncthreads();
      if (tid < 256) { unsigned cum = 0; for (int bk = tid + 1; bk < 256; ++bk) cum += hist[bk];
        const unsigned mine = hist[tid]; if (cum < kk && kk <= cum + mine) { misc[0] = (unsigned)tid; misc[1] = kk - cum; } }
      __syncthreads();
      prefix |= misc[0] << sh; kk = misc[1];
      __syncthreads();
    }
    const int chunk = (n + NTHR - 1) / NTHR; const int i0 = tid * chunk, i1 = min(n, i0 + chunk);
    unsigned eq = 0; for (int i = i0; i < i1; ++i) eq += (keys[i] == prefix) ? 1u : 0u;
    scan[tid] = eq; __syncthreads();
    for (int o = 1; o < NTHR; o <<= 1) { const unsigned a = tid >= o ? scan[tid - o] : 0u; __syncthreads(); scan[tid] += a; __syncthreads(); }
    unsigned erank = scan[tid] - eq;
    const unsigned ngt = cap - kk;
    for (int i = i0; i < i1; ++i) { const unsigned k = keys[i]; int slot = -1;
      if (k > prefix) slot = (int)atomicAdd(&misc[2], 1u);
      else if (k == prefix) { if (erank < kk) slot = (int)(ngt + erank); ++erank; }
      const int row = r0 + i;
      if (slot >= 0) { IDX[sbase + slot] = row; VAL[sbase + slot] = __uint_as_float(k); INV[(size_t)row * NE + e] = sbase + slot; }
      else INV[(size_t)row * NE + e] = -1; }
    if (isctx && tid < 32) { IDX[NB * NE * CAPL + e * 256 + 128 + b * 32 + tid] = 0; VAL[NB * NE * CAPL + e * 256 + 128 + b * 32 + tid] = 0.f; }
    __syncthreads();
  }
}

template <int NF, class AP, class Epi>
__device__ __forceinline__ void sgemm_wave(const AP& ap, const bf16_t* __restrict__ Bt, int K, int m0, int n0, const Epi& epi) {
  const int lane = TIDX & 63, fr = lane & 15, fq = lane >> 4;
  f32x4 acc[4][NF];
#pragma unroll
  for (int i = 0; i < 4; ++i)
#pragma unroll
    for (int j = 0; j < NF; ++j) acc[i][j] = (f32x4){0.f, 0.f, 0.f, 0.f};
  const bf16_t* a_[4]; const bf16_t* b_[NF];
#pragma unroll
  for (int i = 0; i < 4; ++i) a_[i] = ap.row(m0 + 16 * i + fr) + fq * 8;
#pragma unroll
  for (int j = 0; j < NF; ++j) b_[j] = Bt + (size_t)(n0 + 16 * j + fr) * K + fq * 8;
#pragma unroll 2
  for (int k0 = 0; k0 < K; k0 += 32) {
    bf16x8 av[4], bv[NF];
#pragma unroll
    for (int i = 0; i < 4; ++i) av[i] = *(const bf16x8*)(a_[i] + k0);
#pragma unroll
    for (int j = 0; j < NF; ++j) bv[j] = *(const bf16x8*)(b_[j] + k0);
#pragma unroll
    for (int i = 0; i < 4; ++i)
#pragma unroll
      for (int j = 0; j < NF; ++j) acc[i][j] = __builtin_amdgcn_mfma_f32_16x16x32_bf16(av[i], bv[j], acc[i][j], 0, 0, 0);
  }
  epi(acc, m0, n0, fr, fq);
}
struct APDense { const bf16_t* A; int lda; __device__ __forceinline__ const bf16_t* row(int r) const { return A + (size_t)r * lda; } };
struct APGather { const bf16_t* A; const int* idx; __device__ __forceinline__ const bf16_t* row(int r) const { return A + (size_t)idx[r] * DM; } };

__device__ __forceinline__ void rope_pos(int row, bool& lat, int& rp, int& cp) { const int b = row / TT, t = row - b * TT; lat = t >= LC; const int pos = t - LC; rp = pos >> 6; cp = pos & 63; }

struct EpiIn {
  const Prm* pp;
  __device__ __forceinline__ void operator()(f32x4 (&acc)[4][4], int m0, int n0, int fr, int fq) const {
    const Prm& p = *pp; const float* RT = WSP(float, OFF_ROPE);
    if (n0 >= 1472) return;
#pragma unroll
    for (int mf = 0; mf < 4; ++mf)
#pragma unroll
      for (int j = 0; j < 4; ++j) {
        const int row = m0 + 16 * mf + 4 * fq + j; bool lat; int rp, cp; rope_pos(row, lat, rp, cp);
        float v[4] = {acc[mf][0][j], acc[mf][1][j], acc[mf][2][j], acc[mf][3][j]};
        if (n0 < 640) {
          if (lat) { const float c0 = RT[rp * 16 + fr], s0 = RT[2048 + rp * 16 + fr], c1 = RT[cp * 16 + fr], s1 = RT[2048 + cp * 16 + fr];
            const float a = v[0] * c0 - v[1] * s0, bq = v[0] * s0 + v[1] * c0, cq = v[2] * c1 - v[3] * s1, dq = v[2] * s1 + v[3] * c1; v[0] = a; v[1] = bq; v[2] = cq; v[3] = dq; }
          if (n0 < 512) { bf16_t* o = (bf16_t*)(p.ws + OFF_R + R_QA) + (size_t)row * 512 + n0 + fr;
#pragma unroll
            for (int nf = 0; nf < 4; ++nf) o[16 * nf] = f2bf(v[nf] * SCALE_A); }
          else { bf16_t* o = (bf16_t*)(p.ws + OFF_R + R_KA) + (size_t)row * 128 + (n0 - 512) + fr;
#pragma unroll
            for (int nf = 0; nf < 4; ++nf) o[16 * nf] = f2bf(v[nf]); }
        } else if (n0 < 768) { bf16_t* o = (bf16_t*)(p.ws + OFF_R + R_VA) + (size_t)row * 128 + (n0 - 640) + fr;
#pragma unroll
          for (int nf = 0; nf < 4; ++nf) o[16 * nf] = f2bf(v[nf]);
        } else if (n0 < 1152) { bf16_t* o = (bf16_t*)(p.ws + OFF_R + R_CQ) + (size_t)row * QRK + (n0 - 768) + fr;
#pragma unroll
          for (int nf = 0; nf < 4; ++nf) o[16 * nf] = f2bf(v[nf]);
        } else if (n0 < 1408) { bf16_t* o = (bf16_t*)(p.ws + OFF_R + R_CKV) + (size_t)row * KVRK + (n0 - 1152) + fr;
#pragma unroll
          for (int nf = 0; nf < 4; ++nf) o[16 * nf] = f2bf(v[nf]);
        } else {
          const float pr0 = __shfl_xor(v[0], 8), pr1 = __shfl_xor(v[1], 8);
          if (lat) { const int f = fr & 7; const float c0 = RT[4096 + rp * 8 + f], s0 = RT[5120 + rp * 8 + f], c1 = RT[4096 + cp * 8 + f], s1 = RT[5120 + cp * 8 + f];
            v[0] = fr < 8 ? v[0] * c0 - pr0 * s0 : pr0 * s0 + v[0] * c0; v[1] = fr < 8 ? v[1] * c1 - pr1 * s1 : pr1 * s1 + v[1] * c1; }
          bf16_t* o = WSP(bf16_t, OFF_KR) + (size_t)row * 32 + fr; o[0] = f2bf(v[0]); o[16] = f2bf(v[1]);
        }
      }
  }
};
struct EpiQup {
  const Prm* pp;
  __device__ __forceinline__ void operator()(f32x4 (&acc)[4][6], int m0, int n0, int fr, int fq) const {
    const Prm& p = *pp; const float* RT = WSP(float, OFF_ROPE); const float* ssq = WSP(float, OFF_SSQQ);
#pragma unroll
    for (int mf = 0; mf < 4; ++mf)
#pragma unroll
      for (int j = 0; j < 4; ++j) {
        const int row = m0 + 16 * mf + 4 * fq + j; bool lat; int rp, cp; rope_pos(row, lat, rp, cp);
        const float rs = rsqrtf(ssq[row] * (1.f / QRK) + EPS) * SCALE_B;
        float v[6];
#pragma unroll
        for (int nf = 0; nf < 6; ++nf) v[nf] = acc[mf][nf][j] * rs;
        const float pr0 = __shfl_xor(v[4], 8), pr1 = __shfl_xor(v[5], 8);
        if (lat) { const int f = fr & 7; const float c0 = RT[4096 + rp * 8 + f], s0 = RT[5120 + rp * 8 + f], c1 = RT[4096 + cp * 8 + f], s1 = RT[5120 + cp * 8 + f];
          v[4] = fr < 8 ? v[4] * c0 - pr0 * s0 : pr0 * s0 + v[4] * c0; v[5] = fr < 8 ? v[5] * c1 - pr1 * s1 : pr1 * s1 + v[5] * c1; }
        bf16_t* o = (bf16_t*)(p.ws + OFF_R + R_QB) + (size_t)row * NQB + n0 + fr;
#pragma unroll
        for (int nf = 0; nf < 6; ++nf) o[16 * nf] = f2bf(v[nf]);
      }
  }
};
struct EpiKVup {
  const Prm* pp;
  __device__ __forceinline__ void operator()(f32x4 (&acc)[4][4], int m0, int n0, int fr, int fq) const {
    const Prm& p = *pp; const float* ssq = WSP(float, OFF_SSQK);
    const int hd = n0 >> 7, part = (n0 >> 6) & 1;
    bf16_t* base = (bf16_t*)(p.ws + OFF_R + (part ? R_VB : R_KB));
#pragma unroll
    for (int mf = 0; mf < 4; ++mf)
#pragma unroll
      for (int j = 0; j < 4; ++j) {
        const int row = m0 + 16 * mf + 4 * fq + j; const float rs = rsqrtf(ssq[row] * (1.f / KVRK) + EPS);
        bf16_t* o = base + (size_t)row * 512 + hd * 64 + fr;
#pragma unroll
        for (int nf = 0; nf < 4; ++nf) o[16 * nf] = f2bf(acc[mf][nf][j] * rs);
      }
  }
};
struct EpiOut {
  const Prm* pp; int l;
  __device__ __forceinline__ void operator()(f32x4 (&acc)[4][4], int m0, int n0, int fr, int fq) const {
    const Prm& p = *pp; const float* MOD = WSP(float, OFF_MOD);
#pragma unroll
    for (int mf = 0; mf < 4; ++mf)
#pragma unroll
      for (int j = 0; j < 4; ++j) {
        const int row = m0 + 16 * mf + 4 * fq + j; const float* ga = MOD + (size_t)(l * 5 + row_mi(row)) * 6144 + 2 * 1024 + n0 + fr;
        float* X = WSP(float, OFF_X) + (size_t)row * DM + n0 + fr;
#pragma unroll
        for (int nf = 0; nf < 4; ++nf) X[16 * nf] += ga[16 * nf] * acc[mf][nf][j];
      }
  }
};
struct EpiMoeUp {
  const Prm* pp;
  __device__ __forceinline__ void operator()(f32x4 (&acc)[4][4], int m0, int n0, int fr, int fq) const {
    const Prm& p = *pp; const int j0 = n0 >> 1;
#pragma unroll
    for (int mf = 0; mf < 4; ++mf)
#pragma unroll
      for (int j = 0; j < 4; ++j) {
        const int slot = m0 + 16 * mf + 4 * fq + j;
        bf16_t* o = (bf16_t*)(p.ws + OFF_R + R_ACT) + (size_t)slot * DFF + j0 + fr;
        o[0] = f2bf(silu_f(acc[mf][0][j]) * acc[mf][2][j]); o[16] = f2bf(silu_f(acc[mf][1][j]) * acc[mf][3][j]);
      }
  }
};
struct EpiMoeDown {
  const Prm* pp;
  __device__ __forceinline__ void operator()(f32x4 (&acc)[4][4], int m0, int n0, int fr, int fq) const {
    const Prm& p = *pp; const float* VAL = WSP(float, OFF_VAL);
#pragma unroll
    for (int mf = 0; mf < 4; ++mf)
#pragma unroll
      for (int j = 0; j < 4; ++j) {
        const int slot = m0 + 16 * mf + 4 * fq + j; const float vv = VAL[slot];
        bf16_t* o = (bf16_t*)(p.ws + OFF_R + R_Y) + (size_t)slot * DM + n0 + fr;
#pragma unroll
        for (int nf = 0; nf < 4; ++nf) o[16 * nf] = f2bf(acc[mf][nf][j] * vv);
      }
  }
};

__device__ __forceinline__ void ph_gemm_in(const Prm& p, int l, int bid, int nb) {
  const int wv = TIDX >> 6, wm = wv >> 1, wn = wv & 1;
  const bf16_t* Bt = (const bf16_t*)(p.ws + OFF_W + (size_t)l * SZ_WL);
  APDense ap{(const bf16_t*)(p.ws + OFF_R + R_H), DM}; EpiIn epi{&p};
  constexpr int NCT = NINP / 128;
  for (int it = bid; it < (MR / 256) * NCT; it += nb) { const int rt = it / NCT, ct = it % NCT;
    sgemm_wave<4>(ap, Bt, DM, rt * 256 + wm * 64, ct * 128 + wn * 64, epi); }
}
__device__ __forceinline__ void ph_ssq(const Prm& p, int bid, int nb) {
  const int lane = TIDX & 63, wv = TIDX >> 6;
  for (int r = bid * NWAVE + wv; r < MR; r += nb * NWAVE) {
    const bf16_t* cq = (const bf16_t*)(p.ws + OFF_R + R_CQ) + (size_t)r * QRK; const bf16_t* ck = (const bf16_t*)(p.ws + OFF_R + R_CKV) + (size_t)r * KVRK;
    float s = 0.f; for (int i = lane; i < QRK; i += 64) { const float v = bf2f(cq[i]); s += v * v; }
    float s2 = 0.f; for (int i = lane; i < KVRK; i += 64) { const float v = bf2f(ck[i]); s2 += v * v; }
    s = wave_sum(s); s2 = wave_sum(s2);
    if (lane == 0) { WSP(float, OFF_SSQQ)[r] = s; WSP(float, OFF_SSQK)[r] = s2; }
  }
}
__device__ __forceinline__ void ph_gemm_up(const Prm& p, int l, int bid, int nb) {
  const int wv = TIDX >> 6, wm = wv >> 1, wn = wv & 1;
  const bf16_t* WQ = (const bf16_t*)(p.ws + OFF_W + (size_t)l * SZ_WL + SZ_WIN);
  const bf16_t* WKV = (const bf16_t*)(p.ws + OFF_W + (size_t)l * SZ_WL + SZ_WIN + SZ_WQ);
  constexpr int IQ = (MR / 256) * 4, IKV = (MR / 256) * 8;
  for (int it = bid; it < IQ + IKV; it += nb) {
    if (it < IQ) { const int rt = it / 4, ct = it % 4; APDense ap{(const bf16_t*)(p.ws + OFF_R + R_CQ), QRK}; EpiQup epi{&p};
      sgemm_wave<6>(ap, WQ, QRK, rt * 256 + wm * 64, ct * 192 + wn * 96, epi); }
    else { const int i2 = it - IQ, rt = i2 / 8, ct = i2 % 8; APDense ap{(const bf16_t*)(p.ws + OFF_R + R_CKV), KVRK}; EpiKVup epi{&p};
      sgemm_wave<4>(ap, WKV, KVRK, rt * 256 + wm * 64, ct * 128 + wn * 64, epi); }
  }
}
__device__ __forceinline__ void ph_gemm_out(const Prm& p, int l, int bid, int nb) {
  const int wv = TIDX >> 6, wm = wv >> 1, wn = wv & 1;
  const bf16_t* Bt = (const bf16_t*)(p.ws + OFF_W + (size_t)l * SZ_WL + SZ_WIN + SZ_WQ + SZ_WKV);
  APDense ap{(const bf16_t*)(p.ws + OFF_R + R_H), DM}; EpiOut epi{&p, l};
  for (int it = bid; it < (MR / 256) * 8; it += nb) { const int rt = it / 8, ct = it % 8;
    sgemm_wave<4>(ap, Bt, DM, rt * 256 + wm * 64, ct * 128 + wn * 64, epi); }
}
__device__ __forceinline__ void ph_moe_up(const Prm& p, int l, int bid, int nb) {
  const int wv = TIDX >> 6, wm = wv >> 1, wn = wv & 1;
  const int nrt = (l == DEPTH - 1) ? 256 : 272;
  APGather ap{(const bf16_t*)(p.ws + OFF_R + R_H), WSP(int, OFF_IDX)}; EpiMoeUp epi{&p};
  for (int it = bid; it < nrt * 8; it += nb) { const int rt = it / 8, ct = it % 8; const int e = rt < 256 ? ((rt >> 2) & 15) : rt - 256;
    sgemm_wave<4>(ap, WSP(bf16_t, OFF_WGU) + (size_t)e * 1024 * 1024, DM, rt * 256 + wm * 64, ct * 128 + wn * 64, epi); }
}
__device__ __forceinline__ void ph_moe_down(const Prm& p, int l, int bid, int nb) {
  const int wv = TIDX >> 6, wm = wv >> 1, wn = wv & 1;
  const int nrt = (l == DEPTH - 1) ? 256 : 272;
  APDense ap{(const bf16_t*)(p.ws + OFF_R + R_ACT), DFF}; EpiMoeDown epi{&p};
  for (int it = bid; it < nrt * 8; it += nb) { const int rt = it / 8, ct = it % 8; const int e = rt < 256 ? ((rt >> 2) & 15) : rt - 256;
    sgemm_wave<4>(ap, WSP(bf16_t, OFF_WD) + (size_t)e * 1024 * 512, DFF, rt * 256 + wm * 64, ct * 128 + wn * 64, epi); }
}

namespace pg8 {
#define PG8_LAS __attribute__((address_space(3)))
constexpr int BM = 256, BK = 64, HALF = 128, HTB = HALF * BK * 2, STAGE_BYTES = 8 * HTB;
__device__ __forceinline__ int lds_byte(int r, int c) { const int st = (r >> 4) * 2 + (c >> 5), rr = r & 15, cc = c & 31, ob = rr * 64 + cc * 2; return st * 1024 + (ob ^ (((ob >> 9) & 1) << 5)); }
__device__ __forceinline__ void stage_rc(int b, int& R, int& C) { const int st = b / 1024, sb = b % 1024, swz = sb ^ (((sb >> 9) & 1) << 5); R = (st >> 1) * 16 + swz / 64; C = (st & 1) * 32 + (swz % 64) / 2; }
struct Unit { int pm, pn; size_t boff; int r0; };
struct Gemm { const bf16_t* A; const bf16_t* Bt; int K; const int* idx; };
template <bool GATHER, bool HALFM = false, class Epi, class Sched>
__device__ __forceinline__ void gemm_phase(PG8_LAS unsigned char* lds, const Gemm g, const Sched& S, const Epi& E) {
    const int tid = TIDX, wid = __builtin_amdgcn_readfirstlane(tid >> 6), lane = tid & 63, wr = wid >> 2, wc = wid & 3, fr = lane & 15, fq = lane >> 4;
    const int K = g.K, nt = K / BK;
    int RA[2], CA[2]; unsigned voffB[2], voffA[2];
#pragma unroll
    for (int i = 0; i < 2; ++i) { int R, C; stage_rc(tid * 16 + i * 8192, R, C); RA[i] = R; CA[i] = C; voffA[i] = (unsigned)(R * K + C) * 2u; voffB[i] = voffA[i]; }
    const size_t kstep = (size_t)(BK * 2);
    const size_t hstep = (size_t)HALF * K * 2;
    const size_t tstep = 2 * hstep;
    const unsigned ldsw = (unsigned)wid * 1024u;
    const int aoff = lds_byte(wr * 64 + fr, fq * 8), boff = lds_byte(wc * 32 + fr, fq * 8);
#define PG8_SA(b, h) (((b) * 2 + (h)) * HTB)
#define PG8_SB(b, h) ((4 + (b) * 2 + (h)) * HTB)
#define PG8_STAGE(bufoff, gbase, voff) do { _Pragma("unroll") for (int _i = 0; _i < 2; ++_i) \
        __builtin_amdgcn_global_load_lds((const unsigned*)((const char*)(gbase) + (voff)[_i]), (PG8_LAS unsigned*)(lds + (bufoff) + ldsw + _i * 8192), 16, 0, 0); } while (0)
#define PG8_LDA(dst, b, h) do { _Pragma("unroll") for (int m = 0; m < 4; ++m) _Pragma("unroll") for (int k = 0; k < 2; ++k) dst[m][k] = *(const PG8_LAS bf16x8*)(lds + PG8_SA(b, h) + aoff + m * 2048 + k * 1024); } while (0)
#define PG8_LDB(dst, b, h) do { _Pragma("unroll") for (int n = 0; n < 2; ++n) _Pragma("unroll") for (int k = 0; k < 2; ++k) dst[n][k] = *(const PG8_LAS bf16x8*)(lds + PG8_SB(b, h) + boff + n * 2048 + k * 1024); } while (0)
#define PG8_MMA(ai, bj, At, Bt) do { __builtin_amdgcn_s_setprio(1); _Pragma("unroll") for (int m = 0; m < 4; ++m) _Pragma("unroll") for (int n = 0; n < 2; ++n) _Pragma("unroll") for (int k = 0; k < 2; ++k) \
        acc[ai][bj][m][n] = __builtin_amdgcn_mfma_f32_16x16x32_bf16(Bt[n][k], At[m][k], acc[ai][bj][m][n], 0, 0, 0); __builtin_amdgcn_s_setprio(0); } while (0)
#define PG8_WAIT_V(n) asm volatile("s_waitcnt vmcnt(" #n ")" ::: "memory")
#define PG8_WAIT_L(n) asm volatile("s_waitcnt lgkmcnt(" #n ")" ::: "memory")
#define PG8_BAR __builtin_amdgcn_s_barrier()
#define PG8_SCHED __builtin_amdgcn_sched_barrier(0)
    Unit cur, nxt; int ui = 0;
    if (!S.next(0, cur)) return;
    f32x4 acc[2][2][4][2];
#pragma unroll
    for (int a = 0; a < 2; ++a)
#pragma unroll
        for (int b = 0; b < 2; ++b)
#pragma unroll
            for (int m = 0; m < 4; ++m)
#pragma unroll
                for (int n = 0; n < 2; ++n) acc[a][b][m][n] = (f32x4){0.f, 0.f, 0.f, 0.f};
    bf16x8 At[4][2], B0[2][2], B1[2][2];
    unsigned oc0[2], oc1[2], on0[2], on1[2];
    auto set_off = [&](const Unit& u, unsigned (&o0)[2], unsigned (&o1)[2]) {
        if constexpr (GATHER) {
#pragma unroll
            for (int i = 0; i < 2; ++i) { const int r0 = g.idx[u.r0 + RA[i]], r1 = g.idx[u.r0 + HALF + RA[i]]; o0[i] = (unsigned)(r0 * K + CA[i]) * 2u; o1[i] = (unsigned)(r1 * K + CA[i]) * 2u; }
        } else {
#pragma unroll
            for (int i = 0; i < 2; ++i) { o0[i] = voffA[i]; o1[i] = voffA[i] + (unsigned)hstep; }
        }
    };
    auto a_base = [&](const Unit& u) -> const char* { if constexpr (GATHER) return (const char*)g.A; else return (const char*)g.A + (size_t)u.r0 * (size_t)(K * 2); };
    const char* cA = a_base(cur); const char* cB = (const char*)g.Bt + cur.boff + (size_t)cur.pn * tstep;
    set_off(cur, oc0, oc1);
    PG8_STAGE(PG8_SB(0, 0), cB, voffB); PG8_STAGE(PG8_SB(0, 1), cB + hstep, voffB); PG8_STAGE(PG8_SA(0, 0), cA, oc0); PG8_STAGE(PG8_SA(0, 1), cA, oc1);
    if (wr == 1) PG8_BAR;
    PG8_WAIT_V(2); PG8_BAR;
    PG8_STAGE(PG8_SB(1, 0), cB + kstep, voffB); PG8_STAGE(PG8_SA(1, 0), cA + kstep, oc0); PG8_STAGE(PG8_SB(1, 1), cB + hstep + kstep, voffB);
    PG8_WAIT_V(6); PG8_BAR;
    for (;;) {
        const bool has_next = S.next(ui + 1, nxt);
        const char* nA = has_next ? a_base(nxt) : cA; const char* nB = has_next ? (const char*)g.Bt + nxt.boff + (size_t)nxt.pn * tstep : cB;
        if (has_next) set_off(nxt, on0, on1); else {
#pragma unroll
            for (int i = 0; i < 2; ++i) { on0[i] = oc0[i]; on1[i] = oc1[i]; } }
#pragma unroll 1
        for (int t = 0; t < nt; t += 2) {
            const bool last = (t == nt - 2);
            const char* a1 = cA + (size_t)(t + 1) * kstep;
            const char* a2 = last ? nA : cA + (size_t)(t + 2) * kstep; const char* b2 = last ? nB : cB + (size_t)(t + 2) * kstep;
            const char* a3 = a2 + kstep; const char* b3 = b2 + kstep;
            unsigned o20[2], o21[2];
#pragma unroll
            for (int i = 0; i < 2; ++i) { o20[i] = last ? on0[i] : oc0[i]; o21[i] = last ? on1[i] : oc1[i]; }
            PG8_LDB(B0, 0, 0); PG8_LDB(B1, 0, 1); PG8_SCHED; PG8_LDA(At, 0, 0); PG8_STAGE(PG8_SA(1, 1), a1, oc1);
            PG8_WAIT_V(8); PG8_WAIT_L(0); PG8_BAR; PG8_MMA(0, 0, At, B0); PG8_MMA(0, 1, At, B1); PG8_BAR; PG8_SCHED;
            if constexpr (!HALFM) { PG8_LDA(At, 0, 1); } PG8_STAGE(PG8_SB(0, 0), b2, voffB); PG8_STAGE(PG8_SB(0, 1), b2 + hstep, voffB); PG8_STAGE(PG8_SA(0, 0), a2, o20);
            PG8_WAIT_V(8); PG8_WAIT_L(0); PG8_BAR; if constexpr (!HALFM) { PG8_MMA(1, 0, At, B0); PG8_MMA(1, 1, At, B1); } PG8_BAR; PG8_SCHED;
            PG8_LDB(B0, 1, 0); PG8_LDB(B1, 1, 1); PG8_SCHED; PG8_LDA(At, 1, 0); PG8_STAGE(PG8_SA(0, 1), a2, o21);
            PG8_WAIT_V(8); PG8_WAIT_L(0); PG8_BAR; PG8_MMA(0, 0, At, B0); PG8_MMA(0, 1, At, B1); PG8_BAR; PG8_SCHED;
            if constexpr (!HALFM) { PG8_LDA(At, 1, 1); } PG8_STAGE(PG8_SB(1, 0), b3, voffB); PG8_STAGE(PG8_SB(1, 1), b3 + hstep, voffB); PG8_STAGE(PG8_SA(1, 0), a3, o20);
            PG8_WAIT_V(8); PG8_WAIT_L(0); PG8_BAR; if constexpr (!HALFM) { PG8_MMA(1, 0, At, B0); PG8_MMA(1, 1, At, B1); } PG8_BAR; PG8_SCHED;
        }
        if (wr == 0) PG8_BAR;
        E.template run<HALFM>(acc, cur, wr, wc, fr, fq, lds, tid);
        if (!has_next) break;
#pragma unroll
        for (int a = 0; a < 2; ++a)
#pragma unroll
            for (int b = 0; b < 2; ++b)
#pragma unroll
                for (int m = 0; m < 4; ++m)
#pragma unroll
                    for (int n = 0; n < 2; ++n) acc[a][b][m][n] = (f32x4){0.f, 0.f, 0.f, 0.f};
        cur = nxt; cA = nA; cB = nB; ++ui;
#pragma unroll
        for (int i = 0; i < 2; ++i) { oc0[i] = on0[i]; oc1[i] = on1[i]; }
        if (wr == 1) PG8_BAR;
    }
    PG8_WAIT_V(0);
    PG8_BAR;
#undef PG8_SA
#undef PG8_SB
#undef PG8_STAGE
#undef PG8_LDA
#undef PG8_LDB
#undef PG8_MMA
#undef PG8_WAIT_V
#undef PG8_WAIT_L
#undef PG8_BAR
#undef PG8_SCHED
}
}

__device__ __forceinline__ int vcu_of(int bid, int nb) { return (nb % 8 == 0) ? (bid % 8) * (nb / 8) + bid / 8 : bid; }
struct SchedDense { int nM, nN, G, c; bool rev; bool skipctx; int lim;
  __device__ __forceinline__ bool next(int i, pg8::Unit& u) const { const int L = i * G + (rev ? G - 1 - c : c); if (L >= lim) return false; int pm = L / nN; u.pn = L % nN;
    if (skipctx) pm = pm + pm / 32 + 1; u.pm = pm; u.r0 = pm * 256; u.boff = 0; return true; } };
struct SchedDenseTail { int nN, base, nh, c;
  __device__ __forceinline__ bool next(int i, pg8::Unit& u) const { if (i > 0 || c >= nh) return false; const int L = base + (c >> 1); u.pm = L / nN; u.pn = L % nN;
    u.r0 = u.pm * 256 + (c & 1) * 128; u.boff = 0; return true; } };
struct SchedMoe { int nrt, G, c; size_t estride;
  __device__ __forceinline__ bool next(int i, pg8::Unit& u) const { const int L = i * G + c; if (L >= nrt * 4) return false; u.pm = L >> 2; u.pn = L & 3; u.r0 = u.pm * 256;
    const int e = u.pm < 256 ? ((u.pm >> 2) & 15) : u.pm - 256; u.boff = (size_t)e * estride; return true; } };
struct SchedMoeTail { int c; size_t estride;
  __device__ __forceinline__ bool next(int i, pg8::Unit& u) const { if (i > 0 || (c & 15) >= 4 || (c >> 4) >= NE) return false; const int e = c >> 4; u.pm = 256 + e; u.pn = c & 15;
    u.r0 = u.pm * 256; u.boff = (size_t)e * estride; return true; } };

__device__ __forceinline__ f32x4 shfl32(f32x4 v) { f32x4 r;
#pragma unroll
  for (int i = 0; i < 4; ++i) { auto x = __builtin_amdgcn_permlane32_swap(__float_as_uint(v[i]), __float_as_uint(v[i]), false, false); r[i] = __uint_as_float((TIDX & 32) ? x[0] : x[1]); }
  return r; }
__device__ __forceinline__ void rope32_grp(f32x4& v0, f32x4& v1, const float* RT, int rp, int cp, int fq) {
  const f32x4 p0 = shfl32(v0), p1 = shfl32(v1); const int f = 4 * (fq & 1);
  const f32x4 c0 = *(const f32x4*)(RT + 4096 + rp * 8 + f), s0 = *(const f32x4*)(RT + 5120 + rp * 8 + f), c1 = *(const f32x4*)(RT + 4096 + cp * 8 + f), s1 = *(const f32x4*)(RT + 5120 + cp * 8 + f);
  if (fq < 2) { v0 = v0 * c0 - p0 * s0; v1 = v1 * c1 - p1 * s1; } else { v0 = p0 * s0 + v0 * c0; v1 = p1 * s1 + v1 * c1; }
}
constexpr int ROPE_TAB_OFF = 131072 + 16384 + 128;
constexpr int STG_OFF = 131072, STG_OFF2 = 3 * 16384  , STG_RS = 512;
#define WSE(T, off) ((T*)(ws + (off)))
template <bool HM, class Epi>
__device__ __forceinline__ void epi_staged(const Epi& E, f32x4 (&acc)[2][2][4][2], const pg8::Unit& u, int wr, int wc, int fr, int fq, PG8_LAS unsigned char* lds, int tid) {
  constexpr int NCH = Epi::NCOL / 8, NPASS = 32 * NCH / NTHR;
  typename Epi::Ctx ctx; E.begin(ctx, u, wr, wc, fr, fq);
  const PG8_LAS float* rtab = (const PG8_LAS float*)(lds + ROPE_TAB_OFF);
  unsigned wofs[2][2], rofs[NPASS], gofs[NPASS], gld[NPASS]; bool gval[NPASS];
#pragma unroll
  for (int bj = 0; bj < 2; ++bj)
#pragma unroll
    for (int n = 0; n < 2; ++n) { const unsigned chunk = bj * 16 + wc * 4 + n * 2 + (fq >> 1); wofs[bj][n] = Epi::LEAN ? 0u : (unsigned)(wr * 16 + fr) * STG_RS + ((chunk ^ (unsigned)fr) << 4) + (fq & 1) * 8; }
#pragma unroll
  for (int ps = 0; ps < NPASS; ++ps) { const unsigned c = (unsigned)tid + NTHR * ps, rl = c / NCH, ch = c % NCH;
    rofs[ps] = rl * STG_RS + ((ch ^ (rl & 15u)) << 4);
    E.dst(u, (int)((rl >> 4) * 64 + (rl & 15u)), (int)(ch * 8), gofs[ps], gld[ps], gval[ps]); }
#pragma unroll
  for (int ai = 0; ai < (HM ? 1 : 2); ++ai)
#pragma unroll
    for (int m = 0; m < 4; ++m) {
      PG8_LAS unsigned char* stg = lds + ((m & 1) ? STG_OFF2 : STG_OFF);
      f32x4 v[2][2] = {{acc[ai][0][m][0], acc[ai][0][m][1]}, {acc[ai][1][m][0], acc[ai][1][m][1]}};
      E.pre(v, ai * 128 + m * 16, ai, m, ctx, u, wc, fr, fq, rtab);
#pragma unroll
      for (int bj = 0; bj < Epi::NCOL / 128; ++bj)
#pragma unroll
        for (int n = 0; n < 2; ++n) { u32x2 w; w.x = cvtpk_e(v[bj][n][0], v[bj][n][1]); w.y = cvtpk_e(v[bj][n][2], v[bj][n][3]);
          unsigned wo = wofs[bj][n];
          if (Epi::LEAN) { int frl = fr; asm volatile("" : "+v"(frl)); const unsigned chunk = bj * 16 + wc * 4 + n * 2 + (fq >> 1); wo = (unsigned)(wr * 16 + frl) * STG_RS + ((chunk ^ (unsigned)frl) << 4) + (fq & 1) * 8; }
          *(PG8_LAS u32x2*)(stg + wo) = w; }
      asm volatile("s_waitcnt lgkmcnt(0)" ::: "memory"); __builtin_amdgcn_s_barrier(); asm volatile("" ::: "memory");
#pragma unroll
      for (int ps = 0; ps < NPASS; ++ps) {
        const u32x4 val = *(const PG8_LAS u32x4*)(stg + rofs[ps]);
        unsigned go = gofs[ps]; asm volatile("" : "+v"(go));
        if (gval[ps]) __builtin_nontemporal_store(val, (u32x4*)(E.ws + (size_t)(go + (unsigned)(ai * 128 + m * 16) * gld[ps]))); }
    }
  asm volatile("s_waitcnt lgkmcnt(0)" ::: "memory"); __builtin_amdgcn_s_barrier(); asm volatile("" ::: "memory");
}
#define EPI_RUN   template <bool HM> __device__ __forceinline__ void run(f32x4 (&acc)[2][2][4][2], const pg8::Unit& u, int wr, int wc, int fr, int fq, PG8_LAS unsigned char* lds, int tid) const { epi_staged<HM>(*this, acc, u, wr, wc, fr, fq, lds, tid); }
__device__ __forceinline__ void rot4(f32x4& x1, f32x4& x2, int pos, const f32x4& w) {
  f32x4 c, sn;
#pragma unroll
  for (int j = 0; j < 4; ++j) { const float a = __builtin_amdgcn_fractf((float)pos * w[j]); c[j] = __builtin_amdgcn_cosf(a); sn[j] = __builtin_amdgcn_sinf(a); }
  const f32x4 a = x1 * c - x2 * sn, b = x1 * sn + x2 * c; x1 = a; x2 = b;
}
__device__ __forceinline__ f32x4 rope_w(int i0, float nf) { f32x4 w;
#pragma unroll
  for (int j = 0; j < 4; ++j) w[j] = exp2f(-(float)(i0 + j) * (13.287712379549449f / nf)) * 0.15915494309189535f;
  return w; }
__device__ __forceinline__ void rope32_hw(f32x4& v0, f32x4& v1, int rp, int cp, int fq, const f32x4& w32) {
  const f32x4 p0 = shfl32(v0), p1 = shfl32(v1);
  f32x4 c0, s0, c1, s1;
#pragma unroll
  for (int j = 0; j < 4; ++j) { const float a = __builtin_amdgcn_fractf((float)rp * w32[j]), bq = __builtin_amdgcn_fractf((float)cp * w32[j]);
    c0[j] = __builtin_amdgcn_cosf(a); s0[j] = __builtin_amdgcn_sinf(a); c1[j] = __builtin_amdgcn_cosf(bq); s1[j] = __builtin_amdgcn_sinf(bq); }
  if (fq < 2) { v0 = v0 * c0 - p0 * s0; v1 = v1 * c1 - p1 * s1; } else { v0 = p0 * s0 + v0 * c0; v1 = p1 * s1 + v1 * c1; }
}
__device__ __forceinline__ void tile_pos(int pm, bool& lat, int& pos0) { const int tb = pm % 33; lat = tb != 0; pos0 = (tb - 1) * 256; }
struct Epi2In {
  static constexpr int NCOL = 256; static constexpr bool LEAN = true;
  EPI_RUN
  unsigned char* ws;
  struct Ctx { int pos0, rloc; bool lat; };
  __device__ __forceinline__ void begin(Ctx& c, const pg8::Unit& u, int wr, int wc, int fr, int fq) const {
    c.rloc = wr * 64 + fr; tile_pos(u.pm, c.lat, c.pos0); c.pos0 += c.rloc + (u.r0 - u.pm * 256); }
  __device__ __forceinline__ void dst(const pg8::Unit& u, int rsub, int col, unsigned& gofs, unsigned& gld, bool& gval) const {
    const int gc = u.pn * 256 + col; const unsigned row = (unsigned)(u.r0 + rsub);
    const unsigned ld = gc < 512 ? 512u : gc < 768 ? 128u : gc < 1152 ? (unsigned)QRK : gc < 1408 ? (unsigned)KVRK : 32u;
    const unsigned base = gc < 512 ? (unsigned)(OFF_R + R_QA) : gc < 640 ? (unsigned)(OFF_R + R_KA) : gc < 768 ? (unsigned)(OFF_R + R_VA) : gc < 1152 ? (unsigned)(OFF_R + R_CQ) : gc < 1408 ? (unsigned)(OFF_R + R_CKV) : (unsigned)OFF_KR;
    const unsigned c0 = gc < 512 ? 0u : gc < 640 ? 512u : gc < 768 ? 640u : gc < 1152 ? 768u : gc < 1408 ? 1152u : 1408u;
    gval = gc < 1440; gld = ld * 2; gofs = base + row * gld + ((unsigned)gc - c0) * 2;
  }
  __device__ __forceinline__ void pre(f32x4 (&v)[2][2], int rowstep, int ai, int m, const Ctx& c, const pg8::Unit& u, int wc, int fr, int fq, const PG8_LAS float* rtab) const {
    int pos = c.pos0 + rowstep; asm volatile("" : "+v"(pos));
    const int rp = pos >> 6, cp = pos & 63; const bool lat = c.lat;
#pragma unroll
    for (int bj = 0; bj < 2; ++bj) {
      const int cg = u.pn * 256 + bj * 128 + wc * 32, g32 = cg >> 5;
      f32x4& v0 = v[bj][0]; f32x4& v1 = v[bj][1];
      if (g32 < 20) {
        if (lat) { const f32x4 w64 = *(const PG8_LAS f32x4*)(rtab + 4 * fq); rot4(v0, v1, (g32 & 1) ? cp : rp, w64); }
        if (g32 < 16) { v0 = v0 * SCALE_A; v1 = v1 * SCALE_A; }
      } else if (g32 >= 24 && g32 < 44) {
        float sq = v0[0] * v0[0] + v0[1] * v0[1] + v0[2] * v0[2] + v0[3] * v0[3] + v1[0] * v1[0] + v1[1] * v1[1] + v1[2] * v1[2] + v1[3] * v1[3];
        sq = sum16sw(sq); sq = sum32sw(sq);
        if (fq == 0) atomicAdd(WSE(float, g32 < 36 ? OFF_SSQQ : OFF_SSQK) + (u.r0 + rowstep + c.rloc), sq);
      } else if (g32 == 44) { if (lat) { const f32x4 w32 = *(const PG8_LAS f32x4*)(rtab + 16 + 4 * (fq & 1)); rope32_hw(v0, v1, rp, cp, fq, w32); } }
    }
  }
};
struct Epi2Qup {
  static constexpr int NCOL = 256; static constexpr bool LEAN = false;
  EPI_RUN
  unsigned char* ws;
  struct Ctx { float rs[2][4]; int pos0; bool lat; };
  __device__ __forceinline__ void begin(Ctx& c, const pg8::Unit& u, int wr, int wc, int fr, int fq) const {
    tile_pos(u.pm, c.lat, c.pos0); c.pos0 += wr * 64 + fr + (u.r0 - u.pm * 256);
#pragma unroll
    for (int ai = 0; ai < 2; ++ai)
#pragma unroll
      for (int m = 0; m < 4; ++m) c.rs[ai][m] = WSE(float, OFF_SSQQ)[u.r0 + ai * 128 + wr * 64 + m * 16 + fr];
#pragma unroll
    for (int ai = 0; ai < 2; ++ai)
#pragma unroll
      for (int m = 0; m < 4; ++m) c.rs[ai][m] = rsqrtf(c.rs[ai][m] * (1.f / QRK) + EPS) * SCALE_B; }
  __device__ __forceinline__ void dst(const pg8::Unit& u, int rsub, int col, unsigned& gofs, unsigned& gld, bool& gval) const {
    gld = NQB * 2; gofs = (unsigned)(OFF_R + R_QB) + (unsigned)(u.r0 + rsub) * gld + (u.pn * 256 + col) * 2; gval = true; }
  __device__ __forceinline__ void pre(f32x4 (&v)[2][2], int rowstep, int ai, int m, const Ctx& c, const pg8::Unit& u, int wc, int fr, int fq, const PG8_LAS float* rtab) const {
    int pos = c.pos0 + rowstep; asm volatile("" : "+v"(pos));
    const int rp = pos >> 6, cp = pos & 63; const float rs = c.rs[ai][m];
#pragma unroll
    for (int bj = 0; bj < 2; ++bj) { const int g32 = (u.pn * 256 + bj * 128 + wc * 32) >> 5;
      v[bj][0] = v[bj][0] * rs; v[bj][1] = v[bj][1] * rs;
      if ((g32 % 3) == 2) { if (c.lat) { const f32x4 w32 = *(const PG8_LAS f32x4*)(rtab + 16 + 4 * (fq & 1)); rope32_hw(v[bj][0], v[bj][1], rp, cp, fq, w32); } } }
  }
};
struct Epi2KV {
  static constexpr int NCOL = 256; static constexpr bool LEAN = false;
  EPI_RUN
  unsigned char* ws;
  struct Ctx { float rs[2][4]; };
  __device__ __forceinline__ void begin(Ctx& c, const pg8::Unit& u, int wr, int wc, int fr, int fq) const {
#pragma unroll
    for (int ai = 0; ai < 2; ++ai)
#pragma unroll
      for (int m = 0; m < 4; ++m) c.rs[ai][m] = WSE(float, OFF_SSQK)[u.r0 + ai * 128 + wr * 64 + m * 16 + fr];
#pragma unroll
    for (int ai = 0; ai < 2; ++ai)
#pragma unroll
      for (int m = 0; m < 4; ++m) c.rs[ai][m] = rsqrtf(c.rs[ai][m] * (1.f / KVRK) + EPS); }
  __device__ __forceinline__ void dst(const pg8::Unit& u, int rsub, int col, unsigned& gofs, unsigned& gld, bool& gval) const {
    const int gc = u.pn * 256 + col, hd = gc >> 7, sub = (gc >> 6) & 1;
    gld = 512 * 2; gofs = (unsigned)(OFF_R + (sub ? R_VB : R_KB)) + (unsigned)(u.r0 + rsub) * gld + (hd * 64 + (gc & 63)) * 2; gval = true; }
  __device__ __forceinline__ void pre(f32x4 (&v)[2][2], int rowstep, int ai, int m, const Ctx& c, const pg8::Unit& u, int wc, int fr, int fq, const PG8_LAS float* rtab) const {
    const float rs = c.rs[ai][m];
#pragma unroll
    for (int bj = 0; bj < 2; ++bj) { v[bj][0] = v[bj][0] * rs; v[bj][1] = v[bj][1] * rs; }
  }
};
struct Epi2Out {
  static constexpr int NCOL = 256; static constexpr bool LEAN = false;
  EPI_RUN
  unsigned char* ws; int l;
  struct Ctx { f32x4 ga[2][2]; };
  __device__ __forceinline__ void begin(Ctx& c, const pg8::Unit& u, int wr, int wc, int fr, int fq) const {
    const float* ga = WSE(float, OFF_MOD) + (size_t)(l * 5 + row_mi(u.pm * 256)) * 6144 + 2 * 1024 + u.pn * 256 + wc * 32 + 4 * fq;
#pragma unroll
    for (int bj = 0; bj < 2; ++bj)
#pragma unroll
      for (int n = 0; n < 2; ++n) c.ga[bj][n] = *(const f32x4*)(ga + bj * 128 + n * 16); }
  __device__ __forceinline__ void dst(const pg8::Unit& u, int rsub, int col, unsigned& gofs, unsigned& gld, bool& gval) const {
    gld = DM * 2; gofs = (unsigned)(OFF_R + R_MIXG) + (unsigned)(u.r0 + rsub) * gld + (u.pn * 256 + col) * 2; gval = true; }
  __device__ __forceinline__ void pre(f32x4 (&v)[2][2], int rowstep, int ai, int m, const Ctx& c, const pg8::Unit& u, int wc, int fr, int fq, const PG8_LAS float* rtab) const {
#pragma unroll
    for (int bj = 0; bj < 2; ++bj)
#pragma unroll
      for (int n = 0; n < 2; ++n) v[bj][n] = v[bj][n] * c.ga[bj][n];
  }
};
struct Epi2MoeUp {
  static constexpr int NCOL = 128; static constexpr bool LEAN = false;
  EPI_RUN
  unsigned char* ws;
  struct Ctx { };
  __device__ __forceinline__ void begin(Ctx& c, const pg8::Unit& u, int wr, int wc, int fr, int fq) const { }
  __device__ __forceinline__ void dst(const pg8::Unit& u, int rsub, int col, unsigned& gofs, unsigned& gld, bool& gval) const {
    gld = DFF * 2; gofs = (unsigned)(OFF_R + R_ACT) + (unsigned)(u.r0 + rsub) * gld + (u.pn * 128 + col) * 2; gval = true; }
  __device__ __forceinline__ void pre(f32x4 (&v)[2][2], int rowstep, int ai, int m, const Ctx& c, const pg8::Unit& u, int wc, int fr, int fq, const PG8_LAS float* rtab) const {
#pragma unroll
    for (int n = 0; n < 2; ++n)
#pragma unroll
      for (int j = 0; j < 4; ++j) v[0][n][j] = silu_fast(v[0][n][j]) * v[1][n][j];
  }
};
struct Epi2MoeDown {
  static constexpr int NCOL = 256; static constexpr bool LEAN = false;
  EPI_RUN
  unsigned char* ws;
  struct Ctx { float vv[2][4]; };
  __device__ __forceinline__ void begin(Ctx& c, const pg8::Unit& u, int wr, int wc, int fr, int fq) const {
#pragma unroll
    for (int ai = 0; ai < 2; ++ai)
#pragma unroll
      for (int m = 0; m < 4; ++m) c.vv[ai][m] = WSE(float, OFF_VAL)[u.r0 + ai * 128 + wr * 64 + m * 16 + fr]; }
  __device__ __forceinline__ void dst(const pg8::Unit& u, int rsub, int col, unsigned& gofs, unsigned& gld, bool& gval) const {
    gld = DM * 2; gofs = (unsigned)(OFF_R + R_Y) + (unsigned)(u.r0 + rsub) * gld + (u.pn * 256 + col) * 2; gval = true; }
  __device__ __forceinline__ void pre(f32x4 (&v)[2][2], int rowstep, int ai, int m, const Ctx& c, const pg8::Unit& u, int wc, int fr, int fq, const PG8_LAS float* rtab) const {
    const float vv = c.vv[ai][m];
#pragma unroll
    for (int bj = 0; bj < 2; ++bj) { v[bj][0] = v[bj][0] * vv; v[bj][1] = v[bj][1] * vv; }
  }
};
#define LDS3 ((PG8_LAS unsigned char*)lds)
__device__ __forceinline__ void ph2_gemm_in(const Prm& p, int l, unsigned char* lds, int bid, int nb) {
  pg8::Gemm g{(const bf16_t*)(p.ws + OFF_R + R_H), (const bf16_t*)(p.ws + OFF_W + (size_t)l * SZ_WL), DM, nullptr};
  const int vcu = vcu_of(bid, nb);
  const int nun = (MR / 256) * (NINP / 256), extra = nun % nb;
  const bool halftail = extra > 0 && 2 * extra <= nb;
  SchedDense S{MR / 256, NINP / 256, nb, vcu, false, false, halftail ? nun - extra : nun}; Epi2In E{p.ws};
  pg8::gemm_phase<false>(LDS3, g, S, E);
  if (halftail) { SchedDenseTail T{NINP / 256, nun - extra, 2 * extra, vcu}; pg8::gemm_phase<false, true>(LDS3, g, T, E);
    if (vcu >= 2 * extra) ph_wconv_moe(p, l, lds, vcu - 2 * extra, nb - 2 * extra); }
  else if (extra == 0) ph_wconv_moe(p, l, lds, vcu, nb); else if (vcu >= extra) ph_wconv_moe(p, l, lds, vcu - extra, nb - extra);
}
__device__ __forceinline__ void ph2_gemm_qup(const Prm& p, int l, unsigned char* lds, int bid, int nb) {
  pg8::Gemm g{(const bf16_t*)(p.ws + OFF_R + R_CQ), (const bf16_t*)(p.ws + OFF_W + (size_t)l * SZ_WL + SZ_WIN), QRK, nullptr};
  const bool lastl = (l == DEPTH - 1); SchedDense S{lastl ? MR / 256 - NB : MR / 256, NQB / 256, nb, vcu_of(bid, nb), false, lastl, (lastl ? MR / 256 - NB : MR / 256) * (NQB / 256)}; Epi2Qup E{p.ws}; pg8::gemm_phase<false>(LDS3, g, S, E);
}
__device__ __forceinline__ void ph2_gemm_kvup(const Prm& p, int l, unsigned char* lds, int bid, int nb) {
  pg8::Gemm g{(const bf16_t*)(p.ws + OFF_R + R_CKV), (const bf16_t*)(p.ws + OFF_W + (size_t)l * SZ_WL + SZ_WIN + SZ_WQ), KVRK, nullptr};
  SchedDense S{MR / 256, NKVB / 256, nb, vcu_of(bid, nb), true, false, (MR / 256) * (NKVB / 256)}; Epi2KV E{p.ws}; pg8::gemm_phase<false>(LDS3, g, S, E);
}
__device__ __forceinline__ void ph2_gemm_out(const Prm& p, int l, unsigned char* lds, int bid, int nb) {
  pg8::Gemm g{(const bf16_t*)(p.ws + OFF_R + R_H), (const bf16_t*)(p.ws + OFF_W + (size_t)l * SZ_WL + SZ_WIN + SZ_WQ + SZ_WKV), DM, nullptr};
  const bool lastl = (l == DEPTH - 1); const int vcu = vcu_of(bid, nb);
  const int nun = (lastl ? MR / 256 - NB : MR / 256) * (DM / 256), extra = nun % nb;
  const bool halftail = !lastl && extra > 0 && 2 * extra <= nb;
  SchedDense S{lastl ? MR / 256 - NB : MR / 256, DM / 256, nb, vcu, false, lastl, halftail ? nun - extra : nun}; Epi2Out E{p.ws, l};
  pg8::gemm_phase<false>(LDS3, g, S, E);
  if (halftail) { SchedDenseTail T{DM / 256, nun - extra, 2 * extra, vcu}; pg8::gemm_phase<false, true>(LDS3, g, T, E); }
  if (l + 1 < DEPTH) {
    const int busy = halftail ? 2 * extra : extra;
    if (busy == 0) { ph_mod(p, l + 1, lds, vcu, nb); ph_wconv_dense(p, l + 1, lds, vcu, nb); }
    else if (vcu >= busy) { ph_mod(p, l + 1, lds, vcu - busy, nb - busy); ph_wconv_dense(p, l + 1, lds, vcu - busy, nb - busy); }
  }
}
__device__ __forceinline__ void ph2_moe_up(const Prm& p, int l, unsigned char* lds, int bid, int nb) {
  pg8::Gemm g{(const bf16_t*)(p.ws + OFF_R + R_H), WSP(bf16_t, OFF_WGU), DM, WSP(int, OFF_IDX)};
  const bool halftail = (l != DEPTH - 1) && nb >= 256;
  SchedMoe S{(l == DEPTH - 1 || halftail) ? 256 : 272, nb, vcu_of(bid, nb), (size_t)1024 * 1024 * 2}; Epi2MoeUp E{p.ws};
  pg8::gemm_phase<true>(LDS3, g, S, E);
  if (halftail) { SchedMoeTail T{vcu_of(bid, nb), (size_t)1024 * 1024 * 2}; pg8::gemm_phase<true, true>(LDS3, g, T, E); }
}
__device__ __forceinline__ void ph2_moe_down(const Prm& p, int l, unsigned char* lds, int bid, int nb) {
  pg8::Gemm g{(const bf16_t*)(p.ws + OFF_R + R_ACT), WSP(bf16_t, OFF_WD), DFF, nullptr};
  const bool halftail = (l != DEPTH - 1) && nb >= 256;
  SchedMoe S{(l == DEPTH - 1 || halftail) ? 256 : 272, nb, vcu_of(bid, nb), (size_t)1024 * 512 * 2}; Epi2MoeDown E{p.ws};
  pg8::gemm_phase<false>(LDS3, g, S, E);
  if (halftail) { SchedMoeTail T{vcu_of(bid, nb), (size_t)1024 * 512 * 2}; pg8::gemm_phase<false, true>(LDS3, g, T, E); }
}

template <int DQK>
__device__ __forceinline__ void attn_naive_unit(const Prm& p, int l, int kind, int b, int hd, int qblk, unsigned char* lds) {
  float* Ks = (float*)lds;
  float* Vs = Ks + 32 * DQK;
  const int tid = TIDX;
  const bool isB = (kind == 0 || kind == 2), isctx = kind >= 2;
  const int nq = isctx ? LC : SEQ; const int qi = qblk * NTHR + tid; const bool qvalid = qi < nq;
  const int qrow = b * TT + (isctx ? 0 : LC) + (qvalid ? qi : 0);
  float q[DQK];
  { const bf16_t* qp = isB ? (const bf16_t*)(p.ws + OFF_R + R_QB) + (size_t)qrow * NQB + hd * 96 : (const bf16_t*)(p.ws + OFF_R + R_QA) + (size_t)qrow * 512 + hd * 64;
#pragma unroll
    for (int d = 0; d < DQK; ++d) q[d] = bf2f(qp[d]); }
  float m = -1e30f, lsum = 0.f, o[64];
#pragma unroll
  for (int d = 0; d < 64; ++d) o[d] = 0.f;
  const int q0 = qblk * NTHR;
  int klo = 0, khi = LC;
  if (!isctx) { if (isB) khi = TT; else { klo = max(0, q0 - 128); khi = min(SEQ, q0 + NTHR + 128); } }
  const int kvh = hd >> 2;
  for (int seg = 0; seg < 2; ++seg) {
    int t0, t1; if (seg == 0) { t0 = 0; t1 = LC; } else { if (isctx) break; if (isB) { t0 = LC; t1 = TT; } else { t0 = LC + klo; t1 = LC + khi; } }
    for (int tb = t0; tb < t1; tb += 32) {
      __syncthreads();
      {
        for (int i = tid; i < 32 * DQK; i += NTHR) { const int kk = i / DQK, d = i % DQK; const size_t kr = (size_t)(b * TT + tb + kk);
          float v;
          if (isB) v = d < 64 ? bf2f(((const bf16_t*)(p.ws + OFF_R + R_KB))[kr * 512 + hd * 64 + d]) : bf2f(WSP(bf16_t, OFF_KR)[kr * 32 + d - 64]);
          else v = bf2f(((const bf16_t*)(p.ws + OFF_R + R_KA))[kr * 128 + kvh * 64 + d]);
          Ks[i] = v; }
        for (int i = tid; i < 32 * 64; i += NTHR) { const int kk = i >> 6, d = i & 63; const size_t kr = (size_t)(b * TT + tb + kk);
          Vs[i] = isB ? bf2f(((const bf16_t*)(p.ws + OFF_R + R_VB))[kr * 512 + hd * 64 + d]) : bf2f(((const bf16_t*)(p.ws + OFF_R + R_VA))[kr * 128 + kvh * 64 + d]); }
      }
      __syncthreads();
      if (qvalid) {
        for (int kk = 0; kk < 32; ++kk) {
          if (!isB && seg == 1) { const int ts = tb + kk - LC; const int dlt = qi - ts; if (dlt > 128 || dlt < -128) continue; }
          float s = 0.f;
#pragma unroll
          for (int d = 0; d < DQK; ++d) s += q[d] * Ks[kk * DQK + d];
          if (s > m) { const float al = exp2f(m - s); lsum *= al;
#pragma unroll
            for (int d = 0; d < 64; ++d) o[d] *= al;
            m = s; }
          const float pe = exp2f(s - m); lsum += pe;
#pragma unroll
          for (int d = 0; d < 64; ++d) o[d] += pe * Vs[kk * 64 + d];
        }
      }
    }
  }
  if (qvalid) {
    if (!isB) { const float sk = p.sink[l * 8 + hd] * LOG2E; if (sk > m) { const float al = exp2f(m - sk); lsum = lsum * al + 1.f;
#pragma unroll
        for (int d = 0; d < 64; ++d) o[d] *= al; } else lsum += exp2f(sk - m); }
    const float il = 1.f / lsum;
    bf16_t* op = (bf16_t*)(p.ws + OFF_R + R_H) + (size_t)qrow * DM + (isB ? 512 : 0) + hd * 64;
#pragma unroll
    for (int d = 0; d < 64; ++d) op[d] = f2bf(o[d] * il);
  }
}
__device__ __forceinline__ void ph_attn_naive(const Prm& p, int l, unsigned char* lds, int bid, int nb) {
  const int nun = 1024 + (l == DEPTH - 1 ? 0 : 64);
  for (int u = bid; u < nun; u += nb) {
    int kind, b, hd, qb;
    if (u < 1024) { kind = u & 1; int r = u >> 1; qb = r & 15; r >>= 4; hd = r & 7; b = r >> 3; }
    else { const int r = u - 1024; kind = 2 + (r & 1); hd = (r >> 1) & 7; b = r >> 4; qb = 0; }
    if (kind == 0 || kind == 2) attn_naive_unit<96>(p, l, kind, b, hd, qb, lds); else attn_naive_unit<64>(p, l, kind, b, hd, qb, lds);
    __syncthreads();
  }
}

#define SBAR() __builtin_amdgcn_sched_barrier(0)
typedef short s16x4 __attribute__((ext_vector_type(4)));
__device__ __forceinline__ int crow(int r, int hi) { return (r & 3) + 8 * (r >> 2) + 4 * hi; }
__device__ __forceinline__ unsigned cvtpk(float lo, float hi) { unsigned r; asm volatile("v_cvt_pk_bf16_f32 %0, %1, %2" : "=v"(r) : "v"(lo), "v"(hi)); return r; }
constexpr float ATHR = 8.f;
__device__ __forceinline__ void partialSM(f32x16& p0, f32x16& p1, float& m_reg, float& alpha) {
  float pmax = p0[0];
#pragma unroll
  for (int r = 1; r < 16; ++r) pmax = fmaxf(pmax, p0[r]);
#pragma unroll
  for (int r = 0; r < 16; ++r) pmax = fmaxf(pmax, p1[r]);
  { auto rr = __builtin_amdgcn_permlane32_swap(__float_as_uint(pmax), __float_as_uint(pmax), false, false); pmax = fmaxf(__uint_as_float(rr[0]), __uint_as_float(rr[1])); }
  float mn;
  if (__builtin_expect(__all(pmax - m_reg <= ATHR), 1)) { mn = m_reg; alpha = 1.f; }
  else { mn = fmaxf(m_reg, pmax); alpha = __builtin_amdgcn_exp2f(m_reg - mn); m_reg = mn; }
#pragma unroll
  for (int r = 0; r < 16; ++r) { p0[r] -= mn; p1[r] -= mn; }
#pragma unroll
  for (int r = 0; r < 16; ++r) p0[r] = __builtin_amdgcn_exp2f(p0[r]);
}
__device__ __forceinline__ void finishSM(f32x16& p0, f32x16& p1, float alpha, float& l_reg, bf16x8& pa0, bf16x8& pa1, bf16x8& pa2, bf16x8& pa3) {
#pragma unroll
  for (int r = 0; r < 16; ++r) p1[r] = __builtin_amdgcn_exp2f(p1[r]);
  float ps = 0.f;
#pragma unroll
  for (int r = 0; r < 16; ++r) ps += p0[r];
#pragma unroll
  for (int r = 0; r < 16; ++r) ps += p1[r];
  { auto rr = __builtin_amdgcn_permlane32_swap(__float_as_uint(ps), __float_as_uint(ps), false, false); ps = __uint_as_float(rr[0]) + __uint_as_float(rr[1]); }
  l_reg = l_reg * alpha + ps;
#define PK4(P, BASE, OUT) do { unsigned a0 = cvtpk(P[BASE + 0], P[BASE + 1]), a1 = cvtpk(P[BASE + 2], P[BASE + 3]);   \
    unsigned b0 = cvtpk(P[BASE + 4], P[BASE + 5]), b1 = cvtpk(P[BASE + 6], P[BASE + 7]);                              \
    auto r0 = __builtin_amdgcn_permlane32_swap(a0, b0, false, false); auto r1 = __builtin_amdgcn_permlane32_swap(a1, b1, false, false); \
    u32x4 w = {r0[0], r1[0], r0[1], r1[1]}; OUT = *reinterpret_cast<bf16x8*>(&w); } while (0)
  PK4(p0, 0, pa0); PK4(p0, 8, pa1); PK4(p1, 0, pa2); PK4(p1, 8, pa3);
#undef PK4
}
template <int DQK>
__device__ __forceinline__ void qkt(f32x16& p0, f32x16& p1, const char* Ks, const bf16x8* qr, int r32, int hi) {
  constexpr int KST = DQK * 2 + 16;
  p0 = f32x16{}; p1 = f32x16{};
#pragma unroll
  for (int d0 = 0; d0 < DQK / 16; ++d0) { const int cb = (d0 * 16 + hi * 8) * 2;
    const bf16x8 b0 = *reinterpret_cast<const bf16x8*>(Ks + r32 * KST + cb);
    const bf16x8 b1 = *reinterpret_cast<const bf16x8*>(Ks + (32 + r32) * KST + cb);
    p0 = __builtin_amdgcn_mfma_f32_32x32x16_bf16(b0, qr[d0], p0, 0, 0, 0);
    p1 = __builtin_amdgcn_mfma_f32_32x32x16_bf16(b1, qr[d0], p1, 0, 0, 0); }
}
__device__ __forceinline__ int v_st(int k, int c) { const int kk = (k & ~0xC) | ((k & 4) << 1) | ((k & 8) >> 1); return ((kk >> 3) * 2 + (c >> 5)) * 512 + ((kk & 7) * 32 + (c & 31)) * 2; }
__device__ __forceinline__ int v_rd_base(int lane) { return ((lane & 3) << 3) | (((lane >> 2) & 3) << 6) | (((lane >> 4) & 1) << 5) | (((lane >> 5) & 1) << 8); }
constexpr int v_rd_off(int d0, int ks, int half) { return d0 * 512 + ks * 2048 + half * 1024; }
template <int OFF> __device__ __forceinline__ s16x4 tr_read(int vb) { s16x4 r; asm volatile("ds_read_b64_tr_b16 %0, %1 offset:%2" : "=&v"(r) : "v"(vb), "i"(OFF) : "memory"); return r; }
template <int D0> __device__ __forceinline__ void pv_one(f32x16& od, int vb, bf16x8 pa0, bf16x8 pa1, bf16x8 pa2, bf16x8 pa3) {
  const s16x4 l0 = tr_read<v_rd_off(D0, 0, 0)>(vb), h0 = tr_read<v_rd_off(D0, 0, 1)>(vb), l1 = tr_read<v_rd_off(D0, 1, 0)>(vb), h1 = tr_read<v_rd_off(D0, 1, 1)>(vb);
  const s16x4 l2 = tr_read<v_rd_off(D0, 2, 0)>(vb), h2 = tr_read<v_rd_off(D0, 2, 1)>(vb), l3 = tr_read<v_rd_off(D0, 3, 0)>(vb), h3 = tr_read<v_rd_off(D0, 3, 1)>(vb);
  asm volatile("s_waitcnt lgkmcnt(0)" ::: "memory"); SBAR();
#define PK(L, H) (bf16x8){L[0], L[1], L[2], L[3], H[0], H[1], H[2], H[3]}
  od = __builtin_amdgcn_mfma_f32_32x32x16_bf16(pa0, PK(l0, h0), od, 0, 0, 0);
  od = __builtin_amdgcn_mfma_f32_32x32x16_bf16(pa1, PK(l1, h1), od, 0, 0, 0);
  od = __builtin_amdgcn_mfma_f32_32x32x16_bf16(pa2, PK(l2, h2), od, 0, 0, 0);
  od = __builtin_amdgcn_mfma_f32_32x32x16_bf16(pa3, PK(l3, h3), od, 0, 0, 0);
#undef PK
}
__device__ __forceinline__ void pv_all(f32x16* o, int vb, bf16x8 pa0, bf16x8 pa1, bf16x8 pa2, bf16x8 pa3) { pv_one<0>(o[0], vb, pa0, pa1, pa2, pa3); pv_one<1>(o[1], vb, pa0, pa1, pa2, pa3); }

template <int KIND>
__device__ __forceinline__ void attn_fast_unit(const Prm& p, int l, bool isctx, int b, int hd, int qb, unsigned char* ldsu) {
  constexpr int DQK = KIND == 0 ? 96 : 64, KST = DQK * 2 + 16, SHM_K = 64 * KST, SHM_V = 8192, LPT = KIND == 0 ? 3 : 2;
  char* lds = (char*)ldsu;
  const int tid = TIDX, wid = tid >> 6, lane = tid & 63, r32 = lane & 31, hi = lane >> 5;
  char* V_lds = lds; char* K_lds = lds + 2 * SHM_V;
  float* ws = (float*)(lds + 2 * SHM_V + 2 * SHM_K) + wid * 64; float* li_l = ws; float* al_l = ws + 32;
  const int q0 = qb * 256;
  const size_t rowq0 = (size_t)b * TT + (isctx ? 0 : LC) + q0;
  const bf16_t *Qp, *Kp, *Vp; const bf16_t* KRp = WSP(bf16_t, OFF_KR); int ldq, ldk; int ocol;
  if (KIND == 0) { Qp = (const bf16_t*)(p.ws + OFF_R + R_QB) + hd * 96; ldq = NQB; Kp = (const bf16_t*)(p.ws + OFF_R + R_KB) + hd * 64; Vp = (const bf16_t*)(p.ws + OFF_R + R_VB) + hd * 64; ldk = 512; ocol = 512 + hd * 64; }
  else { Qp = (const bf16_t*)(p.ws + OFF_R + R_QA) + hd * 64; ldq = 512; Kp = (const bf16_t*)(p.ws + OFF_R + R_KA) + (hd >> 2) * 64; Vp = (const bf16_t*)(p.ws + OFF_R + R_VA) + (hd >> 2) * 64; ldk = 128; ocol = hd * 64; }
  int NT, kshift = 0; bool domask = false;
  if (isctx) NT = 4; else if (KIND == 0) NT = TT / 64; else { const int ks = max(0, q0 - 128), ke = min(SEQ, q0 + 384); NT = 4 + (ke - ks) / 64; kshift = ks; domask = true; }
  const size_t kb0 = (size_t)b * TT;
  float m_reg = -1e30f, l_reg = 0.f; f32x16 o[2] = {}; bf16x8 qr[DQK / 16];
  { const bf16_t* Qw = Qp + (rowq0 + wid * 32 + r32) * ldq + hi * 8;
#pragma unroll
    for (int d0 = 0; d0 < DQK / 16; ++d0) qr[d0] = *reinterpret_cast<const bf16x8*>(Qw + d0 * 16); }
  const int sr = tid >> 3, sc = (tid & 7) * 8, vst = v_st(sr, sc), kst = sr * KST + sc * 2;
  const int rr_ = (tid & 255) >> 2, rc_ = (tid & 3) * 8, krst = rr_ * KST + 128 + rc_ * 2;
  const int vb0 = (int)(uintptr_t)V_lds + v_rd_base(lane);
  struct { bf16x8 v, k, kr; } st_[2];
#define KROW(j) (kb0 + (size_t)(j) * 64 + ((j) >= 4 ? kshift : 0))
#define SLOAD(i, j) do { const size_t kr0_ = KROW(j); st_[i].v = *reinterpret_cast<const bf16x8*>(Vp + (kr0_ + sr) * ldk + sc); st_[i].k = *reinterpret_cast<const bf16x8*>(Kp + (kr0_ + sr) * ldk + sc); \
    if (KIND == 0) st_[i].kr = *reinterpret_cast<const bf16x8*>(KRp + (kr0_ + rr_) * 32 + rc_); } while (0)
#define SWRITE(bf, i) do { *(bf16x8*)(V_lds + (bf) * SHM_V + vst) = st_[i].v; *(bf16x8*)(K_lds + (bf) * SHM_K + kst) = st_[i].k; \
    if (KIND == 0) { if (tid < 256) *(bf16x8*)(K_lds + (bf) * SHM_K + krst) = st_[i].kr; } } while (0)
#define SWAIT() do { if (LPT == 3) asm volatile("s_waitcnt vmcnt(3)" ::: "memory"); else asm volatile("s_waitcnt vmcnt(2)" ::: "memory"); } while (0)
#define RESC(a) do { if (__any((a) < 1.f)) { if (hi == 0) al_l[r32] = (a); asm volatile("s_waitcnt lgkmcnt(0)" ::: "memory"); \
    _Pragma("unroll") for (int d = 0; d < 2; ++d) _Pragma("unroll") for (int r = 0; r < 16; ++r) o[d][r] *= al_l[crow(r, hi)]; } } while (0)
#define AMASK(P0, P1, j) do { if (KIND == 1) { if (domask && (j) >= 4) { const int tq_ = q0 + wid * 32 + r32; const int tk_ = kshift + ((j) - 4) * 64 + 4 * hi; \
    _Pragma("unroll") for (int r = 0; r < 16; ++r) { const int d_ = tq_ - (tk_ + (r & 3) + 8 * (r >> 2)); if (d_ > 128 || d_ < -128) P0[r] = -INFINITY; if (d_ - 32 > 128 || d_ - 32 < -128) P1[r] = -INFINITY; } } } } while (0)
  f32x16 pA0, pA1, pB0, pB1; float alA, alB; bf16x8 pa0, pa1, pa2, pa3;
  SLOAD(0, 0); asm volatile("s_waitcnt vmcnt(0)" ::: "memory"); SWRITE(0, 0); __syncthreads();
  qkt<DQK>(pA0, pA1, K_lds, qr, r32, hi); AMASK(pA0, pA1, 0); partialSM(pA0, pA1, m_reg, alA);
  SLOAD(1, 1); if (2 < NT) SLOAD(0, 2);
  SWAIT(); SWRITE(1, 1); __syncthreads();
  for (int j = 1; j + 1 < NT; j += 2) {
    SBAR(); qkt<DQK>(pB0, pB1, K_lds + SHM_K, qr, r32, hi);
    finishSM(pA0, pA1, alA, l_reg, pa0, pa1, pa2, pa3); SBAR();
    SLOAD(1, j + 2); SBAR();
    pv_all(o, vb0, pa0, pa1, pa2, pa3); AMASK(pB0, pB1, j); partialSM(pB0, pB1, m_reg, alB);
    __syncthreads(); SWAIT(); SWRITE(0, 0);
    RESC(alB); __syncthreads();
    SBAR(); qkt<DQK>(pA0, pA1, K_lds, qr, r32, hi);
    finishSM(pB0, pB1, alB, l_reg, pa0, pa1, pa2, pa3); SBAR();
    if (j + 3 < NT) SLOAD(0, j + 3); SBAR();
    pv_all(o, vb0 + SHM_V, pa0, pa1, pa2, pa3); AMASK(pA0, pA1, j + 1); partialSM(pA0, pA1, m_reg, alA);
    __syncthreads(); SWAIT(); SWRITE(1, 1);
    RESC(alA); __syncthreads();
  }
  SBAR(); qkt<DQK>(pB0, pB1, K_lds + SHM_K, qr, r32, hi);
  finishSM(pA0, pA1, alA, l_reg, pa0, pa1, pa2, pa3); SBAR();
  pv_all(o, vb0, pa0, pa1, pa2, pa3); AMASK(pB0, pB1, NT - 1); partialSM(pB0, pB1, m_reg, alB);
  __syncthreads(); RESC(alB);
  finishSM(pB0, pB1, alB, l_reg, pa0, pa1, pa2, pa3); SBAR();
  pv_all(o, vb0 + SHM_V, pa0, pa1, pa2, pa3);
  if (KIND == 1) l_reg += __builtin_amdgcn_exp2f(p.sink[l * 8 + hd] * LOG2E - m_reg);
  if (hi == 0) li_l[r32] = l_reg; asm volatile("s_waitcnt lgkmcnt(0)" ::: "memory");
  float rli[16];
#pragma unroll
  for (int r = 0; r < 16; ++r) rli[r] = __builtin_amdgcn_rcpf(li_l[crow(r, hi)]);
  bf16_t* Ow = (bf16_t*)(p.ws + OFF_R + R_H) + (rowq0 + wid * 32) * DM + ocol;
#pragma unroll
  for (int r = 0; r < 16; ++r) { const int orow = crow(r, hi);
#pragma unroll
    for (int d0 = 0; d0 < 2; ++d0) Ow[(size_t)orow * DM + d0 * 32 + r32] = f2bf(o[d0][r] * rli[r]); }
  __syncthreads();
#undef KROW
#undef SLOAD
#undef SWRITE
#undef SWAIT
#undef RESC
#undef AMASK
}
__device__ __forceinline__ float max3f_(float a, float b, float c) { return fmaxf(fmaxf(a, b), c); }
template <bool FIRST>
__device__ __forceinline__ void psm2(f32x16& p0, f32x16& p1, float& mhat, f32x16& negm, float& alpha) {
  float a = max3f_(p0[0], p0[1], p1[0]), b = max3f_(p0[2], p0[3], p1[1]); a = max3f_(a, p1[2], p1[3]);
#pragma unroll
  for (int r = 4; r < 16; r += 4) { a = max3f_(a, p0[r], p0[r + 1]); b = max3f_(b, p0[r + 2], p0[r + 3]); a = max3f_(a, p1[r], p1[r + 1]); b = max3f_(b, p1[r + 2], p1[r + 3]); }
  float rm = fmaxf(a, b);
  { auto rr = __builtin_amdgcn_permlane32_swap(__float_as_uint(rm), __float_as_uint(rm), false, false); rm = fmaxf(__uint_as_float(rr[0]), __uint_as_float(rr[1])); }
  alpha = 1.f;
  if (FIRST || __builtin_expect(__any(rm > ATHR), 0)) {
    const float dl = FIRST ? rm : fmaxf(rm, 0.f);
    mhat += dl;
#pragma unroll
    for (int r = 0; r < 16; ++r) { p0[r] -= dl; p1[r] -= dl; }
    const float nm = -mhat;
#pragma unroll
    for (int r = 0; r < 16; ++r) negm[r] = nm;
    alpha = __builtin_amdgcn_exp2f(-dl);
  }
#pragma unroll
  for (int r = 0; r < 16; ++r) p0[r] = __builtin_amdgcn_exp2f(p0[r]);
}
template <bool FIRST>
__device__ __forceinline__ void psm2q(f32x16& p0, f32x16& p1, float& mhat, f32x16& negm, float& alpha, float& lsum) {
  float a = max3f_(p0[0], p0[1], p1[0]), b = max3f_(p0[2], p0[3], p1[1]); a = max3f_(a, p1[2], p1[3]);
#pragma unroll
  for (int r = 4; r < 16; r += 4) { a = max3f_(a, p0[r], p0[r + 1]); b = max3f_(b, p0[r + 2], p0[r + 3]); a = max3f_(a, p1[r], p1[r + 1]); b = max3f_(b, p1[r + 2], p1[r + 3]); }
  float rm = fmaxf(a, b);
  { auto rr = __builtin_amdgcn_permlane32_swap(__float_as_uint(rm), __float_as_uint(rm), false, false); rm = fmaxf(__uint_as_float(rr[0]), __uint_as_float(rr[1])); }
  alpha = 1.f;
  if (FIRST || __builtin_expect(__any(rm > ATHR), 0)) {
    const float dl = FIRST ? rm : fmaxf(rm, 0.f);
    mhat += dl;
#pragma unroll
    for (int r = 0; r < 16; ++r) { p0[r] -= dl; p1[r] -= dl; }
    const float nm = -mhat;
#pragma unroll
    for (int r = 0; r < 16; ++r) negm[r] = nm;
    alpha = __builtin_amdgcn_exp2f(-dl);
  }
  float s0 = 0.f, s1 = 0.f;
#pragma unroll
  for (int r = 0; r < 16; r += 2) { p0[r] = __builtin_amdgcn_exp2f(p0[r]); s0 += p0[r]; p0[r + 1] = __builtin_amdgcn_exp2f(p0[r + 1]); s1 += p0[r + 1]; }
  lsum = FIRST ? (s0 + s1) : lsum * alpha + (s0 + s1);
}
__device__ __forceinline__ void fsm2(f32x16& p0, f32x16& p1, bf16x8& pa0, bf16x8& pa1, bf16x8& pa2, bf16x8& pa3) {
#pragma unroll
  for (int r = 0; r < 16; ++r) p1[r] = __builtin_amdgcn_exp2f(p1[r]);
#define PK4(P, BASE, OUT) do { unsigned a0 = cvtpk(P[BASE + 0], P[BASE + 1]), a1 = cvtpk(P[BASE + 2], P[BASE + 3]);   \
    unsigned b0 = cvtpk(P[BASE + 4], P[BASE + 5]), b1 = cvtpk(P[BASE + 6], P[BASE + 7]);                              \
    auto r0 = __builtin_amdgcn_permlane32_swap(a0, b0, false, false); auto r1 = __builtin_amdgcn_permlane32_swap(a1, b1, false, false); \
    u32x4 w = {r0[0], r1[0], r0[1], r1[1]}; OUT = *reinterpret_cast<bf16x8*>(&w); } while (0)
  PK4(p0, 0, pa0); PK4(p0, 8, pa1); PK4(p1, 0, pa2); PK4(p1, 8, pa3);
#undef PK4
}
template <int DQK>
__device__ __forceinline__ void qkt2(f32x16& p0, f32x16& p1, const char* Ks, const bf16x8* qr, const f32x16& negm, int r32, int hi) {
  constexpr int KST = DQK * 2 + 16, ND = DQK / 16;
  bf16x8 kb0[ND], kb1[ND];
#pragma unroll
  for (int d0 = 0; d0 < ND; ++d0) { const int cb = (d0 * 16 + hi * 8) * 2;
    kb0[d0] = *reinterpret_cast<const bf16x8*>(Ks + r32 * KST + cb); kb1[d0] = *reinterpret_cast<const bf16x8*>(Ks + (32 + r32) * KST + cb); }
#pragma unroll
  for (int d0 = 0; d0 < ND; ++d0) {
    if (d0 == 0) { p0 = __builtin_amdgcn_mfma_f32_32x32x16_bf16(kb0[0], qr[0], negm, 0, 0, 0); p1 = __builtin_amdgcn_mfma_f32_32x32x16_bf16(kb1[0], qr[0], negm, 0, 0, 0); }
    else { p0 = __builtin_amdgcn_mfma_f32_32x32x16_bf16(kb0[d0], qr[d0], p0, 0, 0, 0); p1 = __builtin_amdgcn_mfma_f32_32x32x16_bf16(kb1[d0], qr[d0], p1, 0, 0, 0); } }
}
__device__ __forceinline__ void pv_all2(f32x16* o, int vb, bf16x8 pa0, bf16x8 pa1, bf16x8 pa2, bf16x8 pa3) {
  pv_one<0>(o[0], vb, pa0, pa1, pa2, pa3); pv_one<1>(o[1], vb, pa0, pa1, pa2, pa3);
  const bf16x8 ones = {16256, 16256, 16256, 16256, 16256, 16256, 16256, 16256};
  o[2] = __builtin_amdgcn_mfma_f32_32x32x16_bf16(pa0, ones, o[2], 0, 0, 0); o[2] = __builtin_amdgcn_mfma_f32_32x32x16_bf16(pa1, ones, o[2], 0, 0, 0);
  o[2] = __builtin_amdgcn_mfma_f32_32x32x16_bf16(pa2, ones, o[2], 0, 0, 0); o[2] = __builtin_amdgcn_mfma_f32_32x32x16_bf16(pa3, ones, o[2], 0, 0, 0);
}
template <int KIND>
__device__ __forceinline__ void attn_fast_unit2(const Prm& p, int l, bool isctx, int b, int hd, int qb, unsigned char* ldsu) {
  constexpr int DQK = KIND == 0 ? 96 : 64, KST = DQK * 2 + 16, SHM_K = 64 * KST, SHM_V = 8192, LPT = KIND == 0 ? 3 : 2;
  char* lds = (char*)ldsu;
  const int tid = TIDX, wid = tid >> 6, lane = tid & 63, r32 = lane & 31, hi = lane >> 5;
  char* V_lds = lds; char* K_lds = lds + 2 * SHM_V;
  float* ws = (float*)(lds + 2 * SHM_V + 2 * SHM_K) + wid * 64; float* li_l = ws; float* al_l = ws + 32;
  const int q0 = qb * 256;
  const size_t rowq0 = (size_t)b * TT + (isctx ? 0 : LC) + q0;
  const bf16_t *Qp, *Kp, *Vp; const bf16_t* KRp = WSP(bf16_t, OFF_KR); int ldq, ldk; int ocol;
  if (KIND == 0) { Qp = (const bf16_t*)(p.ws + OFF_R + R_QB) + hd * 96; ldq = NQB; Kp = (const bf16_t*)(p.ws + OFF_R + R_KB) + hd * 64; Vp = (const bf16_t*)(p.ws + OFF_R + R_VB) + hd * 64; ldk = 512; ocol = 512 + hd * 64; }
  else { Qp = (const bf16_t*)(p.ws + OFF_R + R_QA) + hd * 64; ldq = 512; Kp = (const bf16_t*)(p.ws + OFF_R + R_KA) + (hd >> 2) * 64; Vp = (const bf16_t*)(p.ws + OFF_R + R_VA) + (hd >> 2) * 64; ldk = 128; ocol = hd * 64; }
  int NT, kshift = 0; bool domask = false;
  if (isctx) NT = 4; else if (KIND == 0) NT = TT / 64; else { const int ks = max(0, q0 - 128), ke = min(SEQ, q0 + 384); NT = 4 + (ke - ks) / 64; kshift = ks; domask = true; }
  const size_t kb0 = (size_t)b * TT;
  float mhat = 0.f; f32x16 o[3] = {}; f32x16 negm = {}; bf16x8 qr[DQK / 16];
  { const bf16_t* Qw = Qp + (rowq0 + wid * 32 + r32) * ldq + hi * 8;
#pragma unroll
    for (int d0 = 0; d0 < DQK / 16; ++d0) qr[d0] = *reinterpret_cast<const bf16x8*>(Qw + d0 * 16); }
  const int sr = tid >> 3, sc = (tid & 7) * 8, vst = v_st(sr, sc), kst = sr * KST + sc * 2;
  const int rr_ = (tid & 255) >> 2, rc_ = (tid & 3) * 8, krst = rr_ * KST + 128 + rc_ * 2;
  const int vb0 = (int)(uintptr_t)V_lds + v_rd_base(lane);
  struct { bf16x8 v, k, kr; } st_[1];
#define KROW(j) (kb0 + (size_t)(j) * 64 + ((j) >= 4 ? kshift : 0))
  const unsigned voffs = (unsigned)(sr * ldk + sc) * 2u, kroffs = (unsigned)(rr_ * 32 + rc_) * 2u;
#define SLOAD(i, j) do { const size_t kr0_ = KROW(j); const char* vb_ = (const char*)(Vp + kr0_ * ldk); const char* kb_ = (const char*)(Kp + kr0_ * ldk); \
    st_[i].v = *reinterpret_cast<const bf16x8*>(vb_ + voffs); st_[i].k = *reinterpret_cast<const bf16x8*>(kb_ + voffs); \
    if (KIND == 0) { const char* rb_ = (const char*)(KRp + kr0_ * 32); st_[i].kr = *reinterpret_cast<const bf16x8*>(rb_ + kroffs); } } while (0)
#define SWRITE(bf, i) do { *(bf16x8*)(V_lds + (bf) * SHM_V + vst) = st_[i].v; *(bf16x8*)(K_lds + (bf) * SHM_K + kst) = st_[i].k; \
    if (KIND == 0) { if (tid < 256) *(bf16x8*)(K_lds + (bf) * SHM_K + krst) = st_[i].kr; } } while (0)
#define SWAIT() do { if (LPT == 3) asm volatile("s_waitcnt vmcnt(3)" ::: "memory"); else asm volatile("s_waitcnt vmcnt(2)" ::: "memory"); } while (0)
#define RESC(a) do { if (__any((a) < 1.f)) { if (hi == 0) al_l[r32] = (a); asm volatile("s_waitcnt lgkmcnt(0)" ::: "memory"); \
    _Pragma("unroll") for (int d = 0; d < 3; ++d) _Pragma("unroll") for (int r = 0; r < 16; ++r) o[d][r] *= al_l[crow(r, hi)]; } } while (0)
#define AMASK(P0, P1, j) do { if (KIND == 1) { if (domask && (j) >= 4) { const int tq_ = q0 + wid * 32 + r32; const int tk_ = kshift + ((j) - 4) * 64 + 4 * hi; \
    _Pragma("unroll") for (int r = 0; r < 16; ++r) { const int d_ = tq_ - (tk_ + (r & 3) + 8 * (r >> 2)); if (d_ > 128 || d_ < -128) P0[r] = -INFINITY; if (d_ - 32 > 128 || d_ - 32 < -128) P1[r] = -INFINITY; } } } } while (0)
  if (__builtin_amdgcn_readfirstlane(wid) >= 4) __builtin_amdgcn_s_setprio(1);
  f32x16 pA0, pA1, pB0, pB1; float alA, alB; bf16x8 pa0, pa1, pa2, pa3;
  const int wq0_ = q0 + __builtin_amdgcn_readfirstlane(wid) * 32;
#define TACT(j) (KIND != 1 || !domask || (j) < 4 || (kshift + ((j) - 4) * 64 + 63 >= wq0_ - 128 && kshift + ((j) - 4) * 64 <= wq0_ + 31 + 128))
  bool actA, actB;
  SLOAD(0, 0); asm volatile("s_waitcnt vmcnt(0)" ::: "memory"); SWRITE(0, 0); __syncthreads();
  actA = true; qkt2<DQK>(pA0, pA1, K_lds, qr, negm, r32, hi); AMASK(pA0, pA1, 0); psm2<true>(pA0, pA1, mhat, negm, alA);
  SLOAD(0, 1);
  SWRITE(1, 0); __syncthreads();
  for (int j = 1; j + 1 < NT; j += 2) {
    actB = TACT(j);
    SBAR(); if (actB) qkt2<DQK>(pB0, pB1, K_lds + SHM_K, qr, negm, r32, hi);
    if (actA) fsm2(pA0, pA1, pa0, pa1, pa2, pa3); SBAR();
    SLOAD(0, j + 1); SBAR();
    if (actA) pv_all2(o, vb0, pa0, pa1, pa2, pa3); if (actB) { AMASK(pB0, pB1, j); psm2<false>(pB0, pB1, mhat, negm, alB); } else alB = 1.f;
    __syncthreads(); SWRITE(0, 0);
    RESC(alB); __syncthreads();
    actA = TACT(j + 1);
    SBAR(); if (actA) qkt2<DQK>(pA0, pA1, K_lds, qr, negm, r32, hi);
    if (actB) fsm2(pB0, pB1, pa0, pa1, pa2, pa3); SBAR();
    SLOAD(0, j + 2); SBAR();
    if (actB) pv_all2(o, vb0 + SHM_V, pa0, pa1, pa2, pa3); if (actA) { AMASK(pA0, pA1, j + 1); psm2<false>(pA0, pA1, mhat, negm, alA); } else alA = 1.f;
    __syncthreads(); SWRITE(1, 0);
    RESC(alA); __syncthreads();
  }
  actB = TACT(NT - 1);
  SBAR(); if (actB) qkt2<DQK>(pB0, pB1, K_lds + SHM_K, qr, negm, r32, hi);
  if (actA) fsm2(pA0, pA1, pa0, pa1, pa2, pa3); SBAR();
  if (actA) pv_all2(o, vb0, pa0, pa1, pa2, pa3); if (actB) { AMASK(pB0, pB1, NT - 1); psm2<false>(pB0, pB1, mhat, negm, alB); } else alB = 1.f;
  __syncthreads(); RESC(alB);
  if (actB) { fsm2(pB0, pB1, pa0, pa1, pa2, pa3); SBAR();
    pv_all2(o, vb0 + SHM_V, pa0, pa1, pa2, pa3); }
  __builtin_amdgcn_s_setprio(0);
  float rli[16];
  if (KIND == 1) { if (hi == 0) li_l[r32] = mhat; asm volatile("s_waitcnt lgkmcnt(0)" ::: "memory"); const float sk2 = p.sink[l * 8 + hd] * LOG2E;
#pragma unroll
    for (int r = 0; r < 16; ++r) rli[r] = __builtin_amdgcn_rcpf(o[2][r] + __builtin_amdgcn_exp2f(sk2 - li_l[crow(r, hi)])); }
  else {
#pragma unroll
    for (int r = 0; r < 16; ++r) rli[r] = __builtin_amdgcn_rcpf(o[2][r]); }
  bf16_t* Ow = (bf16_t*)(p.ws + OFF_R + R_H) + (rowq0 + wid * 32) * DM + ocol;
#pragma unroll
  for (int r = 0; r < 16; ++r) { const int orow = crow(r, hi);
#pragma unroll
    for (int d0 = 0; d0 < 2; ++d0) Ow[(size_t)orow * DM + d0 * 32 + r32] = f2bf(o[d0][r] * rli[r]); }
  __syncthreads();
#undef KROW
#undef SLOAD
#undef SWRITE
#undef SWAIT
#undef RESC
#undef AMASK
#undef TACT
}
#ifdef DBG_ATTN_PROBE
template <int KIND, int VAR>
__device__ __forceinline__ void attn_probe_unit(const Prm& p, int l, bool isctx, int b, int hd, int qb, unsigned char* ldsu) {
  constexpr int DQK = KIND == 0 ? 96 : 64, KST = DQK * 2 + 16, SHM_K = 64 * KST, SHM_V = 8192, LPT = KIND == 0 ? 3 : 2;
  char* lds = (char*)ldsu;
  const int tid = TIDX, wid = tid >> 6, lane = tid & 63, r32 = lane & 31, hi = lane >> 5;
  char* V_lds = lds; char* K_lds = lds + 2 * SHM_V;
  float* ws = (float*)(lds + 2 * SHM_V + 2 * SHM_K) + wid * 64; float* li_l = ws; float* al_l = ws + 32;
  const int q0 = qb * 256;
  const size_t rowq0 = (size_t)b * TT + (isctx ? 0 : LC) + q0;
  const bf16_t *Qp, *Kp, *Vp; const bf16_t* KRp = WSP(bf16_t, OFF_KR); int ldq, ldk; int ocol;
  if (KIND == 0) { Qp = (const bf16_t*)(p.ws + OFF_R + R_QB) + hd * 96; ldq = NQB; Kp = (const bf16_t*)(p.ws + OFF_R + R_KB) + hd * 64; Vp = (const bf16_t*)(p.ws + OFF_R + R_VB) + hd * 64; ldk = 512; ocol = 512 + hd * 64; }
  else { Qp = (const bf16_t*)(p.ws + OFF_R + R_QA) + hd * 64; ldq = 512; Kp = (const bf16_t*)(p.ws + OFF_R + R_KA) + (hd >> 2) * 64; Vp = (const bf16_t*)(p.ws + OFF_R + R_VA) + (hd >> 2) * 64; ldk = 128; ocol = hd * 64; }
  int NT, kshift = 0; bool domask = false;
  if (isctx) NT = 4; else if (KIND == 0) NT = TT / 64; else { const int ks = max(0, q0 - 128), ke = min(SEQ, q0 + 384); NT = 4 + (ke - ks) / 64; kshift = ks; domask = true; }
  const size_t kb0 = (size_t)b * TT;
  float mhat = 0.f; f32x16 o[3] = {}; f32x16 negm = {}; bf16x8 qr[DQK / 16];
  { const bf16_t* Qw = Qp + (rowq0 + wid * 32 + r32) * ldq + hi * 8;
#pragma unroll
    for (int d0 = 0; d0 < DQK / 16; ++d0) qr[d0] = *reinterpret_cast<const bf16x8*>(Qw + d0 * 16); }
  const int sr = tid >> 3, sc = (tid & 7) * 8, vst = v_st(sr, sc), kst = sr * KST + sc * 2;
  const int rr_ = (tid & 255) >> 2, rc_ = (tid & 3) * 8, krst = rr_ * KST + 128 + rc_ * 2;
  const int vb0 = (int)(uintptr_t)V_lds + v_rd_base(lane);
  struct { bf16x8 v, k, kr; } st_[1];
#define KROW(j) (kb0 + (size_t)(j) * 64 + ((j) >= 4 ? kshift : 0))
#define SLOAD(i, j) do { if (VAR & 4) break; const size_t kr0_ = KROW(j); st_[i].v = *reinterpret_cast<const bf16x8*>(Vp + (kr0_ + sr) * ldk + sc); st_[i].k = *reinterpret_cast<const bf16x8*>(Kp + (kr0_ + sr) * ldk + sc); \
    if (KIND == 0) st_[i].kr = *reinterpret_cast<const bf16x8*>(KRp + (kr0_ + rr_) * 32 + rc_); } while (0)
#define SWRITE(bf, i) do { if (VAR & 4) break; *(bf16x8*)(V_lds + (bf) * SHM_V + vst) = st_[i].v; *(bf16x8*)(K_lds + (bf) * SHM_K + kst) = st_[i].k; \
    if (KIND == 0) { if (tid < 256) *(bf16x8*)(K_lds + (bf) * SHM_K + krst) = st_[i].kr; } } while (0)
#define SWAIT() do { if (LPT == 3) asm volatile("s_waitcnt vmcnt(3)" ::: "memory"); else asm volatile("s_waitcnt vmcnt(2)" ::: "memory"); } while (0)
#define RESC(a) do { if (__any((a) < 1.f)) { if (hi == 0) al_l[r32] = (a); asm volatile("s_waitcnt lgkmcnt(0)" ::: "memory"); \
    _Pragma("unroll") for (int d = 0; d < 3; ++d) _Pragma("unroll") for (int r = 0; r < 16; ++r) o[d][r] *= al_l[crow(r, hi)]; } } while (0)
#define AMASK(P0, P1, j) do { if (KIND == 1) { if (domask && (j) >= 4) { const int tq_ = q0 + wid * 32 + r32; const int tk_ = kshift + ((j) - 4) * 64 + 4 * hi; \
    _Pragma("unroll") for (int r = 0; r < 16; ++r) { const int d_ = tq_ - (tk_ + (r & 3) + 8 * (r >> 2)); if (d_ > 128 || d_ < -128) P0[r] = -INFINITY; if (d_ - 32 > 128 || d_ - 32 < -128) P1[r] = -INFINITY; } } } } while (0)
  f32x16 pA0, pA1, pB0, pB1; float alA, alB; bf16x8 pa0, pa1, pa2, pa3;
  const int wq0_ = q0 + __builtin_amdgcn_readfirstlane(wid) * 32;
#define TACT(j) (KIND != 1 || !domask || (j) < 4 || (kshift + ((j) - 4) * 64 + 63 >= wq0_ - 128 && kshift + ((j) - 4) * 64 <= wq0_ + 31 + 128))
  bool actA, actB;
  SLOAD(0, 0); asm volatile("s_waitcnt vmcnt(0)" ::: "memory"); SWRITE(0, 0); do { if (!(VAR & 1)) __syncthreads(); } while (0);
  do { if (!(VAR & 16)) qkt2<DQK>(pA0, pA1, K_lds, qr, negm, r32, hi); else { pA0 = negm; pA1 = negm; asm volatile("" : "+v"(pA0), "+v"(pA1)); } } while (0); AMASK(pA0, pA1, 0); do { if (!(VAR & 2)) psm2<true>(pA0, pA1, mhat, negm, alA); else alA = 1.f; } while (0);
  SLOAD(0, 1);
  SWRITE(1, 0); do { if (!(VAR & 1)) __syncthreads(); } while (0);
  for (int j = 1; j + 1 < NT; j += 2) {
    SBAR(); do { if (!(VAR & 16)) qkt2<DQK>(pB0, pB1, K_lds + SHM_K, qr, negm, r32, hi); else { pB0 = negm; pB1 = negm; asm volatile("" : "+v"(pB0), "+v"(pB1)); } } while (0);
    do { if (!(VAR & 2)) fsm2(pA0, pA1, pa0, pa1, pa2, pa3); else { pa0 = __builtin_bit_cast(bf16x8, (f32x4){pA0[0], pA0[1], pA0[2], pA0[3]}); pa1 = __builtin_bit_cast(bf16x8, (f32x4){pA0[4], pA0[5], pA0[6], pA0[7]}); pa2 = __builtin_bit_cast(bf16x8, (f32x4){pA1[0], pA1[1], pA1[2], pA1[3]}); pa3 = __builtin_bit_cast(bf16x8, (f32x4){pA1[4], pA1[5], pA1[6], pA1[7]}); } } while (0); SBAR();
    SLOAD(0, j + 1); SBAR();
    do { if (!(VAR & 8)) pv_all2(o, vb0, pa0, pa1, pa2, pa3); else { asm volatile("" :: "v"(pa0), "v"(pa1), "v"(pa2), "v"(pa3)); } } while (0); AMASK(pB0, pB1, j); do { if (!(VAR & 2)) psm2<false>(pB0, pB1, mhat, negm, alB); else alB = 1.f; } while (0);
    do { if (!(VAR & 1)) __syncthreads(); } while (0); SWRITE(0, 0);
    RESC(alB); do { if (!(VAR & 1)) __syncthreads(); } while (0);
    SBAR(); do { if (!(VAR & 16)) qkt2<DQK>(pA0, pA1, K_lds, qr, negm, r32, hi); else { pA0 = negm; pA1 = negm; asm volatile("" : "+v"(pA0), "+v"(pA1)); } } while (0);
    do { if (!(VAR & 2)) fsm2(pB0, pB1, pa0, pa1, pa2, pa3); else { pa0 = __builtin_bit_cast(bf16x8, (f32x4){pB0[0], pB0[1], pB0[2], pB0[3]}); pa1 = __builtin_bit_cast(bf16x8, (f32x4){pB0[4], pB0[5], pB0[6], pB0[7]}); pa2 = __builtin_bit_cast(bf16x8, (f32x4){pB1[0], pB1[1], pB1[2], pB1[3]}); pa3 = __builtin_bit_cast(bf16x8, (f32x4){pB1[4], pB1[5], pB1[6], pB1[7]}); } } while (0); SBAR();
    SLOAD(0, j + 2); SBAR();
    do { if (!(VAR & 8)) pv_all2(o, vb0 + SHM_V, pa0, pa1, pa2, pa3); else { asm volatile("" :: "v"(pa0), "v"(pa1), "v"(pa2), "v"(pa3)); } } while (0); AMASK(pA0, pA1, j + 1); do { if (!(VAR & 2)) psm2<false>(pA0, pA1, mhat, negm, alA); else alA = 1.f; } while (0);
    do { if (!(VAR & 1)) __syncthreads(); } while (0); SWRITE(1, 0);
    RESC(alA); do { if (!(VAR & 1)) __syncthreads(); } while (0);
  }
  SBAR(); do { if (!(VAR & 16)) qkt2<DQK>(pB0, pB1, K_lds + SHM_K, qr, negm, r32, hi); else { pB0 = negm; pB1 = negm; asm volatile("" : "+v"(pB0), "+v"(pB1)); } } while (0);
  do { if (!(VAR & 2)) fsm2(pA0, pA1, pa0, pa1, pa2, pa3); else { pa0 = __builtin_bit_cast(bf16x8, (f32x4){pA0[0], pA0[1], pA0[2], pA0[3]}); pa1 = __builtin_bit_cast(bf16x8, (f32x4){pA0[4], pA0[5], pA0[6], pA0[7]}); pa2 = __builtin_bit_cast(bf16x8, (f32x4){pA1[0], pA1[1], pA1[2], pA1[3]}); pa3 = __builtin_bit_cast(bf16x8, (f32x4){pA1[4], pA1[5], pA1[6], pA1[7]}); } } while (0); SBAR();
  do { if (!(VAR & 8)) pv_all2(o, vb0, pa0, pa1, pa2, pa3); else { asm volatile("" :: "v"(pa0), "v"(pa1), "v"(pa2), "v"(pa3)); } } while (0); AMASK(pB0, pB1, NT - 1); do { if (!(VAR & 2)) psm2<false>(pB0, pB1, mhat, negm, alB); else alB = 1.f; } while (0);
  do { if (!(VAR & 1)) __syncthreads(); } while (0); RESC(alB);
  do { if (!(VAR & 2)) fsm2(pB0, pB1, pa0, pa1, pa2, pa3); else { pa0 = __builtin_bit_cast(bf16x8, (f32x4){pB0[0], pB0[1], pB0[2], pB0[3]}); pa1 = __builtin_bit_cast(bf16x8, (f32x4){pB0[4], pB0[5], pB0[6], pB0[7]}); pa2 = __builtin_bit_cast(bf16x8, (f32x4){pB1[0], pB1[1], pB1[2], pB1[3]}); pa3 = __builtin_bit_cast(bf16x8, (f32x4){pB1[4], pB1[5], pB1[6], pB1[7]}); } } while (0); SBAR();
  do { if (!(VAR & 8)) pv_all2(o, vb0 + SHM_V, pa0, pa1, pa2, pa3); else { asm volatile("" :: "v"(pa0), "v"(pa1), "v"(pa2), "v"(pa3)); } } while (0);
  float rli[16];
  if (KIND == 1) { if (hi == 0) li_l[r32] = mhat; asm volatile("s_waitcnt lgkmcnt(0)" ::: "memory"); const float sk2 = p.sink[l * 8 + hd] * LOG2E;
#pragma unroll
    for (int r = 0; r < 16; ++r) rli[r] = __builtin_amdgcn_rcpf(o[2][r] + __builtin_amdgcn_exp2f(sk2 - li_l[crow(r, hi)])); }
  else {
#pragma unroll
    for (int r = 0; r < 16; ++r) rli[r] = __builtin_amdgcn_rcpf(o[2][r]); }
  bf16_t* Ow = (bf16_t*)(p.ws + OFF_R + R_CQ) + ((rowq0 + wid * 32) & 16383) * DM + ocol;
#pragma unroll
  for (int r = 0; r < 16; ++r) { const int orow = crow(r, hi);
#pragma unroll
    for (int d0 = 0; d0 < 2; ++d0) Ow[(size_t)orow * DM + d0 * 32 + r32] = f2bf(o[d0][r] * rli[r]); }
  do { if (!(VAR & 1)) __syncthreads(); } while (0);
#undef KROW
#undef SLOAD
#undef SWRITE
#undef SWAIT
#undef RESC
#undef AMASK
#undef TACT
}

template <int VAR>
__device__ __forceinline__ void ph_attn_probe(const Prm& p, int l, unsigned char* lds, int bid, int nb) {
  const int nrounds = (1024 + nb - 1) / nb;
  for (int rd = 0; rd < nrounds; ++rd) { const int pair = rd * 8 + (bid & 7), qb = bid >> 3, u = pair * 32 + qb;
    if (u < 1024) attn_probe_unit<0, VAR>(p, l, false, u >> 8, (u >> 5) & 7, u & 31, lds); }
}
#endif
__device__ __forceinline__ int v_st_p(int k, int c) { return (c >> 5) * 4096 + (k >> 4) * 1024 + (k & 15) * 64 + (c & 31) * 2; }
__device__ __forceinline__ int v_rd_base_p(int lane) { return ((lane >> 4) & 1) * 32 + (lane & 3) * 8 + (4 * (lane >> 5) + ((lane & 15) >> 2)) * 64; }
constexpr int v_rd_off_p(int d0, int ks, int half) { return d0 * 4096 + ks * 1024 + half * 512; }
template <int D0> __device__ __forceinline__ void pv_one_p(f32x16& od, int vb, bf16x8 pa0, bf16x8 pa1, bf16x8 pa2, bf16x8 pa3) {
  const s16x4 l0 = tr_read<v_rd_off_p(D0, 0, 0)>(vb), h0 = tr_read<v_rd_off_p(D0, 0, 1)>(vb), l1 = tr_read<v_rd_off_p(D0, 1, 0)>(vb), h1 = tr_read<v_rd_off_p(D0, 1, 1)>(vb);
  const s16x4 l2 = tr_read<v_rd_off_p(D0, 2, 0)>(vb), h2 = tr_read<v_rd_off_p(D0, 2, 1)>(vb), l3 = tr_read<v_rd_off_p(D0, 3, 0)>(vb), h3 = tr_read<v_rd_off_p(D0, 3, 1)>(vb);
  asm volatile("s_waitcnt lgkmcnt(0)" ::: "memory"); SBAR();
#define PK(L, H) (bf16x8){L[0], L[1], L[2], L[3], H[0], H[1], H[2], H[3]}
  od = __builtin_amdgcn_mfma_f32_32x32x16_bf16(pa0, PK(l0, h0), od, 0, 0, 0);
  od = __builtin_amdgcn_mfma_f32_32x32x16_bf16(pa1, PK(l1, h1), od, 0, 0, 0);
  od = __builtin_amdgcn_mfma_f32_32x32x16_bf16(pa2, PK(l2, h2), od, 0, 0, 0);
  od = __builtin_amdgcn_mfma_f32_32x32x16_bf16(pa3, PK(l3, h3), od, 0, 0, 0);
#undef PK
}
__device__ __forceinline__ void pv_all2p(f32x16* o, int vb, bf16x8 pa0, bf16x8 pa1, bf16x8 pa2, bf16x8 pa3) {
  const s16x4 a0 = tr_read<v_rd_off_p(0, 0, 0)>(vb), b0 = tr_read<v_rd_off_p(0, 0, 1)>(vb), a1 = tr_read<v_rd_off_p(0, 1, 0)>(vb), b1 = tr_read<v_rd_off_p(0, 1, 1)>(vb);
  const s16x4 a2 = tr_read<v_rd_off_p(0, 2, 0)>(vb), b2 = tr_read<v_rd_off_p(0, 2, 1)>(vb), a3 = tr_read<v_rd_off_p(0, 3, 0)>(vb), b3 = tr_read<v_rd_off_p(0, 3, 1)>(vb);
  const s16x4 c0 = tr_read<v_rd_off_p(1, 0, 0)>(vb), d0 = tr_read<v_rd_off_p(1, 0, 1)>(vb), c1 = tr_read<v_rd_off_p(1, 1, 0)>(vb), d1 = tr_read<v_rd_off_p(1, 1, 1)>(vb);
  const s16x4 c2 = tr_read<v_rd_off_p(1, 2, 0)>(vb), d2 = tr_read<v_rd_off_p(1, 2, 1)>(vb), c3 = tr_read<v_rd_off_p(1, 3, 0)>(vb), d3 = tr_read<v_rd_off_p(1, 3, 1)>(vb);
  asm volatile("s_waitcnt lgkmcnt(0)" ::: "memory"); SBAR();
#define PK(L, H) (bf16x8){L[0], L[1], L[2], L[3], H[0], H[1], H[2], H[3]}
  const bf16x8 ones = {16256, 16256, 16256, 16256, 16256, 16256, 16256, 16256};
  o[0] = __builtin_amdgcn_mfma_f32_32x32x16_bf16(pa0, PK(a0, b0), o[0], 0, 0, 0); o[1] = __builtin_amdgcn_mfma_f32_32x32x16_bf16(pa0, PK(c0, d0), o[1], 0, 0, 0); o[2] = __builtin_amdgcn_mfma_f32_32x32x16_bf16(pa0, ones, o[2], 0, 0, 0);
  o[0] = __builtin_amdgcn_mfma_f32_32x32x16_bf16(pa1, PK(a1, b1), o[0], 0, 0, 0); o[1] = __builtin_amdgcn_mfma_f32_32x32x16_bf16(pa1, PK(c1, d1), o[1], 0, 0, 0); o[2] = __builtin_amdgcn_mfma_f32_32x32x16_bf16(pa1, ones, o[2], 0, 0, 0);
  o[0] = __builtin_amdgcn_mfma_f32_32x32x16_bf16(pa2, PK(a2, b2), o[0], 0, 0, 0); o[1] = __builtin_amdgcn_mfma_f32_32x32x16_bf16(pa2, PK(c2, d2), o[1], 0, 0, 0); o[2] = __builtin_amdgcn_mfma_f32_32x32x16_bf16(pa2, ones, o[2], 0, 0, 0);
  o[0] = __builtin_amdgcn_mfma_f32_32x32x16_bf16(pa3, PK(a3, b3), o[0], 0, 0, 0); o[1] = __builtin_amdgcn_mfma_f32_32x32x16_bf16(pa3, PK(c3, d3), o[1], 0, 0, 0); o[2] = __builtin_amdgcn_mfma_f32_32x32x16_bf16(pa3, ones, o[2], 0, 0, 0);
#undef PK
}
__device__ __forceinline__ void fsm2p(f32x16& p0, f32x16& p1, bf16x8& pa0, bf16x8& pa1, bf16x8& pa2, bf16x8& pa3) {
#pragma unroll
  for (int r = 0; r < 16; ++r) p1[r] = __builtin_amdgcn_exp2f(p1[r]);
#define PK8(P, BASE, OUT) do { u32x4 w = {cvtpk(P[BASE + 0], P[BASE + 1]), cvtpk(P[BASE + 2], P[BASE + 3]), cvtpk(P[BASE + 4], P[BASE + 5]), cvtpk(P[BASE + 6], P[BASE + 7])}; OUT = *reinterpret_cast<bf16x8*>(&w); } while (0)
  PK8(p0, 0, pa0); PK8(p0, 8, pa1); PK8(p1, 0, pa2); PK8(p1, 8, pa3);
#undef PK8
}
__device__ __forceinline__ void pv_all2q(f32x16* o, int vb, bf16x8 pa0, bf16x8 pa1, bf16x8 pa2, bf16x8 pa3) {
  const s16x4 a0 = tr_read<v_rd_off_p(0, 0, 0)>(vb), b0 = tr_read<v_rd_off_p(0, 0, 1)>(vb), a1 = tr_read<v_rd_off_p(0, 1, 0)>(vb), b1 = tr_read<v_rd_off_p(0, 1, 1)>(vb);
  const s16x4 a2 = tr_read<v_rd_off_p(0, 2, 0)>(vb), b2 = tr_read<v_rd_off_p(0, 2, 1)>(vb), a3 = tr_read<v_rd_off_p(0, 3, 0)>(vb), b3 = tr_read<v_rd_off_p(0, 3, 1)>(vb);
  const s16x4 c0 = tr_read<v_rd_off_p(1, 0, 0)>(vb), d0 = tr_read<v_rd_off_p(1, 0, 1)>(vb), c1 = tr_read<v_rd_off_p(1, 1, 0)>(vb), d1 = tr_read<v_rd_off_p(1, 1, 1)>(vb);
  const s16x4 c2 = tr_read<v_rd_off_p(1, 2, 0)>(vb), d2 = tr_read<v_rd_off_p(1, 2, 1)>(vb), c3 = tr_read<v_rd_off_p(1, 3, 0)>(vb), d3 = tr_read<v_rd_off_p(1, 3, 1)>(vb);
  asm volatile("s_waitcnt lgkmcnt(0)" ::: "memory"); SBAR();
#define PK(L, H) (bf16x8){L[0], L[1], L[2], L[3], H[0], H[1], H[2], H[3]}
  o[0] = __builtin_amdgcn_mfma_f32_32x32x16_bf16(pa0, PK(a0, b0), o[0], 0, 0, 0); o[1] = __builtin_amdgcn_mfma_f32_32x32x16_bf16(pa0, PK(c0, d0), o[1], 0, 0, 0);
  o[0] = __builtin_amdgcn_mfma_f32_32x32x16_bf16(pa1, PK(a1, b1), o[0], 0, 0, 0); o[1] = __builtin_amdgcn_mfma_f32_32x32x16_bf16(pa1, PK(c1, d1), o[1], 0, 0, 0);
  o[0] = __builtin_amdgcn_mfma_f32_32x32x16_bf16(pa2, PK(a2, b2), o[0], 0, 0, 0); o[1] = __builtin_amdgcn_mfma_f32_32x32x16_bf16(pa2, PK(c2, d2), o[1], 0, 0, 0);
  o[0] = __builtin_amdgcn_mfma_f32_32x32x16_bf16(pa3, PK(a3, b3), o[0], 0, 0, 0); o[1] = __builtin_amdgcn_mfma_f32_32x32x16_bf16(pa3, PK(c3, d3), o[1], 0, 0, 0);
#undef PK
}
__device__ __forceinline__ void fsm2q(f32x16& p0, f32x16& p1, bf16x8& pa0, bf16x8& pa1, bf16x8& pa2, bf16x8& pa3, float& lsum) {
#pragma unroll
  for (int r = 0; r < 16; r += 2) { p1[r] = __builtin_amdgcn_exp2f(p1[r]); lsum += p1[r]; p1[r + 1] = __builtin_amdgcn_exp2f(p1[r + 1]); lsum += p1[r + 1]; }
#define PK8(P, BASE, OUT) do { u32x4 w = {cvtpk(P[BASE + 0], P[BASE + 1]), cvtpk(P[BASE + 2], P[BASE + 3]), cvtpk(P[BASE + 4], P[BASE + 5]), cvtpk(P[BASE + 6], P[BASE + 7])}; OUT = *reinterpret_cast<bf16x8*>(&w); } while (0)
  PK8(p0, 0, pa0); PK8(p0, 8, pa1); PK8(p1, 0, pa2); PK8(p1, 8, pa3);
#undef PK8
}
template <int KIND>
__device__ __forceinline__ void attn_fast_unit2p(const Prm& p, int l, bool isctx, int b, int hd, int qb, unsigned char* ldsu) {
  constexpr int DQK = KIND == 0 ? 96 : 64, KST = DQK * 2 + 16, SHM_K = 64 * KST, SHM_V = 8192, LPT = KIND == 0 ? 3 : 2;
  char* lds = (char*)ldsu;
  const int tid = TIDX, wid = tid >> 6, lane = tid & 63, r32 = lane & 31, hi = lane >> 5;
  char* V_lds = lds; char* K_lds = lds + 2 * SHM_V;
  float* ws = (float*)(lds + 2 * SHM_V + 2 * SHM_K) + wid * 64; float* li_l = ws; float* al_l = ws + 32;
  const int q0 = qb * 256;
  const size_t rowq0 = (size_t)b * TT + (isctx ? 0 : LC) + q0;
  const bf16_t *Qp, *Kp, *Vp; const bf16_t* KRp = WSP(bf16_t, OFF_KR); int ldq, ldk; int ocol;
  if (KIND == 0) { Qp = (const bf16_t*)(p.ws + OFF_R + R_QB) + hd * 96; ldq = NQB; Kp = (const bf16_t*)(p.ws + OFF_R + R_KB) + hd * 64; Vp = (const bf16_t*)(p.ws + OFF_R + R_VB) + hd * 64; ldk = 512; ocol = 512 + hd * 64; }
  else { Qp = (const bf16_t*)(p.ws + OFF_R + R_QA) + hd * 64; ldq = 512; Kp = (const bf16_t*)(p.ws + OFF_R + R_KA) + (hd >> 2) * 64; Vp = (const bf16_t*)(p.ws + OFF_R + R_VA) + (hd >> 2) * 64; ldk = 128; ocol = hd * 64; }
  int NT, kshift = 0; bool domask = false;
  if (isctx) NT = 4; else if (KIND == 0) NT = TT / 64; else { const int ks = max(0, q0 - 128), ke = min(SEQ, q0 + 384); NT = 4 + (ke - ks) / 64; kshift = ks; domask = true; }
  const size_t kb0 = (size_t)b * TT;
  float mhat = 0.f, lsum = 0.f; f32x16 o[2] = {}; f32x16 negm = {}; bf16x8 qr[DQK / 16];
  { const bf16_t* Qw = Qp + (rowq0 + wid * 32 + r32) * ldq + hi * 8;
#pragma unroll
    for (int d0 = 0; d0 < DQK / 16; ++d0) qr[d0] = *reinterpret_cast<const bf16x8*>(Qw + d0 * 16); }
  const int sr = tid >> 3, sc = (tid & 7) * 8, vst = v_st_p(sr, sc), kst = sr * KST + sc * 2;
  const int rr_ = (tid & 255) >> 2, rc_ = (tid & 3) * 8, krst = rr_ * KST + 128 + rc_ * 2;
  const int vb0 = (int)(uintptr_t)V_lds + v_rd_base_p(lane);
  struct { bf16x8 v, k, kr; } st_[1];
#define KROW(j) (kb0 + (size_t)(j) * 64 + ((j) >= 4 ? kshift : 0))
  const unsigned voffs = (unsigned)(sr * ldk + sc) * 2u, kroffs = (unsigned)(rr_ * 32 + rc_) * 2u;
#define SLOAD(i, j) do { const size_t kr0_ = KROW(j); const char* vb_ = (const char*)(Vp + kr0_ * ldk); const char* kb_ = (const char*)(Kp + kr0_ * ldk); \
    st_[i].v = *reinterpret_cast<const bf16x8*>(vb_ + voffs); st_[i].k = *reinterpret_cast<const bf16x8*>(kb_ + voffs); \
    if (KIND == 0) { const char* rb_ = (const char*)(KRp + kr0_ * 32); st_[i].kr = *reinterpret_cast<const bf16x8*>(rb_ + kroffs); } } while (0)
#define SWRITE(bf, i) do { *(bf16x8*)(V_lds + (bf) * SHM_V + vst) = st_[i].v; *(bf16x8*)(K_lds + (bf) * SHM_K + kst) = st_[i].k; \
    if (KIND == 0) { if (tid < 256) *(bf16x8*)(K_lds + (bf) * SHM_K + krst) = st_[i].kr; } } while (0)
#define SWAIT() do { if (LPT == 3) asm volatile("s_waitcnt vmcnt(3)" ::: "memory"); else asm volatile("s_waitcnt vmcnt(2)" ::: "memory"); } while (0)
#define RESC(a) do { if (__any((a) < 1.f)) { if (hi == 0) al_l[r32] = (a); asm volatile("s_waitcnt lgkmcnt(0)" ::: "memory"); \
    _Pragma("unroll") for (int d = 0; d < 2; ++d) _Pragma("unroll") for (int r = 0; r < 16; ++r) o[d][r] *= al_l[crow(r, hi)]; } } while (0)
#define AMASK(P0, P1, j) do { if (KIND == 1) { if (domask && (j) >= 4) { const int tq_ = q0 + wid * 32 + r32; const int tk_ = kshift + ((j) - 4) * 64 + 4 * hi; \
    _Pragma("unroll") for (int r = 0; r < 16; ++r) { const int d_ = tq_ - (tk_ + (r & 3) + 8 * (r >> 2)); if (d_ > 128 || d_ < -128) P0[r] = -INFINITY; if (d_ - 32 > 128 || d_ - 32 < -128) P1[r] = -INFINITY; } } } } while (0)
  if (__builtin_amdgcn_readfirstlane(wid) >= 4) __builtin_amdgcn_s_setprio(1);
  f32x16 pA0, pA1, pB0, pB1; float alA, alB; bf16x8 pa0, pa1, pa2, pa3;
  const int wq0_ = q0 + __builtin_amdgcn_readfirstlane(wid) * 32;
#define TACT(j) (KIND != 1 || !domask || (j) < 4 || (kshift + ((j) - 4) * 64 + 63 >= wq0_ - 128 && kshift + ((j) - 4) * 64 <= wq0_ + 31 + 128))
  bool actA, actB;
  SLOAD(0, 0); asm volatile("s_waitcnt vmcnt(0)" ::: "memory"); SWRITE(0, 0); __syncthreads();
  actA = true; qkt2<DQK>(pA0, pA1, K_lds, qr, negm, r32, hi); AMASK(pA0, pA1, 0); psm2q<true>(pA0, pA1, mhat, negm, alA, lsum);
  SLOAD(0, 1);
  SWRITE(1, 0); __syncthreads();
  for (int j = 1; j + 1 < NT; j += 2) {
    actB = TACT(j);
    SBAR(); if (actB) qkt2<DQK>(pB0, pB1, K_lds + SHM_K, qr, negm, r32, hi);
    if (actA) fsm2q(pA0, pA1, pa0, pa1, pa2, pa3, lsum); SBAR();
    SLOAD(0, j + 1); SBAR();
    if (actA) pv_all2q(o, vb0, pa0, pa1, pa2, pa3); if (actB) { AMASK(pB0, pB1, j); psm2q<false>(pB0, pB1, mhat, negm, alB, lsum); } else alB = 1.f;
    __syncthreads(); SWRITE(0, 0);
    RESC(alB); __syncthreads();
    actA = TACT(j + 1);
    SBAR(); if (actA) qkt2<DQK>(pA0, pA1, K_lds, qr, negm, r32, hi);
    if (actB) fsm2q(pB0, pB1, pa0, pa1, pa2, pa3, lsum); SBAR();
    SLOAD(0, j + 2); SBAR();
    if (actB) pv_all2q(o, vb0 + SHM_V, pa0, pa1, pa2, pa3); if (actA) { AMASK(pA0, pA1, j + 1); psm2q<false>(pA0, pA1, mhat, negm, alA, lsum); } else alA = 1.f;
    __syncthreads(); SWRITE(1, 0);
    RESC(alA); __syncthreads();
  }
  actB = TACT(NT - 1);
  SBAR(); if (actB) qkt2<DQK>(pB0, pB1, K_lds + SHM_K, qr, negm, r32, hi);
  if (actA) fsm2q(pA0, pA1, pa0, pa1, pa2, pa3, lsum); SBAR();
  if (actA) pv_all2q(o, vb0, pa0, pa1, pa2, pa3); if (actB) { AMASK(pB0, pB1, NT - 1); psm2q<false>(pB0, pB1, mhat, negm, alB, lsum); } else alB = 1.f;
  __syncthreads(); RESC(alB);
  if (actB) { fsm2q(pB0, pB1, pa0, pa1, pa2, pa3, lsum); SBAR();
    pv_all2q(o, vb0 + SHM_V, pa0, pa1, pa2, pa3); }
  __builtin_amdgcn_s_setprio(0);
  const int lanee = TIDX & 63, r32e = lanee & 31, hie = lanee >> 5;
  float rli[16];
  { auto rr = __builtin_amdgcn_permlane32_swap(__float_as_uint(lsum), __float_as_uint(lsum), false, false); lsum = __uint_as_float(rr[0]) + __uint_as_float(rr[1]); }
  if (hie == 0) { al_l[r32e] = lsum; if (KIND == 1) li_l[r32e] = mhat; } asm volatile("s_waitcnt lgkmcnt(0)" ::: "memory");
  if (KIND == 1) { const float sk2 = p.sink[l * 8 + hd] * LOG2E;
#pragma unroll
    for (int r = 0; r < 16; ++r) rli[r] = __builtin_amdgcn_rcpf(al_l[crow(r, hie)] + __builtin_amdgcn_exp2f(sk2 - li_l[crow(r, hie)])); }
  else {
#pragma unroll
    for (int r = 0; r < 16; ++r) rli[r] = __builtin_amdgcn_rcpf(al_l[crow(r, hie)]); }
  bf16_t* Ow = (bf16_t*)(p.ws + OFF_R + R_H) + (rowq0 + wid * 32) * DM + ocol;
#pragma unroll
  for (int r = 0; r < 16; ++r) { const int orow = crow(r, hie);
#pragma unroll
    for (int d0 = 0; d0 < 2; ++d0) Ow[(size_t)orow * DM + d0 * 32 + r32e] = f2bf(o[d0][r] * rli[r]); }
  __syncthreads();
#undef KROW
#undef SLOAD
#undef SWRITE
#undef SWAIT
#undef RESC
#undef AMASK
#undef TACT
}
#ifdef DBG_ATTN_PROBE
template <int KIND, int VAR>
__device__ __forceinline__ void attn_probe_unit(const Prm& p, int l, bool isctx, int b, int hd, int qb, unsigned char* ldsu) {
  constexpr int DQK = KIND == 0 ? 96 : 64, KST = DQK * 2 + 16, SHM_K = 64 * KST, SHM_V = 8192, LPT = KIND == 0 ? 3 : 2;
  char* lds = (char*)ldsu;
  const int tid = TIDX, wid = tid >> 6, lane = tid & 63, r32 = lane & 31, hi = lane >> 5;
  char* V_lds = lds; char* K_lds = lds + 2 * SHM_V;
  float* ws = (float*)(lds + 2 * SHM_V + 2 * SHM_K) + wid * 64; float* li_l = ws; float* al_l = ws + 32;
  const int q0 = qb * 256;
  const size_t rowq0 = (size_t)b * TT + (isctx ? 0 : LC) + q0;
  const bf16_t *Qp, *Kp, *Vp; const bf16_t* KRp = WSP(bf16_t, OFF_KR); int ldq, ldk; int ocol;
  if (KIND == 0) { Qp = (const bf16_t*)(p.ws + OFF_R + R_QB) + hd * 96; ldq = NQB; Kp = (const bf16_t*)(p.ws + OFF_R + R_KB) + hd * 64; Vp = (const bf16_t*)(p.ws + OFF_R + R_VB) + hd * 64; ldk = 512; ocol = 512 + hd * 64; }
  else { Qp = (const bf16_t*)(p.ws + OFF_R + R_QA) + hd * 64; ldq = 512; Kp = (const bf16_t*)(p.ws + OFF_R + R_KA) + (hd >> 2) * 64; Vp = (const bf16_t*)(p.ws + OFF_R + R_VA) + (hd >> 2) * 64; ldk = 128; ocol = hd * 64; }
  int NT, kshift = 0; bool domask = false;
  if (isctx) NT = 4; else if (KIND == 0) NT = TT / 64; else { const int ks = max(0, q0 - 128), ke = min(SEQ, q0 + 384); NT = 4 + (ke - ks) / 64; kshift = ks; domask = true; }
  const size_t kb0 = (size_t)b * TT;
  float mhat = 0.f; f32x16 o[3] = {}; f32x16 negm = {}; bf16x8 qr[DQK / 16];
  { const bf16_t* Qw = Qp + (rowq0 + wid * 32 + r32) * ldq + hi * 8;
#pragma unroll
    for (int d0 = 0; d0 < DQK / 16; ++d0) qr[d0] = *reinterpret_cast<const bf16x8*>(Qw + d0 * 16); }
  const int sr = tid >> 3, sc = (tid & 7) * 8, vst = v_st_p(sr, sc), kst = sr * KST + sc * 2;
  const int rr_ = (tid & 255) >> 2, rc_ = (tid & 3) * 8, krst = rr_ * KST + 128 + rc_ * 2;
  const int vb0 = (int)(uintptr_t)V_lds + v_rd_base_p(lane);
  struct { bf16x8 v, k, kr; } st_[1];
#define KROW(j) (kb0 + (size_t)(j) * 64 + ((j) >= 4 ? kshift : 0))
#define SLOAD(i, j) do { if (VAR & 4) break; const size_t kr0_ = KROW(j); st_[i].v = *reinterpret_cast<const bf16x8*>(Vp + (kr0_ + sr) * ldk + sc); st_[i].k = *reinterpret_cast<const bf16x8*>(Kp + (kr0_ + sr) * ldk + sc); \
    if (KIND == 0) st_[i].kr = *reinterpret_cast<const bf16x8*>(KRp + (kr0_ + rr_) * 32 + rc_); } while (0)
#define SWRITE(bf, i) do { if (VAR & 4) break; *(bf16x8*)(V_lds + (bf) * SHM_V + vst) = st_[i].v; *(bf16x8*)(K_lds + (bf) * SHM_K + kst) = st_[i].k; \
    if (KIND == 0) { if (tid < 256) *(bf16x8*)(K_lds + (bf) * SHM_K + krst) = st_[i].kr; } } while (0)
#define SWAIT() do { if (LPT == 3) asm volatile("s_waitcnt vmcnt(3)" ::: "memory"); else asm volatile("s_waitcnt vmcnt(2)" ::: "memory"); } while (0)
#define RESC(a) do { if (__any((a) < 1.f)) { if (hi == 0) al_l[r32] = (a); asm volatile("s_waitcnt lgkmcnt(0)" ::: "memory"); \
    _Pragma("unroll") for (int d = 0; d < 3; ++d) _Pragma("unroll") for (int r = 0; r < 16; ++r) o[d][r] *= al_l[crow(r, hi)]; } } while (0)
#define AMASK(P0, P1, j) do { if (KIND == 1) { if (domask && (j) >= 4) { const int tq_ = q0 + wid * 32 + r32; const int tk_ = kshift + ((j) - 4) * 64 + 4 * hi; \
    _Pragma("unroll") for (int r = 0; r < 16; ++r) { const int d_ = tq_ - (tk_ + (r & 3) + 8 * (r >> 2)); if (d_ > 128 || d_ < -128) P0[r] = -INFINITY; if (d_ - 32 > 128 || d_ - 32 < -128) P1[r] = -INFINITY; } } } } while (0)
  f32x16 pA0, pA1, pB0, pB1; float alA, alB; bf16x8 pa0, pa1, pa2, pa3;
  const int wq0_ = q0 + __builtin_amdgcn_readfirstlane(wid) * 32;
#define TACT(j) (KIND != 1 || !domask || (j) < 4 || (kshift + ((j) - 4) * 64 + 63 >= wq0_ - 128 && kshift + ((j) - 4) * 64 <= wq0_ + 31 + 128))
  bool actA, actB;
  SLOAD(0, 0); asm volatile("s_waitcnt vmcnt(0)" ::: "memory"); SWRITE(0, 0); do { if (!(VAR & 1)) __syncthreads(); } while (0);
  do { if (!(VAR & 16)) qkt2<DQK>(pA0, pA1, K_lds, qr, negm, r32, hi); else { pA0 = negm; pA1 = negm; asm volatile("" : "+v"(pA0), "+v"(pA1)); } } while (0); AMASK(pA0, pA1, 0); do { if (!(VAR & 2)) psm2<true>(pA0, pA1, mhat, negm, alA); else alA = 1.f; } while (0);
  SLOAD(0, 1);
  SWRITE(1, 0); do { if (!(VAR & 1)) __syncthreads(); } while (0);
  for (int j = 1; j + 1 < NT; j += 2) {
    SBAR(); do { if (!(VAR & 16)) qkt2<DQK>(pB0, pB1, K_lds + SHM_K, qr, negm, r32, hi); else { pB0 = negm; pB1 = negm; asm volatile("" : "+v"(pB0), "+v"(pB1)); } } while (0);
    do { if (!(VAR & 2)) fsm2p(pA0, pA1, pa0, pa1, pa2, pa3); else { pa0 = __builtin_bit_cast(bf16x8, (f32x4){pA0[0], pA0[1], pA0[2], pA0[3]}); pa1 = __builtin_bit_cast(bf16x8, (f32x4){pA0[4], pA0[5], pA0[6], pA0[7]}); pa2 = __builtin_bit_cast(bf16x8, (f32x4){pA1[0], pA1[1], pA1[2], pA1[3]}); pa3 = __builtin_bit_cast(bf16x8, (f32x4){pA1[4], pA1[5], pA1[6], pA1[7]}); } } while (0); SBAR();
    SLOAD(0, j + 1); SBAR();
    do { if (!(VAR & 8)) pv_all2p(o, vb0, pa0, pa1, pa2, pa3); else { asm volatile("" :: "v"(pa0), "v"(pa1), "v"(pa2), "v"(pa3)); } } while (0); AMASK(pB0, pB1, j); do { if (!(VAR & 2)) psm2<false>(pB0, pB1, mhat, negm, alB); else alB = 1.f; } while (0);
    do { if (!(VAR & 1)) __syncthreads(); } while (0); SWRITE(0, 0);
    RESC(alB); do { if (!(VAR & 1)) __syncthreads(); } while (0);
    SBAR(); do { if (!(VAR & 16)) qkt2<DQK>(pA0, pA1, K_lds, qr, negm, r32, hi); else { pA0 = negm; pA1 = negm; asm volatile("" : "+v"(pA0), "+v"(pA1)); } } while (0);
    do { if (!(VAR & 2)) fsm2p(pB0, pB1, pa0, pa1, pa2, pa3); else { pa0 = __builtin_bit_cast(bf16x8, (f32x4){pB0[0], pB0[1], pB0[2], pB0[3]}); pa1 = __builtin_bit_cast(bf16x8, (f32x4){pB0[4], pB0[5], pB0[6], pB0[7]}); pa2 = __builtin_bit_cast(bf16x8, (f32x4){pB1[0], pB1[1], pB1[2], pB1[3]}); pa3 = __builtin_bit_cast(bf16x8, (f32x4){pB1[4], pB1[5], pB1[6], pB1[7]}); } } while (0); SBAR();
    SLOAD(0, j + 2); SBAR();
    do { if (!(VAR & 8)) pv_all2p(o, vb0 + SHM_V, pa0, pa1, pa2, pa3); else { asm volatile("" :: "v"(pa0), "v"(pa1), "v"(pa2), "v"(pa3)); } } while (0); AMASK(pA0, pA1, j + 1); do { if (!(VAR & 2)) psm2<false>(pA0, pA1, mhat, negm, alA); else alA = 1.f; } while (0);
    do { if (!(VAR & 1)) __syncthreads(); } while (0); SWRITE(1, 0);
    RESC(alA); do { if (!(VAR & 1)) __syncthreads(); } while (0);
  }
  SBAR(); do { if (!(VAR & 16)) qkt2<DQK>(pB0, pB1, K_lds + SHM_K, qr, negm, r32, hi); else { pB0 = negm; pB1 = negm; asm volatile("" : "+v"(pB0), "+v"(pB1)); } } while (0);
  do { if (!(VAR & 2)) fsm2p(pA0, pA1, pa0, pa1, pa2, pa3); else { pa0 = __builtin_bit_cast(bf16x8, (f32x4){pA0[0], pA0[1], pA0[2], pA0[3]}); pa1 = __builtin_bit_cast(bf16x8, (f32x4){pA0[4], pA0[5], pA0[6], pA0[7]}); pa2 = __builtin_bit_cast(bf16x8, (f32x4){pA1[0], pA1[1], pA1[2], pA1[3]}); pa3 = __builtin_bit_cast(bf16x8, (f32x4){pA1[4], pA1[5], pA1[6], pA1[7]}); } } while (0); SBAR();
  do { if (!(VAR & 8)) pv_all2p(o, vb0, pa0, pa1, pa2, pa3); else { asm volatile("" :: "v"(pa0), "v"(pa1), "v"(pa2), "v"(pa3)); } } while (0); AMASK(pB0, pB1, NT - 1); do { if (!(VAR & 2)) psm2<false>(pB0, pB1, mhat, negm, alB); else alB = 1.f; } while (0);
  do { if (!(VAR & 1)) __syncthreads(); } while (0); RESC(alB);
  do { if (!(VAR & 2)) fsm2p(pB0, pB1, pa0, pa1, pa2, pa3); else { pa0 = __builtin_bit_cast(bf16x8, (f32x4){pB0[0], pB0[1], pB0[2], pB0[3]}); pa1 = __builtin_bit_cast(bf16x8, (f32x4){pB0[4], pB0[5], pB0[6], pB0[7]}); pa2 = __builtin_bit_cast(bf16x8, (f32x4){pB1[0], pB1[1], pB1[2], pB1[3]}); pa3 = __builtin_bit_cast(bf16x8, (f32x4){pB1[4], pB1[5], pB1[6], pB1[7]}); } } while (0); SBAR();
  do { if (!(VAR & 8)) pv_all2p(o, vb0 + SHM_V, pa0, pa1, pa2, pa3); else { asm volatile("" :: "v"(pa0), "v"(pa1), "v"(pa2), "v"(pa3)); } } while (0);
  float rli[16];
  if (KIND == 1) { if (hi == 0) li_l[r32] = mhat; asm volatile("s_waitcnt lgkmcnt(0)" ::: "memory"); const float sk2 = p.sink[l * 8 + hd] * LOG2E;
#pragma unroll
    for (int r = 0; r < 16; ++r) rli[r] = __builtin_amdgcn_rcpf(o[2][r] + __builtin_amdgcn_exp2f(sk2 - li_l[crow(r, hi)])); }
  else {
#pragma unroll
    for (int r = 0; r < 16; ++r) rli[r] = __builtin_amdgcn_rcpf(o[2][r]); }
  bf16_t* Ow = (bf16_t*)(p.ws + OFF_R + R_CQ) + ((rowq0 + wid * 32) & 16383) * DM + ocol;
#pragma unroll
  for (int r = 0; r < 16; ++r) { const int orow = crow(r, hi);
#pragma unroll
    for (int d0 = 0; d0 < 2; ++d0) Ow[(size_t)orow * DM + d0 * 32 + r32] = f2bf(o[d0][r] * rli[r]); }
  do { if (!(VAR & 1)) __syncthreads(); } while (0);
#undef KROW
#undef SLOAD
#undef SWRITE
#undef SWAIT
#undef RESC
#undef AMASK
#undef TACT
}

template <int VAR>
__device__ __forceinline__ void ph_attn_probe(const Prm& p, int l, unsigned char* lds, int bid, int nb) {
  const int nrounds = (1024 + nb - 1) / nb;
  for (int rd = 0; rd < nrounds; ++rd) { const int pair = rd * 8 + (bid & 7), qb = bid >> 3, u = pair * 32 + qb;
    if (u < 1024) attn_probe_unit<0, VAR>(p, l, false, u >> 8, (u >> 5) & 7, u & 31, lds); }
}
#endif
template <int KIND>
__device__ __forceinline__ void attn_fast_unit3(const Prm& p, int l, bool isctx, int b, int hd, int qb, unsigned char* ldsu) {
  constexpr int DQK = KIND == 0 ? 96 : 64, KST = DQK * 2 + 16, SHM_K = 64 * KST, SHM_V = 8192, LPT = KIND == 0 ? 3 : 2;
  char* lds = (char*)ldsu;
  const int tid = TIDX, wid = tid >> 6, lane = tid & 63, r32 = lane & 31, hi = lane >> 5;
  char* V_lds = lds; char* K_lds = lds + 3 * SHM_V;
  float* ws = (float*)(lds + 3 * SHM_V + 3 * SHM_K) + wid * 64; float* li_l = ws; float* al_l = ws + 32;
  const int q0 = qb * 256;
  const size_t rowq0 = (size_t)b * TT + (isctx ? 0 : LC) + q0;
  const bf16_t *Qp, *Kp, *Vp; const bf16_t* KRp = WSP(bf16_t, OFF_KR); int ldq, ldk; int ocol;
  if (KIND == 0) { Qp = (const bf16_t*)(p.ws + OFF_R + R_QB) + hd * 96; ldq = NQB; Kp = (const bf16_t*)(p.ws + OFF_R + R_KB) + hd * 64; Vp = (const bf16_t*)(p.ws + OFF_R + R_VB) + hd * 64; ldk = 512; ocol = 512 + hd * 64; }
  else { Qp = (const bf16_t*)(p.ws + OFF_R + R_QA) + hd * 64; ldq = 512; Kp = (const bf16_t*)(p.ws + OFF_R + R_KA) + (hd >> 2) * 64; Vp = (const bf16_t*)(p.ws + OFF_R + R_VA) + (hd >> 2) * 64; ldk = 128; ocol = hd * 64; }
  int NT, kshift = 0; bool domask = false;
  if (isctx) NT = 4; else if (KIND == 0) NT = TT / 64; else { const int ks = max(0, q0 - 128), ke = min(SEQ, q0 + 384); NT = 4 + (ke - ks) / 64; kshift = ks; domask = true; }
  const size_t kb0 = (size_t)b * TT;
  float mhat = 0.f; f32x16 o[3] = {}; f32x16 negm = {}; bf16x8 qr[DQK / 16];
  { const bf16_t* Qw = Qp + (rowq0 + wid * 32 + r32) * ldq + hi * 8;
#pragma unroll
    for (int d0 = 0; d0 < DQK / 16; ++d0) qr[d0] = *reinterpret_cast<const bf16x8*>(Qw + d0 * 16); }
  const int sr = tid >> 3, sc = (tid & 7) * 8, vst = v_st(sr, sc), kst = sr * KST + sc * 2;
  const int rr_ = (tid & 255) >> 2, rc_ = (tid & 3) * 8, krst = rr_ * KST + 128 + rc_ * 2;
  const int vb0 = (int)(uintptr_t)V_lds + v_rd_base(lane);
  struct { bf16x8 v, k, kr; } st_[1];
#define KROW(j) (kb0 + (size_t)(j) * 64 + ((j) >= 4 ? kshift : 0))
#define SLOAD(i, j) do { const size_t kr0_ = KROW(j); st_[i].v = *reinterpret_cast<const bf16x8*>(Vp + (kr0_ + sr) * ldk + sc); st_[i].k = *reinterpret_cast<const bf16x8*>(Kp + (kr0_ + sr) * ldk + sc); \
    if (KIND == 0) st_[i].kr = *reinterpret_cast<const bf16x8*>(KRp + (kr0_ + rr_) * 32 + rc_); } while (0)
#define SWRITE(bf, i) do { *(bf16x8*)(V_lds + (bf) * SHM_V + vst) = st_[i].v; *(bf16x8*)(K_lds + (bf) * SHM_K + kst) = st_[i].k; \
    if (KIND == 0) { if (tid < 256) *(bf16x8*)(K_lds + (bf) * SHM_K + krst) = st_[i].kr; } } while (0)
#define SWAIT() do { if (LPT == 3) asm volatile("s_waitcnt vmcnt(3)" ::: "memory"); else asm volatile("s_waitcnt vmcnt(2)" ::: "memory"); } while (0)
#define RESC(a) do { if (__any((a) < 1.f)) { if (hi == 0) al_l[r32] = (a); asm volatile("s_waitcnt lgkmcnt(0)" ::: "memory"); \
    _Pragma("unroll") for (int d = 0; d < 3; ++d) _Pragma("unroll") for (int r = 0; r < 16; ++r) o[d][r] *= al_l[crow(r, hi)]; } } while (0)
#define AMASK(P0, P1, j) do { if (KIND == 1) { if (domask && (j) >= 4) { const int tq_ = q0 + wid * 32 + r32; const int tk_ = kshift + ((j) - 4) * 64 + 4 * hi; \
    _Pragma("unroll") for (int r = 0; r < 16; ++r) { const int d_ = tq_ - (tk_ + (r & 3) + 8 * (r >> 2)); if (d_ > 128 || d_ < -128) P0[r] = -INFINITY; if (d_ - 32 > 128 || d_ - 32 < -128) P1[r] = -INFINITY; } } } } while (0)
  f32x16 pA0, pA1, pB0, pB1; float alA, alB; bf16x8 pa0, pa1, pa2, pa3;
  SLOAD(0, 0); SWRITE(0, 0); SLOAD(0, 1); SWRITE(1, 0); __syncthreads();
  qkt2<DQK>(pA0, pA1, K_lds, qr, negm, r32, hi); AMASK(pA0, pA1, 0); psm2<true>(pA0, pA1, mhat, negm, alA);
  int r0 = 0, r1 = 1, r2 = 2;
#define ITER(PP0, PP1, PC0, PC1, ALC, j) do { \
    if ((j) + 2 < NT) SLOAD(0, (j) + 2); \
    SBAR(); qkt2<DQK>(PC0, PC1, K_lds + r1 * SHM_K, qr, negm, r32, hi); \
    fsm2(PP0, PP1, pa0, pa1, pa2, pa3); SBAR(); \
    pv_all2(o, vb0 + r0 * SHM_V, pa0, pa1, pa2, pa3); AMASK(PC0, PC1, (j) + 1); psm2<false>(PC0, PC1, mhat, negm, ALC); \
    RESC(ALC); \
    if ((j) + 2 < NT) SWRITE(r2, 0); \
    __syncthreads(); \
    { const int t_ = r0; r0 = r1; r1 = r2; r2 = t_; } } while (0)
  int j = 0;
  for (; j + 2 < NT; j += 2) { ITER(pA0, pA1, pB0, pB1, alB, j); ITER(pB0, pB1, pA0, pA1, alA, j + 1); }
  ITER(pA0, pA1, pB0, pB1, alB, j);
  fsm2(pB0, pB1, pa0, pa1, pa2, pa3); SBAR();
  pv_all2(o, vb0 + r0 * SHM_V, pa0, pa1, pa2, pa3);
#undef ITER
  float rli[16];
  if (KIND == 1) { if (hi == 0) li_l[r32] = mhat; asm volatile("s_waitcnt lgkmcnt(0)" ::: "memory"); const float sk2 = p.sink[l * 8 + hd] * LOG2E;
#pragma unroll
    for (int r = 0; r < 16; ++r) rli[r] = __builtin_amdgcn_rcpf(o[2][r] + __builtin_amdgcn_exp2f(sk2 - li_l[crow(r, hi)])); }
  else {
#pragma unroll
    for (int r = 0; r < 16; ++r) rli[r] = __builtin_amdgcn_rcpf(o[2][r]); }
  bf16_t* Ow = (bf16_t*)(p.ws + OFF_R + R_H) + (rowq0 + wid * 32) * DM + ocol;
#pragma unroll
  for (int r = 0; r < 16; ++r) { const int orow = crow(r, hi);
#pragma unroll
    for (int d0 = 0; d0 < 2; ++d0) Ow[(size_t)orow * DM + d0 * 32 + r32] = f2bf(o[d0][r] * rli[r]); }
  __syncthreads();
#undef KROW
#undef SLOAD
#undef SWRITE
#undef SWAIT
#undef RESC
#undef AMASK
}
#ifndef ATTN_V2
#define ATTN_V2 1
#endif
#ifndef ATTN_V3
#define ATTN_V3 0
#endif
#ifndef ATTN_V2P
#define ATTN_V2P 1
#endif
#if ATTN_V2P
#define ATTN_UNIT attn_fast_unit2p
#elif ATTN_V3
#define ATTN_UNIT attn_fast_unit3
#elif ATTN_V2
#define ATTN_UNIT attn_fast_unit2
#else
#define ATTN_UNIT attn_fast_unit
#endif
__device__ __forceinline__ void ph_attn_fast(const Prm& p, int l, unsigned char* lds, int bid, int nb) {
  const int nrounds = (1024 + nb - 1) / nb;
  for (int rd = 0; rd < nrounds; ++rd) { int u;
    if ((nb & 7) == 0 && (nb >> 3) == 32) { const int pair = rd * 8 + (bid & 7), qb = bid >> 3; u = pair * 32 + qb; } else u = rd * nb + bid;
    if (u < 1024) ATTN_UNIT<0>(p, l, false, u >> 8, (u >> 5) & 7, u & 31, lds); }
  for (int rd = 0; rd < nrounds; ++rd) { int u;
    if ((nb & 7) == 0 && (nb >> 3) == 32) { const int pair = rd * 8 + (bid & 7), qb = bid >> 3; u = pair * 32 + qb; } else u = rd * nb + bid;
    if (u < 1024) ATTN_UNIT<1>(p, l, false, u >> 8, (u >> 5) & 7, u & 31, lds); }
  if (l != DEPTH - 1) for (int u = bid; u < 64; u += nb) { const int kind = u & 1, hd = (u >> 1) & 7, b = u >> 4;
      if (kind == 0) ATTN_UNIT<0>(p, l, true, b, hd, 0, lds); else ATTN_UNIT<1>(p, l, true, b, hd, 0, lds); }
}

#define XB_TMO      128
#define XB_XCNT(j)  (256  + 64 * (j))
#define XB_XSUB(j)  (1280 + 64 * (j))
#define XB_XGEN(j)  (2304 + 64 * (j))
#define XB_TOP      3328
#define XB_TOPGEN   3392
#define XCD_BAR_WORDS 3456
#define XB_SPIN_CAP (1u << 22)
#define LAS __attribute__((address_space(3)))
__device__ __forceinline__ unsigned xb_ld(unsigned* p)              { return __hip_atomic_load(p, __ATOMIC_RELAXED, __HIP_MEMORY_SCOPE_AGENT); }
__device__ __forceinline__ unsigned xb_add(unsigned* p, unsigned v) { return __hip_atomic_fetch_add(p, v, __ATOMIC_RELAXED, __HIP_MEMORY_SCOPE_AGENT); }
__device__ __forceinline__ unsigned xb_xcc_id() { return (unsigned)__builtin_amdgcn_s_getreg((3 << 11) | 20) & 0xFu; }
#define XB_SPIN(cond, bar) do { unsigned _sp = 0; while (cond) { __builtin_amdgcn_s_sleep(1); \
    if ((++_sp & 255u) == 0u) { if (xb_ld(&(bar)[XB_TMO])) break; if (_sp > XB_SPIN_CAP) { atomicAdd(&(bar)[XB_TMO], 1u); break; } } } } while (0)
struct XcdBarrier { unsigned* bar; unsigned x; volatile LAS unsigned* st; };
__device__ __forceinline__ XcdBarrier xcd_barrier_post(unsigned* bar, volatile LAS unsigned* st) {
    XcdBarrier b; b.bar = bar; b.x = xb_xcc_id(); b.st = st;
    if (TIDX == 0) (void)xb_add(&bar[XB_XCNT(b.x)], 1u);
    return b;
}
__device__ __forceinline__ void xcd_barrier_complete(unsigned* bar, unsigned x, unsigned& nloc, unsigned& nx) {
    const unsigned G = gridDim.x * gridDim.y * gridDim.z;
    unsigned sum, cnt, mine, sp = 0u;
    for (;;) {
        sum = 0u; cnt = 0u; mine = 0u;
#pragma unroll
        for (unsigned j = 0; j < 16; ++j) { const unsigned c = xb_ld(&bar[XB_XCNT(j)]); sum += c; cnt += (c > 0u) ? 1u : 0u; mine = (j == x) ? c : mine; }
        if (sum == G) break;
        __builtin_amdgcn_s_sleep(1);
        if ((++sp & 255u) == 0u) { if (xb_ld(&bar[XB_TMO])) break; if (sp > XB_SPIN_CAP) { atomicAdd(&bar[XB_TMO], 1u); break; } }
    }
    nloc = mine > 0u ? mine : 1u; nx = cnt > 0u ? cnt : 1u;
}
__device__ __forceinline__ void xcd_barrier(const XcdBarrier& b) {
    asm volatile("s_waitcnt vmcnt(0)" ::: "memory");
    __syncthreads();
    if (TIDX == 0) {
        unsigned* bar = b.bar;
        __builtin_amdgcn_s_waitcnt(0);
        unsigned nloc = b.st[0], nx = b.st[1];
        if (nloc == 0u) { xcd_barrier_complete(bar, b.x, nloc, nx); b.st[0] = nloc; b.st[1] = nx; }
        const unsigned old = xb_add(&bar[XB_XSUB(b.x)], 1u);
        const unsigned gen = old / nloc;
        if (old + 1u == (gen + 1u) * nloc) {
            __builtin_amdgcn_fence(__ATOMIC_RELEASE, "agent");
            asm volatile("s_waitcnt vmcnt(0)" ::: "memory");
            const unsigned og = xb_add(&bar[XB_TOP], 1u);
            const unsigned tg = og / nx;
            if (og + 1u == (tg + 1u) * nx) xb_add(&bar[XB_TOPGEN], 1u);
            else XB_SPIN(xb_ld(&bar[XB_TOPGEN]) == tg, bar);
            __builtin_amdgcn_fence(__ATOMIC_ACQUIRE, "agent");
            xb_add(&bar[XB_XGEN(b.x)], 1u);
            asm volatile("s_waitcnt vmcnt(0)" ::: "memory");
        } else {
            XB_SPIN(xb_ld(&bar[XB_XGEN(b.x)]) == gen, bar);
            __builtin_amdgcn_fence(__ATOMIC_ACQUIRE, "agent");
            asm volatile("s_waitcnt vmcnt(0)" ::: "memory");
        }
    }
    __syncthreads();
}

constexpr int NPHASE = 22;
__device__ __forceinline__ void run_phase1(const Prm& p, int ph, unsigned char* lds, int bid, int nb) {
  if (ph == 0) { ph_mod(p, 0, lds, bid, nb); ph_wconv_dense(p, 0, lds, bid, nb); return; }
  if (ph == 21) { ph_final(p, bid, nb); return; }
  const int alt = ph >= 100 ? 10 : 0; if (alt) ph -= 100;
  const int l = (ph - 1) / 10, s = (ph - 1) % 10 + alt;
  switch (s) {
    case 0: ph_norm_a(p, l, bid, nb); break;
#if FAST_GEMM
#if !defined(DBG_ONLY) || DBG_ONLY == 1
    case 1: ph2_gemm_in(p, l, lds, bid, nb); break;
#endif
#if !defined(DBG_ONLY) || DBG_ONLY == 2
    case 2: ph2_gemm_qup(p, l, lds, bid, nb); ph2_gemm_kvup(p, l, lds, bid, nb); break;
#endif
#if !defined(DBG_ONLY) || DBG_ONLY == 3
    case 3: break;
#endif
#else
    case 1: ph_gemm_in(p, l, bid, nb); break;
    case 2: ph_ssq(p, bid, nb); break;
    case 3: ph_gemm_up(p, l, bid, nb); break;
#endif
#if FAST_ATTN
    case 4: ph_attn_fast(p, l, lds, bid, nb); break;
#else
    case 4: ph_attn_naive(p, l, lds, bid, nb); break;
#endif
#if FAST_GEMM
#if !defined(DBG_ONLY) || DBG_ONLY == 5
    case 5: ph2_gemm_out(p, l, lds, bid, nb); break;
#endif
#else
    case 5: ph_gemm_out(p, l, bid, nb); break;
#endif
    case 6: ph_norm_b<true>(p, l, lds, bid, nb); break;
#ifdef DBG_NB
    case 16: ph_norm_b<false>(p, l, lds, bid, nb); break;
#endif
#ifdef DBG_ATTN_PROBE
    case 14: ph_attn_probe<DBG_ATTN_PROBE>(p, l, lds, bid, nb); break;
#endif
    case 7: ph_topk(p, l, lds, bid, nb); break;
#if FAST_GEMM
#if !defined(DBG_ONLY) || DBG_ONLY == 8
    case 8: ph2_moe_up(p, l, lds, bid, nb); break;
#endif
#if !defined(DBG_ONLY) || DBG_ONLY == 9
    case 9: ph2_moe_down(p, l, lds, bid, nb); break;
#endif
#else
    case 8: ph_moe_up(p, l, bid, nb); break;
    case 9: ph_moe_down(p, l, bid, nb); break;
#endif
  }
}

#ifndef DBG_TWICE
#define DBG_TWICE 0
#endif
#ifndef DBG_ALT
#define DBG_ALT 0
#endif
#ifndef DBG_PRE
#define DBG_PRE 0
#endif
__device__ __forceinline__ void run_phase(const Prm& p, int ph, unsigned char* lds, int bid, int nb) {
  if (DBG_PRE) { if (ph >= 1 && ph <= 20 && (ph - 1) % 10 == 0) { run_phase1(p, ph + DBG_PRE, lds, bid, nb); __syncthreads(); } }
  run_phase1(p, ph, lds, bid, nb);
  if (DBG_TWICE) { const int s = ph == 0 ? 10 : (ph == 21 ? 11 : (ph - 1) % 10); if ((DBG_TWICE >> s) & 1) { __syncthreads(); run_phase1(p, ph + DBG_ALT, lds, bid, nb); } }
}
constexpr int LDS_BYTES = FAST_GEMM ? 131072 + 16384 + 128 + 128 : 65536;
#if MK_SPLIT
__global__ void __launch_bounds__(NTHR, 2) k_phase(Prm p, int ph) {
  extern __shared__ __attribute__((aligned(16))) unsigned char lds[];
  run_phase(p, ph, lds, blockIdx.x, gridDim.x);
}
#endif
#if !MK_SPLIT
__global__ void __launch_bounds__(NTHR, 2) k_mega(Prm p) {
  extern __shared__ __attribute__((aligned(16))) unsigned char lds[];
  cg::grid_group grid = cg::this_grid();
  if (p.out == nullptr) grid.sync();
  volatile LAS unsigned* st = (volatile LAS unsigned*)((LAS unsigned char*)lds + 131072 + 16384 + 64);
  if (TIDX < 2) st[TIDX] = 0u;
  if (TIDX < 24) { const int i = TIDX; ((LAS float*)((LAS unsigned char*)lds + ROPE_TAB_OFF))[i] = (i < 16 ? exp2f(-(float)i * (13.287712379549449f / 16.f)) : exp2f(-(float)(i - 16) * (13.287712379549449f / 8.f))) * 0.15915494309189535f; }
  __syncthreads();
  XcdBarrier xb = xcd_barrier_post((unsigned*)(p.ws + OFF_CTL) + 1024, st);
#pragma unroll 1
  for (int ph = 0; ph < NPHASE; ++ph) { int phv = ph; asm volatile("" : "+s"(phv));
    run_phase(p, phv, lds, blockIdx.x, gridDim.x);
    if (ph + 1 < NPHASE && (ph % 10) != 4) xcd_barrier(xb); }
}
#define K_MAIN k_mega
#else
#define K_MAIN k_phase
#endif

extern "C" void kernel_launch(void* const* d_in, const int* in_sizes, int n_in, void* d_out, int out_size, void* d_ws, size_t ws_size, hipStream_t stream) {
  static int grid = 0;
  if (grid == 0) {
    if (n_in != 20 || ws_size < WS_END || out_size != NB * SEQ * DM) { fprintf(stderr, "kernel_launch: bad shapes n_in %d ws %zu (need %zu) out %d\n", n_in, ws_size, (size_t)WS_END, out_size); grid = -1; return; }
    int dev = 0, cus = 0, per = 0;
    (void)hipGetDevice(&dev); (void)hipDeviceGetAttribute(&cus, hipDeviceAttributeMultiprocessorCount, dev);
    (void)hipFuncSetAttribute((const void*)K_MAIN, hipFuncAttributeMaxDynamicSharedMemorySize, LDS_BYTES);
    (void)hipOccupancyMaxActiveBlocksPerMultiprocessor(&per, (const void*)K_MAIN, NTHR, LDS_BYTES);
    if (per < 1) per = 1;
    if (per > 1) per = 1;
    grid = cus * per;
    (void)hipGetLastError();
  }
  if (grid < 0) return;
  Prm p{};
  const float** pf = (const float**)&p;
  for (int i = 0; i < 20; ++i) pf[i] = (const float*)d_in[i];
  p.out = (float*)d_out; p.ws = (unsigned char*)d_ws;
#if MK_SPLIT
  for (int ph = 0; ph < NPHASE; ++ph) hipLaunchKernelGGL(k_phase, dim3(1024), dim3(NTHR), LDS_BYTES, stream, p, ph);
#else
  (void)hipMemsetAsync((char*)d_ws + OFF_CTL, 0, 65536, stream);
  void* args[] = {&p};
  hipError_t e = hipLaunchCooperativeKernel((const void*)k_mega, dim3(grid), dim3(NTHR), args, LDS_BYTES, stream);
  if (e != hipSuccess) fprintf(stderr, "cooperative launch failed: %s (grid %d)\n", hipGetErrorString(e), grid);
#endif
}
```

```cpp
#include <hip/hip_runtime.h>
#include <hip/hip_cooperative_groups.h>
#include <cstdint>
#include <cstdio>
namespace cg = cooperative_groups;

#ifndef MK_SPLIT
#define MK_SPLIT 0
#endif
#ifndef FAST_GEMM
#define FAST_GEMM 1
#endif
#ifndef FAST_ATTN
#define FAST_ATTN 1
#endif

typedef unsigned short bf16_t;
typedef short bf16x8 __attribute__((ext_vector_type(8)));
typedef float f32x4 __attribute__((ext_vector_type(4)));
typedef float f32x16 __attribute__((ext_vector_type(16)));
typedef unsigned u32x4 __attribute__((ext_vector_type(4)));
typedef unsigned u32x2 __attribute__((ext_vector_type(2)));

constexpr int NTHR = 512, NWAVE = 8;
constexpr int NB = 4, SEQ = 8192, LC = 256, TT = SEQ + LC, MR = NB * TT, DM = 1024, DEPTH = 2;
constexpr int NIN = 1440, NINP = 1536, QRK = 384, KVRK = 256, NQB = 768, NKVB = 1024;
constexpr int NE = 16, DFF = 512, CAPL = 1024, CAPC = 32;
constexpr int NSLOT = NB * NE * CAPL + NE * 256;
constexpr float EPS = 1e-6f;
constexpr float LOG2E = 1.4426950408889634f;
constexpr float SCALE_A = 0.125f * LOG2E;
constexpr float SCALE_B = 0.10206207261596575f * LOG2E;

constexpr size_t al256(size_t v) { return (v + 255) / 256 * 256; }
constexpr size_t OFF_CTL = 0;
constexpr size_t OFF_MOD = 1u << 20;
constexpr size_t OFF_ROPE = OFF_MOD + al256((size_t)2 * 5 * 6144 * 4);
constexpr size_t OFF_SSQQ = OFF_ROPE + al256((size_t)(2 * 2048 + 2 * 1024) * 4);
constexpr size_t OFF_SSQK = OFF_SSQQ + al256((size_t)MR * 4);
constexpr size_t OFF_AFF = OFF_SSQK + al256((size_t)MR * 4);
constexpr size_t OFF_INV = OFF_AFF + al256((size_t)MR * 16 * 4);
constexpr size_t OFF_IDX = OFF_INV + al256((size_t)MR * 16 * 4);
constexpr size_t OFF_VAL = OFF_IDX + al256((size_t)NSLOT * 4);
constexpr size_t OFF_KR = OFF_VAL + al256((size_t)NSLOT * 4);
constexpr size_t SZ_WIN = (size_t)NINP * DM * 2, SZ_WQ = (size_t)NQB * QRK * 2, SZ_WKV = (size_t)NKVB * KVRK * 2, SZ_WO = (size_t)DM * DM * 2;
constexpr size_t SZ_WL = SZ_WIN + SZ_WQ + SZ_WKV + SZ_WO;
constexpr size_t OFF_W = OFF_KR + al256((size_t)MR * 32 * 2);
constexpr size_t OFF_WGU = OFF_W + 2 * SZ_WL;
constexpr size_t OFF_WD = OFF_WGU + (size_t)NE * 1024 * 1024 * 2;
constexpr size_t OFF_X = OFF_WD + (size_t)NE * 1024 * 512 * 2;
constexpr size_t OFF_R = OFF_X + (size_t)MR * DM * 4;
constexpr size_t R_H = 0;
constexpr size_t R_QA = R_H + (size_t)MR * DM * 2;
constexpr size_t R_KA = R_QA + (size_t)MR * 512 * 2;
constexpr size_t R_VA = R_KA + (size_t)MR * 128 * 2;
constexpr size_t R_QB = R_VA + (size_t)MR * 128 * 2;
constexpr size_t R_KB = R_QB + (size_t)MR * 768 * 2;
constexpr size_t R_VB = R_KB + (size_t)MR * 512 * 2;
constexpr size_t R_CQ = R_VB + (size_t)MR * 512 * 2;
constexpr size_t R_CKV = R_CQ + (size_t)MR * QRK * 2;
constexpr size_t R_END = R_CKV + (size_t)MR * KVRK * 2;
constexpr size_t R_MIXG = R_QA;
constexpr size_t R_ACT = R_QA;
constexpr size_t R_Y = R_ACT + (size_t)NSLOT * DFF * 2;
static_assert(R_Y + (size_t)NSLOT * DM * 2 <= R_END, "moe overlay fits");
constexpr size_t WS_END = OFF_R + R_END;

struct Prm {
  const float *x, *c, *ctx, *c_ctx, *w_mod, *b_mod, *norm_attn, *norm_ffn, *w_in, *sink, *q_norm, *kv_norm, *w_q_up, *w_kv_up, *w_out, *w_router, *w_gate, *w_up,
      *w_down, *norm_final;
  float* out;
  unsigned char* ws;
};

__device__ __forceinline__ float bf2f(bf16_t v) { return __uint_as_float((unsigned)v << 16); }
__device__ __forceinline__ bf16_t f2bf(float f) { unsigned u = __float_as_uint(f); return (bf16_t)((u + 0x7fffu + ((u >> 16) & 1u)) >> 16); }
__device__ __forceinline__ unsigned pk2(float lo, float hi) { return (unsigned)f2bf(lo) | ((unsigned)f2bf(hi) << 16); }
template <int CTRL> __device__ __forceinline__ float dpp_mov(float x) { return __int_as_float(__builtin_amdgcn_update_dpp(0, __float_as_int(x), CTRL, 0xF, 0xF, true)); }
__device__ __forceinline__ float xor1(float x) { return dpp_mov<0xB1>(x); }
__device__ __forceinline__ float xor2(float x) { return dpp_mov<0x4E>(x); }
__device__ __forceinline__ float hmir(float x) { return dpp_mov<0x141>(x); }
__device__ __forceinline__ float xor8(float x) { return dpp_mov<0x128>(x); }
__device__ __forceinline__ float sum16sw(float x) { auto r = __builtin_amdgcn_permlane16_swap(__float_as_uint(x), __float_as_uint(x), false, false); return __uint_as_float(r[0]) + __uint_as_float(r[1]); }
__device__ __forceinline__ float sum32sw(float x) { auto r = __builtin_amdgcn_permlane32_swap(__float_as_uint(x), __float_as_uint(x), false, false); return __uint_as_float(r[0]) + __uint_as_float(r[1]); }
__device__ __forceinline__ float max16sw(float x) { auto r = __builtin_amdgcn_permlane16_swap(__float_as_uint(x), __float_as_uint(x), false, false); return fmaxf(__uint_as_float(r[0]), __uint_as_float(r[1])); }
__device__ __forceinline__ float max32sw(float x) { auto r = __builtin_amdgcn_permlane32_swap(__float_as_uint(x), __float_as_uint(x), false, false); return fmaxf(__uint_as_float(r[0]), __uint_as_float(r[1])); }
__device__ __forceinline__ float wave_sum(float v) {
  v += xor1(v); v += xor2(v); v += hmir(v); v += xor8(v); v = sum16sw(v); v = sum32sw(v);
  return v;
}
__device__ __forceinline__ float silu_f(float v) { return v / (1.f + __expf(-v)); }
__device__ __forceinline__ float silu_fast(float v) { return v * __builtin_amdgcn_rcpf(1.f + __builtin_amdgcn_exp2f(-1.4426950408889634f * v)); }
__device__ __forceinline__ unsigned cvtpk_e(float lo, float hi) { unsigned r; asm volatile("v_cvt_pk_bf16_f32 %0, %1, %2" : "=v"(r) : "v"(lo), "v"(hi)); return r; }
__device__ __forceinline__ int row_mi(int r) { const int b = r / TT, t = r - b * TT; return t < LC ? 4 : b; }

__device__ __forceinline__ int opaque_tid() { int t = __builtin_amdgcn_workitem_id_x(); asm volatile("" : "+v"(t)); return t; }
#define TIDX opaque_tid()
#define WSP(T, off) ((T*)(p.ws + (off)))

__device__ __forceinline__ void ph_mod(const Prm& p, int l, unsigned char* lds, int bid, int nb) {
  float* sc = (float*)lds;
  float* red = sc + 5 * 1024;
  const int tid = TIDX;
  for (int i = tid; i < 5 * 1024; i += NTHR) { const int mi = i >> 10, d = i & 1023; const float v = mi < 4 ? p.c[mi * 1024 + d] : p.c_ctx[d]; sc[i] = silu_f(v); }
  __syncthreads();
  float* MOD = WSP(float, OFF_MOD);
  const int cl = tid & 31, kg = tid >> 5;
  for (int it = bid; it < 192; it += nb) {
    const int e0 = it * 32;
    const float* w = p.w_mod + (size_t)l * 1024 * 6144 + e0 + cl;
    float a0 = 0, a1 = 0, a2 = 0, a3 = 0, a4 = 0;
#pragma unroll
    for (int k0 = 0; k0 < 64; k0 += 16) { float wv[16];
#pragma unroll
      for (int j = 0; j < 16; ++j) wv[j] = w[(size_t)(kg * 64 + k0 + j) * 6144];
#pragma unroll
      for (int j = 0; j < 16; ++j) { const int d = kg * 64 + k0 + j;
        a0 += sc[d] * wv[j]; a1 += sc[1024 + d] * wv[j]; a2 += sc[2048 + d] * wv[j]; a3 += sc[3072 + d] * wv[j]; a4 += sc[4096 + d] * wv[j]; } }
    float* rr = red + (kg * 32 + cl) * 5; rr[0] = a0; rr[1] = a1; rr[2] = a2; rr[3] = a3; rr[4] = a4;
    __syncthreads();
    if (tid < 160) { const int c2 = tid & 31, mi = tid >> 5; float s = 0; for (int g = 0; g < 16; ++g) s += red[(g * 32 + c2) * 5 + mi];
      MOD[(size_t)(l * 5 + mi) * 6144 + e0 + c2] = s + p.b_mod[l * 6144 + e0 + c2]; }
    __syncthreads();
  }
}

template <class Src>
__device__ __forceinline__ void tr_tile(const Src& src, bf16_t* dst, int K, int k0, int n0, float* tl  ) {
  const int tid = TIDX;
#pragma unroll
  for (int i = 0; i < 8; ++i) { const int e = tid + i * NTHR, kk = e >> 6, nn = e & 63; tl[kk * 65 + nn] = src(k0 + kk, n0 + nn); }
  __syncthreads();
#pragma unroll
  for (int i = 0; i < 2; ++i) { const int e = tid + i * NTHR, nn = e >> 4, kc = (e & 15) * 4;
    u32x2 o; o.x = pk2(tl[(kc + 0) * 65 + nn], tl[(kc + 1) * 65 + nn]); o.y = pk2(tl[(kc + 2) * 65 + nn], tl[(kc + 3) * 65 + nn]);
    *(u32x2*)(dst + (size_t)(n0 + nn) * K + k0 + kc) = o; }
  __syncthreads();
}
struct SrcIn { const float* w; __device__ float operator()(int k, int n) const { return n < NIN ? w[(size_t)k * NIN + n] : 0.f; } };
struct SrcScaled { const float* w; const float* nv; int N; __device__ float operator()(int k, int n) const { return w[(size_t)k * N + n] * nv[k]; } };
struct SrcPlain { const float* w; int N; __device__ float operator()(int k, int n) const { return w[(size_t)k * N + n]; } };
#if FAST_GEMM
struct SrcGU { const float* g; const float* u; __device__ float operator()(int k, int n) const { const int t = n >> 8, w = n & 255; return w < 128 ? g[(size_t)k * DFF + t * 128 + w] : u[(size_t)k * DFF + t * 128 + w - 128]; } };
#else
struct SrcGU { const float* g; const float* u; __device__ float operator()(int k, int n) const { const int t = n >> 6, w = n & 63; return w < 32 ? g[(size_t)k * DFF + t * 32 + w] : u[(size_t)k * DFF + t * 32 + w - 32]; } };
#endif

constexpr int WCB = 4;
struct WcItem { const float* sp; int ss; bf16_t* dp; int dK; const float* nv; int ncol; };
template <class F>
__device__ __forceinline__ void wconv_run(const F& item, int NIT, unsigned char* lds, int rank, int nranks) {
  float* tl = (float*)lds;
  const int tid = TIDX;
  for (int base = rank; base < NIT; base += nranks * WCB) {
    f32x4 rg[WCB][2]; float sc[WCB][2];
#pragma unroll
    for (int d = 0; d < WCB; ++d) { const int it = base + d * nranks;
      if (it < NIT) { const WcItem w = item(it);
#pragma unroll
        for (int i = 0; i < 2; ++i) { const int e = tid + i * NTHR, kk = e >> 4, n4 = (e & 15) * 4;
          rg[d][i] = n4 < w.ncol ? __builtin_nontemporal_load((const f32x4*)(w.sp + (size_t)kk * w.ss + n4)) : (f32x4){0.f, 0.f, 0.f, 0.f};
          sc[d][i] = w.nv ? w.nv[kk] : 1.f; } } }
#pragma unroll
    for (int d = 0; d < WCB; ++d) { const int it = base + d * nranks;
      if (it < NIT) { const WcItem w = item(it); float* t = tl + (d & 1) * (64 * 65);
#pragma unroll
        for (int i = 0; i < 2; ++i) { const int e = tid + i * NTHR, kk = e >> 4, n4 = (e & 15) * 4;
#pragma unroll
          for (int j = 0; j < 4; ++j) t[kk * 65 + n4 + j] = rg[d][i][j] * sc[d][i]; }
        __syncthreads();
#pragma unroll
        for (int i = 0; i < 2; ++i) { const int e = tid + i * NTHR, nn = e >> 4, kc = (e & 15) * 4;
          u32x2 o; o.x = pk2(t[(kc + 0) * 65 + nn], t[(kc + 1) * 65 + nn]); o.y = pk2(t[(kc + 2) * 65 + nn], t[(kc + 3) * 65 + nn]);
          *(u32x2*)(w.dp + (size_t)nn * w.dK + kc) = o; } } }
  }
  __syncthreads();
}
__device__ __forceinline__ void ph_wconv_dense(const Prm& p, int l, unsigned char* lds, int bid, int nb) {
  constexpr int T_IN = (DM / 64) * (NINP / 64), T_Q = (QRK / 64) * (NQB / 64), T_KV = (KVRK / 64) * (NKVB / 64), T_O = (DM / 64) * (DM / 64), T_L = T_IN + T_Q + T_KV + T_O;
  wconv_run([&p, l](int it) __attribute__((always_inline)) -> WcItem { int r = it; WcItem w;
    bf16_t* wb = (bf16_t*)(p.ws + OFF_W + (size_t)l * SZ_WL);
    if (r < T_IN) { const int kt = r / (NINP / 64), nt = r % (NINP / 64), n0 = nt * 64;
      w.sp = p.w_in + (size_t)l * DM * NIN + (size_t)(kt * 64) * NIN + n0; w.ss = NIN; w.dp = wb + (size_t)n0 * DM + kt * 64; w.dK = DM; w.nv = nullptr; w.ncol = NIN - n0; return w; } r -= T_IN;
    if (r < T_Q) { const int kt = r / (NQB / 64), nt = r % (NQB / 64);
      w.sp = p.w_q_up + (size_t)l * QRK * NQB + (size_t)(kt * 64) * NQB + nt * 64; w.ss = NQB; w.dp = (bf16_t*)((unsigned char*)wb + SZ_WIN) + (size_t)(nt * 64) * QRK + kt * 64; w.dK = QRK;
      w.nv = p.q_norm + l * QRK + kt * 64; w.ncol = 64; return w; } r -= T_Q;
    if (r < T_KV) { const int kt = r / (NKVB / 64), nt = r % (NKVB / 64);
      w.sp = p.w_kv_up + (size_t)l * KVRK * NKVB + (size_t)(kt * 64) * NKVB + nt * 64; w.ss = NKVB; w.dp = (bf16_t*)((unsigned char*)wb + SZ_WIN + SZ_WQ) + (size_t)(nt * 64) * KVRK + kt * 64; w.dK = KVRK;
      w.nv = p.kv_norm + l * KVRK + kt * 64; w.ncol = 64; return w; } r -= T_KV;
    { const int kt = r / (DM / 64), nt = r % (DM / 64);
      w.sp = p.w_out + (size_t)l * DM * DM + (size_t)(kt * 64) * DM + nt * 64; w.ss = DM; w.dp = (bf16_t*)((unsigned char*)wb + SZ_WIN + SZ_WQ + SZ_WKV) + (size_t)(nt * 64) * DM + kt * 64; w.dK = DM;
      w.nv = nullptr; w.ncol = 64; return w; } }, T_L, lds, bid, nb);
}
__device__ __forceinline__ void ph_wconv_moe(const Prm& p, int l, unsigned char* lds, int rank, int nranks) {
  constexpr int T_GU = (DM / 64) * (1024 / 64), T_D = (DFF / 64) * (DM / 64), T_E = T_GU + T_D;
  wconv_run([&p, l](int it) __attribute__((always_inline)) -> WcItem { const int e = it / T_E; int r = it % T_E; WcItem w; w.nv = nullptr; w.ncol = 64;
    if (r < T_GU) { const int kt = r >> 4, nt = r & 15, n0 = nt * 64, t = n0 >> 8, wq = n0 & 255;
      const float* src = (wq < 128 ? p.w_gate : p.w_up) + ((size_t)l * NE + e) * DM * DFF;
      w.sp = src + (size_t)(kt * 64) * DFF + t * 128 + (wq & 127); w.ss = DFF; w.dp = WSP(bf16_t, OFF_WGU) + (size_t)e * 1024 * 1024 + (size_t)n0 * DM + kt * 64; w.dK = DM; }
    else { r -= T_GU; const int kt = r >> 4, nt = r & 15;
      w.sp = p.w_down + ((size_t)l * NE + e) * DFF * DM + (size_t)(kt * 64) * DM + nt * 64; w.ss = DM; w.dp = WSP(bf16_t, OFF_WD) + (size_t)e * 1024 * 512 + (size_t)(nt * 64) * DFF + kt * 64; w.dK = DFF; }
    return w; }, NE * T_E, lds, rank, nranks);
}

typedef int i32x4 __attribute__((ext_vector_type(4)));
__device__ __forceinline__ void y_acc(f32x4 (&s)[4], const u32x2 (&y)[4]) {
#pragma unroll
  for (int j = 0; j < 4; ++j) { s[j][0] += __uint_as_float(y[j].x << 16); s[j][1] += __uint_as_float(y[j].x & 0xffff0000u); s[j][2] += __uint_as_float(y[j].y << 16); s[j][3] += __uint_as_float(y[j].y & 0xffff0000u); }
}
struct RowLd { f32x4 x[4]; i32x4 q[4]; };
__device__ __forceinline__ void row_issue(const Prm& p, int l, int r, int lane, RowLd& R) {
  const int b = r / TT, t = r - b * TT;
  if (l == 0) { const float* src = t < LC ? p.ctx + ((size_t)b * LC + t) * DM : p.x + ((size_t)b * SEQ + (t - LC)) * DM;
#pragma unroll
    for (int j = 0; j < 4; ++j) R.x[j] = *(const f32x4*)(src + 4 * lane + 256 * j);
  } else { int zv = 0; asm volatile("" : "+v"(zv));
    const float* X = WSP(float, OFF_X) + (size_t)r * DM; const i32x4* inv = (const i32x4*)(WSP(int, OFF_INV) + (size_t)r * 16 + zv);
#pragma unroll
    for (int j = 0; j < 4; ++j) { R.x[j] = *(const f32x4*)(X + 4 * lane + 256 * j); R.q[j] = inv[j]; } }
}
__device__ __forceinline__ void row_finish(const Prm& p, int l, int r, int lane, RowLd& R, f32x4 (&v)[4]) {
  if (l == 0) {
#pragma unroll
    for (int j = 0; j < 4; ++j) v[j] = R.x[j];
    return; }
  const int b = r / TT, t = r - b * TT;
  const bf16_t* Y = (const bf16_t*)(p.ws + OFF_R + R_Y) + 4 * lane;
  int c0 = 0, c1 = 0, c2 = 0, c3 = 0, cnt = 0;
#pragma unroll
  for (int e = 0; e < 16; ++e) { const int sv = __builtin_amdgcn_readfirstlane(R.q[e >> 2][e & 3]);
    if (sv >= 0) { c0 = cnt == 0 ? sv : c0; c1 = cnt == 1 ? sv : c1; c2 = cnt == 2 ? sv : c2; c3 = cnt == 3 ? sv : c3; ++cnt; } }
  u32x2 y0[4], y1[4], y2[4], y3[4];
#pragma unroll
  for (int j = 0; j < 4; ++j) { y0[j] = (u32x2){0u, 0u}; y1[j] = y0[j]; y2[j] = y0[j]; y3[j] = y0[j]; }
  if (cnt > 0) {
#pragma unroll
    for (int j = 0; j < 4; ++j) y0[j] = *(const u32x2*)(Y + (size_t)c0 * DM + 256 * j); }
  if (cnt > 1) {
#pragma unroll
    for (int j = 0; j < 4; ++j) y1[j] = *(const u32x2*)(Y + (size_t)c1 * DM + 256 * j); }
  if (cnt > 2) {
#pragma unroll
    for (int j = 0; j < 4; ++j) y2[j] = *(const u32x2*)(Y + (size_t)c2 * DM + 256 * j); }
  if (cnt > 3) {
#pragma unroll
    for (int j = 0; j < 4; ++j) y3[j] = *(const u32x2*)(Y + (size_t)c3 * DM + 256 * j); }
  f32x4 s[4];
#pragma unroll
  for (int j = 0; j < 4; ++j) s[j] = (f32x4){0.f, 0.f, 0.f, 0.f};
  y_acc(s, y0); y_acc(s, y1); y_acc(s, y2); y_acc(s, y3);
  if (cnt > 4) { int k = 0;
#pragma unroll
    for (int e = 0; e < 16; ++e) { const int sv = __builtin_amdgcn_readfirstlane(R.q[e >> 2][e & 3]);
      if (sv >= 0) { if (k >= 4) { u32x2 yy[4];
#pragma unroll
          for (int j = 0; j < 4; ++j) yy[j] = *(const u32x2*)(Y + (size_t)sv * DM + 256 * j);
          y_acc(s, yy); }
        ++k; } } }
  const float* gf = WSP(float, OFF_MOD) + (size_t)((l - 1) * 5 + (t < LC ? 4 : b)) * 6144 + 5 * 1024;
#pragma unroll
  for (int j = 0; j < 4; ++j) { const f32x4 g = *(const f32x4*)(gf + 4 * lane + 256 * j); v[j] = R.x[j] + g * s[j]; }
}
__device__ __forceinline__ float row_ssq(const f32x4 (&v)[4]) { float ss = 0.f;
#pragma unroll
  for (int j = 0; j < 4; ++j) ss += v[j][0] * v[j][0] + v[j][1] * v[j][1] + v[j][2] * v[j][2] + v[j][3] * v[j][3];
  return wave_sum(ss); }
__device__ __forceinline__ void norm_a_store(const Prm& p, int l, int r, int lane, const f32x4 (&v)[4]) {
  const float* md = WSP(float, OFF_MOD) + (size_t)(l * 5 + row_mi(r)) * 6144;
  f32x4 nwv[4], shv[4], sclv[4];
#pragma unroll
  for (int j = 0; j < 4; ++j) { const int c = 4 * lane + 256 * j; nwv[j] = *(const f32x4*)(p.norm_attn + l * DM + c); shv[j] = *(const f32x4*)(md + c); sclv[j] = *(const f32x4*)(md + 1024 + c); }
  const float rs = rsqrtf(row_ssq(v) * (1.f / DM) + EPS);
  float* X = WSP(float, OFF_X) + (size_t)r * DM; bf16_t* H = (bf16_t*)(p.ws + OFF_R + R_H) + (size_t)r * DM;
  if (lane == 0) { WSP(float, OFF_SSQQ)[r] = 0.f; WSP(float, OFF_SSQK)[r] = 0.f; }
#pragma unroll
  for (int j = 0; j < 4; ++j) { const int c = 4 * lane + 256 * j;
    *(f32x4*)(X + c) = v[j];
    const f32x4 nw = nwv[j], sh = shv[j], scl = sclv[j];
    const f32x4 h = v[j] * rs * nw * (scl + 1.f) + sh;
    u32x2 o; o.x = pk2(h[0], h[1]); o.y = pk2(h[2], h[3]); *(u32x2*)(H + c) = o; }
}
constexpr int RPI = 4, RPA = 2;
#define ROWPIPE(R0, R1, ROWOF, LAYER, STORE) do { \
    RowLd A0, A1, B0, B1; f32x4 va[4], vb[4]; \
    int r = (R0); \
    if (r < (R1)) row_issue(p, LAYER, ROWOF(r), lane, A0); if (r + 1 < (R1)) row_issue(p, LAYER, ROWOF(r + 1), lane, A1); \
    for (; r < (R1); r += 4) { \
      if (r + 2 < (R1)) row_issue(p, LAYER, ROWOF(r + 2), lane, B0); if (r + 3 < (R1)) row_issue(p, LAYER, ROWOF(r + 3), lane, B1); \
      row_finish(p, LAYER, ROWOF(r), lane, A0, va); if (r + 1 < (R1)) row_finish(p, LAYER, ROWOF(r + 1), lane, A1, vb); \
      STORE(r, va); if (r + 1 < (R1)) STORE(r + 1, vb); \
      if (r + 2 >= (R1)) break; \
      if (r + 4 < (R1)) row_issue(p, LAYER, ROWOF(r + 4), lane, A0); if (r + 5 < (R1)) row_issue(p, LAYER, ROWOF(r + 5), lane, A1); \
      row_finish(p, LAYER, ROWOF(r + 2), lane, B0, va); if (r + 3 < (R1)) row_finish(p, LAYER, ROWOF(r + 3), lane, B1, vb); \
      STORE(r + 2, va); if (r + 3 < (R1)) STORE(r + 3, vb); \
    } } while (0)
__device__ __forceinline__ void ph_norm_a(const Prm& p, int l, int bid, int nb) {
  const int lane = TIDX & 63, wv = __builtin_amdgcn_readfirstlane(TIDX >> 6);
  const int nw = nb * NWAVE, rpw = (MR + nw - 1) / nw, gw = bid * NWAVE + wv;
  const int r0 = gw * rpw, r1 = min(MR, r0 + rpw);
#define ROWID(x) (x)
#define NA_STORE(x, v) norm_a_store(p, l, (x), lane, v)
  ROWPIPE(r0, r1, ROWID, l, NA_STORE);
#undef ROWID
#undef NA_STORE
}
__device__ __forceinline__ void final_store(const Prm& p, int q, int lane, const f32x4 (&v)[4]) {
  f32x4 nfv[4];
#pragma unroll
  for (int j = 0; j < 4; ++j) nfv[j] = *(const f32x4*)(p.norm_final + 4 * lane + 256 * j);
  const float rs = rsqrtf(row_ssq(v) * (1.f / DM) + EPS); float* o = p.out + (size_t)q * DM;
#pragma unroll
  for (int j = 0; j < 4; ++j) { const int c = 4 * lane + 256 * j; *(f32x4*)(o + c) = v[j] * rs * nfv[j]; }
}
__device__ __forceinline__ void ph_final(const Prm& p, int bid, int nb) {
  const int lane = TIDX & 63, wv = __builtin_amdgcn_readfirstlane(TIDX >> 6);
  const int nw = nb * NWAVE, NQ = NB * SEQ, rpw = (NQ + nw - 1) / nw, gw = bid * NWAVE + wv;
  const int q0 = gw * rpw, q1 = min(NQ, q0 + rpw);
#define ROWQ(x) (((x) / SEQ) * TT + LC + ((x) % SEQ))
#define FIN_STORE(x, v) final_store(p, (x), lane, v)
  ROWPIPE(q0, q1, ROWQ, DEPTH, FIN_STORE);
#undef ROWQ
#undef FIN_STORE
}
template <bool ROUTER>
__device__ __forceinline__ void norm_b_row(const Prm& p, int l, int r, int lane, const f32x4 (&v)[4], const float* wl) {
  const int b = r / TT, t = r - b * TT;
  const float* md = WSP(float, OFF_MOD) + (size_t)(l * 5 + (t < LC ? 4 : b)) * 6144;
  f32x4 nwv[4], shv[4], sclv[4];
#pragma unroll
  for (int j = 0; j < 4; ++j) { const int c = 4 * lane + 256 * j; nwv[j] = *(const f32x4*)(p.norm_ffn + l * DM + c); shv[j] = *(const f32x4*)(md + 3 * 1024 + c); sclv[j] = *(const f32x4*)(md + 4 * 1024 + c); }
  const float rs = rsqrtf(row_ssq(v) * (1.f / DM) + EPS);
  bf16_t* H = (bf16_t*)(p.ws + OFF_R + R_H) + (size_t)r * DM;
  float lg[NE];
#pragma unroll
  for (int e = 0; e < NE; ++e) lg[e] = 0.f;
#pragma unroll
  for (int j = 0; j < 4; ++j) { const int c = 4 * lane + 256 * j;
    const f32x4 nw = nwv[j], sh = shv[j], scl = sclv[j];
    const f32x4 h = v[j] * rs * nw * (scl + 1.f) + sh;
    u32x2 o; o.x = pk2(h[0], h[1]); o.y = pk2(h[2], h[3]); *(u32x2*)(H + c) = o;
    if (ROUTER)
#pragma unroll
    for (int ip = 0; ip < 2; ++ip) {
      f32x4 w8[2][4];
#pragma unroll
      for (int i2 = 0; i2 < 2; ++i2)
#pragma unroll
        for (int e4 = 0; e4 < 4; ++e4) w8[i2][e4] = *(const f32x4*)(wl + ((((j * 4 + ip * 2 + i2) * 4 + e4) * 64 + lane) << 2));
      __builtin_amdgcn_sched_barrier(0);
#pragma unroll
      for (int i2 = 0; i2 < 2; ++i2)
#pragma unroll
        for (int e4 = 0; e4 < 4; ++e4) { const float hv = h[ip * 2 + i2]; const f32x4 w4 = w8[i2][e4];
          lg[4 * e4] += hv * w4[0]; lg[4 * e4 + 1] += hv * w4[1]; lg[4 * e4 + 2] += hv * w4[2]; lg[4 * e4 + 3] += hv * w4[3]; }
      __builtin_amdgcn_sched_barrier(0);
    } }
  if (!ROUTER) return;
#pragma unroll
  for (int e = 0; e < NE; ++e) { lg[e] += xor1(lg[e]); lg[e] += xor2(lg[e]); }
  float t8[8], t4[4], t2[2], t1;
#pragma unroll
  for (int i = 0; i < 8; ++i) { auto rr = __builtin_amdgcn_permlane32_swap(__float_as_uint(lg[i]), __float_as_uint(lg[i + 8]), false, false); t8[i] = __uint_as_float(rr[0]) + __uint_as_float(rr[1]); }
#pragma unroll
  for (int i = 0; i < 4; ++i) { auto rr = __builtin_amdgcn_permlane16_swap(__float_as_uint(t8[i]), __float_as_uint(t8[i + 4]), false, false); t4[i] = __uint_as_float(rr[0]) + __uint_as_float(rr[1]); }
  { const bool hb = lane & 8;
#pragma unroll
    for (int i = 0; i < 2; ++i) { const float snd = hb ? t4[i] : t4[i + 2], kp = hb ? t4[i + 2] : t4[i]; t2[i] = kp + xor8(snd); } }
  { const bool hb = lane & 4; const float snd = hb ? t2[0] : t2[1], kp = hb ? t2[1] : t2[0]; t1 = kp + hmir(snd); }
  float mx = t1;
  mx = fmaxf(mx, hmir(mx)); mx = fmaxf(mx, xor8(mx)); mx = max16sw(mx); mx = max32sw(mx);
  const float ex = __expf(t1 - mx); float sm = ex;
  sm += hmir(sm); sm += xor8(sm); sm = sum16sw(sm); sm = sum32sw(sm);
  if ((lane & 3) == 0) WSP(float, OFF_AFF)[(size_t)r * NE + (lane >> 2)] = ex / sm;
}
template <bool ROUTER>
__device__ __forceinline__ void ph_norm_b(const Prm& p, int l, unsigned char* lds, int bid, int nb) {
  const int tid = TIDX, lane = tid & 63, wv = __builtin_amdgcn_readfirstlane(tid >> 6);
  float* wl = (float*)lds;
  { const float* wr = p.w_router + (size_t)l * DM * NE;
    for (int idx = tid; idx < DM * NE; idx += NTHR) { const int d = idx >> 4, e = idx & 15, j = d >> 8, ln = (d >> 2) & 63, i = d & 3;
      wl[((((j * 4 + i) * 4 + (e >> 2)) * 64 + ln) << 2) + (e & 3)] = wr[idx]; } }
  __syncthreads();
  const int nw = nb * NWAVE, rpw = (MR + nw - 1) / nw, gw = bid * NWAVE + wv;
  const int r0 = gw * rpw, r1 = min(MR, r0 + rpw);
  for (int r = r0; r < r1; r += RPI) {
    f32x4 v[RPI][4]; u32x2 mg[RPI][4]; bool sk[RPI];
#pragma unroll
    for (int i = 0; i < RPI; ++i) { sk[i] = (r + i >= r1) || ((l == DEPTH - 1) && ((r + i) % TT) < LC);
      if (!sk[i]) { const float* X = WSP(float, OFF_X) + (size_t)(r + i) * DM; const bf16_t* MG = (const bf16_t*)(p.ws + OFF_R + R_MIXG) + (size_t)(r + i) * DM;
#pragma unroll
        for (int j = 0; j < 4; ++j) { v[i][j] = *(const f32x4*)(X + 4 * lane + 256 * j); mg[i][j] = *(const u32x2*)(MG + 4 * lane + 256 * j); } } }
#pragma unroll
    for (int i = 0; i < RPI; ++i) if (!sk[i]) {
      float* X = WSP(float, OFF_X) + (size_t)(r + i) * DM;
#pragma unroll
      for (int j = 0; j < 4; ++j) { v[i][j][0] += __uint_as_float(mg[i][j].x << 16); v[i][j][1] += __uint_as_float(mg[i][j].x & 0xffff0000u); v[i][j][2] += __uint_as_float(mg[i][j].y << 16); v[i][j][3] += __uint_as_float(mg[i][j].y & 0xffff0000u);
        *(f32x4*)(X + 4 * lane + 256 * j) = v[i][j]; }
      norm_b_row<ROUTER>(p, l, r + i, lane, v[i], wl); }
  }
  __syncthreads();
}

__device__ __forceinline__ void ph_topk(const Prm& p, int l, unsigned char* lds, int bid, int nb) {
  unsigned* keys = (unsigned*)lds;
  unsigned* hist = keys + 8192;
  unsigned* scan = hist + 8 * 256;
  unsigned* misc = scan + 512;
  const int tid = TIDX;
  const float* AFF = WSP(float, OFF_AFF);
  int* IDX = WSP(int, OFF_IDX); float* VAL = WSP(float, OFF_VAL); int* INV = WSP(int, OFF_INV);
  const int ngroups = (l == DEPTH - 1) ? 64 : 128;
  for (int g = bid; g < ngroups; g += nb) {
    const bool isctx = g >= 64; const int b = (g & 63) >> 4, e = g & 15;
    const int n = isctx ? LC : SEQ, cap = isctx ? CAPC : CAPL, r0 = b * TT + (isctx ? 0 : LC);
    const int sbase = isctx ? (NB * NE * CAPL + e * 256 + b * 32) : ((b * NE + e) * CAPL);
    for (int i = tid; i < n; i += NTHR) keys[i] = __float_as_uint(AFF[(size_t)(r0 + i) * NE + e]);
    if (tid == 0) misc[2] = 0;
    __syncthreads();
    unsigned prefix = 0, kk = cap;
    for (int pass = 3; pass >= 0; --pass) {
      for (int i = tid; i < 8 * 256; i += NTHR) hist[i] = 0;
      __syncthreads();
      const int sh = pass * 8; const unsigned hm = pass == 3 ? 0u : (0xffffffffu << (sh + 8));
      unsigned* myh = hist + (tid >> 6) * 256;
      for (int i = tid; i < n; i += NTHR) { const unsigned k = keys[i]; if ((k & hm) == (prefix & hm)) atomicAdd(&myh[(k >> sh) & 255u], 1u); }
      __syncthreads();
      if (tid < 256) { unsigned t_ = 0;
#pragma unroll
        for (int w = 0; w < 8; ++w) t_ += hist[w * 256 + tid];
        hist[tid] = t_; }
      __syncthreads();
      if (tid < 256) { unsigned cum = 0; for (int bk = tid + 1; bk < 256; ++bk) cum += hist[bk];
        const unsigned mine = hist[tid]; if (cum < kk && kk <= cum + mine) { misc[0] = (unsigned)tid; misc[1] = kk - cum; } }
      __syncthreads();
      prefix |= misc[0] << sh; kk = misc[1];
      __syncthreads();
    }
    const int chunk = (n + NTHR - 1) / NTHR; const int i0 = tid * chunk, i1 = min(n, i0 + chunk);
    unsigned eq = 0; for (int i = i0; i < i1; ++i) eq += (keys[i] == prefix) ? 1u : 0u;
    scan[tid] = eq; __syncthreads();
    for (int o = 1; o < NTHR; o <<= 1) { const unsigned a = tid >= o ? scan[tid - o] : 0u; __syncthreads(); scan[tid] += a; __syncthreads(); }
    unsigned erank = scan[tid] - eq;
    const unsigned ngt = cap - kk;
    for (int i = i0; i < i1; ++i) { const unsigned k = keys[i]; int slot = -1;
      if (k > prefix) slot = (int)atomicAdd(&misc[2], 1u);
      else if (k == prefix) { if (erank < kk) slot = (int)(ngt + erank); ++erank; }
      const int row = r0 + i;
      if (slot >= 0) { IDX[sbase + slot] = row; VAL[sbase + slot] = __uint_as_float(k); INV[(size_t)row * NE + e] = sbase + slot; }
      else INV[(size_t)row * NE + e] = -1; }
    if (isctx && tid < 32) { IDX[NB * NE * CAPL + e * 256 + 128 + b * 32 + tid] = 0; VAL[NB * NE * CAPL + e * 256 + 128 + b * 32 + tid] = 0.f; }
    __syncthreads();
  }
}

template <int NF, class AP, class Epi>
__device__ __forceinline__ void sgemm_wave(const AP& ap, const bf16_t* __restrict__ Bt, int K, int m0, int n0, const Epi& epi) {
  const int lane = TIDX & 63, fr = lane & 15, fq = lane >> 4;
  f32x4 acc[4][NF];
#pragma unroll
  for (int i = 0; i < 4; ++i)
#pragma unroll
    for (int j = 0; j < NF; ++j) acc[i][j] = (f32x4){0.f, 0.f, 0.f, 0.f};
  const bf16_t* a_[4]; const bf16_t* b_[NF];
#pragma unroll
  for (int i = 0; i < 4; ++i) a_[i] = ap.row(m0 + 16 * i + fr) + fq * 8;
#pragma unroll
  for (int j = 0; j < NF; ++j) b_[j] = Bt + (size_t)(n0 + 16 * j + fr) * K + fq * 8;
#pragma unroll 2
  for (int k0 = 0; k0 < K; k0 += 32) {
    bf16x8 av[4], bv[NF];
#pragma unroll
    for (int i = 0; i < 4; ++i) av[i] = *(const bf16x8*)(a_[i] + k0);
#pragma unroll
    for (int j = 0; j < NF; ++j) bv[j] = *(const bf16x8*)(b_[j] + k0);
#pragma unroll
    for (int i = 0; i < 4; ++i)
#pragma unroll
      for (int j = 0; j < NF; ++j) acc[i][j] = __builtin_amdgcn_mfma_f32_16x16x32_bf16(av[i], bv[j], acc[i][j], 0, 0, 0);
  }
  epi(acc, m0, n0, fr, fq);
}
struct APDense { const bf16_t* A; int lda; __device__ __forceinline__ const bf16_t* row(int r) const { return A + (size_t)r * lda; } };
struct APGather { const bf16_t* A; const int* idx; __device__ __forceinline__ const bf16_t* row(int r) const { return A + (size_t)idx[r] * DM; } };

__device__ __forceinline__ void rope_pos(int row, bool& lat, int& rp, int& cp) { const int b = row / TT, t = row - b * TT; lat = t >= LC; const int pos = t - LC; rp = pos >> 6; cp = pos & 63; }

struct EpiIn {
  const Prm* pp;
  __device__ __forceinline__ void operator()(f32x4 (&acc)[4][4], int m0, int n0, int fr, int fq) const {
    const Prm& p = *pp; const float* RT = WSP(float, OFF_ROPE);
    if (n0 >= 1472) return;
#pragma unroll
    for (int mf = 0; mf < 4; ++mf)
#pragma unroll
      for (int j = 0; j < 4; ++j) {
        const int row = m0 + 16 * mf + 4 * fq + j; bool lat; int rp, cp; rope_pos(row, lat, rp, cp);
        float v[4] = {acc[mf][0][j], acc[mf][1][j], acc[mf][2][j], acc[mf][3][j]};
        if (n0 < 640) {
          if (lat) { const float c0 = RT[rp * 16 + fr], s0 = RT[2048 + rp * 16 + fr], c1 = RT[cp * 16 + fr], s1 = RT[2048 + cp * 16 + fr];
            const float a = v[0] * c0 - v[1] * s0, bq = v[0] * s0 + v[1] * c0, cq = v[2] * c1 - v[3] * s1, dq = v[2] * s1 + v[3] * c1; v[0] = a; v[1] = bq; v[2] = cq; v[3] = dq; }
          if (n0 < 512) { bf16_t* o = (bf16_t*)(p.ws + OFF_R + R_QA) + (size_t)row * 512 + n0 + fr;
#pragma unroll
            for (int nf = 0; nf < 4; ++nf) o[16 * nf] = f2bf(v[nf] * SCALE_A); }
          else { bf16_t* o = (bf16_t*)(p.ws + OFF_R + R_KA) + (size_t)row * 128 + (n0 - 512) + fr;
#pragma unroll
            for (int nf = 0; nf < 4; ++nf) o[16 * nf] = f2bf(v[nf]); }
        } else if (n0 < 768) { bf16_t* o = (bf16_t*)(p.ws + OFF_R + R_VA) + (size_t)row * 128 + (n0 - 640) + fr;
#pragma unroll
          for (int nf = 0; nf < 4; ++nf) o[16 * nf] = f2bf(v[nf]);
        } else if (n0 < 1152) { bf16_t* o = (bf16_t*)(p.ws + OFF_R + R_CQ) + (size_t)row * QRK + (n0 - 768) + fr;
#pragma unroll
          for (int nf = 0; nf < 4; ++nf) o[16 * nf] = f2bf(v[nf]);
        } else if (n0 < 1408) { bf16_t* o = (bf16_t*)(p.ws + OFF_R + R_CKV) + (size_t)row * KVRK + (n0 - 1152) + fr;
#pragma unroll
          for (int nf = 0; nf < 4; ++nf) o[16 * nf] = f2bf(v[nf]);
        } else {
          const float pr0 = __shfl_xor(v[0], 8), pr1 = __shfl_xor(v[1], 8);
          if (lat) { const int f = fr & 7; const float c0 = RT[4096 + rp * 8 + f], s0 = RT[5120 + rp * 8 + f], c1 = RT[4096 + cp * 8 + f], s1 = RT[5120 + cp * 8 + f];
            v[0] = fr < 8 ? v[0] * c0 - pr0 * s0 : pr0 * s0 + v[0] * c0; v[1] = fr < 8 ? v[1] * c1 - pr1 * s1 : pr1 * s1 + v[1] * c1; }
          bf16_t* o = WSP(bf16_t, OFF_KR) + (size_t)row * 32 + fr; o[0] = f2bf(v[0]); o[16] = f2bf(v[1]);
        }
      }
  }
};
struct EpiQup {
  const Prm* pp;
  __device__ __forceinline__ void operator()(f32x4 (&acc)[4][6], int m0, int n0, int fr, int fq) const {
    const Prm& p = *pp; const float* RT = WSP(float, OFF_ROPE); const float* ssq = WSP(float, OFF_SSQQ);
#pragma unroll
    for (int mf = 0; mf < 4; ++mf)
#pragma unroll
      for (int j = 0; j < 4; ++j) {
        const int row = m0 + 16 * mf + 4 * fq + j; bool lat; int rp, cp; rope_pos(row, lat, rp, cp);
        const float rs = rsqrtf(ssq[row] * (1.f / QRK) + EPS) * SCALE_B;
        float v[6];
#pragma unroll
        for (int nf = 0; nf < 6; ++nf) v[nf] = acc[mf][nf][j] * rs;
        const float pr0 = __shfl_xor(v[4], 8), pr1 = __shfl_xor(v[5], 8);
        if (lat) { const int f = fr & 7; const float c0 = RT[4096 + rp * 8 + f], s0 = RT[5120 + rp * 8 + f], c1 = RT[4096 + cp * 8 + f], s1 = RT[5120 + cp * 8 + f];
          v[4] = fr < 8 ? v[4] * c0 - pr0 * s0 : pr0 * s0 + v[4] * c0; v[5] = fr < 8 ? v[5] * c1 - pr1 * s1 : pr1 * s1 + v[5] * c1; }
        bf16_t* o = (bf16_t*)(p.ws + OFF_R + R_QB) + (size_t)row * NQB + n0 + fr;
#pragma unroll
        for (int nf = 0; nf < 6; ++nf) o[16 * nf] = f2bf(v[nf]);
      }
  }
};
struct EpiKVup {
  const Prm* pp;
  __device__ __forceinline__ void operator()(f32x4 (&acc)[4][4], int m0, int n0, int fr, int fq) const {
    const Prm& p = *pp; const float* ssq = WSP(float, OFF_SSQK);
    const int hd = n0 >> 7, part = (n0 >> 6) & 1;
    bf16_t* base = (bf16_t*)(p.ws + OFF_R + (part ? R_VB : R_KB));
#pragma unroll
    for (int mf = 0; mf < 4; ++mf)
#pragma unroll
      for (int j = 0; j < 4; ++j) {
        const int row = m0 + 16 * mf + 4 * fq + j; const float rs = rsqrtf(ssq[row] * (1.f / KVRK) + EPS);
        bf16_t* o = base + (size_t)row * 512 + hd * 64 + fr;
#pragma unroll
        for (int nf = 0; nf < 4; ++nf) o[16 * nf] = f2bf(acc[mf][nf][j] * rs);
      }
  }
};
struct EpiOut {
  const Prm* pp; int l;
  __device__ __forceinline__ void operator()(f32x4 (&acc)[4][4], int m0, int n0, int fr, int fq) const {
    const Prm& p = *pp; const float* MOD = WSP(float, OFF_MOD);
#pragma unroll
    for (int mf = 0; mf < 4; ++mf)
#pragma unroll
      for (int j = 0; j < 4; ++j) {
        const int row = m0 + 16 * mf + 4 * fq + j; const float* ga = MOD + (size_t)(l * 5 + row_mi(row)) * 6144 + 2 * 1024 + n0 + fr;
        float* X = WSP(float, OFF_X) + (size_t)row * DM + n0 + fr;
#pragma unroll
        for (int nf = 0; nf < 4; ++nf) X[16 * nf] += ga[16 * nf] * acc[mf][nf][j];
      }
  }
};
struct EpiMoeUp {
  const Prm* pp;
  __device__ __forceinline__ void operator()(f32x4 (&acc)[4][4], int m0, int n0, int fr, int fq) const {
    const Prm& p = *pp; const int j0 = n0 >> 1;
#pragma unroll
    for (int mf = 0; mf < 4; ++mf)
#pragma unroll
      for (int j = 0; j < 4; ++j) {
        const int slot = m0 + 16 * mf + 4 * fq + j;
        bf16_t* o = (bf16_t*)(p.ws + OFF_R + R_ACT) + (size_t)slot * DFF + j0 + fr;
        o[0] = f2bf(silu_f(acc[mf][0][j]) * acc[mf][2][j]); o[16] = f2bf(silu_f(acc[mf][1][j]) * acc[mf][3][j]);
      }
  }
};
struct EpiMoeDown {
  const Prm* pp;
  __device__ __forceinline__ void operator()(f32x4 (&acc)[4][4], int m0, int n0, int fr, int fq) const {
    const Prm& p = *pp; const float* VAL = WSP(float, OFF_VAL);
#pragma unroll
    for (int mf = 0; mf < 4; ++mf)
#pragma unroll
      for (int j = 0; j < 4; ++j) {
        const int slot = m0 + 16 * mf + 4 * fq + j; const float vv = VAL[slot];
        bf16_t* o = (bf16_t*)(p.ws + OFF_R + R_Y) + (size_t)slot * DM + n0 + fr;
#pragma unroll
        for (int nf = 0; nf < 4; ++nf) o[16 * nf] = f2bf(acc[mf][nf][j] * vv);
      }
  }
};

__device__ __forceinline__ void ph_gemm_in(const Prm& p, int l, int bid, int nb) {
  const int wv = TIDX >> 6, wm = wv >> 1, wn = wv & 1;
  const bf16_t* Bt = (const bf16_t*)(p.ws + OFF_W + (size_t)l * SZ_WL);
  APDense ap{(const bf16_t*)(p.ws + OFF_R + R_H), DM}; EpiIn epi{&p};
  constexpr int NCT = NINP / 128;
  for (int it = bid; it < (MR / 256) * NCT; it += nb) { const int rt = it / NCT, ct = it % NCT;
    sgemm_wave<4>(ap, Bt, DM, rt * 256 + wm * 64, ct * 128 + wn * 64, epi); }
}
__device__ __forceinline__ void ph_ssq(const Prm& p, int bid, int nb) {
  const int lane = TIDX & 63, wv = TIDX >> 6;
  for (int r = bid * NWAVE + wv; r < MR; r += nb * NWAVE) {
    const bf16_t* cq = (const bf16_t*)(p.ws + OFF_R + R_CQ) + (size_t)r * QRK; const bf16_t* ck = (const bf16_t*)(p.ws + OFF_R + R_CKV) + (size_t)r * KVRK;
    float s = 0.f; for (int i = lane; i < QRK; i += 64) { const float v = bf2f(cq[i]); s += v * v; }
    float s2 = 0.f; for (int i = lane; i < KVRK; i += 64) { const float v = bf2f(ck[i]); s2 += v * v; }
    s = wave_sum(s); s2 = wave_sum(s2);
    if (lane == 0) { WSP(float, OFF_SSQQ)[r] = s; WSP(float, OFF_SSQK)[r] = s2; }
  }
}
__device__ __forceinline__ void ph_gemm_up(const Prm& p, int l, int bid, int nb) {
  const int wv = TIDX >> 6, wm = wv >> 1, wn = wv & 1;
  const bf16_t* WQ = (const bf16_t*)(p.ws + OFF_W + (size_t)l * SZ_WL + SZ_WIN);
  const bf16_t* WKV = (const bf16_t*)(p.ws + OFF_W + (size_t)l * SZ_WL + SZ_WIN + SZ_WQ);
  constexpr int IQ = (MR / 256) * 4, IKV = (MR / 256) * 8;
  for (int it = bid; it < IQ + IKV; it += nb) {
    if (it < IQ) { const int rt = it / 4, ct = it % 4; APDense ap{(const bf16_t*)(p.ws + OFF_R + R_CQ), QRK}; EpiQup epi{&p};
      sgemm_wave<6>(ap, WQ, QRK, rt * 256 + wm * 64, ct * 192 + wn * 96, epi); }
    else { const int i2 = it - IQ, rt = i2 / 8, ct = i2 % 8; APDense ap{(const bf16_t*)(p.ws + OFF_R + R_CKV), KVRK}; EpiKVup epi{&p};
      sgemm_wave<4>(ap, WKV, KVRK, rt * 256 + wm * 64, ct * 128 + wn * 64, epi); }
  }
}
__device__ __forceinline__ void ph_gemm_out(const Prm& p, int l, int bid, int nb) {
  const int wv = TIDX >> 6, wm = wv >> 1, wn = wv & 1;
  const bf16_t* Bt = (const bf16_t*)(p.ws + OFF_W + (size_t)l * SZ_WL + SZ_WIN + SZ_WQ + SZ_WKV);
  APDense ap{(const bf16_t*)(p.ws + OFF_R + R_H), DM}; EpiOut epi{&p, l};
  for (int it = bid; it < (MR / 256) * 8; it += nb) { const int rt = it / 8, ct = it % 8;
    sgemm_wave<4>(ap, Bt, DM, rt * 256 + wm * 64, ct * 128 + wn * 64, epi); }
}
__device__ __forceinline__ void ph_moe_up(const Prm& p, int l, int bid, int nb) {
  const int wv = TIDX >> 6, wm = wv >> 1, wn = wv & 1;
  const int nrt = (l == DEPTH - 1) ? 256 : 272;
  APGather ap{(const bf16_t*)(p.ws + OFF_R + R_H), WSP(int, OFF_IDX)}; EpiMoeUp epi{&p};
  for (int it = bid; it < nrt * 8; it += nb) { const int rt = it / 8, ct = it % 8; const int e = rt < 256 ? ((rt >> 2) & 15) : rt - 256;
    sgemm_wave<4>(ap, WSP(bf16_t, OFF_WGU) + (size_t)e * 1024 * 1024, DM, rt * 256 + wm * 64, ct * 128 + wn * 64, epi); }
}
__device__ __forceinline__ void ph_moe_down(const Prm& p, int l, int bid, int nb) {
  const int wv = TIDX >> 6, wm = wv >> 1, wn = wv & 1;
  const int nrt = (l == DEPTH - 1) ? 256 : 272;
  APDense ap{(const bf16_t*)(p.ws + OFF_R + R_ACT), DFF}; EpiMoeDown epi{&p};
  for (int it = bid; it < nrt * 8; it += nb) { const int rt = it / 8, ct = it % 8; const int e = rt < 256 ? ((rt >> 2) & 15) : rt - 256;
    sgemm_wave<4>(ap, WSP(bf16_t, OFF_WD) + (size_t)e * 1024 * 512, DFF, rt * 256 + wm * 64, ct * 128 + wn * 64, epi); }
}

namespace pg8 {
#define PG8_LAS __attribute__((address_space(3)))
constexpr int BM = 256, BK = 64, HALF = 128, HTB = HALF * BK * 2, STAGE_BYTES = 8 * HTB;
__device__ __forceinline__ int lds_byte(int r, int c) { const int st = (r >> 4) * 2 + (c >> 5), rr = r & 15, cc = c & 31, ob = rr * 64 + cc * 2; return st * 1024 + (ob ^ (((ob >> 9) & 1) << 5)); }
__device__ __forceinline__ void stage_rc(int b, int& R, int& C) { const int st = b / 1024, sb = b % 1024, swz = sb ^ (((sb >> 9) & 1) << 5); R = (st >> 1) * 16 + swz / 64; C = (st & 1) * 32 + (swz % 64) / 2; }
struct Unit { int pm, pn; size_t boff; int r0; };
struct Gemm { const bf16_t* A; const bf16_t* Bt; int K; const int* idx; };
template <bool GATHER, bool HALFM = false, class Epi, class Sched>
__device__ __forceinline__ void gemm_phase(PG8_LAS unsigned char* lds, const Gemm g, const Sched& S, const Epi& E) {
    const int tid = TIDX, wid = __builtin_amdgcn_readfirstlane(tid >> 6), lane = tid & 63, wr = wid >> 2, wc = wid & 3, fr = lane & 15, fq = lane >> 4;
    const int K = g.K, nt = K / BK;
    int RA[2], CA[2]; unsigned voffB[2], voffA[2];
#pragma unroll
    for (int i = 0; i < 2; ++i) { int R, C; stage_rc(tid * 16 + i * 8192, R, C); RA[i] = R; CA[i] = C; voffA[i] = (unsigned)(R * K + C) * 2u; voffB[i] = voffA[i]; }
    const size_t kstep = (size_t)(BK * 2);
    const size_t hstep = (size_t)HALF * K * 2;
    const size_t tstep = 2 * hstep;
    const unsigned ldsw = (unsigned)wid * 1024u;
    const int aoff = lds_byte(wr * 64 + fr, fq * 8), boff = lds_byte(wc * 32 + fr, fq * 8);
#define PG8_SA(b, h) (((b) * 2 + (h)) * HTB)
#define PG8_SB(b, h) ((4 + (b) * 2 + (h)) * HTB)
#define PG8_STAGE(bufoff, gbase, voff) do { _Pragma("unroll") for (int _i = 0; _i < 2; ++_i) \
        __builtin_amdgcn_global_load_lds((const unsigned*)((const char*)(gbase) + (voff)[_i]), (PG8_LAS unsigned*)(lds + (bufoff) + ldsw + _i * 8192), 16, 0, 0); } while (0)
#define PG8_LDA(dst, b, h) do { _Pragma("unroll") for (int m = 0; m < 4; ++m) _Pragma("unroll") for (int k = 0; k < 2; ++k) dst[m][k] = *(const PG8_LAS bf16x8*)(lds + PG8_SA(b, h) + aoff + m * 2048 + k * 1024); } while (0)
#define PG8_LDB(dst, b, h) do { _Pragma("unroll") for (int n = 0; n < 2; ++n) _Pragma("unroll") for (int k = 0; k < 2; ++k) dst[n][k] = *(const PG8_LAS bf16x8*)(lds + PG8_SB(b, h) + boff + n * 2048 + k * 1024); } while (0)
#define PG8_MMA(ai, bj, At, Bt) do { __builtin_amdgcn_s_setprio(1); _Pragma("unroll") for (int m = 0; m < 4; ++m) _Pragma("unroll") for (int n = 0; n < 2; ++n) _Pragma("unroll") for (int k = 0; k < 2; ++k) \
        acc[ai][bj][m][n] = __builtin_amdgcn_mfma_f32_16x16x32_bf16(Bt[n][k], At[m][k], acc[ai][bj][m][n], 0, 0, 0); __builtin_amdgcn_s_setprio(0); } while (0)
#define PG8_WAIT_V(n) asm volatile("s_waitcnt vmcnt(" #n ")" ::: "memory")
#define PG8_WAIT_L(n) asm volatile("s_waitcnt lgkmcnt(" #n ")" ::: "memory")
#define PG8_BAR __builtin_amdgcn_s_barrier()
#define PG8_SCHED __builtin_amdgcn_sched_barrier(0)
    Unit cur, nxt; int ui = 0;
    if (!S.next(0, cur)) return;
    f32x4 acc[2][2][4][2];
#pragma unroll
    for (int a = 0; a < 2; ++a)
#pragma unroll
        for (int b = 0; b < 2; ++b)
#pragma unroll
            for (int m = 0; m < 4; ++m)
#pragma unroll
                for (int n = 0; n < 2; ++n) acc[a][b][m][n] = (f32x4){0.f, 0.f, 0.f, 0.f};
    bf16x8 At[4][2], B0[2][2], B1[2][2];
    unsigned oc0[2], oc1[2], on0[2], on1[2];
    auto set_off = [&](const Unit& u, unsigned (&o0)[2], unsigned (&o1)[2]) {
        if constexpr (GATHER) {
#pragma unroll
            for (int i = 0; i < 2; ++i) { const int r0 = g.idx[u.r0 + RA[i]], r1 = g.idx[u.r0 + HALF + RA[i]]; o0[i] = (unsigned)(r0 * K + CA[i]) * 2u; o1[i] = (unsigned)(r1 * K + CA[i]) * 2u; }
        } else {
#pragma unroll
            for (int i = 0; i < 2; ++i) { o0[i] = voffA[i]; o1[i] = voffA[i] + (unsigned)hstep; }
        }
    };
    auto a_base = [&](const Unit& u) -> const char* { if constexpr (GATHER) return (const char*)g.A; else return (const char*)g.A + (size_t)u.r0 * (size_t)(K * 2); };
    const char* cA = a_base(cur); const char* cB = (const char*)g.Bt + cur.boff + (size_t)cur.pn * tstep;
    set_off(cur, oc0, oc1);
    PG8_STAGE(PG8_SB(0, 0), cB, voffB); PG8_STAGE(PG8_SB(0, 1), cB + hstep, voffB); PG8_STAGE(PG8_SA(0, 0), cA, oc0); PG8_STAGE(PG8_SA(0, 1), cA, oc1);
    if (wr == 1) PG8_BAR;
    PG8_WAIT_V(2); PG8_BAR;
    PG8_STAGE(PG8_SB(1, 0), cB + kstep, voffB); PG8_STAGE(PG8_SA(1, 0), cA + kstep, oc0); PG8_STAGE(PG8_SB(1, 1), cB + hstep + kstep, voffB);
    PG8_WAIT_V(6); PG8_BAR;
    for (;;) {
        const bool has_next = S.next(ui + 1, nxt);
        const char* nA = has_next ? a_base(nxt) : cA; const char* nB = has_next ? (const char*)g.Bt + nxt.boff + (size_t)nxt.pn * tstep : cB;
        if (has_next) set_off(nxt, on0, on1); else {
#pragma unroll
            for (int i = 0; i < 2; ++i) { on0[i] = oc0[i]; on1[i] = oc1[i]; } }
#pragma unroll 1
        for (int t = 0; t < nt; t += 2) {
            const bool last = (t == nt - 2);
            const char* a1 = cA + (size_t)(t + 1) * kstep;
            const char* a2 = last ? nA : cA + (size_t)(t + 2) * kstep; const char* b2 = last ? nB : cB + (size_t)(t + 2) * kstep;
            const char* a3 = a2 + kstep; const char* b3 = b2 + kstep;
            unsigned o20[2], o21[2];
#pragma unroll
            for (int i = 0; i < 2; ++i) { o20[i] = last ? on0[i] : oc0[i]; o21[i] = last ? on1[i] : oc1[i]; }
            PG8_LDB(B0, 0, 0); PG8_LDB(B1, 0, 1); PG8_SCHED; PG8_LDA(At, 0, 0); PG8_STAGE(PG8_SA(1, 1), a1, oc1);
            PG8_WAIT_V(8); PG8_WAIT_L(0); PG8_BAR; PG8_MMA(0, 0, At, B0); PG8_MMA(0, 1, At, B1); PG8_BAR; PG8_SCHED;
            if constexpr (!HALFM) { PG8_LDA(At, 0, 1); } PG8_STAGE(PG8_SB(0, 0), b2, voffB); PG8_STAGE(PG8_SB(0, 1), b2 + hstep, voffB); PG8_STAGE(PG8_SA(0, 0), a2, o20);
            PG8_WAIT_V(8); PG8_WAIT_L(0); PG8_BAR; if constexpr (!HALFM) { PG8_MMA(1, 0, At, B0); PG8_MMA(1, 1, At, B1); } PG8_BAR; PG8_SCHED;
            PG8_LDB(B0, 1, 0); PG8_LDB(B1, 1, 1); PG8_SCHED; PG8_LDA(At, 1, 0); PG8_STAGE(PG8_SA(0, 1), a2, o21);
            PG8_WAIT_V(8); PG8_WAIT_L(0); PG8_BAR; PG8_MMA(0, 0, At, B0); PG8_MMA(0, 1, At, B1); PG8_BAR; PG8_SCHED;
            if constexpr (!HALFM) { PG8_LDA(At, 1, 1); } PG8_STAGE(PG8_SB(1, 0), b3, voffB); PG8_STAGE(PG8_SB(1, 1), b3 + hstep, voffB); PG8_STAGE(PG8_SA(1, 0), a3, o20);
            PG8_WAIT_V(8); PG8_WAIT_L(0); PG8_BAR; if constexpr (!HALFM) { PG8_MMA(1, 0, At, B0); PG8_MMA(1, 1, At, B1); } PG8_BAR; PG8_SCHED;
        }
        if (wr == 0) PG8_BAR;
        E.template run<HALFM>(acc, cur, wr, wc, fr, fq, lds, tid);
        if (!has_next) break;
#pragma unroll
        for (int a = 0; a < 2; ++a)
#pragma unroll
            for (int b = 0; b < 2; ++b)
#pragma unroll
                for (int m = 0; m < 4; ++m)
#pragma unroll
                    for (int n = 0; n < 2; ++n) acc[a][b][m][n] = (f32x4){0.f, 0.f, 0.f, 0.f};
        cur = nxt; cA = nA; cB = nB; ++ui;
#pragma unroll
        for (int i = 0; i < 2; ++i) { oc0[i] = on0[i]; oc1[i] = on1[i]; }
        if (wr == 1) PG8_BAR;
    }
    PG8_WAIT_V(0);
    PG8_BAR;
#undef PG8_SA
#undef PG8_SB
#undef PG8_STAGE
#undef PG8_LDA
#undef PG8_LDB
#undef PG8_MMA
#undef PG8_WAIT_V
#undef PG8_WAIT_L
#undef PG8_BAR
#undef PG8_SCHED
}
}

__device__ __forceinline__ int vcu_of(int bid, int nb) { return (nb % 8 == 0) ? (bid % 8) * (nb / 8) + bid / 8 : bid; }
struct SchedDense { int nM, nN, G, c; bool rev; bool skipctx; int lim;
  __device__ __forceinline__ bool next(int i, pg8::Unit& u) const { const int L = i * G + (rev ? G - 1 - c : c); if (L >= lim) return false; int pm = L / nN; u.pn = L % nN;
    if (skipctx) pm = pm + pm / 32 + 1; u.pm = pm; u.r0 = pm * 256; u.boff = 0; return true; } };
struct SchedDenseTail { int nN, base, nh, c;
  __device__ __forceinline__ bool next(int i, pg8::Unit& u) const { if (i > 0 || c >= nh) return false; const int L = base + (c >> 1); u.pm = L / nN; u.pn = L % nN;
    u.r0 = u.pm * 256 + (c & 1) * 128; u.boff = 0; return true; } };
struct SchedMoe { int nrt, G, c; size_t estride;
  __device__ __forceinline__ bool next(int i, pg8::Unit& u) const { const int L = i * G + c; if (L >= nrt * 4) return false; u.pm = L >> 2; u.pn = L & 3; u.r0 = u.pm * 256;
    const int e = u.pm < 256 ? ((u.pm >> 2) & 15) : u.pm - 256; u.boff = (size_t)e * estride; return true; } };
struct SchedMoeTail { int c; size_t estride;
  __device__ __forceinline__ bool next(int i, pg8::Unit& u) const { if (i > 0 || (c & 15) >= 4 || (c >> 4) >= NE) return false; const int e = c >> 4; u.pm = 256 + e; u.pn = c & 15;
    u.r0 = u.pm * 256; u.boff = (size_t)e * estride; return true; } };

__device__ __forceinline__ f32x4 shfl32(f32x4 v) { f32x4 r;
#pragma unroll
  for (int i = 0; i < 4; ++i) { auto x = __builtin_amdgcn_permlane32_swap(__float_as_uint(v[i]), __float_as_uint(v[i]), false, false); r[i] = __uint_as_float((TIDX & 32) ? x[0] : x[1]); }
  return r; }
__device__ __forceinline__ void rope32_grp(f32x4& v0, f32x4& v1, const float* RT, int rp, int cp, int fq) {
  const f32x4 p0 = shfl32(v0), p1 = shfl32(v1); const int f = 4 * (fq & 1);
  const f32x4 c0 = *(const f32x4*)(RT + 4096 + rp * 8 + f), s0 = *(const f32x4*)(RT + 5120 + rp * 8 + f), c1 = *(const f32x4*)(RT + 4096 + cp * 8 + f), s1 = *(const f32x4*)(RT + 5120 + cp * 8 + f);
  if (fq < 2) { v0 = v0 * c0 - p0 * s0; v1 = v1 * c1 - p1 * s1; } else { v0 = p0 * s0 + v0 * c0; v1 = p1 * s1 + v1 * c1; }
}
constexpr int ROPE_TAB_OFF = 131072 + 16384 + 128;
constexpr int STG_OFF = 131072, STG_OFF2 = 3 * 16384  , STG_RS = 512;
#define WSE(T, off) ((T*)(ws + (off)))
template <bool HM, class Epi>
__device__ __forceinline__ void epi_staged(const Epi& E, f32x4 (&acc)[2][2][4][2], const pg8::Unit& u, int wr, int wc, int fr, int fq, PG8_LAS unsigned char* lds, int tid) {
  constexpr int NCH = Epi::NCOL / 8, NPASS = 32 * NCH / NTHR;
  typename Epi::Ctx ctx; E.begin(ctx, u, wr, wc, fr, fq);
  const PG8_LAS float* rtab = (const PG8_LAS float*)(lds + ROPE_TAB_OFF);
  unsigned wofs[2][2], rofs[NPASS], gofs[NPASS], gld[NPASS]; bool gval[NPASS];
#pragma unroll
  for (int bj = 0; bj < 2; ++bj)
#pragma unroll
    for (int n = 0; n < 2; ++n) { const unsigned chunk = bj * 16 + wc * 4 + n * 2 + (fq >> 1); wofs[bj][n] = Epi::LEAN ? 0u : (unsigned)(wr * 16 + fr) * STG_RS + ((chunk ^ (unsigned)fr) << 4) + (fq & 1) * 8; }
#pragma unroll
  for (int ps = 0; ps < NPASS; ++ps) { const unsigned c = (unsigned)tid + NTHR * ps, rl = c / NCH, ch = c % NCH;
    rofs[ps] = rl * STG_RS + ((ch ^ (rl & 15u)) << 4);
    E.dst(u, (int)((rl >> 4) * 64 + (rl & 15u)), (int)(ch * 8), gofs[ps], gld[ps], gval[ps]); }
#pragma unroll
  for (int ai = 0; ai < (HM ? 1 : 2); ++ai)
#pragma unroll
    for (int m = 0; m < 4; ++m) {
      PG8_LAS unsigned char* stg = lds + ((m & 1) ? STG_OFF2 : STG_OFF);
      f32x4 v[2][2] = {{acc[ai][0][m][0], acc[ai][0][m][1]}, {acc[ai][1][m][0], acc[ai][1][m][1]}};
      E.pre(v, ai * 128 + m * 16, ai, m, ctx, u, wc, fr, fq, rtab);
#pragma unroll
      for (int bj = 0; bj < Epi::NCOL / 128; ++bj)
#pragma unroll
        for (int n = 0; n < 2; ++n) { u32x2 w; w.x = cvtpk_e(v[bj][n][0], v[bj][n][1]); w.y = cvtpk_e(v[bj][n][2], v[bj][n][3]);
          unsigned wo = wofs[bj][n];
          if (Epi::LEAN) { int frl = fr; asm volatile("" : "+v"(frl)); const unsigned chunk = bj * 16 + wc * 4 + n * 2 + (fq >> 1); wo = (unsigned)(wr * 16 + frl) * STG_RS + ((chunk ^ (unsigned)frl) << 4) + (fq & 1) * 8; }
          *(PG8_LAS u32x2*)(stg + wo) = w; }
      asm volatile("s_waitcnt lgkmcnt(0)" ::: "memory"); __builtin_amdgcn_s_barrier(); asm volatile("" ::: "memory");
#pragma unroll
      for (int ps = 0; ps < NPASS; ++ps) {
        const u32x4 val = *(const PG8_LAS u32x4*)(stg + rofs[ps]);
        unsigned go = gofs[ps]; asm volatile("" : "+v"(go));
        if (gval[ps]) __builtin_nontemporal_store(val, (u32x4*)(E.ws + (size_t)(go + (unsigned)(ai * 128 + m * 16) * gld[ps]))); }
    }
  asm volatile("s_waitcnt lgkmcnt(0)" ::: "memory"); __builtin_amdgcn_s_barrier(); asm volatile("" ::: "memory");
}
#define EPI_RUN   template <bool HM> __device__ __forceinline__ void run(f32x4 (&acc)[2][2][4][2], const pg8::Unit& u, int wr, int wc, int fr, int fq, PG8_LAS unsigned char* lds, int tid) const { epi_staged<HM>(*this, acc, u, wr, wc, fr, fq, lds, tid); }
__device__ __forceinline__ void rot4(f32x4& x1, f32x4& x2, int pos, const f32x4& w) {
  f32x4 c, sn;
#pragma unroll
  for (int j = 0; j < 4; ++j) { const float a = __builtin_amdgcn_fractf((float)pos * w[j]); c[j] = __builtin_amdgcn_cosf(a); sn[j] = __builtin_amdgcn_sinf(a); }
  const f32x4 a = x1 * c - x2 * sn, b = x1 * sn + x2 * c; x1 = a; x2 = b;
}
__device__ __forceinline__ f32x4 rope_w(int i0, float nf) { f32x4 w;
#pragma unroll
  for (int j = 0; j < 4; ++j) w[j] = exp2f(-(float)(i0 + j) * (13.287712379549449f / nf)) * 0.15915494309189535f;
  return w; }
__device__ __forceinline__ void rope32_hw(f32x4& v0, f32x4& v1, int rp, int cp, int fq, const f32x4& w32) {
  const f32x4 p0 = shfl32(v0), p1 = shfl32(v1);
  f32x4 c0, s0, c1, s1;
#pragma unroll
  for (int j = 0; j < 4; ++j) { const float a = __builtin_amdgcn_fractf((float)rp * w32[j]), bq = __builtin_amdgcn_fractf((float)cp * w32[j]);
    c0[j] = __builtin_amdgcn_cosf(a); s0[j] = __builtin_amdgcn_sinf(a); c1[j] = __builtin_amdgcn_cosf(bq); s1[j] = __builtin_amdgcn_sinf(bq); }
  if (fq < 2) { v0 = v0 * c0 - p0 * s0; v1 = v1 * c1 - p1 * s1; } else { v0 = p0 * s0 + v0 * c0; v1 = p1 * s1 + v1 * c1; }
}
__device__ __forceinline__ void tile_pos(int pm, bool& lat, int& pos0) { const int tb = pm % 33; lat = tb != 0; pos0 = (tb - 1) * 256; }
struct Epi2In {
  static constexpr int NCOL = 256; static constexpr bool LEAN = true;
  EPI_RUN
  unsigned char* ws;
  struct Ctx { int pos0, rloc; bool lat; };
  __device__ __forceinline__ void begin(Ctx& c, const pg8::Unit& u, int wr, int wc, int fr, int fq) const {
    c.rloc = wr * 64 + fr; tile_pos(u.pm, c.lat, c.pos0); c.pos0 += c.rloc + (u.r0 - u.pm * 256); }
  __device__ __forceinline__ void dst(const pg8::Unit& u, int rsub, int col, unsigned& gofs, unsigned& gld, bool& gval) const {
    const int gc = u.pn * 256 + col; const unsigned row = (unsigned)(u.r0 + rsub);
    const unsigned ld = gc < 512 ? 512u : gc < 768 ? 128u : gc < 1152 ? (unsigned)QRK : gc < 1408 ? (unsigned)KVRK : 32u;
    const unsigned base = gc < 512 ? (unsigned)(OFF_R + R_QA) : gc < 640 ? (unsigned)(OFF_R + R_KA) : gc < 768 ? (unsigned)(OFF_R + R_VA) : gc < 1152 ? (unsigned)(OFF_R + R_CQ) : gc < 1408 ? (unsigned)(OFF_R + R_CKV) : (unsigned)OFF_KR;
    const unsigned c0 = gc < 512 ? 0u : gc < 640 ? 512u : gc < 768 ? 640u : gc < 1152 ? 768u : gc < 1408 ? 1152u : 1408u;
    gval = gc < 1440; gld = ld * 2; gofs = base + row * gld + ((unsigned)gc - c0) * 2;
  }
  __device__ __forceinline__ void pre(f32x4 (&v)[2][2], int rowstep, int ai, int m, const Ctx& c, const pg8::Unit& u, int wc, int fr, int fq, const PG8_LAS float* rtab) const {
    int pos = c.pos0 + rowstep; asm volatile("" : "+v"(pos));
    const int rp = pos >> 6, cp = pos & 63; const bool lat = c.lat;
#pragma unroll
    for (int bj = 0; bj < 2; ++bj) {
      const int cg = u.pn * 256 + bj * 128 + wc * 32, g32 = cg >> 5;
      f32x4& v0 = v[bj][0]; f32x4& v1 = v[bj][1];
      if (g32 < 20) {
        if (lat) { const f32x4 w64 = *(const PG8_LAS f32x4*)(rtab + 4 * fq); rot4(v0, v1, (g32 & 1) ? cp : rp, w64); }
        if (g32 < 16) { v0 = v0 * SCALE_A; v1 = v1 * SCALE_A; }
      } else if (g32 >= 24 && g32 < 44) {
        float sq = v0[0] * v0[0] + v0[1] * v0[1] + v0[2] * v0[2] + v0[3] * v0[3] + v1[0] * v1[0] + v1[1] * v1[1] + v1[2] * v1[2] + v1[3] * v1[3];
        sq = sum16sw(sq); sq = sum32sw(sq);
        if (fq == 0) atomicAdd(WSE(float, g32 < 36 ? OFF_SSQQ : OFF_SSQK) + (u.r0 + rowstep + c.rloc), sq);
      } else if (g32 == 44) { if (lat) { const f32x4 w32 = *(const PG8_LAS f32x4*)(rtab + 16 + 4 * (fq & 1)); rope32_hw(v0, v1, rp, cp, fq, w32); } }
    }
  }
};
struct Epi2Qup {
  static constexpr int NCOL = 256; static constexpr bool LEAN = false;
  EPI_RUN
  unsigned char* ws;
  struct Ctx { float rs[2][4]; int pos0; bool lat; };
  __device__ __forceinline__ void begin(Ctx& c, const pg8::Unit& u, int wr, int wc, int fr, int fq) const {
    tile_pos(u.pm, c.lat, c.pos0); c.pos0 += wr * 64 + fr + (u.r0 - u.pm * 256);
#pragma unroll
    for (int ai = 0; ai < 2; ++ai)
#pragma unroll
      for (int m = 0; m < 4; ++m) c.rs[ai][m] = WSE(float, OFF_SSQQ)[u.r0 + ai * 128 + wr * 64 + m * 16 + fr];
#pragma unroll
    for (int ai = 0; ai < 2; ++ai)
#pragma unroll
      for (int m = 0; m < 4; ++m) c.rs[ai][m] = rsqrtf(c.rs[ai][m] * (1.f / QRK) + EPS) * SCALE_B; }
  __device__ __forceinline__ void dst(const pg8::Unit& u, int rsub, int col, unsigned& gofs, unsigned& gld, bool& gval) const {
    gld = NQB * 2; gofs = (unsigned)(OFF_R + R_QB) + (unsigned)(u.r0 + rsub) * gld + (u.pn * 256 + col) * 2; gval = true; }
  __device__ __forceinline__ void pre(f32x4 (&v)[2][2], int rowstep, int ai, int m, const Ctx& c, const pg8::Unit& u, int wc, int fr, int fq, const PG8_LAS float* rtab) const {
    int pos = c.pos0 + rowstep; asm volatile("" : "+v"(pos));
    const int rp = pos >> 6, cp = pos & 63; const float rs = c.rs[ai][m];
#pragma unroll
    for (int bj = 0; bj < 2; ++bj) { const int g32 = (u.pn * 256 + bj * 128 + wc * 32) >> 5;
      v[bj][0] = v[bj][0] * rs; v[bj][1] = v[bj][1] * rs;
      if ((g32 % 3) == 2) { if (c.lat) { const f32x4 w32 = *(const PG8_LAS f32x4*)(rtab + 16 + 4 * (fq & 1)); rope32_hw(v[bj][0], v[bj][1], rp, cp, fq, w32); } } }
  }
};
struct Epi2KV {
  static constexpr int NCOL = 256; static constexpr bool LEAN = false;
  EPI_RUN
  unsigned char* ws;
  struct Ctx { float rs[2][4]; };
  __device__ __forceinline__ void begin(Ctx& c, const pg8::Unit& u, int wr, int wc, int fr, int fq) const {
#pragma unroll
    for (int ai = 0; ai < 2; ++ai)
#pragma unroll
      for (int m = 0; m < 4; ++m) c.rs[ai][m] = WSE(float, OFF_SSQK)[u.r0 + ai * 128 + wr * 64 + m * 16 + fr];
#pragma unroll
    for (int ai = 0; ai < 2; ++ai)
#pragma unroll
      for (int m = 0; m < 4; ++m) c.rs[ai][m] = rsqrtf(c.rs[ai][m] * (1.f / KVRK) + EPS); }
  __device__ __forceinline__ void dst(const pg8::Unit& u, int rsub, int col, unsigned& gofs, unsigned& gld, bool& gval) const {
    const int gc = u.pn * 256 + col, hd = gc >> 7, sub = (gc >> 6) & 1;
    gld = 512 * 2; gofs = (unsigned)(OFF_R + (sub ? R_VB : R_KB)) + (unsigned)(u.r0 + rsub) * gld + (hd * 64 + (gc & 63)) * 2; gval = true; }
  __device__ __forceinline__ void pre(f32x4 (&v)[2][2], int rowstep, int ai, int m, const Ctx& c, const pg8::Unit& u, int wc, int fr, int fq, const PG8_LAS float* rtab) const {
    const float rs = c.rs[ai][m];
#pragma unroll
    for (int bj = 0; bj < 2; ++bj) { v[bj][0] = v[bj][0] * rs; v[bj][1] = v[bj][1] * rs; }
  }
};
struct Epi2Out {
  static constexpr int NCOL = 256; static constexpr bool LEAN = false;
  EPI_RUN
  unsigned char* ws; int l;
  struct Ctx { f32x4 ga[2][2]; };
  __device__ __forceinline__ void begin(Ctx& c, const pg8::Unit& u, int wr, int wc, int fr, int fq) const {
    const float* ga = WSE(float, OFF_MOD) + (size_t)(l * 5 + row_mi(u.pm * 256)) * 6144 + 2 * 1024 + u.pn * 256 + wc * 32 + 4 * fq;
#pragma unroll
    for (int bj = 0; bj < 2; ++bj)
#pragma unroll
      for (int n = 0; n < 2; ++n) c.ga[bj][n] = *(const f32x4*)(ga + bj * 128 + n * 16); }
  __device__ __forceinline__ void dst(const pg8::Unit& u, int rsub, int col, unsigned& gofs, unsigned& gld, bool& gval) const {
    gld = DM * 2; gofs = (unsigned)(OFF_R + R_MIXG) + (unsigned)(u.r0 + rsub) * gld + (u.pn * 256 + col) * 2; gval = true; }
  __device__ __forceinline__ void pre(f32x4 (&v)[2][2], int rowstep, int ai, int m, const Ctx& c, const pg8::Unit& u, int wc, int fr, int fq, const PG8_LAS float* rtab) const {
#pragma unroll
    for (int bj = 0; bj < 2; ++bj)
#pragma unroll
      for (int n = 0; n < 2; ++n) v[bj][n] = v[bj][n] * c.ga[bj][n];
  }
};
struct Epi2MoeUp {
  static constexpr int NCOL = 128; static constexpr bool LEAN = false;
  EPI_RUN
  unsigned char* ws;
  struct Ctx { };
  __device__ __forceinline__ void begin(Ctx& c, const pg8::Unit& u, int wr, int wc, int fr, int fq) const { }
  __device__ __forceinline__ void dst(const pg8::Unit& u, int rsub, int col, unsigned& gofs, unsigned& gld, bool& gval) const {
    gld = DFF * 2; gofs = (unsigned)(OFF_R + R_ACT) + (unsigned)(u.r0 + rsub) * gld + (u.pn * 128 + col) * 2; gval = true; }
  __device__ __forceinline__ void pre(f32x4 (&v)[2][2], int rowstep, int ai, int m, const Ctx& c, const pg8::Unit& u, int wc, int fr, int fq, const PG8_LAS float* rtab) const {
#pragma unroll
    for (int n = 0; n < 2; ++n)
#pragma unroll
      for (int j = 0; j < 4; ++j) v[0][n][j] = silu_fast(v[0][n][j]) * v[1][n][j];
  }
};
struct Epi2MoeDown {
  static constexpr int NCOL = 256; static constexpr bool LEAN = false;
  EPI_RUN
  unsigned char* ws;
  struct Ctx { float vv[2][4]; };
  __device__ __forceinline__ void begin(Ctx& c, const pg8::Unit& u, int wr, int wc, int fr, int fq) const {
#pragma unroll
    for (int ai = 0; ai < 2; ++ai)
#pragma unroll
      for (int m = 0; m < 4; ++m) c.vv[ai][m] = WSE(float, OFF_VAL)[u.r0 + ai * 128 + wr * 64 + m * 16 + fr]; }
  __device__ __forceinline__ void dst(const pg8::Unit& u, int rsub, int col, unsigned& gofs, unsigned& gld, bool& gval) const {
    gld = DM * 2; gofs = (unsigned)(OFF_R + R_Y) + (unsigned)(u.r0 + rsub) * gld + (u.pn * 256 + col) * 2; gval = true; }
  __device__ __forceinline__ void pre(f32x4 (&v)[2][2], int rowstep, int ai, int m, const Ctx& c, const pg8::Unit& u, int wc, int fr, int fq, const PG8_LAS float* rtab) const {
    const float vv = c.vv[ai][m];
#pragma unroll
    for (int bj = 0; bj < 2; ++bj) { v[bj][0] = v[bj][0] * vv; v[bj][1] = v[bj][1] * vv; }
  }
};
#define LDS3 ((PG8_LAS unsigned char*)lds)
__device__ __forceinline__ void ph2_gemm_in(const Prm& p, int l, unsigned char* lds, int bid, int nb) {
  pg8::Gemm g{(const bf16_t*)(p.ws + OFF_R + R_H), (const bf16_t*)(p.ws + OFF_W + (size_t)l * SZ_WL), DM, nullptr};
  const int vcu = vcu_of(bid, nb);
  const int nun = (MR / 256) * (NINP / 256), extra = nun % nb;
  const bool halftail = extra > 0 && 2 * extra <= nb;
  SchedDense S{MR / 256, NINP / 256, nb, vcu, false, false, halftail ? nun - extra : nun}; Epi2In E{p.ws};
  pg8::gemm_phase<false>(LDS3, g, S, E);
  if (halftail) { SchedDenseTail T{NINP / 256, nun - extra, 2 * extra, vcu}; pg8::gemm_phase<false, true>(LDS3, g, T, E);
    if (vcu >= 2 * extra) ph_wconv_moe(p, l, lds, vcu - 2 * extra, nb - 2 * extra); }
  else if (extra == 0) ph_wconv_moe(p, l, lds, vcu, nb); else if (vcu >= extra) ph_wconv_moe(p, l, lds, vcu - extra, nb - extra);
}
__device__ __forceinline__ void ph2_gemm_qup(const Prm& p, int l, unsigned char* lds, int bid, int nb) {
  pg8::Gemm g{(const bf16_t*)(p.ws + OFF_R + R_CQ), (const bf16_t*)(p.ws + OFF_W + (size_t)l * SZ_WL + SZ_WIN), QRK, nullptr};
  const bool lastl = (l == DEPTH - 1); SchedDense S{lastl ? MR / 256 - NB : MR / 256, NQB / 256, nb, vcu_of(bid, nb), false, lastl, (lastl ? MR / 256 - NB : MR / 256) * (NQB / 256)}; Epi2Qup E{p.ws}; pg8::gemm_phase<false>(LDS3, g, S, E);
}
__device__ __forceinline__ void ph2_gemm_kvup(const Prm& p, int l, unsigned char* lds, int bid, int nb) {
  pg8::Gemm g{(const bf16_t*)(p.ws + OFF_R + R_CKV), (const bf16_t*)(p.ws + OFF_W + (size_t)l * SZ_WL + SZ_WIN + SZ_WQ), KVRK, nullptr};
  SchedDense S{MR / 256, NKVB / 256, nb, vcu_of(bid, nb), true, false, (MR / 256) * (NKVB / 256)}; Epi2KV E{p.ws}; pg8::gemm_phase<false>(LDS3, g, S, E);
}
__device__ __forceinline__ void ph2_gemm_out(const Prm& p, int l, unsigned char* lds, int bid, int nb) {
  pg8::Gemm g{(const bf16_t*)(p.ws + OFF_R + R_H), (const bf16_t*)(p.ws + OFF_W + (size_t)l * SZ_WL + SZ_WIN + SZ_WQ + SZ_WKV), DM, nullptr};
  const bool lastl = (l == DEPTH - 1); const int vcu = vcu_of(bid, nb);
  const int nun = (lastl ? MR / 256 - NB : MR / 256) * (DM / 256), extra = nun % nb;
  const bool halftail = !lastl && extra > 0 && 2 * extra <= nb;
  SchedDense S{lastl ? MR / 256 - NB : MR / 256, DM / 256, nb, vcu, false, lastl, halftail ? nun - extra : nun}; Epi2Out E{p.ws, l};
  pg8::gemm_phase<false>(LDS3, g, S, E);
  if (halftail) { SchedDenseTail T{DM / 256, nun - extra, 2 * extra, vcu}; pg8::gemm_phase<false, true>(LDS3, g, T, E); }
  if (l + 1 < DEPTH) {
    const int busy = halftail ? 2 * extra : extra;
    if (busy == 0) { ph_mod(p, l + 1, lds, vcu, nb); ph_wconv_dense(p, l + 1, lds, vcu, nb); }
    else if (vcu >= busy) { ph_mod(p, l + 1, lds, vcu - busy, nb - busy); ph_wconv_dense(p, l + 1, lds, vcu - busy, nb - busy); }
  }
}
__device__ __forceinline__ void ph2_moe_up(const Prm& p, int l, unsigned char* lds, int bid, int nb) {
  pg8::Gemm g{(const bf16_t*)(p.ws + OFF_R + R_H), WSP(bf16_t, OFF_WGU), DM, WSP(int, OFF_IDX)};
  const bool halftail = (l != DEPTH - 1) && nb >= 256;
  SchedMoe S{(l == DEPTH - 1 || halftail) ? 256 : 272, nb, vcu_of(bid, nb), (size_t)1024 * 1024 * 2}; Epi2MoeUp E{p.ws};
  pg8::gemm_phase<true>(LDS3, g, S, E);
  if (halftail) { SchedMoeTail T{vcu_of(bid, nb), (size_t)1024 * 1024 * 2}; pg8::gemm_phase<true, true>(LDS3, g, T, E); }
}
__device__ __forceinline__ void ph2_moe_down(const Prm& p, int l, unsigned char* lds, int bid, int nb) {
  pg8::Gemm g{(const bf16_t*)(p.ws + OFF_R + R_ACT), WSP(bf16_t, OFF_WD), DFF, nullptr};
  const bool halftail = (l != DEPTH - 1) && nb >= 256;
  SchedMoe S{(l == DEPTH - 1 || halftail) ? 256 : 272, nb, vcu_of(bid, nb), (size_t)1024 * 512 * 2}; Epi2MoeDown E{p.ws};
  pg8::gemm_phase<false>(LDS3, g, S, E);
  if (halftail) { SchedMoeTail T{vcu_of(bid, nb), (size_t)1024 * 512 * 2}; pg8::gemm_phase<false, true>(LDS3, g, T, E); }
}

template <int DQK>
__device__ __forceinline__ void attn_naive_unit(const Prm& p, int l, int kind, int b, int hd, int qblk, unsigned char* lds) {
  float* Ks = (float*)lds;
  float* Vs = Ks + 32 * DQK;
  const int tid = TIDX;
  const bool isB = (kind == 0 || kind == 2), isctx = kind >= 2;
  const int nq = isctx ? LC : SEQ; const int qi = qblk * NTHR + tid; const bool qvalid = qi < nq;
  const int qrow = b * TT + (isctx ? 0 : LC) + (qvalid ? qi : 0);
  float q[DQK];
  { const bf16_t* qp = isB ? (const bf16_t*)(p.ws + OFF_R + R_QB) + (size_t)qrow * NQB + hd * 96 : (const bf16_t*)(p.ws + OFF_R + R_QA) + (size_t)qrow * 512 + hd * 64;
#pragma unroll
    for (int d = 0; d < DQK; ++d) q[d] = bf2f(qp[d]); }
  float m = -1e30f, lsum = 0.f, o[64];
#pragma unroll
  for (int d = 0; d < 64; ++d) o[d] = 0.f;
  const int q0 = qblk * NTHR;
  int klo = 0, khi = LC;
  if (!isctx) { if (isB) khi = TT; else { klo = max(0, q0 - 128); khi = min(SEQ, q0 + NTHR + 128); } }
  const int kvh = hd >> 2;
  for (int seg = 0; seg < 2; ++seg) {
    int t0, t1; if (seg == 0) { t0 = 0; t1 = LC; } else { if (isctx) break; if (isB) { t0 = LC; t1 = TT; } else { t0 = LC + klo; t1 = LC + khi; } }
    for (int tb = t0; tb < t1; tb += 32) {
      __syncthreads();
      {
        for (int i = tid; i < 32 * DQK; i += NTHR) { const int kk = i / DQK, d = i % DQK; const size_t kr = (size_t)(b * TT + tb + kk);
          float v;
          if (isB) v = d < 64 ? bf2f(((const bf16_t*)(p.ws + OFF_R + R_KB))[kr * 512 + hd * 64 + d]) : bf2f(WSP(bf16_t, OFF_KR)[kr * 32 + d - 64]);
          else v = bf2f(((const bf16_t*)(p.ws + OFF_R + R_KA))[kr * 128 + kvh * 64 + d]);
          Ks[i] = v; }
        for (int i = tid; i < 32 * 64; i += NTHR) { const int kk = i >> 6, d = i & 63; const size_t kr = (size_t)(b * TT + tb + kk);
          Vs[i] = isB ? bf2f(((const bf16_t*)(p.ws + OFF_R + R_VB))[kr * 512 + hd * 64 + d]) : bf2f(((const bf16_t*)(p.ws + OFF_R + R_VA))[kr * 128 + kvh * 64 + d]); }
      }
      __syncthreads();
      if (qvalid) {
        for (int kk = 0; kk < 32; ++kk) {
          if (!isB && seg == 1) { const int ts = tb + kk - LC; const int dlt = qi - ts; if (dlt > 128 || dlt < -128) continue; }
          float s = 0.f;
#pragma unroll
          for (int d = 0; d < DQK; ++d) s += q[d] * Ks[kk * DQK + d];
          if (s > m) { const float al = exp2f(m - s); lsum *= al;
#pragma unroll
            for (int d = 0; d < 64; ++d) o[d] *= al;
            m = s; }
          const float pe = exp2f(s - m); lsum += pe;
#pragma unroll
          for (int d = 0; d < 64; ++d) o[d] += pe * Vs[kk * 64 + d];
        }
      }
    }
  }
  if (qvalid) {
    if (!isB) { const float sk = p.sink[l * 8 + hd] * LOG2E; if (sk > m) { const float al = exp2f(m - sk); lsum = lsum * al + 1.f;
#pragma unroll
        for (int d = 0; d < 64; ++d) o[d] *= al; } else lsum += exp2f(sk - m); }
    const float il = 1.f / lsum;
    bf16_t* op = (bf16_t*)(p.ws + OFF_R + R_H) + (size_t)qrow * DM + (isB ? 512 : 0) + hd * 64;
#pragma unroll
    for (int d = 0; d < 64; ++d) op[d] = f2bf(o[d] * il);
  }
}
__device__ __forceinline__ void ph_attn_naive(const Prm& p, int l, unsigned char* lds, int bid, int nb) {
  const int nun = 1024 + (l == DEPTH - 1 ? 0 : 64);
  for (int u = bid; u < nun; u += nb) {
    int kind, b, hd, qb;
    if (u < 1024) { kind = u & 1; int r = u >> 1; qb = r & 15; r >>= 4; hd = r & 7; b = r >> 3; }
    else { const int r = u - 1024; kind = 2 + (r & 1); hd = (r >> 1) & 7; b = r >> 4; qb = 0; }
    if (kind == 0 || kind == 2) attn_naive_unit<96>(p, l, kind, b, hd, qb, lds); else attn_naive_unit<64>(p, l, kind, b, hd, qb, lds);
    __syncthreads();
  }
}

#define SBAR() __builtin_amdgcn_sched_barrier(0)
typedef short s16x4 __attribute__((ext_vector_type(4)));
__device__ __forceinline__ int crow(int r, int hi) { return (r & 3) + 8 * (r >> 2) + 4 * hi; }
__device__ __forceinline__ unsigned cvtpk(float lo, float hi) { unsigned r; asm volatile("v_cvt_pk_bf16_f32 %0, %1, %2" : "=v"(r) : "v"(lo), "v"(hi)); return r; }
constexpr float ATHR = 8.f;
__device__ __forceinline__ void partialSM(f32x16& p0, f32x16& p1, float& m_reg, float& alpha) {
  float pmax = p0[0];
#pragma unroll
  for (int r = 1; r < 16; ++r) pmax = fmaxf(pmax, p0[r]);
#pragma unroll
  for (int r = 0; r < 16; ++r) pmax = fmaxf(pmax, p1[r]);
  { auto rr = __builtin_amdgcn_permlane32_swap(__float_as_uint(pmax), __float_as_uint(pmax), false, false); pmax = fmaxf(__uint_as_float(rr[0]), __uint_as_float(rr[1])); }
  float mn;
  if (__builtin_expect(__all(pmax - m_reg <= ATHR), 1)) { mn = m_reg; alpha = 1.f; }
  else { mn = fmaxf(m_reg, pmax); alpha = __builtin_amdgcn_exp2f(m_reg - mn); m_reg = mn; }
#pragma unroll
  for (int r = 0; r < 16; ++r) { p0[r] -= mn; p1[r] -= mn; }
#pragma unroll
  for (int r = 0; r < 16; ++r) p0[r] = __builtin_amdgcn_exp2f(p0[r]);
}
__device__ __forceinline__ void finishSM(f32x16& p0, f32x16& p1, float alpha, float& l_reg, bf16x8& pa0, bf16x8& pa1, bf16x8& pa2, bf16x8& pa3) {
#pragma unroll
  for (int r = 0; r < 16; ++r) p1[r] = __builtin_amdgcn_exp2f(p1[r]);
  float ps = 0.f;
#pragma unroll
  for (int r = 0; r < 16; ++r) ps += p0[r];
#pragma unroll
  for (int r = 0; r < 16; ++r) ps += p1[r];
  { auto rr = __builtin_amdgcn_permlane32_swap(__float_as_uint(ps), __float_as_uint(ps), false, false); ps = __uint_as_float(rr[0]) + __uint_as_float(rr[1]); }
  l_reg = l_reg * alpha + ps;
#define PK4(P, BASE, OUT) do { unsigned a0 = cvtpk(P[BASE + 0], P[BASE + 1]), a1 = cvtpk(P[BASE + 2], P[BASE + 3]);   \
    unsigned b0 = cvtpk(P[BASE + 4], P[BASE + 5]), b1 = cvtpk(P[BASE + 6], P[BASE + 7]);                              \
    auto r0 = __builtin_amdgcn_permlane32_swap(a0, b0, false, false); auto r1 = __builtin_amdgcn_permlane32_swap(a1, b1, false, false); \
    u32x4 w = {r0[0], r1[0], r0[1], r1[1]}; OUT = *reinterpret_cast<bf16x8*>(&w); } while (0)
  PK4(p0, 0, pa0); PK4(p0, 8, pa1); PK4(p1, 0, pa2); PK4(p1, 8, pa3);
#undef PK4
}
template <int DQK>
__device__ __forceinline__ void qkt(f32x16& p0, f32x16& p1, const char* Ks, const bf16x8* qr, int r32, int hi) {
  constexpr int KST = DQK * 2 + 16;
  p0 = f32x16{}; p1 = f32x16{};
#pragma unroll
  for (int d0 = 0; d0 < DQK / 16; ++d0) { const int cb = (d0 * 16 + hi * 8) * 2;
    const bf16x8 b0 = *reinterpret_cast<const bf16x8*>(Ks + r32 * KST + cb);
    const bf16x8 b1 = *reinterpret_cast<const bf16x8*>(Ks + (32 + r32) * KST + cb);
    p0 = __builtin_amdgcn_mfma_f32_32x32x16_bf16(b0, qr[d0], p0, 0, 0, 0);
    p1 = __builtin_amdgcn_mfma_f32_32x32x16_bf16(b1, qr[d0], p1, 0, 0, 0); }
}
__device__ __forceinline__ int v_st(int k, int c) { const int kk = (k & ~0xC) | ((k & 4) << 1) | ((k & 8) >> 1); return ((kk >> 3) * 2 + (c >> 5)) * 512 + ((kk & 7) * 32 + (c & 31)) * 2; }
__device__ __forceinline__ int v_rd_base(int lane) { return ((lane & 3) << 3) | (((lane >> 2) & 3) << 6) | (((lane >> 4) & 1) << 5) | (((lane >> 5) & 1) << 8); }
constexpr int v_rd_off(int d0, int ks, int half) { return d0 * 512 + ks * 2048 + half * 1024; }
template <int OFF> __device__ __forceinline__ s16x4 tr_read(int vb) { s16x4 r; asm volatile("ds_read_b64_tr_b16 %0, %1 offset:%2" : "=&v"(r) : "v"(vb), "i"(OFF) : "memory"); return r; }
template <int D0> __device__ __forceinline__ void pv_one(f32x16& od, int vb, bf16x8 pa0, bf16x8 pa1, bf16x8 pa2, bf16x8 pa3) {
  const s16x4 l0 = tr_read<v_rd_off(D0, 0, 0)>(vb), h0 = tr_read<v_rd_off(D0, 0, 1)>(vb), l1 = tr_read<v_rd_off(D0, 1, 0)>(vb), h1 = tr_read<v_rd_off(D0, 1, 1)>(vb);
  const s16x4 l2 = tr_read<v_rd_off(D0, 2, 0)>(vb), h2 = tr_read<v_rd_off(D0, 2, 1)>(vb), l3 = tr_read<v_rd_off(D0, 3, 0)>(vb), h3 = tr_read<v_rd_off(D0, 3, 1)>(vb);
  asm volatile("s_waitcnt lgkmcnt(0)" ::: "memory"); SBAR();
#define PK(L, H) (bf16x8){L[0], L[1], L[2], L[3], H[0], H[1], H[2], H[3]}
  od = __builtin_amdgcn_mfma_f32_32x32x16_bf16(pa0, PK(l0, h0), od, 0, 0, 0);
  od = __builtin_amdgcn_mfma_f32_32x32x16_bf16(pa1, PK(l1, h1), od, 0, 0, 0);
  od = __builtin_amdgcn_mfma_f32_32x32x16_bf16(pa2, PK(l2, h2), od, 0, 0, 0);
  od = __builtin_amdgcn_mfma_f32_32x32x16_bf16(pa3, PK(l3, h3), od, 0, 0, 0);
#undef PK
}
__device__ __forceinline__ void pv_all(f32x16* o, int vb, bf16x8 pa0, bf16x8 pa1, bf16x8 pa2, bf16x8 pa3) { pv_one<0>(o[0], vb, pa0, pa1, pa2, pa3); pv_one<1>(o[1], vb, pa0, pa1, pa2, pa3); }

template <int KIND>
__device__ __forceinline__ void attn_fast_unit(const Prm& p, int l, bool isctx, int b, int hd, int qb, unsigned char* ldsu) {
  constexpr int DQK = KIND == 0 ? 96 : 64, KST = DQK * 2 + 16, SHM_K = 64 * KST, SHM_V = 8192, LPT = KIND == 0 ? 3 : 2;
  char* lds = (char*)ldsu;
  const int tid = TIDX, wid = tid >> 6, lane = tid & 63, r32 = lane & 31, hi = lane >> 5;
  char* V_lds = lds; char* K_lds = lds + 2 * SHM_V;
  float* ws = (float*)(lds + 2 * SHM_V + 2 * SHM_K) + wid * 64; float* li_l = ws; float* al_l = ws + 32;
  const int q0 = qb * 256;
  const size_t rowq0 = (size_t)b * TT + (isctx ? 0 : LC) + q0;
  const bf16_t *Qp, *Kp, *Vp; const bf16_t* KRp = WSP(bf16_t, OFF_KR); int ldq, ldk; int ocol;
  if (KIND == 0) { Qp = (const bf16_t*)(p.ws + OFF_R + R_QB) + hd * 96; ldq = NQB; Kp = (const bf16_t*)(p.ws + OFF_R + R_KB) + hd * 64; Vp = (const bf16_t*)(p.ws + OFF_R + R_VB) + hd * 64; ldk = 512; ocol = 512 + hd * 64; }
  else { Qp = (const bf16_t*)(p.ws + OFF_R + R_QA) + hd * 64; ldq = 512; Kp = (const bf16_t*)(p.ws + OFF_R + R_KA) + (hd >> 2) * 64; Vp = (const bf16_t*)(p.ws + OFF_R + R_VA) + (hd >> 2) * 64; ldk = 128; ocol = hd * 64; }
  int NT, kshift = 0; bool domask = false;
  if (isctx) NT = 4; else if (KIND == 0) NT = TT / 64; else { const int ks = max(0, q0 - 128), ke = min(SEQ, q0 + 384); NT = 4 + (ke - ks) / 64; kshift = ks; domask = true; }
  const size_t kb0 = (size_t)b * TT;
  float m_reg = -1e30f, l_reg = 0.f; f32x16 o[2] = {}; bf16x8 qr[DQK / 16];
  { const bf16_t* Qw = Qp + (rowq0 + wid * 32 + r32) * ldq + hi * 8;
#pragma unroll
    for (int d0 = 0; d0 < DQK / 16; ++d0) qr[d0] = *reinterpret_cast<const bf16x8*>(Qw + d0 * 16); }
  const int sr = tid >> 3, sc = (tid & 7) * 8, vst = v_st(sr, sc), kst = sr * KST + sc * 2;
  const int rr_ = (tid & 255) >> 2, rc_ = (tid & 3) * 8, krst = rr_ * KST + 128 + rc_ * 2;
  const int vb0 = (int)(uintptr_t)V_lds + v_rd_base(lane);
  struct { bf16x8 v, k, kr; } st_[2];
#define KROW(j) (kb0 + (size_t)(j) * 64 + ((j) >= 4 ? kshift : 0))
#define SLOAD(i, j) do { const size_t kr0_ = KROW(j); st_[i].v = *reinterpret_cast<const bf16x8*>(Vp + (kr0_ + sr) * ldk + sc); st_[i].k = *reinterpret_cast<const bf16x8*>(Kp + (kr0_ + sr) * ldk + sc); \
    if (KIND == 0) st_[i].kr = *reinterpret_cast<const bf16x8*>(KRp + (kr0_ + rr_) * 32 + rc_); } while (0)
#define SWRITE(bf, i) do { *(bf16x8*)(V_lds + (bf) * SHM_V + vst) = st_[i].v; *(bf16x8*)(K_lds + (bf) * SHM_K + kst) = st_[i].k; \
    if (KIND == 0) { if (tid < 256) *(bf16x8*)(K_lds + (bf) * SHM_K + krst) = st_[i].kr; } } while (0)
#define SWAIT() do { if (LPT == 3) asm volatile("s_waitcnt vmcnt(3)" ::: "memory"); else asm volatile("s_waitcnt vmcnt(2)" ::: "memory"); } while (0)
#define RESC(a) do { if (__any((a) < 1.f)) { if (hi == 0) al_l[r32] = (a); asm volatile("s_waitcnt lgkmcnt(0)" ::: "memory"); \
    _Pragma("unroll") for (int d = 0; d < 2; ++d) _Pragma("unroll") for (int r = 0; r < 16; ++r) o[d][r] *= al_l[crow(r, hi)]; } } while (0)
#define AMASK(P0, P1, j) do { if (KIND == 1) { if (domask && (j) >= 4) { const int tq_ = q0 + wid * 32 + r32; const int tk_ = kshift + ((j) - 4) * 64 + 4 * hi; \
    _Pragma("unroll") for (int r = 0; r < 16; ++r) { const int d_ = tq_ - (tk_ + (r & 3) + 8 * (r >> 2)); if (d_ > 128 || d_ < -128) P0[r] = -INFINITY; if (d_ - 32 > 128 || d_ - 32 < -128) P1[r] = -INFINITY; } } } } while (0)
  f32x16 pA0, pA1, pB0, pB1; float alA, alB; bf16x8 pa0, pa1, pa2, pa3;
  SLOAD(0, 0); asm volatile("s_waitcnt vmcnt(0)" ::: "memory"); SWRITE(0, 0); __syncthreads();
  qkt<DQK>(pA0, pA1, K_lds, qr, r32, hi); AMASK(pA0, pA1, 0); partialSM(pA0, pA1, m_reg, alA);
  SLOAD(1, 1); if (2 < NT) SLOAD(0, 2);
  SWAIT(); SWRITE(1, 1); __syncthreads();
  for (int j = 1; j + 1 < NT; j += 2) {
    SBAR(); qkt<DQK>(pB0, pB1, K_lds + SHM_K, qr, r32, hi);
    finishSM(pA0, pA1, alA, l_reg, pa0, pa1, pa2, pa3); SBAR();
    SLOAD(1, j + 2); SBAR();
    pv_all(o, vb0, pa0, pa1, pa2, pa3); AMASK(pB0, pB1, j); partialSM(pB0, pB1, m_reg, alB);
    __syncthreads(); SWAIT(); SWRITE(0, 0);
    RESC(alB); __syncthreads();
    SBAR(); qkt<DQK>(pA0, pA1, K_lds, qr, r32, hi);
    finishSM(pB0, pB1, alB, l_reg, pa0, pa1, pa2, pa3); SBAR();
    if (j + 3 < NT) SLOAD(0, j + 3); SBAR();
    pv_all(o, vb0 + SHM_V, pa0, pa1, pa2, pa3); AMASK(pA0, pA1, j + 1); partialSM(pA0, pA1, m_reg, alA);
    __syncthreads(); SWAIT(); SWRITE(1, 1);
    RESC(alA); __syncthreads();
  }
  SBAR(); qkt<DQK>(pB0, pB1, K_lds + SHM_K, qr, r32, hi);
  finishSM(pA0, pA1, alA, l_reg, pa0, pa1, pa2, pa3); SBAR();
  pv_all(o, vb0, pa0, pa1, pa2, pa3); AMASK(pB0, pB1, NT - 1); partialSM(pB0, pB1, m_reg, alB);
  __syncthreads(); RESC(alB);
  finishSM(pB0, pB1, alB, l_reg, pa0, pa1, pa2, pa3); SBAR();
  pv_all(o, vb0 + SHM_V, pa0, pa1, pa2, pa3);
  if (KIND == 1) l_reg += __builtin_amdgcn_exp2f(p.sink[l * 8 + hd] * LOG2E - m_reg);
  if (hi == 0) li_l[r32] = l_reg; asm volatile("s_waitcnt lgkmcnt(0)" ::: "memory");
  float rli[16];
#pragma unroll
  for (int r = 0; r < 16; ++r) rli[r] = __builtin_amdgcn_rcpf(li_l[crow(r, hi)]);
  bf16_t* Ow = (bf16_t*)(p.ws + OFF_R + R_H) + (rowq0 + wid * 32) * DM + ocol;
#pragma unroll
  for (int r = 0; r < 16; ++r) { const int orow = crow(r, hi);
#pragma unroll
    for (int d0 = 0; d0 < 2; ++d0) Ow[(size_t)orow * DM + d0 * 32 + r32] = f2bf(o[d0][r] * rli[r]); }
  __syncthreads();
#undef KROW
#undef SLOAD
#undef SWRITE
#undef SWAIT
#undef RESC
#undef AMASK
}
__device__ __forceinline__ float max3f_(float a, float b, float c) { return fmaxf(fmaxf(a, b), c); }
template <bool FIRST>
__device__ __forceinline__ void psm2(f32x16& p0, f32x16& p1, float& mhat, f32x16& negm, float& alpha) {
  float a = max3f_(p0[0], p0[1], p1[0]), b = max3f_(p0[2], p0[3], p1[1]); a = max3f_(a, p1[2], p1[3]);
#pragma unroll
  for (int r = 4; r < 16; r += 4) { a = max3f_(a, p0[r], p0[r + 1]); b = max3f_(b, p0[r + 2], p0[r + 3]); a = max3f_(a, p1[r], p1[r + 1]); b = max3f_(b, p1[r + 2], p1[r + 3]); }
  float rm = fmaxf(a, b);
  { auto rr = __builtin_amdgcn_permlane32_swap(__float_as_uint(rm), __float_as_uint(rm), false, false); rm = fmaxf(__uint_as_float(rr[0]), __uint_as_float(rr[1])); }
  alpha = 1.f;
  if (FIRST || __builtin_expect(__any(rm > ATHR), 0)) {
    const float dl = FIRST ? rm : fmaxf(rm, 0.f);
    mhat += dl;
#pragma unroll
    for (int r = 0; r < 16; ++r) { p0[r] -= dl; p1[r] -= dl; }
    const float nm = -mhat;
#pragma unroll
    for (int r = 0; r < 16; ++r) negm[r] = nm;
    alpha = __builtin_amdgcn_exp2f(-dl);
  }
#pragma unroll
  for (int r = 0; r < 16; ++r) p0[r] = __builtin_amdgcn_exp2f(p0[r]);
}
template <bool FIRST>
__device__ __forceinline__ void psm2q(f32x16& p0, f32x16& p1, float& mhat, f32x16& negm, float& alpha, float& lsum) {
  float a = max3f_(p0[0], p0[1], p1[0]), b = max3f_(p0[2], p0[3], p1[1]); a = max3f_(a, p1[2], p1[3]);
#pragma unroll
  for (int r = 4; r < 16; r += 4) { a = max3f_(a, p0[r], p0[r + 1]); b = max3f_(b, p0[r + 2], p0[r + 3]); a = max3f_(a, p1[r], p1[r + 1]); b = max3f_(b, p1[r + 2], p1[r + 3]); }
  float rm = fmaxf(a, b);
  { auto rr = __builtin_amdgcn_permlane32_swap(__float_as_uint(rm), __float_as_uint(rm), false, false); rm = fmaxf(__uint_as_float(rr[0]), __uint_as_float(rr[1])); }
  alpha = 1.f;
  if (FIRST || __builtin_expect(__any(rm > ATHR), 0)) {
    const float dl = FIRST ? rm : fmaxf(rm, 0.f);
    mhat += dl;
#pragma unroll
    for (int r = 0; r < 16; ++r) { p0[r] -= dl; p1[r] -= dl; }
    const float nm = -mhat;
#pragma unroll
    for (int r = 0; r < 16; ++r) negm[r] = nm;
    alpha = __builtin_amdgcn_exp2f(-dl);
  }
  float s0 = 0.f, s1 = 0.f;
#pragma unroll
  for (int r = 0; r < 16; r += 2) { p0[r] = __builtin_amdgcn_exp2f(p0[r]); s0 += p0[r]; p0[r + 1] = __builtin_amdgcn_exp2f(p0[r + 1]); s1 += p0[r + 1]; }
  lsum = FIRST ? (s0 + s1) : lsum * alpha + (s0 + s1);
}
__device__ __forceinline__ void fsm2(f32x16& p0, f32x16& p1, bf16x8& pa0, bf16x8& pa1, bf16x8& pa2, bf16x8& pa3) {
#pragma unroll
  for (int r = 0; r < 16; ++r) p1[r] = __builtin_amdgcn_exp2f(p1[r]);
#define PK4(P, BASE, OUT) do { unsigned a0 = cvtpk(P[BASE + 0], P[BASE + 1]), a1 = cvtpk(P[BASE + 2], P[BASE + 3]);   \
    unsigned b0 = cvtpk(P[BASE + 4], P[BASE + 5]), b1 = cvtpk(P[BASE + 6], P[BASE + 7]);                              \
    auto r0 = __builtin_amdgcn_permlane32_swap(a0, b0, false, false); auto r1 = __builtin_amdgcn_permlane32_swap(a1, b1, false, false); \
    u32x4 w = {r0[0], r1[0], r0[1], r1[1]}; OUT = *reinterpret_cast<bf16x8*>(&w); } while (0)
  PK4(p0, 0, pa0); PK4(p0, 8, pa1); PK4(p1, 0, pa2); PK4(p1, 8, pa3);
#undef PK4
}
template <int DQK>
__device__ __forceinline__ void qkt2(f32x16& p0, f32x16& p1, const char* Ks, const bf16x8* qr, const f32x16& negm, int r32, int hi) {
  constexpr int KST = DQK * 2 + 16, ND = DQK / 16;
  bf16x8 kb0[ND], kb1[ND];
#pragma unroll
  for (int d0 = 0; d0 < ND; ++d0) { const int cb = (d0 * 16 + hi * 8) * 2;
    kb0[d0] = *reinterpret_cast<const bf16x8*>(Ks + r32 * KST + cb); kb1[d0] = *reinterpret_cast<const bf16x8*>(Ks + (32 + r32) * KST + cb); }
#pragma unroll
  for (int d0 = 0; d0 < ND; ++d0) {
    if (d0 == 0) { p0 = __builtin_amdgcn_mfma_f32_32x32x16_bf16(kb0[0], qr[0], negm, 0, 0, 0); p1 = __builtin_amdgcn_mfma_f32_32x32x16_bf16(kb1[0], qr[0], negm, 0, 0, 0); }
    else { p0 = __builtin_amdgcn_mfma_f32_32x32x16_bf16(kb0[d0], qr[d0], p0, 0, 0, 0); p1 = __builtin_amdgcn_mfma_f32_32x32x16_bf16(kb1[d0], qr[d0], p1, 0, 0, 0); } }
}
__device__ __forceinline__ void pv_all2(f32x16* o, int vb, bf16x8 pa0, bf16x8 pa1, bf16x8 pa2, bf16x8 pa3) {
  pv_one<0>(o[0], vb, pa0, pa1, pa2, pa3); pv_one<1>(o[1], vb, pa0, pa1, pa2, pa3);
  const bf16x8 ones = {16256, 16256, 16256, 16256, 16256, 16256, 16256, 16256};
  o[2] = __builtin_amdgcn_mfma_f32_32x32x16_bf16(pa0, ones, o[2], 0, 0, 0); o[2] = __builtin_amdgcn_mfma_f32_32x32x16_bf16(pa1, ones, o[2], 0, 0, 0);
  o[2] = __builtin_amdgcn_mfma_f32_32x32x16_bf16(pa2, ones, o[2], 0, 0, 0); o[2] = __builtin_amdgcn_mfma_f32_32x32x16_bf16(pa3, ones, o[2], 0, 0, 0);
}
template <int KIND>
__device__ __forceinline__ void attn_fast_unit2(const Prm& p, int l, bool isctx, int b, int hd, int qb, unsigned char* ldsu) {
  constexpr int DQK = KIND == 0 ? 96 : 64, KST = DQK * 2 + 16, SHM_K = 64 * KST, SHM_V = 8192, LPT = KIND == 0 ? 3 : 2;
  char* lds = (char*)ldsu;
  const int tid = TIDX, wid = tid >> 6, lane = tid & 63, r32 = lane & 31, hi = lane >> 5;
  char* V_lds = lds; char* K_lds = lds + 2 * SHM_V;
  float* ws = (float*)(lds + 2 * SHM_V + 2 * SHM_K) + wid * 64; float* li_l = ws; float* al_l = ws + 32;
  const int q0 = qb * 256;
  const size_t rowq0 = (size_t)b * TT + (isctx ? 0 : LC) + q0;
  const bf16_t *Qp, *Kp, *Vp; const bf16_t* KRp = WSP(bf16_t, OFF_KR); int ldq, ldk; int ocol;
  if (KIND == 0) { Qp = (const bf16_t*)(p.ws + OFF_R + R_QB) + hd * 96; ldq = NQB; Kp = (const bf16_t*)(p.ws + OFF_R + R_KB) + hd * 64; Vp = (const bf16_t*)(p.ws + OFF_R + R_VB) + hd * 64; ldk = 512; ocol = 512 + hd * 64; }
  else { Qp = (const bf16_t*)(p.ws + OFF_R + R_QA) + hd * 64; ldq = 512; Kp = (const bf16_t*)(p.ws + OFF_R + R_KA) + (hd >> 2) * 64; Vp = (const bf16_t*)(p.ws + OFF_R + R_VA) + (hd >> 2) * 64; ldk = 128; ocol = hd * 64; }
  int NT, kshift = 0; bool domask = false;
  if (isctx) NT = 4; else if (KIND == 0) NT = TT / 64; else { const int ks = max(0, q0 - 128), ke = min(SEQ, q0 + 384); NT = 4 + (ke - ks) / 64; kshift = ks; domask = true; }
  const size_t kb0 = (size_t)b * TT;
  float mhat = 0.f; f32x16 o[3] = {}; f32x16 negm = {}; bf16x8 qr[DQK / 16];
  { const bf16_t* Qw = Qp + (rowq0 + wid * 32 + r32) * ldq + hi * 8;
#pragma unroll
    for (int d0 = 0; d0 < DQK / 16; ++d0) qr[d0] = *reinterpret_cast<const bf16x8*>(Qw + d0 * 16); }
  const int sr = tid >> 3, sc = (tid & 7) * 8, vst = v_st(sr, sc), kst = sr * KST + sc * 2;
  const int rr_ = (tid & 255) >> 2, rc_ = (tid & 3) * 8, krst = rr_ * KST + 128 + rc_ * 2;
  const int vb0 = (int)(uintptr_t)V_lds + v_rd_base(lane);
  struct { bf16x8 v, k, kr; } st_[1];
#define KROW(j) (kb0 + (size_t)(j) * 64 + ((j) >= 4 ? kshift : 0))
  const unsigned voffs = (unsigned)(sr * ldk + sc) * 2u, kroffs = (unsigned)(rr_ * 32 + rc_) * 2u;
#define SLOAD(i, j) do { const size_t kr0_ = KROW(j); const char* vb_ = (const char*)(Vp + kr0_ * ldk); const char* kb_ = (const char*)(Kp + kr0_ * ldk); \
    st_[i].v = *reinterpret_cast<const bf16x8*>(vb_ + voffs); st_[i].k = *reinterpret_cast<const bf16x8*>(kb_ + voffs); \
    if (KIND == 0) { const char* rb_ = (const char*)(KRp + kr0_ * 32); st_[i].kr = *reinterpret_cast<const bf16x8*>(rb_ + kroffs); } } while (0)
#define SWRITE(bf, i) do { *(bf16x8*)(V_lds + (bf) * SHM_V + vst) = st_[i].v; *(bf16x8*)(K_lds + (bf) * SHM_K + kst) = st_[i].k; \
    if (KIND == 0) { if (tid < 256) *(bf16x8*)(K_lds + (bf) * SHM_K + krst) = st_[i].kr; } } while (0)
#define SWAIT() do { if (LPT == 3) asm volatile("s_waitcnt vmcnt(3)" ::: "memory"); else asm volatile("s_waitcnt vmcnt(2)" ::: "memory"); } while (0)
#define RESC(a) do { if (__any((a) < 1.f)) { if (hi == 0) al_l[r32] = (a); asm volatile("s_waitcnt lgkmcnt(0)" ::: "memory"); \
    _Pragma("unroll") for (int d = 0; d < 3; ++d) _Pragma("unroll") for (int r = 0; r < 16; ++r) o[d][r] *= al_l[crow(r, hi)]; } } while (0)
#define AMASK(P0, P1, j) do { if (KIND == 1) { if (domask && (j) >= 4) { const int tq_ = q0 + wid * 32 + r32; const int tk_ = kshift + ((j) - 4) * 64 + 4 * hi; \
    _Pragma("unroll") for (int r = 0; r < 16; ++r) { const int d_ = tq_ - (tk_ + (r & 3) + 8 * (r >> 2)); if (d_ > 128 || d_ < -128) P0[r] = -INFINITY; if (d_ - 32 > 128 || d_ - 32 < -128) P1[r] = -INFINITY; } } } } while (0)
  if (__builtin_amdgcn_readfirstlane(wid) >= 4) __builtin_amdgcn_s_setprio(1);
  f32x16 pA0, pA1, pB0, pB1; float alA, alB; bf16x8 pa0, pa1, pa2, pa3;
  const int wq0_ = q0 + __builtin_amdgcn_readfirstlane(wid) * 32;
#define TACT(j) (KIND != 1 || !domask || (j) < 4 || (kshift + ((j) - 4) * 64 + 63 >= wq0_ - 128 && kshift + ((j) - 4) * 64 <= wq0_ + 31 + 128))
  bool actA, actB;
  SLOAD(0, 0); asm volatile("s_waitcnt vmcnt(0)" ::: "memory"); SWRITE(0, 0); __syncthreads();
  actA = true; qkt2<DQK>(pA0, pA1, K_lds, qr, negm, r32, hi); AMASK(pA0, pA1, 0); psm2<true>(pA0, pA1, mhat, negm, alA);
  SLOAD(0, 1);
  SWRITE(1, 0); __syncthreads();
  for (int j = 1; j + 1 < NT; j += 2) {
    actB = TACT(j);
    SBAR(); if (actB) qkt2<DQK>(pB0, pB1, K_lds + SHM_K, qr, negm, r32, hi);
    if (actA) fsm2(pA0, pA1, pa0, pa1, pa2, pa3); SBAR();
    SLOAD(0, j + 1); SBAR();
    if (actA) pv_all2(o, vb0, pa0, pa1, pa2, pa3); if (actB) { AMASK(pB0, pB1, j); psm2<false>(pB0, pB1, mhat, negm, alB); } else alB = 1.f;
    __syncthreads(); SWRITE(0, 0);
    RESC(alB); __syncthreads();
    actA = TACT(j + 1);
    SBAR(); if (actA) qkt2<DQK>(pA0, pA1, K_lds, qr, negm, r32, hi);
    if (actB) fsm2(pB0, pB1, pa0, pa1, pa2, pa3); SBAR();
    SLOAD(0, j + 2); SBAR();
    if (actB) pv_all2(o, vb0 + SHM_V, pa0, pa1, pa2, pa3); if (actA) { AMASK(pA0, pA1, j + 1); psm2<false>(pA0, pA1, mhat, negm, alA); } else alA = 1.f;
    __syncthreads(); SWRITE(1, 0);
    RESC(alA); __syncthreads();
  }
  actB = TACT(NT - 1);
  SBAR(); if (actB) qkt2<DQK>(pB0, pB1, K_lds + SHM_K, qr, negm, r32, hi);
  if (actA) fsm2(pA0, pA1, pa0, pa1, pa2, pa3); SBAR();
  if (actA) pv_all2(o, vb0, pa0, pa1, pa2, pa3); if (actB) { AMASK(pB0, pB1, NT - 1); psm2<false>(pB0, pB1, mhat, negm, alB); } else alB = 1.f;
  __syncthreads(); RESC(alB);
  if (actB) { fsm2(pB0, pB1, pa0, pa1, pa2, pa3); SBAR();
    pv_all2(o, vb0 + SHM_V, pa0, pa1, pa2, pa3); }
  __builtin_amdgcn_s_setprio(0);
  float rli[16];
  if (KIND == 1) { if (hi == 0) li_l[r32] = mhat; asm volatile("s_waitcnt lgkmcnt(0)" ::: "memory"); const float sk2 = p.sink[l * 8 + hd] * LOG2E;
#pragma unroll
    for (int r = 0; r < 16; ++r) rli[r] = __builtin_amdgcn_rcpf(o[2][r] + __builtin_amdgcn_exp2f(sk2 - li_l[crow(r, hi)])); }
  else {
#pragma unroll
    for (int r = 0; r < 16; ++r) rli[r] = __builtin_amdgcn_rcpf(o[2][r]); }
  bf16_t* Ow = (bf16_t*)(p.ws + OFF_R + R_H) + (rowq0 + wid * 32) * DM + ocol;
#pragma unroll
  for (int r = 0; r < 16; ++r) { const int orow = crow(r, hi);
#pragma unroll
    for (int d0 = 0; d0 < 2; ++d0) Ow[(size_t)orow * DM + d0 * 32 + r32] = f2bf(o[d0][r] * rli[r]); }
  __syncthreads();
#undef KROW
#undef SLOAD
#undef SWRITE
#undef SWAIT
#undef RESC
#undef AMASK
#undef TACT
}
#ifdef DBG_ATTN_PROBE
template <int KIND, int VAR>
__device__ __forceinline__ void attn_probe_unit(const Prm& p, int l, bool isctx, int b, int hd, int qb, unsigned char* ldsu) {
  constexpr int DQK = KIND == 0 ? 96 : 64, KST = DQK * 2 + 16, SHM_K = 64 * KST, SHM_V = 8192, LPT = KIND == 0 ? 3 : 2;
  char* lds = (char*)ldsu;
  const int tid = TIDX, wid = tid >> 6, lane = tid & 63, r32 = lane & 31, hi = lane >> 5;
  char* V_lds = lds; char* K_lds = lds + 2 * SHM_V;
  float* ws = (float*)(lds + 2 * SHM_V + 2 * SHM_K) + wid * 64; float* li_l = ws; float* al_l = ws + 32;
  const int q0 = qb * 256;
  const size_t rowq0 = (size_t)b * TT + (isctx ? 0 : LC) + q0;
  const bf16_t *Qp, *Kp, *Vp; const bf16_t* KRp = WSP(bf16_t, OFF_KR); int ldq, ldk; int ocol;
  if (KIND == 0) { Qp = (const bf16_t*)(p.ws + OFF_R + R_QB) + hd * 96; ldq = NQB; Kp = (const bf16_t*)(p.ws + OFF_R + R_KB) + hd * 64; Vp = (const bf16_t*)(p.ws + OFF_R + R_VB) + hd * 64; ldk = 512; ocol = 512 + hd * 64; }
  else { Qp = (const bf16_t*)(p.ws + OFF_R + R_QA) + hd * 64; ldq = 512; Kp = (const bf16_t*)(p.ws + OFF_R + R_KA) + (hd >> 2) * 64; Vp = (const bf16_t*)(p.ws + OFF_R + R_VA) + (hd >> 2) * 64; ldk = 128; ocol = hd * 64; }
  int NT, kshift = 0; bool domask = false;
  if (isctx) NT = 4; else if (KIND == 0) NT = TT / 64; else { const int ks = max(0, q0 - 128), ke = min(SEQ, q0 + 384); NT = 4 + (ke - ks) / 64; kshift = ks; domask = true; }
  const size_t kb0 = (size_t)b * TT;
  float mhat = 0.f; f32x16 o[3] = {}; f32x16 negm = {}; bf16x8 qr[DQK / 16];
  { const bf16_t* Qw = Qp + (rowq0 + wid * 32 + r32) * ldq + hi * 8;
#pragma unroll
    for (int d0 = 0; d0 < DQK / 16; ++d0) qr[d0] = *reinterpret_cast<const bf16x8*>(Qw + d0 * 16); }
  const int sr = tid >> 3, sc = (tid & 7) * 8, vst = v_st(sr, sc), kst = sr * KST + sc * 2;
  const int rr_ = (tid & 255) >> 2, rc_ = (tid & 3) * 8, krst = rr_ * KST + 128 + rc_ * 2;
  const int vb0 = (int)(uintptr_t)V_lds + v_rd_base(lane);
  struct { bf16x8 v, k, kr; } st_[1];
#define KROW(j) (kb0 + (size_t)(j) * 64 + ((j) >= 4 ? kshift : 0))
#define SLOAD(i, j) do { if (VAR & 4) break; const size_t kr0_ = KROW(j); st_[i].v = *reinterpret_cast<const bf16x8*>(Vp + (kr0_ + sr) * ldk + sc); st_[i].k = *reinterpret_cast<const bf16x8*>(Kp + (kr0_ + sr) * ldk + sc); \
    if (KIND == 0) st_[i].kr = *reinterpret_cast<const bf16x8*>(KRp + (kr0_ + rr_) * 32 + rc_); } while (0)
#define SWRITE(bf, i) do { if (VAR & 4) break; *(bf16x8*)(V_lds + (bf) * SHM_V + vst) = st_[i].v; *(bf16x8*)(K_lds + (bf) * SHM_K + kst) = st_[i].k; \
    if (KIND == 0) { if (tid < 256) *(bf16x8*)(K_lds + (bf) * SHM_K + krst) = st_[i].kr; } } while (0)
#define SWAIT() do { if (LPT == 3) asm volatile("s_waitcnt vmcnt(3)" ::: "memory"); else asm volatile("s_waitcnt vmcnt(2)" ::: "memory"); } while (0)
#define RESC(a) do { if (__any((a) < 1.f)) { if (hi == 0) al_l[r32] = (a); asm volatile("s_waitcnt lgkmcnt(0)" ::: "memory"); \
    _Pragma("unroll") for (int d = 0; d < 3; ++d) _Pragma("unroll") for (int r = 0; r < 16; ++r) o[d][r] *= al_l[crow(r, hi)]; } } while (0)
#define AMASK(P0, P1, j) do { if (KIND == 1) { if (domask && (j) >= 4) { const int tq_ = q0 + wid * 32 + r32; const int tk_ = kshift + ((j) - 4) * 64 + 4 * hi; \
    _Pragma("unroll") for (int r = 0; r < 16; ++r) { const int d_ = tq_ - (tk_ + (r & 3) + 8 * (r >> 2)); if (d_ > 128 || d_ < -128) P0[r] = -INFINITY; if (d_ - 32 > 128 || d_ - 32 < -128) P1[r] = -INFINITY; } } } } while (0)
  f32x16 pA0, pA1, pB0, pB1; float alA, alB; bf16x8 pa0, pa1, pa2, pa3;
  const int wq0_ = q0 + __builtin_amdgcn_readfirstlane(wid) * 32;
#define TACT(j) (KIND != 1 || !domask || (j) < 4 || (kshift + ((j) - 4) * 64 + 63 >= wq0_ - 128 && kshift + ((j) - 4) * 64 <= wq0_ + 31 + 128))
  bool actA, actB;
  SLOAD(0, 0); asm volatile("s_waitcnt vmcnt(0)" ::: "memory"); SWRITE(0, 0); do { if (!(VAR & 1)) __syncthreads(); } while (0);
  do { if (!(VAR & 16)) qkt2<DQK>(pA0, pA1, K_lds, qr, negm, r32, hi); else { pA0 = negm; pA1 = negm; asm volatile("" : "+v"(pA0), "+v"(pA1)); } } while (0); AMASK(pA0, pA1, 0); do { if (!(VAR & 2)) psm2<true>(pA0, pA1, mhat, negm, alA); else alA = 1.f; } while (0);
  SLOAD(0, 1);
  SWRITE(1, 0); do { if (!(VAR & 1)) __syncthreads(); } while (0);
  for (int j = 1; j + 1 < NT; j += 2) {
    SBAR(); do { if (!(VAR & 16)) qkt2<DQK>(pB0, pB1, K_lds + SHM_K, qr, negm, r32, hi); else { pB0 = negm; pB1 = negm; asm volatile("" : "+v"(pB0), "+v"(pB1)); } } while (0);
    do { if (!(VAR & 2)) fsm2(pA0, pA1, pa0, pa1, pa2, pa3); else { pa0 = __builtin_bit_cast(bf16x8, (f32x4){pA0[0], pA0[1], pA0[2], pA0[3]}); pa1 = __builtin_bit_cast(bf16x8, (f32x4){pA0[4], pA0[5], pA0[6], pA0[7]}); pa2 = __builtin_bit_cast(bf16x8, (f32x4){pA1[0], pA1[1], pA1[2], pA1[3]}); pa3 = __builtin_bit_cast(bf16x8, (f32x4){pA1[4], pA1[5], pA1[6], pA1[7]}); } } while (0); SBAR();
    SLOAD(0, j + 1); SBAR();
    do { if (!(VAR & 8)) pv_all2(o, vb0, pa0, pa1, pa2, pa3); else { asm volatile("" :: "v"(pa0), "v"(pa1), "v"(pa2), "v"(pa3)); } } while (0); AMASK(pB0, pB1, j); do { if (!(VAR & 2)) psm2<false>(pB0, pB1, mhat, negm, alB); else alB = 1.f; } while (0);
    do { if (!(VAR & 1)) __syncthreads(); } while (0); SWRITE(0, 0);
    RESC(alB); do { if (!(VAR & 1)) __syncthreads(); } while (0);
    SBAR(); do { if (!(VAR & 16)) qkt2<DQK>(pA0, pA1, K_lds, qr, negm, r32, hi); else { pA0 = negm; pA1 = negm; asm volatile("" : "+v"(pA0), "+v"(pA1)); } } while (0);
    do { if (!(VAR & 2)) fsm2(pB0, pB1, pa0, pa1, pa2, pa3); else { pa0 = __builtin_bit_cast(bf16x8, (f32x4){pB0[0], pB0[1], pB0[2], pB0[3]}); pa1 = __builtin_bit_cast(bf16x8, (f32x4){pB0[4], pB0[5], pB0[6], pB0[7]}); pa2 = __builtin_bit_cast(bf16x8, (f32x4){pB1[0], pB1[1], pB1[2], pB1[3]}); pa3 = __builtin_bit_cast(bf16x8, (f32x4){pB1[4], pB1[5], pB1[6], pB1[7]}); } } while (0); SBAR();
    SLOAD(0, j + 2); SBAR();
    do { if (!(VAR & 8)) pv_all2(o, vb0 + SHM_V, pa0, pa1, pa2, pa3); else { asm volatile("" :: "v"(pa0), "v"(pa1), "v"(pa2), "v"(pa3)); } } while (0); AMASK(pA0, pA1, j + 1); do { if (!(VAR & 2)) psm2<false>(pA0, pA1, mhat, negm, alA); else alA = 1.f; } while (0);
    do { if (!(VAR & 1)) __syncthreads(); } while (0); SWRITE(1, 0);
    RESC(alA); do { if (!(VAR & 1)) __syncthreads(); } while (0);
  }
  SBAR(); do { if (!(VAR & 16)) qkt2<DQK>(pB0, pB1, K_lds + SHM_K, qr, negm, r32, hi); else { pB0 = negm; pB1 = negm; asm volatile("" : "+v"(pB0), "+v"(pB1)); } } while (0);
  do { if (!(VAR & 2)) fsm2(pA0, pA1, pa0, pa1, pa2, pa3); else { pa0 = __builtin_bit_cast(bf16x8, (f32x4){pA0[0], pA0[1], pA0[2], pA0[3]}); pa1 = __builtin_bit_cast(bf16x8, (f32x4){pA0[4], pA0[5], pA0[6], pA0[7]}); pa2 = __builtin_bit_cast(bf16x8, (f32x4){pA1[0], pA1[1], pA1[2], pA1[3]}); pa3 = __builtin_bit_cast(bf16x8, (f32x4){pA1[4], pA1[5], pA1[6], pA1[7]}); } } while (0); SBAR();
  do { if (!(VAR & 8)) pv_all2(o, vb0, pa0, pa1, pa2, pa3); else { asm volatile("" :: "v"(pa0), "v"(pa1), "v"(pa2), "v"(pa3)); } } while (0); AMASK(pB0, pB1, NT - 1); do { if (!(VAR & 2)) psm2<false>(pB0, pB1, mhat, negm, alB); else alB = 1.f; } while (0);
  do { if (!(VAR & 1)) __syncthreads(); } while (0); RESC(alB);
  do { if (!(VAR & 2)) fsm2(pB0, pB1, pa0, pa1, pa2, pa3); else { pa0 = __builtin_bit_cast(bf16x8, (f32x4){pB0[0], pB0[1], pB0[2], pB0[3]}); pa1 = __builtin_bit_cast(bf16x8, (f32x4){pB0[4], pB0[5], pB0[6], pB0[7]}); pa2 = __builtin_bit_cast(bf16x8, (f32x4){pB1[0], pB1[1], pB1[2], pB1[3]}); pa3 = __builtin_bit_cast(bf16x8, (f32x4){pB1[4], pB1[5], pB1[6], pB1[7]}); } } while (0); SBAR();
  do { if (!(VAR & 8)) pv_all2(o, vb0 + SHM_V, pa0, pa1, pa2, pa3); else { asm volatile("" :: "v"(pa0), "v"(pa1), "v"(pa2), "v"(pa3)); } } while (0);
  float rli[16];
  if (KIND == 1) { if (hi == 0) li_l[r32] = mhat; asm volatile("s_waitcnt lgkmcnt(0)" ::: "memory"); const float sk2 = p.sink[l * 8 + hd] * LOG2E;
#pragma unroll
    for (int r = 0; r < 16; ++r) rli[r] = __builtin_amdgcn_rcpf(o[2][r] + __builtin_amdgcn_exp2f(sk2 - li_l[crow(r, hi)])); }
  else {
#pragma unroll
    for (int r = 0; r < 16; ++r) rli[r] = __builtin_amdgcn_rcpf(o[2][r]); }
  bf16_t* Ow = (bf16_t*)(p.ws + OFF_R + R_CQ) + ((rowq0 + wid * 32) & 16383) * DM + ocol;
#pragma unroll
  for (int r = 0; r < 16; ++r) { const int orow = crow(r, hi);
#pragma unroll
    for (int d0 = 0; d0 < 2; ++d0) Ow[(size_t)orow * DM + d0 * 32 + r32] = f2bf(o[d0][r] * rli[r]); }
  do { if (!(VAR & 1)) __syncthreads(); } while (0);
#undef KROW
#undef SLOAD
#undef SWRITE
#undef SWAIT
#undef RESC
#undef AMASK
#undef TACT
}

template <int VAR>
__device__ __forceinline__ void ph_attn_probe(const Prm& p, int l, unsigned char* lds, int bid, int nb) {
  const int nrounds = (1024 + nb - 1) / nb;
  for (int rd = 0; rd < nrounds; ++rd) { const int pair = rd * 8 + (bid & 7), qb = bid >> 3, u = pair * 32 + qb;
    if (u < 1024) attn_probe_unit<0, VAR>(p, l, false, u >> 8, (u >> 5) & 7, u & 31, lds); }
}
#endif
__device__ __forceinline__ int v_st_p(int k, int c) { return (c >> 5) * 4096 + (k >> 4) * 1024 + (k & 15) * 64 + (c & 31) * 2; }
__device__ __forceinline__ int v_rd_base_p(int lane) { return ((lane >> 4) & 1) * 32 + (lane & 3) * 8 + (4 * (lane >> 5) + ((lane & 15) >> 2)) * 64; }
constexpr int v_rd_off_p(int d0, int ks, int half) { return d0 * 4096 + ks * 1024 + half * 512; }
template <int D0> __device__ __forceinline__ void pv_one_p(f32x16& od, int vb, bf16x8 pa0, bf16x8 pa1, bf16x8 pa2, bf16x8 pa3) {
  const s16x4 l0 = tr_read<v_rd_off_p(D0, 0, 0)>(vb), h0 = tr_read<v_rd_off_p(D0, 0, 1)>(vb), l1 = tr_read<v_rd_off_p(D0, 1, 0)>(vb), h1 = tr_read<v_rd_off_p(D0, 1, 1)>(vb);
  const s16x4 l2 = tr_read<v_rd_off_p(D0, 2, 0)>(vb), h2 = tr_read<v_rd_off_p(D0, 2, 1)>(vb), l3 = tr_read<v_rd_off_p(D0, 3, 0)>(vb), h3 = tr_read<v_rd_off_p(D0, 3, 1)>(vb);
  asm volatile("s_waitcnt lgkmcnt(0)" ::: "memory"); SBAR();
#define PK(L, H) (bf16x8){L[0], L[1], L[2], L[3], H[0], H[1], H[2], H[3]}
  od = __builtin_amdgcn_mfma_f32_32x32x16_bf16(pa0, PK(l0, h0), od, 0, 0, 0);
  od = __builtin_amdgcn_mfma_f32_32x32x16_bf16(pa1, PK(l1, h1), od, 0, 0, 0);
  od = __builtin_amdgcn_mfma_f32_32x32x16_bf16(pa2, PK(l2, h2), od, 0, 0, 0);
  od = __builtin_amdgcn_mfma_f32_32x32x16_bf16(pa3, PK(l3, h3), od, 0, 0, 0);
#undef PK
}
__device__ __forceinline__ void pv_all2p(f32x16* o, int vb, bf16x8 pa0, bf16x8 pa1, bf16x8 pa2, bf16x8 pa3) {
  const s16x4 a0 = tr_read<v_rd_off_p(0, 0, 0)>(vb), b0 = tr_read<v_rd_off_p(0, 0, 1)>(vb), a1 = tr_read<v_rd_off_p(0, 1, 0)>(vb), b1 = tr_read<v_rd_off_p(0, 1, 1)>(vb);
  const s16x4 a2 = tr_read<v_rd_off_p(0, 2, 0)>(vb), b2 = tr_read<v_rd_off_p(0, 2, 1)>(vb), a3 = tr_read<v_rd_off_p(0, 3, 0)>(vb), b3 = tr_read<v_rd_off_p(0, 3, 1)>(vb);
  const s16x4 c0 = tr_read<v_rd_off_p(1, 0, 0)>(vb), d0 = tr_read<v_rd_off_p(1, 0, 1)>(vb), c1 = tr_read<v_rd_off_p(1, 1, 0)>(vb), d1 = tr_read<v_rd_off_p(1, 1, 1)>(vb);
  const s16x4 c2 = tr_read<v_rd_off_p(1, 2, 0)>(vb), d2 = tr_read<v_rd_off_p(1, 2, 1)>(vb), c3 = tr_read<v_rd_off_p(1, 3, 0)>(vb), d3 = tr_read<v_rd_off_p(1, 3, 1)>(vb);
  asm volatile("s_waitcnt lgkmcnt(0)" ::: "memory"); SBAR();
#define PK(L, H) (bf16x8){L[0], L[1], L[2], L[3], H[0], H[1], H[2], H[3]}
  const bf16x8 ones = {16256, 16256, 16256, 16256, 16256, 16256, 16256, 16256};
  o[0] = __builtin_amdgcn_mfma_f32_32x32x16_bf16(pa0, PK(a0, b0), o[0], 0, 0, 0); o[1] = __builtin_amdgcn_mfma_f32_32x32x16_bf16(pa0, PK(c0, d0), o[1], 0, 0, 0); o[2] = __builtin_amdgcn_mfma_f32_32x32x16_bf16(pa0, ones, o[2], 0, 0, 0);
  o[0] = __builtin_amdgcn_mfma_f32_32x32x16_bf16(pa1, PK(a1, b1), o[0], 0, 0, 0); o[1] = __builtin_amdgcn_mfma_f32_32x32x16_bf16(pa1, PK(c1, d1), o[1], 0, 0, 0); o[2] = __builtin_amdgcn_mfma_f32_32x32x16_bf16(pa1, ones, o[2], 0, 0, 0);
  o[0] = __builtin_amdgcn_mfma_f32_32x32x16_bf16(pa2, PK(a2, b2), o[0], 0, 0, 0); o[1] = __builtin_amdgcn_mfma_f32_32x32x16_bf16(pa2, PK(c2, d2), o[1], 0, 0, 0); o[2] = __builtin_amdgcn_mfma_f32_32x32x16_bf16(pa2, ones, o[2], 0, 0, 0);
  o[0] = __builtin_amdgcn_mfma_f32_32x32x16_bf16(pa3, PK(a3, b3), o[0], 0, 0, 0); o[1] = __builtin_amdgcn_mfma_f32_32x32x16_bf16(pa3, PK(c3, d3), o[1], 0, 0, 0); o[2] = __builtin_amdgcn_mfma_f32_32x32x16_bf16(pa3, ones, o[2], 0, 0, 0);
#undef PK
}
__device__ __forceinline__ void fsm2p(f32x16& p0, f32x16& p1, bf16x8& pa0, bf16x8& pa1, bf16x8& pa2, bf16x8& pa3) {
#pragma unroll
  for (int r = 0; r < 16; ++r) p1[r] = __builtin_amdgcn_exp2f(p1[r]);
#define PK8(P, BASE, OUT) do { u32x4 w = {cvtpk(P[BASE + 0], P[BASE + 1]), cvtpk(P[BASE + 2], P[BASE + 3]), cvtpk(P[BASE + 4], P[BASE + 5]), cvtpk(P[BASE + 6], P[BASE + 7])}; OUT = *reinterpret_cast<bf16x8*>(&w); } while (0)
  PK8(p0, 0, pa0); PK8(p0, 8, pa1); PK8(p1, 0, pa2); PK8(p1, 8, pa3);
#undef PK8
}
__device__ __forceinline__ void pv_all2q(f32x16* o, int vb, bf16x8 pa0, bf16x8 pa1, bf16x8 pa2, bf16x8 pa3) {
  const s16x4 a0 = tr_read<v_rd_off_p(0, 0, 0)>(vb), b0 = tr_read<v_rd_off_p(0, 0, 1)>(vb), a1 = tr_read<v_rd_off_p(0, 1, 0)>(vb), b1 = tr_read<v_rd_off_p(0, 1, 1)>(vb);
  const s16x4 a2 = tr_read<v_rd_off_p(0, 2, 0)>(vb), b2 = tr_read<v_rd_off_p(0, 2, 1)>(vb), a3 = tr_read<v_rd_off_p(0, 3, 0)>(vb), b3 = tr_read<v_rd_off_p(0, 3, 1)>(vb);
  const s16x4 c0 = tr_read<v_rd_off_p(1, 0, 0)>(vb), d0 = tr_read<v_rd_off_p(1, 0, 1)>(vb), c1 = tr_read<v_rd_off_p(1, 1, 0)>(vb), d1 = tr_read<v_rd_off_p(1, 1, 1)>(vb);
  const s16x4 c2 = tr_read<v_rd_off_p(1, 2, 0)>(vb), d2 = tr_read<v_rd_off_p(1, 2, 1)>(vb), c3 = tr_read<v_rd_off_p(1, 3, 0)>(vb), d3 = tr_read<v_rd_off_p(1, 3, 1)>(vb);
  asm volatile("s_waitcnt lgkmcnt(0)" ::: "memory"); SBAR();
#define PK(L, H) (bf16x8){L[0], L[1], L[2], L[3], H[0], H[1], H[2], H[3]}
  o[0] = __builtin_amdgcn_mfma_f32_32x32x16_bf16(pa0, PK(a0, b0), o[0], 0, 0, 0); o[1] = __builtin_amdgcn_mfma_f32_32x32x16_bf16(pa0, PK(c0, d0), o[1], 0, 0, 0);
  o[0] = __builtin_amdgcn_mfma_f32_32x32x16_bf16(pa1, PK(a1, b1), o[0], 0, 0, 0); o[1] = __builtin_amdgcn_mfma_f32_32x32x16_bf16(pa1, PK(c1, d1), o[1], 0, 0, 0);
  o[0] = __builtin_amdgcn_mfma_f32_32x32x16_bf16(pa2, PK(a2, b2), o[0], 0, 0, 0); o[1] = __builtin_amdgcn_mfma_f32_32x32x16_bf16(pa2, PK(c2, d2), o[1], 0, 0, 0);
  o[0] = __builtin_amdgcn_mfma_f32_32x32x16_bf16(pa3, PK(a3, b3), o[0], 0, 0, 0); o[1] = __builtin_amdgcn_mfma_f32_32x32x16_bf16(pa3, PK(c3, d3), o[1], 0, 0, 0);
#undef PK
}
__device__ __forceinline__ void fsm2q(f32x16& p0, f32x16& p1, bf16x8& pa0, bf16x8& pa1, bf16x8& pa2, bf16x8& pa3, float& lsum) {
#pragma unroll
  for (int r = 0; r < 16; r += 2) { p1[r] = __builtin_amdgcn_exp2f(p1[r]); lsum += p1[r]; p1[r + 1] = __builtin_amdgcn_exp2f(p1[r + 1]); lsum += p1[r + 1]; }
#define PK8(P, BASE, OUT) do { u32x4 w = {cvtpk(P[BASE + 0], P[BASE + 1]), cvtpk(P[BASE + 2], P[BASE + 3]), cvtpk(P[BASE + 4], P[BASE + 5]), cvtpk(P[BASE + 6], P[BASE + 7])}; OUT = *reinterpret_cast<bf16x8*>(&w); } while (0)
  PK8(p0, 0, pa0); PK8(p0, 8, pa1); PK8(p1, 0, pa2); PK8(p1, 8, pa3);
#undef PK8
}
template <int KIND>
__device__ __forceinline__ void attn_fast_unit2p(const Prm& p, int l, bool isctx, int b, int hd, int qb, unsigned char* ldsu) {
  constexpr int DQK = KIND == 0 ? 96 : 64, KST = DQK * 2 + 16, SHM_K = 64 * KST, SHM_V = 8192, LPT = KIND == 0 ? 3 : 2;
  char* lds = (char*)ldsu;
  const int tid = TIDX, wid = tid >> 6, lane = tid & 63, r32 = lane & 31, hi = lane >> 5;
  char* V_lds = lds; char* K_lds = lds + 2 * SHM_V;
  float* ws = (float*)(lds + 2 * SHM_V + 2 * SHM_K) + wid * 64; float* li_l = ws; float* al_l = ws + 32;
  const int q0 = qb * 256;
  const size_t rowq0 = (size_t)b * TT + (isctx ? 0 : LC) + q0;
  const bf16_t *Qp, *Kp, *Vp; const bf16_t* KRp = WSP(bf16_t, OFF_KR); int ldq, ldk; int ocol;
  if (KIND == 0) { Qp = (const bf16_t*)(p.ws + OFF_R + R_QB) + hd * 96; ldq = NQB; Kp = (const bf16_t*)(p.ws + OFF_R + R_KB) + hd * 64; Vp = (const bf16_t*)(p.ws + OFF_R + R_VB) + hd * 64; ldk = 512; ocol = 512 + hd * 64; }
  else { Qp = (const bf16_t*)(p.ws + OFF_R + R_QA) + hd * 64; ldq = 512; Kp = (const bf16_t*)(p.ws + OFF_R + R_KA) + (hd >> 2) * 64; Vp = (const bf16_t*)(p.ws + OFF_R + R_VA) + (hd >> 2) * 64; ldk = 128; ocol = hd * 64; }
  int NT, kshift = 0; bool domask = false;
  if (isctx) NT = 4; else if (KIND == 0) NT = TT / 64; else { const int ks = max(0, q0 - 128), ke = min(SEQ, q0 + 384); NT = 4 + (ke - ks) / 64; kshift = ks; domask = true; }
  const size_t kb0 = (size_t)b * TT;
  float mhat = 0.f, lsum = 0.f; f32x16 o[2] = {}; f32x16 negm = {}; bf16x8 qr[DQK / 16];
  { const bf16_t* Qw = Qp + (rowq0 + wid * 32 + r32) * ldq + hi * 8;
#pragma unroll
    for (int d0 = 0; d0 < DQK / 16; ++d0) qr[d0] = *reinterpret_cast<const bf16x8*>(Qw + d0 * 16); }
  const int sr = tid >> 3, sc = (tid & 7) * 8, vst = v_st_p(sr, sc), kst = sr * KST + sc * 2;
  const int rr_ = (tid & 255) >> 2, rc_ = (tid & 3) * 8, krst = rr_ * KST + 128 + rc_ * 2;
  const int vb0 = (int)(uintptr_t)V_lds + v_rd_base_p(lane);
  struct { bf16x8 v, k, kr; } st_[1];
#define KROW(j) (kb0 + (size_t)(j) * 64 + ((j) >= 4 ? kshift : 0))
  const unsigned voffs = (unsigned)(sr * ldk + sc) * 2u, kroffs = (unsigned)(rr_ * 32 + rc_) * 2u;
#define SLOAD(i, j) do { const size_t kr0_ = KROW(j); const char* vb_ = (const char*)(Vp + kr0_ * ldk); const char* kb_ = (const char*)(Kp + kr0_ * ldk); \
    st_[i].v = *reinterpret_cast<const bf16x8*>(vb_ + voffs); st_[i].k = *reinterpret_cast<const bf16x8*>(kb_ + voffs); \
    if (KIND == 0) { const char* rb_ = (const char*)(KRp + kr0_ * 32); st_[i].kr = *reinterpret_cast<const bf16x8*>(rb_ + kroffs); } } while (0)
#define SWRITE(bf, i) do { *(bf16x8*)(V_lds + (bf) * SHM_V + vst) = st_[i].v; *(bf16x8*)(K_lds + (bf) * SHM_K + kst) = st_[i].k; \
    if (KIND == 0) { if (tid < 256) *(bf16x8*)(K_lds + (bf) * SHM_K + krst) = st_[i].kr; } } while (0)
#define SWAIT() do { if (LPT == 3) asm volatile("s_waitcnt vmcnt(3)" ::: "memory"); else asm volatile("s_waitcnt vmcnt(2)" ::: "memory"); } while (0)
#define RESC(a) do { if (__any((a) < 1.f)) { if (hi == 0) al_l[r32] = (a); asm volatile("s_waitcnt lgkmcnt(0)" ::: "memory"); \
    _Pragma("unroll") for (int d = 0; d < 2; ++d) _Pragma("unroll") for (int r = 0; r < 16; ++r) o[d][r] *= al_l[crow(r, hi)]; } } while (0)
#define AMASK(P0, P1, j) do { if (KIND == 1) { if (domask && (j) >= 4) { const int tq_ = q0 + wid * 32 + r32; const int tk_ = kshift + ((j) - 4) * 64 + 4 * hi; \
    _Pragma("unroll") for (int r = 0; r < 16; ++r) { const int d_ = tq_ - (tk_ + (r & 3) + 8 * (r >> 2)); if (d_ > 128 || d_ < -128) P0[r] = -INFINITY; if (d_ - 32 > 128 || d_ - 32 < -128) P1[r] = -INFINITY; } } } } while (0)
  if (__builtin_amdgcn_readfirstlane(wid) >= 4) __builtin_amdgcn_s_setprio(1);
  f32x16 pA0, pA1, pB0, pB1; float alA, alB; bf16x8 pa0, pa1, pa2, pa3;
  const int wq0_ = q0 + __builtin_amdgcn_readfirstlane(wid) * 32;
#define TACT(j) (KIND != 1 || !domask || (j) < 4 || (kshift + ((j) - 4) * 64 + 63 >= wq0_ - 128 && kshift + ((j) - 4) * 64 <= wq0_ + 31 + 128))
  bool actA, actB;
  SLOAD(0, 0); asm volatile("s_waitcnt vmcnt(0)" ::: "memory"); SWRITE(0, 0); __syncthreads();
  actA = true; qkt2<DQK>(pA0, pA1, K_lds, qr, negm, r32, hi); AMASK(pA0, pA1, 0); psm2q<true>(pA0, pA1, mhat, negm, alA, lsum);
  SLOAD(0, 1);
  SWRITE(1, 0); __syncthreads();
  for (int j = 1; j + 1 < NT; j += 2) {
    actB = TACT(j);
    SBAR(); if (actB) qkt2<DQK>(pB0, pB1, K_lds + SHM_K, qr, negm, r32, hi);
    if (actA) fsm2q(pA0, pA1, pa0, pa1, pa2, pa3, lsum); SBAR();
    SLOAD(0, j + 1); SBAR();
    if (actA) pv_all2q(o, vb0, pa0, pa1, pa2, pa3); if (actB) { AMASK(pB0, pB1, j); psm2q<false>(pB0, pB1, mhat, negm, alB, lsum); } else alB = 1.f;
    __syncthreads(); SWRITE(0, 0);
    RESC(alB); __syncthreads();
    actA = TACT(j + 1);
    SBAR(); if (actA) qkt2<DQK>(pA0, pA1, K_lds, qr, negm, r32, hi);
    if (actB) fsm2q(pB0, pB1, pa0, pa1, pa2, pa3, lsum); SBAR();
    SLOAD(0, j + 2); SBAR();
    if (actB) pv_all2q(o, vb0 + SHM_V, pa0, pa1, pa2, pa3); if (actA) { AMASK(pA0, pA1, j + 1); psm2q<false>(pA0, pA1, mhat, negm, alA, lsum); } else alA = 1.f;
    __syncthreads(); SWRITE(1, 0);
    RESC(alA); __syncthreads();
  }
  actB = TACT(NT - 1);
  SBAR(); if (actB) qkt2<DQK>(pB0, pB1, K_lds + SHM_K, qr, negm, r32, hi);
  if (actA) fsm2q(pA0, pA1, pa0, pa1, pa2, pa3, lsum); SBAR();
  if (actA) pv_all2q(o, vb0, pa0, pa1, pa2, pa3); if (actB) { AMASK(pB0, pB1, NT - 1); psm2q<false>(pB0, pB1, mhat, negm, alB, lsum); } else alB = 1.f;
  __syncthreads(); RESC(alB);
  if (actB) { fsm2q(pB0, pB1, pa0, pa1, pa2, pa3, lsum); SBAR();
    pv_all2q(o, vb0 + SHM_V, pa0, pa1, pa2, pa3); }
  __builtin_amdgcn_s_setprio(0);
  const int lanee = TIDX & 63, r32e = lanee & 31, hie = lanee >> 5;
  float rli[16];
  { auto rr = __builtin_amdgcn_permlane32_swap(__float_as_uint(lsum), __float_as_uint(lsum), false, false); lsum = __uint_as_float(rr[0]) + __uint_as_float(rr[1]); }
  if (hie == 0) { al_l[r32e] = lsum; if (KIND == 1) li_l[r32e] = mhat; } asm volatile("s_waitcnt lgkmcnt(0)" ::: "memory");
  if (KIND == 1) { const float sk2 = p.sink[l * 8 + hd] * LOG2E;
#pragma unroll
    for (int r = 0; r < 16; ++r) rli[r] = __builtin_amdgcn_rcpf(al_l[crow(r, hie)] + __builtin_amdgcn_exp2f(sk2 - li_l[crow(r, hie)])); }
  else {
#pragma unroll
    for (int r = 0; r < 16; ++r) rli[r] = __builtin_amdgcn_rcpf(al_l[crow(r, hie)]); }
  bf16_t* Ow = (bf16_t*)(p.ws + OFF_R + R_H) + (rowq0 + wid * 32) * DM + ocol;
#pragma unroll
  for (int r = 0; r < 16; ++r) { const int orow = crow(r, hie);
#pragma unroll
    for (int d0 = 0; d0 < 2; ++d0) Ow[(size_t)orow * DM + d0 * 32 + r32e] = f2bf(o[d0][r] * rli[r]); }
  __syncthreads();
#undef KROW
#undef SLOAD
#undef SWRITE
#undef SWAIT
#undef RESC
#undef AMASK
#undef TACT
}
#ifdef DBG_ATTN_PROBE
template <int KIND, int VAR>
__device__ __forceinline__ void attn_probe_unit(const Prm& p, int l, bool isctx, int b, int hd, int qb, unsigned char* ldsu) {
  constexpr int DQK = KIND == 0 ? 96 : 64, KST = DQK * 2 + 16, SHM_K = 64 * KST, SHM_V = 8192, LPT = KIND == 0 ? 3 : 2;
  char* lds = (char*)ldsu;
  const int tid = TIDX, wid = tid >> 6, lane = tid & 63, r32 = lane & 31, hi = lane >> 5;
  char* V_lds = lds; char* K_lds = lds + 2 * SHM_V;
  float* ws = (float*)(lds + 2 * SHM_V + 2 * SHM_K) + wid * 64; float* li_l = ws; float* al_l = ws + 32;
  const int q0 = qb * 256;
  const size_t rowq0 = (size_t)b * TT + (isctx ? 0 : LC) + q0;
  const bf16_t *Qp, *Kp, *Vp; const bf16_t* KRp = WSP(bf16_t, OFF_KR); int ldq, ldk; int ocol;
  if (KIND == 0) { Qp = (const bf16_t*)(p.ws + OFF_R + R_QB) + hd * 96; ldq = NQB; Kp = (const bf16_t*)(p.ws + OFF_R + R_KB) + hd * 64; Vp = (const bf16_t*)(p.ws + OFF_R + R_VB) + hd * 64; ldk = 512; ocol = 512 + hd * 64; }
  else { Qp = (const bf16_t*)(p.ws + OFF_R + R_QA) + hd * 64; ldq = 512; Kp = (const bf16_t*)(p.ws + OFF_R + R_KA) + (hd >> 2) * 64; Vp = (const bf16_t*)(p.ws + OFF_R + R_VA) + (hd >> 2) * 64; ldk = 128; ocol = hd * 64; }
  int NT, kshift = 0; bool domask = false;
  if (isctx) NT = 4; else if (KIND == 0) NT = TT / 64; else { const int ks = max(0, q0 - 128), ke = min(SEQ, q0 + 384); NT = 4 + (ke - ks) / 64; kshift = ks; domask = true; }
  const size_t kb0 = (size_t)b * TT;
  float mhat = 0.f; f32x16 o[3] = {}; f32x16 negm = {}; bf16x8 qr[DQK / 16];
  { const bf16_t* Qw = Qp + (rowq0 + wid * 32 + r32) * ldq + hi * 8;
#pragma unroll
    for (int d0 = 0; d0 < DQK / 16; ++d0) qr[d0] = *reinterpret_cast<const bf16x8*>(Qw + d0 * 16); }
  const int sr = tid >> 3, sc = (tid & 7) * 8, vst = v_st_p(sr, sc), kst = sr * KST + sc * 2;
  const int rr_ = (tid & 255) >> 2, rc_ = (tid & 3) * 8, krst = rr_ * KST + 128 + rc_ * 2;
  const int vb0 = (int)(uintptr_t)V_lds + v_rd_base_p(lane);
  struct { bf16x8 v, k, kr; } st_[1];
#define KROW(j) (kb0 + (size_t)(j) * 64 + ((j) >= 4 ? kshift : 0))
#define SLOAD(i, j) do { if (VAR & 4) break; const size_t kr0_ = KROW(j); st_[i].v = *reinterpret_cast<const bf16x8*>(Vp + (kr0_ + sr) * ldk + sc); st_[i].k = *reinterpret_cast<const bf16x8*>(Kp + (kr0_ + sr) * ldk + sc); \
    if (KIND == 0) st_[i].kr = *reinterpret_cast<const bf16x8*>(KRp + (kr0_ + rr_) * 32 + rc_); } while (0)
#define SWRITE(bf, i) do { if (VAR & 4) break; *(bf16x8*)(V_lds + (bf) * SHM_V + vst) = st_[i].v; *(bf16x8*)(K_lds + (bf) * SHM_K + kst) = st_[i].k; \
    if (KIND == 0) { if (tid < 256) *(bf16x8*)(K_lds + (bf) * SHM_K + krst) = st_[i].kr; } } while (0)
#define SWAIT() do { if (LPT == 3) asm volatile("s_waitcnt vmcnt(3)" ::: "memory"); else asm volatile("s_waitcnt vmcnt(2)" ::: "memory"); } while (0)
#define RESC(a) do { if (__any((a) < 1.f)) { if (hi == 0) al_l[r32] = (a); asm volatile("s_waitcnt lgkmcnt(0)" ::: "memory"); \
    _Pragma("unroll") for (int d = 0; d < 3; ++d) _Pragma("unroll") for (int r = 0; r < 16; ++r) o[d][r] *= al_l[crow(r, hi)]; } } while (0)
#define AMASK(P0, P1, j) do { if (KIND == 1) { if (domask && (j) >= 4) { const int tq_ = q0 + wid * 32 + r32; const int tk_ = kshift + ((j) - 4) * 64 + 4 * hi; \
    _Pragma("unroll") for (int r = 0; r < 16; ++r) { const int d_ = tq_ - (tk_ + (r & 3) + 8 * (r >> 2)); if (d_ > 128 || d_ < -128) P0[r] = -INFINITY; if (d_ - 32 > 128 || d_ - 32 < -128) P1[r] = -INFINITY; } } } } while (0)
  f32x16 pA0, pA1, pB0, pB1; float alA, alB; bf16x8 pa0, pa1, pa2, pa3;
  const int wq0_ = q0 + __builtin_amdgcn_readfirstlane(wid) * 32;
#define TACT(j) (KIND != 1 || !domask || (j) < 4 || (kshift + ((j) - 4) * 64 + 63 >= wq0_ - 128 && kshift + ((j) - 4) * 64 <= wq0_ + 31 + 128))
  bool actA, actB;
  SLOAD(0, 0); asm volatile("s_waitcnt vmcnt(0)" ::: "memory"); SWRITE(0, 0); do { if (!(VAR & 1)) __syncthreads(); } while (0);
  do { if (!(VAR & 16)) qkt2<DQK>(pA0, pA1, K_lds, qr, negm, r32, hi); else { pA0 = negm; pA1 = negm; asm volatile("" : "+v"(pA0), "+v"(pA1)); } } while (0); AMASK(pA0, pA1, 0); do { if (!(VAR & 2)) psm2<true>(pA0, pA1, mhat, negm, alA); else alA = 1.f; } while (0);
  SLOAD(0, 1);
  SWRITE(1, 0); do { if (!(VAR & 1)) __syncthreads(); } while (0);
  for (int j = 1; j + 1 < NT; j += 2) {
    SBAR(); do { if (!(VAR & 16)) qkt2<DQK>(pB0, pB1, K_lds + SHM_K, qr, negm, r32, hi); else { pB0 = negm; pB1 = negm; asm volatile("" : "+v"(pB0), "+v"(pB1)); } } while (0);
    do { if (!(VAR & 2)) fsm2p(pA0, pA1, pa0, pa1, pa2, pa3); else { pa0 = __builtin_bit_cast(bf16x8, (f32x4){pA0[0], pA0[1], pA0[2], pA0[3]}); pa1 = __builtin_bit_cast(bf16x8, (f32x4){pA0[4], pA0[5], pA0[6], pA0[7]}); pa2 = __builtin_bit_cast(bf16x8, (f32x4){pA1[0], pA1[1], pA1[2], pA1[3]}); pa3 = __builtin_bit_cast(bf16x8, (f32x4){pA1[4], pA1[5], pA1[6], pA1[7]}); } } while (0); SBAR();
    SLOAD(0, j + 1); SBAR();
    do { if (!(VAR & 8)) pv_all2p(o, vb0, pa0, pa1, pa2, pa3); else { asm volatile("" :: "v"(pa0), "v"(pa1), "v"(pa2), "v"(pa3)); } } while (0); AMASK(pB0, pB1, j); do { if (!(VAR & 2)) psm2<false>(pB0, pB1, mhat, negm, alB); else alB = 1.f; } while (0);
    do { if (!(VAR & 1)) __syncthreads(); } while (0); SWRITE(0, 0);
    RESC(alB); do { if (!(VAR & 1)) __syncthreads(); } while (0);
    SBAR(); do { if (!(VAR & 16)) qkt2<DQK>(pA0, pA1, K_lds, qr, negm, r32, hi); else { pA0 = negm; pA1 = negm; asm volatile("" : "+v"(pA0), "+v"(pA1)); } } while (0);
    do { if (!(VAR & 2)) fsm2p(pB0, pB1, pa0, pa1, pa2, pa3); else { pa0 = __builtin_bit_cast(bf16x8, (f32x4){pB0[0], pB0[1], pB0[2], pB0[3]}); pa1 = __builtin_bit_cast(bf16x8, (f32x4){pB0[4], pB0[5], pB0[6], pB0[7]}); pa2 = __builtin_bit_cast(bf16x8, (f32x4){pB1[0], pB1[1], pB1[2], pB1[3]}); pa3 = __builtin_bit_cast(bf16x8, (f32x4){pB1[4], pB1[5], pB1[6], pB1[7]}); } } while (0); SBAR();
    SLOAD(0, j + 2); SBAR();
    do { if (!(VAR & 8)) pv_all2p(o, vb0 + SHM_V, pa0, pa1, pa2, pa3); else { asm volatile("" :: "v"(pa0), "v"(pa1), "v"(pa2), "v"(pa3)); } } while (0); AMASK(pA0, pA1, j + 1); do { if (!(VAR & 2)) psm2<false>(pA0, pA1, mhat, negm, alA); else alA = 1.f; } while (0);
    do { if (!(VAR & 1)) __syncthreads(); } while (0); SWRITE(1, 0);
    RESC(alA); do { if (!(VAR & 1)) __syncthreads(); } while (0);
  }
  SBAR(); do { if (!(VAR & 16)) qkt2<DQK>(pB0, pB1, K_lds + SHM_K, qr, negm, r32, hi); else { pB0 = negm; pB1 = negm; asm volatile("" : "+v"(pB0), "+v"(pB1)); } } while (0);
  do { if (!(VAR & 2)) fsm2p(pA0, pA1, pa0, pa1, pa2, pa3); else { pa0 = __builtin_bit_cast(bf16x8, (f32x4){pA0[0], pA0[1], pA0[2], pA0[3]}); pa1 = __builtin_bit_cast(bf16x8, (f32x4){pA0[4], pA0[5], pA0[6], pA0[7]}); pa2 = __builtin_bit_cast(bf16x8, (f32x4){pA1[0], pA1[1], pA1[2], pA1[3]}); pa3 = __builtin_bit_cast(bf16x8, (f32x4){pA1[4], pA1[5], pA1[6], pA1[7]}); } } while (0); SBAR();
  do { if (!(VAR & 8)) pv_all2p(o, vb0, pa0, pa1, pa2, pa3); else { asm volatile("" :: "v"(pa0), "v"(pa1), "v"(pa2), "v"(pa3)); } } while (0); AMASK(pB0, pB1, NT - 1); do { if (!(VAR & 2)) psm2<false>(pB0, pB1, mhat, negm, alB); else alB = 1.f; } while (0);
  do { if (!(VAR & 1)) __syncthreads(); } while (0); RESC(alB);
  do { if (!(VAR & 2)) fsm2p(pB0, pB1, pa0, pa1, pa2, pa3); else { pa0 = __builtin_bit_cast(bf16x8, (f32x4){pB0[0], pB0[1], pB0[2], pB0[3]}); pa1 = __builtin_bit_cast(bf16x8, (f32x4){pB0[4], pB0[5], pB0[6], pB0[7]}); pa2 = __builtin_bit_cast(bf16x8, (f32x4){pB1[0], pB1[1], pB1[2], pB1[3]}); pa3 = __builtin_bit_cast(bf16x8, (f32x4){pB1[4], pB1[5], pB1[6], pB1[7]}); } } while (0); SBAR();
  do { if (!(VAR & 8)) pv_all2p(o, vb0 + SHM_V, pa0, pa1, pa2, pa3); else { asm volatile("" :: "v"(pa0), "v"(pa1), "v"(pa2), "v"(pa3)); } } while (0);
  float rli[16];
  if (KIND == 1) { if (hi == 0) li_l[r32] = mhat; asm volatile("s_waitcnt lgkmcnt(0)" ::: "memory"); const float sk2 = p.sink[l * 8 + hd] * LOG2E;
#pragma unroll
    for (int r = 0; r < 16; ++r) rli[r] = __builtin_amdgcn_rcpf(o[2][r] + __builtin_amdgcn_exp2f(sk2 - li_l[crow(r, hi)])); }
  else {
#pragma unroll
    for (int r = 0; r < 16; ++r) rli[r] = __builtin_amdgcn_rcpf(o[2][r]); }
  bf16_t* Ow = (bf16_t*)(p.ws + OFF_R + R_CQ) + ((rowq0 + wid * 32) & 16383) * DM + ocol;
#pragma unroll
  for (int r = 0; r < 16; ++r) { const int orow = crow(r, hi);
#pragma unroll
    for (int d0 = 0; d0 < 2; ++d0) Ow[(size_t)orow * DM + d0 * 32 + r32] = f2bf(o[d0][r] * rli[r]); }
  do { if (!(VAR & 1)) __syncthreads(); } while (0);
#undef KROW
#undef SLOAD
#undef SWRITE
#undef SWAIT
#undef RESC
#undef AMASK
#undef TACT
}

template <int VAR>
__device__ __forceinline__ void ph_attn_probe(const Prm& p, int l, unsigned char* lds, int bid, int nb) {
  const int nrounds = (1024 + nb - 1) / nb;
  for (int rd = 0; rd < nrounds; ++rd) { const int pair = rd * 8 + (bid & 7), qb = bid >> 3, u = pair * 32 + qb;
    if (u < 1024) attn_probe_unit<0, VAR>(p, l, false, u >> 8, (u >> 5) & 7, u & 31, lds); }
}
#endif
template <int KIND>
__device__ __forceinline__ void attn_fast_unit3(const Prm& p, int l, bool isctx, int b, int hd, int qb, unsigned char* ldsu) {
  constexpr int DQK = KIND == 0 ? 96 : 64, KST = DQK * 2 + 16, SHM_K = 64 * KST, SHM_V = 8192, LPT = KIND == 0 ? 3 : 2;
  char* lds = (char*)ldsu;
  const int tid = TIDX, wid = tid >> 6, lane = tid & 63, r32 = lane & 31, hi = lane >> 5;
  char* V_lds = lds; char* K_lds = lds + 3 * SHM_V;
  float* ws = (float*)(lds + 3 * SHM_V + 3 * SHM_K) + wid * 64; float* li_l = ws; float* al_l = ws + 32;
  const int q0 = qb * 256;
  const size_t rowq0 = (size_t)b * TT + (isctx ? 0 : LC) + q0;
  const bf16_t *Qp, *Kp, *Vp; const bf16_t* KRp = WSP(bf16_t, OFF_KR); int ldq, ldk; int ocol;
  if (KIND == 0) { Qp = (const bf16_t*)(p.ws + OFF_R + R_QB) + hd * 96; ldq = NQB; Kp = (const bf16_t*)(p.ws + OFF_R + R_KB) + hd * 64; Vp = (const bf16_t*)(p.ws + OFF_R + R_VB) + hd * 64; ldk = 512; ocol = 512 + hd * 64; }
  else { Qp = (const bf16_t*)(p.ws + OFF_R + R_QA) + hd * 64; ldq = 512; Kp = (const bf16_t*)(p.ws + OFF_R + R_KA) + (hd >> 2) * 64; Vp = (const bf16_t*)(p.ws + OFF_R + R_VA) + (hd >> 2) * 64; ldk = 128; ocol = hd * 64; }
  int NT, kshift = 0; bool domask = false;
  if (isctx) NT = 4; else if (KIND == 0) NT = TT / 64; else { const int ks = max(0, q0 - 128), ke = min(SEQ, q0 + 384); NT = 4 + (ke - ks) / 64; kshift = ks; domask = true; }
  const size_t kb0 = (size_t)b * TT;
  float mhat = 0.f; f32x16 o[3] = {}; f32x16 negm = {}; bf16x8 qr[DQK / 16];
  { const bf16_t* Qw = Qp + (rowq0 + wid * 32 + r32) * ldq + hi * 8;
#pragma unroll
    for (int d0 = 0; d0 < DQK / 16; ++d0) qr[d0] = *reinterpret_cast<const bf16x8*>(Qw + d0 * 16); }
  const int sr = tid >> 3, sc = (tid & 7) * 8, vst = v_st(sr, sc), kst = sr * KST + sc * 2;
  const int rr_ = (tid & 255) >> 2, rc_ = (tid & 3) * 8, krst = rr_ * KST + 128 + rc_ * 2;
  const int vb0 = (int)(uintptr_t)V_lds + v_rd_base(lane);
  struct { bf16x8 v, k, kr; } st_[1];
#define KROW(j) (kb0 + (size_t)(j) * 64 + ((j) >= 4 ? kshift : 0))
#define SLOAD(i, j) do { const size_t kr0_ = KROW(j); st_[i].v = *reinterpret_cast<const bf16x8*>(Vp + (kr0_ + sr) * ldk + sc); st_[i].k = *reinterpret_cast<const bf16x8*>(Kp + (kr0_ + sr) * ldk + sc); \
    if (KIND == 0) st_[i].kr = *reinterpret_cast<const bf16x8*>(KRp + (kr0_ + rr_) * 32 + rc_); } while (0)
#define SWRITE(bf, i) do { *(bf16x8*)(V_lds + (bf) * SHM_V + vst) = st_[i].v; *(bf16x8*)(K_lds + (bf) * SHM_K + kst) = st_[i].k; \
    if (KIND == 0) { if (tid < 256) *(bf16x8*)(K_lds + (bf) * SHM_K + krst) = st_[i].kr; } } while (0)
#define SWAIT() do { if (LPT == 3) asm volatile("s_waitcnt vmcnt(3)" ::: "memory"); else asm volatile("s_waitcnt vmcnt(2)" ::: "memory"); } while (0)
#define RESC(a) do { if (__any((a) < 1.f)) { if (hi == 0) al_l[r32] = (a); asm volatile("s_waitcnt lgkmcnt(0)" ::: "memory"); \
    _Pragma("unroll") for (int d = 0; d < 3; ++d) _Pragma("unroll") for (int r = 0; r < 16; ++r) o[d][r] *= al_l[crow(r, hi)]; } } while (0)
#define AMASK(P0, P1, j) do { if (KIND == 1) { if (domask && (j) >= 4) { const int tq_ = q0 + wid * 32 + r32; const int tk_ = kshift + ((j) - 4) * 64 + 4 * hi; \
    _Pragma("unroll") for (int r = 0; r < 16; ++r) { const int d_ = tq_ - (tk_ + (r & 3) + 8 * (r >> 2)); if (d_ > 128 || d_ < -128) P0[r] = -INFINITY; if (d_ - 32 > 128 || d_ - 32 < -128) P1[r] = -INFINITY; } } } } while (0)
  f32x16 pA0, pA1, pB0, pB1; float alA, alB; bf16x8 pa0, pa1, pa2, pa3;
  SLOAD(0, 0); SWRITE(0, 0); SLOAD(0, 1); SWRITE(1, 0); __syncthreads();
  qkt2<DQK>(pA0, pA1, K_lds, qr, negm, r32, hi); AMASK(pA0, pA1, 0); psm2<true>(pA0, pA1, mhat, negm, alA);
  int r0 = 0, r1 = 1, r2 = 2;
#define ITER(PP0, PP1, PC0, PC1, ALC, j) do { \
    if ((j) + 2 < NT) SLOAD(0, (j) + 2); \
    SBAR(); qkt2<DQK>(PC0, PC1, K_lds + r1 * SHM_K, qr, negm, r32, hi); \
    fsm2(PP0, PP1, pa0, pa1, pa2, pa3); SBAR(); \
    pv_all2(o, vb0 + r0 * SHM_V, pa0, pa1, pa2, pa3); AMASK(PC0, PC1, (j) + 1); psm2<false>(PC0, PC1, mhat, negm, ALC); \
    RESC(ALC); \
    if ((j) + 2 < NT) SWRITE(r2, 0); \
    __syncthreads(); \
    { const int t_ = r0; r0 = r1; r1 = r2; r2 = t_; } } while (0)
  int j = 0;
  for (; j + 2 < NT; j += 2) { ITER(pA0, pA1, pB0, pB1, alB, j); ITER(pB0, pB1, pA0, pA1, alA, j + 1); }
  ITER(pA0, pA1, pB0, pB1, alB, j);
  fsm2(pB0, pB1, pa0, pa1, pa2, pa3); SBAR();
  pv_all2(o, vb0 + r0 * SHM_V, pa0, pa1, pa2, pa3);
#undef ITER
  float rli[16];
  if (KIND == 1) { if (hi == 0) li_l[r32] = mhat; asm volatile("s_waitcnt lgkmcnt(0)" ::: "memory"); const float sk2 = p.sink[l * 8 + hd] * LOG2E;
#pragma unroll
    for (int r = 0; r < 16; ++r) rli[r] = __builtin_amdgcn_rcpf(o[2][r] + __builtin_amdgcn_exp2f(sk2 - li_l[crow(r, hi)])); }
  else {
#pragma unroll
    for (int r = 0; r < 16; ++r) rli[r] = __builtin_amdgcn_rcpf(o[2][r]); }
  bf16_t* Ow = (bf16_t*)(p.ws + OFF_R + R_H) + (rowq0 + wid * 32) * DM + ocol;
#pragma unroll
  for (int r = 0; r < 16; ++r) { const int orow = crow(r, hi);
#pragma unroll
    for (int d0 = 0; d0 < 2; ++d0) Ow[(size_t)orow * DM + d0 * 32 + r32] = f2bf(o[d0][r] * rli[r]); }
  __syncthreads();
#undef KROW
#undef SLOAD
#undef SWRITE
#undef SWAIT
#undef RESC
#undef AMASK
}
#ifndef ATTN_V2
#define ATTN_V2 1
#endif
#ifndef ATTN_V3
#define ATTN_V3 0
#endif
#ifndef ATTN_V2P
#define ATTN_V2P 1
#endif
#if ATTN_V2P
#define ATTN_UNIT attn_fast_unit2p
#elif ATTN_V3
#define ATTN_UNIT attn_fast_unit3
#elif ATTN_V2
#define ATTN_UNIT attn_fast_unit2
#else
#define ATTN_UNIT attn_fast_unit
#endif
__device__ __forceinline__ void ph_attn_fast(const Prm& p, int l, unsigned char* lds, int bid, int nb) {
  const int nrounds = (1024 + nb - 1) / nb;
  for (int rd = 0; rd < nrounds; ++rd) { int u;
    if ((nb & 7) == 0 && (nb >> 3) == 32) { const int pair = rd * 8 + (bid & 7), qb = bid >> 3; u = pair * 32 + qb; } else u = rd * nb + bid;
    if (u < 1024) ATTN_UNIT<0>(p, l, false, u >> 8, (u >> 5) & 7, u & 31, lds); }
  for (int rd = 0; rd < nrounds; ++rd) { int u;
    if ((nb & 7) == 0 && (nb >> 3) == 32) { const int pair = rd * 8 + (bid & 7), qb = bid >> 3; u = pair * 32 + qb; } else u = rd * nb + bid;
    if (u < 1024) ATTN_UNIT<1>(p, l, false, u >> 8, (u >> 5) & 7, u & 31, lds); }
  if (l != DEPTH - 1) for (int u = bid; u < 64; u += nb) { const int kind = u & 1, hd = (u >> 1) & 7, b = u >> 4;
      if (kind == 0) ATTN_UNIT<0>(p, l, true, b, hd, 0, lds); else ATTN_UNIT<1>(p, l, true, b, hd, 0, lds); }
}

#define XB_TMO      128
#define XB_XCNT(j)  (256  + 64 * (j))
#define XB_XSUB(j)  (1280 + 64 * (j))
#define XB_XGEN(j)  (2304 + 64 * (j))
#define XB_TOP      3328
#define XB_TOPGEN   3392
#define XCD_BAR_WORDS 3456
#define XB_SPIN_CAP (1u << 22)
#define LAS __attribute__((address_space(3)))
__device__ __forceinline__ unsigned xb_ld(unsigned* p)              { return __hip_atomic_load(p, __ATOMIC_RELAXED, __HIP_MEMORY_SCOPE_AGENT); }
__device__ __forceinline__ unsigned xb_add(unsigned* p, unsigned v) { return __hip_atomic_fetch_add(p, v, __ATOMIC_RELAXED, __HIP_MEMORY_SCOPE_AGENT); }
__device__ __forceinline__ unsigned xb_xcc_id() { return (unsigned)__builtin_amdgcn_s_getreg((3 << 11) | 20) & 0xFu; }
#define XB_SPIN(cond, bar) do { unsigned _sp = 0; while (cond) { __builtin_amdgcn_s_sleep(1); \
    if ((++_sp & 255u) == 0u) { if (xb_ld(&(bar)[XB_TMO])) break; if (_sp > XB_SPIN_CAP) { atomicAdd(&(bar)[XB_TMO], 1u); break; } } } } while (0)
struct XcdBarrier { unsigned* bar; unsigned x; volatile LAS unsigned* st; };
__device__ __forceinline__ XcdBarrier xcd_barrier_post(unsigned* bar, volatile LAS unsigned* st) {
    XcdBarrier b; b.bar = bar; b.x = xb_xcc_id(); b.st = st;
    if (TIDX == 0) (void)xb_add(&bar[XB_XCNT(b.x)], 1u);
    return b;
}
__device__ __forceinline__ void xcd_barrier_complete(unsigned* bar, unsigned x, unsigned& nloc, unsigned& nx) {
    const unsigned G = gridDim.x * gridDim.y * gridDim.z;
    unsigned sum, cnt, mine, sp = 0u;
    for (;;) {
        sum = 0u; cnt = 0u; mine = 0u;
#pragma unroll
        for (unsigned j = 0; j < 16; ++j) { const unsigned c = xb_ld(&bar[XB_XCNT(j)]); sum += c; cnt += (c > 0u) ? 1u : 0u; mine = (j == x) ? c : mine; }
        if (sum == G) break;
        __builtin_amdgcn_s_sleep(1);
        if ((++sp & 255u) == 0u) { if (xb_ld(&bar[XB_TMO])) break; if (sp > XB_SPIN_CAP) { atomicAdd(&bar[XB_TMO], 1u); break; } }
    }
    nloc = mine > 0u ? mine : 1u; nx = cnt > 0u ? cnt : 1u;
}
__device__ __forceinline__ void xcd_barrier(const XcdBarrier& b) {
    asm volatile("s_waitcnt vmcnt(0)" ::: "memory");
    __syncthreads();
    if (TIDX == 0) {
        unsigned* bar = b.bar;
        __builtin_amdgcn_s_waitcnt(0);
        unsigned nloc = b.st[0], nx = b.st[1];
        if (nloc == 0u) { xcd_barrier_complete(bar, b.x, nloc, nx); b.st[0] = nloc; b.st[1] = nx; }
        const unsigned old = xb_add(&bar[XB_XSUB(b.x)], 1u);
        const unsigned gen = old / nloc;
        if (old + 1u == (gen + 1u) * nloc) {
            __builtin_amdgcn_fence(__ATOMIC_RELEASE, "agent");
            asm volatile("s_waitcnt vmcnt(0)" ::: "memory");
            const unsigned og = xb_add(&bar[XB_TOP], 1u);
            const unsigned tg = og / nx;
            if (og + 1u == (tg + 1u) * nx) xb_add(&bar[XB_TOPGEN], 1u);
            else XB_SPIN(xb_ld(&bar[XB_TOPGEN]) == tg, bar);
            __builtin_amdgcn_fence(__ATOMIC_ACQUIRE, "agent");
            xb_add(&bar[XB_XGEN(b.x)], 1u);
            asm volatile("s_waitcnt vmcnt(0)" ::: "memory");
        } else {
            XB_SPIN(xb_ld(&bar[XB_XGEN(b.x)]) == gen, bar);
            __builtin_amdgcn_fence(__ATOMIC_ACQUIRE, "agent");
            asm volatile("s_waitcnt vmcnt(0)" ::: "memory");
        }
    }
    __syncthreads();
}

constexpr int NPHASE = 22;
__device__ __forceinline__ void run_phase1(const Prm& p, int ph, unsigned char* lds, int bid, int nb) {
  if (ph == 0) { ph_mod(p, 0, lds, bid, nb); ph_wconv_dense(p, 0, lds, bid, nb); return; }
  if (ph == 21) { ph_final(p, bid, nb); return; }
  const int alt = ph >= 100 ? 10 : 0; if (alt) ph -= 100;
  const int l = (ph - 1) / 10, s = (ph - 1) % 10 + alt;
  switch (s) {
    case 0: ph_norm_a(p, l, bid, nb); break;
#if FAST_GEMM
#if !defined(DBG_ONLY) || DBG_ONLY == 1
    case 1: ph2_gemm_in(p, l, lds, bid, nb); break;
#endif
#if !defined(DBG_ONLY) || DBG_ONLY == 2
    case 2: ph2_gemm_qup(p, l, lds, bid, nb); ph2_gemm_kvup(p, l, lds, bid, nb); break;
#endif
#if !defined(DBG_ONLY) || DBG_ONLY == 3
    case 3: break;
#endif
#else
    case 1: ph_gemm_in(p, l, bid, nb); break;
    case 2: ph_ssq(p, bid, nb); break;
    case 3: ph_gemm_up(p, l, bid, nb); break;
#endif
#if FAST_ATTN
    case 4: ph_attn_fast(p, l, lds, bid, nb); break;
#else
    case 4: ph_attn_naive(p, l, lds, bid, nb); break;
#endif
#if FAST_GEMM
#if !defined(DBG_ONLY) || DBG_ONLY == 5
    case 5: ph2_gemm_out(p, l, lds, bid, nb); break;
#endif
#else
    case 5: ph_gemm_out(p, l, bid, nb); break;
#endif
    case 6: ph_norm_b<true>(p, l, lds, bid, nb); break;
#ifdef DBG_NB
    case 16: ph_norm_b<false>(p, l, lds, bid, nb); break;
#endif
#ifdef DBG_ATTN_PROBE
    case 14: ph_attn_probe<DBG_ATTN_PROBE>(p, l, lds, bid, nb); break;
#endif
    case 7: ph_topk(p, l, lds, bid, nb); break;
#if FAST_GEMM
#if !defined(DBG_ONLY) || DBG_ONLY == 8
    case 8: ph2_moe_up(p, l, lds, bid, nb); break;
#endif
#if !defined(DBG_ONLY) || DBG_ONLY == 9
    case 9: ph2_moe_down(p, l, lds, bid, nb); break;
#endif
#else
    case 8: ph_moe_up(p, l, bid, nb); break;
    case 9: ph_moe_down(p, l, bid, nb); break;
#endif
  }
}

#ifndef DBG_TWICE
#define DBG_TWICE 0
#endif
#ifndef DBG_ALT
#define DBG_ALT 0
#endif
#ifndef DBG_PRE
#define DBG_PRE 0
#endif
__device__ __forceinline__ void run_phase(const Prm& p, int ph, unsigned char* lds, int bid, int nb) {
  if (DBG_PRE) { if (ph >= 1 && ph <= 20 && (ph - 1) % 10 == 0) { run_phase1(p, ph + DBG_PRE, lds, bid, nb); __syncthreads(); } }
  run_phase1(p, ph, lds, bid, nb);
  if (DBG_TWICE) { const int s = ph == 0 ? 10 : (ph == 21 ? 11 : (ph - 1) % 10); if ((DBG_TWICE >> s) & 1) { __syncthreads(); run_phase1(p, ph + DBG_ALT, lds, bid, nb); } }
}
constexpr int LDS_BYTES = FAST_GEMM ? 131072 + 16384 + 128 + 128 : 65536;
#if MK_SPLIT
__global__ void __launch_bounds__(NTHR, 2) k_phase(Prm p, int ph) {
  extern __shared__ __attribute__((aligned(16))) unsigned char lds[];
  run_phase(p, ph, lds, blockIdx.x, gridDim.x);
}
#endif
#if !MK_SPLIT
__global__ void __launch_bounds__(NTHR, 2) k_mega(Prm p) {
  extern __shared__ __attribute__((aligned(16))) unsigned char lds[];
  cg::grid_group grid = cg::this_grid();
  if (p.out == nullptr) grid.sync();
  volatile LAS unsigned* st = (volatile LAS unsigned*)((LAS unsigned char*)lds + 131072 + 16384 + 64);
  if (TIDX < 2) st[TIDX] = 0u;
  if (TIDX < 24) { const int i = TIDX; ((LAS float*)((LAS unsigned char*)lds + ROPE_TAB_OFF))[i] = (i < 16 ? exp2f(-(float)i * (13.287712379549449f / 16.f)) : exp2f(-(float)(i - 16) * (13.287712379549449f / 8.f))) * 0.15915494309189535f; }
  __syncthreads();
  XcdBarrier xb = xcd_barrier_post((unsigned*)(p.ws + OFF_CTL) + 1024, st);
#pragma unroll 1
  for (int ph = 0; ph < NPHASE; ++ph) { int phv = ph; asm volatile("" : "+s"(phv));
    run_phase(p, phv, lds, blockIdx.x, gridDim.x);
    if (ph + 1 < NPHASE && (ph % 10) != 4) xcd_barrier(xb); }
}
#define K_MAIN k_mega
#else
#define K_MAIN k_phase
#endif

extern "C" void kernel_launch(void* const* d_in, const int* in_sizes, int n_in, void* d_out, int out_size, void* d_ws, size_t ws_size, hipStream_t stream) {
  static int grid = 0;
  if (grid == 0) {
    if (n_in != 20 || ws_size < WS_END || out_size != NB * SEQ * DM) { fprintf(stderr, "kernel_launch: bad shapes n_in %d ws %zu (need %zu) out %d\n", n_in, ws_size, (size_t)WS_END, out_size); grid = -1; return; }
    int dev = 0, cus = 0, per = 0;
    (void)hipGetDevice(&dev); (void)hipDeviceGetAttribute(&cus, hipDeviceAttributeMultiprocessorCount, dev);
    (void)hipFuncSetAttribute((const void*)K_MAIN, hipFuncAttributeMaxDynamicSharedMemorySize, LDS_BYTES);
    (void)hipOccupancyMaxActiveBlocksPerMultiprocessor(&per, (const void*)K_MAIN, NTHR, LDS_BYTES);
    if (per < 1) per = 1;
    if (per > 1) per = 1;
    grid = cus * per;
    (void)hipGetLastError();
  }
  if (grid < 0) return;
  Prm p{};
  const float** pf = (const float**)&p;
  for (int i = 0; i < 20; ++i) pf[i] = (const float*)d_in[i];
  p.out = (float*)d_out; p.ws = (unsigned char*)d_ws;
#if MK_SPLIT
  for (int ph = 0; ph < NPHASE; ++ph) hipLaunchKernelGGL(k_phase, dim3(1024), dim3(NTHR), LDS_BYTES, stream, p, ph);
#else
  (void)hipMemsetAsync((char*)d_ws + OFF_CTL, 0, 65536, stream);
  void* args[] = {&p};
  hipError_t e = hipLaunchCooperativeKernel((const void*)k_mega, dim3(grid), dim3(NTHR), args, LDS_BYTES, stream);
  if (e != hipSuccess) fprintf(stderr, "cooperative launch failed: %s (grid %d)\n", hipGetErrorString(e), grid);
#endif
}
```

```cpp
#include <hip/hip_runtime.h>
#include <hip/hip_cooperative_groups.h>
#include <cstdint>
#include <cstdio>
namespace cg = cooperative_groups;

#ifndef MK_SPLIT
#define MK_SPLIT 0
#endif
#ifndef FAST_GEMM
#define FAST_GEMM 1
#endif
#ifndef FAST_ATTN
#define FAST_ATTN 1
#endif

typedef unsigned short bf16_t;
typedef short bf16x8 __attribute__((ext_vector_type(8)));
typedef float f32x4 __attribute__((ext_vector_type(4)));
typedef float f32x16 __attribute__((ext_vector_type(16)));
typedef unsigned u32x4 __attribute__((ext_vector_type(4)));
typedef unsigned u32x2 __attribute__((ext_vector_type(2)));

constexpr int NTHR = 512, NWAVE = 8;
constexpr int NB = 4, SEQ = 8192, LC = 256, TT = SEQ + LC, MR = NB * TT, DM = 1024, DEPTH = 2;
constexpr int NIN = 1440, NINP = 1536, QRK = 384, KVRK = 256, NQB = 768, NKVB = 1024;
constexpr int NE = 16, DFF = 512, CAPL = 1024, CAPC = 32;
constexpr int NSLOT = NB * NE * CAPL + NE * 256;
constexpr float EPS = 1e-6f;
constexpr float LOG2E = 1.4426950408889634f;
constexpr float SCALE_A = 0.125f * LOG2E;
constexpr float SCALE_B = 0.10206207261596575f * LOG2E;

constexpr size_t al256(size_t v) { return (v + 255) / 256 * 256; }
constexpr size_t OFF_CTL = 0;
constexpr size_t OFF_MOD = 1u << 20;
constexpr size_t OFF_ROPE = OFF_MOD + al256((size_t)2 * 5 * 6144 * 4);
constexpr size_t OFF_SSQQ = OFF_ROPE + al256((size_t)(2 * 2048 + 2 * 1024) * 4);
constexpr size_t OFF_SSQK = OFF_SSQQ + al256((size_t)MR * 4);
constexpr size_t OFF_AFF = OFF_SSQK + al256((size_t)MR * 4);
constexpr size_t OFF_INV = OFF_AFF + al256((size_t)MR * 16 * 4);
constexpr size_t OFF_IDX = OFF_INV + al256((size_t)MR * 16 * 4);
constexpr size_t OFF_VAL = OFF_IDX + al256((size_t)NSLOT * 4);
constexpr size_t OFF_KR = OFF_VAL + al256((size_t)NSLOT * 4);
constexpr size_t SZ_WIN = (size_t)NINP * DM * 2, SZ_WQ = (size_t)NQB * QRK * 2, SZ_WKV = (size_t)NKVB * KVRK * 2, SZ_WO = (size_t)DM * DM * 2;
constexpr size_t SZ_WL = SZ_WIN + SZ_WQ + SZ_WKV + SZ_WO;
constexpr size_t OFF_W = OFF_KR + al256((size_t)MR * 32 * 2);
constexpr size_t OFF_WGU = OFF_W + 2 * SZ_WL;
constexpr size_t OFF_WD = OFF_WGU + (size_t)NE * 1024 * 1024 * 2;
constexpr size_t OFF_X = OFF_WD + (size_t)NE * 1024 * 512 * 2;
constexpr size_t OFF_R = OFF_X + (size_t)MR * DM * 4;
constexpr size_t R_H = 0;
constexpr size_t R_QA = R_H + (size_t)MR * DM * 2;
constexpr size_t R_KA = R_QA + (size_t)MR * 512 * 2;
constexpr size_t R_VA = R_KA + (size_t)MR * 128 * 2;
constexpr size_t R_QB = R_VA + (size_t)MR * 128 * 2;
constexpr size_t R_KB = R_QB + (size_t)MR * 768 * 2;
constexpr size_t R_VB = R_KB + (size_t)MR * 512 * 2;
constexpr size_t R_CQ = R_VB + (size_t)MR * 512 * 2;
constexpr size_t R_CKV = R_CQ + (size_t)MR * QRK * 2;
constexpr size_t R_END = R_CKV + (size_t)MR * KVRK * 2;
constexpr size_t R_MIXG = R_QA;
constexpr size_t R_ACT = R_QA;
constexpr size_t R_Y = R_ACT + (size_t)NSLOT * DFF * 2;
static_assert(R_Y + (size_t)NSLOT * DM * 2 <= R_END, "moe overlay fits");
constexpr size_t WS_END = OFF_R + R_END;

struct Prm {
  const float *x, *c, *ctx, *c_ctx, *w_mod, *b_mod, *norm_attn, *norm_ffn, *w_in, *sink, *q_norm, *kv_norm, *w_q_up, *w_kv_up, *w_out, *w_router, *w_gate, *w_up,
      *w_down, *norm_final;
  float* out;
  unsigned char* ws;
};

__device__ __forceinline__ float bf2f(bf16_t v) { return __uint_as_float((unsigned)v << 16); }
__device__ __forceinline__ bf16_t f2bf(float f) { unsigned u = __float_as_uint(f); return (bf16_t)((u + 0x7fffu + ((u >> 16) & 1u)) >> 16); }
__device__ __forceinline__ unsigned pk2(float lo, float hi) { return (unsigned)f2bf(lo) | ((unsigned)f2bf(hi) << 16); }
template <int CTRL> __device__ __forceinline__ float dpp_mov(float x) { return __int_as_float(__builtin_amdgcn_update_dpp(0, __float_as_int(x), CTRL, 0xF, 0xF, true)); }
__device__ __forceinline__ float xor1(float x) { return dpp_mov<0xB1>(x); }
__device__ __forceinline__ float xor2(float x) { return dpp_mov<0x4E>(x); }
__device__ __forceinline__ float hmir(float x) { return dpp_mov<0x141>(x); }
__device__ __forceinline__ float xor8(float x) { return dpp_mov<0x128>(x); }
__device__ __forceinline__ float sum16sw(float x) { auto r = __builtin_amdgcn_permlane16_swap(__float_as_uint(x), __float_as_uint(x), false, false); return __uint_as_float(r[0]) + __uint_as_float(r[1]); }
__device__ __forceinline__ float sum32sw(float x) { auto r = __builtin_amdgcn_permlane32_swap(__float_as_uint(x), __float_as_uint(x), false, false); return __uint_as_float(r[0]) + __uint_as_float(r[1]); }
__device__ __forceinline__ float max16sw(float x) { auto r = __builtin_amdgcn_permlane16_swap(__float_as_uint(x), __float_as_uint(x), false, false); return fmaxf(__uint_as_float(r[0]), __uint_as_float(r[1])); }
__device__ __forceinline__ float max32sw(float x) { auto r = __builtin_amdgcn_permlane32_swap(__float_as_uint(x), __float_as_uint(x), false, false); return fmaxf(__uint_as_float(r[0]), __uint_as_float(r[1])); }
__device__ __forceinline__ float wave_sum(float v) {
  v += xor1(v); v += xor2(v); v += hmir(v); v += xor8(v); v = sum16sw(v); v = sum32sw(v);
  return v;
}
__device__ __forceinline__ float silu_f(float v) { return v / (1.f + __expf(-v)); }
__device__ __forceinline__ float silu_fast(float v) { return v * __builtin_amdgcn_rcpf(1.f + __builtin_amdgcn_exp2f(-1.4426950408889634f * v)); }
__device__ __forceinline__ unsigned cvtpk_e(float lo, float hi) { unsigned r; asm volatile("v_cvt_pk_bf16_f32 %0, %1, %2" : "=v"(r) : "v"(lo), "v"(hi)); return r; }
__device__ __forceinline__ int row_mi(int r) { const int b = r / TT, t = r - b * TT; return t < LC ? 4 : b; }

__device__ __forceinline__ int opaque_tid() { int t = __builtin_amdgcn_workitem_id_x(); asm volatile("" : "+v"(t)); return t; }
#define TIDX opaque_tid()
#define WSP(T, off) ((T*)(p.ws + (off)))

__device__ __forceinline__ void ph_mod(const Prm& p, int l, unsigned char* lds, int bid, int nb) {
  float* sc = (float*)lds;
  float* red = sc + 5 * 1024;
  const int tid = TIDX;
  for (int i = tid; i < 5 * 1024; i += NTHR) { const int mi = i >> 10, d = i & 1023; const float v = mi < 4 ? p.c[mi * 1024 + d] : p.c_ctx[d]; sc[i] = silu_f(v); }
  __syncthreads();
  float* MOD = WSP(float, OFF_MOD);
  const int cl = tid & 31, kg = tid >> 5;
  for (int it = bid; it < 192; it += nb) {
    const int e0 = it * 32;
    const float* w = p.w_mod + (size_t)l * 1024 * 6144 + e0 + cl;
    float a0 = 0, a1 = 0, a2 = 0, a3 = 0, a4 = 0;
#pragma unroll
    for (int k0 = 0; k0 < 64; k0 += 16) { float wv[16];
#pragma unroll
      for (int j = 0; j < 16; ++j) wv[j] = w[(size_t)(kg * 64 + k0 + j) * 6144];
#pragma unroll
      for (int j = 0; j < 16; ++j) { const int d = kg * 64 + k0 + j;
        a0 += sc[d] * wv[j]; a1 += sc[1024 + d] * wv[j]; a2 += sc[2048 + d] * wv[j]; a3 += sc[3072 + d] * wv[j]; a4 += sc[4096 + d] * wv[j]; } }
    float* rr = red + (kg * 32 + cl) * 5; rr[0] = a0; rr[1] = a1; rr[2] = a2; rr[3] = a3; rr[4] = a4;
    __syncthreads();
    if (tid < 160) { const int c2 = tid & 31, mi = tid >> 5; float s = 0; for (int g = 0; g < 16; ++g) s += red[(g * 32 + c2) * 5 + mi];
      MOD[(size_t)(l * 5 + mi) * 6144 + e0 + c2] = s + p.b_mod[l * 6144 + e0 + c2]; }
    __syncthreads();
  }
}

template <class Src>
__device__ __forceinline__ void tr_tile(const Src& src, bf16_t* dst, int K, int k0, int n0, float* tl  ) {
  const int tid = TIDX;
#pragma unroll
  for (int i = 0; i < 8; ++i) { const int e = tid + i * NTHR, kk = e >> 6, nn = e & 63; tl[kk * 65 + nn] = src(k0 + kk, n0 + nn); }
  __syncthreads();
#pragma unroll
  for (int i = 0; i < 2; ++i) { const int e = tid + i * NTHR, nn = e >> 4, kc = (e & 15) * 4;
    u32x2 o; o.x = pk2(tl[(kc + 0) * 65 + nn], tl[(kc + 1) * 65 + nn]); o.y = pk2(tl[(kc + 2) * 65 + nn], tl[(kc + 3) * 65 + nn]);
    *(u32x2*)(dst + (size_t)(n0 + nn) * K + k0 + kc) = o; }
  __syncthreads();
}
struct SrcIn { const float* w; __device__ float operator()(int k, int n) const { return n < NIN ? w[(size_t)k * NIN + n] : 0.f; } };
struct SrcScaled { const float* w; const float* nv; int N; __device__ float operator()(int k, int n) const { return w[(size_t)k * N + n] * nv[k]; } };
struct SrcPlain { const float* w; int N; __device__ float operator()(int k, int n) const { return w[(size_t)k * N + n]; } };
#if FAST_GEMM
struct SrcGU { const float* g; const float* u; __device__ float operator()(int k, int n) const { const int t = n >> 8, w = n & 255; return w < 128 ? g[(size_t)k * DFF + t * 128 + w] : u[(size_t)k * DFF + t * 128 + w - 128]; } };
#else
struct SrcGU { const float* g; const float* u; __device__ float operator()(int k, int n) const { const int t = n >> 6, w = n & 63; return w < 32 ? g[(size_t)k * DFF + t * 32 + w] : u[(size_t)k * DFF + t * 32 + w - 32]; } };
#endif

constexpr int WCB = 4;
struct WcItem { const float* sp; int ss; bf16_t* dp; int dK; const float* nv; int ncol; };
template <class F>
__device__ __forceinline__ void wconv_run(const F& item, int NIT, unsigned char* lds, int rank, int nranks) {
  float* tl = (float*)lds;
  const int tid = TIDX;
  for (int base = rank; base < NIT; base += nranks * WCB) {
    f32x4 rg[WCB][2]; float sc[WCB][2];
#pragma unroll
    for (int d = 0; d < WCB; ++d) { const int it = base + d * nranks;
      if (it < NIT) { const WcItem w = item(it);
#pragma unroll
        for (int i = 0; i < 2; ++i) { const int e = tid + i * NTHR, kk = e >> 4, n4 = (e & 15) * 4;
          rg[d][i] = n4 < w.ncol ? __builtin_nontemporal_load((const f32x4*)(w.sp + (size_t)kk * w.ss + n4)) : (f32x4){0.f, 0.f, 0.f, 0.f};
          sc[d][i] = w.nv ? w.nv[kk] : 1.f; } } }
#pragma unroll
    for (int d = 0; d < WCB; ++d) { const int it = base + d * nranks;
      if (it < NIT) { const WcItem w = item(it); float* t = tl + (d & 1) * (64 * 65);
#pragma unroll
        for (int i = 0; i < 2; ++i) { const int e = tid + i * NTHR, kk = e >> 4, n4 = (e & 15) * 4;
#pragma unroll
          for (int j = 0; j < 4; ++j) t[kk * 65 + n4 + j] = rg[d][i][j] * sc[d][i]; }
        __syncthreads();
#pragma unroll
        for (int i = 0; i < 2; ++i) { const int e = tid + i * NTHR, nn = e >> 4, kc = (e & 15) * 4;
          u32x2 o; o.x = pk2(t[(kc + 0) * 65 + nn], t[(kc + 1) * 65 + nn]); o.y = pk2(t[(kc + 2) * 65 + nn], t[(kc + 3) * 65 + nn]);
          *(u32x2*)(w.dp + (size_t)nn * w.dK + kc) = o; } } }
  }
  __syncthreads();
}
__device__ __forceinline__ void ph_wconv_dense(const Prm& p, int l, unsigned char* lds, int bid, int nb) {
  constexpr int T_IN = (DM / 64) * (NINP / 64), T_Q = (QRK / 64) * (NQB / 64), T_KV = (KVRK / 64) * (NKVB / 64), T_O = (DM / 64) * (DM / 64), T_L = T_IN + T_Q + T_KV + T_O;
  wconv_run([&p, l](int it) __attribute__((always_inline)) -> WcItem { int r = it; WcItem w;
    bf16_t* wb = (bf16_t*)(p.ws + OFF_W + (size_t)l * SZ_WL);
    if (r < T_IN) { const int kt = r / (NINP / 64), nt = r % (NINP / 64), n0 = nt * 64;
      w.sp = p.w_in + (size_t)l * DM * NIN + (size_t)(kt * 64) * NIN + n0; w.ss = NIN; w.dp = wb + (size_t)n0 * DM + kt * 64; w.dK = DM; w.nv = nullptr; w.ncol = NIN - n0; return w; } r -= T_IN;
    if (r < T_Q) { const int kt = r / (NQB / 64), nt = r % (NQB / 64);
      w.sp = p.w_q_up + (size_t)l * QRK * NQB + (size_t)(kt * 64) * NQB + nt * 64; w.ss = NQB; w.dp = (bf16_t*)((unsigned char*)wb + SZ_WIN) + (size_t)(nt * 64) * QRK + kt * 64; w.dK = QRK;
      w.nv = p.q_norm + l * QRK + kt * 64; w.ncol = 64; return w; } r -= T_Q;
    if (r < T_KV) { const int kt = r / (NKVB / 64), nt = r % (NKVB / 64);
      w.sp = p.w_kv_up + (size_t)l * KVRK * NKVB + (size_t)(kt * 64) * NKVB + nt * 64; w.ss = NKVB; w.dp = (bf16_t*)((unsigned char*)wb + SZ_WIN + SZ_WQ) + (size_t)(nt * 64) * KVRK + kt * 64; w.dK = KVRK;
      w.nv = p.kv_norm + l * KVRK + kt * 64; w.ncol = 64; return w; } r -= T_KV;
    { const int kt = r / (DM / 64), nt = r % (DM / 64);
      w.sp = p.w_out + (size_t)l * DM * DM + (size_t)(kt * 64) * DM + nt * 64; w.ss = DM; w.dp = (bf16_t*)((unsigned char*)wb + SZ_WIN + SZ_WQ + SZ_WKV) + (size_t)(nt * 64) * DM + kt * 64; w.dK = DM;
      w.nv = nullptr; w.ncol = 64; return w; } }, T_L, lds, bid, nb);
}
__device__ __forceinline__ void ph_wconv_moe(const Prm& p, int l, unsigned char* lds, int rank, int nranks) {
  constexpr int T_GU = (DM / 64) * (1024 / 64), T_D = (DFF / 64) * (DM / 64), T_E = T_GU + T_D;
  wconv_run([&p, l](int it) __attribute__((always_inline)) -> WcItem { const int e = it / T_E; int r = it % T_E; WcItem w; w.nv = nullptr; w.ncol = 64;
    if (r < T_GU) { const int kt = r >> 4, nt = r & 15, n0 = nt * 64, t = n0 >> 8, wq = n0 & 255;
      const float* src = (wq < 128 ? p.w_gate : p.w_up) + ((size_t)l * NE + e) * DM * DFF;
      w.sp = src + (size_t)(kt * 64) * DFF + t * 128 + (wq & 127); w.ss = DFF; w.dp = WSP(bf16_t, OFF_WGU) + (size_t)e * 1024 * 1024 + (size_t)n0 * DM + kt * 64; w.dK = DM; }
    else { r -= T_GU; const int kt = r >> 4, nt = r & 15;
      w.sp = p.w_down + ((size_t)l * NE + e) * DFF * DM + (size_t)(kt * 64) * DM + nt * 64; w.ss = DM; w.dp = WSP(bf16_t, OFF_WD) + (size_t)e * 1024 * 512 + (size_t)(nt * 64) * DFF + kt * 64; w.dK = DFF; }
    return w; }, NE * T_E, lds, rank, nranks);
}

typedef int i32x4 __attribute__((ext_vector_type(4)));
__device__ __forceinline__ void y_acc(f32x4 (&s)[4], const u32x2 (&y)[4]) {
#pragma unroll
  for (int j = 0; j < 4; ++j) { s[j][0] += __uint_as_float(y[j].x << 16); s[j][1] += __uint_as_float(y[j].x & 0xffff0000u); s[j][2] += __uint_as_float(y[j].y << 16); s[j][3] += __uint_as_float(y[j].y & 0xffff0000u); }
}
struct RowLd { f32x4 x[4]; i32x4 q[4]; };
__device__ __forceinline__ void row_issue(const Prm& p, int l, int r, int lane, RowLd& R) {
  const int b = r / TT, t = r - b * TT;
  if (l == 0) { const float* src = t < LC ? p.ctx + ((size_t)b * LC + t) * DM : p.x + ((size_t)b * SEQ + (t - LC)) * DM;
#pragma unroll
    for (int j = 0; j < 4; ++j) R.x[j] = *(const f32x4*)(src + 4 * lane + 256 * j);
  } else { int zv = 0; asm volatile("" : "+v"(zv));
    const float* X = WSP(float, OFF_X) + (size_t)r * DM; const i32x4* inv = (const i32x4*)(WSP(int, OFF_INV) + (size_t)r * 16 + zv);
#pragma unroll
    for (int j = 0; j < 4; ++j) { R.x[j] = *(const f32x4*)(X + 4 * lane + 256 * j); R.q[j] = inv[j]; } }
}
__device__ __forceinline__ void row_finish(const Prm& p, int l, int r, int lane, RowLd& R, f32x4 (&v)[4]) {
  if (l == 0) {
#pragma unroll
    for (int j = 0; j < 4; ++j) v[j] = R.x[j];
    return; }
  const int b = r / TT, t = r - b * TT;
  const float* gf = WSP(float, OFF_MOD) + (size_t)((l - 1) * 5 + (t < LC ? 4 : b)) * 6144 + 5 * 1024;
  f32x4 gv[4];
#pragma unroll
  for (int j = 0; j < 4; ++j) gv[j] = *(const f32x4*)(gf + 4 * lane + 256 * j);
  const bf16_t* Y = (const bf16_t*)(p.ws + OFF_R + R_Y) + 4 * lane;
  int c0 = 0, c1 = 0, c2 = 0, c3 = 0, cnt = 0;
#pragma unroll
  for (int e = 0; e < 16; ++e) { const int sv = __builtin_amdgcn_readfirstlane(R.q[e >> 2][e & 3]);
    if (sv >= 0) { c0 = cnt == 0 ? sv : c0; c1 = cnt == 1 ? sv : c1; c2 = cnt == 2 ? sv : c2; c3 = cnt == 3 ? sv : c3; ++cnt; } }
  u32x2 y0[4], y1[4], y2[4], y3[4];
#pragma unroll
  for (int j = 0; j < 4; ++j) { y0[j] = (u32x2){0u, 0u}; y1[j] = y0[j]; y2[j] = y0[j]; y3[j] = y0[j]; }
  if (cnt > 0) {
#pragma unroll
    for (int j = 0; j < 4; ++j) y0[j] = *(const u32x2*)(Y + (size_t)c0 * DM + 256 * j); }
  if (cnt > 1) {
#pragma unroll
    for (int j = 0; j < 4; ++j) y1[j] = *(const u32x2*)(Y + (size_t)c1 * DM + 256 * j); }
  if (cnt > 2) {
#pragma unroll
    for (int j = 0; j < 4; ++j) y2[j] = *(const u32x2*)(Y + (size_t)c2 * DM + 256 * j); }
  if (cnt > 3) {
#pragma unroll
    for (int j = 0; j < 4; ++j) y3[j] = *(const u32x2*)(Y + (size_t)c3 * DM + 256 * j); }
  f32x4 s[4];
#pragma unroll
  for (int j = 0; j < 4; ++j) s[j] = (f32x4){0.f, 0.f, 0.f, 0.f};
  y_acc(s, y0); y_acc(s, y1); y_acc(s, y2); y_acc(s, y3);
  if (cnt > 4) { int k = 0;
#pragma unroll
    for (int e = 0; e < 16; ++e) { const int sv = __builtin_amdgcn_readfirstlane(R.q[e >> 2][e & 3]);
      if (sv >= 0) { if (k >= 4) { u32x2 yy[4];
#pragma unroll
          for (int j = 0; j < 4; ++j) yy[j] = *(const u32x2*)(Y + (size_t)sv * DM + 256 * j);
          y_acc(s, yy); }
        ++k; } } }
#pragma unroll
  for (int j = 0; j < 4; ++j) v[j] = R.x[j] + gv[j] * s[j];
}
__device__ __forceinline__ float row_ssq(const f32x4 (&v)[4]) { float ss = 0.f;
#pragma unroll
  for (int j = 0; j < 4; ++j) ss += v[j][0] * v[j][0] + v[j][1] * v[j][1] + v[j][2] * v[j][2] + v[j][3] * v[j][3];
  return wave_sum(ss); }
__device__ __forceinline__ void norm_a_store(const Prm& p, int l, int r, int lane, const f32x4 (&v)[4]) {
  const float* md = WSP(float, OFF_MOD) + (size_t)(l * 5 + row_mi(r)) * 6144;
  f32x4 nwv[4], shv[4], sclv[4];
#pragma unroll
  for (int j = 0; j < 4; ++j) { const int c = 4 * lane + 256 * j; nwv[j] = *(const f32x4*)(p.norm_attn + l * DM + c); shv[j] = *(const f32x4*)(md + c); sclv[j] = *(const f32x4*)(md + 1024 + c); }
  const float rs = rsqrtf(row_ssq(v) * (1.f / DM) + EPS);
  float* X = WSP(float, OFF_X) + (size_t)r * DM; bf16_t* H = (bf16_t*)(p.ws + OFF_R + R_H) + (size_t)r * DM;
  if (lane == 0) { WSP(float, OFF_SSQQ)[r] = 0.f; WSP(float, OFF_SSQK)[r] = 0.f; }
#pragma unroll
  for (int j = 0; j < 4; ++j) { const int c = 4 * lane + 256 * j;
    *(f32x4*)(X + c) = v[j];
    const f32x4 nw = nwv[j], sh = shv[j], scl = sclv[j];
    const f32x4 h = v[j] * rs * nw * (scl + 1.f) + sh;
    u32x2 o; o.x = pk2(h[0], h[1]); o.y = pk2(h[2], h[3]); *(u32x2*)(H + c) = o; }
}
constexpr int RPI = 4, RPA = 2;
#define ROWPIPE(R0, R1, ROWOF, LAYER, STORE) do { \
    RowLd A0, A1, B0, B1; f32x4 va[4], vb[4]; \
    int r = (R0); \
    if (r < (R1)) row_issue(p, LAYER, ROWOF(r), lane, A0); if (r + 1 < (R1)) row_issue(p, LAYER, ROWOF(r + 1), lane, A1); \
    for (; r < (R1); r += 4) { \
      if (r + 2 < (R1)) row_issue(p, LAYER, ROWOF(r + 2), lane, B0); if (r + 3 < (R1)) row_issue(p, LAYER, ROWOF(r + 3), lane, B1); \
      row_finish(p, LAYER, ROWOF(r), lane, A0, va); if (r + 1 < (R1)) row_finish(p, LAYER, ROWOF(r + 1), lane, A1, vb); \
      STORE(r, va); if (r + 1 < (R1)) STORE(r + 1, vb); \
      if (r + 2 >= (R1)) break; \
      if (r + 4 < (R1)) row_issue(p, LAYER, ROWOF(r + 4), lane, A0); if (r + 5 < (R1)) row_issue(p, LAYER, ROWOF(r + 5), lane, A1); \
      row_finish(p, LAYER, ROWOF(r + 2), lane, B0, va); if (r + 3 < (R1)) row_finish(p, LAYER, ROWOF(r + 3), lane, B1, vb); \
      STORE(r + 2, va); if (r + 3 < (R1)) STORE(r + 3, vb); \
    } } while (0)
__device__ __forceinline__ void ph_norm_a(const Prm& p, int l, int bid, int nb) {
  const int lane = TIDX & 63, wv = __builtin_amdgcn_readfirstlane(TIDX >> 6);
  const int nw = nb * NWAVE, rpw = (MR + nw - 1) / nw, gw = bid * NWAVE + wv;
  const int r0 = gw * rpw, r1 = min(MR, r0 + rpw);
#define ROWID(x) (x)
#define NA_STORE(x, v) norm_a_store(p, l, (x), lane, v)
  ROWPIPE(r0, r1, ROWID, l, NA_STORE);
#undef ROWID
#undef NA_STORE
}
__device__ __forceinline__ void final_store(const Prm& p, int q, int lane, const f32x4 (&v)[4]) {
  f32x4 nfv[4];
#pragma unroll
  for (int j = 0; j < 4; ++j) nfv[j] = *(const f32x4*)(p.norm_final + 4 * lane + 256 * j);
  const float rs = rsqrtf(row_ssq(v) * (1.f / DM) + EPS); float* o = p.out + (size_t)q * DM;
#pragma unroll
  for (int j = 0; j < 4; ++j) { const int c = 4 * lane + 256 * j; *(f32x4*)(o + c) = v[j] * rs * nfv[j]; }
}
__device__ __forceinline__ void ph_final(const Prm& p, int bid, int nb) {
  const int lane = TIDX & 63, wv = __builtin_amdgcn_readfirstlane(TIDX >> 6);
  const int nw = nb * NWAVE, NQ = NB * SEQ, rpw = (NQ + nw - 1) / nw, gw = bid * NWAVE + wv;
  const int q0 = gw * rpw, q1 = min(NQ, q0 + rpw);
#define ROWQ(x) (((x) / SEQ) * TT + LC + ((x) % SEQ))
#define FIN_STORE(x, v) final_store(p, (x), lane, v)
  ROWPIPE(q0, q1, ROWQ, DEPTH, FIN_STORE);
#undef ROWQ
#undef FIN_STORE
}
template <bool ROUTER>
__device__ __forceinline__ void norm_b_row(const Prm& p, int l, int r, int lane, const f32x4 (&v)[4], const float* wl) {
  const int b = r / TT, t = r - b * TT;
  const float* md = WSP(float, OFF_MOD) + (size_t)(l * 5 + (t < LC ? 4 : b)) * 6144;
  f32x4 nwv[4], shv[4], sclv[4];
#pragma unroll
  for (int j = 0; j < 4; ++j) { const int c = 4 * lane + 256 * j; nwv[j] = *(const f32x4*)(p.norm_ffn + l * DM + c); shv[j] = *(const f32x4*)(md + 3 * 1024 + c); sclv[j] = *(const f32x4*)(md + 4 * 1024 + c); }
  const float rs = rsqrtf(row_ssq(v) * (1.f / DM) + EPS);
  bf16_t* H = (bf16_t*)(p.ws + OFF_R + R_H) + (size_t)r * DM;
  float lg[NE];
#pragma unroll
  for (int e = 0; e < NE; ++e) lg[e] = 0.f;
#pragma unroll
  for (int j = 0; j < 4; ++j) { const int c = 4 * lane + 256 * j;
    const f32x4 nw = nwv[j], sh = shv[j], scl = sclv[j];
    const f32x4 h = v[j] * rs * nw * (scl + 1.f) + sh;
    u32x2 o; o.x = pk2(h[0], h[1]); o.y = pk2(h[2], h[3]); *(u32x2*)(H + c) = o;
    if (ROUTER)
#pragma unroll
    for (int ip = 0; ip < 2; ++ip) {
      f32x4 w8[2][4];
#pragma unroll
      for (int i2 = 0; i2 < 2; ++i2)
#pragma unroll
        for (int e4 = 0; e4 < 4; ++e4) w8[i2][e4] = *(const f32x4*)(wl + ((((j * 4 + ip * 2 + i2) * 4 + e4) * 64 + lane) << 2));
      __builtin_amdgcn_sched_barrier(0);
#pragma unroll
      for (int i2 = 0; i2 < 2; ++i2)
#pragma unroll
        for (int e4 = 0; e4 < 4; ++e4) { const float hv = h[ip * 2 + i2]; const f32x4 w4 = w8[i2][e4];
          lg[4 * e4] += hv * w4[0]; lg[4 * e4 + 1] += hv * w4[1]; lg[4 * e4 + 2] += hv * w4[2]; lg[4 * e4 + 3] += hv * w4[3]; }
      __builtin_amdgcn_sched_barrier(0);
    } }
  if (!ROUTER) return;
#pragma unroll
  for (int e = 0; e < NE; ++e) { lg[e] += xor1(lg[e]); lg[e] += xor2(lg[e]); }
  float t8[8], t4[4], t2[2], t1;
#pragma unroll
  for (int i = 0; i < 8; ++i) { auto rr = __builtin_amdgcn_permlane32_swap(__float_as_uint(lg[i]), __float_as_uint(lg[i + 8]), false, false); t8[i] = __uint_as_float(rr[0]) + __uint_as_float(rr[1]); }
#pragma unroll
  for (int i = 0; i < 4; ++i) { auto rr = __builtin_amdgcn_permlane16_swap(__float_as_uint(t8[i]), __float_as_uint(t8[i + 4]), false, false); t4[i] = __uint_as_float(rr[0]) + __uint_as_float(rr[1]); }
  { const bool hb = lane & 8;
#pragma unroll
    for (int i = 0; i < 2; ++i) { const float snd = hb ? t4[i] : t4[i + 2], kp = hb ? t4[i + 2] : t4[i]; t2[i] = kp + xor8(snd); } }
  { const bool hb = lane & 4; const float snd = hb ? t2[0] : t2[1], kp = hb ? t2[1] : t2[0]; t1 = kp + hmir(snd); }
  float mx = t1;
  mx = fmaxf(mx, hmir(mx)); mx = fmaxf(mx, xor8(mx)); mx = max16sw(mx); mx = max32sw(mx);
  const float ex = __expf(t1 - mx); float sm = ex;
  sm += hmir(sm); sm += xor8(sm); sm = sum16sw(sm); sm = sum32sw(sm);
  if ((lane & 3) == 0) WSP(float, OFF_AFF)[(size_t)r * NE + (lane >> 2)] = ex / sm;
}
template <bool ROUTER>
__device__ __forceinline__ void ph_norm_b(const Prm& p, int l, unsigned char* lds, int bid, int nb) {
  const int tid = TIDX, lane = tid & 63, wv = __builtin_amdgcn_readfirstlane(tid >> 6);
  float* wl = (float*)lds;
  { const float* wr = p.w_router + (size_t)l * DM * NE;
    float rv[DM * NE / NTHR];
#pragma unroll
    for (int q = 0; q < DM * NE / NTHR; ++q) rv[q] = wr[tid + q * NTHR];
#pragma unroll
    for (int q = 0; q < DM * NE / NTHR; ++q) { const int idx = tid + q * NTHR; const int d = idx >> 4, e = idx & 15, j = d >> 8, ln = (d >> 2) & 63, i = d & 3;
      wl[((((j * 4 + i) * 4 + (e >> 2)) * 64 + ln) << 2) + (e & 3)] = rv[q]; } }
  __syncthreads();
  const int nw = nb * NWAVE, rpw = (MR + nw - 1) / nw, gw = bid * NWAVE + wv;
  const int r0 = gw * rpw, r1 = min(MR, r0 + rpw);
  for (int r = r0; r < r1; r += RPI) {
    f32x4 v[RPI][4]; u32x2 mg[RPI][4]; bool sk[RPI];
#pragma unroll
    for (int i = 0; i < RPI; ++i) { sk[i] = (r + i >= r1) || ((l == DEPTH - 1) && ((r + i) % TT) < LC);
      if (!sk[i]) { const float* X = WSP(float, OFF_X) + (size_t)(r + i) * DM; const bf16_t* MG = (const bf16_t*)(p.ws + OFF_R + R_MIXG) + (size_t)(r + i) * DM;
#pragma unroll
        for (int j = 0; j < 4; ++j) { v[i][j] = *(const f32x4*)(X + 4 * lane + 256 * j); mg[i][j] = *(const u32x2*)(MG + 4 * lane + 256 * j); } } }
#pragma unroll
    for (int i = 0; i < RPI; ++i) if (!sk[i]) {
      float* X = WSP(float, OFF_X) + (size_t)(r + i) * DM;
#pragma unroll
      for (int j = 0; j < 4; ++j) { v[i][j][0] += __uint_as_float(mg[i][j].x << 16); v[i][j][1] += __uint_as_float(mg[i][j].x & 0xffff0000u); v[i][j][2] += __uint_as_float(mg[i][j].y << 16); v[i][j][3] += __uint_as_float(mg[i][j].y & 0xffff0000u);
        *(f32x4*)(X + 4 * lane + 256 * j) = v[i][j]; }
      norm_b_row<ROUTER>(p, l, r + i, lane, v[i], wl); }
  }
  __syncthreads();
}

__device__ __forceinline__ void ph_topk(const Prm& p, int l, unsigned char* lds, int bid, int nb) {
  unsigned* keys = (unsigned*)lds;
  unsigned* hist = keys + 8192;
  unsigned* scan = hist + 8 * 256;
  unsigned* misc = scan + 512;
  const int tid = TIDX;
  const float* AFF = WSP(float, OFF_AFF);
  int* IDX = WSP(int, OFF_IDX); float* VAL = WSP(float, OFF_VAL); int* INV = WSP(int, OFF_INV);
  const int ngroups = (l == DEPTH - 1) ? 64 : 128;
  for (int g = bid; g < ngroups; g += nb) {
    const bool isctx = g >= 64; const int b = (g & 63) >> 4, e = g & 15;
    const int n = isctx ? LC : SEQ, cap = isctx ? CAPC : CAPL, r0 = b * TT + (isctx ? 0 : LC);
    const int sbase = isctx ? (NB * NE * CAPL + e * 256 + b * 32) : ((b * NE + e) * CAPL);
    for (int i = tid; i < n; i += NTHR) keys[i] = __float_as_uint(AFF[(size_t)(r0 + i) * NE + e]);
    if (tid == 0) misc[2] = 0;
    __syncthreads();
    unsigned prefix = 0, kk = cap;
    for (int pass = 3; pass >= 0; --pass) {
      for (int i = tid; i < 8 * 256; i += NTHR) hist[i] = 0;
      __syncthreads();
      const int sh = pass * 8; const unsigned hm = pass == 3 ? 0u : (0xffffffffu << (sh + 8));
      unsigned* myh = hist + (tid >> 6) * 256;
      for (int i = tid; i < n; i += NTHR) { const unsigned k = keys[i]; if ((k & hm) == (prefix & hm)) atomicAdd(&myh[(k >> sh) & 255u], 1u); }
      __syncthreads();
      if (tid < 256) { unsigned t_ = 0;
#pragma unroll
        for (int w = 0; w < 8; ++w) t_ += hist[w * 256 + tid];
        hist[tid] = t_; }
      __syncthreads();
      if (tid < 256) { unsigned cum = 0; for (int bk = tid + 1; bk < 256; ++bk) cum += hist[bk];
        const unsigned mine = hist[tid]; if (cum < kk && kk <= cum + mine) { misc[0] = (unsigned)tid; misc[1] = kk - cum; } }
      __syncthreads();
      prefix |= misc[0] << sh; kk = misc[1];
      __syncthreads();
    }
    const int chunk = (n + NTHR - 1) / NTHR; const int i0 = tid * chunk, i1 = min(n, i0 + chunk);
    unsigned eq = 0; for (int i = i0; i < i1; ++i) eq += (keys[i] == prefix) ? 1u : 0u;
    scan[tid] = eq; __syncthreads();
    for (int o = 1; o < NTHR; o <<= 1) { const unsigned a = tid >= o ? scan[tid - o] : 0u; __syncthreads(); scan[tid] += a; __syncthreads(); }
    unsigned erank = scan[tid] - eq;
    const unsigned ngt = cap - kk;
    for (int i = i0; i < i1; ++i) { const unsigned k = keys[i]; int slot = -1;
      if (k > prefix) slot = (int)atomicAdd(&misc[2], 1u);
      else if (k == prefix) { if (erank < kk) slot = (int)(ngt + erank); ++erank; }
      const int row = r0 + i;
      if (slot >= 0) { IDX[sbase + slot] = row; VAL[sbase + slot] = __uint_as_float(k); INV[(size_t)row * NE + e] = sbase + slot; }
      else INV[(size_t)row * NE + e] = -1; }
    if (isctx && tid < 32) { IDX[NB * NE * CAPL + e * 256 + 128 + b * 32 + tid] = 0; VAL[NB * NE * CAPL + e * 256 + 128 + b * 32 + tid] = 0.f; }
    __syncthreads();
  }
}

template <int NF, class AP, class Epi>
__device__ __forceinline__ void sgemm_wave(const AP& ap, const bf16_t* __restrict__ Bt, int K, int m0, int n0, const Epi& epi) {
  const int lane = TIDX & 63, fr = lane & 15, fq = lane >> 4;
  f32x4 acc[4][NF];
#pragma unroll
  for (int i = 0; i < 4; ++i)
#pragma unroll
    for (int j = 0; j < NF; ++j) acc[i][j] = (f32x4){0.f, 0.f, 0.f, 0.f};
  const bf16_t* a_[4]; const bf16_t* b_[NF];
#pragma unroll
  for (int i = 0; i < 4; ++i) a_[i] = ap.row(m0 + 16 * i + fr) + fq * 8;
#pragma unroll
  for (int j = 0; j < NF; ++j) b_[j] = Bt + (size_t)(n0 + 16 * j + fr) * K + fq * 8;
#pragma unroll 2
  for (int k0 = 0; k0 < K; k0 += 32) {
    bf16x8 av[4], bv[NF];
#pragma unroll
    for (int i = 0; i < 4; ++i) av[i] = *(const bf16x8*)(a_[i] + k0);
#pragma unroll
    for (int j = 0; j < NF; ++j) bv[j] = *(const bf16x8*)(b_[j] + k0);
#pragma unroll
    for (int i = 0; i < 4; ++i)
#pragma unroll
      for (int j = 0; j < NF; ++j) acc[i][j] = __builtin_amdgcn_mfma_f32_16x16x32_bf16(av[i], bv[j], acc[i][j], 0, 0, 0);
  }
  epi(acc, m0, n0, fr, fq);
}
struct APDense { const bf16_t* A; int lda; __device__ __forceinline__ const bf16_t* row(int r) const { return A + (size_t)r * lda; } };
struct APGather { const bf16_t* A; const int* idx; __device__ __forceinline__ const bf16_t* row(int r) const { return A + (size_t)idx[r] * DM; } };

__device__ __forceinline__ void rope_pos(int row, bool& lat, int& rp, int& cp) { const int b = row / TT, t = row - b * TT; lat = t >= LC; const int pos = t - LC; rp = pos >> 6; cp = pos & 63; }

struct EpiIn {
  const Prm* pp;
  __device__ __forceinline__ void operator()(f32x4 (&acc)[4][4], int m0, int n0, int fr, int fq) const {
    const Prm& p = *pp; const float* RT = WSP(float, OFF_ROPE);
    if (n0 >= 1472) return;
#pragma unroll
    for (int mf = 0; mf < 4; ++mf)
#pragma unroll
      for (int j = 0; j < 4; ++j) {
        const int row = m0 + 16 * mf + 4 * fq + j; bool lat; int rp, cp; rope_pos(row, lat, rp, cp);
        float v[4] = {acc[mf][0][j], acc[mf][1][j], acc[mf][2][j], acc[mf][3][j]};
        if (n0 < 640) {
          if (lat) { const float c0 = RT[rp * 16 + fr], s0 = RT[2048 + rp * 16 + fr], c1 = RT[cp * 16 + fr], s1 = RT[2048 + cp * 16 + fr];
            const float a = v[0] * c0 - v[1] * s0, bq = v[0] * s0 + v[1] * c0, cq = v[2] * c1 - v[3] * s1, dq = v[2] * s1 + v[3] * c1; v[0] = a; v[1] = bq; v[2] = cq; v[3] = dq; }
          if (n0 < 512) { bf16_t* o = (bf16_t*)(p.ws + OFF_R + R_QA) + (size_t)row * 512 + n0 + fr;
#pragma unroll
            for (int nf = 0; nf < 4; ++nf) o[16 * nf] = f2bf(v[nf] * SCALE_A); }
          else { bf16_t* o = (bf16_t*)(p.ws + OFF_R + R_KA) + (size_t)row * 128 + (n0 - 512) + fr;
#pragma unroll
            for (int nf = 0; nf < 4; ++nf) o[16 * nf] = f2bf(v[nf]); }
        } else if (n0 < 768) { bf16_t* o = (bf16_t*)(p.ws + OFF_R + R_VA) + (size_t)row * 128 + (n0 - 640) + fr;
#pragma unroll
          for (int nf = 0; nf < 4; ++nf) o[16 * nf] = f2bf(v[nf]);
        } else if (n0 < 1152) { bf16_t* o = (bf16_t*)(p.ws + OFF_R + R_CQ) + (size_t)row * QRK + (n0 - 768) + fr;
#pragma unroll
          for (int nf = 0; nf < 4; ++nf) o[16 * nf] = f2bf(v[nf]);
        } else if (n0 < 1408) { bf16_t* o = (bf16_t*)(p.ws + OFF_R + R_CKV) + (size_t)row * KVRK + (n0 - 1152) + fr;
#pragma unroll
          for (int nf = 0; nf < 4; ++nf) o[16 * nf] = f2bf(v[nf]);
        } else {
          const float pr0 = __shfl_xor(v[0], 8), pr1 = __shfl_xor(v[1], 8);
          if (lat) { const int f = fr & 7; const float c0 = RT[4096 + rp * 8 + f], s0 = RT[5120 + rp * 8 + f], c1 = RT[4096 + cp * 8 + f], s1 = RT[5120 + cp * 8 + f];
            v[0] = fr < 8 ? v[0] * c0 - pr0 * s0 : pr0 * s0 + v[0] * c0; v[1] = fr < 8 ? v[1] * c1 - pr1 * s1 : pr1 * s1 + v[1] * c1; }
          bf16_t* o = WSP(bf16_t, OFF_KR) + (size_t)row * 32 + fr; o[0] = f2bf(v[0]); o[16] = f2bf(v[1]);
        }
      }
  }
};
struct EpiQup {
  const Prm* pp;
  __device__ __forceinline__ void operator()(f32x4 (&acc)[4][6], int m0, int n0, int fr, int fq) const {
    const Prm& p = *pp; const float* RT = WSP(float, OFF_ROPE); const float* ssq = WSP(float, OFF_SSQQ);
#pragma unroll
    for (int mf = 0; mf < 4; ++mf)
#pragma unroll
      for (int j = 0; j < 4; ++j) {
        const int row = m0 + 16 * mf + 4 * fq + j; bool lat; int rp, cp; rope_pos(row, lat, rp, cp);
        const float rs = rsqrtf(ssq[row] * (1.f / QRK) + EPS) * SCALE_B;
        float v[6];
#pragma unroll
        for (int nf = 0; nf < 6; ++nf) v[nf] = acc[mf][nf][j] * rs;
        const float pr0 = __shfl_xor(v[4], 8), pr1 = __shfl_xor(v[5], 8);
        if (lat) { const int f = fr & 7; const float c0 = RT[4096 + rp * 8 + f], s0 = RT[5120 + rp * 8 + f], c1 = RT[4096 + cp * 8 + f], s1 = RT[5120 + cp * 8 + f];
          v[4] = fr < 8 ? v[4] * c0 - pr0 * s0 : pr0 * s0 + v[4] * c0; v[5] = fr < 8 ? v[5] * c1 - pr1 * s1 : pr1 * s1 + v[5] * c1; }
        bf16_t* o = (bf16_t*)(p.ws + OFF_R + R_QB) + (size_t)row * NQB + n0 + fr;
#pragma unroll
        for (int nf = 0; nf < 6; ++nf) o[16 * nf] = f2bf(v[nf]);
      }
  }
};
struct EpiKVup {
  const Prm* pp;
  __device__ __forceinline__ void operator()(f32x4 (&acc)[4][4], int m0, int n0, int fr, int fq) const {
    const Prm& p = *pp; const float* ssq = WSP(float, OFF_SSQK);
    const int hd = n0 >> 7, part = (n0 >> 6) & 1;
    bf16_t* base = (bf16_t*)(p.ws + OFF_R + (part ? R_VB : R_KB));
#pragma unroll
    for (int mf = 0; mf < 4; ++mf)
#pragma unroll
      for (int j = 0; j < 4; ++j) {
        const int row = m0 + 16 * mf + 4 * fq + j; const float rs = rsqrtf(ssq[row] * (1.f / KVRK) + EPS);
        bf16_t* o = base + (size_t)row * 512 + hd * 64 + fr;
#pragma unroll
        for (int nf = 0; nf < 4; ++nf) o[16 * nf] = f2bf(acc[mf][nf][j] * rs);
      }
  }
};
struct EpiOut {
  const Prm* pp; int l;
  __device__ __forceinline__ void operator()(f32x4 (&acc)[4][4], int m0, int n0, int fr, int fq) const {
    const Prm& p = *pp; const float* MOD = WSP(float, OFF_MOD);
#pragma unroll
    for (int mf = 0; mf < 4; ++mf)
#pragma unroll
      for (int j = 0; j < 4; ++j) {
        const int row = m0 + 16 * mf + 4 * fq + j; const float* ga = MOD + (size_t)(l * 5 + row_mi(row)) * 6144 + 2 * 1024 + n0 + fr;
        float* X = WSP(float, OFF_X) + (size_t)row * DM + n0 + fr;
#pragma unroll
        for (int nf = 0; nf < 4; ++nf) X[16 * nf] += ga[16 * nf] * acc[mf][nf][j];
      }
  }
};
struct EpiMoeUp {
  const Prm* pp;
  __device__ __forceinline__ void operator()(f32x4 (&acc)[4][4], int m0, int n0, int fr, int fq) const {
    const Prm& p = *pp; const int j0 = n0 >> 1;
#pragma unroll
    for (int mf = 0; mf < 4; ++mf)
#pragma unroll
      for (int j = 0; j < 4; ++j) {
        const int slot = m0 + 16 * mf + 4 * fq + j;
        bf16_t* o = (bf16_t*)(p.ws + OFF_R + R_ACT) + (size_t)slot * DFF + j0 + fr;
        o[0] = f2bf(silu_f(acc[mf][0][j]) * acc[mf][2][j]); o[16] = f2bf(silu_f(acc[mf][1][j]) * acc[mf][3][j]);
      }
  }
};
struct EpiMoeDown {
  const Prm* pp;
  __device__ __forceinline__ void operator()(f32x4 (&acc)[4][4], int m0, int n0, int fr, int fq) const {
    const Prm& p = *pp; const float* VAL = WSP(float, OFF_VAL);
#pragma unroll
    for (int mf = 0; mf < 4; ++mf)
#pragma unroll
      for (int j = 0; j < 4; ++j) {
        const int slot = m0 + 16 * mf + 4 * fq + j; const float vv = VAL[slot];
        bf16_t* o = (bf16_t*)(p.ws + OFF_R + R_Y) + (size_t)slot * DM + n0 + fr;
#pragma unroll
        for (int nf = 0; nf < 4; ++nf) o[16 * nf] = f2bf(acc[mf][nf][j] * vv);
      }
  }
};

__device__ __forceinline__ void ph_gemm_in(const Prm& p, int l, int bid, int nb) {
  const int wv = TIDX >> 6, wm = wv >> 1, wn = wv & 1;
  const bf16_t* Bt = (const bf16_t*)(p.ws + OFF_W + (size_t)l * SZ_WL);
  APDense ap{(const bf16_t*)(p.ws + OFF_R + R_H), DM}; EpiIn epi{&p};
  constexpr int NCT = NINP / 128;
  for (int it = bid; it < (MR / 256) * NCT; it += nb) { const int rt = it / NCT, ct = it % NCT;
    sgemm_wave<4>(ap, Bt, DM, rt * 256 + wm * 64, ct * 128 + wn * 64, epi); }
}
__device__ __forceinline__ void ph_ssq(const Prm& p, int bid, int nb) {
  const int lane = TIDX & 63, wv = TIDX >> 6;
  for (int r = bid * NWAVE + wv; r < MR; r += nb * NWAVE) {
    const bf16_t* cq = (const bf16_t*)(p.ws + OFF_R + R_CQ) + (size_t)r * QRK; const bf16_t* ck = (const bf16_t*)(p.ws + OFF_R + R_CKV) + (size_t)r * KVRK;
    float s = 0.f; for (int i = lane; i < QRK; i += 64) { const float v = bf2f(cq[i]); s += v * v; }
    float s2 = 0.f; for (int i = lane; i < KVRK; i += 64) { const float v = bf2f(ck[i]); s2 += v * v; }
    s = wave_sum(s); s2 = wave_sum(s2);
    if (lane == 0) { WSP(float, OFF_SSQQ)[r] = s; WSP(float, OFF_SSQK)[r] = s2; }
  }
}
__device__ __forceinline__ void ph_gemm_up(const Prm& p, int l, int bid, int nb) {
  const int wv = TIDX >> 6, wm = wv >> 1, wn = wv & 1;
  const bf16_t* WQ = (const bf16_t*)(p.ws + OFF_W + (size_t)l * SZ_WL + SZ_WIN);
  const bf16_t* WKV = (const bf16_t*)(p.ws + OFF_W + (size_t)l * SZ_WL + SZ_WIN + SZ_WQ);
  constexpr int IQ = (MR / 256) * 4, IKV = (MR / 256) * 8;
  for (int it = bid; it < IQ + IKV; it += nb) {
    if (it < IQ) { const int rt = it / 4, ct = it % 4; APDense ap{(const bf16_t*)(p.ws + OFF_R + R_CQ), QRK}; EpiQup epi{&p};
      sgemm_wave<6>(ap, WQ, QRK, rt * 256 + wm * 64, ct * 192 + wn * 96, epi); }
    else { const int i2 = it - IQ, rt = i2 / 8, ct = i2 % 8; APDense ap{(const bf16_t*)(p.ws + OFF_R + R_CKV), KVRK}; EpiKVup epi{&p};
      sgemm_wave<4>(ap, WKV, KVRK, rt * 256 + wm * 64, ct * 128 + wn * 64, epi); }
  }
}
__device__ __forceinline__ void ph_gemm_out(const Prm& p, int l, int bid, int nb) {
  const int wv = TIDX >> 6, wm = wv >> 1, wn = wv & 1;
  const bf16_t* Bt = (const bf16_t*)(p.ws + OFF_W + (size_t)l * SZ_WL + SZ_WIN + SZ_WQ + SZ_WKV);
  APDense ap{(const bf16_t*)(p.ws + OFF_R + R_H), DM}; EpiOut epi{&p, l};
  for (int it = bid; it < (MR / 256) * 8; it += nb) { const int rt = it / 8, ct = it % 8;
    sgemm_wave<4>(ap, Bt, DM, rt * 256 + wm * 64, ct * 128 + wn * 64, epi); }
}
__device__ __forceinline__ void ph_moe_up(const Prm& p, int l, int bid, int nb) {
  const int wv = TIDX >> 6, wm = wv >> 1, wn = wv & 1;
  const int nrt = (l == DEPTH - 1) ? 256 : 272;
  APGather ap{(const bf16_t*)(p.ws + OFF_R + R_H), WSP(int, OFF_IDX)}; EpiMoeUp epi{&p};
  for (int it = bid; it < nrt * 8; it += nb) { const int rt = it / 8, ct = it % 8; const int e = rt < 256 ? ((rt >> 2) & 15) : rt - 256;
    sgemm_wave<4>(ap, WSP(bf16_t, OFF_WGU) + (size_t)e * 1024 * 1024, DM, rt * 256 + wm * 64, ct * 128 + wn * 64, epi); }
}
__device__ __forceinline__ void ph_moe_down(const Prm& p, int l, int bid, int nb) {
  const int wv = TIDX >> 6, wm = wv >> 1, wn = wv & 1;
  const int nrt = (l == DEPTH - 1) ? 256 : 272;
  APDense ap{(const bf16_t*)(p.ws + OFF_R + R_ACT), DFF}; EpiMoeDown epi{&p};
  for (int it = bid; it < nrt * 8; it += nb) { const int rt = it / 8, ct = it % 8; const int e = rt < 256 ? ((rt >> 2) & 15) : rt - 256;
    sgemm_wave<4>(ap, WSP(bf16_t, OFF_WD) + (size_t)e * 1024 * 512, DFF, rt * 256 + wm * 64, ct * 128 + wn * 64, epi); }
}

namespace pg8 {
#define PG8_LAS __attribute__((address_space(3)))
constexpr int BM = 256, BK = 64, HALF = 128, HTB = HALF * BK * 2, STAGE_BYTES = 8 * HTB;
__device__ __forceinline__ int lds_byte(int r, int c) { const int st = (r >> 4) * 2 + (c >> 5), rr = r & 15, cc = c & 31, ob = rr * 64 + cc * 2; return st * 1024 + (ob ^ (((ob >> 9) & 1) << 5)); }
__device__ __forceinline__ void stage_rc(int b, int& R, int& C) { const int st = b / 1024, sb = b % 1024, swz = sb ^ (((sb >> 9) & 1) << 5); R = (st >> 1) * 16 + swz / 64; C = (st & 1) * 32 + (swz % 64) / 2; }
struct Unit { int pm, pn; size_t boff; int r0; };
struct Gemm { const bf16_t* A; const bf16_t* Bt; int K; const int* idx; };
template <bool GATHER, bool HALFM = false, class Epi, class Sched>
__device__ __forceinline__ void gemm_phase(PG8_LAS unsigned char* lds, const Gemm g, const Sched& S, const Epi& E) {
    const int tid = TIDX, wid = __builtin_amdgcn_readfirstlane(tid >> 6), lane = tid & 63, wr = wid >> 2, wc = wid & 3, fr = lane & 15, fq = lane >> 4;
    const int K = g.K, nt = K / BK;
    int RA[2], CA[2]; unsigned voffB[2], voffA[2];
#pragma unroll
    for (int i = 0; i < 2; ++i) { int R, C; stage_rc(tid * 16 + i * 8192, R, C); RA[i] = R; CA[i] = C; voffA[i] = (unsigned)(R * K + C) * 2u; voffB[i] = voffA[i]; }
    const size_t kstep = (size_t)(BK * 2);
    const size_t hstep = (size_t)HALF * K * 2;
    const size_t tstep = 2 * hstep;
    const unsigned ldsw = (unsigned)wid * 1024u;
    const int aoff = lds_byte(wr * 64 + fr, fq * 8), boff = lds_byte(wc * 32 + fr, fq * 8);
#define PG8_SA(b, h) (((b) * 2 + (h)) * HTB)
#define PG8_SB(b, h) ((4 + (b) * 2 + (h)) * HTB)
#define PG8_STAGE(bufoff, gbase, voff) do { _Pragma("unroll") for (int _i = 0; _i < 2; ++_i) \
        __builtin_amdgcn_global_load_lds((const unsigned*)((const char*)(gbase) + (voff)[_i]), (PG8_LAS unsigned*)(lds + (bufoff) + ldsw + _i * 8192), 16, 0, 0); } while (0)
#define PG8_LDA(dst, b, h) do { _Pragma("unroll") for (int m = 0; m < 4; ++m) _Pragma("unroll") for (int k = 0; k < 2; ++k) dst[m][k] = *(const PG8_LAS bf16x8*)(lds + PG8_SA(b, h) + aoff + m * 2048 + k * 1024); } while (0)
#define PG8_LDB(dst, b, h) do { _Pragma("unroll") for (int n = 0; n < 2; ++n) _Pragma("unroll") for (int k = 0; k < 2; ++k) dst[n][k] = *(const PG8_LAS bf16x8*)(lds + PG8_SB(b, h) + boff + n * 2048 + k * 1024); } while (0)
#define PG8_MMA(ai, bj, At, Bt) do { __builtin_amdgcn_s_setprio(1); _Pragma("unroll") for (int m = 0; m < 4; ++m) _Pragma("unroll") for (int n = 0; n < 2; ++n) _Pragma("unroll") for (int k = 0; k < 2; ++k) \
        acc[ai][bj][m][n] = __builtin_amdgcn_mfma_f32_16x16x32_bf16(Bt[n][k], At[m][k], acc[ai][bj][m][n], 0, 0, 0); __builtin_amdgcn_s_setprio(0); } while (0)
#define PG8_WAIT_V(n) asm volatile("s_waitcnt vmcnt(" #n ")" ::: "memory")
#define PG8_WAIT_L(n) asm volatile("s_waitcnt lgkmcnt(" #n ")" ::: "memory")
#define PG8_BAR __builtin_amdgcn_s_barrier()
#define PG8_SCHED __builtin_amdgcn_sched_barrier(0)
    Unit cur, nxt; int ui = 0;
    if (!S.next(0, cur)) return;
    f32x4 acc[2][2][4][2];
#pragma unroll
    for (int a = 0; a < 2; ++a)
#pragma unroll
        for (int b = 0; b < 2; ++b)
#pragma unroll
            for (int m = 0; m < 4; ++m)
#pragma unroll
                for (int n = 0; n < 2; ++n) acc[a][b][m][n] = (f32x4){0.f, 0.f, 0.f, 0.f};
    bf16x8 At[4][2], B0[2][2], B1[2][2];
    unsigned oc0[2], oc1[2], on0[2], on1[2];
    auto set_off = [&](const Unit& u, unsigned (&o0)[2], unsigned (&o1)[2]) {
        if constexpr (GATHER) {
#pragma unroll
            for (int i = 0; i < 2; ++i) { const int r0 = g.idx[u.r0 + RA[i]], r1 = g.idx[u.r0 + HALF + RA[i]]; o0[i] = (unsigned)(r0 * K + CA[i]) * 2u; o1[i] = (unsigned)(r1 * K + CA[i]) * 2u; }
        } else {
#pragma unroll
            for (int i = 0; i < 2; ++i) { o0[i] = voffA[i]; o1[i] = voffA[i] + (unsigned)hstep; }
        }
    };
    auto a_base = [&](const Unit& u) -> const char* { if constexpr (GATHER) return (const char*)g.A; else return (const char*)g.A + (size_t)u.r0 * (size_t)(K * 2); };
    const char* cA = a_base(cur); const char* cB = (const char*)g.Bt + cur.boff + (size_t)cur.pn * tstep;
    set_off(cur, oc0, oc1);
    PG8_STAGE(PG8_SB(0, 0), cB, voffB); PG8_STAGE(PG8_SB(0, 1), cB + hstep, voffB); PG8_STAGE(PG8_SA(0, 0), cA, oc0); PG8_STAGE(PG8_SA(0, 1), cA, oc1);
    if (wr == 1) PG8_BAR;
    PG8_WAIT_V(2); PG8_BAR;
    PG8_STAGE(PG8_SB(1, 0), cB + kstep, voffB); PG8_STAGE(PG8_SA(1, 0), cA + kstep, oc0); PG8_STAGE(PG8_SB(1, 1), cB + hstep + kstep, voffB);
    PG8_WAIT_V(6); PG8_BAR;
    for (;;) {
        const bool has_next = S.next(ui + 1, nxt);
        const char* nA = has_next ? a_base(nxt) : cA; const char* nB = has_next ? (const char*)g.Bt + nxt.boff + (size_t)nxt.pn * tstep : cB;
        if (has_next) set_off(nxt, on0, on1); else {
#pragma unroll
            for (int i = 0; i < 2; ++i) { on0[i] = oc0[i]; on1[i] = oc1[i]; } }
#pragma unroll 1
        for (int t = 0; t < nt; t += 2) {
            const bool last = (t == nt - 2);
            const char* a1 = cA + (size_t)(t + 1) * kstep;
            const char* a2 = last ? nA : cA + (size_t)(t + 2) * kstep; const char* b2 = last ? nB : cB + (size_t)(t + 2) * kstep;
            const char* a3 = a2 + kstep; const char* b3 = b2 + kstep;
            unsigned o20[2], o21[2];
#pragma unroll
            for (int i = 0; i < 2; ++i) { o20[i] = last ? on0[i] : oc0[i]; o21[i] = last ? on1[i] : oc1[i]; }
            PG8_LDB(B0, 0, 0); PG8_LDB(B1, 0, 1); PG8_SCHED; PG8_LDA(At, 0, 0); PG8_STAGE(PG8_SA(1, 1), a1, oc1);
            PG8_WAIT_V(8); PG8_WAIT_L(0); PG8_BAR; PG8_MMA(0, 0, At, B0); PG8_MMA(0, 1, At, B1); PG8_BAR; PG8_SCHED;
            if constexpr (!HALFM) { PG8_LDA(At, 0, 1); } PG8_STAGE(PG8_SB(0, 0), b2, voffB); PG8_STAGE(PG8_SB(0, 1), b2 + hstep, voffB); PG8_STAGE(PG8_SA(0, 0), a2, o20);
            PG8_WAIT_V(8); PG8_WAIT_L(0); PG8_BAR; if constexpr (!HALFM) { PG8_MMA(1, 0, At, B0); PG8_MMA(1, 1, At, B1); } PG8_BAR; PG8_SCHED;
            PG8_LDB(B0, 1, 0); PG8_LDB(B1, 1, 1); PG8_SCHED; PG8_LDA(At, 1, 0); PG8_STAGE(PG8_SA(0, 1), a2, o21);
            PG8_WAIT_V(8); PG8_WAIT_L(0); PG8_BAR; PG8_MMA(0, 0, At, B0); PG8_MMA(0, 1, At, B1); PG8_BAR; PG8_SCHED;
            if constexpr (!HALFM) { PG8_LDA(At, 1, 1); } PG8_STAGE(PG8_SB(1, 0), b3, voffB); PG8_STAGE(PG8_SB(1, 1), b3 + hstep, voffB); PG8_STAGE(PG8_SA(1, 0), a3, o20);
            PG8_WAIT_V(8); PG8_WAIT_L(0); PG8_BAR; if constexpr (!HALFM) { PG8_MMA(1, 0, At, B0); PG8_MMA(1, 1, At, B1); } PG8_BAR; PG8_SCHED;
        }
        if (wr == 0) PG8_BAR;
        E.template run<HALFM>(acc, cur, wr, wc, fr, fq, lds, tid);
        if (!has_next) break;
#pragma unroll
        for (int a = 0; a < 2; ++a)
#pragma unroll
            for (int b = 0; b < 2; ++b)
#pragma unroll
                for (int m = 0; m < 4; ++m)
#pragma unroll
                    for (int n = 0; n < 2; ++n) acc[a][b][m][n] = (f32x4){0.f, 0.f, 0.f, 0.f};
        cur = nxt; cA = nA; cB = nB; ++ui;
#pragma unroll
        for (int i = 0; i < 2; ++i) { oc0[i] = on0[i]; oc1[i] = on1[i]; }
        if (wr == 1) PG8_BAR;
    }
    PG8_WAIT_V(0);
    PG8_BAR;
#undef PG8_SA
#undef PG8_SB
#undef PG8_STAGE
#undef PG8_LDA
#undef PG8_LDB
#undef PG8_MMA
#undef PG8_WAIT_V
#undef PG8_WAIT_L
#undef PG8_BAR
#undef PG8_SCHED
}
}

__device__ __forceinline__ int vcu_of(int bid, int nb) { return (nb % 8 == 0) ? (bid % 8) * (nb / 8) + bid / 8 : bid; }
struct SchedDense { int nM, nN, G, c; bool rev; bool skipctx; int lim;
  __device__ __forceinline__ bool next(int i, pg8::Unit& u) const { const int L = i * G + (rev ? G - 1 - c : c); if (L >= lim) return false; int pm = L / nN; u.pn = L % nN;
    if (skipctx) pm = pm + pm / 32 + 1; u.pm = pm; u.r0 = pm * 256; u.boff = 0; return true; } };
struct SchedDenseTail { int nN, base, nh, c;
  __device__ __forceinline__ bool next(int i, pg8::Unit& u) const { if (i > 0 || c >= nh) return false; const int L = base + (c >> 1); u.pm = L / nN; u.pn = L % nN;
    u.r0 = u.pm * 256 + (c & 1) * 128; u.boff = 0; return true; } };
struct SchedMoe { int nrt, G, c; size_t estride;
  __device__ __forceinline__ bool next(int i, pg8::Unit& u) const { const int L = i * G + c; if (L >= nrt * 4) return false; u.pm = L >> 2; u.pn = L & 3; u.r0 = u.pm * 256;
    const int e = u.pm < 256 ? ((u.pm >> 2) & 15) : u.pm - 256; u.boff = (size_t)e * estride; return true; } };
struct SchedMoeTail { int c; size_t estride;
  __device__ __forceinline__ bool next(int i, pg8::Unit& u) const { if (i > 0 || (c & 15) >= 4 || (c >> 4) >= NE) return false; const int e = c >> 4; u.pm = 256 + e; u.pn = c & 15;
    u.r0 = u.pm * 256; u.boff = (size_t)e * estride; return true; } };

__device__ __forceinline__ f32x4 shfl32(f32x4 v) { f32x4 r;
#pragma unroll
  for (int i = 0; i < 4; ++i) { auto x = __builtin_amdgcn_permlane32_swap(__float_as_uint(v[i]), __float_as_uint(v[i]), false, false); r[i] = __uint_as_float((TIDX & 32) ? x[0] : x[1]); }
  return r; }
__device__ __forceinline__ void rope32_grp(f32x4& v0, f32x4& v1, const float* RT, int rp, int cp, int fq) {
  const f32x4 p0 = shfl32(v0), p1 = shfl32(v1); const int f = 4 * (fq & 1);
  const f32x4 c0 = *(const f32x4*)(RT + 4096 + rp * 8 + f), s0 = *(const f32x4*)(RT + 5120 + rp * 8 + f), c1 = *(const f32x4*)(RT + 4096 + cp * 8 + f), s1 = *(const f32x4*)(RT + 5120 + cp * 8 + f);
  if (fq < 2) { v0 = v0 * c0 - p0 * s0; v1 = v1 * c1 - p1 * s1; } else { v0 = p0 * s0 + v0 * c0; v1 = p1 * s1 + v1 * c1; }
}
constexpr int ROPE_TAB_OFF = 131072 + 16384 + 128;
constexpr int STG_OFF = 131072, STG_OFF2 = 3 * 16384  , STG_RS = 512;
#define WSE(T, off) ((T*)(ws + (off)))
template <bool HM, class Epi>
__device__ __forceinline__ void epi_staged(const Epi& E, f32x4 (&acc)[2][2][4][2], const pg8::Unit& u, int wr, int wc, int fr, int fq, PG8_LAS unsigned char* lds, int tid) {
  constexpr int NCH = Epi::NCOL / 8, NPASS = 32 * NCH / NTHR;
  typename Epi::Ctx ctx; E.begin(ctx, u, wr, wc, fr, fq);
  const PG8_LAS float* rtab = (const PG8_LAS float*)(lds + ROPE_TAB_OFF);
  unsigned wofs[2][2], rofs[NPASS], gofs[NPASS], gld[NPASS]; bool gval[NPASS];
#pragma unroll
  for (int bj = 0; bj < 2; ++bj)
#pragma unroll
    for (int n = 0; n < 2; ++n) { const unsigned chunk = bj * 16 + wc * 4 + n * 2 + (fq >> 1); wofs[bj][n] = Epi::LEAN ? 0u : (unsigned)(wr * 16 + fr) * STG_RS + ((chunk ^ (unsigned)fr) << 4) + (fq & 1) * 8; }
#pragma unroll
  for (int ps = 0; ps < NPASS; ++ps) { const unsigned c = (unsigned)tid + NTHR * ps, rl = c / NCH, ch = c % NCH;
    rofs[ps] = rl * STG_RS + ((ch ^ (rl & 15u)) << 4);
    E.dst(u, (int)((rl >> 4) * 64 + (rl & 15u)), (int)(ch * 8), gofs[ps], gld[ps], gval[ps]); }
#pragma unroll
  for (int ai = 0; ai < (HM ? 1 : 2); ++ai)
#pragma unroll
    for (int m = 0; m < 4; ++m) {
      PG8_LAS unsigned char* stg = lds + ((m & 1) ? STG_OFF2 : STG_OFF);
      f32x4 v[2][2] = {{acc[ai][0][m][0], acc[ai][0][m][1]}, {acc[ai][1][m][0], acc[ai][1][m][1]}};
      E.pre(v, ai * 128 + m * 16, ai, m, ctx, u, wc, fr, fq, rtab);
#pragma unroll
      for (int bj = 0; bj < Epi::NCOL / 128; ++bj)
#pragma unroll
        for (int n = 0; n < 2; ++n) { u32x2 w; w.x = cvtpk_e(v[bj][n][0], v[bj][n][1]); w.y = cvtpk_e(v[bj][n][2], v[bj][n][3]);
          unsigned wo = wofs[bj][n];
          if (Epi::LEAN) { int frl = fr; asm volatile("" : "+v"(frl)); const unsigned chunk = bj * 16 + wc * 4 + n * 2 + (fq >> 1); wo = (unsigned)(wr * 16 + frl) * STG_RS + ((chunk ^ (unsigned)frl) << 4) + (fq & 1) * 8; }
          *(PG8_LAS u32x2*)(stg + wo) = w; }
      asm volatile("s_waitcnt lgkmcnt(0)" ::: "memory"); __builtin_amdgcn_s_barrier(); asm volatile("" ::: "memory");
#pragma unroll
      for (int ps = 0; ps < NPASS; ++ps) {
        const u32x4 val = *(const PG8_LAS u32x4*)(stg + rofs[ps]);
        unsigned go = gofs[ps]; asm volatile("" : "+v"(go));
        if (gval[ps]) __builtin_nontemporal_store(val, (u32x4*)(E.ws + (size_t)(go + (unsigned)(ai * 128 + m * 16) * gld[ps]))); }
    }
  asm volatile("s_waitcnt lgkmcnt(0)" ::: "memory"); __builtin_amdgcn_s_barrier(); asm volatile("" ::: "memory");
}
#define EPI_RUN   template <bool HM> __device__ __forceinline__ void run(f32x4 (&acc)[2][2][4][2], const pg8::Unit& u, int wr, int wc, int fr, int fq, PG8_LAS unsigned char* lds, int tid) const { epi_staged<HM>(*this, acc, u, wr, wc, fr, fq, lds, tid); }
__device__ __forceinline__ void rot4(f32x4& x1, f32x4& x2, int pos, const f32x4& w) {
  f32x4 c, sn;
#pragma unroll
  for (int j = 0; j < 4; ++j) { const float a = __builtin_amdgcn_fractf((float)pos * w[j]); c[j] = __builtin_amdgcn_cosf(a); sn[j] = __builtin_amdgcn_sinf(a); }
  const f32x4 a = x1 * c - x2 * sn, b = x1 * sn + x2 * c; x1 = a; x2 = b;
}
__device__ __forceinline__ f32x4 rope_w(int i0, float nf) { f32x4 w;
#pragma unroll
  for (int j = 0; j < 4; ++j) w[j] = exp2f(-(float)(i0 + j) * (13.287712379549449f / nf)) * 0.15915494309189535f;
  return w; }
__device__ __forceinline__ void rope32_hw(f32x4& v0, f32x4& v1, int rp, int cp, int fq, const f32x4& w32) {
  const f32x4 p0 = shfl32(v0), p1 = shfl32(v1);
  f32x4 c0, s0, c1, s1;
#pragma unroll
  for (int j = 0; j < 4; ++j) { const float a = __builtin_amdgcn_fractf((float)rp * w32[j]), bq = __builtin_amdgcn_fractf((float)cp * w32[j]);
    c0[j] = __builtin_amdgcn_cosf(a); s0[j] = __builtin_amdgcn_sinf(a); c1[j] = __builtin_amdgcn_cosf(bq); s1[j] = __builtin_amdgcn_sinf(bq); }
  if (fq < 2) { v0 = v0 * c0 - p0 * s0; v1 = v1 * c1 - p1 * s1; } else { v0 = p0 * s0 + v0 * c0; v1 = p1 * s1 + v1 * c1; }
}
__device__ __forceinline__ void tile_pos(int pm, bool& lat, int& pos0) { const int tb = pm % 33; lat = tb != 0; pos0 = (tb - 1) * 256; }
struct Epi2In {
  static constexpr int NCOL = 256; static constexpr bool LEAN = true;
  EPI_RUN
  unsigned char* ws;
  struct Ctx { int pos0, rloc; bool lat; };
  __device__ __forceinline__ void begin(Ctx& c, const pg8::Unit& u, int wr, int wc, int fr, int fq) const {
    c.rloc = wr * 64 + fr; tile_pos(u.pm, c.lat, c.pos0); c.pos0 += c.rloc + (u.r0 - u.pm * 256); }
  __device__ __forceinline__ void dst(const pg8::Unit& u, int rsub, int col, unsigned& gofs, unsigned& gld, bool& gval) const {
    const int gc = u.pn * 256 + col; const unsigned row = (unsigned)(u.r0 + rsub);
    const unsigned ld = gc < 512 ? 512u : gc < 768 ? 128u : gc < 1152 ? (unsigned)QRK : gc < 1408 ? (unsigned)KVRK : 32u;
    const unsigned base = gc < 512 ? (unsigned)(OFF_R + R_QA) : gc < 640 ? (unsigned)(OFF_R + R_KA) : gc < 768 ? (unsigned)(OFF_R + R_VA) : gc < 1152 ? (unsigned)(OFF_R + R_CQ) : gc < 1408 ? (unsigned)(OFF_R + R_CKV) : (unsigned)OFF_KR;
    const unsigned c0 = gc < 512 ? 0u : gc < 640 ? 512u : gc < 768 ? 640u : gc < 1152 ? 768u : gc < 1408 ? 1152u : 1408u;
    gval = gc < 1440; gld = ld * 2; gofs = base + row * gld + ((unsigned)gc - c0) * 2;
  }
  __device__ __forceinline__ void pre(f32x4 (&v)[2][2], int rowstep, int ai, int m, const Ctx& c, const pg8::Unit& u, int wc, int fr, int fq, const PG8_LAS float* rtab) const {
    int pos = c.pos0 + rowstep; asm volatile("" : "+v"(pos));
    const int rp = pos >> 6, cp = pos & 63; const bool lat = c.lat;
#pragma unroll
    for (int bj = 0; bj < 2; ++bj) {
      const int cg = u.pn * 256 + bj * 128 + wc * 32, g32 = cg >> 5;
      f32x4& v0 = v[bj][0]; f32x4& v1 = v[bj][1];
      if (g32 < 20) {
        if (lat) { const f32x4 w64 = *(const PG8_LAS f32x4*)(rtab + 4 * fq); rot4(v0, v1, (g32 & 1) ? cp : rp, w64); }
        if (g32 < 16) { v0 = v0 * SCALE_A; v1 = v1 * SCALE_A; }
      } else if (g32 >= 24 && g32 < 44) {
        float sq = v0[0] * v0[0] + v0[1] * v0[1] + v0[2] * v0[2] + v0[3] * v0[3] + v1[0] * v1[0] + v1[1] * v1[1] + v1[2] * v1[2] + v1[3] * v1[3];
        sq = sum16sw(sq); sq = sum32sw(sq);
        if (fq == 0) atomicAdd(WSE(float, g32 < 36 ? OFF_SSQQ : OFF_SSQK) + (u.r0 + rowstep + c.rloc), sq);
      } else if (g32 == 44) { if (lat) { const f32x4 w32 = *(const PG8_LAS f32x4*)(rtab + 16 + 4 * (fq & 1)); rope32_hw(v0, v1, rp, cp, fq, w32); } }
    }
  }
};
struct Epi2Qup {
  static constexpr int NCOL = 256; static constexpr bool LEAN = false;
  EPI_RUN
  unsigned char* ws;
  struct Ctx { float rs[2][4]; int pos0; bool lat; };
  __device__ __forceinline__ void begin(Ctx& c, const pg8::Unit& u, int wr, int wc, int fr, int fq) const {
    tile_pos(u.pm, c.lat, c.pos0); c.pos0 += wr * 64 + fr + (u.r0 - u.pm * 256);
#pragma unroll
    for (int ai = 0; ai < 2; ++ai)
#pragma unroll
      for (int m = 0; m < 4; ++m) c.rs[ai][m] = WSE(float, OFF_SSQQ)[u.r0 + ai * 128 + wr * 64 + m * 16 + fr];
#pragma unroll
    for (int ai = 0; ai < 2; ++ai)
#pragma unroll
      for (int m = 0; m < 4; ++m) c.rs[ai][m] = rsqrtf(c.rs[ai][m] * (1.f / QRK) + EPS) * SCALE_B; }
  __device__ __forceinline__ void dst(const pg8::Unit& u, int rsub, int col, unsigned& gofs, unsigned& gld, bool& gval) const {
    gld = NQB * 2; gofs = (unsigned)(OFF_R + R_QB) + (unsigned)(u.r0 + rsub) * gld + (u.pn * 256 + col) * 2; gval = true; }
  __device__ __forceinline__ void pre(f32x4 (&v)[2][2], int rowstep, int ai, int m, const Ctx& c, const pg8::Unit& u, int wc, int fr, int fq, const PG8_LAS float* rtab) const {
    int pos = c.pos0 + rowstep; asm volatile("" : "+v"(pos));
    const int rp = pos >> 6, cp = pos & 63; const float rs = c.rs[ai][m];
#pragma unroll
    for (int bj = 0; bj < 2; ++bj) { const int g32 = (u.pn * 256 + bj * 128 + wc * 32) >> 5;
      v[bj][0] = v[bj][0] * rs; v[bj][1] = v[bj][1] * rs;
      if ((g32 % 3) == 2) { if (c.lat) { const f32x4 w32 = *(const PG8_LAS f32x4*)(rtab + 16 + 4 * (fq & 1)); rope32_hw(v[bj][0], v[bj][1], rp, cp, fq, w32); } } }
  }
};
struct Epi2KV {
  static constexpr int NCOL = 256; static constexpr bool LEAN = false;
  EPI_RUN
  unsigned char* ws;
  struct Ctx { float rs[2][4]; };
  __device__ __forceinline__ void begin(Ctx& c, const pg8::Unit& u, int wr, int wc, int fr, int fq) const {
#pragma unroll
    for (int ai = 0; ai < 2; ++ai)
#pragma unroll
      for (int m = 0; m < 4; ++m) c.rs[ai][m] = WSE(float, OFF_SSQK)[u.r0 + ai * 128 + wr * 64 + m * 16 + fr];
#pragma unroll
    for (int ai = 0; ai < 2; ++ai)
#pragma unroll
      for (int m = 0; m < 4; ++m) c.rs[ai][m] = rsqrtf(c.rs[ai][m] * (1.f / KVRK) + EPS); }
  __device__ __forceinline__ void dst(const pg8::Unit& u, int rsub, int col, unsigned& gofs, unsigned& gld, bool& gval) const {
    const int gc = u.pn * 256 + col, hd = gc >> 7, sub = (gc >> 6) & 1;
    gld = 512 * 2; gofs = (unsigned)(OFF_R + (sub ? R_VB : R_KB)) + (unsigned)(u.r0 + rsub) * gld + (hd * 64 + (gc & 63)) * 2; gval = true; }
  __device__ __forceinline__ void pre(f32x4 (&v)[2][2], int rowstep, int ai, int m, const Ctx& c, const pg8::Unit& u, int wc, int fr, int fq, const PG8_LAS float* rtab) const {
    const float rs = c.rs[ai][m];
#pragma unroll
    for (int bj = 0; bj < 2; ++bj) { v[bj][0] = v[bj][0] * rs; v[bj][1] = v[bj][1] * rs; }
  }
};
struct Epi2Out {
  static constexpr int NCOL = 256; static constexpr bool LEAN = false;
  EPI_RUN
  unsigned char* ws; int l;
  struct Ctx { f32x4 ga[2][2]; };
  __device__ __forceinline__ void begin(Ctx& c, const pg8::Unit& u, int wr, int wc, int fr, int fq) const {
    const float* ga = WSE(float, OFF_MOD) + (size_t)(l * 5 + row_mi(u.pm * 256)) * 6144 + 2 * 1024 + u.pn * 256 + wc * 32 + 4 * fq;
#pragma unroll
    for (int bj = 0; bj < 2; ++bj)
#pragma unroll
      for (int n = 0; n < 2; ++n) c.ga[bj][n] = *(const f32x4*)(ga + bj * 128 + n * 16); }
  __device__ __forceinline__ void dst(const pg8::Unit& u, int rsub, int col, unsigned& gofs, unsigned& gld, bool& gval) const {
    gld = DM * 2; gofs = (unsigned)(OFF_R + R_MIXG) + (unsigned)(u.r0 + rsub) * gld + (u.pn * 256 + col) * 2; gval = true; }
  __device__ __forceinline__ void pre(f32x4 (&v)[2][2], int rowstep, int ai, int m, const Ctx& c, const pg8::Unit& u, int wc, int fr, int fq, const PG8_LAS float* rtab) const {
#pragma unroll
    for (int bj = 0; bj < 2; ++bj)
#pragma unroll
      for (int n = 0; n < 2; ++n) v[bj][n] = v[bj][n] * c.ga[bj][n];
  }
};
struct Epi2MoeUp {
  static constexpr int NCOL = 128; static constexpr bool LEAN = false;
  EPI_RUN
  unsigned char* ws;
  struct Ctx { };
  __device__ __forceinline__ void begin(Ctx& c, const pg8::Unit& u, int wr, int wc, int fr, int fq) const { }
  __device__ __forceinline__ void dst(const pg8::Unit& u, int rsub, int col, unsigned& gofs, unsigned& gld, bool& gval) const {
    gld = DFF * 2; gofs = (unsigned)(OFF_R + R_ACT) + (unsigned)(u.r0 + rsub) * gld + (u.pn * 128 + col) * 2; gval = true; }
  __device__ __forceinline__ void pre(f32x4 (&v)[2][2], int rowstep, int ai, int m, const Ctx& c, const pg8::Unit& u, int wc, int fr, int fq, const PG8_LAS float* rtab) const {
#pragma unroll
    for (int n = 0; n < 2; ++n)
#pragma unroll
      for (int j = 0; j < 4; ++j) v[0][n][j] = silu_fast(v[0][n][j]) * v[1][n][j];
  }
};
struct Epi2MoeDown {
  static constexpr int NCOL = 256; static constexpr bool LEAN = false;
  EPI_RUN
  unsigned char* ws;
  struct Ctx { float vv[2][4]; };
  __device__ __forceinline__ void begin(Ctx& c, const pg8::Unit& u, int wr, int wc, int fr, int fq) const {
#pragma unroll
    for (int ai = 0; ai < 2; ++ai)
#pragma unroll
      for (int m = 0; m < 4; ++m) c.vv[ai][m] = WSE(float, OFF_VAL)[u.r0 + ai * 128 + wr * 64 + m * 16 + fr]; }
  __device__ __forceinline__ void dst(const pg8::Unit& u, int rsub, int col, unsigned& gofs, unsigned& gld, bool& gval) const {
    gld = DM * 2; gofs = (unsigned)(OFF_R + R_Y) + (unsigned)(u.r0 + rsub) * gld + (u.pn * 256 + col) * 2; gval = true; }
  __device__ __forceinline__ void pre(f32x4 (&v)[2][2], int rowstep, int ai, int m, const Ctx& c, const pg8::Unit& u, int wc, int fr, int fq, const PG8_LAS float* rtab) const {
    const float vv = c.vv[ai][m];
#pragma unroll
    for (int bj = 0; bj < 2; ++bj) { v[bj][0] = v[bj][0] * vv; v[bj][1] = v[bj][1] * vv; }
  }
};
#define LDS3 ((PG8_LAS unsigned char*)lds)
__device__ __forceinline__ void ph2_gemm_in(const Prm& p, int l, unsigned char* lds, int bid, int nb) {
  pg8::Gemm g{(const bf16_t*)(p.ws + OFF_R + R_H), (const bf16_t*)(p.ws + OFF_W + (size_t)l * SZ_WL), DM, nullptr};
  const int vcu = vcu_of(bid, nb);
  const int nun = (MR / 256) * (NINP / 256), extra = nun % nb;
  const bool halftail = extra > 0 && 2 * extra <= nb;
  SchedDense S{MR / 256, NINP / 256, nb, vcu, false, false, halftail ? nun - extra : nun}; Epi2In E{p.ws};
  pg8::gemm_phase<false>(LDS3, g, S, E);
  if (halftail) { SchedDenseTail T{NINP / 256, nun - extra, 2 * extra, vcu}; pg8::gemm_phase<false, true>(LDS3, g, T, E);
    if (vcu >= 2 * extra) ph_wconv_moe(p, l, lds, vcu - 2 * extra, nb - 2 * extra); }
  else if (extra == 0) ph_wconv_moe(p, l, lds, vcu, nb); else if (vcu >= extra) ph_wconv_moe(p, l, lds, vcu - extra, nb - extra);
}
__device__ __forceinline__ void ph2_gemm_qup(const Prm& p, int l, unsigned char* lds, int bid, int nb) {
  pg8::Gemm g{(const bf16_t*)(p.ws + OFF_R + R_CQ), (const bf16_t*)(p.ws + OFF_W + (size_t)l * SZ_WL + SZ_WIN), QRK, nullptr};
  const bool lastl = (l == DEPTH - 1); SchedDense S{lastl ? MR / 256 - NB : MR / 256, NQB / 256, nb, vcu_of(bid, nb), false, lastl, (lastl ? MR / 256 - NB : MR / 256) * (NQB / 256)}; Epi2Qup E{p.ws}; pg8::gemm_phase<false>(LDS3, g, S, E);
}
__device__ __forceinline__ void ph2_gemm_kvup(const Prm& p, int l, unsigned char* lds, int bid, int nb) {
  pg8::Gemm g{(const bf16_t*)(p.ws + OFF_R + R_CKV), (const bf16_t*)(p.ws + OFF_W + (size_t)l * SZ_WL + SZ_WIN + SZ_WQ), KVRK, nullptr};
  SchedDense S{MR / 256, NKVB / 256, nb, vcu_of(bid, nb), true, false, (MR / 256) * (NKVB / 256)}; Epi2KV E{p.ws}; pg8::gemm_phase<false>(LDS3, g, S, E);
}
__device__ __forceinline__ void ph2_gemm_out(const Prm& p, int l, unsigned char* lds, int bid, int nb) {
  pg8::Gemm g{(const bf16_t*)(p.ws + OFF_R + R_H), (const bf16_t*)(p.ws + OFF_W + (size_t)l * SZ_WL + SZ_WIN + SZ_WQ + SZ_WKV), DM, nullptr};
  const bool lastl = (l == DEPTH - 1); const int vcu = vcu_of(bid, nb);
  const int nun = (lastl ? MR / 256 - NB : MR / 256) * (DM / 256), extra = nun % nb;
  const bool halftail = !lastl && extra > 0 && 2 * extra <= nb;
  SchedDense S{lastl ? MR / 256 - NB : MR / 256, DM / 256, nb, vcu, false, lastl, halftail ? nun - extra : nun}; Epi2Out E{p.ws, l};
  pg8::gemm_phase<false>(LDS3, g, S, E);
  if (halftail) { SchedDenseTail T{DM / 256, nun - extra, 2 * extra, vcu}; pg8::gemm_phase<false, true>(LDS3, g, T, E); }
  if (l + 1 < DEPTH) {
    const int busy = halftail ? 2 * extra : extra;
    if (busy == 0) { ph_mod(p, l + 1, lds, vcu, nb); ph_wconv_dense(p, l + 1, lds, vcu, nb); }
    else if (vcu >= busy) { ph_mod(p, l + 1, lds, vcu - busy, nb - busy); ph_wconv_dense(p, l + 1, lds, vcu - busy, nb - busy); }
  }
}
__device__ __forceinline__ void ph2_moe_up(const Prm& p, int l, unsigned char* lds, int bid, int nb) {
  pg8::Gemm g{(const bf16_t*)(p.ws + OFF_R + R_H), WSP(bf16_t, OFF_WGU), DM, WSP(int, OFF_IDX)};
  const bool halftail = (l != DEPTH - 1) && nb >= 256;
  SchedMoe S{(l == DEPTH - 1 || halftail) ? 256 : 272, nb, vcu_of(bid, nb), (size_t)1024 * 1024 * 2}; Epi2MoeUp E{p.ws};
  pg8::gemm_phase<true>(LDS3, g, S, E);
  if (halftail) { SchedMoeTail T{vcu_of(bid, nb), (size_t)1024 * 1024 * 2}; pg8::gemm_phase<true, true>(LDS3, g, T, E); }
}
__device__ __forceinline__ void ph2_moe_down(const Prm& p, int l, unsigned char* lds, int bid, int nb) {
  pg8::Gemm g{(const bf16_t*)(p.ws + OFF_R + R_ACT), WSP(bf16_t, OFF_WD), DFF, nullptr};
  const bool halftail = (l != DEPTH - 1) && nb >= 256;
  SchedMoe S{(l == DEPTH - 1 || halftail) ? 256 : 272, nb, vcu_of(bid, nb), (size_t)1024 * 512 * 2}; Epi2MoeDown E{p.ws};
  pg8::gemm_phase<false>(LDS3, g, S, E);
  if (halftail) { SchedMoeTail T{vcu_of(bid, nb), (size_t)1024 * 512 * 2}; pg8::gemm_phase<false, true>(LDS3, g, T, E); }
}

template <int DQK>
__device__ __forceinline__ void attn_naive_unit(const Prm& p, int l, int kind, int b, int hd, int qblk, unsigned char* lds) {
  float* Ks = (float*)lds;
  float* Vs = Ks + 32 * DQK;
  const int tid = TIDX;
  const bool isB = (kind == 0 || kind == 2), isctx = kind >= 2;
  const int nq = isctx ? LC : SEQ; const int qi = qblk * NTHR + tid; const bool qvalid = qi < nq;
  const int qrow = b * TT + (isctx ? 0 : LC) + (qvalid ? qi : 0);
  float q[DQK];
  { const bf16_t* qp = isB ? (const bf16_t*)(p.ws + OFF_R + R_QB) + (size_t)qrow * NQB + hd * 96 : (const bf16_t*)(p.ws + OFF_R + R_QA) + (size_t)qrow * 512 + hd * 64;
#pragma unroll
    for (int d = 0; d < DQK; ++d) q[d] = bf2f(qp[d]); }
  float m = -1e30f, lsum = 0.f, o[64];
#pragma unroll
  for (int d = 0; d < 64; ++d) o[d] = 0.f;
  const int q0 = qblk * NTHR;
  int klo = 0, khi = LC;
  if (!isctx) { if (isB) khi = TT; else { klo = max(0, q0 - 128); khi = min(SEQ, q0 + NTHR + 128); } }
  const int kvh = hd >> 2;
  for (int seg = 0; seg < 2; ++seg) {
    int t0, t1; if (seg == 0) { t0 = 0; t1 = LC; } else { if (isctx) break; if (isB) { t0 = LC; t1 = TT; } else { t0 = LC + klo; t1 = LC + khi; } }
    for (int tb = t0; tb < t1; tb += 32) {
      __syncthreads();
      {
        for (int i = tid; i < 32 * DQK; i += NTHR) { const int kk = i / DQK, d = i % DQK; const size_t kr = (size_t)(b * TT + tb + kk);
          float v;
          if (isB) v = d < 64 ? bf2f(((const bf16_t*)(p.ws + OFF_R + R_KB))[kr * 512 + hd * 64 + d]) : bf2f(WSP(bf16_t, OFF_KR)[kr * 32 + d - 64]);
          else v = bf2f(((const bf16_t*)(p.ws + OFF_R + R_KA))[kr * 128 + kvh * 64 + d]);
          Ks[i] = v; }
        for (int i = tid; i < 32 * 64; i += NTHR) { const int kk = i >> 6, d = i & 63; const size_t kr = (size_t)(b * TT + tb + kk);
          Vs[i] = isB ? bf2f(((const bf16_t*)(p.ws + OFF_R + R_VB))[kr * 512 + hd * 64 + d]) : bf2f(((const bf16_t*)(p.ws + OFF_R + R_VA))[kr * 128 + kvh * 64 + d]); }
      }
      __syncthreads();
      if (qvalid) {
        for (int kk = 0; kk < 32; ++kk) {
          if (!isB && seg == 1) { const int ts = tb + kk - LC; const int dlt = qi - ts; if (dlt > 128 || dlt < -128) continue; }
          float s = 0.f;
#pragma unroll
          for (int d = 0; d < DQK; ++d) s += q[d] * Ks[kk * DQK + d];
          if (s > m) { const float al = exp2f(m - s); lsum *= al;
#pragma unroll
            for (int d = 0; d < 64; ++d) o[d] *= al;
            m = s; }
          const float pe = exp2f(s - m); lsum += pe;
#pragma unroll
          for (int d = 0; d < 64; ++d) o[d] += pe * Vs[kk * 64 + d];
        }
      }
    }
  }
  if (qvalid) {
    if (!isB) { const float sk = p.sink[l * 8 + hd] * LOG2E; if (sk > m) { const float al = exp2f(m - sk); lsum = lsum * al + 1.f;
#pragma unroll
        for (int d = 0; d < 64; ++d) o[d] *= al; } else lsum += exp2f(sk - m); }
    const float il = 1.f / lsum;
    bf16_t* op = (bf16_t*)(p.ws + OFF_R + R_H) + (size_t)qrow * DM + (isB ? 512 : 0) + hd * 64;
#pragma unroll
    for (int d = 0; d < 64; ++d) op[d] = f2bf(o[d] * il);
  }
}
__device__ __forceinline__ void ph_attn_naive(const Prm& p, int l, unsigned char* lds, int bid, int nb) {
  const int nun = 1024 + (l == DEPTH - 1 ? 0 : 64);
  for (int u = bid; u < nun; u += nb) {
    int kind, b, hd, qb;
    if (u < 1024) { kind = u & 1; int r = u >> 1; qb = r & 15; r >>= 4; hd = r & 7; b = r >> 3; }
    else { const int r = u - 1024; kind = 2 + (r & 1); hd = (r >> 1) & 7; b = r >> 4; qb = 0; }
    if (kind == 0 || kind == 2) attn_naive_unit<96>(p, l, kind, b, hd, qb, lds); else attn_naive_unit<64>(p, l, kind, b, hd, qb, lds);
    __syncthreads();
  }
}

#define SBAR() __builtin_amdgcn_sched_barrier(0)
typedef short s16x4 __attribute__((ext_vector_type(4)));
__device__ __forceinline__ int crow(int r, int hi) { return (r & 3) + 8 * (r >> 2) + 4 * hi; }
__device__ __forceinline__ unsigned cvtpk(float lo, float hi) { unsigned r; asm volatile("v_cvt_pk_bf16_f32 %0, %1, %2" : "=v"(r) : "v"(lo), "v"(hi)); return r; }
constexpr float ATHR = 8.f;
__device__ __forceinline__ void partialSM(f32x16& p0, f32x16& p1, float& m_reg, float& alpha) {
  float pmax = p0[0];
#pragma unroll
  for (int r = 1; r < 16; ++r) pmax = fmaxf(pmax, p0[r]);
#pragma unroll
  for (int r = 0; r < 16; ++r) pmax = fmaxf(pmax, p1[r]);
  { auto rr = __builtin_amdgcn_permlane32_swap(__float_as_uint(pmax), __float_as_uint(pmax), false, false); pmax = fmaxf(__uint_as_float(rr[0]), __uint_as_float(rr[1])); }
  float mn;
  if (__builtin_expect(__all(pmax - m_reg <= ATHR), 1)) { mn = m_reg; alpha = 1.f; }
  else { mn = fmaxf(m_reg, pmax); alpha = __builtin_amdgcn_exp2f(m_reg - mn); m_reg = mn; }
#pragma unroll
  for (int r = 0; r < 16; ++r) { p0[r] -= mn; p1[r] -= mn; }
#pragma unroll
  for (int r = 0; r < 16; ++r) p0[r] = __builtin_amdgcn_exp2f(p0[r]);
}
__device__ __forceinline__ void finishSM(f32x16& p0, f32x16& p1, float alpha, float& l_reg, bf16x8& pa0, bf16x8& pa1, bf16x8& pa2, bf16x8& pa3) {
#pragma unroll
  for (int r = 0; r < 16; ++r) p1[r] = __builtin_amdgcn_exp2f(p1[r]);
  float ps = 0.f;
#pragma unroll
  for (int r = 0; r < 16; ++r) ps += p0[r];
#pragma unroll
  for (int r = 0; r < 16; ++r) ps += p1[r];
  { auto rr = __builtin_amdgcn_permlane32_swap(__float_as_uint(ps), __float_as_uint(ps), false, false); ps = __uint_as_float(rr[0]) + __uint_as_float(rr[1]); }
  l_reg = l_reg * alpha + ps;
#define PK4(P, BASE, OUT) do { unsigned a0 = cvtpk(P[BASE + 0], P[BASE + 1]), a1 = cvtpk(P[BASE + 2], P[BASE + 3]);   \
    unsigned b0 = cvtpk(P[BASE + 4], P[BASE + 5]), b1 = cvtpk(P[BASE + 6], P[BASE + 7]);                              \
    auto r0 = __builtin_amdgcn_permlane32_swap(a0, b0, false, false); auto r1 = __builtin_amdgcn_permlane32_swap(a1, b1, false, false); \
    u32x4 w = {r0[0], r1[0], r0[1], r1[1]}; OUT = *reinterpret_cast<bf16x8*>(&w); } while (0)
  PK4(p0, 0, pa0); PK4(p0, 8, pa1); PK4(p1, 0, pa2); PK4(p1, 8, pa3);
#undef PK4
}
template <int DQK>
__device__ __forceinline__ void qkt(f32x16& p0, f32x16& p1, const char* Ks, const bf16x8* qr, int r32, int hi) {
  constexpr int KST = DQK * 2 + 16;
  p0 = f32x16{}; p1 = f32x16{};
#pragma unroll
  for (int d0 = 0; d0 < DQK / 16; ++d0) { const int cb = (d0 * 16 + hi * 8) * 2;
    const bf16x8 b0 = *reinterpret_cast<const bf16x8*>(Ks + r32 * KST + cb);
    const bf16x8 b1 = *reinterpret_cast<const bf16x8*>(Ks + (32 + r32) * KST + cb);
    p0 = __builtin_amdgcn_mfma_f32_32x32x16_bf16(b0, qr[d0], p0, 0, 0, 0);
    p1 = __builtin_amdgcn_mfma_f32_32x32x16_bf16(b1, qr[d0], p1, 0, 0, 0); }
}
__device__ __forceinline__ int v_st(int k, int c) { const int kk = (k & ~0xC) | ((k & 4) << 1) | ((k & 8) >> 1); return ((kk >> 3) * 2 + (c >> 5)) * 512 + ((kk & 7) * 32 + (c & 31)) * 2; }
__device__ __forceinline__ int v_rd_base(int lane) { return ((lane & 3) << 3) | (((lane >> 2) & 3) << 6) | (((lane >> 4) & 1) << 5) | (((lane >> 5) & 1) << 8); }
constexpr int v_rd_off(int d0, int ks, int half) { return d0 * 512 + ks * 2048 + half * 1024; }
template <int OFF> __device__ __forceinline__ s16x4 tr_read(int vb) { s16x4 r; asm volatile("ds_read_b64_tr_b16 %0, %1 offset:%2" : "=&v"(r) : "v"(vb), "i"(OFF) : "memory"); return r; }
template <int D0> __device__ __forceinline__ void pv_one(f32x16& od, int vb, bf16x8 pa0, bf16x8 pa1, bf16x8 pa2, bf16x8 pa3) {
  const s16x4 l0 = tr_read<v_rd_off(D0, 0, 0)>(vb), h0 = tr_read<v_rd_off(D0, 0, 1)>(vb), l1 = tr_read<v_rd_off(D0, 1, 0)>(vb), h1 = tr_read<v_rd_off(D0, 1, 1)>(vb);
  const s16x4 l2 = tr_read<v_rd_off(D0, 2, 0)>(vb), h2 = tr_read<v_rd_off(D0, 2, 1)>(vb), l3 = tr_read<v_rd_off(D0, 3, 0)>(vb), h3 = tr_read<v_rd_off(D0, 3, 1)>(vb);
  asm volatile("s_waitcnt lgkmcnt(0)" ::: "memory"); SBAR();
#define PK(L, H) (bf16x8){L[0], L[1], L[2], L[3], H[0], H[1], H[2], H[3]}
  od = __builtin_amdgcn_mfma_f32_32x32x16_bf16(pa0, PK(l0, h0), od, 0, 0, 0);
  od = __builtin_amdgcn_mfma_f32_32x32x16_bf16(pa1, PK(l1, h1), od, 0, 0, 0);
  od = __builtin_amdgcn_mfma_f32_32x32x16_bf16(pa2, PK(l2, h2), od, 0, 0, 0);
  od = __builtin_amdgcn_mfma_f32_32x32x16_bf16(pa3, PK(l3, h3), od, 0, 0, 0);
#undef PK
}
__device__ __forceinline__ void pv_all(f32x16* o, int vb, bf16x8 pa0, bf16x8 pa1, bf16x8 pa2, bf16x8 pa3) { pv_one<0>(o[0], vb, pa0, pa1, pa2, pa3); pv_one<1>(o[1], vb, pa0, pa1, pa2, pa3); }

template <int KIND>
__device__ __forceinline__ void attn_fast_unit(const Prm& p, int l, bool isctx, int b, int hd, int qb, unsigned char* ldsu) {
  constexpr int DQK = KIND == 0 ? 96 : 64, KST = DQK * 2 + 16, SHM_K = 64 * KST, SHM_V = 8192, LPT = KIND == 0 ? 3 : 2;
  char* lds = (char*)ldsu;
  const int tid = TIDX, wid = tid >> 6, lane = tid & 63, r32 = lane & 31, hi = lane >> 5;
  char* V_lds = lds; char* K_lds = lds + 2 * SHM_V;
  float* ws = (float*)(lds + 2 * SHM_V + 2 * SHM_K) + wid * 64; float* li_l = ws; float* al_l = ws + 32;
  const int q0 = qb * 256;
  const size_t rowq0 = (size_t)b * TT + (isctx ? 0 : LC) + q0;
  const bf16_t *Qp, *Kp, *Vp; const bf16_t* KRp = WSP(bf16_t, OFF_KR); int ldq, ldk; int ocol;
  if (KIND == 0) { Qp = (const bf16_t*)(p.ws + OFF_R + R_QB) + hd * 96; ldq = NQB; Kp = (const bf16_t*)(p.ws + OFF_R + R_KB) + hd * 64; Vp = (const bf16_t*)(p.ws + OFF_R + R_VB) + hd * 64; ldk = 512; ocol = 512 + hd * 64; }
  else { Qp = (const bf16_t*)(p.ws + OFF_R + R_QA) + hd * 64; ldq = 512; Kp = (const bf16_t*)(p.ws + OFF_R + R_KA) + (hd >> 2) * 64; Vp = (const bf16_t*)(p.ws + OFF_R + R_VA) + (hd >> 2) * 64; ldk = 128; ocol = hd * 64; }
  int NT, kshift = 0; bool domask = false;
  if (isctx) NT = 4; else if (KIND == 0) NT = TT / 64; else { const int ks = max(0, q0 - 128), ke = min(SEQ, q0 + 384); NT = 4 + (ke - ks) / 64; kshift = ks; domask = true; }
  const size_t kb0 = (size_t)b * TT;
  float m_reg = -1e30f, l_reg = 0.f; f32x16 o[2] = {}; bf16x8 qr[DQK / 16];
  { const bf16_t* Qw = Qp + (rowq0 + wid * 32 + r32) * ldq + hi * 8;
#pragma unroll
    for (int d0 = 0; d0 < DQK / 16; ++d0) qr[d0] = *reinterpret_cast<const bf16x8*>(Qw + d0 * 16); }
  const int sr = tid >> 3, sc = (tid & 7) * 8, vst = v_st(sr, sc), kst = sr * KST + sc * 2;
  const int rr_ = (tid & 255) >> 2, rc_ = (tid & 3) * 8, krst = rr_ * KST + 128 + rc_ * 2;
  const int vb0 = (int)(uintptr_t)V_lds + v_rd_base(lane);
  struct { bf16x8 v, k, kr; } st_[2];
#define KROW(j) (kb0 + (size_t)(j) * 64 + ((j) >= 4 ? kshift : 0))
#define SLOAD(i, j) do { const size_t kr0_ = KROW(j); st_[i].v = *reinterpret_cast<const bf16x8*>(Vp + (kr0_ + sr) * ldk + sc); st_[i].k = *reinterpret_cast<const bf16x8*>(Kp + (kr0_ + sr) * ldk + sc); \
    if (KIND == 0) st_[i].kr = *reinterpret_cast<const bf16x8*>(KRp + (kr0_ + rr_) * 32 + rc_); } while (0)
#define SWRITE(bf, i) do { *(bf16x8*)(V_lds + (bf) * SHM_V + vst) = st_[i].v; *(bf16x8*)(K_lds + (bf) * SHM_K + kst) = st_[i].k; \
    if (KIND == 0) { if (tid < 256) *(bf16x8*)(K_lds + (bf) * SHM_K + krst) = st_[i].kr; } } while (0)
#define SWAIT() do { if (LPT == 3) asm volatile("s_waitcnt vmcnt(3)" ::: "memory"); else asm volatile("s_waitcnt vmcnt(2)" ::: "memory"); } while (0)
#define RESC(a) do { if (__any((a) < 1.f)) { if (hi == 0) al_l[r32] = (a); asm volatile("s_waitcnt lgkmcnt(0)" ::: "memory"); \
    _Pragma("unroll") for (int d = 0; d < 2; ++d) _Pragma("unroll") for (int r = 0; r < 16; ++r) o[d][r] *= al_l[crow(r, hi)]; } } while (0)
#define AMASK(P0, P1, j) do { if (KIND == 1) { if (domask && (j) >= 4) { const int tq_ = q0 + wid * 32 + r32; const int tk_ = kshift + ((j) - 4) * 64 + 4 * hi; \
    _Pragma("unroll") for (int r = 0; r < 16; ++r) { const int d_ = tq_ - (tk_ + (r & 3) + 8 * (r >> 2)); if (d_ > 128 || d_ < -128) P0[r] = -INFINITY; if (d_ - 32 > 128 || d_ - 32 < -128) P1[r] = -INFINITY; } } } } while (0)
  f32x16 pA0, pA1, pB0, pB1; float alA, alB; bf16x8 pa0, pa1, pa2, pa3;
  SLOAD(0, 0); asm volatile("s_waitcnt vmcnt(0)" ::: "memory"); SWRITE(0, 0); __syncthreads();
  qkt<DQK>(pA0, pA1, K_lds, qr, r32, hi); AMASK(pA0, pA1, 0); partialSM(pA0, pA1, m_reg, alA);
  SLOAD(1, 1); if (2 < NT) SLOAD(0, 2);
  SWAIT(); SWRITE(1, 1); __syncthreads();
  for (int j = 1; j + 1 < NT; j += 2) {
    SBAR(); qkt<DQK>(pB0, pB1, K_lds + SHM_K, qr, r32, hi);
    finishSM(pA0, pA1, alA, l_reg, pa0, pa1, pa2, pa3); SBAR();
    SLOAD(1, j + 2); SBAR();
    pv_all(o, vb0, pa0, pa1, pa2, pa3); AMASK(pB0, pB1, j); partialSM(pB0, pB1, m_reg, alB);
    __syncthreads(); SWAIT(); SWRITE(0, 0);
    RESC(alB); __syncthreads();
    SBAR(); qkt<DQK>(pA0, pA1, K_lds, qr, r32, hi);
    finishSM(pB0, pB1, alB, l_reg, pa0, pa1, pa2, pa3); SBAR();
    if (j + 3 < NT) SLOAD(0, j + 3); SBAR();
    pv_all(o, vb0 + SHM_V, pa0, pa1, pa2, pa3); AMASK(pA0, pA1, j + 1); partialSM(pA0, pA1, m_reg, alA);
    __syncthreads(); SWAIT(); SWRITE(1, 1);
    RESC(alA); __syncthreads();
  }
  SBAR(); qkt<DQK>(pB0, pB1, K_lds + SHM_K, qr, r32, hi);
  finishSM(pA0, pA1, alA, l_reg, pa0, pa1, pa2, pa3); SBAR();
  pv_all(o, vb0, pa0, pa1, pa2, pa3); AMASK(pB0, pB1, NT - 1); partialSM(pB0, pB1, m_reg, alB);
  __syncthreads(); RESC(alB);
  finishSM(pB0, pB1, alB, l_reg, pa0, pa1, pa2, pa3); SBAR();
  pv_all(o, vb0 + SHM_V, pa0, pa1, pa2, pa3);
  if (KIND == 1) l_reg += __builtin_amdgcn_exp2f(p.sink[l * 8 + hd] * LOG2E - m_reg);
  if (hi == 0) li_l[r32] = l_reg; asm volatile("s_waitcnt lgkmcnt(0)" ::: "memory");
  float rli[16];
#pragma unroll
  for (int r = 0; r < 16; ++r) rli[r] = __builtin_amdgcn_rcpf(li_l[crow(r, hi)]);
  bf16_t* Ow = (bf16_t*)(p.ws + OFF_R + R_H) + (rowq0 + wid * 32) * DM + ocol;
#pragma unroll
  for (int r = 0; r < 16; ++r) { const int orow = crow(r, hi);
#pragma unroll
    for (int d0 = 0; d0 < 2; ++d0) Ow[(size_t)orow * DM + d0 * 32 + r32] = f2bf(o[d0][r] * rli[r]); }
  __syncthreads();
#undef KROW
#undef SLOAD
#undef SWRITE
#undef SWAIT
#undef RESC
#undef AMASK
}
__device__ __forceinline__ float max3f_(float a, float b, float c) { return fmaxf(fmaxf(a, b), c); }
template <bool FIRST>
__device__ __forceinline__ void psm2(f32x16& p0, f32x16& p1, float& mhat, f32x16& negm, float& alpha) {
  float a = max3f_(p0[0], p0[1], p1[0]), b = max3f_(p0[2], p0[3], p1[1]); a = max3f_(a, p1[2], p1[3]);
#pragma unroll
  for (int r = 4; r < 16; r += 4) { a = max3f_(a, p0[r], p0[r + 1]); b = max3f_(b, p0[r + 2], p0[r + 3]); a = max3f_(a, p1[r], p1[r + 1]); b = max3f_(b, p1[r + 2], p1[r + 3]); }
  float rm = fmaxf(a, b);
  { auto rr = __builtin_amdgcn_permlane32_swap(__float_as_uint(rm), __float_as_uint(rm), false, false); rm = fmaxf(__uint_as_float(rr[0]), __uint_as_float(rr[1])); }
  alpha = 1.f;
  if (FIRST || __builtin_expect(__any(rm > ATHR), 0)) {
    const float dl = FIRST ? rm : fmaxf(rm, 0.f);
    mhat += dl;
#pragma unroll
    for (int r = 0; r < 16; ++r) { p0[r] -= dl; p1[r] -= dl; }
    const float nm = -mhat;
#pragma unroll
    for (int r = 0; r < 16; ++r) negm[r] = nm;
    alpha = __builtin_amdgcn_exp2f(-dl);
  }
#pragma unroll
  for (int r = 0; r < 16; ++r) p0[r] = __builtin_amdgcn_exp2f(p0[r]);
}
template <bool FIRST>
__device__ __forceinline__ void psm2q(f32x16& p0, f32x16& p1, float& mhat, f32x16& negm, float& alpha, float& lsum) {
  float a = max3f_(p0[0], p0[1], p1[0]), b = max3f_(p0[2], p0[3], p1[1]); a = max3f_(a, p1[2], p1[3]);
#pragma unroll
  for (int r = 4; r < 16; r += 4) { a = max3f_(a, p0[r], p0[r + 1]); b = max3f_(b, p0[r + 2], p0[r + 3]); a = max3f_(a, p1[r], p1[r + 1]); b = max3f_(b, p1[r + 2], p1[r + 3]); }
  float rm = fmaxf(a, b);
  { auto rr = __builtin_amdgcn_permlane32_swap(__float_as_uint(rm), __float_as_uint(rm), false, false); rm = fmaxf(__uint_as_float(rr[0]), __uint_as_float(rr[1])); }
  alpha = 1.f;
  if (FIRST || __builtin_expect(__any(rm > ATHR), 0)) {
    const float dl = FIRST ? rm : fmaxf(rm, 0.f);
    mhat += dl;
#pragma unroll
    for (int r = 0; r < 16; ++r) { p0[r] -= dl; p1[r] -= dl; }
    const float nm = -mhat;
#pragma unroll
    for (int r = 0; r < 16; ++r) negm[r] = nm;
    alpha = __builtin_amdgcn_exp2f(-dl);
  }
  float s0 = 0.f, s1 = 0.f;
#pragma unroll
  for (int r = 0; r < 16; r += 2) { p0[r] = __builtin_amdgcn_exp2f(p0[r]); s0 += p0[r]; p0[r + 1] = __builtin_amdgcn_exp2f(p0[r + 1]); s1 += p0[r + 1]; }
  lsum = FIRST ? (s0 + s1) : lsum * alpha + (s0 + s1);
}
__device__ __forceinline__ void fsm2(f32x16& p0, f32x16& p1, bf16x8& pa0, bf16x8& pa1, bf16x8& pa2, bf16x8& pa3) {
#pragma unroll
  for (int r = 0; r < 16; ++r) p1[r] = __builtin_amdgcn_exp2f(p1[r]);
#define PK4(P, BASE, OUT) do { unsigned a0 = cvtpk(P[BASE + 0], P[BASE + 1]), a1 = cvtpk(P[BASE + 2], P[BASE + 3]);   \
    unsigned b0 = cvtpk(P[BASE + 4], P[BASE + 5]), b1 = cvtpk(P[BASE + 6], P[BASE + 7]);                              \
    auto r0 = __builtin_amdgcn_permlane32_swap(a0, b0, false, false); auto r1 = __builtin_amdgcn_permlane32_swap(a1, b1, false, false); \
    u32x4 w = {r0[0], r1[0], r0[1], r1[1]}; OUT = *reinterpret_cast<bf16x8*>(&w); } while (0)
  PK4(p0, 0, pa0); PK4(p0, 8, pa1); PK4(p1, 0, pa2); PK4(p1, 8, pa3);
#undef PK4
}
template <int DQK>
__device__ __forceinline__ void qkt2(f32x16& p0, f32x16& p1, const char* Ks, const bf16x8* qr, const f32x16& negm, int r32, int hi) {
  constexpr int KST = DQK * 2 + 16, ND = DQK / 16;
  bf16x8 kb0[ND], kb1[ND];
#pragma unroll
  for (int d0 = 0; d0 < ND; ++d0) { const int cb = (d0 * 16 + hi * 8) * 2;
    kb0[d0] = *reinterpret_cast<const bf16x8*>(Ks + r32 * KST + cb); kb1[d0] = *reinterpret_cast<const bf16x8*>(Ks + (32 + r32) * KST + cb); }
#pragma unroll
  for (int d0 = 0; d0 < ND; ++d0) {
    if (d0 == 0) { p0 = __builtin_amdgcn_mfma_f32_32x32x16_bf16(kb0[0], qr[0], negm, 0, 0, 0); p1 = __builtin_amdgcn_mfma_f32_32x32x16_bf16(kb1[0], qr[0], negm, 0, 0, 0); }
    else { p0 = __builtin_amdgcn_mfma_f32_32x32x16_bf16(kb0[d0], qr[d0], p0, 0, 0, 0); p1 = __builtin_amdgcn_mfma_f32_32x32x16_bf16(kb1[d0], qr[d0], p1, 0, 0, 0); } }
}
__device__ __forceinline__ void pv_all2(f32x16* o, int vb, bf16x8 pa0, bf16x8 pa1, bf16x8 pa2, bf16x8 pa3) {
  pv_one<0>(o[0], vb, pa0, pa1, pa2, pa3); pv_one<1>(o[1], vb, pa0, pa1, pa2, pa3);
  const bf16x8 ones = {16256, 16256, 16256, 16256, 16256, 16256, 16256, 16256};
  o[2] = __builtin_amdgcn_mfma_f32_32x32x16_bf16(pa0, ones, o[2], 0, 0, 0); o[2] = __builtin_amdgcn_mfma_f32_32x32x16_bf16(pa1, ones, o[2], 0, 0, 0);
  o[2] = __builtin_amdgcn_mfma_f32_32x32x16_bf16(pa2, ones, o[2], 0, 0, 0); o[2] = __builtin_amdgcn_mfma_f32_32x32x16_bf16(pa3, ones, o[2], 0, 0, 0);
}
template <int KIND>
__device__ __forceinline__ void attn_fast_unit2(const Prm& p, int l, bool isctx, int b, int hd, int qb, unsigned char* ldsu) {
  constexpr int DQK = KIND == 0 ? 96 : 64, KST = DQK * 2 + 16, SHM_K = 64 * KST, SHM_V = 8192, LPT = KIND == 0 ? 3 : 2;
  char* lds = (char*)ldsu;
  const int tid = TIDX, wid = tid >> 6, lane = tid & 63, r32 = lane & 31, hi = lane >> 5;
  char* V_lds = lds; char* K_lds = lds + 2 * SHM_V;
  float* ws = (float*)(lds + 2 * SHM_V + 2 * SHM_K) + wid * 64; float* li_l = ws; float* al_l = ws + 32;
  const int q0 = qb * 256;
  const size_t rowq0 = (size_t)b * TT + (isctx ? 0 : LC) + q0;
  const bf16_t *Qp, *Kp, *Vp; const bf16_t* KRp = WSP(bf16_t, OFF_KR); int ldq, ldk; int ocol;
  if (KIND == 0) { Qp = (const bf16_t*)(p.ws + OFF_R + R_QB) + hd * 96; ldq = NQB; Kp = (const bf16_t*)(p.ws + OFF_R + R_KB) + hd * 64; Vp = (const bf16_t*)(p.ws + OFF_R + R_VB) + hd * 64; ldk = 512; ocol = 512 + hd * 64; }
  else { Qp = (const bf16_t*)(p.ws + OFF_R + R_QA) + hd * 64; ldq = 512; Kp = (const bf16_t*)(p.ws + OFF_R + R_KA) + (hd >> 2) * 64; Vp = (const bf16_t*)(p.ws + OFF_R + R_VA) + (hd >> 2) * 64; ldk = 128; ocol = hd * 64; }
  int NT, kshift = 0; bool domask = false;
  if (isctx) NT = 4; else if (KIND == 0) NT = TT / 64; else { const int ks = max(0, q0 - 128), ke = min(SEQ, q0 + 384); NT = 4 + (ke - ks) / 64; kshift = ks; domask = true; }
  const size_t kb0 = (size_t)b * TT;
  float mhat = 0.f; f32x16 o[3] = {}; f32x16 negm = {}; bf16x8 qr[DQK / 16];
  { const bf16_t* Qw = Qp + (rowq0 + wid * 32 + r32) * ldq + hi * 8;
#pragma unroll
    for (int d0 = 0; d0 < DQK / 16; ++d0) qr[d0] = *reinterpret_cast<const bf16x8*>(Qw + d0 * 16); }
  const int sr = tid >> 3, sc = (tid & 7) * 8, vst = v_st(sr, sc), kst = sr * KST + sc * 2;
  const int rr_ = (tid & 255) >> 2, rc_ = (tid & 3) * 8, krst = rr_ * KST + 128 + rc_ * 2;
  const int vb0 = (int)(uintptr_t)V_lds + v_rd_base(lane);
  struct { bf16x8 v, k, kr; } st_[1];
#define KROW(j) (kb0 + (size_t)(j) * 64 + ((j) >= 4 ? kshift : 0))
  const unsigned voffs = (unsigned)(sr * ldk + sc) * 2u, kroffs = (unsigned)(rr_ * 32 + rc_) * 2u;
#define SLOAD(i, j) do { const size_t kr0_ = KROW(j); const char* vb_ = (const char*)(Vp + kr0_ * ldk); const char* kb_ = (const char*)(Kp + kr0_ * ldk); \
    st_[i].v = *reinterpret_cast<const bf16x8*>(vb_ + voffs); st_[i].k = *reinterpret_cast<const bf16x8*>(kb_ + voffs); \
    if (KIND == 0) { const char* rb_ = (const char*)(KRp + kr0_ * 32); st_[i].kr = *reinterpret_cast<const bf16x8*>(rb_ + kroffs); } } while (0)
#define SWRITE(bf, i) do { *(bf16x8*)(V_lds + (bf) * SHM_V + vst) = st_[i].v; *(bf16x8*)(K_lds + (bf) * SHM_K + kst) = st_[i].k; \
    if (KIND == 0) { if (tid < 256) *(bf16x8*)(K_lds + (bf) * SHM_K + krst) = st_[i].kr; } } while (0)
#define SWAIT() do { if (LPT == 3) asm volatile("s_waitcnt vmcnt(3)" ::: "memory"); else asm volatile("s_waitcnt vmcnt(2)" ::: "memory"); } while (0)
#define RESC(a) do { if (__any((a) < 1.f)) { if (hi == 0) al_l[r32] = (a); asm volatile("s_waitcnt lgkmcnt(0)" ::: "memory"); \
    _Pragma("unroll") for (int d = 0; d < 3; ++d) _Pragma("unroll") for (int r = 0; r < 16; ++r) o[d][r] *= al_l[crow(r, hi)]; } } while (0)
#define AMASK(P0, P1, j) do { if (KIND == 1) { if (domask && (j) >= 4) { const int tq_ = q0 + wid * 32 + r32; const int tk_ = kshift + ((j) - 4) * 64 + 4 * hi; \
    _Pragma("unroll") for (int r = 0; r < 16; ++r) { const int d_ = tq_ - (tk_ + (r & 3) + 8 * (r >> 2)); if (d_ > 128 || d_ < -128) P0[r] = -INFINITY; if (d_ - 32 > 128 || d_ - 32 < -128) P1[r] = -INFINITY; } } } } while (0)
  if (__builtin_amdgcn_readfirstlane(wid) >= 4) __builtin_amdgcn_s_setprio(1);
  f32x16 pA0, pA1, pB0, pB1; float alA, alB; bf16x8 pa0, pa1, pa2, pa3;
  const int wq0_ = q0 + __builtin_amdgcn_readfirstlane(wid) * 32;
#define TACT(j) (KIND != 1 || !domask || (j) < 4 || (kshift + ((j) - 4) * 64 + 63 >= wq0_ - 128 && kshift + ((j) - 4) * 64 <= wq0_ + 31 + 128))
  bool actA, actB;
  SLOAD(0, 0); asm volatile("s_waitcnt vmcnt(0)" ::: "memory"); SWRITE(0, 0); __syncthreads();
  actA = true; qkt2<DQK>(pA0, pA1, K_lds, qr, negm, r32, hi); AMASK(pA0, pA1, 0); psm2<true>(pA0, pA1, mhat, negm, alA);
  SLOAD(0, 1);
  SWRITE(1, 0); __syncthreads();
  for (int j = 1; j + 1 < NT; j += 2) {
    actB = TACT(j);
    SBAR(); if (actB) qkt2<DQK>(pB0, pB1, K_lds + SHM_K, qr, negm, r32, hi);
    if (actA) fsm2(pA0, pA1, pa0, pa1, pa2, pa3); SBAR();
    SLOAD(0, j + 1); SBAR();
    if (actA) pv_all2(o, vb0, pa0, pa1, pa2, pa3); if (actB) { AMASK(pB0, pB1, j); psm2<false>(pB0, pB1, mhat, negm, alB); } else alB = 1.f;
    __syncthreads(); SWRITE(0, 0);
    RESC(alB); __syncthreads();
    actA = TACT(j + 1);
    SBAR(); if (actA) qkt2<DQK>(pA0, pA1, K_lds, qr, negm, r32, hi);
    if (actB) fsm2(pB0, pB1, pa0, pa1, pa2, pa3); SBAR();
    SLOAD(0, j + 2); SBAR();
    if (actB) pv_all2(o, vb0 + SHM_V, pa0, pa1, pa2, pa3); if (actA) { AMASK(pA0, pA1, j + 1); psm2<false>(pA0, pA1, mhat, negm, alA); } else alA = 1.f;
    __syncthreads(); SWRITE(1, 0);
    RESC(alA); __syncthreads();
  }
  actB = TACT(NT - 1);
  SBAR(); if (actB) qkt2<DQK>(pB0, pB1, K_lds + SHM_K, qr, negm, r32, hi);
  if (actA) fsm2(pA0, pA1, pa0, pa1, pa2, pa3); SBAR();
  if (actA) pv_all2(o, vb0, pa0, pa1, pa2, pa3); if (actB) { AMASK(pB0, pB1, NT - 1); psm2<false>(pB0, pB1, mhat, negm, alB); } else alB = 1.f;
  __syncthreads(); RESC(alB);
  if (actB) { fsm2(pB0, pB1, pa0, pa1, pa2, pa3); SBAR();
    pv_all2(o, vb0 + SHM_V, pa0, pa1, pa2, pa3); }
  __builtin_amdgcn_s_setprio(0);
  float rli[16];
  if (KIND == 1) { if (hi == 0) li_l[r32] = mhat; asm volatile("s_waitcnt lgkmcnt(0)" ::: "memory"); const float sk2 = p.sink[l * 8 + hd] * LOG2E;
#pragma unroll
    for (int r = 0; r < 16; ++r) rli[r] = __builtin_amdgcn_rcpf(o[2][r] + __builtin_amdgcn_exp2f(sk2 - li_l[crow(r, hi)])); }
  else {
#pragma unroll
    for (int r = 0; r < 16; ++r) rli[r] = __builtin_amdgcn_rcpf(o[2][r]); }
  bf16_t* Ow = (bf16_t*)(p.ws + OFF_R + R_H) + (rowq0 + wid * 32) * DM + ocol;
#pragma unroll
  for (int r = 0; r < 16; ++r) { const int orow = crow(r, hi);
#pragma unroll
    for (int d0 = 0; d0 < 2; ++d0) Ow[(size_t)orow * DM + d0 * 32 + r32] = f2bf(o[d0][r] * rli[r]); }
  __syncthreads();
#undef KROW
#undef SLOAD
#undef SWRITE
#undef SWAIT
#undef RESC
#undef AMASK
#undef TACT
}
#ifdef DBG_ATTN_PROBE
template <int KIND, int VAR>
__device__ __forceinline__ void attn_probe_unit(const Prm& p, int l, bool isctx, int b, int hd, int qb, unsigned char* ldsu) {
  constexpr int DQK = KIND == 0 ? 96 : 64, KST = DQK * 2 + 16, SHM_K = 64 * KST, SHM_V = 8192, LPT = KIND == 0 ? 3 : 2;
  char* lds = (char*)ldsu;
  const int tid = TIDX, wid = tid >> 6, lane = tid & 63, r32 = lane & 31, hi = lane >> 5;
  char* V_lds = lds; char* K_lds = lds + 2 * SHM_V;
  float* ws = (float*)(lds + 2 * SHM_V + 2 * SHM_K) + wid * 64; float* li_l = ws; float* al_l = ws + 32;
  const int q0 = qb * 256;
  const size_t rowq0 = (size_t)b * TT + (isctx ? 0 : LC) + q0;
  const bf16_t *Qp, *Kp, *Vp; const bf16_t* KRp = WSP(bf16_t, OFF_KR); int ldq, ldk; int ocol;
  if (KIND == 0) { Qp = (const bf16_t*)(p.ws + OFF_R + R_QB) + hd * 96; ldq = NQB; Kp = (const bf16_t*)(p.ws + OFF_R + R_KB) + hd * 64; Vp = (const bf16_t*)(p.ws + OFF_R + R_VB) + hd * 64; ldk = 512; ocol = 512 + hd * 64; }
  else { Qp = (const bf16_t*)(p.ws + OFF_R + R_QA) + hd * 64; ldq = 512; Kp = (const bf16_t*)(p.ws + OFF_R + R_KA) + (hd >> 2) * 64; Vp = (const bf16_t*)(p.ws + OFF_R + R_VA) + (hd >> 2) * 64; ldk = 128; ocol = hd * 64; }
  int NT, kshift = 0; bool domask = false;
  if (isctx) NT = 4; else if (KIND == 0) NT = TT / 64; else { const int ks = max(0, q0 - 128), ke = min(SEQ, q0 + 384); NT = 4 + (ke - ks) / 64; kshift = ks; domask = true; }
  const size_t kb0 = (size_t)b * TT;
  float mhat = 0.f; f32x16 o[3] = {}; f32x16 negm = {}; bf16x8 qr[DQK / 16];
  { const bf16_t* Qw = Qp + (rowq0 + wid * 32 + r32) * ldq + hi * 8;
#pragma unroll
    for (int d0 = 0; d0 < DQK / 16; ++d0) qr[d0] = *reinterpret_cast<const bf16x8*>(Qw + d0 * 16); }
  const int sr = tid >> 3, sc = (tid & 7) * 8, vst = v_st(sr, sc), kst = sr * KST + sc * 2;
  const int rr_ = (tid & 255) >> 2, rc_ = (tid & 3) * 8, krst = rr_ * KST + 128 + rc_ * 2;
  const int vb0 = (int)(uintptr_t)V_lds + v_rd_base(lane);
  struct { bf16x8 v, k, kr; } st_[1];
#define KROW(j) (kb0 + (size_t)(j) * 64 + ((j) >= 4 ? kshift : 0))
#define SLOAD(i, j) do { if (VAR & 4) break; const size_t kr0_ = KROW(j); st_[i].v = *reinterpret_cast<const bf16x8*>(Vp + (kr0_ + sr) * ldk + sc); st_[i].k = *reinterpret_cast<const bf16x8*>(Kp + (kr0_ + sr) * ldk + sc); \
    if (KIND == 0) st_[i].kr = *reinterpret_cast<const bf16x8*>(KRp + (kr0_ + rr_) * 32 + rc_); } while (0)
#define SWRITE(bf, i) do { if (VAR & 4) break; *(bf16x8*)(V_lds + (bf) * SHM_V + vst) = st_[i].v; *(bf16x8*)(K_lds + (bf) * SHM_K + kst) = st_[i].k; \
    if (KIND == 0) { if (tid < 256) *(bf16x8*)(K_lds + (bf) * SHM_K + krst) = st_[i].kr; } } while (0)
#define SWAIT() do { if (LPT == 3) asm volatile("s_waitcnt vmcnt(3)" ::: "memory"); else asm volatile("s_waitcnt vmcnt(2)" ::: "memory"); } while (0)
#define RESC(a) do { if (__any((a) < 1.f)) { if (hi == 0) al_l[r32] = (a); asm volatile("s_waitcnt lgkmcnt(0)" ::: "memory"); \
    _Pragma("unroll") for (int d = 0; d < 3; ++d) _Pragma("unroll") for (int r = 0; r < 16; ++r) o[d][r] *= al_l[crow(r, hi)]; } } while (0)
#define AMASK(P0, P1, j) do { if (KIND == 1) { if (domask && (j) >= 4) { const int tq_ = q0 + wid * 32 + r32; const int tk_ = kshift + ((j) - 4) * 64 + 4 * hi; \
    _Pragma("unroll") for (int r = 0; r < 16; ++r) { const int d_ = tq_ - (tk_ + (r & 3) + 8 * (r >> 2)); if (d_ > 128 || d_ < -128) P0[r] = -INFINITY; if (d_ - 32 > 128 || d_ - 32 < -128) P1[r] = -INFINITY; } } } } while (0)
  f32x16 pA0, pA1, pB0, pB1; float alA, alB; bf16x8 pa0, pa1, pa2, pa3;
  const int wq0_ = q0 + __builtin_amdgcn_readfirstlane(wid) * 32;
#define TACT(j) (KIND != 1 || !domask || (j) < 4 || (kshift + ((j) - 4) * 64 + 63 >= wq0_ - 128 && kshift + ((j) - 4) * 64 <= wq0_ + 31 + 128))
  bool actA, actB;
  SLOAD(0, 0); asm volatile("s_waitcnt vmcnt(0)" ::: "memory"); SWRITE(0, 0); do { if (!(VAR & 1)) __syncthreads(); } while (0);
  do { if (!(VAR & 16)) qkt2<DQK>(pA0, pA1, K_lds, qr, negm, r32, hi); else { pA0 = negm; pA1 = negm; asm volatile("" : "+v"(pA0), "+v"(pA1)); } } while (0); AMASK(pA0, pA1, 0); do { if (!(VAR & 2)) psm2<true>(pA0, pA1, mhat, negm, alA); else alA = 1.f; } while (0);
  SLOAD(0, 1);
  SWRITE(1, 0); do { if (!(VAR & 1)) __syncthreads(); } while (0);
  for (int j = 1; j + 1 < NT; j += 2) {
    SBAR(); do { if (!(VAR & 16)) qkt2<DQK>(pB0, pB1, K_lds + SHM_K, qr, negm, r32, hi); else { pB0 = negm; pB1 = negm; asm volatile("" : "+v"(pB0), "+v"(pB1)); } } while (0);
    do { if (!(VAR & 2)) fsm2(pA0, pA1, pa0, pa1, pa2, pa3); else { pa0 = __builtin_bit_cast(bf16x8, (f32x4){pA0[0], pA0[1], pA0[2], pA0[3]}); pa1 = __builtin_bit_cast(bf16x8, (f32x4){pA0[4], pA0[5], pA0[6], pA0[7]}); pa2 = __builtin_bit_cast(bf16x8, (f32x4){pA1[0], pA1[1], pA1[2], pA1[3]}); pa3 = __builtin_bit_cast(bf16x8, (f32x4){pA1[4], pA1[5], pA1[6], pA1[7]}); } } while (0); SBAR();
    SLOAD(0, j + 1); SBAR();
    do { if (!(VAR & 8)) pv_all2(o, vb0, pa0, pa1, pa2, pa3); else { asm volatile("" :: "v"(pa0), "v"(pa1), "v"(pa2), "v"(pa3)); } } while (0); AMASK(pB0, pB1, j); do { if (!(VAR & 2)) psm2<false>(pB0, pB1, mhat, negm, alB); else alB = 1.f; } while (0);
    do { if (!(VAR & 1)) __syncthreads(); } while (0); SWRITE(0, 0);
    RESC(alB); do { if (!(VAR & 1)) __syncthreads(); } while (0);
    SBAR(); do { if (!(VAR & 16)) qkt2<DQK>(pA0, pA1, K_lds, qr, negm, r32, hi); else { pA0 = negm; pA1 = negm; asm volatile("" : "+v"(pA0), "+v"(pA1)); } } while (0);
    do { if (!(VAR & 2)) fsm2(pB0, pB1, pa0, pa1, pa2, pa3); else { pa0 = __builtin_bit_cast(bf16x8, (f32x4){pB0[0], pB0[1], pB0[2], pB0[3]}); pa1 = __builtin_bit_cast(bf16x8, (f32x4){pB0[4], pB0[5], pB0[6], pB0[7]}); pa2 = __builtin_bit_cast(bf16x8, (f32x4){pB1[0], pB1[1], pB1[2], pB1[3]}); pa3 = __builtin_bit_cast(bf16x8, (f32x4){pB1[4], pB1[5], pB1[6], pB1[7]}); } } while (0); SBAR();
    SLOAD(0, j + 2); SBAR();
    do { if (!(VAR & 8)) pv_all2(o, vb0 + SHM_V, pa0, pa1, pa2, pa3); else { asm volatile("" :: "v"(pa0), "v"(pa1), "v"(pa2), "v"(pa3)); } } while (0); AMASK(pA0, pA1, j + 1); do { if (!(VAR & 2)) psm2<false>(pA0, pA1, mhat, negm, alA); else alA = 1.f; } while (0);
    do { if (!(VAR & 1)) __syncthreads(); } while (0); SWRITE(1, 0);
    RESC(alA); do { if (!(VAR & 1)) __syncthreads(); } while (0);
  }
  SBAR(); do { if (!(VAR & 16)) qkt2<DQK>(pB0, pB1, K_lds + SHM_K, qr, negm, r32, hi); else { pB0 = negm; pB1 = negm; asm volatile("" : "+v"(pB0), "+v"(pB1)); } } while (0);
  do { if (!(VAR & 2)) fsm2(pA0, pA1, pa0, pa1, pa2, pa3); else { pa0 = __builtin_bit_cast(bf16x8, (f32x4){pA0[0], pA0[1], pA0[2], pA0[3]}); pa1 = __builtin_bit_cast(bf16x8, (f32x4){pA0[4], pA0[5], pA0[6], pA0[7]}); pa2 = __builtin_bit_cast(bf16x8, (f32x4){pA1[0], pA1[1], pA1[2], pA1[3]}); pa3 = __builtin_bit_cast(bf16x8, (f32x4){pA1[4], pA1[5], pA1[6], pA1[7]}); } } while (0); SBAR();
  do { if (!(VAR & 8)) pv_all2(o, vb0, pa0, pa1, pa2, pa3); else { asm volatile("" :: "v"(pa0), "v"(pa1), "v"(pa2), "v"(pa3)); } } while (0); AMASK(pB0, pB1, NT - 1); do { if (!(VAR & 2)) psm2<false>(pB0, pB1, mhat, negm, alB); else alB = 1.f; } while (0);
  do { if (!(VAR & 1)) __syncthreads(); } while (0); RESC(alB);
  do { if (!(VAR & 2)) fsm2(pB0, pB1, pa0, pa1, pa2, pa3); else { pa0 = __builtin_bit_cast(bf16x8, (f32x4){pB0[0], pB0[1], pB0[2], pB0[3]}); pa1 = __builtin_bit_cast(bf16x8, (f32x4){pB0[4], pB0[5], pB0[6], pB0[7]}); pa2 = __builtin_bit_cast(bf16x8, (f32x4){pB1[0], pB1[1], pB1[2], pB1[3]}); pa3 = __builtin_bit_cast(bf16x8, (f32x4){pB1[4], pB1[5], pB1[6], pB1[7]}); } } while (0); SBAR();
  do { if (!(VAR & 8)) pv_all2(o, vb0 + SHM_V, pa0, pa1, pa2, pa3); else { asm volatile("" :: "v"(pa0), "v"(pa1), "v"(pa2), "v"(pa3)); } } while (0);
  float rli[16];
  if (KIND == 1) { if (hi == 0) li_l[r32] = mhat; asm volatile("s_waitcnt lgkmcnt(0)" ::: "memory"); const float sk2 = p.sink[l * 8 + hd] * LOG2E;
#pragma unroll
    for (int r = 0; r < 16; ++r) rli[r] = __builtin_amdgcn_rcpf(o[2][r] + __builtin_amdgcn_exp2f(sk2 - li_l[crow(r, hi)])); }
  else {
#pragma unroll
    for (int r = 0; r < 16; ++r) rli[r] = __builtin_amdgcn_rcpf(o[2][r]); }
  bf16_t* Ow = (bf16_t*)(p.ws + OFF_R + R_CQ) + ((rowq0 + wid * 32) & 16383) * DM + ocol;
#pragma unroll
  for (int r = 0; r < 16; ++r) { const int orow = crow(r, hi);
#pragma unroll
    for (int d0 = 0; d0 < 2; ++d0) Ow[(size_t)orow * DM + d0 * 32 + r32] = f2bf(o[d0][r] * rli[r]); }
  do { if (!(VAR & 1)) __syncthreads(); } while (0);
#undef KROW
#undef SLOAD
#undef SWRITE
#undef SWAIT
#undef RESC
#undef AMASK
#undef TACT
}

template <int VAR>
__device__ __forceinline__ void ph_attn_probe(const Prm& p, int l, unsigned char* lds, int bid, int nb) {
  const int nrounds = (1024 + nb - 1) / nb;
  for (int rd = 0; rd < nrounds; ++rd) { const int pair = rd * 8 + (bid & 7), qb = bid >> 3, u = pair * 32 + qb;
    if (u < 1024) attn_probe_unit<0, VAR>(p, l, false, u >> 8, (u >> 5) & 7, u & 31, lds); }
}
#endif
__device__ __forceinline__ int v_st_p(int k, int c) { return (c >> 5) * 4096 + (k >> 4) * 1024 + (k & 15) * 64 + (c & 31) * 2; }
__device__ __forceinline__ int v_rd_base_p(int lane) { return ((lane >> 4) & 1) * 32 + (lane & 3) * 8 + (4 * (lane >> 5) + ((lane & 15) >> 2)) * 64; }
constexpr int v_rd_off_p(int d0, int ks, int half) { return d0 * 4096 + ks * 1024 + half * 512; }
template <int D0> __device__ __forceinline__ void pv_one_p(f32x16& od, int vb, bf16x8 pa0, bf16x8 pa1, bf16x8 pa2, bf16x8 pa3) {
  const s16x4 l0 = tr_read<v_rd_off_p(D0, 0, 0)>(vb), h0 = tr_read<v_rd_off_p(D0, 0, 1)>(vb), l1 = tr_read<v_rd_off_p(D0, 1, 0)>(vb), h1 = tr_read<v_rd_off_p(D0, 1, 1)>(vb);
  const s16x4 l2 = tr_read<v_rd_off_p(D0, 2, 0)>(vb), h2 = tr_read<v_rd_off_p(D0, 2, 1)>(vb), l3 = tr_read<v_rd_off_p(D0, 3, 0)>(vb), h3 = tr_read<v_rd_off_p(D0, 3, 1)>(vb);
  asm volatile("s_waitcnt lgkmcnt(0)" ::: "memory"); SBAR();
#define PK(L, H) (bf16x8){L[0], L[1], L[2], L[3], H[0], H[1], H[2], H[3]}
  od = __builtin_amdgcn_mfma_f32_32x32x16_bf16(pa0, PK(l0, h0), od, 0, 0, 0);
  od = __builtin_amdgcn_mfma_f32_32x32x16_bf16(pa1, PK(l1, h1), od, 0, 0, 0);
  od = __builtin_amdgcn_mfma_f32_32x32x16_bf16(pa2, PK(l2, h2), od, 0, 0, 0);
  od = __builtin_amdgcn_mfma_f32_32x32x16_bf16(pa3, PK(l3, h3), od, 0, 0, 0);
#undef PK
}
__device__ __forceinline__ void pv_all2p(f32x16* o, int vb, bf16x8 pa0, bf16x8 pa1, bf16x8 pa2, bf16x8 pa3) {
  const s16x4 a0 = tr_read<v_rd_off_p(0, 0, 0)>(vb), b0 = tr_read<v_rd_off_p(0, 0, 1)>(vb), a1 = tr_read<v_rd_off_p(0, 1, 0)>(vb), b1 = tr_read<v_rd_off_p(0, 1, 1)>(vb);
  const s16x4 a2 = tr_read<v_rd_off_p(0, 2, 0)>(vb), b2 = tr_read<v_rd_off_p(0, 2, 1)>(vb), a3 = tr_read<v_rd_off_p(0, 3, 0)>(vb), b3 = tr_read<v_rd_off_p(0, 3, 1)>(vb);
  const s16x4 c0 = tr_read<v_rd_off_p(1, 0, 0)>(vb), d0 = tr_read<v_rd_off_p(1, 0, 1)>(vb), c1 = tr_read<v_rd_off_p(1, 1, 0)>(vb), d1 = tr_read<v_rd_off_p(1, 1, 1)>(vb);
  const s16x4 c2 = tr_read<v_rd_off_p(1, 2, 0)>(vb), d2 = tr_read<v_rd_off_p(1, 2, 1)>(vb), c3 = tr_read<v_rd_off_p(1, 3, 0)>(vb), d3 = tr_read<v_rd_off_p(1, 3, 1)>(vb);
  asm volatile("s_waitcnt lgkmcnt(0)" ::: "memory"); SBAR();
#define PK(L, H) (bf16x8){L[0], L[1], L[2], L[3], H[0], H[1], H[2], H[3]}
  const bf16x8 ones = {16256, 16256, 16256, 16256, 16256, 16256, 16256, 16256};
  o[0] = __builtin_amdgcn_mfma_f32_32x32x16_bf16(pa0, PK(a0, b0), o[0], 0, 0, 0); o[1] = __builtin_amdgcn_mfma_f32_32x32x16_bf16(pa0, PK(c0, d0), o[1], 0, 0, 0); o[2] = __builtin_amdgcn_mfma_f32_32x32x16_bf16(pa0, ones, o[2], 0, 0, 0);
  o[0] = __builtin_amdgcn_mfma_f32_32x32x16_bf16(pa1, PK(a1, b1), o[0], 0, 0, 0); o[1] = __builtin_amdgcn_mfma_f32_32x32x16_bf16(pa1, PK(c1, d1), o[1], 0, 0, 0); o[2] = __builtin_amdgcn_mfma_f32_32x32x16_bf16(pa1, ones, o[2], 0, 0, 0);
  o[0] = __builtin_amdgcn_mfma_f32_32x32x16_bf16(pa2, PK(a2, b2), o[0], 0, 0, 0); o[1] = __builtin_amdgcn_mfma_f32_32x32x16_bf16(pa2, PK(c2, d2), o[1], 0, 0, 0); o[2] = __builtin_amdgcn_mfma_f32_32x32x16_bf16(pa2, ones, o[2], 0, 0, 0);
  o[0] = __builtin_amdgcn_mfma_f32_32x32x16_bf16(pa3, PK(a3, b3), o[0], 0, 0, 0); o[1] = __builtin_amdgcn_mfma_f32_32x32x16_bf16(pa3, PK(c3, d3), o[1], 0, 0, 0); o[2] = __builtin_amdgcn_mfma_f32_32x32x16_bf16(pa3, ones, o[2], 0, 0, 0);
#undef PK
}
__device__ __forceinline__ void fsm2p(f32x16& p0, f32x16& p1, bf16x8& pa0, bf16x8& pa1, bf16x8& pa2, bf16x8& pa3) {
#pragma unroll
  for (int r = 0; r < 16; ++r) p1[r] = __builtin_amdgcn_exp2f(p1[r]);
#define PK8(P, BASE, OUT) do { u32x4 w = {cvtpk(P[BASE + 0], P[BASE + 1]), cvtpk(P[BASE + 2], P[BASE + 3]), cvtpk(P[BASE + 4], P[BASE + 5]), cvtpk(P[BASE + 6], P[BASE + 7])}; OUT = *reinterpret_cast<bf16x8*>(&w); } while (0)
  PK8(p0, 0, pa0); PK8(p0, 8, pa1); PK8(p1, 0, pa2); PK8(p1, 8, pa3);
#undef PK8
}
__device__ __forceinline__ void pv_all2q(f32x16* o, int vb, bf16x8 pa0, bf16x8 pa1, bf16x8 pa2, bf16x8 pa3) {
  const s16x4 a0 = tr_read<v_rd_off_p(0, 0, 0)>(vb), b0 = tr_read<v_rd_off_p(0, 0, 1)>(vb), a1 = tr_read<v_rd_off_p(0, 1, 0)>(vb), b1 = tr_read<v_rd_off_p(0, 1, 1)>(vb);
  const s16x4 a2 = tr_read<v_rd_off_p(0, 2, 0)>(vb), b2 = tr_read<v_rd_off_p(0, 2, 1)>(vb), a3 = tr_read<v_rd_off_p(0, 3, 0)>(vb), b3 = tr_read<v_rd_off_p(0, 3, 1)>(vb);
  const s16x4 c0 = tr_read<v_rd_off_p(1, 0, 0)>(vb), d0 = tr_read<v_rd_off_p(1, 0, 1)>(vb), c1 = tr_read<v_rd_off_p(1, 1, 0)>(vb), d1 = tr_read<v_rd_off_p(1, 1, 1)>(vb);
  const s16x4 c2 = tr_read<v_rd_off_p(1, 2, 0)>(vb), d2 = tr_read<v_rd_off_p(1, 2, 1)>(vb), c3 = tr_read<v_rd_off_p(1, 3, 0)>(vb), d3 = tr_read<v_rd_off_p(1, 3, 1)>(vb);
  asm volatile("s_waitcnt lgkmcnt(0)" ::: "memory"); SBAR();
#define PK(L, H) (bf16x8){L[0], L[1], L[2], L[3], H[0], H[1], H[2], H[3]}
  o[0] = __builtin_amdgcn_mfma_f32_32x32x16_bf16(pa0, PK(a0, b0), o[0], 0, 0, 0); o[1] = __builtin_amdgcn_mfma_f32_32x32x16_bf16(pa0, PK(c0, d0), o[1], 0, 0, 0);
  o[0] = __builtin_amdgcn_mfma_f32_32x32x16_bf16(pa1, PK(a1, b1), o[0], 0, 0, 0); o[1] = __builtin_amdgcn_mfma_f32_32x32x16_bf16(pa1, PK(c1, d1), o[1], 0, 0, 0);
  o[0] = __builtin_amdgcn_mfma_f32_32x32x16_bf16(pa2, PK(a2, b2), o[0], 0, 0, 0); o[1] = __builtin_amdgcn_mfma_f32_32x32x16_bf16(pa2, PK(c2, d2), o[1], 0, 0, 0);
  o[0] = __builtin_amdgcn_mfma_f32_32x32x16_bf16(pa3, PK(a3, b3), o[0], 0, 0, 0); o[1] = __builtin_amdgcn_mfma_f32_32x32x16_bf16(pa3, PK(c3, d3), o[1], 0, 0, 0);
#undef PK
}
__device__ __forceinline__ void fsm2q(f32x16& p0, f32x16& p1, bf16x8& pa0, bf16x8& pa1, bf16x8& pa2, bf16x8& pa3, float& lsum) {
#pragma unroll
  for (int r = 0; r < 16; r += 2) { p1[r] = __builtin_amdgcn_exp2f(p1[r]); lsum += p1[r]; p1[r + 1] = __builtin_amdgcn_exp2f(p1[r + 1]); lsum += p1[r + 1]; }
#define PK8(P, BASE, OUT) do { u32x4 w = {cvtpk(P[BASE + 0], P[BASE + 1]), cvtpk(P[BASE + 2], P[BASE + 3]), cvtpk(P[BASE + 4], P[BASE + 5]), cvtpk(P[BASE + 6], P[BASE + 7])}; OUT = *reinterpret_cast<bf16x8*>(&w); } while (0)
  PK8(p0, 0, pa0); PK8(p0, 8, pa1); PK8(p1, 0, pa2); PK8(p1, 8, pa3);
#undef PK8
}
template <int KIND>
__device__ __forceinline__ void attn_fast_unit2p(const Prm& p, int l, bool isctx, int b, int hd, int qb, unsigned char* ldsu) {
  constexpr int DQK = KIND == 0 ? 96 : 64, KST = DQK * 2 + 16, SHM_K = 64 * KST, SHM_V = 8192, LPT = KIND == 0 ? 3 : 2;
  char* lds = (char*)ldsu;
  const int tid = TIDX, wid = tid >> 6, lane = tid & 63, r32 = lane & 31, hi = lane >> 5;
  char* V_lds = lds; char* K_lds = lds + 2 * SHM_V;
  float* ws = (float*)(lds + 2 * SHM_V + 2 * SHM_K) + wid * 64; float* li_l = ws; float* al_l = ws + 32;
  const int q0 = qb * 256;
  const size_t rowq0 = (size_t)b * TT + (isctx ? 0 : LC) + q0;
  const bf16_t *Qp, *Kp, *Vp; const bf16_t* KRp = WSP(bf16_t, OFF_KR); int ldq, ldk; int ocol;
  if (KIND == 0) { Qp = (const bf16_t*)(p.ws + OFF_R + R_QB) + hd * 96; ldq = NQB; Kp = (const bf16_t*)(p.ws + OFF_R + R_KB) + hd * 64; Vp = (const bf16_t*)(p.ws + OFF_R + R_VB) + hd * 64; ldk = 512; ocol = 512 + hd * 64; }
  else { Qp = (const bf16_t*)(p.ws + OFF_R + R_QA) + hd * 64; ldq = 512; Kp = (const bf16_t*)(p.ws + OFF_R + R_KA) + (hd >> 2) * 64; Vp = (const bf16_t*)(p.ws + OFF_R + R_VA) + (hd >> 2) * 64; ldk = 128; ocol = hd * 64; }
  int NT, kshift = 0; bool domask = false;
  if (isctx) NT = 4; else if (KIND == 0) NT = TT / 64; else { const int ks = max(0, q0 - 128), ke = min(SEQ, q0 + 384); NT = 4 + (ke - ks) / 64; kshift = ks; domask = true; }
  const size_t kb0 = (size_t)b * TT;
  float mhat = 0.f, lsum = 0.f; f32x16 o[2] = {}; f32x16 negm = {}; bf16x8 qr[DQK / 16];
  { const bf16_t* Qw = Qp + (rowq0 + wid * 32 + r32) * ldq + hi * 8;
#pragma unroll
    for (int d0 = 0; d0 < DQK / 16; ++d0) qr[d0] = *reinterpret_cast<const bf16x8*>(Qw + d0 * 16); }
  const int sr = tid >> 3, sc = (tid & 7) * 8, vst = v_st_p(sr, sc), kst = sr * KST + sc * 2;
  const int rr_ = (tid & 255) >> 2, rc_ = (tid & 3) * 8, krst = rr_ * KST + 128 + rc_ * 2;
  const int vb0 = (int)(uintptr_t)V_lds + v_rd_base_p(lane);
  struct { bf16x8 v, k, kr; } st_[1];
#define KROW(j) (kb0 + (size_t)(j) * 64 + ((j) >= 4 ? kshift : 0))
  const unsigned voffs = (unsigned)(sr * ldk + sc) * 2u, kroffs = (unsigned)(rr_ * 32 + rc_) * 2u;
#define SLOAD(i, j) do { const size_t kr0_ = KROW(j); const char* vb_ = (const char*)(Vp + kr0_ * ldk); const char* kb_ = (const char*)(Kp + kr0_ * ldk); \
    st_[i].v = *reinterpret_cast<const bf16x8*>(vb_ + voffs); st_[i].k = *reinterpret_cast<const bf16x8*>(kb_ + voffs); \
    if (KIND == 0) { const char* rb_ = (const char*)(KRp + kr0_ * 32); st_[i].kr = *reinterpret_cast<const bf16x8*>(rb_ + kroffs); } } while (0)
#define SWRITE(bf, i) do { *(bf16x8*)(V_lds + (bf) * SHM_V + vst) = st_[i].v; *(bf16x8*)(K_lds + (bf) * SHM_K + kst) = st_[i].k; \
    if (KIND == 0) { if (tid < 256) *(bf16x8*)(K_lds + (bf) * SHM_K + krst) = st_[i].kr; } } while (0)
#define SWAIT() do { if (LPT == 3) asm volatile("s_waitcnt vmcnt(3)" ::: "memory"); else asm volatile("s_waitcnt vmcnt(2)" ::: "memory"); } while (0)
#define RESC(a) do { if (__any((a) < 1.f)) { if (hi == 0) al_l[r32] = (a); asm volatile("s_waitcnt lgkmcnt(0)" ::: "memory"); \
    _Pragma("unroll") for (int d = 0; d < 2; ++d) _Pragma("unroll") for (int r = 0; r < 16; ++r) o[d][r] *= al_l[crow(r, hi)]; } } while (0)
#define AMASK(P0, P1, j) do { if (KIND == 1) { if (domask && (j) >= 4) { const int tq_ = q0 + wid * 32 + r32; const int tk_ = kshift + ((j) - 4) * 64 + 4 * hi; \
    _Pragma("unroll") for (int r = 0; r < 16; ++r) { const int d_ = tq_ - (tk_ + (r & 3) + 8 * (r >> 2)); if (d_ > 128 || d_ < -128) P0[r] = -INFINITY; if (d_ - 32 > 128 || d_ - 32 < -128) P1[r] = -INFINITY; } } } } while (0)
  if (__builtin_amdgcn_readfirstlane(wid) >= 4) __builtin_amdgcn_s_setprio(1);
  f32x16 pA0, pA1, pB0, pB1; float alA, alB; bf16x8 pa0, pa1, pa2, pa3;
  const int wq0_ = q0 + __builtin_amdgcn_readfirstlane(wid) * 32;
#define TACT(j) (KIND != 1 || !domask || (j) < 4 || (kshift + ((j) - 4) * 64 + 63 >= wq0_ - 128 && kshift + ((j) - 4) * 64 <= wq0_ + 31 + 128))
  bool actA, actB;
  SLOAD(0, 0); asm volatile("s_waitcnt vmcnt(0)" ::: "memory"); SWRITE(0, 0); __syncthreads();
  actA = true; qkt2<DQK>(pA0, pA1, K_lds, qr, negm, r32, hi); AMASK(pA0, pA1, 0); psm2q<true>(pA0, pA1, mhat, negm, alA, lsum);
  SLOAD(0, 1);
  SWRITE(1, 0); __syncthreads();
  for (int j = 1; j + 1 < NT; j += 2) {
    actB = TACT(j);
    SBAR(); if (actB) qkt2<DQK>(pB0, pB1, K_lds + SHM_K, qr, negm, r32, hi);
    if (actA) fsm2q(pA0, pA1, pa0, pa1, pa2, pa3, lsum); SBAR();
    SLOAD(0, j + 1); SBAR();
    if (actA) pv_all2q(o, vb0, pa0, pa1, pa2, pa3); if (actB) { AMASK(pB0, pB1, j); psm2q<false>(pB0, pB1, mhat, negm, alB, lsum); } else alB = 1.f;
    __syncthreads(); SWRITE(0, 0);
    RESC(alB); __syncthreads();
    actA = TACT(j + 1);
    SBAR(); if (actA) qkt2<DQK>(pA0, pA1, K_lds, qr, negm, r32, hi);
    if (actB) fsm2q(pB0, pB1, pa0, pa1, pa2, pa3, lsum); SBAR();
    SLOAD(0, j + 2); SBAR();
    if (actB) pv_all2q(o, vb0 + SHM_V, pa0, pa1, pa2, pa3); if (actA) { AMASK(pA0, pA1, j + 1); psm2q<false>(pA0, pA1, mhat, negm, alA, lsum); } else alA = 1.f;
    __syncthreads(); SWRITE(1, 0);
    RESC(alA); __syncthreads();
  }
  actB = TACT(NT - 1);
  SBAR(); if (actB) qkt2<DQK>(pB0, pB1, K_lds + SHM_K, qr, negm, r32, hi);
  if (actA) fsm2q(pA0, pA1, pa0, pa1, pa2, pa3, lsum); SBAR();
  if (actA) pv_all2q(o, vb0, pa0, pa1, pa2, pa3); if (actB) { AMASK(pB0, pB1, NT - 1); psm2q<false>(pB0, pB1, mhat, negm, alB, lsum); } else alB = 1.f;
  __syncthreads(); RESC(alB);
  if (actB) { fsm2q(pB0, pB1, pa0, pa1, pa2, pa3, lsum); SBAR();
    pv_all2q(o, vb0 + SHM_V, pa0, pa1, pa2, pa3); }
  __builtin_amdgcn_s_setprio(0);
  const int lanee = TIDX & 63, r32e = lanee & 31, hie = lanee >> 5;
  float rli[16];
  { auto rr = __builtin_amdgcn_permlane32_swap(__float_as_uint(lsum), __float_as_uint(lsum), false, false); lsum = __uint_as_float(rr[0]) + __uint_as_float(rr[1]); }
  if (hie == 0) { al_l[r32e] = lsum; if (KIND == 1) li_l[r32e] = mhat; } asm volatile("s_waitcnt lgkmcnt(0)" ::: "memory");
  if (KIND == 1) { const float sk2 = p.sink[l * 8 + hd] * LOG2E;
#pragma unroll
    for (int r = 0; r < 16; ++r) rli[r] = __builtin_amdgcn_rcpf(al_l[crow(r, hie)] + __builtin_amdgcn_exp2f(sk2 - li_l[crow(r, hie)])); }
  else {
#pragma unroll
    for (int r = 0; r < 16; ++r) rli[r] = __builtin_amdgcn_rcpf(al_l[crow(r, hie)]); }
  bf16_t* Ow = (bf16_t*)(p.ws + OFF_R + R_H) + (rowq0 + wid * 32) * DM + ocol;
#pragma unroll
  for (int r = 0; r < 16; ++r) { const int orow = crow(r, hie);
#pragma unroll
    for (int d0 = 0; d0 < 2; ++d0) Ow[(size_t)orow * DM + d0 * 32 + r32e] = f2bf(o[d0][r] * rli[r]); }
  __syncthreads();
#undef KROW
#undef SLOAD
#undef SWRITE
#undef SWAIT
#undef RESC
#undef AMASK
#undef TACT
}
#ifdef DBG_ATTN_PROBE
template <int KIND, int VAR>
__device__ __forceinline__ void attn_probe_unit(const Prm& p, int l, bool isctx, int b, int hd, int qb, unsigned char* ldsu) {
  constexpr int DQK = KIND == 0 ? 96 : 64, KST = DQK * 2 + 16, SHM_K = 64 * KST, SHM_V = 8192, LPT = KIND == 0 ? 3 : 2;
  char* lds = (char*)ldsu;
  const int tid = TIDX, wid = tid >> 6, lane = tid & 63, r32 = lane & 31, hi = lane >> 5;
  char* V_lds = lds; char* K_lds = lds + 2 * SHM_V;
  float* ws = (float*)(lds + 2 * SHM_V + 2 * SHM_K) + wid * 64; float* li_l = ws; float* al_l = ws + 32;
  const int q0 = qb * 256;
  const size_t rowq0 = (size_t)b * TT + (isctx ? 0 : LC) + q0;
  const bf16_t *Qp, *Kp, *Vp; const bf16_t* KRp = WSP(bf16_t, OFF_KR); int ldq, ldk; int ocol;
  if (KIND == 0) { Qp = (const bf16_t*)(p.ws + OFF_R + R_QB) + hd * 96; ldq = NQB; Kp = (const bf16_t*)(p.ws + OFF_R + R_KB) + hd * 64; Vp = (const bf16_t*)(p.ws + OFF_R + R_VB) + hd * 64; ldk = 512; ocol = 512 + hd * 64; }
  else { Qp = (const bf16_t*)(p.ws + OFF_R + R_QA) + hd * 64; ldq = 512; Kp = (const bf16_t*)(p.ws + OFF_R + R_KA) + (hd >> 2) * 64; Vp = (const bf16_t*)(p.ws + OFF_R + R_VA) + (hd >> 2) * 64; ldk = 128; ocol = hd * 64; }
  int NT, kshift = 0; bool domask = false;
  if (isctx) NT = 4; else if (KIND == 0) NT = TT / 64; else { const int ks = max(0, q0 - 128), ke = min(SEQ, q0 + 384); NT = 4 + (ke - ks) / 64; kshift = ks; domask = true; }
  const size_t kb0 = (size_t)b * TT;
  float mhat = 0.f; f32x16 o[3] = {}; f32x16 negm = {}; bf16x8 qr[DQK / 16];
  { const bf16_t* Qw = Qp + (rowq0 + wid * 32 + r32) * ldq + hi * 8;
#pragma unroll
    for (int d0 = 0; d0 < DQK / 16; ++d0) qr[d0] = *reinterpret_cast<const bf16x8*>(Qw + d0 * 16); }
  const int sr = tid >> 3, sc = (tid & 7) * 8, vst = v_st_p(sr, sc), kst = sr * KST + sc * 2;
  const int rr_ = (tid & 255) >> 2, rc_ = (tid & 3) * 8, krst = rr_ * KST + 128 + rc_ * 2;
  const int vb0 = (int)(uintptr_t)V_lds + v_rd_base_p(lane);
  struct { bf16x8 v, k, kr; } st_[1];
#define KROW(j) (kb0 + (size_t)(j) * 64 + ((j) >= 4 ? kshift : 0))
#define SLOAD(i, j) do { if (VAR & 4) break; const size_t kr0_ = KROW(j); st_[i].v = *reinterpret_cast<const bf16x8*>(Vp + (kr0_ + sr) * ldk + sc); st_[i].k = *reinterpret_cast<const bf16x8*>(Kp + (kr0_ + sr) * ldk + sc); \
    if (KIND == 0) st_[i].kr = *reinterpret_cast<const bf16x8*>(KRp + (kr0_ + rr_) * 32 + rc_); } while (0)
#define SWRITE(bf, i) do { if (VAR & 4) break; *(bf16x8*)(V_lds + (bf) * SHM_V + vst) = st_[i].v; *(bf16x8*)(K_lds + (bf) * SHM_K + kst) = st_[i].k; \
    if (KIND == 0) { if (tid < 256) *(bf16x8*)(K_lds + (bf) * SHM_K + krst) = st_[i].kr; } } while (0)
#define SWAIT() do { if (LPT == 3) asm volatile("s_waitcnt vmcnt(3)" ::: "memory"); else asm volatile("s_waitcnt vmcnt(2)" ::: "memory"); } while (0)
#define RESC(a) do { if (__any((a) < 1.f)) { if (hi == 0) al_l[r32] = (a); asm volatile("s_waitcnt lgkmcnt(0)" ::: "memory"); \
    _Pragma("unroll") for (int d = 0; d < 3; ++d) _Pragma("unroll") for (int r = 0; r < 16; ++r) o[d][r] *= al_l[crow(r, hi)]; } } while (0)
#define AMASK(P0, P1, j) do { if (KIND == 1) { if (domask && (j) >= 4) { const int tq_ = q0 + wid * 32 + r32; const int tk_ = kshift + ((j) - 4) * 64 + 4 * hi; \
    _Pragma("unroll") for (int r = 0; r < 16; ++r) { const int d_ = tq_ - (tk_ + (r & 3) + 8 * (r >> 2)); if (d_ > 128 || d_ < -128) P0[r] = -INFINITY; if (d_ - 32 > 128 || d_ - 32 < -128) P1[r] = -INFINITY; } } } } while (0)
  f32x16 pA0, pA1, pB0, pB1; float alA, alB; bf16x8 pa0, pa1, pa2, pa3;
  const int wq0_ = q0 + __builtin_amdgcn_readfirstlane(wid) * 32;
#define TACT(j) (KIND != 1 || !domask || (j) < 4 || (kshift + ((j) - 4) * 64 + 63 >= wq0_ - 128 && kshift + ((j) - 4) * 64 <= wq0_ + 31 + 128))
  bool actA, actB;
  SLOAD(0, 0); asm volatile("s_waitcnt vmcnt(0)" ::: "memory"); SWRITE(0, 0); do { if (!(VAR & 1)) __syncthreads(); } while (0);
  do { if (!(VAR & 16)) qkt2<DQK>(pA0, pA1, K_lds, qr, negm, r32, hi); else { pA0 = negm; pA1 = negm; asm volatile("" : "+v"(pA0), "+v"(pA1)); } } while (0); AMASK(pA0, pA1, 0); do { if (!(VAR & 2)) psm2<true>(pA0, pA1, mhat, negm, alA); else alA = 1.f; } while (0);
  SLOAD(0, 1);
  SWRITE(1, 0); do { if (!(VAR & 1)) __syncthreads(); } while (0);
  for (int j = 1; j + 1 < NT; j += 2) {
    SBAR(); do { if (!(VAR & 16)) qkt2<DQK>(pB0, pB1, K_lds + SHM_K, qr, negm, r32, hi); else { pB0 = negm; pB1 = negm; asm volatile("" : "+v"(pB0), "+v"(pB1)); } } while (0);
    do { if (!(VAR & 2)) fsm2p(pA0, pA1, pa0, pa1, pa2, pa3); else { pa0 = __builtin_bit_cast(bf16x8, (f32x4){pA0[0], pA0[1], pA0[2], pA0[3]}); pa1 = __builtin_bit_cast(bf16x8, (f32x4){pA0[4], pA0[5], pA0[6], pA0[7]}); pa2 = __builtin_bit_cast(bf16x8, (f32x4){pA1[0], pA1[1], pA1[2], pA1[3]}); pa3 = __builtin_bit_cast(bf16x8, (f32x4){pA1[4], pA1[5], pA1[6], pA1[7]}); } } while (0); SBAR();
    SLOAD(0, j + 1); SBAR();
    do { if (!(VAR & 8)) pv_all2p(o, vb0, pa0, pa1, pa2, pa3); else { asm volatile("" :: "v"(pa0), "v"(pa1), "v"(pa2), "v"(pa3)); } } while (0); AMASK(pB0, pB1, j); do { if (!(VAR & 2)) psm2<false>(pB0, pB1, mhat, negm, alB); else alB = 1.f; } while (0);
    do { if (!(VAR & 1)) __syncthreads(); } while (0); SWRITE(0, 0);
    RESC(alB); do { if (!(VAR & 1)) __syncthreads(); } while (0);
    SBAR(); do { if (!(VAR & 16)) qkt2<DQK>(pA0, pA1, K_lds, qr, negm, r32, hi); else { pA0 = negm; pA1 = negm; asm volatile("" : "+v"(pA0), "+v"(pA1)); } } while (0);
    do { if (!(VAR & 2)) fsm2p(pB0, pB1, pa0, pa1, pa2, pa3); else { pa0 = __builtin_bit_cast(bf16x8, (f32x4){pB0[0], pB0[1], pB0[2], pB0[3]}); pa1 = __builtin_bit_cast(bf16x8, (f32x4){pB0[4], pB0[5], pB0[6], pB0[7]}); pa2 = __builtin_bit_cast(bf16x8, (f32x4){pB1[0], pB1[1], pB1[2], pB1[3]}); pa3 = __builtin_bit_cast(bf16x8, (f32x4){pB1[4], pB1[5], pB1[6], pB1[7]}); } } while (0); SBAR();
    SLOAD(0, j + 2); SBAR();
    do { if (!(VAR & 8)) pv_all2p(o, vb0 + SHM_V, pa0, pa1, pa2, pa3); else { asm volatile("" :: "v"(pa0), "v"(pa1), "v"(pa2), "v"(pa3)); } } while (0); AMASK(pA0, pA1, j + 1); do { if (!(VAR & 2)) psm2<false>(pA0, pA1, mhat, negm, alA); else alA = 1.f; } while (0);
    do { if (!(VAR & 1)) __syncthreads(); } while (0); SWRITE(1, 0);
    RESC(alA); do { if (!(VAR & 1)) __syncthreads(); } while (0);
  }
  SBAR(); do { if (!(VAR & 16)) qkt2<DQK>(pB0, pB1, K_lds + SHM_K, qr, negm, r32, hi); else { pB0 = negm; pB1 = negm; asm volatile("" : "+v"(pB0), "+v"(pB1)); } } while (0);
  do { if (!(VAR & 2)) fsm2p(pA0, pA1, pa0, pa1, pa2, pa3); else { pa0 = __builtin_bit_cast(bf16x8, (f32x4){pA0[0], pA0[1], pA0[2], pA0[3]}); pa1 = __builtin_bit_cast(bf16x8, (f32x4){pA0[4], pA0[5], pA0[6], pA0[7]}); pa2 = __builtin_bit_cast(bf16x8, (f32x4){pA1[0], pA1[1], pA1[2], pA1[3]}); pa3 = __builtin_bit_cast(bf16x8, (f32x4){pA1[4], pA1[5], pA1[6], pA1[7]}); } } while (0); SBAR();
  do { if (!(VAR & 8)) pv_all2p(o, vb0, pa0, pa1, pa2, pa3); else { asm volatile("" :: "v"(pa0), "v"(pa1), "v"(pa2), "v"(pa3)); } } while (0); AMASK(pB0, pB1, NT - 1); do { if (!(VAR & 2)) psm2<false>(pB0, pB1, mhat, negm, alB); else alB = 1.f; } while (0);
  do { if (!(VAR & 1)) __syncthreads(); } while (0); RESC(alB);
  do { if (!(VAR & 2)) fsm2p(pB0, pB1, pa0, pa1, pa2, pa3); else { pa0 = __builtin_bit_cast(bf16x8, (f32x4){pB0[0], pB0[1], pB0[2], pB0[3]}); pa1 = __builtin_bit_cast(bf16x8, (f32x4){pB0[4], pB0[5], pB0[6], pB0[7]}); pa2 = __builtin_bit_cast(bf16x8, (f32x4){pB1[0], pB1[1], pB1[2], pB1[3]}); pa3 = __builtin_bit_cast(bf16x8, (f32x4){pB1[4], pB1[5], pB1[6], pB1[7]}); } } while (0); SBAR();
  do { if (!(VAR & 8)) pv_all2p(o, vb0 + SHM_V, pa0, pa1, pa2, pa3); else { asm volatile("" :: "v"(pa0), "v"(pa1), "v"(pa2), "v"(pa3)); } } while (0);
  float rli[16];
  if (KIND == 1) { if (hi == 0) li_l[r32] = mhat; asm volatile("s_waitcnt lgkmcnt(0)" ::: "memory"); const float sk2 = p.sink[l * 8 + hd] * LOG2E;
#pragma unroll
    for (int r = 0; r < 16; ++r) rli[r] = __builtin_amdgcn_rcpf(o[2][r] + __builtin_amdgcn_exp2f(sk2 - li_l[crow(r, hi)])); }
  else {
#pragma unroll
    for (int r = 0; r < 16; ++r) rli[r] = __builtin_amdgcn_rcpf(o[2][r]); }
  bf16_t* Ow = (bf16_t*)(p.ws + OFF_R + R_CQ) + ((rowq0 + wid * 32) & 16383) * DM + ocol;
#pragma unroll
  for (int r = 0; r < 16; ++r) { const int orow = crow(r, hi);
#pragma unroll
    for (int d0 = 0; d0 < 2; ++d0) Ow[(size_t)orow * DM + d0 * 32 + r32] = f2bf(o[d0][r] * rli[r]); }
  do { if (!(VAR & 1)) __syncthreads(); } while (0);
#undef KROW
#undef SLOAD
#undef SWRITE
#undef SWAIT
#undef RESC
#undef AMASK
#undef TACT
}

template <int VAR>
__device__ __forceinline__ void ph_attn_probe(const Prm& p, int l, unsigned char* lds, int bid, int nb) {
  const int nrounds = (1024 + nb - 1) / nb;
  for (int rd = 0; rd < nrounds; ++rd) { const int pair = rd * 8 + (bid & 7), qb = bid >> 3, u = pair * 32 + qb;
    if (u < 1024) attn_probe_unit<0, VAR>(p, l, false, u >> 8, (u >> 5) & 7, u & 31, lds); }
}
#endif
template <int KIND>
__device__ __forceinline__ void attn_fast_unit3(const Prm& p, int l, bool isctx, int b, int hd, int qb, unsigned char* ldsu) {
  constexpr int DQK = KIND == 0 ? 96 : 64, KST = DQK * 2 + 16, SHM_K = 64 * KST, SHM_V = 8192, LPT = KIND == 0 ? 3 : 2;
  char* lds = (char*)ldsu;
  const int tid = TIDX, wid = tid >> 6, lane = tid & 63, r32 = lane & 31, hi = lane >> 5;
  char* V_lds = lds; char* K_lds = lds + 3 * SHM_V;
  float* ws = (float*)(lds + 3 * SHM_V + 3 * SHM_K) + wid * 64; float* li_l = ws; float* al_l = ws + 32;
  const int q0 = qb * 256;
  const size_t rowq0 = (size_t)b * TT + (isctx ? 0 : LC) + q0;
  const bf16_t *Qp, *Kp, *Vp; const bf16_t* KRp = WSP(bf16_t, OFF_KR); int ldq, ldk; int ocol;
  if (KIND == 0) { Qp = (const bf16_t*)(p.ws + OFF_R + R_QB) + hd * 96; ldq = NQB; Kp = (const bf16_t*)(p.ws + OFF_R + R_KB) + hd * 64; Vp = (const bf16_t*)(p.ws + OFF_R + R_VB) + hd * 64; ldk = 512; ocol = 512 + hd * 64; }
  else { Qp = (const bf16_t*)(p.ws + OFF_R + R_QA) + hd * 64; ldq = 512; Kp = (const bf16_t*)(p.ws + OFF_R + R_KA) + (hd >> 2) * 64; Vp = (const bf16_t*)(p.ws + OFF_R + R_VA) + (hd >> 2) * 64; ldk = 128; ocol = hd * 64; }
  int NT, kshift = 0; bool domask = false;
  if (isctx) NT = 4; else if (KIND == 0) NT = TT / 64; else { const int ks = max(0, q0 - 128), ke = min(SEQ, q0 + 384); NT = 4 + (ke - ks) / 64; kshift = ks; domask = true; }
  const size_t kb0 = (size_t)b * TT;
  float mhat = 0.f; f32x16 o[3] = {}; f32x16 negm = {}; bf16x8 qr[DQK / 16];
  { const bf16_t* Qw = Qp + (rowq0 + wid * 32 + r32) * ldq + hi * 8;
#pragma unroll
    for (int d0 = 0; d0 < DQK / 16; ++d0) qr[d0] = *reinterpret_cast<const bf16x8*>(Qw + d0 * 16); }
  const int sr = tid >> 3, sc = (tid & 7) * 8, vst = v_st(sr, sc), kst = sr * KST + sc * 2;
  const int rr_ = (tid & 255) >> 2, rc_ = (tid & 3) * 8, krst = rr_ * KST + 128 + rc_ * 2;
  const int vb0 = (int)(uintptr_t)V_lds + v_rd_base(lane);
  struct { bf16x8 v, k, kr; } st_[1];
#define KROW(j) (kb0 + (size_t)(j) * 64 + ((j) >= 4 ? kshift : 0))
#define SLOAD(i, j) do { const size_t kr0_ = KROW(j); st_[i].v = *reinterpret_cast<const bf16x8*>(Vp + (kr0_ + sr) * ldk + sc); st_[i].k = *reinterpret_cast<const bf16x8*>(Kp + (kr0_ + sr) * ldk + sc); \
    if (KIND == 0) st_[i].kr = *reinterpret_cast<const bf16x8*>(KRp + (kr0_ + rr_) * 32 + rc_); } while (0)
#define SWRITE(bf, i) do { *(bf16x8*)(V_lds + (bf) * SHM_V + vst) = st_[i].v; *(bf16x8*)(K_lds + (bf) * SHM_K + kst) = st_[i].k; \
    if (KIND == 0) { if (tid < 256) *(bf16x8*)(K_lds + (bf) * SHM_K + krst) = st_[i].kr; } } while (0)
#define SWAIT() do { if (LPT == 3) asm volatile("s_waitcnt vmcnt(3)" ::: "memory"); else asm volatile("s_waitcnt vmcnt(2)" ::: "memory"); } while (0)
#define RESC(a) do { if (__any((a) < 1.f)) { if (hi == 0) al_l[r32] = (a); asm volatile("s_waitcnt lgkmcnt(0)" ::: "memory"); \
    _Pragma("unroll") for (int d = 0; d < 3; ++d) _Pragma("unroll") for (int r = 0; r < 16; ++r) o[d][r] *= al_l[crow(r, hi)]; } } while (0)
#define AMASK(P0, P1, j) do { if (KIND == 1) { if (domask && (j) >= 4) { const int tq_ = q0 + wid * 32 + r32; const int tk_ = kshift + ((j) - 4) * 64 + 4 * hi; \
    _Pragma("unroll") for (int r = 0; r < 16; ++r) { const int d_ = tq_ - (tk_ + (r & 3) + 8 * (r >> 2)); if (d_ > 128 || d_ < -128) P0[r] = -INFINITY; if (d_ - 32 > 128 || d_ - 32 < -128) P1[r] = -INFINITY; } } } } while (0)
  f32x16 pA0, pA1, pB0, pB1; float alA, alB; bf16x8 pa0, pa1, pa2, pa3;
  SLOAD(0, 0); SWRITE(0, 0); SLOAD(0, 1); SWRITE(1, 0); __syncthreads();
  qkt2<DQK>(pA0, pA1, K_lds, qr, negm, r32, hi); AMASK(pA0, pA1, 0); psm2<true>(pA0, pA1, mhat, negm, alA);
  int r0 = 0, r1 = 1, r2 = 2;
#define ITER(PP0, PP1, PC0, PC1, ALC, j) do { \
    if ((j) + 2 < NT) SLOAD(0, (j) + 2); \
    SBAR(); qkt2<DQK>(PC0, PC1, K_lds + r1 * SHM_K, qr, negm, r32, hi); \
    fsm2(PP0, PP1, pa0, pa1, pa2, pa3); SBAR(); \
    pv_all2(o, vb0 + r0 * SHM_V, pa0, pa1, pa2, pa3); AMASK(PC0, PC1, (j) + 1); psm2<false>(PC0, PC1, mhat, negm, ALC); \
    RESC(ALC); \
    if ((j) + 2 < NT) SWRITE(r2, 0); \
    __syncthreads(); \
    { const int t_ = r0; r0 = r1; r1 = r2; r2 = t_; } } while (0)
  int j = 0;
  for (; j + 2 < NT; j += 2) { ITER(pA0, pA1, pB0, pB1, alB, j); ITER(pB0, pB1, pA0, pA1, alA, j + 1); }
  ITER(pA0, pA1, pB0, pB1, alB, j);
  fsm2(pB0, pB1, pa0, pa1, pa2, pa3); SBAR();
  pv_all2(o, vb0 + r0 * SHM_V, pa0, pa1, pa2, pa3);
#undef ITER
  float rli[16];
  if (KIND == 1) { if (hi == 0) li_l[r32] = mhat; asm volatile("s_waitcnt lgkmcnt(0)" ::: "memory"); const float sk2 = p.sink[l * 8 + hd] * LOG2E;
#pragma unroll
    for (int r = 0; r < 16; ++r) rli[r] = __builtin_amdgcn_rcpf(o[2][r] + __builtin_amdgcn_exp2f(sk2 - li_l[crow(r, hi)])); }
  else {
#pragma unroll
    for (int r = 0; r < 16; ++r) rli[r] = __builtin_amdgcn_rcpf(o[2][r]); }
  bf16_t* Ow = (bf16_t*)(p.ws + OFF_R + R_H) + (rowq0 + wid * 32) * DM + ocol;
#pragma unroll
  for (int r = 0; r < 16; ++r) { const int orow = crow(r, hi);
#pragma unroll
    for (int d0 = 0; d0 < 2; ++d0) Ow[(size_t)orow * DM + d0 * 32 + r32] = f2bf(o[d0][r] * rli[r]); }
  __syncthreads();
#undef KROW
#undef SLOAD
#undef SWRITE
#undef SWAIT
#undef RESC
#undef AMASK
}
#ifndef ATTN_V2
#define ATTN_V2 1
#endif
#ifndef ATTN_V3
#define ATTN_V3 0
#endif
#ifndef ATTN_V2P
#define ATTN_V2P 1
#endif
#if ATTN_V2P
#define ATTN_UNIT attn_fast_unit2p
#elif ATTN_V3
#define ATTN_UNIT attn_fast_unit3
#elif ATTN_V2
#define ATTN_UNIT attn_fast_unit2
#else
#define ATTN_UNIT attn_fast_unit
#endif
__device__ __forceinline__ void ph_attn_fast(const Prm& p, int l, unsigned char* lds, int bid, int nb) {
  const int nrounds = (1024 + nb - 1) / nb;
  for (int rd = 0; rd < nrounds; ++rd) { int u;
    if ((nb & 7) == 0 && (nb >> 3) == 32) { const int pair = rd * 8 + (bid & 7), qb = bid >> 3; u = pair * 32 + qb; } else u = rd * nb + bid;
    if (u < 1024) ATTN_UNIT<0>(p, l, false, u >> 8, (u >> 5) & 7, u & 31, lds); }
  for (int rd = 0; rd < nrounds; ++rd) { int u;
    if ((nb & 7) == 0 && (nb >> 3) == 32) { const int pair = rd * 8 + (bid & 7), qb = bid >> 3; u = pair * 32 + qb; } else u = rd * nb + bid;
    if (u < 1024) ATTN_UNIT<1>(p, l, false, u >> 8, (u >> 5) & 7, u & 31, lds); }
  if (l != DEPTH - 1) for (int u = bid; u < 64; u += nb) { const int kind = u & 1, hd = (u >> 1) & 7, b = u >> 4;
      if (kind == 0) ATTN_UNIT<0>(p, l, true, b, hd, 0, lds); else ATTN_UNIT<1>(p, l, true, b, hd, 0, lds); }
}

#define XB_TMO      128
#define XB_XCNT(j)  (256  + 64 * (j))
#define XB_XSUB(j)  (1280 + 64 * (j))
#define XB_XGEN(j)  (2304 + 64 * (j))
#define XB_TOP      3328
#define XB_TOPGEN   3392
#define XCD_BAR_WORDS 3456
#define XB_SPIN_CAP (1u << 22)
#define LAS __attribute__((address_space(3)))
__device__ __forceinline__ unsigned xb_ld(unsigned* p)              { return __hip_atomic_load(p, __ATOMIC_RELAXED, __HIP_MEMORY_SCOPE_AGENT); }
__device__ __forceinline__ unsigned xb_add(unsigned* p, unsigned v) { return __hip_atomic_fetch_add(p, v, __ATOMIC_RELAXED, __HIP_MEMORY_SCOPE_AGENT); }
__device__ __forceinline__ unsigned xb_xcc_id() { return (unsigned)__builtin_amdgcn_s_getreg((3 << 11) | 20) & 0xFu; }
#define XB_SPIN(cond, bar) do { unsigned _sp = 0; while (cond) { __builtin_amdgcn_s_sleep(1); \
    if ((++_sp & 255u) == 0u) { if (xb_ld(&(bar)[XB_TMO])) break; if (_sp > XB_SPIN_CAP) { atomicAdd(&(bar)[XB_TMO], 1u); break; } } } } while (0)
struct XcdBarrier { unsigned* bar; unsigned x; volatile LAS unsigned* st; };
__device__ __forceinline__ XcdBarrier xcd_barrier_post(unsigned* bar, volatile LAS unsigned* st) {
    XcdBarrier b; b.bar = bar; b.x = xb_xcc_id(); b.st = st;
    if (TIDX == 0) (void)xb_add(&bar[XB_XCNT(b.x)], 1u);
    return b;
}
__device__ __forceinline__ void xcd_barrier_complete(unsigned* bar, unsigned x, unsigned& nloc, unsigned& nx) {
    const unsigned G = gridDim.x * gridDim.y * gridDim.z;
    unsigned sum, cnt, mine, sp = 0u;
    for (;;) {
        sum = 0u; cnt = 0u; mine = 0u;
#pragma unroll
        for (unsigned j = 0; j < 16; ++j) { const unsigned c = xb_ld(&bar[XB_XCNT(j)]); sum += c; cnt += (c > 0u) ? 1u : 0u; mine = (j == x) ? c : mine; }
        if (sum == G) break;
        __builtin_amdgcn_s_sleep(1);
        if ((++sp & 255u) == 0u) { if (xb_ld(&bar[XB_TMO])) break; if (sp > XB_SPIN_CAP) { atomicAdd(&bar[XB_TMO], 1u); break; } }
    }
    nloc = mine > 0u ? mine : 1u; nx = cnt > 0u ? cnt : 1u;
}
__device__ __forceinline__ void xcd_barrier(const XcdBarrier& b) {
    asm volatile("s_waitcnt vmcnt(0)" ::: "memory");
    __syncthreads();
    if (TIDX == 0) {
        unsigned* bar = b.bar;
        __builtin_amdgcn_s_waitcnt(0);
        unsigned nloc = b.st[0], nx = b.st[1];
        if (nloc == 0u) { xcd_barrier_complete(bar, b.x, nloc, nx); b.st[0] = nloc; b.st[1] = nx; }
        const unsigned old = xb_add(&bar[XB_XSUB(b.x)], 1u);
        const unsigned gen = old / nloc;
        if (old + 1u == (gen + 1u) * nloc) {
            __builtin_amdgcn_fence(__ATOMIC_RELEASE, "agent");
            asm volatile("s_waitcnt vmcnt(0)" ::: "memory");
            const unsigned og = xb_add(&bar[XB_TOP], 1u);
            const unsigned tg = og / nx;
            if (og + 1u == (tg + 1u) * nx) xb_add(&bar[XB_TOPGEN], 1u);
            else XB_SPIN(xb_ld(&bar[XB_TOPGEN]) == tg, bar);
            __builtin_amdgcn_fence(__ATOMIC_ACQUIRE, "agent");
            xb_add(&bar[XB_XGEN(b.x)], 1u);
            asm volatile("s_waitcnt vmcnt(0)" ::: "memory");
        } else {
            XB_SPIN(xb_ld(&bar[XB_XGEN(b.x)]) == gen, bar);
            __builtin_amdgcn_fence(__ATOMIC_ACQUIRE, "agent");
            asm volatile("s_waitcnt vmcnt(0)" ::: "memory");
        }
    }
    __syncthreads();
}

constexpr int NPHASE = 22;
__device__ __forceinline__ void run_phase1(const Prm& p, int ph, unsigned char* lds, int bid, int nb) {
  if (ph == 0) { ph_mod(p, 0, lds, bid, nb); ph_wconv_dense(p, 0, lds, bid, nb); return; }
  if (ph == 21) { ph_final(p, bid, nb); return; }
  const int alt = ph >= 100 ? 10 : 0; if (alt) ph -= 100;
  const int l = (ph - 1) / 10, s = (ph - 1) % 10 + alt;
  switch (s) {
    case 0: ph_norm_a(p, l, bid, nb); break;
#if FAST_GEMM
#if !defined(DBG_ONLY) || DBG_ONLY == 1
    case 1: ph2_gemm_in(p, l, lds, bid, nb); break;
#endif
#if !defined(DBG_ONLY) || DBG_ONLY == 2
    case 2: ph2_gemm_qup(p, l, lds, bid, nb); ph2_gemm_kvup(p, l, lds, bid, nb); break;
#endif
#if !defined(DBG_ONLY) || DBG_ONLY == 3
    case 3: break;
#endif
#else
    case 1: ph_gemm_in(p, l, bid, nb); break;
    case 2: ph_ssq(p, bid, nb); break;
    case 3: ph_gemm_up(p, l, bid, nb); break;
#endif
#if FAST_ATTN
    case 4: ph_attn_fast(p, l, lds, bid, nb); break;
#else
    case 4: ph_attn_naive(p, l, lds, bid, nb); break;
#endif
#if FAST_GEMM
#if !defined(DBG_ONLY) || DBG_ONLY == 5
    case 5: ph2_gemm_out(p, l, lds, bid, nb); break;
#endif
#else
    case 5: ph_gemm_out(p, l, bid, nb); break;
#endif
    case 6: ph_norm_b<true>(p, l, lds, bid, nb); break;
#ifdef DBG_NB
    case 16: ph_norm_b<false>(p, l, lds, bid, nb); break;
#endif
#ifdef DBG_ATTN_PROBE
    case 14: ph_attn_probe<DBG_ATTN_PROBE>(p, l, lds, bid, nb); break;
#endif
    case 7: ph_topk(p, l, lds, bid, nb); break;
#if FAST_GEMM
#if !defined(DBG_ONLY) || DBG_ONLY == 8
    case 8: ph2_moe_up(p, l, lds, bid, nb); break;
#endif
#if !defined(DBG_ONLY) || DBG_ONLY == 9
    case 9: ph2_moe_down(p, l, lds, bid, nb); break;
#endif
#else
    case 8: ph_moe_up(p, l, bid, nb); break;
    case 9: ph_moe_down(p, l, bid, nb); break;
#endif
  }
}

#ifndef DBG_TWICE
#define DBG_TWICE 0
#endif
#ifndef DBG_ALT
#define DBG_ALT 0
#endif
#ifndef DBG_PRE
#define DBG_PRE 0
#endif
__device__ __forceinline__ void run_phase(const Prm& p, int ph, unsigned char* lds, int bid, int nb) {
  if (DBG_PRE) { if (ph >= 1 && ph <= 20 && (ph - 1) % 10 == 0) { run_phase1(p, ph + DBG_PRE, lds, bid, nb); __syncthreads(); } }
  run_phase1(p, ph, lds, bid, nb);
  if (DBG_TWICE) { const int s = ph == 0 ? 10 : (ph == 21 ? 11 : (ph - 1) % 10); if ((DBG_TWICE >> s) & 1) { __syncthreads(); run_phase1(p, ph + DBG_ALT, lds, bid, nb); } }
}
constexpr int LDS_BYTES = FAST_GEMM ? 131072 + 16384 + 128 + 128 : 65536;
#if MK_SPLIT
__global__ void __launch_bounds__(NTHR, 2) k_phase(Prm p, int ph) {
  extern __shared__ __attribute__((aligned(16))) unsigned char lds[];
  run_phase(p, ph, lds, blockIdx.x, gridDim.x);
}
#endif
#if !MK_SPLIT
__global__ void __launch_bounds__(NTHR, 2) k_mega(Prm p) {
  extern __shared__ __attribute__((aligned(16))) unsigned char lds[];
  cg::grid_group grid = cg::this_grid();
  if (p.out == nullptr) grid.sync();
  volatile LAS unsigned* st = (volatile LAS unsigned*)((LAS unsigned char*)lds + 131072 + 16384 + 64);
  if (TIDX < 2) st[TIDX] = 0u;
  if (TIDX < 24) { const int i = TIDX; ((LAS float*)((LAS unsigned char*)lds + ROPE_TAB_OFF))[i] = (i < 16 ? exp2f(-(float)i * (13.287712379549449f / 16.f)) : exp2f(-(float)(i - 16) * (13.287712379549449f / 8.f))) * 0.15915494309189535f; }
  __syncthreads();
  XcdBarrier xb = xcd_barrier_post((unsigned*)(p.ws + OFF_CTL) + 1024, st);
#pragma unroll 1
  for (int ph = 0; ph < NPHASE; ++ph) { int phv = ph; asm volatile("" : "+s"(phv));
    run_phase(p, phv, lds, blockIdx.x, gridDim.x);
    if (ph + 1 < NPHASE && (ph % 10) != 4) xcd_barrier(xb); }
}
#define K_MAIN k_mega
#else
#define K_MAIN k_phase
#endif

extern "C" void kernel_launch(void* const* d_in, const int* in_sizes, int n_in, void* d_out, int out_size, void* d_ws, size_t ws_size, hipStream_t stream) {
  static int grid = 0;
  if (grid == 0) {
    if (n_in != 20 || ws_size < WS_END || out_size != NB * SEQ * DM) { fprintf(stderr, "kernel_launch: bad shapes n_in %d ws %zu (need %zu) out %d\n", n_in, ws_size, (size_t)WS_END, out_size); grid = -1; return; }
    int dev = 0, cus = 0, per = 0;
    (void)hipGetDevice(&dev); (void)hipDeviceGetAttribute(&cus, hipDeviceAttributeMultiprocessorCount, dev);
    (void)hipFuncSetAttribute((const void*)K_MAIN, hipFuncAttributeMaxDynamicSharedMemorySize, LDS_BYTES);
    (void)hipOccupancyMaxActiveBlocksPerMultiprocessor(&per, (const void*)K_MAIN, NTHR, LDS_BYTES);
    if (per < 1) per = 1;
    if (per > 1) per = 1;
    grid = cus * per;
    (void)hipGetLastError();
  }
  if (grid < 0) return;
  Prm p{};
  const float** pf = (const float**)&p;
  for (int i = 0; i < 20; ++i) pf[i] = (const float*)d_in[i];
  p.out = (float*)d_out; p.ws = (unsigned char*)d_ws;
#if MK_SPLIT
  for (int ph = 0; ph < NPHASE; ++ph) hipLaunchKernelGGL(k_phase, dim3(1024), dim3(NTHR), LDS_BYTES, stream, p, ph);
#else
  (void)hipMemsetAsync((char*)d_ws + OFF_CTL, 0, 65536, stream);
  void* args[] = {&p};
  hipError_t e = hipLaunchCooperativeKernel((const void*)k_mega, dim3(grid), dim3(NTHR), args, LDS_BYTES, stream);
  if (e != hipSuccess) fprintf(stderr, "cooperative launch failed: %s (grid %d)\n", hipGetErrorString(e), grid);
#endif
}
```

```cpp
#include <hip/hip_runtime.h>
#include <hip/hip_cooperative_groups.h>
#include <cstdint>
#include <cstdio>
namespace cg = cooperative_groups;

#ifndef MK_SPLIT
#define MK_SPLIT 0
#endif
#ifndef FAST_GEMM
#define FAST_GEMM 1
#endif
#ifndef FAST_ATTN
#define FAST_ATTN 1
#endif

typedef unsigned short bf16_t;
typedef short bf16x8 __attribute__((ext_vector_type(8)));
typedef float f32x4 __attribute__((ext_vector_type(4)));
typedef float f32x16 __attribute__((ext_vector_type(16)));
typedef unsigned u32x4 __attribute__((ext_vector_type(4)));
typedef unsigned u32x2 __attribute__((ext_vector_type(2)));

constexpr int NTHR = 512, NWAVE = 8;
constexpr int NB = 4, SEQ = 8192, LC = 256, TT = SEQ + LC, MR = NB * TT, DM = 1024, DEPTH = 2;
constexpr int NIN = 1440, NINP = 1536, QRK = 384, KVRK = 256, NQB = 768, NKVB = 1024;
constexpr int NE = 16, DFF = 512, CAPL = 1024, CAPC = 32;
constexpr int NSLOT = NB * NE * CAPL + NE * 256;
constexpr float EPS = 1e-6f;
constexpr float LOG2E = 1.4426950408889634f;
constexpr float SCALE_A = 0.125f * LOG2E;
constexpr float SCALE_B = 0.10206207261596575f * LOG2E;

constexpr size_t al256(size_t v) { return (v + 255) / 256 * 256; }
constexpr size_t OFF_CTL = 0;
constexpr size_t OFF_MOD = 1u << 20;
constexpr size_t OFF_ROPE = OFF_MOD + al256((size_t)2 * 5 * 6144 * 4);
constexpr size_t OFF_SSQQ = OFF_ROPE + al256((size_t)(2 * 2048 + 2 * 1024) * 4);
constexpr size_t OFF_SSQK = OFF_SSQQ + al256((size_t)MR * 4);
constexpr size_t OFF_AFF = OFF_SSQK + al256((size_t)MR * 4);
constexpr size_t OFF_INV = OFF_AFF + al256((size_t)MR * 16 * 4);
constexpr size_t OFF_IDX = OFF_INV + al256((size_t)MR * 16 * 4);
constexpr size_t OFF_VAL = OFF_IDX + al256((size_t)NSLOT * 4);
constexpr size_t OFF_KR = OFF_VAL + al256((size_t)NSLOT * 4);
constexpr size_t SZ_WIN = (size_t)NINP * DM * 2, SZ_WQ = (size_t)NQB * QRK * 2, SZ_WKV = (size_t)NKVB * KVRK * 2, SZ_WO = (size_t)DM * DM * 2;
constexpr size_t SZ_WL = SZ_WIN + SZ_WQ + SZ_WKV + SZ_WO;
constexpr size_t OFF_W = OFF_KR + al256((size_t)MR * 32 * 2);
constexpr size_t OFF_WGU = OFF_W + 2 * SZ_WL;
constexpr size_t OFF_WD = OFF_WGU + (size_t)NE * 1024 * 1024 * 2;
constexpr size_t OFF_X = OFF_WD + (size_t)NE * 1024 * 512 * 2;
constexpr size_t OFF_R = OFF_X + (size_t)MR * DM * 4;
constexpr size_t R_H = 0;
constexpr size_t R_QA = R_H + (size_t)MR * DM * 2;
constexpr size_t R_KA = R_QA + (size_t)MR * 512 * 2;
constexpr size_t R_VA = R_KA + (size_t)MR * 128 * 2;
constexpr size_t R_QB = R_VA + (size_t)MR * 128 * 2;
constexpr size_t R_KB = R_QB + (size_t)MR * 768 * 2;
constexpr size_t R_VB = R_KB + (size_t)MR * 512 * 2;
constexpr size_t R_CQ = R_VB + (size_t)MR * 512 * 2;
constexpr size_t R_CKV = R_CQ + (size_t)MR * QRK * 2;
constexpr size_t R_END = R_CKV + (size_t)MR * KVRK * 2;
constexpr size_t R_MIXG = R_QA;
constexpr size_t R_ACT = R_QA;
constexpr size_t R_Y = R_ACT + (size_t)NSLOT * DFF * 2;
static_assert(R_Y + (size_t)NSLOT * DM * 2 <= R_END, "moe overlay fits");
constexpr size_t WS_END = OFF_R + R_END;

struct Prm {
  const float *x, *c, *ctx, *c_ctx, *w_mod, *b_mod, *norm_attn, *norm_ffn, *w_in, *sink, *q_norm, *kv_norm, *w_q_up, *w_kv_up, *w_out, *w_router, *w_gate, *w_up,
      *w_down, *norm_final;
  float* out;
  unsigned char* ws;
};

__device__ __forceinline__ float bf2f(bf16_t v) { return __uint_as_float((unsigned)v << 16); }
__device__ __forceinline__ bf16_t f2bf(float f) { unsigned u = __float_as_uint(f); return (bf16_t)((u + 0x7fffu + ((u >> 16) & 1u)) >> 16); }
__device__ __forceinline__ unsigned pk2(float lo, float hi) { return (unsigned)f2bf(lo) | ((unsigned)f2bf(hi) << 16); }
template <int CTRL> __device__ __forceinline__ float dpp_mov(float x) { return __int_as_float(__builtin_amdgcn_update_dpp(0, __float_as_int(x), CTRL, 0xF, 0xF, true)); }
__device__ __forceinline__ float xor1(float x) { return dpp_mov<0xB1>(x); }
__device__ __forceinline__ float xor2(float x) { return dpp_mov<0x4E>(x); }
__device__ __forceinline__ float hmir(float x) { return dpp_mov<0x141>(x); }
__device__ __forceinline__ float xor8(float x) { return dpp_mov<0x128>(x); }
__device__ __forceinline__ float sum16sw(float x) { auto r = __builtin_amdgcn_permlane16_swap(__float_as_uint(x), __float_as_uint(x), false, false); return __uint_as_float(r[0]) + __uint_as_float(r[1]); }
__device__ __forceinline__ float sum32sw(float x) { auto r = __builtin_amdgcn_permlane32_swap(__float_as_uint(x), __float_as_uint(x), false, false); return __uint_as_float(r[0]) + __uint_as_float(r[1]); }
__device__ __forceinline__ float max16sw(float x) { auto r = __builtin_amdgcn_permlane16_swap(__float_as_uint(x), __float_as_uint(x), false, false); return fmaxf(__uint_as_float(r[0]), __uint_as_float(r[1])); }
__device__ __forceinline__ float max32sw(float x) { auto r = __builtin_amdgcn_permlane32_swap(__float_as_uint(x), __float_as_uint(x), false, false); return fmaxf(__uint_as_float(r[0]), __uint_as_float(r[1])); }
__device__ __forceinline__ float wave_sum(float v) {
  v += xor1(v); v += xor2(v); v += hmir(v); v += xor8(v); v = sum16sw(v); v = sum32sw(v);
  return v;
}
__device__ __forceinline__ float silu_f(float v) { return v / (1.f + __expf(-v)); }
__device__ __forceinline__ float silu_fast(float v) { return v * __builtin_amdgcn_rcpf(1.f + __builtin_amdgcn_exp2f(-1.4426950408889634f * v)); }
__device__ __forceinline__ unsigned cvtpk_e(float lo, float hi) { unsigned r; asm volatile("v_cvt_pk_bf16_f32 %0, %1, %2" : "=v"(r) : "v"(lo), "v"(hi)); return r; }
__device__ __forceinline__ int row_mi(int r) { const int b = r / TT, t = r - b * TT; return t < LC ? 4 : b; }

__device__ __forceinline__ int opaque_tid() { int t = __builtin_amdgcn_workitem_id_x(); asm volatile("" : "+v"(t)); return t; }
#define TIDX opaque_tid()
#define WSP(T, off) ((T*)(p.ws + (off)))

__device__ __forceinline__ void ph_mod(const Prm& p, int l, unsigned char* lds, int bid, int nb) {
  float* sc = (float*)lds;
  float* red = sc + 5 * 1024;
  const int tid = TIDX;
  for (int i = tid; i < 5 * 1024; i += NTHR) { const int mi = i >> 10, d = i & 1023; const float v = mi < 4 ? p.c[mi * 1024 + d] : p.c_ctx[d]; sc[i] = silu_f(v); }
  __syncthreads();
  float* MOD = WSP(float, OFF_MOD);
  const int cl = tid & 31, kg = tid >> 5;
  for (int it = bid; it < 192; it += nb) {
    const int e0 = it * 32;
    const float* w = p.w_mod + (size_t)l * 1024 * 6144 + e0 + cl;
    float a0 = 0, a1 = 0, a2 = 0, a3 = 0, a4 = 0;
#pragma unroll
    for (int k0 = 0; k0 < 64; k0 += 16) { float wv[16];
#pragma unroll
      for (int j = 0; j < 16; ++j) wv[j] = w[(size_t)(kg * 64 + k0 + j) * 6144];
#pragma unroll
      for (int j = 0; j < 16; ++j) { const int d = kg * 64 + k0 + j;
        a0 += sc[d] * wv[j]; a1 += sc[1024 + d] * wv[j]; a2 += sc[2048 + d] * wv[j]; a3 += sc[3072 + d] * wv[j]; a4 += sc[4096 + d] * wv[j]; } }
    float* rr = red + (kg * 32 + cl) * 5; rr[0] = a0; rr[1] = a1; rr[2] = a2; rr[3] = a3; rr[4] = a4;
    __syncthreads();
    if (tid < 160) { const int c2 = tid & 31, mi = tid >> 5; float s = 0; for (int g = 0; g < 16; ++g) s += red[(g * 32 + c2) * 5 + mi];
      MOD[(size_t)(l * 5 + mi) * 6144 + e0 + c2] = s + p.b_mod[l * 6144 + e0 + c2]; }
    __syncthreads();
  }
}

template <class Src>
__device__ __forceinline__ void tr_tile(const Src& src, bf16_t* dst, int K, int k0, int n0, float* tl  ) {
  const int tid = TIDX;
#pragma unroll
  for (int i = 0; i < 8; ++i) { const int e = tid + i * NTHR, kk = e >> 6, nn = e & 63; tl[kk * 65 + nn] = src(k0 + kk, n0 + nn); }
  __syncthreads();
#pragma unroll
  for (int i = 0; i < 2; ++i) { const int e = tid + i * NTHR, nn = e >> 4, kc = (e & 15) * 4;
    u32x2 o; o.x = pk2(tl[(kc + 0) * 65 + nn], tl[(kc + 1) * 65 + nn]); o.y = pk2(tl[(kc + 2) * 65 + nn], tl[(kc + 3) * 65 + nn]);
    *(u32x2*)(dst + (size_t)(n0 + nn) * K + k0 + kc) = o; }
  __syncthreads();
}
struct SrcIn { const float* w; __device__ float operator()(int k, int n) const { return n < NIN ? w[(size_t)k * NIN + n] : 0.f; } };
struct SrcScaled { const float* w; const float* nv; int N; __device__ float operator()(int k, int n) const { return w[(size_t)k * N + n] * nv[k]; } };
struct SrcPlain { const float* w; int N; __device__ float operator()(int k, int n) const { return w[(size_t)k * N + n]; } };
#if FAST_GEMM
struct SrcGU { const float* g; const float* u; __device__ float operator()(int k, int n) const { const int t = n >> 8, w = n & 255; return w < 128 ? g[(size_t)k * DFF + t * 128 + w] : u[(size_t)k * DFF + t * 128 + w - 128]; } };
#else
struct SrcGU { const float* g; const float* u; __device__ float operator()(int k, int n) const { const int t = n >> 6, w = n & 63; return w < 32 ? g[(size_t)k * DFF + t * 32 + w] : u[(size_t)k * DFF + t * 32 + w - 32]; } };
#endif

constexpr int WCB = 4;
struct WcItem { const float* sp; int ss; bf16_t* dp; int dK; const float* nv; int ncol; };
template <class F>
__device__ __forceinline__ void wconv_run(const F& item, int NIT, unsigned char* lds, int rank, int nranks) {
  float* tl = (float*)lds;
  const int tid = TIDX;
  for (int base = rank; base < NIT; base += nranks * WCB) {
    f32x4 rg[WCB][2]; float sc[WCB][2];
#pragma unroll
    for (int d = 0; d < WCB; ++d) { const int it = base + d * nranks;
      if (it < NIT) { const WcItem w = item(it);
#pragma unroll
        for (int i = 0; i < 2; ++i) { const int e = tid + i * NTHR, kk = e >> 4, n4 = (e & 15) * 4;
          rg[d][i] = n4 < w.ncol ? __builtin_nontemporal_load((const f32x4*)(w.sp + (size_t)kk * w.ss + n4)) : (f32x4){0.f, 0.f, 0.f, 0.f};
          sc[d][i] = w.nv ? w.nv[kk] : 1.f; } } }
#pragma unroll
    for (int d = 0; d < WCB; ++d) { const int it = base + d * nranks;
      if (it < NIT) { const WcItem w = item(it); float* t = tl + (d & 1) * (64 * 65);
#pragma unroll
        for (int i = 0; i < 2; ++i) { const int e = tid + i * NTHR, kk = e >> 4, n4 = (e & 15) * 4;
#pragma unroll
          for (int j = 0; j < 4; ++j) t[kk * 65 + n4 + j] = rg[d][i][j] * sc[d][i]; }
        __syncthreads();
#pragma unroll
        for (int i = 0; i < 2; ++i) { const int e = tid + i * NTHR, nn = e >> 4, kc = (e & 15) * 4;
          u32x2 o; o.x = pk2(t[(kc + 0) * 65 + nn], t[(kc + 1) * 65 + nn]); o.y = pk2(t[(kc + 2) * 65 + nn], t[(kc + 3) * 65 + nn]);
          *(u32x2*)(w.dp + (size_t)nn * w.dK + kc) = o; } } }
  }
  __syncthreads();
}
__device__ __forceinline__ void ph_wconv_dense(const Prm& p, int l, unsigned char* lds, int bid, int nb) {
  constexpr int T_IN = (DM / 64) * (NINP / 64), T_Q = (QRK / 64) * (NQB / 64), T_KV = (KVRK / 64) * (NKVB / 64), T_O = (DM / 64) * (DM / 64), T_L = T_IN + T_Q + T_KV + T_O;
  wconv_run([&p, l](int it) __attribute__((always_inline)) -> WcItem { int r = it; WcItem w;
    bf16_t* wb = (bf16_t*)(p.ws + OFF_W + (size_t)l * SZ_WL);
    if (r < T_IN) { const int kt = r / (NINP / 64), nt = r % (NINP / 64), n0 = nt * 64;
      w.sp = p.w_in + (size_t)l * DM * NIN + (size_t)(kt * 64) * NIN + n0; w.ss = NIN; w.dp = wb + (size_t)n0 * DM + kt * 64; w.dK = DM; w.nv = nullptr; w.ncol = NIN - n0; return w; } r -= T_IN;
    if (r < T_Q) { const int kt = r / (NQB / 64), nt = r % (NQB / 64);
      w.sp = p.w_q_up + (size_t)l * QRK * NQB + (size_t)(kt * 64) * NQB + nt * 64; w.ss = NQB; w.dp = (bf16_t*)((unsigned char*)wb + SZ_WIN) + (size_t)(nt * 64) * QRK + kt * 64; w.dK = QRK;
      w.nv = p.q_norm + l * QRK + kt * 64; w.ncol = 64; return w; } r -= T_Q;
    if (r < T_KV) { const int kt = r / (NKVB / 64), nt = r % (NKVB / 64);
      w.sp = p.w_kv_up + (size_t)l * KVRK * NKVB + (size_t)(kt * 64) * NKVB + nt * 64; w.ss = NKVB; w.dp = (bf16_t*)((unsigned char*)wb + SZ_WIN + SZ_WQ) + (size_t)(nt * 64) * KVRK + kt * 64; w.dK = KVRK;
      w.nv = p.kv_norm + l * KVRK + kt * 64; w.ncol = 64; return w; } r -= T_KV;
    { const int kt = r / (DM / 64), nt = r % (DM / 64);
      w.sp = p.w_out + (size_t)l * DM * DM + (size_t)(kt * 64) * DM + nt * 64; w.ss = DM; w.dp = (bf16_t*)((unsigned char*)wb + SZ_WIN + SZ_WQ + SZ_WKV) + (size_t)(nt * 64) * DM + kt * 64; w.dK = DM;
      w.nv = nullptr; w.ncol = 64; return w; } }, T_L, lds, bid, nb);
}
__device__ __forceinline__ void ph_wconv_moe(const Prm& p, int l, unsigned char* lds, int rank, int nranks) {
  constexpr int T_GU = (DM / 64) * (1024 / 64), T_D = (DFF / 64) * (DM / 64), T_E = T_GU + T_D;
  wconv_run([&p, l](int it) __attribute__((always_inline)) -> WcItem { const int e = it / T_E; int r = it % T_E; WcItem w; w.nv = nullptr; w.ncol = 64;
    if (r < T_GU) { const int kt = r >> 4, nt = r & 15, n0 = nt * 64, t = n0 >> 8, wq = n0 & 255;
      const float* src = (wq < 128 ? p.w_gate : p.w_up) + ((size_t)l * NE + e) * DM * DFF;
      w.sp = src + (size_t)(kt * 64) * DFF + t * 128 + (wq & 127); w.ss = DFF; w.dp = WSP(bf16_t, OFF_WGU) + (size_t)e * 1024 * 1024 + (size_t)n0 * DM + kt * 64; w.dK = DM; }
    else { r -= T_GU; const int kt = r >> 4, nt = r & 15;
      w.sp = p.w_down + ((size_t)l * NE + e) * DFF * DM + (size_t)(kt * 64) * DM + nt * 64; w.ss = DM; w.dp = WSP(bf16_t, OFF_WD) + (size_t)e * 1024 * 512 + (size_t)(nt * 64) * DFF + kt * 64; w.dK = DFF; }
    return w; }, NE * T_E, lds, rank, nranks);
}

typedef int i32x4 __attribute__((ext_vector_type(4)));
__device__ __forceinline__ void y_acc(f32x4 (&s)[4], const u32x2 (&y)[4]) {
#pragma unroll
  for (int j = 0; j < 4; ++j) { s[j][0] += __uint_as_float(y[j].x << 16); s[j][1] += __uint_as_float(y[j].x & 0xffff0000u); s[j][2] += __uint_as_float(y[j].y << 16); s[j][3] += __uint_as_float(y[j].y & 0xffff0000u); }
}
struct RowLd { f32x4 x[4]; i32x4 q[4]; };
__device__ __forceinline__ void row_issue(const Prm& p, int l, int r, int lane, RowLd& R) {
  const int b = r / TT, t = r - b * TT;
  if (l == 0) { const float* src = t < LC ? p.ctx + ((size_t)b * LC + t) * DM : p.x + ((size_t)b * SEQ + (t - LC)) * DM;
#pragma unroll
    for (int j = 0; j < 4; ++j) R.x[j] = *(const f32x4*)(src + 4 * lane + 256 * j);
  } else { int zv = 0; asm volatile("" : "+v"(zv));
    const float* X = WSP(float, OFF_X) + (size_t)r * DM; const i32x4* inv = (const i32x4*)(WSP(int, OFF_INV) + (size_t)r * 16 + zv);
#pragma unroll
    for (int j = 0; j < 4; ++j) { R.x[j] = *(const f32x4*)(X + 4 * lane + 256 * j); R.q[j] = inv[j]; } }
}
__device__ __forceinline__ void row_finish(const Prm& p, int l, int r, int lane, RowLd& R, f32x4 (&v)[4]) {
  if (l == 0) {
#pragma unroll
    for (int j = 0; j < 4; ++j) v[j] = R.x[j];
    return; }
  const int b = r / TT, t = r - b * TT;
  const float* gf = WSP(float, OFF_MOD) + (size_t)((l - 1) * 5 + (t < LC ? 4 : b)) * 6144 + 5 * 1024;
  f32x4 gv[4];
#pragma unroll
  for (int j = 0; j < 4; ++j) gv[j] = *(const f32x4*)(gf + 4 * lane + 256 * j);
  const bf16_t* Y = (const bf16_t*)(p.ws + OFF_R + R_Y) + 4 * lane;
  int c0 = 0, c1 = 0, c2 = 0, c3 = 0, cnt = 0;
#pragma unroll
  for (int e = 0; e < 16; ++e) { const int sv = __builtin_amdgcn_readfirstlane(R.q[e >> 2][e & 3]);
    if (sv >= 0) { c0 = cnt == 0 ? sv : c0; c1 = cnt == 1 ? sv : c1; c2 = cnt == 2 ? sv : c2; c3 = cnt == 3 ? sv : c3; ++cnt; } }
  u32x2 y0[4], y1[4], y2[4], y3[4];
#pragma unroll
  for (int j = 0; j < 4; ++j) { y0[j] = (u32x2){0u, 0u}; y1[j] = y0[j]; y2[j] = y0[j]; y3[j] = y0[j]; }
  if (cnt > 0) {
#pragma unroll
    for (int j = 0; j < 4; ++j) y0[j] = *(const u32x2*)(Y + (size_t)c0 * DM + 256 * j); }
  if (cnt > 1) {
#pragma unroll
    for (int j = 0; j < 4; ++j) y1[j] = *(const u32x2*)(Y + (size_t)c1 * DM + 256 * j); }
  if (cnt > 2) {
#pragma unroll
    for (int j = 0; j < 4; ++j) y2[j] = *(const u32x2*)(Y + (size_t)c2 * DM + 256 * j); }
  if (cnt > 3) {
#pragma unroll
    for (int j = 0; j < 4; ++j) y3[j] = *(const u32x2*)(Y + (size_t)c3 * DM + 256 * j); }
  f32x4 s[4];
#pragma unroll
  for (int j = 0; j < 4; ++j) s[j] = (f32x4){0.f, 0.f, 0.f, 0.f};
  y_acc(s, y0); y_acc(s, y1); y_acc(s, y2); y_acc(s, y3);
  if (cnt > 4) { int k = 0;
#pragma unroll
    for (int e = 0; e < 16; ++e) { const int sv = __builtin_amdgcn_readfirstlane(R.q[e >> 2][e & 3]);
      if (sv >= 0) { if (k >= 4) { u32x2 yy[4];
#pragma unroll
          for (int j = 0; j < 4; ++j) yy[j] = *(const u32x2*)(Y + (size_t)sv * DM + 256 * j);
          y_acc(s, yy); }
        ++k; } } }
#pragma unroll
  for (int j = 0; j < 4; ++j) v[j] = R.x[j] + gv[j] * s[j];
}
__device__ __forceinline__ float row_ssq(const f32x4 (&v)[4]) { float ss = 0.f;
#pragma unroll
  for (int j = 0; j < 4; ++j) ss += v[j][0] * v[j][0] + v[j][1] * v[j][1] + v[j][2] * v[j][2] + v[j][3] * v[j][3];
  return wave_sum(ss); }
__device__ __forceinline__ void norm_a_store(const Prm& p, int l, int r, int lane, const f32x4 (&v)[4]) {
  const float* md = WSP(float, OFF_MOD) + (size_t)(l * 5 + row_mi(r)) * 6144;
  f32x4 nwv[4], shv[4], sclv[4];
#pragma unroll
  for (int j = 0; j < 4; ++j) { const int c = 4 * lane + 256 * j; nwv[j] = *(const f32x4*)(p.norm_attn + l * DM + c); shv[j] = *(const f32x4*)(md + c); sclv[j] = *(const f32x4*)(md + 1024 + c); }
  const float rs = rsqrtf(row_ssq(v) * (1.f / DM) + EPS);
  float* X = WSP(float, OFF_X) + (size_t)r * DM; bf16_t* H = (bf16_t*)(p.ws + OFF_R + R_H) + (size_t)r * DM;
  if (lane == 0) { WSP(float, OFF_SSQQ)[r] = 0.f; WSP(float, OFF_SSQK)[r] = 0.f; }
#pragma unroll
  for (int j = 0; j < 4; ++j) { const int c = 4 * lane + 256 * j;
    *(f32x4*)(X + c) = v[j];
    const f32x4 nw = nwv[j], sh = shv[j], scl = sclv[j];
    const f32x4 h = v[j] * rs * nw * (scl + 1.f) + sh;
    u32x2 o; o.x = pk2(h[0], h[1]); o.y = pk2(h[2], h[3]); *(u32x2*)(H + c) = o; }
}
constexpr int RPI = 4, RPA = 2;
#define ROWPIPE(R0, R1, ROWOF, LAYER, STORE) do { \
    RowLd A0, A1, B0, B1; f32x4 va[4], vb[4]; \
    int r = (R0); \
    if (r < (R1)) row_issue(p, LAYER, ROWOF(r), lane, A0); if (r + 1 < (R1)) row_issue(p, LAYER, ROWOF(r + 1), lane, A1); \
    for (; r < (R1); r += 4) { \
      if (r + 2 < (R1)) row_issue(p, LAYER, ROWOF(r + 2), lane, B0); if (r + 3 < (R1)) row_issue(p, LAYER, ROWOF(r + 3), lane, B1); \
      row_finish(p, LAYER, ROWOF(r), lane, A0, va); if (r + 1 < (R1)) row_finish(p, LAYER, ROWOF(r + 1), lane, A1, vb); \
      STORE(r, va); if (r + 1 < (R1)) STORE(r + 1, vb); \
      if (r + 2 >= (R1)) break; \
      if (r + 4 < (R1)) row_issue(p, LAYER, ROWOF(r + 4), lane, A0); if (r + 5 < (R1)) row_issue(p, LAYER, ROWOF(r + 5), lane, A1); \
      row_finish(p, LAYER, ROWOF(r + 2), lane, B0, va); if (r + 3 < (R1)) row_finish(p, LAYER, ROWOF(r + 3), lane, B1, vb); \
      STORE(r + 2, va); if (r + 3 < (R1)) STORE(r + 3, vb); \
    } } while (0)
__device__ __forceinline__ void ph_norm_a(const Prm& p, int l, int bid, int nb) {
  const int lane = TIDX & 63, wv = __builtin_amdgcn_readfirstlane(TIDX >> 6);
  const int nw = nb * NWAVE, rpw = (MR + nw - 1) / nw, gw = bid * NWAVE + wv;
  const int r0 = gw * rpw, r1 = min(MR, r0 + rpw);
#define ROWID(x) (x)
#define NA_STORE(x, v) norm_a_store(p, l, (x), lane, v)
  ROWPIPE(r0, r1, ROWID, l, NA_STORE);
#undef ROWID
#undef NA_STORE
}
__device__ __forceinline__ void final_store(const Prm& p, int q, int lane, const f32x4 (&v)[4]) {
  f32x4 nfv[4];
#pragma unroll
  for (int j = 0; j < 4; ++j) nfv[j] = *(const f32x4*)(p.norm_final + 4 * lane + 256 * j);
  const float rs = rsqrtf(row_ssq(v) * (1.f / DM) + EPS); float* o = p.out + (size_t)q * DM;
#pragma unroll
  for (int j = 0; j < 4; ++j) { const int c = 4 * lane + 256 * j; *(f32x4*)(o + c) = v[j] * rs * nfv[j]; }
}
__device__ __forceinline__ void ph_final(const Prm& p, int bid, int nb) {
  const int lane = TIDX & 63, wv = __builtin_amdgcn_readfirstlane(TIDX >> 6);
  const int nw = nb * NWAVE, NQ = NB * SEQ, rpw = (NQ + nw - 1) / nw, gw = bid * NWAVE + wv;
  const int q0 = gw * rpw, q1 = min(NQ, q0 + rpw);
#define ROWQ(x) (((x) / SEQ) * TT + LC + ((x) % SEQ))
#define FIN_STORE(x, v) final_store(p, (x), lane, v)
  ROWPIPE(q0, q1, ROWQ, DEPTH, FIN_STORE);
#undef ROWQ
#undef FIN_STORE
}
template <bool ROUTER>
__device__ __forceinline__ void norm_b_row(const Prm& p, int l, int r, int lane, const f32x4 (&v)[4], const float* wl) {
  const int b = r / TT, t = r - b * TT;
  const float* md = WSP(float, OFF_MOD) + (size_t)(l * 5 + (t < LC ? 4 : b)) * 6144;
  f32x4 nwv[4], shv[4], sclv[4];
#pragma unroll
  for (int j = 0; j < 4; ++j) { const int c = 4 * lane + 256 * j; nwv[j] = *(const f32x4*)(p.norm_ffn + l * DM + c); shv[j] = *(const f32x4*)(md + 3 * 1024 + c); sclv[j] = *(const f32x4*)(md + 4 * 1024 + c); }
  const float rs = rsqrtf(row_ssq(v) * (1.f / DM) + EPS);
  bf16_t* H = (bf16_t*)(p.ws + OFF_R + R_H) + (size_t)r * DM;
  float lg[NE];
#pragma unroll
  for (int e = 0; e < NE; ++e) lg[e] = 0.f;
#pragma unroll
  for (int j = 0; j < 4; ++j) { const int c = 4 * lane + 256 * j;
    const f32x4 nw = nwv[j], sh = shv[j], scl = sclv[j];
    const f32x4 h = v[j] * rs * nw * (scl + 1.f) + sh;
    u32x2 o; o.x = pk2(h[0], h[1]); o.y = pk2(h[2], h[3]); *(u32x2*)(H + c) = o;
    if (ROUTER)
#pragma unroll
    for (int ip = 0; ip < 2; ++ip) {
      f32x4 w8[2][4];
#pragma unroll
      for (int i2 = 0; i2 < 2; ++i2)
#pragma unroll
        for (int e4 = 0; e4 < 4; ++e4) w8[i2][e4] = *(const f32x4*)(wl + ((((j * 4 + ip * 2 + i2) * 4 + e4) * 64 + lane) << 2));
      __builtin_amdgcn_sched_barrier(0);
#pragma unroll
      for (int i2 = 0; i2 < 2; ++i2)
#pragma unroll
        for (int e4 = 0; e4 < 4; ++e4) { const float hv = h[ip * 2 + i2]; const f32x4 w4 = w8[i2][e4];
          lg[4 * e4] += hv * w4[0]; lg[4 * e4 + 1] += hv * w4[1]; lg[4 * e4 + 2] += hv * w4[2]; lg[4 * e4 + 3] += hv * w4[3]; }
      __builtin_amdgcn_sched_barrier(0);
    } }
  if (!ROUTER) return;
#pragma unroll
  for (int e = 0; e < NE; ++e) { lg[e] += xor1(lg[e]); lg[e] += xor2(lg[e]); }
  float t8[8], t4[4], t2[2], t1;
#pragma unroll
  for (int i = 0; i < 8; ++i) { auto rr = __builtin_amdgcn_permlane32_swap(__float_as_uint(lg[i]), __float_as_uint(lg[i + 8]), false, false); t8[i] = __uint_as_float(rr[0]) + __uint_as_float(rr[1]); }
#pragma unroll
  for (int i = 0; i < 4; ++i) { auto rr = __builtin_amdgcn_permlane16_swap(__float_as_uint(t8[i]), __float_as_uint(t8[i + 4]), false, false); t4[i] = __uint_as_float(rr[0]) + __uint_as_float(rr[1]); }
  { const bool hb = lane & 8;
#pragma unroll
    for (int i = 0; i < 2; ++i) { const float snd = hb ? t4[i] : t4[i + 2], kp = hb ? t4[i + 2] : t4[i]; t2[i] = kp + xor8(snd); } }
  { const bool hb = lane & 4; const float snd = hb ? t2[0] : t2[1], kp = hb ? t2[1] : t2[0]; t1 = kp + hmir(snd); }
  float mx = t1;
  mx = fmaxf(mx, hmir(mx)); mx = fmaxf(mx, xor8(mx)); mx = max16sw(mx); mx = max32sw(mx);
  const float ex = __expf(t1 - mx); float sm = ex;
  sm += hmir(sm); sm += xor8(sm); sm = sum16sw(sm); sm = sum32sw(sm);
  if ((lane & 3) == 0) WSP(float, OFF_AFF)[(size_t)r * NE + (lane >> 2)] = ex / sm;
}
template <bool ROUTER>
__device__ __forceinline__ void ph_norm_b(const Prm& p, int l, unsigned char* lds, int bid, int nb) {
  const int tid = TIDX, lane = tid & 63, wv = __builtin_amdgcn_readfirstlane(tid >> 6);
  float* wl = (float*)lds;
  { const float* wr = p.w_router + (size_t)l * DM * NE;
    float rv[DM * NE / NTHR];
#pragma unroll
    for (int q = 0; q < DM * NE / NTHR; ++q) rv[q] = wr[tid + q * NTHR];
#pragma unroll
    for (int q = 0; q < DM * NE / NTHR; ++q) { const int idx = tid + q * NTHR; const int d = idx >> 4, e = idx & 15, j = d >> 8, ln = (d >> 2) & 63, i = d & 3;
      wl[((((j * 4 + i) * 4 + (e >> 2)) * 64 + ln) << 2) + (e & 3)] = rv[q]; } }
  __syncthreads();
  const int nw = nb * NWAVE, rpw = (MR + nw - 1) / nw, gw = bid * NWAVE + wv;
  const int r0 = gw * rpw, r1 = min(MR, r0 + rpw);
  for (int r = r0; r < r1; r += RPI) {
    f32x4 v[RPI][4]; u32x2 mg[RPI][4]; bool sk[RPI];
#pragma unroll
    for (int i = 0; i < RPI; ++i) { sk[i] = (r + i >= r1) || ((l == DEPTH - 1) && ((r + i) % TT) < LC);
      if (!sk[i]) { const float* X = WSP(float, OFF_X) + (size_t)(r + i) * DM; const bf16_t* MG = (const bf16_t*)(p.ws + OFF_R + R_MIXG) + (size_t)(r + i) * DM;
#pragma unroll
        for (int j = 0; j < 4; ++j) { v[i][j] = *(const f32x4*)(X + 4 * lane + 256 * j); mg[i][j] = *(const u32x2*)(MG + 4 * lane + 256 * j); } } }
#pragma unroll
    for (int i = 0; i < RPI; ++i) if (!sk[i]) {
      float* X = WSP(float, OFF_X) + (size_t)(r + i) * DM;
#pragma unroll
      for (int j = 0; j < 4; ++j) { v[i][j][0] += __uint_as_float(mg[i][j].x << 16); v[i][j][1] += __uint_as_float(mg[i][j].x & 0xffff0000u); v[i][j][2] += __uint_as_float(mg[i][j].y << 16); v[i][j][3] += __uint_as_float(mg[i][j].y & 0xffff0000u);
        *(f32x4*)(X + 4 * lane + 256 * j) = v[i][j]; }
      norm_b_row<ROUTER>(p, l, r + i, lane, v[i], wl); }
  }
  __syncthreads();
}

__device__ __forceinline__ void ph_topk(const Prm& p, int l, unsigned char* lds, int bid, int nb) {
  unsigned* keys = (unsigned*)lds;
  unsigned* hist = keys + 8192;
  unsigned* scan = hist + 8 * 256;
  unsigned* misc = scan + 512;
  const int tid = TIDX;
  const float* AFF = WSP(float, OFF_AFF);
  int* IDX = WSP(int, OFF_IDX); float* VAL = WSP(float, OFF_VAL); int* INV = WSP(int, OFF_INV);
  const int ngroups = (l == DEPTH - 1) ? 64 : 128;
  for (int g = bid; g < ngroups; g += nb) {
    const bool isctx = g >= 64; const int b = (g & 63) >> 4, e = g & 15;
    const int n = isctx ? LC : SEQ, cap = isctx ? CAPC : CAPL, r0 = b * TT + (isctx ? 0 : LC);
    const int sbase = isctx ? (NB * NE * CAPL + e * 256 + b * 32) : ((b * NE + e) * CAPL);
    for (int i = tid; i < n; i += NTHR) keys[i] = __float_as_uint(AFF[(size_t)(r0 + i) * NE + e]);
    if (tid == 0) misc[2] = 0;
    __syncthreads();
    unsigned prefix = 0, kk = cap;
    for (int pass = 3; pass >= 0; --pass) {
      for (int i = tid; i < 8 * 256; i += NTHR) hist[i] = 0;
      __syncthreads();
      const int sh = pass * 8; const unsigned hm = pass == 3 ? 0u : (0xffffffffu << (sh + 8));
      unsigned* myh = hist + (tid >> 6) * 256;
      for (int i = tid; i < n; i += NTHR) { const unsigned k = keys[i]; if ((k & hm) == (prefix & hm)) atomicAdd(&myh[(k >> sh) & 255u], 1u); }
      __syncthreads();
      if (tid < 256) { unsigned t_ = 0;
#pragma unroll
        for (int w = 0; w < 8; ++w) t_ += hist[w * 256 + tid];
        hist[tid] = t_; }
      __syncthreads();
      if (tid < 256) { unsigned cum = 0; for (int bk = tid + 1; bk < 256; ++bk) cum += hist[bk];
        const unsigned mine = hist[tid]; if (cum < kk && kk <= cum + mine) { misc[0] = (unsigned)tid; misc[1] = kk - cum; } }
      __syncthreads();
      prefix |= misc[0] << sh; kk = misc[1];
      __syncthreads();
    }
    const int chunk = (n + NTHR - 1) / NTHR; const int i0 = tid * chunk, i1 = min(n, i0 + chunk);
    unsigned eq = 0; for (int i = i0; i < i1; ++i) eq += (keys[i] == prefix) ? 1u : 0u;
    scan[tid] = eq; __syncthreads();
    for (int o = 1; o < NTHR; o <<= 1) { const unsigned a = tid >= o ? scan[tid - o] : 0u; __syncthreads(); scan[tid] += a; __syncthreads(); }
    unsigned erank = scan[tid] - eq;
    const unsigned ngt = cap - kk;
    for (int i = i0; i < i1; ++i) { const unsigned k = keys[i]; int slot = -1;
      if (k > prefix) slot = (int)atomicAdd(&misc[2], 1u);
      else if (k == prefix) { if (erank < kk) slot = (int)(ngt + erank); ++erank; }
      const int row = r0 + i;
      if (slot >= 0) { IDX[sbase + slot] = row; VAL[sbase + slot] = __uint_as_float(k); INV[(size_t)row * NE + e] = sbase + slot; }
      else INV[(size_t)row * NE + e] = -1; }
    if (isctx && tid < 32) { IDX[NB * NE * CAPL + e * 256 + 128 + b * 32 + tid] = 0; VAL[NB * NE * CAPL + e * 256 + 128 + b * 32 + tid] = 0.f; }
    __syncthreads();
  }
}

template <int NF, class AP, class Epi>
__device__ __forceinline__ void sgemm_wave(const AP& ap, const bf16_t* __restrict__ Bt, int K, int m0, int n0, const Epi& epi) {
  const int lane = TIDX & 63, fr = lane & 15, fq = lane >> 4;
  f32x4 acc[4][NF];
#pragma unroll
  for (int i = 0; i < 4; ++i)
#pragma unroll
    for (int j = 0; j < NF; ++j) acc[i][j] = (f32x4){0.f, 0.f, 0.f, 0.f};
  const bf16_t* a_[4]; const bf16_t* b_[NF];
#pragma unroll
  for (int i = 0; i < 4; ++i) a_[i] = ap.row(m0 + 16 * i + fr) + fq * 8;
#pragma unroll
  for (int j = 0; j < NF; ++j) b_[j] = Bt + (size_t)(n0 + 16 * j + fr) * K + fq * 8;
#pragma unroll 2
  for (int k0 = 0; k0 < K; k0 += 32) {
    bf16x8 av[4], bv[NF];
#pragma unroll
    for (int i = 0; i < 4; ++i) av[i] = *(const bf16x8*)(a_[i] + k0);
#pragma unroll
    for (int j = 0; j < NF; ++j) bv[j] = *(const bf16x8*)(b_[j] + k0);
#pragma unroll
    for (int i = 0; i < 4; ++i)
#pragma unroll
      for (int j = 0; j < NF; ++j) acc[i][j] = __builtin_amdgcn_mfma_f32_16x16x32_bf16(av[i], bv[j], acc[i][j], 0, 0, 0);
  }
  epi(acc, m0, n0, fr, fq);
}
struct APDense { const bf16_t* A; int lda; __device__ __forceinline__ const bf16_t* row(int r) const { return A + (size_t)r * lda; } };
struct APGather { const bf16_t* A; const int* idx; __device__ __forceinline__ const bf16_t* row(int r) const { return A + (size_t)idx[r] * DM; } };

__device__ __forceinline__ void rope_pos(int row, bool& lat, int& rp, int& cp) { const int b = row / TT, t = row - b * TT; lat = t >= LC; const int pos = t - LC; rp = pos >> 6; cp = pos & 63; }

struct EpiIn {
  const Prm* pp;
  __device__ __forceinline__ void operator()(f32x4 (&acc)[4][4], int m0, int n0, int fr, int fq) const {
    const Prm& p = *pp; const float* RT = WSP(float, OFF_ROPE);
    if (n0 >= 1472) return;
#pragma unroll
    for (int mf = 0; mf < 4; ++mf)
#pragma unroll
      for (int j = 0; j < 4; ++j) {
        const int row = m0 + 16 * mf + 4 * fq + j; bool lat; int rp, cp; rope_pos(row, lat, rp, cp);
        float v[4] = {acc[mf][0][j], acc[mf][1][j], acc[mf][2][j], acc[mf][3][j]};
        if (n0 < 640) {
          if (lat) { const float c0 = RT[rp * 16 + fr], s0 = RT[2048 + rp * 16 + fr], c1 = RT[cp * 16 + fr], s1 = RT[2048 + cp * 16 + fr];
            const float a = v[0] * c0 - v[1] * s0, bq = v[0] * s0 + v[1] * c0, cq = v[2] * c1 - v[3] * s1, dq = v[2] * s1 + v[3] * c1; v[0] = a; v[1] = bq; v[2] = cq; v[3] = dq; }
          if (n0 < 512) { bf16_t* o = (bf16_t*)(p.ws + OFF_R + R_QA) + (size_t)row * 512 + n0 + fr;
#pragma unroll
            for (int nf = 0; nf < 4; ++nf) o[16 * nf] = f2bf(v[nf] * SCALE_A); }
          else { bf16_t* o = (bf16_t*)(p.ws + OFF_R + R_KA) + (size_t)row * 128 + (n0 - 512) + fr;
#pragma unroll
            for (int nf = 0; nf < 4; ++nf) o[16 * nf] = f2bf(v[nf]); }
        } else if (n0 < 768) { bf16_t* o = (bf16_t*)(p.ws + OFF_R + R_VA) + (size_t)row * 128 + (n0 - 640) + fr;
#pragma unroll
          for (int nf = 0; nf < 4; ++nf) o[16 * nf] = f2bf(v[nf]);
        } else if (n0 < 1152) { bf16_t* o = (bf16_t*)(p.ws + OFF_R + R_CQ) + (size_t)row * QRK + (n0 - 768) + fr;
#pragma unroll
          for (int nf = 0; nf < 4; ++nf) o[16 * nf] = f2bf(v[nf]);
        } else if (n0 < 1408) { bf16_t* o = (bf16_t*)(p.ws + OFF_R + R_CKV) + (size_t)row * KVRK + (n0 - 1152) + fr;
#pragma unroll
          for (int nf = 0; nf < 4; ++nf) o[16 * nf] = f2bf(v[nf]);
        } else {
          const float pr0 = __shfl_xor(v[0], 8), pr1 = __shfl_xor(v[1], 8);
          if (lat) { const int f = fr & 7; const float c0 = RT[4096 + rp * 8 + f], s0 = RT[5120 + rp * 8 + f], c1 = RT[4096 + cp * 8 + f], s1 = RT[5120 + cp * 8 + f];
            v[0] = fr < 8 ? v[0] * c0 - pr0 * s0 : pr0 * s0 + v[0] * c0; v[1] = fr < 8 ? v[1] * c1 - pr1 * s1 : pr1 * s1 + v[1] * c1; }
          bf16_t* o = WSP(bf16_t, OFF_KR) + (size_t)row * 32 + fr; o[0] = f2bf(v[0]); o[16] = f2bf(v[1]);
        }
      }
  }
};
struct EpiQup {
  const Prm* pp;
  __device__ __forceinline__ void operator()(f32x4 (&acc)[4][6], int m0, int n0, int fr, int fq) const {
    const Prm& p = *pp; const float* RT = WSP(float, OFF_ROPE); const float* ssq = WSP(float, OFF_SSQQ);
#pragma unroll
    for (int mf = 0; mf < 4; ++mf)
#pragma unroll
      for (int j = 0; j < 4; ++j) {
        const int row = m0 + 16 * mf + 4 * fq + j; bool lat; int rp, cp; rope_pos(row, lat, rp, cp);
        const float rs = rsqrtf(ssq[row] * (1.f / QRK) + EPS) * SCALE_B;
        float v[6];
#pragma unroll
        for (int nf = 0; nf < 6; ++nf) v[nf] = acc[mf][nf][j] * rs;
        const float pr0 = __shfl_xor(v[4], 8), pr1 = __shfl_xor(v[5], 8);
        if (lat) { const int f = fr & 7; const float c0 = RT[4096 + rp * 8 + f], s0 = RT[5120 + rp * 8 + f], c1 = RT[4096 + cp * 8 + f], s1 = RT[5120 + cp * 8 + f];
          v[4] = fr < 8 ? v[4] * c0 - pr0 * s0 : pr0 * s0 + v[4] * c0; v[5] = fr < 8 ? v[5] * c1 - pr1 * s1 : pr1 * s1 + v[5] * c1; }
        bf16_t* o = (bf16_t*)(p.ws + OFF_R + R_QB) + (size_t)row * NQB + n0 + fr;
#pragma unroll
        for (int nf = 0; nf < 6; ++nf) o[16 * nf] = f2bf(v[nf]);
      }
  }
};
struct EpiKVup {
  const Prm* pp;
  __device__ __forceinline__ void operator()(f32x4 (&acc)[4][4], int m0, int n0, int fr, int fq) const {
    const Prm& p = *pp; const float* ssq = WSP(float, OFF_SSQK);
    const int hd = n0 >> 7, part = (n0 >> 6) & 1;
    bf16_t* base = (bf16_t*)(p.ws + OFF_R + (part ? R_VB : R_KB));
#pragma unroll
    for (int mf = 0; mf < 4; ++mf)
#pragma unroll
      for (int j = 0; j < 4; ++j) {
        const int row = m0 + 16 * mf + 4 * fq + j; const float rs = rsqrtf(ssq[row] * (1.f / KVRK) + EPS);
        bf16_t* o = base + (size_t)row * 512 + hd * 64 + fr;
#pragma unroll
        for (int nf = 0; nf < 4; ++nf) o[16 * nf] = f2bf(acc[mf][nf][j] * rs);
      }
  }
};
struct EpiOut {
  const Prm* pp; int l;
  __device__ __forceinline__ void operator()(f32x4 (&acc)[4][4], int m0, int n0, int fr, int fq) const {
    const Prm& p = *pp; const float* MOD = WSP(float, OFF_MOD);
#pragma unroll
    for (int mf = 0; mf < 4; ++mf)
#pragma unroll
      for (int j = 0; j < 4; ++j) {
        const int row = m0 + 16 * mf + 4 * fq + j; const float* ga = MOD + (size_t)(l * 5 + row_mi(row)) * 6144 + 2 * 1024 + n0 + fr;
        float* X = WSP(float, OFF_X) + (size_t)row * DM + n0 + fr;
#pragma unroll
        for (int nf = 0; nf < 4; ++nf) X[16 * nf] += ga[16 * nf] * acc[mf][nf][j];
      }
  }
};
struct EpiMoeUp {
  const Prm* pp;
  __device__ __forceinline__ void operator()(f32x4 (&acc)[4][4], int m0, int n0, int fr, int fq) const {
    const Prm& p = *pp; const int j0 = n0 >> 1;
#pragma unroll
    for (int mf = 0; mf < 4; ++mf)
#pragma unroll
      for (int j = 0; j < 4; ++j) {
        const int slot = m0 + 16 * mf + 4 * fq + j;
        bf16_t* o = (bf16_t*)(p.ws + OFF_R + R_ACT) + (size_t)slot * DFF + j0 + fr;
        o[0] = f2bf(silu_f(acc[mf][0][j]) * acc[mf][2][j]); o[16] = f2bf(silu_f(acc[mf][1][j]) * acc[mf][3][j]);
      }
  }
};
struct EpiMoeDown {
  const Prm* pp;
  __device__ __forceinline__ void operator()(f32x4 (&acc)[4][4], int m0, int n0, int fr, int fq) const {
    const Prm& p = *pp; const float* VAL = WSP(float, OFF_VAL);
#pragma unroll
    for (int mf = 0; mf < 4; ++mf)
#pragma unroll
      for (int j = 0; j < 4; ++j) {
        const int slot = m0 + 16 * mf + 4 * fq + j; const float vv = VAL[slot];
        bf16_t* o = (bf16_t*)(p.ws + OFF_R + R_Y) + (size_t)slot * DM + n0 + fr;
#pragma unroll
        for (int nf = 0; nf < 4; ++nf) o[16 * nf] = f2bf(acc[mf][nf][j] * vv);
      }
  }
};

__device__ __forceinline__ void ph_gemm_in(const Prm& p, int l, int bid, int nb) {
  const int wv = TIDX >> 6, wm = wv >> 1, wn = wv & 1;
  const bf16_t* Bt = (const bf16_t*)(p.ws + OFF_W + (size_t)l * SZ_WL);
  APDense ap{(const bf16_t*)(p.ws + OFF_R + R_H), DM}; EpiIn epi{&p};
  constexpr int NCT = NINP / 128;
  for (int it = bid; it < (MR / 256) * NCT; it += nb) { const int rt = it / NCT, ct = it % NCT;
    sgemm_wave<4>(ap, Bt, DM, rt * 256 + wm * 64, ct * 128 + wn * 64, epi); }
}
__device__ __forceinline__ void ph_ssq(const Prm& p, int bid, int nb) {
  const int lane = TIDX & 63, wv = TIDX >> 6;
  for (int r = bid * NWAVE + wv; r < MR; r += nb * NWAVE) {
    const bf16_t* cq = (const bf16_t*)(p.ws + OFF_R + R_CQ) + (size_t)r * QRK; const bf16_t* ck = (const bf16_t*)(p.ws + OFF_R + R_CKV) + (size_t)r * KVRK;
    float s = 0.f; for (int i = lane; i < QRK; i += 64) { const float v = bf2f(cq[i]); s += v * v; }
    float s2 = 0.f; for (int i = lane; i < KVRK; i += 64) { const float v = bf2f(ck[i]); s2 += v * v; }
    s = wave_sum(s); s2 = wave_sum(s2);
    if (lane == 0) { WSP(float, OFF_SSQQ)[r] = s; WSP(float, OFF_SSQK)[r] = s2; }
  }
}
__device__ __forceinline__ void ph_gemm_up(const Prm& p, int l, int bid, int nb) {
  const int wv = TIDX >> 6, wm = wv >> 1, wn = wv & 1;
  const bf16_t* WQ = (const bf16_t*)(p.ws + OFF_W + (size_t)l * SZ_WL + SZ_WIN);
  const bf16_t* WKV = (const bf16_t*)(p.ws + OFF_W + (size_t)l * SZ_WL + SZ_WIN + SZ_WQ);
  constexpr int IQ = (MR / 256) * 4, IKV = (MR / 256) * 8;
  for (int it = bid; it < IQ + IKV; it += nb) {
    if (it < IQ) { const int rt = it / 4, ct = it % 4; APDense ap{(const bf16_t*)(p.ws + OFF_R + R_CQ), QRK}; EpiQup epi{&p};
      sgemm_wave<6>(ap, WQ, QRK, rt * 256 + wm * 64, ct * 192 + wn * 96, epi); }
    else { const int i2 = it - IQ, rt = i2 / 8, ct = i2 % 8; APDense ap{(const bf16_t*)(p.ws + OFF_R + R_CKV), KVRK}; EpiKVup epi{&p};
      sgemm_wave<4>(ap, WKV, KVRK, rt * 256 + wm * 64, ct * 128 + wn * 64, epi); }
  }
}
__device__ __forceinline__ void ph_gemm_out(const Prm& p, int l, int bid, int nb) {
  const int wv = TIDX >> 6, wm = wv >> 1, wn = wv & 1;
  const bf16_t* Bt = (const bf16_t*)(p.ws + OFF_W + (size_t)l * SZ_WL + SZ_WIN + SZ_WQ + SZ_WKV);
  APDense ap{(const bf16_t*)(p.ws + OFF_R + R_H), DM}; EpiOut epi{&p, l};
  for (int it = bid; it < (MR / 256) * 8; it += nb) { const int rt = it / 8, ct = it % 8;
    sgemm_wave<4>(ap, Bt, DM, rt * 256 + wm * 64, ct * 128 + wn * 64, epi); }
}
__device__ __forceinline__ void ph_moe_up(const Prm& p, int l, int bid, int nb) {
  const int wv = TIDX >> 6, wm = wv >> 1, wn = wv & 1;
  const int nrt = (l == DEPTH - 1) ? 256 : 272;
  APGather ap{(const bf16_t*)(p.ws + OFF_R + R_H), WSP(int, OFF_IDX)}; EpiMoeUp epi{&p};
  for (int it = bid; it < nrt * 8; it += nb) { const int rt = it / 8, ct = it % 8; const int e = rt < 256 ? ((rt >> 2) & 15) : rt - 256;
    sgemm_wave<4>(ap, WSP(bf16_t, OFF_WGU) + (size_t)e * 1024 * 1024, DM, rt * 256 + wm * 64, ct * 128 + wn * 64, epi); }
}
__device__ __forceinline__ void ph_moe_down(const Prm& p, int l, int bid, int nb) {
  const int wv = TIDX >> 6, wm = wv >> 1, wn = wv & 1;
  const int nrt = (l == DEPTH - 1) ? 256 : 272;
  APDense ap{(const bf16_t*)(p.ws + OFF_R + R_ACT), DFF}; EpiMoeDown epi{&p};
  for (int it = bid; it < nrt * 8; it += nb) { const int rt = it / 8, ct = it % 8; const int e = rt < 256 ? ((rt >> 2) & 15) : rt - 256;
    sgemm_wave<4>(ap, WSP(bf16_t, OFF_WD) + (size_t)e * 1024 * 512, DFF, rt * 256 + wm * 64, ct * 128 + wn * 64, epi); }
}

namespace pg8 {
#define PG8_LAS __attribute__((address_space(3)))
constexpr int BM = 256, BK = 64, HALF = 128, HTB = HALF * BK * 2, STAGE_BYTES = 8 * HTB;
__device__ __forceinline__ int lds_byte(int r, int c) { const int st = (r >> 4) * 2 + (c >> 5), rr = r & 15, cc = c & 31, ob = rr * 64 + cc * 2; return st * 1024 + (ob ^ (((ob >> 9) & 1) << 5)); }
__device__ __forceinline__ void stage_rc(int b, int& R, int& C) { const int st = b / 1024, sb = b % 1024, swz = sb ^ (((sb >> 9) & 1) << 5); R = (st >> 1) * 16 + swz / 64; C = (st & 1) * 32 + (swz % 64) / 2; }
struct Unit { int pm, pn; size_t boff; int r0; };
struct Gemm { const bf16_t* A; const bf16_t* Bt; int K; const int* idx; };
template <bool GATHER, bool HALFM = false, class Epi, class Sched>
__device__ __forceinline__ void gemm_phase(PG8_LAS unsigned char* lds, const Gemm g, const Sched& S, const Epi& E) {
    const int tid = TIDX, wid = __builtin_amdgcn_readfirstlane(tid >> 6), lane = tid & 63, wr = wid >> 2, wc = wid & 3, fr = lane & 15, fq = lane >> 4;
    const int K = g.K, nt = K / BK;
    int RA[2], CA[2]; unsigned voffB[2], voffA[2];
#pragma unroll
    for (int i = 0; i < 2; ++i) { int R, C; stage_rc(tid * 16 + i * 8192, R, C); RA[i] = R; CA[i] = C; voffA[i] = (unsigned)(R * K + C) * 2u; voffB[i] = voffA[i]; }
    const size_t kstep = (size_t)(BK * 2);
    const size_t hstep = (size_t)HALF * K * 2;
    const size_t tstep = 2 * hstep;
    const unsigned ldsw = (unsigned)wid * 1024u;
    const int aoff = lds_byte(wr * 64 + fr, fq * 8), boff = lds_byte(wc * 32 + fr, fq * 8);
#define PG8_SA(b, h) (((b) * 2 + (h)) * HTB)
#define PG8_SB(b, h) ((4 + (b) * 2 + (h)) * HTB)
#define PG8_STAGE(bufoff, gbase, voff) do { _Pragma("unroll") for (int _i = 0; _i < 2; ++_i) \
        __builtin_amdgcn_global_load_lds((const unsigned*)((const char*)(gbase) + (voff)[_i]), (PG8_LAS unsigned*)(lds + (bufoff) + ldsw + _i * 8192), 16, 0, 0); } while (0)
#define PG8_LDA(dst, b, h) do { _Pragma("unroll") for (int m = 0; m < 4; ++m) _Pragma("unroll") for (int k = 0; k < 2; ++k) dst[m][k] = *(const PG8_LAS bf16x8*)(lds + PG8_SA(b, h) + aoff + m * 2048 + k * 1024); } while (0)
#define PG8_LDB(dst, b, h) do { _Pragma("unroll") for (int n = 0; n < 2; ++n) _Pragma("unroll") for (int k = 0; k < 2; ++k) dst[n][k] = *(const PG8_LAS bf16x8*)(lds + PG8_SB(b, h) + boff + n * 2048 + k * 1024); } while (0)
#define PG8_MMA(ai, bj, At, Bt) do { __builtin_amdgcn_s_setprio(1); _Pragma("unroll") for (int m = 0; m < 4; ++m) _Pragma("unroll") for (int n = 0; n < 2; ++n) _Pragma("unroll") for (int k = 0; k < 2; ++k) \
        acc[ai][bj][m][n] = __builtin_amdgcn_mfma_f32_16x16x32_bf16(Bt[n][k], At[m][k], acc[ai][bj][m][n], 0, 0, 0); __builtin_amdgcn_s_setprio(0); } while (0)
#define PG8_WAIT_V(n) asm volatile("s_waitcnt vmcnt(" #n ")" ::: "memory")
#define PG8_WAIT_L(n) asm volatile("s_waitcnt lgkmcnt(" #n ")" ::: "memory")
#define PG8_BAR __builtin_amdgcn_s_barrier()
#define PG8_SCHED __builtin_amdgcn_sched_barrier(0)
    Unit cur, nxt; int ui = 0;
    if (!S.next(0, cur)) return;
    typename Epi::Ctx ectx; if constexpr (Epi::EARLY) E.begin(ectx, cur, wr, wc, fr, fq);
    f32x4 acc[2][2][4][2];
#pragma unroll
    for (int a = 0; a < 2; ++a)
#pragma unroll
        for (int b = 0; b < 2; ++b)
#pragma unroll
            for (int m = 0; m < 4; ++m)
#pragma unroll
                for (int n = 0; n < 2; ++n) acc[a][b][m][n] = (f32x4){0.f, 0.f, 0.f, 0.f};
    bf16x8 At[4][2], B0[2][2], B1[2][2];
    unsigned oc0[2], oc1[2], on0[2], on1[2];
    auto set_off = [&](const Unit& u, unsigned (&o0)[2], unsigned (&o1)[2]) {
        if constexpr (GATHER) {
#pragma unroll
            for (int i = 0; i < 2; ++i) { const int r0 = g.idx[u.r0 + RA[i]], r1 = g.idx[u.r0 + HALF + RA[i]]; o0[i] = (unsigned)(r0 * K + CA[i]) * 2u; o1[i] = (unsigned)(r1 * K + CA[i]) * 2u; }
        } else {
#pragma unroll
            for (int i = 0; i < 2; ++i) { o0[i] = voffA[i]; o1[i] = voffA[i] + (unsigned)hstep; }
        }
    };
    auto a_base = [&](const Unit& u) -> const char* { if constexpr (GATHER) return (const char*)g.A; else return (const char*)g.A + (size_t)u.r0 * (size_t)(K * 2); };
    const char* cA = a_base(cur); const char* cB = (const char*)g.Bt + cur.boff + (size_t)cur.pn * tstep;
    set_off(cur, oc0, oc1);
    PG8_STAGE(PG8_SB(0, 0), cB, voffB); PG8_STAGE(PG8_SB(0, 1), cB + hstep, voffB); PG8_STAGE(PG8_SA(0, 0), cA, oc0); PG8_STAGE(PG8_SA(0, 1), cA, oc1);
    if (wr == 1) PG8_BAR;
    PG8_WAIT_V(2); PG8_BAR;
    PG8_STAGE(PG8_SB(1, 0), cB + kstep, voffB); PG8_STAGE(PG8_SA(1, 0), cA + kstep, oc0); PG8_STAGE(PG8_SB(1, 1), cB + hstep + kstep, voffB);
    PG8_WAIT_V(6); PG8_BAR;
    for (;;) {
        const bool has_next = S.next(ui + 1, nxt);
        const char* nA = has_next ? a_base(nxt) : cA; const char* nB = has_next ? (const char*)g.Bt + nxt.boff + (size_t)nxt.pn * tstep : cB;
        if (has_next) set_off(nxt, on0, on1); else {
#pragma unroll
            for (int i = 0; i < 2; ++i) { on0[i] = oc0[i]; on1[i] = oc1[i]; } }
#pragma unroll 1
        for (int t = 0; t < nt; t += 2) {
            const bool last = (t == nt - 2);
            const char* a1 = cA + (size_t)(t + 1) * kstep;
            const char* a2 = last ? nA : cA + (size_t)(t + 2) * kstep; const char* b2 = last ? nB : cB + (size_t)(t + 2) * kstep;
            const char* a3 = a2 + kstep; const char* b3 = b2 + kstep;
            unsigned o20[2], o21[2];
#pragma unroll
            for (int i = 0; i < 2; ++i) { o20[i] = last ? on0[i] : oc0[i]; o21[i] = last ? on1[i] : oc1[i]; }
            PG8_LDB(B0, 0, 0); PG8_LDB(B1, 0, 1); PG8_SCHED; PG8_LDA(At, 0, 0); PG8_STAGE(PG8_SA(1, 1), a1, oc1);
            PG8_WAIT_V(8); PG8_WAIT_L(0); PG8_BAR; PG8_MMA(0, 0, At, B0); PG8_MMA(0, 1, At, B1); PG8_BAR; PG8_SCHED;
            if constexpr (!HALFM) { PG8_LDA(At, 0, 1); } PG8_STAGE(PG8_SB(0, 0), b2, voffB); PG8_STAGE(PG8_SB(0, 1), b2 + hstep, voffB); PG8_STAGE(PG8_SA(0, 0), a2, o20);
            PG8_WAIT_V(8); PG8_WAIT_L(0); PG8_BAR; if constexpr (!HALFM) { PG8_MMA(1, 0, At, B0); PG8_MMA(1, 1, At, B1); } PG8_BAR; PG8_SCHED;
            PG8_LDB(B0, 1, 0); PG8_LDB(B1, 1, 1); PG8_SCHED; PG8_LDA(At, 1, 0); PG8_STAGE(PG8_SA(0, 1), a2, o21);
            PG8_WAIT_V(8); PG8_WAIT_L(0); PG8_BAR; PG8_MMA(0, 0, At, B0); PG8_MMA(0, 1, At, B1); PG8_BAR; PG8_SCHED;
            if constexpr (!HALFM) { PG8_LDA(At, 1, 1); } PG8_STAGE(PG8_SB(1, 0), b3, voffB); PG8_STAGE(PG8_SB(1, 1), b3 + hstep, voffB); PG8_STAGE(PG8_SA(1, 0), a3, o20);
            PG8_WAIT_V(8); PG8_WAIT_L(0); PG8_BAR; if constexpr (!HALFM) { PG8_MMA(1, 0, At, B0); PG8_MMA(1, 1, At, B1); } PG8_BAR; PG8_SCHED;
        }
        if (wr == 0) PG8_BAR;
        if constexpr (!Epi::EARLY) E.begin(ectx, cur, wr, wc, fr, fq);
        E.template run<HALFM>(ectx, acc, cur, wr, wc, fr, fq, lds, tid);
        if (!has_next) break;
#pragma unroll
        for (int a = 0; a < 2; ++a)
#pragma unroll
            for (int b = 0; b < 2; ++b)
#pragma unroll
                for (int m = 0; m < 4; ++m)
#pragma unroll
                    for (int n = 0; n < 2; ++n) acc[a][b][m][n] = (f32x4){0.f, 0.f, 0.f, 0.f};
        cur = nxt; cA = nA; cB = nB; ++ui;
        if constexpr (Epi::EARLY) E.begin(ectx, cur, wr, wc, fr, fq);
#pragma unroll
        for (int i = 0; i < 2; ++i) { oc0[i] = on0[i]; oc1[i] = on1[i]; }
        if (wr == 1) PG8_BAR;
    }
    PG8_WAIT_V(0);
    PG8_BAR;
#undef PG8_SA
#undef PG8_SB
#undef PG8_STAGE
#undef PG8_LDA
#undef PG8_LDB
#undef PG8_MMA
#undef PG8_WAIT_V
#undef PG8_WAIT_L
#undef PG8_BAR
#undef PG8_SCHED
}
}

__device__ __forceinline__ int vcu_of(int bid, int nb) { return (nb % 8 == 0) ? (bid % 8) * (nb / 8) + bid / 8 : bid; }
struct SchedDense { int nM, nN, G, c; bool rev; bool skipctx; int lim;
  __device__ __forceinline__ bool next(int i, pg8::Unit& u) const { const int L = i * G + (rev ? G - 1 - c : c); if (L >= lim) return false; int pm = L / nN; u.pn = L % nN;
    if (skipctx) pm = pm + pm / 32 + 1; u.pm = pm; u.r0 = pm * 256; u.boff = 0; return true; } };
struct SchedDenseTail { int nN, base, nh, c;
  __device__ __forceinline__ bool next(int i, pg8::Unit& u) const { if (i > 0 || c >= nh) return false; const int L = base + (c >> 1); u.pm = L / nN; u.pn = L % nN;
    u.r0 = u.pm * 256 + (c & 1) * 128; u.boff = 0; return true; } };
struct SchedMoe { int nrt, G, c; size_t estride;
  __device__ __forceinline__ bool next(int i, pg8::Unit& u) const { const int L = i * G + c; if (L >= nrt * 4) return false; u.pm = L >> 2; u.pn = L & 3; u.r0 = u.pm * 256;
    const int e = u.pm < 256 ? ((u.pm >> 2) & 15) : u.pm - 256; u.boff = (size_t)e * estride; return true; } };
struct SchedMoeTail { int c; size_t estride;
  __device__ __forceinline__ bool next(int i, pg8::Unit& u) const { if (i > 0 || (c & 15) >= 4 || (c >> 4) >= NE) return false; const int e = c >> 4; u.pm = 256 + e; u.pn = c & 15;
    u.r0 = u.pm * 256; u.boff = (size_t)e * estride; return true; } };

__device__ __forceinline__ f32x4 shfl32(f32x4 v) { f32x4 r;
#pragma unroll
  for (int i = 0; i < 4; ++i) { auto x = __builtin_amdgcn_permlane32_swap(__float_as_uint(v[i]), __float_as_uint(v[i]), false, false); r[i] = __uint_as_float((TIDX & 32) ? x[0] : x[1]); }
  return r; }
__device__ __forceinline__ void rope32_grp(f32x4& v0, f32x4& v1, const float* RT, int rp, int cp, int fq) {
  const f32x4 p0 = shfl32(v0), p1 = shfl32(v1); const int f = 4 * (fq & 1);
  const f32x4 c0 = *(const f32x4*)(RT + 4096 + rp * 8 + f), s0 = *(const f32x4*)(RT + 5120 + rp * 8 + f), c1 = *(const f32x4*)(RT + 4096 + cp * 8 + f), s1 = *(const f32x4*)(RT + 5120 + cp * 8 + f);
  if (fq < 2) { v0 = v0 * c0 - p0 * s0; v1 = v1 * c1 - p1 * s1; } else { v0 = p0 * s0 + v0 * c0; v1 = p1 * s1 + v1 * c1; }
}
constexpr int ROPE_TAB_OFF = 131072 + 16384 + 128;
constexpr int STG_OFF = 131072, STG_OFF2 = 3 * 16384  , STG_RS = 512;
#define WSE(T, off) ((T*)(ws + (off)))
template <bool HM, class Epi>
__device__ __forceinline__ void epi_staged(const Epi& E, const typename Epi::Ctx& ctx, f32x4 (&acc)[2][2][4][2], const pg8::Unit& u, int wr, int wc, int fr, int fq, PG8_LAS unsigned char* lds, int tid) {
  constexpr int NCH = Epi::NCOL / 8, NPASS = 32 * NCH / NTHR;
  const PG8_LAS float* rtab = (const PG8_LAS float*)(lds + ROPE_TAB_OFF);
  unsigned wofs[2][2], rofs[NPASS], gofs[NPASS], gld[NPASS]; bool gval[NPASS];
#pragma unroll
  for (int bj = 0; bj < 2; ++bj)
#pragma unroll
    for (int n = 0; n < 2; ++n) { const unsigned chunk = bj * 16 + wc * 4 + n * 2 + (fq >> 1); wofs[bj][n] = Epi::LEAN ? 0u : (unsigned)(wr * 16 + fr) * STG_RS + ((chunk ^ (unsigned)fr) << 4) + (fq & 1) * 8; }
#pragma unroll
  for (int ps = 0; ps < NPASS; ++ps) { const unsigned c = (unsigned)tid + NTHR * ps, rl = c / NCH, ch = c % NCH;
    rofs[ps] = rl * STG_RS + ((ch ^ (rl & 15u)) << 4);
    E.dst(u, (int)((rl >> 4) * 64 + (rl & 15u)), (int)(ch * 8), gofs[ps], gld[ps], gval[ps]); }
#pragma unroll
  for (int ai = 0; ai < (HM ? 1 : 2); ++ai)
#pragma unroll
    for (int m = 0; m < 4; ++m) {
      PG8_LAS unsigned char* stg = lds + ((m & 1) ? STG_OFF2 : STG_OFF);
      f32x4 v[2][2] = {{acc[ai][0][m][0], acc[ai][0][m][1]}, {acc[ai][1][m][0], acc[ai][1][m][1]}};
      E.pre(v, ai * 128 + m * 16, ai, m, ctx, u, wc, fr, fq, rtab);
#pragma unroll
      for (int bj = 0; bj < Epi::NCOL / 128; ++bj)
#pragma unroll
        for (int n = 0; n < 2; ++n) { u32x2 w; w.x = cvtpk_e(v[bj][n][0], v[bj][n][1]); w.y = cvtpk_e(v[bj][n][2], v[bj][n][3]);
          unsigned wo = wofs[bj][n];
          if (Epi::LEAN) { int frl = fr; asm volatile("" : "+v"(frl)); const unsigned chunk = bj * 16 + wc * 4 + n * 2 + (fq >> 1); wo = (unsigned)(wr * 16 + frl) * STG_RS + ((chunk ^ (unsigned)frl) << 4) + (fq & 1) * 8; }
          *(PG8_LAS u32x2*)(stg + wo) = w; }
      asm volatile("s_waitcnt lgkmcnt(0)" ::: "memory"); __builtin_amdgcn_s_barrier(); asm volatile("" ::: "memory");
#pragma unroll
      for (int ps = 0; ps < NPASS; ++ps) {
        const u32x4 val = *(const PG8_LAS u32x4*)(stg + rofs[ps]);
        unsigned go = gofs[ps]; asm volatile("" : "+v"(go));
        if (gval[ps]) __builtin_nontemporal_store(val, (u32x4*)(E.ws + (size_t)(go + (unsigned)(ai * 128 + m * 16) * gld[ps]))); }
    }
  asm volatile("s_waitcnt lgkmcnt(0)" ::: "memory"); __builtin_amdgcn_s_barrier(); asm volatile("" ::: "memory");
}
#define EPI_RUN   template <bool HM, class C> __device__ __forceinline__ void run(const C& ctx, f32x4 (&acc)[2][2][4][2], const pg8::Unit& u, int wr, int wc, int fr, int fq, PG8_LAS unsigned char* lds, int tid) const { epi_staged<HM>(*this, ctx, acc, u, wr, wc, fr, fq, lds, tid); }
__device__ __forceinline__ void rot4(f32x4& x1, f32x4& x2, int pos, const f32x4& w) {
  f32x4 c, sn;
#pragma unroll
  for (int j = 0; j < 4; ++j) { const float a = __builtin_amdgcn_fractf((float)pos * w[j]); c[j] = __builtin_amdgcn_cosf(a); sn[j] = __builtin_amdgcn_sinf(a); }
  const f32x4 a = x1 * c - x2 * sn, b = x1 * sn + x2 * c; x1 = a; x2 = b;
}
__device__ __forceinline__ f32x4 rope_w(int i0, float nf) { f32x4 w;
#pragma unroll
  for (int j = 0; j < 4; ++j) w[j] = exp2f(-(float)(i0 + j) * (13.287712379549449f / nf)) * 0.15915494309189535f;
  return w; }
__device__ __forceinline__ void rope32_hw(f32x4& v0, f32x4& v1, int rp, int cp, int fq, const f32x4& w32) {
  const f32x4 p0 = shfl32(v0), p1 = shfl32(v1);
  f32x4 c0, s0, c1, s1;
#pragma unroll
  for (int j = 0; j < 4; ++j) { const float a = __builtin_amdgcn_fractf((float)rp * w32[j]), bq = __builtin_amdgcn_fractf((float)cp * w32[j]);
    c0[j] = __builtin_amdgcn_cosf(a); s0[j] = __builtin_amdgcn_sinf(a); c1[j] = __builtin_amdgcn_cosf(bq); s1[j] = __builtin_amdgcn_sinf(bq); }
  if (fq < 2) { v0 = v0 * c0 - p0 * s0; v1 = v1 * c1 - p1 * s1; } else { v0 = p0 * s0 + v0 * c0; v1 = p1 * s1 + v1 * c1; }
}
__device__ __forceinline__ void tile_pos(int pm, bool& lat, int& pos0) { const int tb = pm % 33; lat = tb != 0; pos0 = (tb - 1) * 256; }
struct Epi2In {
  static constexpr int NCOL = 256; static constexpr bool LEAN = true; static constexpr bool EARLY = false;
  EPI_RUN
  unsigned char* ws;
  struct Ctx { int pos0, rloc; bool lat; };
  __device__ __forceinline__ void begin(Ctx& c, const pg8::Unit& u, int wr, int wc, int fr, int fq) const {
    c.rloc = wr * 64 + fr; tile_pos(u.pm, c.lat, c.pos0); c.pos0 += c.rloc + (u.r0 - u.pm * 256); }
  __device__ __forceinline__ void dst(const pg8::Unit& u, int rsub, int col, unsigned& gofs, unsigned& gld, bool& gval) const {
    const int gc = u.pn * 256 + col; const unsigned row = (unsigned)(u.r0 + rsub);
    const unsigned ld = gc < 512 ? 512u : gc < 768 ? 128u : gc < 1152 ? (unsigned)QRK : gc < 1408 ? (unsigned)KVRK : 32u;
    const unsigned base = gc < 512 ? (unsigned)(OFF_R + R_QA) : gc < 640 ? (unsigned)(OFF_R + R_KA) : gc < 768 ? (unsigned)(OFF_R + R_VA) : gc < 1152 ? (unsigned)(OFF_R + R_CQ) : gc < 1408 ? (unsigned)(OFF_R + R_CKV) : (unsigned)OFF_KR;
    const unsigned c0 = gc < 512 ? 0u : gc < 640 ? 512u : gc < 768 ? 640u : gc < 1152 ? 768u : gc < 1408 ? 1152u : 1408u;
    gval = gc < 1440; gld = ld * 2; gofs = base + row * gld + ((unsigned)gc - c0) * 2;
  }
  __device__ __forceinline__ void pre(f32x4 (&v)[2][2], int rowstep, int ai, int m, const Ctx& c, const pg8::Unit& u, int wc, int fr, int fq, const PG8_LAS float* rtab) const {
    int pos = c.pos0 + rowstep; asm volatile("" : "+v"(pos));
    const int rp = pos >> 6, cp = pos & 63; const bool lat = c.lat;
#pragma unroll
    for (int bj = 0; bj < 2; ++bj) {
      const int cg = u.pn * 256 + bj * 128 + wc * 32, g32 = cg >> 5;
      f32x4& v0 = v[bj][0]; f32x4& v1 = v[bj][1];
      if (g32 < 20) {
        if (lat) { const f32x4 w64 = *(const PG8_LAS f32x4*)(rtab + 4 * fq); rot4(v0, v1, (g32 & 1) ? cp : rp, w64); }
        if (g32 < 16) { v0 = v0 * SCALE_A; v1 = v1 * SCALE_A; }
      } else if (g32 >= 24 && g32 < 44) {
        float sq = v0[0] * v0[0] + v0[1] * v0[1] + v0[2] * v0[2] + v0[3] * v0[3] + v1[0] * v1[0] + v1[1] * v1[1] + v1[2] * v1[2] + v1[3] * v1[3];
        sq = sum16sw(sq); sq = sum32sw(sq);
        if (fq == 0) atomicAdd(WSE(float, g32 < 36 ? OFF_SSQQ : OFF_SSQK) + (u.r0 + rowstep + c.rloc), sq);
      } else if (g32 == 44) { if (lat) { const f32x4 w32 = *(const PG8_LAS f32x4*)(rtab + 16 + 4 * (fq & 1)); rope32_hw(v0, v1, rp, cp, fq, w32); } }
    }
  }
};
struct Epi2Qup {
  static constexpr int NCOL = 256; static constexpr bool LEAN = false; static constexpr bool EARLY = true;
  EPI_RUN
  unsigned char* ws;
  struct Ctx { float rs[2][4]; int pos0; bool lat; };
  __device__ __forceinline__ void begin(Ctx& c, const pg8::Unit& u, int wr, int wc, int fr, int fq) const {
    tile_pos(u.pm, c.lat, c.pos0); c.pos0 += wr * 64 + fr + (u.r0 - u.pm * 256);
#pragma unroll
    for (int ai = 0; ai < 2; ++ai)
#pragma unroll
      for (int m = 0; m < 4; ++m) c.rs[ai][m] = WSE(float, OFF_SSQQ)[u.r0 + ai * 128 + wr * 64 + m * 16 + fr];
#pragma unroll
    for (int ai = 0; ai < 2; ++ai)
#pragma unroll
      for (int m = 0; m < 4; ++m) c.rs[ai][m] = rsqrtf(c.rs[ai][m] * (1.f / QRK) + EPS) * SCALE_B; }
  __device__ __forceinline__ void dst(const pg8::Unit& u, int rsub, int col, unsigned& gofs, unsigned& gld, bool& gval) const {
    gld = NQB * 2; gofs = (unsigned)(OFF_R + R_QB) + (unsigned)(u.r0 + rsub) * gld + (u.pn * 256 + col) * 2; gval = true; }
  __device__ __forceinline__ void pre(f32x4 (&v)[2][2], int rowstep, int ai, int m, const Ctx& c, const pg8::Unit& u, int wc, int fr, int fq, const PG8_LAS float* rtab) const {
    int pos = c.pos0 + rowstep; asm volatile("" : "+v"(pos));
    const int rp = pos >> 6, cp = pos & 63; const float rs = c.rs[ai][m];
#pragma unroll
    for (int bj = 0; bj < 2; ++bj) { const int g32 = (u.pn * 256 + bj * 128 + wc * 32) >> 5;
      v[bj][0] = v[bj][0] * rs; v[bj][1] = v[bj][1] * rs;
      if ((g32 % 3) == 2) { if (c.lat) { const f32x4 w32 = *(const PG8_LAS f32x4*)(rtab + 16 + 4 * (fq & 1)); rope32_hw(v[bj][0], v[bj][1], rp, cp, fq, w32); } } }
  }
};
struct Epi2KV {
  static constexpr int NCOL = 256; static constexpr bool LEAN = false; static constexpr bool EARLY = true;
  EPI_RUN
  unsigned char* ws;
  struct Ctx { float rs[2][4]; };
  __device__ __forceinline__ void begin(Ctx& c, const pg8::Unit& u, int wr, int wc, int fr, int fq) const {
#pragma unroll
    for (int ai = 0; ai < 2; ++ai)
#pragma unroll
      for (int m = 0; m < 4; ++m) c.rs[ai][m] = WSE(float, OFF_SSQK)[u.r0 + ai * 128 + wr * 64 + m * 16 + fr];
#pragma unroll
    for (int ai = 0; ai < 2; ++ai)
#pragma unroll
      for (int m = 0; m < 4; ++m) c.rs[ai][m] = rsqrtf(c.rs[ai][m] * (1.f / KVRK) + EPS); }
  __device__ __forceinline__ void dst(const pg8::Unit& u, int rsub, int col, unsigned& gofs, unsigned& gld, bool& gval) const {
    const int gc = u.pn * 256 + col, hd = gc >> 7, sub = (gc >> 6) & 1;
    gld = 512 * 2; gofs = (unsigned)(OFF_R + (sub ? R_VB : R_KB)) + (unsigned)(u.r0 + rsub) * gld + (hd * 64 + (gc & 63)) * 2; gval = true; }
  __device__ __forceinline__ void pre(f32x4 (&v)[2][2], int rowstep, int ai, int m, const Ctx& c, const pg8::Unit& u, int wc, int fr, int fq, const PG8_LAS float* rtab) const {
    const float rs = c.rs[ai][m];
#pragma unroll
    for (int bj = 0; bj < 2; ++bj) { v[bj][0] = v[bj][0] * rs; v[bj][1] = v[bj][1] * rs; }
  }
};
struct Epi2Out {
  static constexpr int NCOL = 256; static constexpr bool LEAN = false; static constexpr bool EARLY = false;
  EPI_RUN
  unsigned char* ws; int l;
  struct Ctx { f32x4 ga[2][2]; };
  __device__ __forceinline__ void begin(Ctx& c, const pg8::Unit& u, int wr, int wc, int fr, int fq) const {
    const float* ga = WSE(float, OFF_MOD) + (size_t)(l * 5 + row_mi(u.pm * 256)) * 6144 + 2 * 1024 + u.pn * 256 + wc * 32 + 4 * fq;
#pragma unroll
    for (int bj = 0; bj < 2; ++bj)
#pragma unroll
      for (int n = 0; n < 2; ++n) c.ga[bj][n] = *(const f32x4*)(ga + bj * 128 + n * 16); }
  __device__ __forceinline__ void dst(const pg8::Unit& u, int rsub, int col, unsigned& gofs, unsigned& gld, bool& gval) const {
    gld = DM * 2; gofs = (unsigned)(OFF_R + R_MIXG) + (unsigned)(u.r0 + rsub) * gld + (u.pn * 256 + col) * 2; gval = true; }
  __device__ __forceinline__ void pre(f32x4 (&v)[2][2], int rowstep, int ai, int m, const Ctx& c, const pg8::Unit& u, int wc, int fr, int fq, const PG8_LAS float* rtab) const {
#pragma unroll
    for (int bj = 0; bj < 2; ++bj)
#pragma unroll
      for (int n = 0; n < 2; ++n) v[bj][n] = v[bj][n] * c.ga[bj][n];
  }
};
struct Epi2MoeUp {
  static constexpr int NCOL = 128; static constexpr bool LEAN = false; static constexpr bool EARLY = false;
  EPI_RUN
  unsigned char* ws;
  struct Ctx { };
  __device__ __forceinline__ void begin(Ctx& c, const pg8::Unit& u, int wr, int wc, int fr, int fq) const { }
  __device__ __forceinline__ void dst(const pg8::Unit& u, int rsub, int col, unsigned& gofs, unsigned& gld, bool& gval) const {
    gld = DFF * 2; gofs = (unsigned)(OFF_R + R_ACT) + (unsigned)(u.r0 + rsub) * gld + (u.pn * 128 + col) * 2; gval = true; }
  __device__ __forceinline__ void pre(f32x4 (&v)[2][2], int rowstep, int ai, int m, const Ctx& c, const pg8::Unit& u, int wc, int fr, int fq, const PG8_LAS float* rtab) const {
#pragma unroll
    for (int n = 0; n < 2; ++n)
#pragma unroll
      for (int j = 0; j < 4; ++j) v[0][n][j] = silu_fast(v[0][n][j]) * v[1][n][j];
  }
};
struct Epi2MoeDown {
  static constexpr int NCOL = 256; static constexpr bool LEAN = false; static constexpr bool EARLY = true;
  EPI_RUN
  unsigned char* ws;
  struct Ctx { float vv[2][4]; };
  __device__ __forceinline__ void begin(Ctx& c, const pg8::Unit& u, int wr, int wc, int fr, int fq) const {
#pragma unroll
    for (int ai = 0; ai < 2; ++ai)
#pragma unroll
      for (int m = 0; m < 4; ++m) c.vv[ai][m] = WSE(float, OFF_VAL)[u.r0 + ai * 128 + wr * 64 + m * 16 + fr]; }
  __device__ __forceinline__ void dst(const pg8::Unit& u, int rsub, int col, unsigned& gofs, unsigned& gld, bool& gval) const {
    gld = DM * 2; gofs = (unsigned)(OFF_R + R_Y) + (unsigned)(u.r0 + rsub) * gld + (u.pn * 256 + col) * 2; gval = true; }
  __device__ __forceinline__ void pre(f32x4 (&v)[2][2], int rowstep, int ai, int m, const Ctx& c, const pg8::Unit& u, int wc, int fr, int fq, const PG8_LAS float* rtab) const {
    const float vv = c.vv[ai][m];
#pragma unroll
    for (int bj = 0; bj < 2; ++bj) { v[bj][0] = v[bj][0] * vv; v[bj][1] = v[bj][1] * vv; }
  }
};
#define LDS3 ((PG8_LAS unsigned char*)lds)
__device__ __forceinline__ void ph2_gemm_in(const Prm& p, int l, unsigned char* lds, int bid, int nb) {
  pg8::Gemm g{(const bf16_t*)(p.ws + OFF_R + R_H), (const bf16_t*)(p.ws + OFF_W + (size_t)l * SZ_WL), DM, nullptr};
  const int vcu = vcu_of(bid, nb);
  const int nun = (MR / 256) * (NINP / 256), extra = nun % nb;
  const bool halftail = extra > 0 && 2 * extra <= nb;
  SchedDense S{MR / 256, NINP / 256, nb, vcu, false, false, halftail ? nun - extra : nun}; Epi2In E{p.ws};
  pg8::gemm_phase<false>(LDS3, g, S, E);
  if (halftail) { SchedDenseTail T{NINP / 256, nun - extra, 2 * extra, vcu}; pg8::gemm_phase<false, true>(LDS3, g, T, E);
    if (vcu >= 2 * extra) ph_wconv_moe(p, l, lds, vcu - 2 * extra, nb - 2 * extra); }
  else if (extra == 0) ph_wconv_moe(p, l, lds, vcu, nb); else if (vcu >= extra) ph_wconv_moe(p, l, lds, vcu - extra, nb - extra);
}
__device__ __forceinline__ void ph2_gemm_qup(const Prm& p, int l, unsigned char* lds, int bid, int nb) {
  pg8::Gemm g{(const bf16_t*)(p.ws + OFF_R + R_CQ), (const bf16_t*)(p.ws + OFF_W + (size_t)l * SZ_WL + SZ_WIN), QRK, nullptr};
  const bool lastl = (l == DEPTH - 1); SchedDense S{lastl ? MR / 256 - NB : MR / 256, NQB / 256, nb, vcu_of(bid, nb), false, lastl, (lastl ? MR / 256 - NB : MR / 256) * (NQB / 256)}; Epi2Qup E{p.ws}; pg8::gemm_phase<false>(LDS3, g, S, E);
}
__device__ __forceinline__ void ph2_gemm_kvup(const Prm& p, int l, unsigned char* lds, int bid, int nb) {
  pg8::Gemm g{(const bf16_t*)(p.ws + OFF_R + R_CKV), (const bf16_t*)(p.ws + OFF_W + (size_t)l * SZ_WL + SZ_WIN + SZ_WQ), KVRK, nullptr};
  SchedDense S{MR / 256, NKVB / 256, nb, vcu_of(bid, nb), true, false, (MR / 256) * (NKVB / 256)}; Epi2KV E{p.ws}; pg8::gemm_phase<false>(LDS3, g, S, E);
}
__device__ __forceinline__ void ph2_gemm_out(const Prm& p, int l, unsigned char* lds, int bid, int nb) {
  pg8::Gemm g{(const bf16_t*)(p.ws + OFF_R + R_H), (const bf16_t*)(p.ws + OFF_W + (size_t)l * SZ_WL + SZ_WIN + SZ_WQ + SZ_WKV), DM, nullptr};
  const bool lastl = (l == DEPTH - 1); const int vcu = vcu_of(bid, nb);
  const int nun = (lastl ? MR / 256 - NB : MR / 256) * (DM / 256), extra = nun % nb;
  const bool halftail = !lastl && extra > 0 && 2 * extra <= nb;
  SchedDense S{lastl ? MR / 256 - NB : MR / 256, DM / 256, nb, vcu, false, lastl, halftail ? nun - extra : nun}; Epi2Out E{p.ws, l};
  pg8::gemm_phase<false>(LDS3, g, S, E);
  if (halftail) { SchedDenseTail T{DM / 256, nun - extra, 2 * extra, vcu}; pg8::gemm_phase<false, true>(LDS3, g, T, E); }
  if (l + 1 < DEPTH) {
    const int busy = halftail ? 2 * extra : extra;
    if (busy == 0) { ph_mod(p, l + 1, lds, vcu, nb); ph_wconv_dense(p, l + 1, lds, vcu, nb); }
    else if (vcu >= busy) { ph_mod(p, l + 1, lds, vcu - busy, nb - busy); ph_wconv_dense(p, l + 1, lds, vcu - busy, nb - busy); }
  }
}
__device__ __forceinline__ void ph2_moe_up(const Prm& p, int l, unsigned char* lds, int bid, int nb) {
  pg8::Gemm g{(const bf16_t*)(p.ws + OFF_R + R_H), WSP(bf16_t, OFF_WGU), DM, WSP(int, OFF_IDX)};
  const bool halftail = (l != DEPTH - 1) && nb >= 256;
  SchedMoe S{(l == DEPTH - 1 || halftail) ? 256 : 272, nb, vcu_of(bid, nb), (size_t)1024 * 1024 * 2}; Epi2MoeUp E{p.ws};
  pg8::gemm_phase<true>(LDS3, g, S, E);
  if (halftail) { SchedMoeTail T{vcu_of(bid, nb), (size_t)1024 * 1024 * 2}; pg8::gemm_phase<true, true>(LDS3, g, T, E); }
}
__device__ __forceinline__ void ph2_moe_down(const Prm& p, int l, unsigned char* lds, int bid, int nb) {
  pg8::Gemm g{(const bf16_t*)(p.ws + OFF_R + R_ACT), WSP(bf16_t, OFF_WD), DFF, nullptr};
  const bool halftail = (l != DEPTH - 1) && nb >= 256;
  SchedMoe S{(l == DEPTH - 1 || halftail) ? 256 : 272, nb, vcu_of(bid, nb), (size_t)1024 * 512 * 2}; Epi2MoeDown E{p.ws};
  pg8::gemm_phase<false>(LDS3, g, S, E);
  if (halftail) { SchedMoeTail T{vcu_of(bid, nb), (size_t)1024 * 512 * 2}; pg8::gemm_phase<false, true>(LDS3, g, T, E); }
}

template <int DQK>
__device__ __forceinline__ void attn_naive_unit(const Prm& p, int l, int kind, int b, int hd, int qblk, unsigned char* lds) {
  float* Ks = (float*)lds;
  float* Vs = Ks + 32 * DQK;
  const int tid = TIDX;
  const bool isB = (kind == 0 || kind == 2), isctx = kind >= 2;
  const int nq = isctx ? LC : SEQ; const int qi = qblk * NTHR + tid; const bool qvalid = qi < nq;
  const int qrow = b * TT + (isctx ? 0 : LC) + (qvalid ? qi : 0);
  float q[DQK];
  { const bf16_t* qp = isB ? (const bf16_t*)(p.ws + OFF_R + R_QB) + (size_t)qrow * NQB + hd * 96 : (const bf16_t*)(p.ws + OFF_R + R_QA) + (size_t)qrow * 512 + hd * 64;
#pragma unroll
    for (int d = 0; d < DQK; ++d) q[d] = bf2f(qp[d]); }
  float m = -1e30f, lsum = 0.f, o[64];
#pragma unroll
  for (int d = 0; d < 64; ++d) o[d] = 0.f;
  const int q0 = qblk * NTHR;
  int klo = 0, khi = LC;
  if (!isctx) { if (isB) khi = TT; else { klo = max(0, q0 - 128); khi = min(SEQ, q0 + NTHR + 128); } }
  const int kvh = hd >> 2;
  for (int seg = 0; seg < 2; ++seg) {
    int t0, t1; if (seg == 0) { t0 = 0; t1 = LC; } else { if (isctx) break; if (isB) { t0 = LC; t1 = TT; } else { t0 = LC + klo; t1 = LC + khi; } }
    for (int tb = t0; tb < t1; tb += 32) {
      __syncthreads();
      {
        for (int i = tid; i < 32 * DQK; i += NTHR) { const int kk = i / DQK, d = i % DQK; const size_t kr = (size_t)(b * TT + tb + kk);
          float v;
          if (isB) v = d < 64 ? bf2f(((const bf16_t*)(p.ws + OFF_R + R_KB))[kr * 512 + hd * 64 + d]) : bf2f(WSP(bf16_t, OFF_KR)[kr * 32 + d - 64]);
          else v = bf2f(((const bf16_t*)(p.ws + OFF_R + R_KA))[kr * 128 + kvh * 64 + d]);
          Ks[i] = v; }
        for (int i = tid; i < 32 * 64; i += NTHR) { const int kk = i >> 6, d = i & 63; const size_t kr = (size_t)(b * TT + tb + kk);
          Vs[i] = isB ? bf2f(((const bf16_t*)(p.ws + OFF_R + R_VB))[kr * 512 + hd * 64 + d]) : bf2f(((const bf16_t*)(p.ws + OFF_R + R_VA))[kr * 128 + kvh * 64 + d]); }
      }
      __syncthreads();
      if (qvalid) {
        for (int kk = 0; kk < 32; ++kk) {
          if (!isB && seg == 1) { const int ts = tb + kk - LC; const int dlt = qi - ts; if (dlt > 128 || dlt < -128) continue; }
          float s = 0.f;
#pragma unroll
          for (int d = 0; d < DQK; ++d) s += q[d] * Ks[kk * DQK + d];
          if (s > m) { const float al = exp2f(m - s); lsum *= al;
#pragma unroll
            for (int d = 0; d < 64; ++d) o[d] *= al;
            m = s; }
          const float pe = exp2f(s - m); lsum += pe;
#pragma unroll
          for (int d = 0; d < 64; ++d) o[d] += pe * Vs[kk * 64 + d];
        }
      }
    }
  }
  if (qvalid) {
    if (!isB) { const float sk = p.sink[l * 8 + hd] * LOG2E; if (sk > m) { const float al = exp2f(m - sk); lsum = lsum * al + 1.f;
#pragma unroll
        for (int d = 0; d < 64; ++d) o[d] *= al; } else lsum += exp2f(sk - m); }
    const float il = 1.f / lsum;
    bf16_t* op = (bf16_t*)(p.ws + OFF_R + R_H) + (size_t)qrow * DM + (isB ? 512 : 0) + hd * 64;
#pragma unroll
    for (int d = 0; d < 64; ++d) op[d] = f2bf(o[d] * il);
  }
}
__device__ __forceinline__ void ph_attn_naive(const Prm& p, int l, unsigned char* lds, int bid, int nb) {
  const int nun = 1024 + (l == DEPTH - 1 ? 0 : 64);
  for (int u = bid; u < nun; u += nb) {
    int kind, b, hd, qb;
    if (u < 1024) { kind = u & 1; int r = u >> 1; qb = r & 15; r >>= 4; hd = r & 7; b = r >> 3; }
    else { const int r = u - 1024; kind = 2 + (r & 1); hd = (r >> 1) & 7; b = r >> 4; qb = 0; }
    if (kind == 0 || kind == 2) attn_naive_unit<96>(p, l, kind, b, hd, qb, lds); else attn_naive_unit<64>(p, l, kind, b, hd, qb, lds);
    __syncthreads();
  }
}

#define SBAR() __builtin_amdgcn_sched_barrier(0)
typedef short s16x4 __attribute__((ext_vector_type(4)));
__device__ __forceinline__ int crow(int r, int hi) { return (r & 3) + 8 * (r >> 2) + 4 * hi; }
__device__ __forceinline__ unsigned cvtpk(float lo, float hi) { unsigned r; asm volatile("v_cvt_pk_bf16_f32 %0, %1, %2" : "=v"(r) : "v"(lo), "v"(hi)); return r; }
constexpr float ATHR = 8.f;
__device__ __forceinline__ void partialSM(f32x16& p0, f32x16& p1, float& m_reg, float& alpha) {
  float pmax = p0[0];
#pragma unroll
  for (int r = 1; r < 16; ++r) pmax = fmaxf(pmax, p0[r]);
#pragma unroll
  for (int r = 0; r < 16; ++r) pmax = fmaxf(pmax, p1[r]);
  { auto rr = __builtin_amdgcn_permlane32_swap(__float_as_uint(pmax), __float_as_uint(pmax), false, false); pmax = fmaxf(__uint_as_float(rr[0]), __uint_as_float(rr[1])); }
  float mn;
  if (__builtin_expect(__all(pmax - m_reg <= ATHR), 1)) { mn = m_reg; alpha = 1.f; }
  else { mn = fmaxf(m_reg, pmax); alpha = __builtin_amdgcn_exp2f(m_reg - mn); m_reg = mn; }
#pragma unroll
  for (int r = 0; r < 16; ++r) { p0[r] -= mn; p1[r] -= mn; }
#pragma unroll
  for (int r = 0; r < 16; ++r) p0[r] = __builtin_amdgcn_exp2f(p0[r]);
}
__device__ __forceinline__ void finishSM(f32x16& p0, f32x16& p1, float alpha, float& l_reg, bf16x8& pa0, bf16x8& pa1, bf16x8& pa2, bf16x8& pa3) {
#pragma unroll
  for (int r = 0; r < 16; ++r) p1[r] = __builtin_amdgcn_exp2f(p1[r]);
  float ps = 0.f;
#pragma unroll
  for (int r = 0; r < 16; ++r) ps += p0[r];
#pragma unroll
  for (int r = 0; r < 16; ++r) ps += p1[r];
  { auto rr = __builtin_amdgcn_permlane32_swap(__float_as_uint(ps), __float_as_uint(ps), false, false); ps = __uint_as_float(rr[0]) + __uint_as_float(rr[1]); }
  l_reg = l_reg * alpha + ps;
#define PK4(P, BASE, OUT) do { unsigned a0 = cvtpk(P[BASE + 0], P[BASE + 1]), a1 = cvtpk(P[BASE + 2], P[BASE + 3]);   \
    unsigned b0 = cvtpk(P[BASE + 4], P[BASE + 5]), b1 = cvtpk(P[BASE + 6], P[BASE + 7]);                              \
    auto r0 = __builtin_amdgcn_permlane32_swap(a0, b0, false, false); auto r1 = __builtin_amdgcn_permlane32_swap(a1, b1, false, false); \
    u32x4 w = {r0[0], r1[0], r0[1], r1[1]}; OUT = *reinterpret_cast<bf16x8*>(&w); } while (0)
  PK4(p0, 0, pa0); PK4(p0, 8, pa1); PK4(p1, 0, pa2); PK4(p1, 8, pa3);
#undef PK4
}
template <int DQK>
__device__ __forceinline__ void qkt(f32x16& p0, f32x16& p1, const char* Ks, const bf16x8* qr, int r32, int hi) {
  constexpr int KST = DQK * 2 + 16;
  p0 = f32x16{}; p1 = f32x16{};
#pragma unroll
  for (int d0 = 0; d0 < DQK / 16; ++d0) { const int cb = (d0 * 16 + hi * 8) * 2;
    const bf16x8 b0 = *reinterpret_cast<const bf16x8*>(Ks + r32 * KST + cb);
    const bf16x8 b1 = *reinterpret_cast<const bf16x8*>(Ks + (32 + r32) * KST + cb);
    p0 = __builtin_amdgcn_mfma_f32_32x32x16_bf16(b0, qr[d0], p0, 0, 0, 0);
    p1 = __builtin_amdgcn_mfma_f32_32x32x16_bf16(b1, qr[d0], p1, 0, 0, 0); }
}
__device__ __forceinline__ int v_st(int k, int c) { const int kk = (k & ~0xC) | ((k & 4) << 1) | ((k & 8) >> 1); return ((kk >> 3) * 2 + (c >> 5)) * 512 + ((kk & 7) * 32 + (c & 31)) * 2; }
__device__ __forceinline__ int v_rd_base(int lane) { return ((lane & 3) << 3) | (((lane >> 2) & 3) << 6) | (((lane >> 4) & 1) << 5) | (((lane >> 5) & 1) << 8); }
constexpr int v_rd_off(int d0, int ks, int half) { return d0 * 512 + ks * 2048 + half * 1024; }
template <int OFF> __device__ __forceinline__ s16x4 tr_read(int vb) { s16x4 r; asm volatile("ds_read_b64_tr_b16 %0, %1 offset:%2" : "=&v"(r) : "v"(vb), "i"(OFF) : "memory"); return r; }
template <int D0> __device__ __forceinline__ void pv_one(f32x16& od, int vb, bf16x8 pa0, bf16x8 pa1, bf16x8 pa2, bf16x8 pa3) {
  const s16x4 l0 = tr_read<v_rd_off(D0, 0, 0)>(vb), h0 = tr_read<v_rd_off(D0, 0, 1)>(vb), l1 = tr_read<v_rd_off(D0, 1, 0)>(vb), h1 = tr_read<v_rd_off(D0, 1, 1)>(vb);
  const s16x4 l2 = tr_read<v_rd_off(D0, 2, 0)>(vb), h2 = tr_read<v_rd_off(D0, 2, 1)>(vb), l3 = tr_read<v_rd_off(D0, 3, 0)>(vb), h3 = tr_read<v_rd_off(D0, 3, 1)>(vb);
  asm volatile("s_waitcnt lgkmcnt(0)" ::: "memory"); SBAR();
#define PK(L, H) (bf16x8){L[0], L[1], L[2], L[3], H[0], H[1], H[2], H[3]}
  od = __builtin_amdgcn_mfma_f32_32x32x16_bf16(pa0, PK(l0, h0), od, 0, 0, 0);
  od = __builtin_amdgcn_mfma_f32_32x32x16_bf16(pa1, PK(l1, h1), od, 0, 0, 0);
  od = __builtin_amdgcn_mfma_f32_32x32x16_bf16(pa2, PK(l2, h2), od, 0, 0, 0);
  od = __builtin_amdgcn_mfma_f32_32x32x16_bf16(pa3, PK(l3, h3), od, 0, 0, 0);
#undef PK
}
__device__ __forceinline__ void pv_all(f32x16* o, int vb, bf16x8 pa0, bf16x8 pa1, bf16x8 pa2, bf16x8 pa3) { pv_one<0>(o[0], vb, pa0, pa1, pa2, pa3); pv_one<1>(o[1], vb, pa0, pa1, pa2, pa3); }

template <int KIND>
__device__ __forceinline__ void attn_fast_unit(const Prm& p, int l, bool isctx, int b, int hd, int qb, unsigned char* ldsu) {
  constexpr int DQK = KIND == 0 ? 96 : 64, KST = DQK * 2 + 16, SHM_K = 64 * KST, SHM_V = 8192, LPT = KIND == 0 ? 3 : 2;
  char* lds = (char*)ldsu;
  const int tid = TIDX, wid = tid >> 6, lane = tid & 63, r32 = lane & 31, hi = lane >> 5;
  char* V_lds = lds; char* K_lds = lds + 2 * SHM_V;
  float* ws = (float*)(lds + 2 * SHM_V + 2 * SHM_K) + wid * 64; float* li_l = ws; float* al_l = ws + 32;
  const int q0 = qb * 256;
  const size_t rowq0 = (size_t)b * TT + (isctx ? 0 : LC) + q0;
  const bf16_t *Qp, *Kp, *Vp; const bf16_t* KRp = WSP(bf16_t, OFF_KR); int ldq, ldk; int ocol;
  if (KIND == 0) { Qp = (const bf16_t*)(p.ws + OFF_R + R_QB) + hd * 96; ldq = NQB; Kp = (const bf16_t*)(p.ws + OFF_R + R_KB) + hd * 64; Vp = (const bf16_t*)(p.ws + OFF_R + R_VB) + hd * 64; ldk = 512; ocol = 512 + hd * 64; }
  else { Qp = (const bf16_t*)(p.ws + OFF_R + R_QA) + hd * 64; ldq = 512; Kp = (const bf16_t*)(p.ws + OFF_R + R_KA) + (hd >> 2) * 64; Vp = (const bf16_t*)(p.ws + OFF_R + R_VA) + (hd >> 2) * 64; ldk = 128; ocol = hd * 64; }
  int NT, kshift = 0; bool domask = false;
  if (isctx) NT = 4; else if (KIND == 0) NT = TT / 64; else { const int ks = max(0, q0 - 128), ke = min(SEQ, q0 + 384); NT = 4 + (ke - ks) / 64; kshift = ks; domask = true; }
  const size_t kb0 = (size_t)b * TT;
  float m_reg = -1e30f, l_reg = 0.f; f32x16 o[2] = {}; bf16x8 qr[DQK / 16];
  { const bf16_t* Qw = Qp + (rowq0 + wid * 32 + r32) * ldq + hi * 8;
#pragma unroll
    for (int d0 = 0; d0 < DQK / 16; ++d0) qr[d0] = *reinterpret_cast<const bf16x8*>(Qw + d0 * 16); }
  const int sr = tid >> 3, sc = (tid & 7) * 8, vst = v_st(sr, sc), kst = sr * KST + sc * 2;
  const int rr_ = (tid & 255) >> 2, rc_ = (tid & 3) * 8, krst = rr_ * KST + 128 + rc_ * 2;
  const int vb0 = (int)(uintptr_t)V_lds + v_rd_base(lane);
  struct { bf16x8 v, k, kr; } st_[2];
#define KROW(j) (kb0 + (size_t)(j) * 64 + ((j) >= 4 ? kshift : 0))
#define SLOAD(i, j) do { const size_t kr0_ = KROW(j); st_[i].v = *reinterpret_cast<const bf16x8*>(Vp + (kr0_ + sr) * ldk + sc); st_[i].k = *reinterpret_cast<const bf16x8*>(Kp + (kr0_ + sr) * ldk + sc); \
    if (KIND == 0) st_[i].kr = *reinterpret_cast<const bf16x8*>(KRp + (kr0_ + rr_) * 32 + rc_); } while (0)
#define SWRITE(bf, i) do { *(bf16x8*)(V_lds + (bf) * SHM_V + vst) = st_[i].v; *(bf16x8*)(K_lds + (bf) * SHM_K + kst) = st_[i].k; \
    if (KIND == 0) { if (tid < 256) *(bf16x8*)(K_lds + (bf) * SHM_K + krst) = st_[i].kr; } } while (0)
#define SWAIT() do { if (LPT == 3) asm volatile("s_waitcnt vmcnt(3)" ::: "memory"); else asm volatile("s_waitcnt vmcnt(2)" ::: "memory"); } while (0)
#define RESC(a) do { if (__any((a) < 1.f)) { if (hi == 0) al_l[r32] = (a); asm volatile("s_waitcnt lgkmcnt(0)" ::: "memory"); \
    _Pragma("unroll") for (int d = 0; d < 2; ++d) _Pragma("unroll") for (int r = 0; r < 16; ++r) o[d][r] *= al_l[crow(r, hi)]; } } while (0)
#define AMASK(P0, P1, j) do { if (KIND == 1) { if (domask && (j) >= 4) { const int tq_ = q0 + wid * 32 + r32; const int tk_ = kshift + ((j) - 4) * 64 + 4 * hi; \
    _Pragma("unroll") for (int r = 0; r < 16; ++r) { const int d_ = tq_ - (tk_ + (r & 3) + 8 * (r >> 2)); if (d_ > 128 || d_ < -128) P0[r] = -INFINITY; if (d_ - 32 > 128 || d_ - 32 < -128) P1[r] = -INFINITY; } } } } while (0)
  f32x16 pA0, pA1, pB0, pB1; float alA, alB; bf16x8 pa0, pa1, pa2, pa3;
  SLOAD(0, 0); asm volatile("s_waitcnt vmcnt(0)" ::: "memory"); SWRITE(0, 0); __syncthreads();
  qkt<DQK>(pA0, pA1, K_lds, qr, r32, hi); AMASK(pA0, pA1, 0); partialSM(pA0, pA1, m_reg, alA);
  SLOAD(1, 1); if (2 < NT) SLOAD(0, 2);
  SWAIT(); SWRITE(1, 1); __syncthreads();
  for (int j = 1; j + 1 < NT; j += 2) {
    SBAR(); qkt<DQK>(pB0, pB1, K_lds + SHM_K, qr, r32, hi);
    finishSM(pA0, pA1, alA, l_reg, pa0, pa1, pa2, pa3); SBAR();
    SLOAD(1, j + 2); SBAR();
    pv_all(o, vb0, pa0, pa1, pa2, pa3); AMASK(pB0, pB1, j); partialSM(pB0, pB1, m_reg, alB);
    __syncthreads(); SWAIT(); SWRITE(0, 0);
    RESC(alB); __syncthreads();
    SBAR(); qkt<DQK>(pA0, pA1, K_lds, qr, r32, hi);
    finishSM(pB0, pB1, alB, l_reg, pa0, pa1, pa2, pa3); SBAR();
    if (j + 3 < NT) SLOAD(0, j + 3); SBAR();
    pv_all(o, vb0 + SHM_V, pa0, pa1, pa2, pa3); AMASK(pA0, pA1, j + 1); partialSM(pA0, pA1, m_reg, alA);
    __syncthreads(); SWAIT(); SWRITE(1, 1);
    RESC(alA); __syncthreads();
  }
  SBAR(); qkt<DQK>(pB0, pB1, K_lds + SHM_K, qr, r32, hi);
  finishSM(pA0, pA1, alA, l_reg, pa0, pa1, pa2, pa3); SBAR();
  pv_all(o, vb0, pa0, pa1, pa2, pa3); AMASK(pB0, pB1, NT - 1); partialSM(pB0, pB1, m_reg, alB);
  __syncthreads(); RESC(alB);
  finishSM(pB0, pB1, alB, l_reg, pa0, pa1, pa2, pa3); SBAR();
  pv_all(o, vb0 + SHM_V, pa0, pa1, pa2, pa3);
  if (KIND == 1) l_reg += __builtin_amdgcn_exp2f(p.sink[l * 8 + hd] * LOG2E - m_reg);
  if (hi == 0) li_l[r32] = l_reg; asm volatile("s_waitcnt lgkmcnt(0)" ::: "memory");
  float rli[16];
#pragma unroll
  for (int r = 0; r < 16; ++r) rli[r] = __builtin_amdgcn_rcpf(li_l[crow(r, hi)]);
  bf16_t* Ow = (bf16_t*)(p.ws + OFF_R + R_H) + (rowq0 + wid * 32) * DM + ocol;
#pragma unroll
  for (int r = 0; r < 16; ++r) { const int orow = crow(r, hi);
#pragma unroll
    for (int d0 = 0; d0 < 2; ++d0) Ow[(size_t)orow * DM + d0 * 32 + r32] = f2bf(o[d0][r] * rli[r]); }
  __syncthreads();
#undef KROW
#undef SLOAD
#undef SWRITE
#undef SWAIT
#undef RESC
#undef AMASK
}
__device__ __forceinline__ float max3f_(float a, float b, float c) { return fmaxf(fmaxf(a, b), c); }
template <bool FIRST>
__device__ __forceinline__ void psm2(f32x16& p0, f32x16& p1, float& mhat, f32x16& negm, float& alpha) {
  float a = max3f_(p0[0], p0[1], p1[0]), b = max3f_(p0[2], p0[3], p1[1]); a = max3f_(a, p1[2], p1[3]);
#pragma unroll
  for (int r = 4; r < 16; r += 4) { a = max3f_(a, p0[r], p0[r + 1]); b = max3f_(b, p0[r + 2], p0[r + 3]); a = max3f_(a, p1[r], p1[r + 1]); b = max3f_(b, p1[r + 2], p1[r + 3]); }
  float rm = fmaxf(a, b);
  { auto rr = __builtin_amdgcn_permlane32_swap(__float_as_uint(rm), __float_as_uint(rm), false, false); rm = fmaxf(__uint_as_float(rr[0]), __uint_as_float(rr[1])); }
  alpha = 1.f;
  if (FIRST || __builtin_expect(__any(rm > ATHR), 0)) {
    const float dl = FIRST ? rm : fmaxf(rm, 0.f);
    mhat += dl;
#pragma unroll
    for (int r = 0; r < 16; ++r) { p0[r] -= dl; p1[r] -= dl; }
    const float nm = -mhat;
#pragma unroll
    for (int r = 0; r < 16; ++r) negm[r] = nm;
    alpha = __builtin_amdgcn_exp2f(-dl);
  }
#pragma unroll
  for (int r = 0; r < 16; ++r) p0[r] = __builtin_amdgcn_exp2f(p0[r]);
}
template <bool FIRST>
__device__ __forceinline__ void psm2q(f32x16& p0, f32x16& p1, float& mhat, f32x16& negm, float& alpha, float& lsum) {
  float a = max3f_(p0[0], p0[1], p1[0]), b = max3f_(p0[2], p0[3], p1[1]); a = max3f_(a, p1[2], p1[3]);
#pragma unroll
  for (int r = 4; r < 16; r += 4) { a = max3f_(a, p0[r], p0[r + 1]); b = max3f_(b, p0[r + 2], p0[r + 3]); a = max3f_(a, p1[r], p1[r + 1]); b = max3f_(b, p1[r + 2], p1[r + 3]); }
  float rm = fmaxf(a, b);
  { auto rr = __builtin_amdgcn_permlane32_swap(__float_as_uint(rm), __float_as_uint(rm), false, false); rm = fmaxf(__uint_as_float(rr[0]), __uint_as_float(rr[1])); }
  alpha = 1.f;
  if (FIRST || __builtin_expect(__any(rm > ATHR), 0)) {
    const float dl = FIRST ? rm : fmaxf(rm, 0.f);
    mhat += dl;
#pragma unroll
    for (int r = 0; r < 16; ++r) { p0[r] -= dl; p1[r] -= dl; }
    const float nm = -mhat;
#pragma unroll
    for (int r = 0; r < 16; ++r) negm[r] = nm;
    alpha = __builtin_amdgcn_exp2f(-dl);
  }
  float s0 = 0.f, s1 = 0.f;
#pragma unroll
  for (int r = 0; r < 16; r += 2) { p0[r] = __builtin_amdgcn_exp2f(p0[r]); s0 += p0[r]; p0[r + 1] = __builtin_amdgcn_exp2f(p0[r + 1]); s1 += p0[r + 1]; }
  lsum = FIRST ? (s0 + s1) : lsum * alpha + (s0 + s1);
}
__device__ __forceinline__ void fsm2(f32x16& p0, f32x16& p1, bf16x8& pa0, bf16x8& pa1, bf16x8& pa2, bf16x8& pa3) {
#pragma unroll
  for (int r = 0; r < 16; ++r) p1[r] = __builtin_amdgcn_exp2f(p1[r]);
#define PK4(P, BASE, OUT) do { unsigned a0 = cvtpk(P[BASE + 0], P[BASE + 1]), a1 = cvtpk(P[BASE + 2], P[BASE + 3]);   \
    unsigned b0 = cvtpk(P[BASE + 4], P[BASE + 5]), b1 = cvtpk(P[BASE + 6], P[BASE + 7]);                              \
    auto r0 = __builtin_amdgcn_permlane32_swap(a0, b0, false, false); auto r1 = __builtin_amdgcn_permlane32_swap(a1, b1, false, false); \
    u32x4 w = {r0[0], r1[0], r0[1], r1[1]}; OUT = *reinterpret_cast<bf16x8*>(&w); } while (0)
  PK4(p0, 0, pa0); PK4(p0, 8, pa1); PK4(p1, 0, pa2); PK4(p1, 8, pa3);
#undef PK4
}
template <int DQK>
__device__ __forceinline__ void qkt2(f32x16& p0, f32x16& p1, const char* Ks, const bf16x8* qr, const f32x16& negm, int r32, int hi) {
  constexpr int KST = DQK * 2 + 16, ND = DQK / 16;
  bf16x8 kb0[ND], kb1[ND];
#pragma unroll
  for (int d0 = 0; d0 < ND; ++d0) { const int cb = (d0 * 16 + hi * 8) * 2;
    kb0[d0] = *reinterpret_cast<const bf16x8*>(Ks + r32 * KST + cb); kb1[d0] = *reinterpret_cast<const bf16x8*>(Ks + (32 + r32) * KST + cb); }
#pragma unroll
  for (int d0 = 0; d0 < ND; ++d0) {
    if (d0 == 0) { p0 = __builtin_amdgcn_mfma_f32_32x32x16_bf16(kb0[0], qr[0], negm, 0, 0, 0); p1 = __builtin_amdgcn_mfma_f32_32x32x16_bf16(kb1[0], qr[0], negm, 0, 0, 0); }
    else { p0 = __builtin_amdgcn_mfma_f32_32x32x16_bf16(kb0[d0], qr[d0], p0, 0, 0, 0); p1 = __builtin_amdgcn_mfma_f32_32x32x16_bf16(kb1[d0], qr[d0], p1, 0, 0, 0); } }
}
__device__ __forceinline__ void pv_all2(f32x16* o, int vb, bf16x8 pa0, bf16x8 pa1, bf16x8 pa2, bf16x8 pa3) {
  pv_one<0>(o[0], vb, pa0, pa1, pa2, pa3); pv_one<1>(o[1], vb, pa0, pa1, pa2, pa3);
  const bf16x8 ones = {16256, 16256, 16256, 16256, 16256, 16256, 16256, 16256};
  o[2] = __builtin_amdgcn_mfma_f32_32x32x16_bf16(pa0, ones, o[2], 0, 0, 0); o[2] = __builtin_amdgcn_mfma_f32_32x32x16_bf16(pa1, ones, o[2], 0, 0, 0);
  o[2] = __builtin_amdgcn_mfma_f32_32x32x16_bf16(pa2, ones, o[2], 0, 0, 0); o[2] = __builtin_amdgcn_mfma_f32_32x32x16_bf16(pa3, ones, o[2], 0, 0, 0);
}
template <int KIND>
__device__ __forceinline__ void attn_fast_unit2(const Prm& p, int l, bool isctx, int b, int hd, int qb, unsigned char* ldsu) {
  constexpr int DQK = KIND == 0 ? 96 : 64, KST = DQK * 2 + 16, SHM_K = 64 * KST, SHM_V = 8192, LPT = KIND == 0 ? 3 : 2;
  char* lds = (char*)ldsu;
  const int tid = TIDX, wid = tid >> 6, lane = tid & 63, r32 = lane & 31, hi = lane >> 5;
  char* V_lds = lds; char* K_lds = lds + 2 * SHM_V;
  float* ws = (float*)(lds + 2 * SHM_V + 2 * SHM_K) + wid * 64; float* li_l = ws; float* al_l = ws + 32;
  const int q0 = qb * 256;
  const size_t rowq0 = (size_t)b * TT + (isctx ? 0 : LC) + q0;
  const bf16_t *Qp, *Kp, *Vp; const bf16_t* KRp = WSP(bf16_t, OFF_KR); int ldq, ldk; int ocol;
  if (KIND == 0) { Qp = (const bf16_t*)(p.ws + OFF_R + R_QB) + hd * 96; ldq = NQB; Kp = (const bf16_t*)(p.ws + OFF_R + R_KB) + hd * 64; Vp = (const bf16_t*)(p.ws + OFF_R + R_VB) + hd * 64; ldk = 512; ocol = 512 + hd * 64; }
  else { Qp = (const bf16_t*)(p.ws + OFF_R + R_QA) + hd * 64; ldq = 512; Kp = (const bf16_t*)(p.ws + OFF_R + R_KA) + (hd >> 2) * 64; Vp = (const bf16_t*)(p.ws + OFF_R + R_VA) + (hd >> 2) * 64; ldk = 128; ocol = hd * 64; }
  int NT, kshift = 0; bool domask = false;
  if (isctx) NT = 4; else if (KIND == 0) NT = TT / 64; else { const int ks = max(0, q0 - 128), ke = min(SEQ, q0 + 384); NT = 4 + (ke - ks) / 64; kshift = ks; domask = true; }
  const size_t kb0 = (size_t)b * TT;
  float mhat = 0.f; f32x16 o[3] = {}; f32x16 negm = {}; bf16x8 qr[DQK / 16];
  { const bf16_t* Qw = Qp + (rowq0 + wid * 32 + r32) * ldq + hi * 8;
#pragma unroll
    for (int d0 = 0; d0 < DQK / 16; ++d0) qr[d0] = *reinterpret_cast<const bf16x8*>(Qw + d0 * 16); }
  const int sr = tid >> 3, sc = (tid & 7) * 8, vst = v_st(sr, sc), kst = sr * KST + sc * 2;
  const int rr_ = (tid & 255) >> 2, rc_ = (tid & 3) * 8, krst = rr_ * KST + 128 + rc_ * 2;
  const int vb0 = (int)(uintptr_t)V_lds + v_rd_base(lane);
  struct { bf16x8 v, k, kr; } st_[1];
#define KROW(j) (kb0 + (size_t)(j) * 64 + ((j) >= 4 ? kshift : 0))
  const unsigned voffs = (unsigned)(sr * ldk + sc) * 2u, kroffs = (unsigned)(rr_ * 32 + rc_) * 2u;
#define SLOAD(i, j) do { const size_t kr0_ = KROW(j); const char* vb_ = (const char*)(Vp + kr0_ * ldk); const char* kb_ = (const char*)(Kp + kr0_ * ldk); \
    st_[i].v = *reinterpret_cast<const bf16x8*>(vb_ + voffs); st_[i].k = *reinterpret_cast<const bf16x8*>(kb_ + voffs); \
    if (KIND == 0) { const char* rb_ = (const char*)(KRp + kr0_ * 32); st_[i].kr = *reinterpret_cast<const bf16x8*>(rb_ + kroffs); } } while (0)
#define SWRITE(bf, i) do { *(bf16x8*)(V_lds + (bf) * SHM_V + vst) = st_[i].v; *(bf16x8*)(K_lds + (bf) * SHM_K + kst) = st_[i].k; \
    if (KIND == 0) { if (tid < 256) *(bf16x8*)(K_lds + (bf) * SHM_K + krst) = st_[i].kr; } } while (0)
#define SWAIT() do { if (LPT == 3) asm volatile("s_waitcnt vmcnt(3)" ::: "memory"); else asm volatile("s_waitcnt vmcnt(2)" ::: "memory"); } while (0)
#define RESC(a) do { if (__any((a) < 1.f)) { if (hi == 0) al_l[r32] = (a); asm volatile("s_waitcnt lgkmcnt(0)" ::: "memory"); \
    _Pragma("unroll") for (int d = 0; d < 3; ++d) _Pragma("unroll") for (int r = 0; r < 16; ++r) o[d][r] *= al_l[crow(r, hi)]; } } while (0)
#define AMASK(P0, P1, j) do { if (KIND == 1) { if (domask && (j) >= 4) { const int tq_ = q0 + wid * 32 + r32; const int tk_ = kshift + ((j) - 4) * 64 + 4 * hi; \
    _Pragma("unroll") for (int r = 0; r < 16; ++r) { const int d_ = tq_ - (tk_ + (r & 3) + 8 * (r >> 2)); if (d_ > 128 || d_ < -128) P0[r] = -INFINITY; if (d_ - 32 > 128 || d_ - 32 < -128) P1[r] = -INFINITY; } } } } while (0)
  if (__builtin_amdgcn_readfirstlane(wid) >= 4) __builtin_amdgcn_s_setprio(1);
  f32x16 pA0, pA1, pB0, pB1; float alA, alB; bf16x8 pa0, pa1, pa2, pa3;
  const int wq0_ = q0 + __builtin_amdgcn_readfirstlane(wid) * 32;
#define TACT(j) (KIND != 1 || !domask || (j) < 4 || (kshift + ((j) - 4) * 64 + 63 >= wq0_ - 128 && kshift + ((j) - 4) * 64 <= wq0_ + 31 + 128))
  bool actA, actB;
  SLOAD(0, 0); asm volatile("s_waitcnt vmcnt(0)" ::: "memory"); SWRITE(0, 0); __syncthreads();
  actA = true; qkt2<DQK>(pA0, pA1, K_lds, qr, negm, r32, hi); AMASK(pA0, pA1, 0); psm2<true>(pA0, pA1, mhat, negm, alA);
  SLOAD(0, 1);
  SWRITE(1, 0); __syncthreads();
  for (int j = 1; j + 1 < NT; j += 2) {
    actB = TACT(j);
    SBAR(); if (actB) qkt2<DQK>(pB0, pB1, K_lds + SHM_K, qr, negm, r32, hi);
    if (actA) fsm2(pA0, pA1, pa0, pa1, pa2, pa3); SBAR();
    SLOAD(0, j + 1); SBAR();
    if (actA) pv_all2(o, vb0, pa0, pa1, pa2, pa3); if (actB) { AMASK(pB0, pB1, j); psm2<false>(pB0, pB1, mhat, negm, alB); } else alB = 1.f;
    __syncthreads(); SWRITE(0, 0);
    RESC(alB); __syncthreads();
    actA = TACT(j + 1);
    SBAR(); if (actA) qkt2<DQK>(pA0, pA1, K_lds, qr, negm, r32, hi);
    if (actB) fsm2(pB0, pB1, pa0, pa1, pa2, pa3); SBAR();
    SLOAD(0, j + 2); SBAR();
    if (actB) pv_all2(o, vb0 + SHM_V, pa0, pa1, pa2, pa3); if (actA) { AMASK(pA0, pA1, j + 1); psm2<false>(pA0, pA1, mhat, negm, alA); } else alA = 1.f;
    __syncthreads(); SWRITE(1, 0);
    RESC(alA); __syncthreads();
  }
  actB = TACT(NT - 1);
  SBAR(); if (actB) qkt2<DQK>(pB0, pB1, K_lds + SHM_K, qr, negm, r32, hi);
  if (actA) fsm2(pA0, pA1, pa0, pa1, pa2, pa3); SBAR();
  if (actA) pv_all2(o, vb0, pa0, pa1, pa2, pa3); if (actB) { AMASK(pB0, pB1, NT - 1); psm2<false>(pB0, pB1, mhat, negm, alB); } else alB = 1.f;
  __syncthreads(); RESC(alB);
  if (actB) { fsm2(pB0, pB1, pa0, pa1, pa2, pa3); SBAR();
    pv_all2(o, vb0 + SHM_V, pa0, pa1, pa2, pa3); }
  __builtin_amdgcn_s_setprio(0);
  float rli[16];
  if (KIND == 1) { if (hi == 0) li_l[r32] = mhat; asm volatile("s_waitcnt lgkmcnt(0)" ::: "memory"); const float sk2 = p.sink[l * 8 + hd] * LOG2E;
#pragma unroll
    for (int r = 0; r < 16; ++r) rli[r] = __builtin_amdgcn_rcpf(o[2][r] + __builtin_amdgcn_exp2f(sk2 - li_l[crow(r, hi)])); }
  else {
#pragma unroll
    for (int r = 0; r < 16; ++r) rli[r] = __builtin_amdgcn_rcpf(o[2][r]); }
  bf16_t* Ow = (bf16_t*)(p.ws + OFF_R + R_H) + (rowq0 + wid * 32) * DM + ocol;
#pragma unroll
  for (int r = 0; r < 16; ++r) { const int orow = crow(r, hi);
#pragma unroll
    for (int d0 = 0; d0 < 2; ++d0) Ow[(size_t)orow * DM + d0 * 32 + r32] = f2bf(o[d0][r] * rli[r]); }
  __syncthreads();
#undef KROW
#undef SLOAD
#undef SWRITE
#undef SWAIT
#undef RESC
#undef AMASK
#undef TACT
}
#ifdef DBG_ATTN_PROBE
template <int KIND, int VAR>
__device__ __forceinline__ void attn_probe_unit(const Prm& p, int l, bool isctx, int b, int hd, int qb, unsigned char* ldsu) {
  constexpr int DQK = KIND == 0 ? 96 : 64, KST = DQK * 2 + 16, SHM_K = 64 * KST, SHM_V = 8192, LPT = KIND == 0 ? 3 : 2;
  char* lds = (char*)ldsu;
  const int tid = TIDX, wid = tid >> 6, lane = tid & 63, r32 = lane & 31, hi = lane >> 5;
  char* V_lds = lds; char* K_lds = lds + 2 * SHM_V;
  float* ws = (float*)(lds + 2 * SHM_V + 2 * SHM_K) + wid * 64; float* li_l = ws; float* al_l = ws + 32;
  const int q0 = qb * 256;
  const size_t rowq0 = (size_t)b * TT + (isctx ? 0 : LC) + q0;
  const bf16_t *Qp, *Kp, *Vp; const bf16_t* KRp = WSP(bf16_t, OFF_KR); int ldq, ldk; int ocol;
  if (KIND == 0) { Qp = (const bf16_t*)(p.ws + OFF_R + R_QB) + hd * 96; ldq = NQB; Kp = (const bf16_t*)(p.ws + OFF_R + R_KB) + hd * 64; Vp = (const bf16_t*)(p.ws + OFF_R + R_VB) + hd * 64; ldk = 512; ocol = 512 + hd * 64; }
  else { Qp = (const bf16_t*)(p.ws + OFF_R + R_QA) + hd * 64; ldq = 512; Kp = (const bf16_t*)(p.ws + OFF_R + R_KA) + (hd >> 2) * 64; Vp = (const bf16_t*)(p.ws + OFF_R + R_VA) + (hd >> 2) * 64; ldk = 128; ocol = hd * 64; }
  int NT, kshift = 0; bool domask = false;
  if (isctx) NT = 4; else if (KIND == 0) NT = TT / 64; else { const int ks = max(0, q0 - 128), ke = min(SEQ, q0 + 384); NT = 4 + (ke - ks) / 64; kshift = ks; domask = true; }
  const size_t kb0 = (size_t)b * TT;
  float mhat = 0.f; f32x16 o[3] = {}; f32x16 negm = {}; bf16x8 qr[DQK / 16];
  { const bf16_t* Qw = Qp + (rowq0 + wid * 32 + r32) * ldq + hi * 8;
#pragma unroll
    for (int d0 = 0; d0 < DQK / 16; ++d0) qr[d0] = *reinterpret_cast<const bf16x8*>(Qw + d0 * 16); }
  const int sr = tid >> 3, sc = (tid & 7) * 8, vst = v_st(sr, sc), kst = sr * KST + sc * 2;
  const int rr_ = (tid & 255) >> 2, rc_ = (tid & 3) * 8, krst = rr_ * KST + 128 + rc_ * 2;
  const int vb0 = (int)(uintptr_t)V_lds + v_rd_base(lane);
  struct { bf16x8 v, k, kr; } st_[1];
#define KROW(j) (kb0 + (size_t)(j) * 64 + ((j) >= 4 ? kshift : 0))
#define SLOAD(i, j) do { if (VAR & 4) break; const size_t kr0_ = KROW(j); st_[i].v = *reinterpret_cast<const bf16x8*>(Vp + (kr0_ + sr) * ldk + sc); st_[i].k = *reinterpret_cast<const bf16x8*>(Kp + (kr0_ + sr) * ldk + sc); \
    if (KIND == 0) st_[i].kr = *reinterpret_cast<const bf16x8*>(KRp + (kr0_ + rr_) * 32 + rc_); } while (0)
#define SWRITE(bf, i) do { if (VAR & 4) break; *(bf16x8*)(V_lds + (bf) * SHM_V + vst) = st_[i].v; *(bf16x8*)(K_lds + (bf) * SHM_K + kst) = st_[i].k; \
    if (KIND == 0) { if (tid < 256) *(bf16x8*)(K_lds + (bf) * SHM_K + krst) = st_[i].kr; } } while (0)
#define SWAIT() do { if (LPT == 3) asm volatile("s_waitcnt vmcnt(3)" ::: "memory"); else asm volatile("s_waitcnt vmcnt(2)" ::: "memory"); } while (0)
#define RESC(a) do { if (__any((a) < 1.f)) { if (hi == 0) al_l[r32] = (a); asm volatile("s_waitcnt lgkmcnt(0)" ::: "memory"); \
    _Pragma("unroll") for (int d = 0; d < 3; ++d) _Pragma("unroll") for (int r = 0; r < 16; ++r) o[d][r] *= al_l[crow(r, hi)]; } } while (0)
#define AMASK(P0, P1, j) do { if (KIND == 1) { if (domask && (j) >= 4) { const int tq_ = q0 + wid * 32 + r32; const int tk_ = kshift + ((j) - 4) * 64 + 4 * hi; \
    _Pragma("unroll") for (int r = 0; r < 16; ++r) { const int d_ = tq_ - (tk_ + (r & 3) + 8 * (r >> 2)); if (d_ > 128 || d_ < -128) P0[r] = -INFINITY; if (d_ - 32 > 128 || d_ - 32 < -128) P1[r] = -INFINITY; } } } } while (0)
  f32x16 pA0, pA1, pB0, pB1; float alA, alB; bf16x8 pa0, pa1, pa2, pa3;
  const int wq0_ = q0 + __builtin_amdgcn_readfirstlane(wid) * 32;
#define TACT(j) (KIND != 1 || !domask || (j) < 4 || (kshift + ((j) - 4) * 64 + 63 >= wq0_ - 128 && kshift + ((j) - 4) * 64 <= wq0_ + 31 + 128))
  bool actA, actB;
  SLOAD(0, 0); asm volatile("s_waitcnt vmcnt(0)" ::: "memory"); SWRITE(0, 0); do { if (!(VAR & 1)) __syncthreads(); } while (0);
  do { if (!(VAR & 16)) qkt2<DQK>(pA0, pA1, K_lds, qr, negm, r32, hi); else { pA0 = negm; pA1 = negm; asm volatile("" : "+v"(pA0), "+v"(pA1)); } } while (0); AMASK(pA0, pA1, 0); do { if (!(VAR & 2)) psm2<true>(pA0, pA1, mhat, negm, alA); else alA = 1.f; } while (0);
  SLOAD(0, 1);
  SWRITE(1, 0); do { if (!(VAR & 1)) __syncthreads(); } while (0);
  for (int j = 1; j + 1 < NT; j += 2) {
    SBAR(); do { if (!(VAR & 16)) qkt2<DQK>(pB0, pB1, K_lds + SHM_K, qr, negm, r32, hi); else { pB0 = negm; pB1 = negm; asm volatile("" : "+v"(pB0), "+v"(pB1)); } } while (0);
    do { if (!(VAR & 2)) fsm2(pA0, pA1, pa0, pa1, pa2, pa3); else { pa0 = __builtin_bit_cast(bf16x8, (f32x4){pA0[0], pA0[1], pA0[2], pA0[3]}); pa1 = __builtin_bit_cast(bf16x8, (f32x4){pA0[4], pA0[5], pA0[6], pA0[7]}); pa2 = __builtin_bit_cast(bf16x8, (f32x4){pA1[0], pA1[1], pA1[2], pA1[3]}); pa3 = __builtin_bit_cast(bf16x8, (f32x4){pA1[4], pA1[5], pA1[6], pA1[7]}); } } while (0); SBAR();
    SLOAD(0, j + 1); SBAR();
    do { if (!(VAR & 8)) pv_all2(o, vb0, pa0, pa1, pa2, pa3); else { asm volatile("" :: "v"(pa0), "v"(pa1), "v"(pa2), "v"(pa3)); } } while (0); AMASK(pB0, pB1, j); do { if (!(VAR & 2)) psm2<false>(pB0, pB1, mhat, negm, alB); else alB = 1.f; } while (0);
    do { if (!(VAR & 1)) __syncthreads(); } while (0); SWRITE(0, 0);
    RESC(alB); do { if (!(VAR & 1)) __syncthreads(); } while (0);
    SBAR(); do { if (!(VAR & 16)) qkt2<DQK>(pA0, pA1, K_lds, qr, negm, r32, hi); else { pA0 = negm; pA1 = negm; asm volatile("" : "+v"(pA0), "+v"(pA1)); } } while (0);
    do { if (!(VAR & 2)) fsm2(pB0, pB1, pa0, pa1, pa2, pa3); else { pa0 = __builtin_bit_cast(bf16x8, (f32x4){pB0[0], pB0[1], pB0[2], pB0[3]}); pa1 = __builtin_bit_cast(bf16x8, (f32x4){pB0[4], pB0[5], pB0[6], pB0[7]}); pa2 = __builtin_bit_cast(bf16x8, (f32x4){pB1[0], pB1[1], pB1[2], pB1[3]}); pa3 = __builtin_bit_cast(bf16x8, (f32x4){pB1[4], pB1[5], pB1[6], pB1[7]}); } } while (0); SBAR();
    SLOAD(0, j + 2); SBAR();
    do { if (!(VAR & 8)) pv_all2(o, vb0 + SHM_V, pa0, pa1, pa2, pa3); else { asm volatile("" :: "v"(pa0), "v"(pa1), "v"(pa2), "v"(pa3)); } } while (0); AMASK(pA0, pA1, j + 1); do { if (!(VAR & 2)) psm2<false>(pA0, pA1, mhat, negm, alA); else alA = 1.f; } while (0);
    do { if (!(VAR & 1)) __syncthreads(); } while (0); SWRITE(1, 0);
    RESC(alA); do { if (!(VAR & 1)) __syncthreads(); } while (0);
  }
  SBAR(); do { if (!(VAR & 16)) qkt2<DQK>(pB0, pB1, K_lds + SHM_K, qr, negm, r32, hi); else { pB0 = negm; pB1 = negm; asm volatile("" : "+v"(pB0), "+v"(pB1)); } } while (0);
  do { if (!(VAR & 2)) fsm2(pA0, pA1, pa0, pa1, pa2, pa3); else { pa0 = __builtin_bit_cast(bf16x8, (f32x4){pA0[0], pA0[1], pA0[2], pA0[3]}); pa1 = __builtin_bit_cast(bf16x8, (f32x4){pA0[4], pA0[5], pA0[6], pA0[7]}); pa2 = __builtin_bit_cast(bf16x8, (f32x4){pA1[0], pA1[1], pA1[2], pA1[3]}); pa3 = __builtin_bit_cast(bf16x8, (f32x4){pA1[4], pA1[5], pA1[6], pA1[7]}); } } while (0); SBAR();
  do { if (!(VAR & 8)) pv_all2(o, vb0, pa0, pa1, pa2, pa3); else { asm volatile("" :: "v"(pa0), "v"(pa1), "v"(pa2), "v"(pa3)); } } while (0); AMASK(pB0, pB1, NT - 1); do { if (!(VAR & 2)) psm2<false>(pB0, pB1, mhat, negm, alB); else alB = 1.f; } while (0);
  do { if (!(VAR & 1)) __syncthreads(); } while (0); RESC(alB);
  do { if (!(VAR & 2)) fsm2(pB0, pB1, pa0, pa1, pa2, pa3); else { pa0 = __builtin_bit_cast(bf16x8, (f32x4){pB0[0], pB0[1], pB0[2], pB0[3]}); pa1 = __builtin_bit_cast(bf16x8, (f32x4){pB0[4], pB0[5], pB0[6], pB0[7]}); pa2 = __builtin_bit_cast(bf16x8, (f32x4){pB1[0], pB1[1], pB1[2], pB1[3]}); pa3 = __builtin_bit_cast(bf16x8, (f32x4){pB1[4], pB1[5], pB1[6], pB1[7]}); } } while (0); SBAR();
  do { if (!(VAR & 8)) pv_all2(o, vb0 + SHM_V, pa0, pa1, pa2, pa3); else { asm volatile("" :: "v"(pa0), "v"(pa1), "v"(pa2), "v"(pa3)); } } while (0);
  float rli[16];
  if (KIND == 1) { if (hi == 0) li_l[r32] = mhat; asm volatile("s_waitcnt lgkmcnt(0)" ::: "memory"); const float sk2 = p.sink[l * 8 + hd] * LOG2E;
#pragma unroll
    for (int r = 0; r < 16; ++r) rli[r] = __builtin_amdgcn_rcpf(o[2][r] + __builtin_amdgcn_exp2f(sk2 - li_l[crow(r, hi)])); }
  else {
#pragma unroll
    for (int r = 0; r < 16; ++r) rli[r] = __builtin_amdgcn_rcpf(o[2][r]); }
  bf16_t* Ow = (bf16_t*)(p.ws + OFF_R + R_CQ) + ((rowq0 + wid * 32) & 16383) * DM + ocol;
#pragma unroll
  for (int r = 0; r < 16; ++r) { const int orow = crow(r, hi);
#pragma unroll
    for (int d0 = 0; d0 < 2; ++d0) Ow[(size_t)orow * DM + d0 * 32 + r32] = f2bf(o[d0][r] * rli[r]); }
  do { if (!(VAR & 1)) __syncthreads(); } while (0);
#undef KROW
#undef SLOAD
#undef SWRITE
#undef SWAIT
#undef RESC
#undef AMASK
#undef TACT
}

template <int VAR>
__device__ __forceinline__ void ph_attn_probe(const Prm& p, int l, unsigned char* lds, int bid, int nb) {
  const int nrounds = (1024 + nb - 1) / nb;
  for (int rd = 0; rd < nrounds; ++rd) { const int pair = rd * 8 + (bid & 7), qb = bid >> 3, u = pair * 32 + qb;
    if (u < 1024) attn_probe_unit<0, VAR>(p, l, false, u >> 8, (u >> 5) & 7, u & 31, lds); }
}
#endif
__device__ __forceinline__ int v_st_p(int k, int c) { return (c >> 5) * 4096 + (k >> 4) * 1024 + (k & 15) * 64 + (c & 31) * 2; }
__device__ __forceinline__ int v_rd_base_p(int lane) { return ((lane >> 4) & 1) * 32 + (lane & 3) * 8 + (4 * (lane >> 5) + ((lane & 15) >> 2)) * 64; }
constexpr int v_rd_off_p(int d0, int ks, int half) { return d0 * 4096 + ks * 1024 + half * 512; }
template <int D0> __device__ __forceinline__ void pv_one_p(f32x16& od, int vb, bf16x8 pa0, bf16x8 pa1, bf16x8 pa2, bf16x8 pa3) {
  const s16x4 l0 = tr_read<v_rd_off_p(D0, 0, 0)>(vb), h0 = tr_read<v_rd_off_p(D0, 0, 1)>(vb), l1 = tr_read<v_rd_off_p(D0, 1, 0)>(vb), h1 = tr_read<v_rd_off_p(D0, 1, 1)>(vb);
  const s16x4 l2 = tr_read<v_rd_off_p(D0, 2, 0)>(vb), h2 = tr_read<v_rd_off_p(D0, 2, 1)>(vb), l3 = tr_read<v_rd_off_p(D0, 3, 0)>(vb), h3 = tr_read<v_rd_off_p(D0, 3, 1)>(vb);
  asm volatile("s_waitcnt lgkmcnt(0)" ::: "memory"); SBAR();
#define PK(L, H) (bf16x8){L[0], L[1], L[2], L[3], H[0], H[1], H[2], H[3]}
  od = __builtin_amdgcn_mfma_f32_32x32x16_bf16(pa0, PK(l0, h0), od, 0, 0, 0);
  od = __builtin_amdgcn_mfma_f32_32x32x16_bf16(pa1, PK(l1, h1), od, 0, 0, 0);
  od = __builtin_amdgcn_mfma_f32_32x32x16_bf16(pa2, PK(l2, h2), od, 0, 0, 0);
  od = __builtin_amdgcn_mfma_f32_32x32x16_bf16(pa3, PK(l3, h3), od, 0, 0, 0);
#undef PK
}
__device__ __forceinline__ void pv_all2p(f32x16* o, int vb, bf16x8 pa0, bf16x8 pa1, bf16x8 pa2, bf16x8 pa3) {
  const s16x4 a0 = tr_read<v_rd_off_p(0, 0, 0)>(vb), b0 = tr_read<v_rd_off_p(0, 0, 1)>(vb), a1 = tr_read<v_rd_off_p(0, 1, 0)>(vb), b1 = tr_read<v_rd_off_p(0, 1, 1)>(vb);
  const s16x4 a2 = tr_read<v_rd_off_p(0, 2, 0)>(vb), b2 = tr_read<v_rd_off_p(0, 2, 1)>(vb), a3 = tr_read<v_rd_off_p(0, 3, 0)>(vb), b3 = tr_read<v_rd_off_p(0, 3, 1)>(vb);
  const s16x4 c0 = tr_read<v_rd_off_p(1, 0, 0)>(vb), d0 = tr_read<v_rd_off_p(1, 0, 1)>(vb), c1 = tr_read<v_rd_off_p(1, 1, 0)>(vb), d1 = tr_read<v_rd_off_p(1, 1, 1)>(vb);
  const s16x4 c2 = tr_read<v_rd_off_p(1, 2, 0)>(vb), d2 = tr_read<v_rd_off_p(1, 2, 1)>(vb), c3 = tr_read<v_rd_off_p(1, 3, 0)>(vb), d3 = tr_read<v_rd_off_p(1, 3, 1)>(vb);
  asm volatile("s_waitcnt lgkmcnt(0)" ::: "memory"); SBAR();
#define PK(L, H) (bf16x8){L[0], L[1], L[2], L[3], H[0], H[1], H[2], H[3]}
  const bf16x8 ones = {16256, 16256, 16256, 16256, 16256, 16256, 16256, 16256};
  o[0] = __builtin_amdgcn_mfma_f32_32x32x16_bf16(pa0, PK(a0, b0), o[0], 0, 0, 0); o[1] = __builtin_amdgcn_mfma_f32_32x32x16_bf16(pa0, PK(c0, d0), o[1], 0, 0, 0); o[2] = __builtin_amdgcn_mfma_f32_32x32x16_bf16(pa0, ones, o[2], 0, 0, 0);
  o[0] = __builtin_amdgcn_mfma_f32_32x32x16_bf16(pa1, PK(a1, b1), o[0], 0, 0, 0); o[1] = __builtin_amdgcn_mfma_f32_32x32x16_bf16(pa1, PK(c1, d1), o[1], 0, 0, 0); o[2] = __builtin_amdgcn_mfma_f32_32x32x16_bf16(pa1, ones, o[2], 0, 0, 0);
  o[0] = __builtin_amdgcn_mfma_f32_32x32x16_bf16(pa2, PK(a2, b2), o[0], 0, 0, 0); o[1] = __builtin_amdgcn_mfma_f32_32x32x16_bf16(pa2, PK(c2, d2), o[1], 0, 0, 0); o[2] = __builtin_amdgcn_mfma_f32_32x32x16_bf16(pa2, ones, o[2], 0, 0, 0);
  o[0] = __builtin_amdgcn_mfma_f32_32x32x16_bf16(pa3, PK(a3, b3), o[0], 0, 0, 0); o[1] = __builtin_amdgcn_mfma_f32_32x32x16_bf16(pa3, PK(c3, d3), o[1], 0, 0, 0); o[2] = __builtin_amdgcn_mfma_f32_32x32x16_bf16(pa3, ones, o[2], 0, 0, 0);
#undef PK
}
__device__ __forceinline__ void fsm2p(f32x16& p0, f32x16& p1, bf16x8& pa0, bf16x8& pa1, bf16x8& pa2, bf16x8& pa3) {
#pragma unroll
  for (int r = 0; r < 16; ++r) p1[r] = __builtin_amdgcn_exp2f(p1[r]);
#define PK8(P, BASE, OUT) do { u32x4 w = {cvtpk(P[BASE + 0], P[BASE + 1]), cvtpk(P[BASE + 2], P[BASE + 3]), cvtpk(P[BASE + 4], P[BASE + 5]), cvtpk(P[BASE + 6], P[BASE + 7])}; OUT = *reinterpret_cast<bf16x8*>(&w); } while (0)
  PK8(p0, 0, pa0); PK8(p0, 8, pa1); PK8(p1, 0, pa2); PK8(p1, 8, pa3);
#undef PK8
}
__device__ __forceinline__ void pv_all2q(f32x16* o, int vb, bf16x8 pa0, bf16x8 pa1, bf16x8 pa2, bf16x8 pa3) {
  const s16x4 a0 = tr_read<v_rd_off_p(0, 0, 0)>(vb), b0 = tr_read<v_rd_off_p(0, 0, 1)>(vb), a1 = tr_read<v_rd_off_p(0, 1, 0)>(vb), b1 = tr_read<v_rd_off_p(0, 1, 1)>(vb);
  const s16x4 a2 = tr_read<v_rd_off_p(0, 2, 0)>(vb), b2 = tr_read<v_rd_off_p(0, 2, 1)>(vb), a3 = tr_read<v_rd_off_p(0, 3, 0)>(vb), b3 = tr_read<v_rd_off_p(0, 3, 1)>(vb);
  const s16x4 c0 = tr_read<v_rd_off_p(1, 0, 0)>(vb), d0 = tr_read<v_rd_off_p(1, 0, 1)>(vb), c1 = tr_read<v_rd_off_p(1, 1, 0)>(vb), d1 = tr_read<v_rd_off_p(1, 1, 1)>(vb);
  const s16x4 c2 = tr_read<v_rd_off_p(1, 2, 0)>(vb), d2 = tr_read<v_rd_off_p(1, 2, 1)>(vb), c3 = tr_read<v_rd_off_p(1, 3, 0)>(vb), d3 = tr_read<v_rd_off_p(1, 3, 1)>(vb);
  asm volatile("s_waitcnt lgkmcnt(0)" ::: "memory"); SBAR();
#define PK(L, H) (bf16x8){L[0], L[1], L[2], L[3], H[0], H[1], H[2], H[3]}
  o[0] = __builtin_amdgcn_mfma_f32_32x32x16_bf16(pa0, PK(a0, b0), o[0], 0, 0, 0); o[1] = __builtin_amdgcn_mfma_f32_32x32x16_bf16(pa0, PK(c0, d0), o[1], 0, 0, 0);
  o[0] = __builtin_amdgcn_mfma_f32_32x32x16_bf16(pa1, PK(a1, b1), o[0], 0, 0, 0); o[1] = __builtin_amdgcn_mfma_f32_32x32x16_bf16(pa1, PK(c1, d1), o[1], 0, 0, 0);
  o[0] = __builtin_amdgcn_mfma_f32_32x32x16_bf16(pa2, PK(a2, b2), o[0], 0, 0, 0); o[1] = __builtin_amdgcn_mfma_f32_32x32x16_bf16(pa2, PK(c2, d2), o[1], 0, 0, 0);
  o[0] = __builtin_amdgcn_mfma_f32_32x32x16_bf16(pa3, PK(a3, b3), o[0], 0, 0, 0); o[1] = __builtin_amdgcn_mfma_f32_32x32x16_bf16(pa3, PK(c3, d3), o[1], 0, 0, 0);
#undef PK
}
__device__ __forceinline__ void fsm2q(f32x16& p0, f32x16& p1, bf16x8& pa0, bf16x8& pa1, bf16x8& pa2, bf16x8& pa3, float& lsum) {
#pragma unroll
  for (int r = 0; r < 16; r += 2) { p1[r] = __builtin_amdgcn_exp2f(p1[r]); lsum += p1[r]; p1[r + 1] = __builtin_amdgcn_exp2f(p1[r + 1]); lsum += p1[r + 1]; }
#define PK8(P, BASE, OUT) do { u32x4 w = {cvtpk(P[BASE + 0], P[BASE + 1]), cvtpk(P[BASE + 2], P[BASE + 3]), cvtpk(P[BASE + 4], P[BASE + 5]), cvtpk(P[BASE + 6], P[BASE + 7])}; OUT = *reinterpret_cast<bf16x8*>(&w); } while (0)
  PK8(p0, 0, pa0); PK8(p0, 8, pa1); PK8(p1, 0, pa2); PK8(p1, 8, pa3);
#undef PK8
}
template <int KIND>
__device__ __forceinline__ void attn_fast_unit2p(const Prm& p, int l, bool isctx, int b, int hd, int qb, unsigned char* ldsu) {
  constexpr int DQK = KIND == 0 ? 96 : 64, KST = DQK * 2 + 16, SHM_K = 64 * KST, SHM_V = 8192, LPT = KIND == 0 ? 3 : 2;
  char* lds = (char*)ldsu;
  const int tid = TIDX, wid = tid >> 6, lane = tid & 63, r32 = lane & 31, hi = lane >> 5;
  char* V_lds = lds; char* K_lds = lds + 2 * SHM_V;
  float* ws = (float*)(lds + 2 * SHM_V + 2 * SHM_K) + wid * 64; float* li_l = ws; float* al_l = ws + 32;
  const int q0 = qb * 256;
  const size_t rowq0 = (size_t)b * TT + (isctx ? 0 : LC) + q0;
  const bf16_t *Qp, *Kp, *Vp; const bf16_t* KRp = WSP(bf16_t, OFF_KR); int ldq, ldk; int ocol;
  if (KIND == 0) { Qp = (const bf16_t*)(p.ws + OFF_R + R_QB) + hd * 96; ldq = NQB; Kp = (const bf16_t*)(p.ws + OFF_R + R_KB) + hd * 64; Vp = (const bf16_t*)(p.ws + OFF_R + R_VB) + hd * 64; ldk = 512; ocol = 512 + hd * 64; }
  else { Qp = (const bf16_t*)(p.ws + OFF_R + R_QA) + hd * 64; ldq = 512; Kp = (const bf16_t*)(p.ws + OFF_R + R_KA) + (hd >> 2) * 64; Vp = (const bf16_t*)(p.ws + OFF_R + R_VA) + (hd >> 2) * 64; ldk = 128; ocol = hd * 64; }
  int NT, kshift = 0; bool domask = false;
  if (isctx) NT = 4; else if (KIND == 0) NT = TT / 64; else { const int ks = max(0, q0 - 128), ke = min(SEQ, q0 + 384); NT = 4 + (ke - ks) / 64; kshift = ks; domask = true; }
  const size_t kb0 = (size_t)b * TT;
  float mhat = 0.f, lsum = 0.f; f32x16 o[2] = {}; f32x16 negm = {}; bf16x8 qr[DQK / 16];
  { const bf16_t* Qw = Qp + (rowq0 + wid * 32 + r32) * ldq + hi * 8;
#pragma unroll
    for (int d0 = 0; d0 < DQK / 16; ++d0) qr[d0] = *reinterpret_cast<const bf16x8*>(Qw + d0 * 16); }
  const int sr = tid >> 3, sc = (tid & 7) * 8, vst = v_st_p(sr, sc), kst = sr * KST + sc * 2;
  const int rr_ = (tid & 255) >> 2, rc_ = (tid & 3) * 8, krst = rr_ * KST + 128 + rc_ * 2;
  const int vb0 = (int)(uintptr_t)V_lds + v_rd_base_p(lane);
  struct { bf16x8 v, k, kr; } st_[1];
#define KROW(j) (kb0 + (size_t)(j) * 64 + ((j) >= 4 ? kshift : 0))
  const unsigned voffs = (unsigned)(sr * ldk + sc) * 2u, kroffs = (unsigned)(rr_ * 32 + rc_) * 2u;
#define SLOAD(i, j) do { const size_t kr0_ = KROW(j); const char* vb_ = (const char*)(Vp + kr0_ * ldk); const char* kb_ = (const char*)(Kp + kr0_ * ldk); \
    st_[i].v = *reinterpret_cast<const bf16x8*>(vb_ + voffs); st_[i].k = *reinterpret_cast<const bf16x8*>(kb_ + voffs); \
    if (KIND == 0) { const char* rb_ = (const char*)(KRp + kr0_ * 32); st_[i].kr = *reinterpret_cast<const bf16x8*>(rb_ + kroffs); } } while (0)
#define SWRITE(bf, i) do { *(bf16x8*)(V_lds + (bf) * SHM_V + vst) = st_[i].v; *(bf16x8*)(K_lds + (bf) * SHM_K + kst) = st_[i].k; \
    if (KIND == 0) { if (tid < 256) *(bf16x8*)(K_lds + (bf) * SHM_K + krst) = st_[i].kr; } } while (0)
#define SWAIT() do { if (LPT == 3) asm volatile("s_waitcnt vmcnt(3)" ::: "memory"); else asm volatile("s_waitcnt vmcnt(2)" ::: "memory"); } while (0)
#define RESC(a) do { if (__any((a) < 1.f)) { if (hi == 0) al_l[r32] = (a); asm volatile("s_waitcnt lgkmcnt(0)" ::: "memory"); \
    _Pragma("unroll") for (int d = 0; d < 2; ++d) _Pragma("unroll") for (int r = 0; r < 16; ++r) o[d][r] *= al_l[crow(r, hi)]; } } while (0)
#define AMASK(P0, P1, j) do { if (KIND == 1) { if (domask && (j) >= 4) { const int tq_ = q0 + wid * 32 + r32; const int tk_ = kshift + ((j) - 4) * 64 + 4 * hi; \
    _Pragma("unroll") for (int r = 0; r < 16; ++r) { const int d_ = tq_ - (tk_ + (r & 3) + 8 * (r >> 2)); if (d_ > 128 || d_ < -128) P0[r] = -INFINITY; if (d_ - 32 > 128 || d_ - 32 < -128) P1[r] = -INFINITY; } } } } while (0)
  if (__builtin_amdgcn_readfirstlane(wid) >= 4) __builtin_amdgcn_s_setprio(1);
  f32x16 pA0, pA1, pB0, pB1; float alA, alB; bf16x8 pa0, pa1, pa2, pa3;
  const int wq0_ = q0 + __builtin_amdgcn_readfirstlane(wid) * 32;
#define TACT(j) (KIND != 1 || !domask || (j) < 4 || (kshift + ((j) - 4) * 64 + 63 >= wq0_ - 128 && kshift + ((j) - 4) * 64 <= wq0_ + 31 + 128))
  bool actA, actB;
  SLOAD(0, 0); asm volatile("s_waitcnt vmcnt(0)" ::: "memory"); SWRITE(0, 0); __syncthreads();
  actA = true; qkt2<DQK>(pA0, pA1, K_lds, qr, negm, r32, hi); AMASK(pA0, pA1, 0); psm2q<true>(pA0, pA1, mhat, negm, alA, lsum);
  SLOAD(0, 1);
  SWRITE(1, 0); __syncthreads();
  for (int j = 1; j + 1 < NT; j += 2) {
    actB = TACT(j);
    SBAR(); if (actB) qkt2<DQK>(pB0, pB1, K_lds + SHM_K, qr, negm, r32, hi);
    if (actA) fsm2q(pA0, pA1, pa0, pa1, pa2, pa3, lsum); SBAR();
    SLOAD(0, j + 1); SBAR();
    if (actA) pv_all2q(o, vb0, pa0, pa1, pa2, pa3); if (actB) { AMASK(pB0, pB1, j); psm2q<false>(pB0, pB1, mhat, negm, alB, lsum); } else alB = 1.f;
    __syncthreads(); SWRITE(0, 0);
    RESC(alB); __syncthreads();
    actA = TACT(j + 1);
    SBAR(); if (actA) qkt2<DQK>(pA0, pA1, K_lds, qr, negm, r32, hi);
    if (actB) fsm2q(pB0, pB1, pa0, pa1, pa2, pa3, lsum); SBAR();
    SLOAD(0, j + 2); SBAR();
    if (actB) pv_all2q(o, vb0 + SHM_V, pa0, pa1, pa2, pa3); if (actA) { AMASK(pA0, pA1, j + 1); psm2q<false>(pA0, pA1, mhat, negm, alA, lsum); } else alA = 1.f;
    __syncthreads(); SWRITE(1, 0);
    RESC(alA); __syncthreads();
  }
  actB = TACT(NT - 1);
  SBAR(); if (actB) qkt2<DQK>(pB0, pB1, K_lds + SHM_K, qr, negm, r32, hi);
  if (actA) fsm2q(pA0, pA1, pa0, pa1, pa2, pa3, lsum); SBAR();
  if (actA) pv_all2q(o, vb0, pa0, pa1, pa2, pa3); if (actB) { AMASK(pB0, pB1, NT - 1); psm2q<false>(pB0, pB1, mhat, negm, alB, lsum); } else alB = 1.f;
  __syncthreads(); RESC(alB);
  if (actB) { fsm2q(pB0, pB1, pa0, pa1, pa2, pa3, lsum); SBAR();
    pv_all2q(o, vb0 + SHM_V, pa0, pa1, pa2, pa3); }
  __builtin_amdgcn_s_setprio(0);
  const int lanee = TIDX & 63, r32e = lanee & 31, hie = lanee >> 5;
  float rli[16];
  { auto rr = __builtin_amdgcn_permlane32_swap(__float_as_uint(lsum), __float_as_uint(lsum), false, false); lsum = __uint_as_float(rr[0]) + __uint_as_float(rr[1]); }
  if (hie == 0) { al_l[r32e] = lsum; if (KIND == 1) li_l[r32e] = mhat; } asm volatile("s_waitcnt lgkmcnt(0)" ::: "memory");
  if (KIND == 1) { const float sk2 = p.sink[l * 8 + hd] * LOG2E;
#pragma unroll
    for (int r = 0; r < 16; ++r) rli[r] = __builtin_amdgcn_rcpf(al_l[crow(r, hie)] + __builtin_amdgcn_exp2f(sk2 - li_l[crow(r, hie)])); }
  else {
#pragma unroll
    for (int r = 0; r < 16; ++r) rli[r] = __builtin_amdgcn_rcpf(al_l[crow(r, hie)]); }
  bf16_t* Ow = (bf16_t*)(p.ws + OFF_R + R_H) + (rowq0 + wid * 32) * DM + ocol;
#pragma unroll
  for (int r = 0; r < 16; ++r) { const int orow = crow(r, hie);
#pragma unroll
    for (int d0 = 0; d0 < 2; ++d0) Ow[(size_t)orow * DM + d0 * 32 + r32e] = f2bf(o[d0][r] * rli[r]); }
  __syncthreads();
#undef KROW
#undef SLOAD
#undef SWRITE
#undef SWAIT
#undef RESC
#undef AMASK
#undef TACT
}
#ifdef DBG_ATTN_PROBE
template <int KIND, int VAR>
__device__ __forceinline__ void attn_probe_unit(const Prm& p, int l, bool isctx, int b, int hd, int qb, unsigned char* ldsu) {
  constexpr int DQK = KIND == 0 ? 96 : 64, KST = DQK * 2 + 16, SHM_K = 64 * KST, SHM_V = 8192, LPT = KIND == 0 ? 3 : 2;
  char* lds = (char*)ldsu;
  const int tid = TIDX, wid = tid >> 6, lane = tid & 63, r32 = lane & 31, hi = lane >> 5;
  char* V_lds = lds; char* K_lds = lds + 2 * SHM_V;
  float* ws = (float*)(lds + 2 * SHM_V + 2 * SHM_K) + wid * 64; float* li_l = ws; float* al_l = ws + 32;
  const int q0 = qb * 256;
  const size_t rowq0 = (size_t)b * TT + (isctx ? 0 : LC) + q0;
  const bf16_t *Qp, *Kp, *Vp; const bf16_t* KRp = WSP(bf16_t, OFF_KR); int ldq, ldk; int ocol;
  if (KIND == 0) { Qp = (const bf16_t*)(p.ws + OFF_R + R_QB) + hd * 96; ldq = NQB; Kp = (const bf16_t*)(p.ws + OFF_R + R_KB) + hd * 64; Vp = (const bf16_t*)(p.ws + OFF_R + R_VB) + hd * 64; ldk = 512; ocol = 512 + hd * 64; }
  else { Qp = (const bf16_t*)(p.ws + OFF_R + R_QA) + hd * 64; ldq = 512; Kp = (const bf16_t*)(p.ws + OFF_R + R_KA) + (hd >> 2) * 64; Vp = (const bf16_t*)(p.ws + OFF_R + R_VA) + (hd >> 2) * 64; ldk = 128; ocol = hd * 64; }
  int NT, kshift = 0; bool domask = false;
  if (isctx) NT = 4; else if (KIND == 0) NT = TT / 64; else { const int ks = max(0, q0 - 128), ke = min(SEQ, q0 + 384); NT = 4 + (ke - ks) / 64; kshift = ks; domask = true; }
  const size_t kb0 = (size_t)b * TT;
  float mhat = 0.f; f32x16 o[3] = {}; f32x16 negm = {}; bf16x8 qr[DQK / 16];
  { const bf16_t* Qw = Qp + (rowq0 + wid * 32 + r32) * ldq + hi * 8;
#pragma unroll
    for (int d0 = 0; d0 < DQK / 16; ++d0) qr[d0] = *reinterpret_cast<const bf16x8*>(Qw + d0 * 16); }
  const int sr = tid >> 3, sc = (tid & 7) * 8, vst = v_st_p(sr, sc), kst = sr * KST + sc * 2;
  const int rr_ = (tid & 255) >> 2, rc_ = (tid & 3) * 8, krst = rr_ * KST + 128 + rc_ * 2;
  const int vb0 = (int)(uintptr_t)V_lds + v_rd_base_p(lane);
  struct { bf16x8 v, k, kr; } st_[1];
#define KROW(j) (kb0 + (size_t)(j) * 64 + ((j) >= 4 ? kshift : 0))
#define SLOAD(i, j) do { if (VAR & 4) break; const size_t kr0_ = KROW(j); st_[i].v = *reinterpret_cast<const bf16x8*>(Vp + (kr0_ + sr) * ldk + sc); st_[i].k = *reinterpret_cast<const bf16x8*>(Kp + (kr0_ + sr) * ldk + sc); \
    if (KIND == 0) st_[i].kr = *reinterpret_cast<const bf16x8*>(KRp + (kr0_ + rr_) * 32 + rc_); } while (0)
#define SWRITE(bf, i) do { if (VAR & 4) break; *(bf16x8*)(V_lds + (bf) * SHM_V + vst) = st_[i].v; *(bf16x8*)(K_lds + (bf) * SHM_K + kst) = st_[i].k; \
    if (KIND == 0) { if (tid < 256) *(bf16x8*)(K_lds + (bf) * SHM_K + krst) = st_[i].kr; } } while (0)
#define SWAIT() do { if (LPT == 3) asm volatile("s_waitcnt vmcnt(3)" ::: "memory"); else asm volatile("s_waitcnt vmcnt(2)" ::: "memory"); } while (0)
#define RESC(a) do { if (__any((a) < 1.f)) { if (hi == 0) al_l[r32] = (a); asm volatile("s_waitcnt lgkmcnt(0)" ::: "memory"); \
    _Pragma("unroll") for (int d = 0; d < 3; ++d) _Pragma("unroll") for (int r = 0; r < 16; ++r) o[d][r] *= al_l[crow(r, hi)]; } } while (0)
#define AMASK(P0, P1, j) do { if (KIND == 1) { if (domask && (j) >= 4) { const int tq_ = q0 + wid * 32 + r32; const int tk_ = kshift + ((j) - 4) * 64 + 4 * hi; \
    _Pragma("unroll") for (int r = 0; r < 16; ++r) { const int d_ = tq_ - (tk_ + (r & 3) + 8 * (r >> 2)); if (d_ > 128 || d_ < -128) P0[r] = -INFINITY; if (d_ - 32 > 128 || d_ - 32 < -128) P1[r] = -INFINITY; } } } } while (0)
  f32x16 pA0, pA1, pB0, pB1; float alA, alB; bf16x8 pa0, pa1, pa2, pa3;
  const int wq0_ = q0 + __builtin_amdgcn_readfirstlane(wid) * 32;
#define TACT(j) (KIND != 1 || !domask || (j) < 4 || (kshift + ((j) - 4) * 64 + 63 >= wq0_ - 128 && kshift + ((j) - 4) * 64 <= wq0_ + 31 + 128))
  bool actA, actB;
  SLOAD(0, 0); asm volatile("s_waitcnt vmcnt(0)" ::: "memory"); SWRITE(0, 0); do { if (!(VAR & 1)) __syncthreads(); } while (0);
  do { if (!(VAR & 16)) qkt2<DQK>(pA0, pA1, K_lds, qr, negm, r32, hi); else { pA0 = negm; pA1 = negm; asm volatile("" : "+v"(pA0), "+v"(pA1)); } } while (0); AMASK(pA0, pA1, 0); do { if (!(VAR & 2)) psm2<true>(pA0, pA1, mhat, negm, alA); else alA = 1.f; } while (0);
  SLOAD(0, 1);
  SWRITE(1, 0); do { if (!(VAR & 1)) __syncthreads(); } while (0);
  for (int j = 1; j + 1 < NT; j += 2) {
    SBAR(); do { if (!(VAR & 16)) qkt2<DQK>(pB0, pB1, K_lds + SHM_K, qr, negm, r32, hi); else { pB0 = negm; pB1 = negm; asm volatile("" : "+v"(pB0), "+v"(pB1)); } } while (0);
    do { if (!(VAR & 2)) fsm2p(pA0, pA1, pa0, pa1, pa2, pa3); else { pa0 = __builtin_bit_cast(bf16x8, (f32x4){pA0[0], pA0[1], pA0[2], pA0[3]}); pa1 = __builtin_bit_cast(bf16x8, (f32x4){pA0[4], pA0[5], pA0[6], pA0[7]}); pa2 = __builtin_bit_cast(bf16x8, (f32x4){pA1[0], pA1[1], pA1[2], pA1[3]}); pa3 = __builtin_bit_cast(bf16x8, (f32x4){pA1[4], pA1[5], pA1[6], pA1[7]}); } } while (0); SBAR();
    SLOAD(0, j + 1); SBAR();
    do { if (!(VAR & 8)) pv_all2p(o, vb0, pa0, pa1, pa2, pa3); else { asm volatile("" :: "v"(pa0), "v"(pa1), "v"(pa2), "v"(pa3)); } } while (0); AMASK(pB0, pB1, j); do { if (!(VAR & 2)) psm2<false>(pB0, pB1, mhat, negm, alB); else alB = 1.f; } while (0);
    do { if (!(VAR & 1)) __syncthreads(); } while (0); SWRITE(0, 0);
    RESC(alB); do { if (!(VAR & 1)) __syncthreads(); } while (0);
    SBAR(); do { if (!(VAR & 16)) qkt2<DQK>(pA0, pA1, K_lds, qr, negm, r32, hi); else { pA0 = negm; pA1 = negm; asm volatile("" : "+v"(pA0), "+v"(pA1)); } } while (0);
    do { if (!(VAR & 2)) fsm2p(pB0, pB1, pa0, pa1, pa2, pa3); else { pa0 = __builtin_bit_cast(bf16x8, (f32x4){pB0[0], pB0[1], pB0[2], pB0[3]}); pa1 = __builtin_bit_cast(bf16x8, (f32x4){pB0[4], pB0[5], pB0[6], pB0[7]}); pa2 = __builtin_bit_cast(bf16x8, (f32x4){pB1[0], pB1[1], pB1[2], pB1[3]}); pa3 = __builtin_bit_cast(bf16x8, (f32x4){pB1[4], pB1[5], pB1[6], pB1[7]}); } } while (0); SBAR();
    SLOAD(0, j + 2); SBAR();
    do { if (!(VAR & 8)) pv_all2p(o, vb0 + SHM_V, pa0, pa1, pa2, pa3); else { asm volatile("" :: "v"(pa0), "v"(pa1), "v"(pa2), "v"(pa3)); } } while (0); AMASK(pA0, pA1, j + 1); do { if (!(VAR & 2)) psm2<false>(pA0, pA1, mhat, negm, alA); else alA = 1.f; } while (0);
    do { if (!(VAR & 1)) __syncthreads(); } while (0); SWRITE(1, 0);
    RESC(alA); do { if (!(VAR & 1)) __syncthreads(); } while (0);
  }
  SBAR(); do { if (!(VAR & 16)) qkt2<DQK>(pB0, pB1, K_lds + SHM_K, qr, negm, r32, hi); else { pB0 = negm; pB1 = negm; asm volatile("" : "+v"(pB0), "+v"(pB1)); } } while (0);
  do { if (!(VAR & 2)) fsm2p(pA0, pA1, pa0, pa1, pa2, pa3); else { pa0 = __builtin_bit_cast(bf16x8, (f32x4){pA0[0], pA0[1], pA0[2], pA0[3]}); pa1 = __builtin_bit_cast(bf16x8, (f32x4){pA0[4], pA0[5], pA0[6], pA0[7]}); pa2 = __builtin_bit_cast(bf16x8, (f32x4){pA1[0], pA1[1], pA1[2], pA1[3]}); pa3 = __builtin_bit_cast(bf16x8, (f32x4){pA1[4], pA1[5], pA1[6], pA1[7]}); } } while (0); SBAR();
  do { if (!(VAR & 8)) pv_all2p(o, vb0, pa0, pa1, pa2, pa3); else { asm volatile("" :: "v"(pa0), "v"(pa1), "v"(pa2), "v"(pa3)); } } while (0); AMASK(pB0, pB1, NT - 1); do { if (!(VAR & 2)) psm2<false>(pB0, pB1, mhat, negm, alB); else alB = 1.f; } while (0);
  do { if (!(VAR & 1)) __syncthreads(); } while (0); RESC(alB);
  do { if (!(VAR & 2)) fsm2p(pB0, pB1, pa0, pa1, pa2, pa3); else { pa0 = __builtin_bit_cast(bf16x8, (f32x4){pB0[0], pB0[1], pB0[2], pB0[3]}); pa1 = __builtin_bit_cast(bf16x8, (f32x4){pB0[4], pB0[5], pB0[6], pB0[7]}); pa2 = __builtin_bit_cast(bf16x8, (f32x4){pB1[0], pB1[1], pB1[2], pB1[3]}); pa3 = __builtin_bit_cast(bf16x8, (f32x4){pB1[4], pB1[5], pB1[6], pB1[7]}); } } while (0); SBAR();
  do { if (!(VAR & 8)) pv_all2p(o, vb0 + SHM_V, pa0, pa1, pa2, pa3); else { asm volatile("" :: "v"(pa0), "v"(pa1), "v"(pa2), "v"(pa3)); } } while (0);
  float rli[16];
  if (KIND == 1) { if (hi == 0) li_l[r32] = mhat; asm volatile("s_waitcnt lgkmcnt(0)" ::: "memory"); const float sk2 = p.sink[l * 8 + hd] * LOG2E;
#pragma unroll
    for (int r = 0; r < 16; ++r) rli[r] = __builtin_amdgcn_rcpf(o[2][r] + __builtin_amdgcn_exp2f(sk2 - li_l[crow(r, hi)])); }
  else {
#pragma unroll
    for (int r = 0; r < 16; ++r) rli[r] = __builtin_amdgcn_rcpf(o[2][r]); }
  bf16_t* Ow = (bf16_t*)(p.ws + OFF_R + R_CQ) + ((rowq0 + wid * 32) & 16383) * DM + ocol;
#pragma unroll
  for (int r = 0; r < 16; ++r) { const int orow = crow(r, hi);
#pragma unroll
    for (int d0 = 0; d0 < 2; ++d0) Ow[(size_t)orow * DM + d0 * 32 + r32] = f2bf(o[d0][r] * rli[r]); }
  do { if (!(VAR & 1)) __syncthreads(); } while (0);
#undef KROW
#undef SLOAD
#undef SWRITE
#undef SWAIT
#undef RESC
#undef AMASK
#undef TACT
}

template <int VAR>
__device__ __forceinline__ void ph_attn_probe(const Prm& p, int l, unsigned char* lds, int bid, int nb) {
  const int nrounds = (1024 + nb - 1) / nb;
  for (int rd = 0; rd < nrounds; ++rd) { const int pair = rd * 8 + (bid & 7), qb = bid >> 3, u = pair * 32 + qb;
    if (u < 1024) attn_probe_unit<0, VAR>(p, l, false, u >> 8, (u >> 5) & 7, u & 31, lds); }
}
#endif
template <int KIND>
__device__ __forceinline__ void attn_fast_unit3(const Prm& p, int l, bool isctx, int b, int hd, int qb, unsigned char* ldsu) {
  constexpr int DQK = KIND == 0 ? 96 : 64, KST = DQK * 2 + 16, SHM_K = 64 * KST, SHM_V = 8192, LPT = KIND == 0 ? 3 : 2;
  char* lds = (char*)ldsu;
  const int tid = TIDX, wid = tid >> 6, lane = tid & 63, r32 = lane & 31, hi = lane >> 5;
  char* V_lds = lds; char* K_lds = lds + 3 * SHM_V;
  float* ws = (float*)(lds + 3 * SHM_V + 3 * SHM_K) + wid * 64; float* li_l = ws; float* al_l = ws + 32;
  const int q0 = qb * 256;
  const size_t rowq0 = (size_t)b * TT + (isctx ? 0 : LC) + q0;
  const bf16_t *Qp, *Kp, *Vp; const bf16_t* KRp = WSP(bf16_t, OFF_KR); int ldq, ldk; int ocol;
  if (KIND == 0) { Qp = (const bf16_t*)(p.ws + OFF_R + R_QB) + hd * 96; ldq = NQB; Kp = (const bf16_t*)(p.ws + OFF_R + R_KB) + hd * 64; Vp = (const bf16_t*)(p.ws + OFF_R + R_VB) + hd * 64; ldk = 512; ocol = 512 + hd * 64; }
  else { Qp = (const bf16_t*)(p.ws + OFF_R + R_QA) + hd * 64; ldq = 512; Kp = (const bf16_t*)(p.ws + OFF_R + R_KA) + (hd >> 2) * 64; Vp = (const bf16_t*)(p.ws + OFF_R + R_VA) + (hd >> 2) * 64; ldk = 128; ocol = hd * 64; }
  int NT, kshift = 0; bool domask = false;
  if (isctx) NT = 4; else if (KIND == 0) NT = TT / 64; else { const int ks = max(0, q0 - 128), ke = min(SEQ, q0 + 384); NT = 4 + (ke - ks) / 64; kshift = ks; domask = true; }
  const size_t kb0 = (size_t)b * TT;
  float mhat = 0.f; f32x16 o[3] = {}; f32x16 negm = {}; bf16x8 qr[DQK / 16];
  { const bf16_t* Qw = Qp + (rowq0 + wid * 32 + r32) * ldq + hi * 8;
#pragma unroll
    for (int d0 = 0; d0 < DQK / 16; ++d0) qr[d0] = *reinterpret_cast<const bf16x8*>(Qw + d0 * 16); }
  const int sr = tid >> 3, sc = (tid & 7) * 8, vst = v_st(sr, sc), kst = sr * KST + sc * 2;
  const int rr_ = (tid & 255) >> 2, rc_ = (tid & 3) * 8, krst = rr_ * KST + 128 + rc_ * 2;
  const int vb0 = (int)(uintptr_t)V_lds + v_rd_base(lane);
  struct { bf16x8 v, k, kr; } st_[1];
#define KROW(j) (kb0 + (size_t)(j) * 64 + ((j) >= 4 ? kshift : 0))
#define SLOAD(i, j) do { const size_t kr0_ = KROW(j); st_[i].v = *reinterpret_cast<const bf16x8*>(Vp + (kr0_ + sr) * ldk + sc); st_[i].k = *reinterpret_cast<const bf16x8*>(Kp + (kr0_ + sr) * ldk + sc); \
    if (KIND == 0) st_[i].kr = *reinterpret_cast<const bf16x8*>(KRp + (kr0_ + rr_) * 32 + rc_); } while (0)
#define SWRITE(bf, i) do { *(bf16x8*)(V_lds + (bf) * SHM_V + vst) = st_[i].v; *(bf16x8*)(K_lds + (bf) * SHM_K + kst) = st_[i].k; \
    if (KIND == 0) { if (tid < 256) *(bf16x8*)(K_lds + (bf) * SHM_K + krst) = st_[i].kr; } } while (0)
#define SWAIT() do { if (LPT == 3) asm volatile("s_waitcnt vmcnt(3)" ::: "memory"); else asm volatile("s_waitcnt vmcnt(2)" ::: "memory"); } while (0)
#define RESC(a) do { if (__any((a) < 1.f)) { if (hi == 0) al_l[r32] = (a); asm volatile("s_waitcnt lgkmcnt(0)" ::: "memory"); \
    _Pragma("unroll") for (int d = 0; d < 3; ++d) _Pragma("unroll") for (int r = 0; r < 16; ++r) o[d][r] *= al_l[crow(r, hi)]; } } while (0)
#define AMASK(P0, P1, j) do { if (KIND == 1) { if (domask && (j) >= 4) { const int tq_ = q0 + wid * 32 + r32; const int tk_ = kshift + ((j) - 4) * 64 + 4 * hi; \
    _Pragma("unroll") for (int r = 0; r < 16; ++r) { const int d_ = tq_ - (tk_ + (r & 3) + 8 * (r >> 2)); if (d_ > 128 || d_ < -128) P0[r] = -INFINITY; if (d_ - 32 > 128 || d_ - 32 < -128) P1[r] = -INFINITY; } } } } while (0)
  f32x16 pA0, pA1, pB0, pB1; float alA, alB; bf16x8 pa0, pa1, pa2, pa3;
  SLOAD(0, 0); SWRITE(0, 0); SLOAD(0, 1); SWRITE(1, 0); __syncthreads();
  qkt2<DQK>(pA0, pA1, K_lds, qr, negm, r32, hi); AMASK(pA0, pA1, 0); psm2<true>(pA0, pA1, mhat, negm, alA);
  int r0 = 0, r1 = 1, r2 = 2;
#define ITER(PP0, PP1, PC0, PC1, ALC, j) do { \
    if ((j) + 2 < NT) SLOAD(0, (j) + 2); \
    SBAR(); qkt2<DQK>(PC0, PC1, K_lds + r1 * SHM_K, qr, negm, r32, hi); \
    fsm2(PP0, PP1, pa0, pa1, pa2, pa3); SBAR(); \
    pv_all2(o, vb0 + r0 * SHM_V, pa0, pa1, pa2, pa3); AMASK(PC0, PC1, (j) + 1); psm2<false>(PC0, PC1, mhat, negm, ALC); \
    RESC(ALC); \
    if ((j) + 2 < NT) SWRITE(r2, 0); \
    __syncthreads(); \
    { const int t_ = r0; r0 = r1; r1 = r2; r2 = t_; } } while (0)
  int j = 0;
  for (; j + 2 < NT; j += 2) { ITER(pA0, pA1, pB0, pB1, alB, j); ITER(pB0, pB1, pA0, pA1, alA, j + 1); }
  ITER(pA0, pA1, pB0, pB1, alB, j);
  fsm2(pB0, pB1, pa0, pa1, pa2, pa3); SBAR();
  pv_all2(o, vb0 + r0 * SHM_V, pa0, pa1, pa2, pa3);
#undef ITER
  float rli[16];
  if (KIND == 1) { if (hi == 0) li_l[r32] = mhat; asm volatile("s_waitcnt lgkmcnt(0)" ::: "memory"); const float sk2 = p.sink[l * 8 + hd] * LOG2E;
#pragma unroll
    for (int r = 0; r < 16; ++r) rli[r] = __builtin_amdgcn_rcpf(o[2][r] + __builtin_amdgcn_exp2f(sk2 - li_l[crow(r, hi)])); }
  else {
#pragma unroll
    for (int r = 0; r < 16; ++r) rli[r] = __builtin_amdgcn_rcpf(o[2][r]); }
  bf16_t* Ow = (bf16_t*)(p.ws + OFF_R + R_H) + (rowq0 + wid * 32) * DM + ocol;
#pragma unroll
  for (int r = 0; r < 16; ++r) { const int orow = crow(r, hi);
#pragma unroll
    for (int d0 = 0; d0 < 2; ++d0) Ow[(size_t)orow * DM + d0 * 32 + r32] = f2bf(o[d0][r] * rli[r]); }
  __syncthreads();
#undef KROW
#undef SLOAD
#undef SWRITE
#undef SWAIT
#undef RESC
#undef AMASK
}
#ifndef ATTN_V2
#define ATTN_V2 1
#endif
#ifndef ATTN_V3
#define ATTN_V3 0
#endif
#ifndef ATTN_V2P
#define ATTN_V2P 1
#endif
#if ATTN_V2P
#define ATTN_UNIT attn_fast_unit2p
#elif ATTN_V3
#define ATTN_UNIT attn_fast_unit3
#elif ATTN_V2
#define ATTN_UNIT attn_fast_unit2
#else
#define ATTN_UNIT attn_fast_unit
#endif
__device__ __forceinline__ void ph_attn_fast(const Prm& p, int l, unsigned char* lds, int bid, int nb) {
  const int nrounds = (1024 + nb - 1) / nb;
  for (int rd = 0; rd < nrounds; ++rd) { int u;
    if ((nb & 7) == 0 && (nb >> 3) == 32) { const int pair = rd * 8 + (bid & 7), qb = bid >> 3; u = pair * 32 + qb; } else u = rd * nb + bid;
    if (u < 1024) ATTN_UNIT<0>(p, l, false, u >> 8, (u >> 5) & 7, u & 31, lds); }
  for (int rd = 0; rd < nrounds; ++rd) { int u;
    if ((nb & 7) == 0 && (nb >> 3) == 32) { const int pair = rd * 8 + (bid & 7), qb = bid >> 3; u = pair * 32 + qb; } else u = rd * nb + bid;
    if (u < 1024) ATTN_UNIT<1>(p, l, false, u >> 8, (u >> 5) & 7, u & 31, lds); }
  if (l != DEPTH - 1) for (int u = bid; u < 64; u += nb) { const int kind = u & 1, hd = (u >> 1) & 7, b = u >> 4;
      if (kind == 0) ATTN_UNIT<0>(p, l, true, b, hd, 0, lds); else ATTN_UNIT<1>(p, l, true, b, hd, 0, lds); }
}

#define XB_TMO      128
#define XB_XCNT(j)  (256  + 64 * (j))
#define XB_XSUB(j)  (1280 + 64 * (j))
#define XB_XGEN(j)  (2304 + 64 * (j))
#define XB_TOP      3328
#define XB_TOPGEN   3392
#define XCD_BAR_WORDS 3456
#define XB_SPIN_CAP (1u << 22)
#define LAS __attribute__((address_space(3)))
__device__ __forceinline__ unsigned xb_ld(unsigned* p)              { return __hip_atomic_load(p, __ATOMIC_RELAXED, __HIP_MEMORY_SCOPE_AGENT); }
__device__ __forceinline__ unsigned xb_add(unsigned* p, unsigned v) { return __hip_atomic_fetch_add(p, v, __ATOMIC_RELAXED, __HIP_MEMORY_SCOPE_AGENT); }
__device__ __forceinline__ unsigned xb_xcc_id() { return (unsigned)__builtin_amdgcn_s_getreg((3 << 11) | 20) & 0xFu; }
#define XB_SPIN(cond, bar) do { unsigned _sp = 0; while (cond) { __builtin_amdgcn_s_sleep(1); \
    if ((++_sp & 255u) == 0u) { if (xb_ld(&(bar)[XB_TMO])) break; if (_sp > XB_SPIN_CAP) { atomicAdd(&(bar)[XB_TMO], 1u); break; } } } } while (0)
struct XcdBarrier { unsigned* bar; unsigned x; volatile LAS unsigned* st; };
__device__ __forceinline__ XcdBarrier xcd_barrier_post(unsigned* bar, volatile LAS unsigned* st) {
    XcdBarrier b; b.bar = bar; b.x = xb_xcc_id(); b.st = st;
    if (TIDX == 0) (void)xb_add(&bar[XB_XCNT(b.x)], 1u);
    return b;
}
__device__ __forceinline__ void xcd_barrier_complete(unsigned* bar, unsigned x, unsigned& nloc, unsigned& nx) {
    const unsigned G = gridDim.x * gridDim.y * gridDim.z;
    unsigned sum, cnt, mine, sp = 0u;
    for (;;) {
        sum = 0u; cnt = 0u; mine = 0u;
#pragma unroll
        for (unsigned j = 0; j < 16; ++j) { const unsigned c = xb_ld(&bar[XB_XCNT(j)]); sum += c; cnt += (c > 0u) ? 1u : 0u; mine = (j == x) ? c : mine; }
        if (sum == G) break;
        __builtin_amdgcn_s_sleep(1);
        if ((++sp & 255u) == 0u) { if (xb_ld(&bar[XB_TMO])) break; if (sp > XB_SPIN_CAP) { atomicAdd(&bar[XB_TMO], 1u); break; } }
    }
    nloc = mine > 0u ? mine : 1u; nx = cnt > 0u ? cnt : 1u;
}
__device__ __forceinline__ void xcd_barrier(const XcdBarrier& b) {
    asm volatile("s_waitcnt vmcnt(0)" ::: "memory");
    __syncthreads();
    if (TIDX == 0) {
        unsigned* bar = b.bar;
        __builtin_amdgcn_s_waitcnt(0);
        unsigned nloc = b.st[0], nx = b.st[1];
        if (nloc == 0u) { xcd_barrier_complete(bar, b.x, nloc, nx); b.st[0] = nloc; b.st[1] = nx; }
        const unsigned old = xb_add(&bar[XB_XSUB(b.x)], 1u);
        const unsigned gen = old / nloc;
        if (old + 1u == (gen + 1u) * nloc) {
            __builtin_amdgcn_fence(__ATOMIC_RELEASE, "agent");
            asm volatile("s_waitcnt vmcnt(0)" ::: "memory");
            const unsigned og = xb_add(&bar[XB_TOP], 1u);
            const unsigned tg = og / nx;
            if (og + 1u == (tg + 1u) * nx) xb_add(&bar[XB_TOPGEN], 1u);
            else XB_SPIN(xb_ld(&bar[XB_TOPGEN]) == tg, bar);
            __builtin_amdgcn_fence(__ATOMIC_ACQUIRE, "agent");
            xb_add(&bar[XB_XGEN(b.x)], 1u);
            asm volatile("s_waitcnt vmcnt(0)" ::: "memory");
        } else {
            XB_SPIN(xb_ld(&bar[XB_XGEN(b.x)]) == gen, bar);
            __builtin_amdgcn_fence(__ATOMIC_ACQUIRE, "agent");
            asm volatile("s_waitcnt vmcnt(0)" ::: "memory");
        }
    }
    __syncthreads();
}

constexpr int NPHASE = 22;
__device__ __forceinline__ void run_phase1(const Prm& p, int ph, unsigned char* lds, int bid, int nb) {
  if (ph == 0) { ph_mod(p, 0, lds, bid, nb); ph_wconv_dense(p, 0, lds, bid, nb); return; }
  if (ph == 21) { ph_final(p, bid, nb); return; }
  const int alt = ph >= 100 ? 10 : 0; if (alt) ph -= 100;
  const int l = (ph - 1) / 10, s = (ph - 1) % 10 + alt;
  switch (s) {
    case 0: ph_norm_a(p, l, bid, nb); break;
#if FAST_GEMM
#if !defined(DBG_ONLY) || DBG_ONLY == 1
    case 1: ph2_gemm_in(p, l, lds, bid, nb); break;
#endif
#if !defined(DBG_ONLY) || DBG_ONLY == 2
    case 2: ph2_gemm_qup(p, l, lds, bid, nb); ph2_gemm_kvup(p, l, lds, bid, nb); break;
#endif
#if !defined(DBG_ONLY) || DBG_ONLY == 3
    case 3: break;
#endif
#else
    case 1: ph_gemm_in(p, l, bid, nb); break;
    case 2: ph_ssq(p, bid, nb); break;
    case 3: ph_gemm_up(p, l, bid, nb); break;
#endif
#if FAST_ATTN
    case 4: ph_attn_fast(p, l, lds, bid, nb); break;
#else
    case 4: ph_attn_naive(p, l, lds, bid, nb); break;
#endif
#if FAST_GEMM
#if !defined(DBG_ONLY) || DBG_ONLY == 5
    case 5: ph2_gemm_out(p, l, lds, bid, nb); break;
#endif
#else
    case 5: ph_gemm_out(p, l, bid, nb); break;
#endif
    case 6: ph_norm_b<true>(p, l, lds, bid, nb); break;
#ifdef DBG_NB
    case 16: ph_norm_b<false>(p, l, lds, bid, nb); break;
#endif
#ifdef DBG_ATTN_PROBE
    case 14: ph_attn_probe<DBG_ATTN_PROBE>(p, l, lds, bid, nb); break;
#endif
    case 7: ph_topk(p, l, lds, bid, nb); break;
#if FAST_GEMM
#if !defined(DBG_ONLY) || DBG_ONLY == 8
    case 8: ph2_moe_up(p, l, lds, bid, nb); break;
#endif
#if !defined(DBG_ONLY) || DBG_ONLY == 9
    case 9: ph2_moe_down(p, l, lds, bid, nb); break;
#endif
#else
    case 8: ph_moe_up(p, l, bid, nb); break;
    case 9: ph_moe_down(p, l, bid, nb); break;
#endif
  }
}

#ifndef DBG_TWICE
#define DBG_TWICE 0
#endif
#ifndef DBG_ALT
#define DBG_ALT 0
#endif
#ifndef DBG_PRE
#define DBG_PRE 0
#endif
__device__ __forceinline__ void run_phase(const Prm& p, int ph, unsigned char* lds, int bid, int nb) {
  if (DBG_PRE) { if (ph >= 1 && ph <= 20 && (ph - 1) % 10 == 0) { run_phase1(p, ph + DBG_PRE, lds, bid, nb); __syncthreads(); } }
  run_phase1(p, ph, lds, bid, nb);
  if (DBG_TWICE) { const int s = ph == 0 ? 10 : (ph == 21 ? 11 : (ph - 1) % 10); if ((DBG_TWICE >> s) & 1) { __syncthreads(); run_phase1(p, ph + DBG_ALT, lds, bid, nb); } }
}
constexpr int LDS_BYTES = FAST_GEMM ? 131072 + 16384 + 128 + 128 : 65536;
#if MK_SPLIT
__global__ void __launch_bounds__(NTHR, 2) k_phase(Prm p, int ph) {
  extern __shared__ __attribute__((aligned(16))) unsigned char lds[];
  run_phase(p, ph, lds, blockIdx.x, gridDim.x);
}
#endif
#if !MK_SPLIT
__global__ void __launch_bounds__(NTHR, 2) k_mega(Prm p) {
  extern __shared__ __attribute__((aligned(16))) unsigned char lds[];
  cg::grid_group grid = cg::this_grid();
  if (p.out == nullptr) grid.sync();
  volatile LAS unsigned* st = (volatile LAS unsigned*)((LAS unsigned char*)lds + 131072 + 16384 + 64);
  if (TIDX < 2) st[TIDX] = 0u;
  if (TIDX < 24) { const int i = TIDX; ((LAS float*)((LAS unsigned char*)lds + ROPE_TAB_OFF))[i] = (i < 16 ? exp2f(-(float)i * (13.287712379549449f / 16.f)) : exp2f(-(float)(i - 16) * (13.287712379549449f / 8.f))) * 0.15915494309189535f; }
  __syncthreads();
  XcdBarrier xb = xcd_barrier_post((unsigned*)(p.ws + OFF_CTL) + 1024, st);
#pragma unroll 1
  for (int ph = 0; ph < NPHASE; ++ph) { int phv = ph; asm volatile("" : "+s"(phv));
    run_phase(p, phv, lds, blockIdx.x, gridDim.x);
    if (ph + 1 < NPHASE && (ph % 10) != 4) xcd_barrier(xb); }
}
#define K_MAIN k_mega
#else
#define K_MAIN k_phase
#endif

extern "C" void kernel_launch(void* const* d_in, const int* in_sizes, int n_in, void* d_out, int out_size, void* d_ws, size_t ws_size, hipStream_t stream) {
  static int grid = 0;
  if (grid == 0) {
    if (n_in != 20 || ws_size < WS_END || out_size != NB * SEQ * DM) { fprintf(stderr, "kernel_launch: bad shapes n_in %d ws %zu (need %zu) out %d\n", n_in, ws_size, (size_t)WS_END, out_size); grid = -1; return; }
    int dev = 0, cus = 0, per = 0;
    (void)hipGetDevice(&dev); (void)hipDeviceGetAttribute(&cus, hipDeviceAttributeMultiprocessorCount, dev);
    (void)hipFuncSetAttribute((const void*)K_MAIN, hipFuncAttributeMaxDynamicSharedMemorySize, LDS_BYTES);
    (void)hipOccupancyMaxActiveBlocksPerMultiprocessor(&per, (const void*)K_MAIN, NTHR, LDS_BYTES);
    if (per < 1) per = 1;
    if (per > 1) per = 1;
    grid = cus * per;
    (void)hipGetLastError();
  }
  if (grid < 0) return;
  Prm p{};
  const float** pf = (const float**)&p;
  for (int i = 0; i < 20; ++i) pf[i] = (const float*)d_in[i];
  p.out = (float*)d_out; p.ws = (unsigned char*)d_ws;
#if MK_SPLIT
  for (int ph = 0; ph < NPHASE; ++ph) hipLaunchKernelGGL(k_phase, dim3(1024), dim3(NTHR), LDS_BYTES, stream, p, ph);
#else
  (void)hipMemsetAsync((char*)d_ws + OFF_CTL, 0, 65536, stream);
  void* args[] = {&p};
  hipError_t e = hipLaunchCooperativeKernel((const void*)k_mega, dim3(grid), dim3(NTHR), args, LDS_BYTES, stream);
  if (e != hipSuccess) fprintf(stderr, "cooperative launch failed: %s (grid %d)\n", hipGetErrorString(e), grid);
#endif
}
```

```cpp
#include <hip/hip_runtime.h>
#include <hip/hip_cooperative_groups.h>
#include <cstdint>
#include <cstdio>
namespace cg = cooperative_groups;

#ifndef MK_SPLIT
#define MK_SPLIT 0
#endif
#ifndef FAST_GEMM
#define FAST_GEMM 1
#endif
#ifndef FAST_ATTN
#define FAST_ATTN 1
#endif

typedef unsigned short bf16_t;
typedef short bf16x8 __attribute__((ext_vector_type(8)));
typedef float f32x4 __attribute__((ext_vector_type(4)));
typedef float f32x16 __attribute__((ext_vector_type(16)));
typedef unsigned u32x4 __attribute__((ext_vector_type(4)));
typedef unsigned u32x2 __attribute__((ext_vector_type(2)));

constexpr int NTHR = 512, NWAVE = 8;
constexpr int NB = 4, SEQ = 8192, LC = 256, TT = SEQ + LC, MR = NB * TT, DM = 1024, DEPTH = 2;
constexpr int NIN = 1440, NINP = 1536, QRK = 384, KVRK = 256, NQB = 768, NKVB = 1024;
constexpr int NE = 16, DFF = 512, CAPL = 1024, CAPC = 32;
constexpr int NSLOT = NB * NE * CAPL + NE * 256;
constexpr float EPS = 1e-6f;
constexpr float LOG2E = 1.4426950408889634f;
constexpr float SCALE_A = 0.125f * LOG2E;
constexpr float SCALE_B = 0.10206207261596575f * LOG2E;

constexpr size_t al256(size_t v) { return (v + 255) / 256 * 256; }
constexpr size_t OFF_CTL = 0;
constexpr size_t OFF_MOD = 1u << 20;
constexpr size_t OFF_ROPE = OFF_MOD + al256((size_t)2 * 5 * 6144 * 4);
constexpr size_t OFF_SSQQ = OFF_ROPE + al256((size_t)(2 * 2048 + 2 * 1024) * 4);
constexpr size_t OFF_SSQK = OFF_SSQQ + al256((size_t)MR * 4);
constexpr size_t OFF_AFF = OFF_SSQK + al256((size_t)MR * 4);
constexpr size_t OFF_INV = OFF_AFF + al256((size_t)MR * 16 * 4);
constexpr size_t OFF_IDX = OFF_INV + al256((size_t)MR * 16 * 4);
constexpr size_t OFF_VAL = OFF_IDX + al256((size_t)NSLOT * 4);
constexpr size_t OFF_KR = OFF_VAL + al256((size_t)NSLOT * 4);
constexpr size_t SZ_WIN = (size_t)NINP * DM * 2, SZ_WQ = (size_t)NQB * QRK * 2, SZ_WKV = (size_t)NKVB * KVRK * 2, SZ_WO = (size_t)DM * DM * 2;
constexpr size_t SZ_WL = SZ_WIN + SZ_WQ + SZ_WKV + SZ_WO;
constexpr size_t OFF_W = OFF_KR + al256((size_t)MR * 32 * 2);
constexpr size_t OFF_WGU = OFF_W + 2 * SZ_WL;
constexpr size_t OFF_WD = OFF_WGU + (size_t)NE * 1024 * 1024 * 2;
constexpr size_t OFF_X = OFF_WD + (size_t)NE * 1024 * 512 * 2;
constexpr size_t OFF_R = OFF_X + (size_t)MR * DM * 4;
constexpr size_t R_H = 0;
constexpr size_t R_QA = R_H + (size_t)MR * DM * 2;
constexpr size_t R_KA = R_QA + (size_t)MR * 512 * 2;
constexpr size_t R_VA = R_KA + (size_t)MR * 128 * 2;
constexpr size_t R_QB = R_VA + (size_t)MR * 128 * 2;
constexpr size_t R_KB = R_QB + (size_t)MR * 768 * 2;
constexpr size_t R_VB = R_KB + (size_t)MR * 512 * 2;
constexpr size_t R_CQ = R_VB + (size_t)MR * 512 * 2;
constexpr size_t R_CKV = R_CQ + (size_t)MR * QRK * 2;
constexpr size_t R_END = R_CKV + (size_t)MR * KVRK * 2;
constexpr size_t R_MIXG = R_QA;
constexpr size_t R_ACT = R_QA;
constexpr size_t R_Y = R_ACT + (size_t)NSLOT * DFF * 2;
static_assert(R_Y + (size_t)NSLOT * DM * 2 <= R_END, "moe overlay fits");
constexpr size_t WS_END = OFF_R + R_END;

struct Prm {
  const float *x, *c, *ctx, *c_ctx, *w_mod, *b_mod, *norm_attn, *norm_ffn, *w_in, *sink, *q_norm, *kv_norm, *w_q_up, *w_kv_up, *w_out, *w_router, *w_gate, *w_up,
      *w_down, *norm_final;
  float* out;
  unsigned char* ws;
};

__device__ __forceinline__ float bf2f(bf16_t v) { return __uint_as_float((unsigned)v << 16); }
__device__ __forceinline__ bf16_t f2bf(float f) { unsigned u = __float_as_uint(f); return (bf16_t)((u + 0x7fffu + ((u >> 16) & 1u)) >> 16); }
__device__ __forceinline__ unsigned pk2(float lo, float hi) { return (unsigned)f2bf(lo) | ((unsigned)f2bf(hi) << 16); }
template <int CTRL> __device__ __forceinline__ float dpp_mov(float x) { return __int_as_float(__builtin_amdgcn_update_dpp(0, __float_as_int(x), CTRL, 0xF, 0xF, true)); }
__device__ __forceinline__ float xor1(float x) { return dpp_mov<0xB1>(x); }
__device__ __forceinline__ float xor2(float x) { return dpp_mov<0x4E>(x); }
__device__ __forceinline__ float hmir(float x) { return dpp_mov<0x141>(x); }
__device__ __forceinline__ float xor8(float x) { return dpp_mov<0x128>(x); }
__device__ __forceinline__ float sum16sw(float x) { auto r = __builtin_amdgcn_permlane16_swap(__float_as_uint(x), __float_as_uint(x), false, false); return __uint_as_float(r[0]) + __uint_as_float(r[1]); }
__device__ __forceinline__ float sum32sw(float x) { auto r = __builtin_amdgcn_permlane32_swap(__float_as_uint(x), __float_as_uint(x), false, false); return __uint_as_float(r[0]) + __uint_as_float(r[1]); }
__device__ __forceinline__ float max16sw(float x) { auto r = __builtin_amdgcn_permlane16_swap(__float_as_uint(x), __float_as_uint(x), false, false); return fmaxf(__uint_as_float(r[0]), __uint_as_float(r[1])); }
__device__ __forceinline__ float max32sw(float x) { auto r = __builtin_amdgcn_permlane32_swap(__float_as_uint(x), __float_as_uint(x), false, false); return fmaxf(__uint_as_float(r[0]), __uint_as_float(r[1])); }
__device__ __forceinline__ float wave_sum(float v) {
  v += xor1(v); v += xor2(v); v += hmir(v); v += xor8(v); v = sum16sw(v); v = sum32sw(v);
  return v;
}
__device__ __forceinline__ float silu_f(float v) { return v / (1.f + __expf(-v)); }
__device__ __forceinline__ float silu_fast(float v) { return v * __builtin_amdgcn_rcpf(1.f + __builtin_amdgcn_exp2f(-1.4426950408889634f * v)); }
__device__ __forceinline__ unsigned cvtpk_e(float lo, float hi) { unsigned r; asm volatile("v_cvt_pk_bf16_f32 %0, %1, %2" : "=v"(r) : "v"(lo), "v"(hi)); return r; }
__device__ __forceinline__ int row_mi(int r) { const int b = r / TT, t = r - b * TT; return t < LC ? 4 : b; }

__device__ __forceinline__ int opaque_tid() { int t = __builtin_amdgcn_workitem_id_x(); asm volatile("" : "+v"(t)); return t; }
#define TIDX opaque_tid()
#define WSP(T, off) ((T*)(p.ws + (off)))

__device__ __forceinline__ void ph_mod(const Prm& p, int l, unsigned char* lds, int bid, int nb) {
  float* sc = (float*)lds;
  float* red = sc + 5 * 1024;
  const int tid = TIDX;
  for (int i = tid; i < 5 * 1024; i += NTHR) { const int mi = i >> 10, d = i & 1023; const float v = mi < 4 ? p.c[mi * 1024 + d] : p.c_ctx[d]; sc[i] = silu_f(v); }
  __syncthreads();
  float* MOD = WSP(float, OFF_MOD);
  const int cl = tid & 31, kg = tid >> 5;
  for (int it = bid; it < 192; it += nb) {
    const int e0 = it * 32;
    const float* w = p.w_mod + (size_t)l * 1024 * 6144 + e0 + cl;
    float a0 = 0, a1 = 0, a2 = 0, a3 = 0, a4 = 0;
#pragma unroll
    for (int k0 = 0; k0 < 64; k0 += 16) { float wv[16];
#pragma unroll
      for (int j = 0; j < 16; ++j) wv[j] = w[(size_t)(kg * 64 + k0 + j) * 6144];
#pragma unroll
      for (int j = 0; j < 16; ++j) { const int d = kg * 64 + k0 + j;
        a0 += sc[d] * wv[j]; a1 += sc[1024 + d] * wv[j]; a2 += sc[2048 + d] * wv[j]; a3 += sc[3072 + d] * wv[j]; a4 += sc[4096 + d] * wv[j]; } }
    float* rr = red + (kg * 32 + cl) * 5; rr[0] = a0; rr[1] = a1; rr[2] = a2; rr[3] = a3; rr[4] = a4;
    __syncthreads();
    if (tid < 160) { const int c2 = tid & 31, mi = tid >> 5; float s = 0; for (int g = 0; g < 16; ++g) s += red[(g * 32 + c2) * 5 + mi];
      MOD[(size_t)(l * 5 + mi) * 6144 + e0 + c2] = s + p.b_mod[l * 6144 + e0 + c2]; }
    __syncthreads();
  }
}

template <class Src>
__device__ __forceinline__ void tr_tile(const Src& src, bf16_t* dst, int K, int k0, int n0, float* tl  ) {
  const int tid = TIDX;
#pragma unroll
  for (int i = 0; i < 8; ++i) { const int e = tid + i * NTHR, kk = e >> 6, nn = e & 63; tl[kk * 65 + nn] = src(k0 + kk, n0 + nn); }
  __syncthreads();
#pragma unroll
  for (int i = 0; i < 2; ++i) { const int e = tid + i * NTHR, nn = e >> 4, kc = (e & 15) * 4;
    u32x2 o; o.x = pk2(tl[(kc + 0) * 65 + nn], tl[(kc + 1) * 65 + nn]); o.y = pk2(tl[(kc + 2) * 65 + nn], tl[(kc + 3) * 65 + nn]);
    *(u32x2*)(dst + (size_t)(n0 + nn) * K + k0 + kc) = o; }
  __syncthreads();
}
struct SrcIn { const float* w; __device__ float operator()(int k, int n) const { return n < NIN ? w[(size_t)k * NIN + n] : 0.f; } };
struct SrcScaled { const float* w; const float* nv; int N; __device__ float operator()(int k, int n) const { return w[(size_t)k * N + n] * nv[k]; } };
struct SrcPlain { const float* w; int N; __device__ float operator()(int k, int n) const { return w[(size_t)k * N + n]; } };
#if FAST_GEMM
struct SrcGU { const float* g; const float* u; __device__ float operator()(int k, int n) const { const int t = n >> 8, w = n & 255; return w < 128 ? g[(size_t)k * DFF + t * 128 + w] : u[(size_t)k * DFF + t * 128 + w - 128]; } };
#else
struct SrcGU { const float* g; const float* u; __device__ float operator()(int k, int n) const { const int t = n >> 6, w = n & 63; return w < 32 ? g[(size_t)k * DFF + t * 32 + w] : u[(size_t)k * DFF + t * 32 + w - 32]; } };
#endif

constexpr int WCB = 4;
struct WcItem { const float* sp; int ss; bf16_t* dp; int dK; const float* nv; int ncol; };
template <class F>
__device__ __forceinline__ void wconv_run(const F& item, int NIT, unsigned char* lds, int rank, int nranks) {
  float* tl = (float*)lds;
  const int tid = TIDX;
  for (int base = rank; base < NIT; base += nranks * WCB) {
    f32x4 rg[WCB][2]; float sc[WCB][2];
#pragma unroll
    for (int d = 0; d < WCB; ++d) { const int it = base + d * nranks;
      if (it < NIT) { const WcItem w = item(it);
#pragma unroll
        for (int i = 0; i < 2; ++i) { const int e = tid + i * NTHR, kk = e >> 4, n4 = (e & 15) * 4;
          rg[d][i] = n4 < w.ncol ? __builtin_nontemporal_load((const f32x4*)(w.sp + (size_t)kk * w.ss + n4)) : (f32x4){0.f, 0.f, 0.f, 0.f};
          sc[d][i] = w.nv ? w.nv[kk] : 1.f; } } }
#pragma unroll
    for (int d = 0; d < WCB; ++d) { const int it = base + d * nranks;
      if (it < NIT) { const WcItem w = item(it); float* t = tl + (d & 1) * (64 * 65);
#pragma unroll
        for (int i = 0; i < 2; ++i) { const int e = tid + i * NTHR, kk = e >> 4, n4 = (e & 15) * 4;
#pragma unroll
          for (int j = 0; j < 4; ++j) t[kk * 65 + n4 + j] = rg[d][i][j] * sc[d][i]; }
        __syncthreads();
#pragma unroll
        for (int i = 0; i < 2; ++i) { const int e = tid + i * NTHR, nn = e >> 4, kc = (e & 15) * 4;
          u32x2 o; o.x = pk2(t[(kc + 0) * 65 + nn], t[(kc + 1) * 65 + nn]); o.y = pk2(t[(kc + 2) * 65 + nn], t[(kc + 3) * 65 + nn]);
          *(u32x2*)(w.dp + (size_t)nn * w.dK + kc) = o; } } }
  }
  __syncthreads();
}
__device__ __forceinline__ void ph_wconv_dense(const Prm& p, int l, unsigned char* lds, int bid, int nb) {
  constexpr int T_IN = (DM / 64) * (NINP / 64), T_Q = (QRK / 64) * (NQB / 64), T_KV = (KVRK / 64) * (NKVB / 64), T_O = (DM / 64) * (DM / 64), T_L = T_IN + T_Q + T_KV + T_O;
  wconv_run([&p, l](int it) __attribute__((always_inline)) -> WcItem { int r = it; WcItem w;
    bf16_t* wb = (bf16_t*)(p.ws + OFF_W + (size_t)l * SZ_WL);
    if (r < T_IN) { const int kt = r / (NINP / 64), nt = r % (NINP / 64), n0 = nt * 64;
      w.sp = p.w_in + (size_t)l * DM * NIN + (size_t)(kt * 64) * NIN + n0; w.ss = NIN; w.dp = wb + (size_t)n0 * DM + kt * 64; w.dK = DM; w.nv = nullptr; w.ncol = NIN - n0; return w; } r -= T_IN;
    if (r < T_Q) { const int kt = r / (NQB / 64), nt = r % (NQB / 64);
      w.sp = p.w_q_up + (size_t)l * QRK * NQB + (size_t)(kt * 64) * NQB + nt * 64; w.ss = NQB; w.dp = (bf16_t*)((unsigned char*)wb + SZ_WIN) + (size_t)(nt * 64) * QRK + kt * 64; w.dK = QRK;
      w.nv = p.q_norm + l * QRK + kt * 64; w.ncol = 64; return w; } r -= T_Q;
    if (r < T_KV) { const int kt = r / (NKVB / 64), nt = r % (NKVB / 64);
      w.sp = p.w_kv_up + (size_t)l * KVRK * NKVB + (size_t)(kt * 64) * NKVB + nt * 64; w.ss = NKVB; w.dp = (bf16_t*)((unsigned char*)wb + SZ_WIN + SZ_WQ) + (size_t)(nt * 64) * KVRK + kt * 64; w.dK = KVRK;
      w.nv = p.kv_norm + l * KVRK + kt * 64; w.ncol = 64; return w; } r -= T_KV;
    { const int kt = r / (DM / 64), nt = r % (DM / 64);
      w.sp = p.w_out + (size_t)l * DM * DM + (size_t)(kt * 64) * DM + nt * 64; w.ss = DM; w.dp = (bf16_t*)((unsigned char*)wb + SZ_WIN + SZ_WQ + SZ_WKV) + (size_t)(nt * 64) * DM + kt * 64; w.dK = DM;
      w.nv = nullptr; w.ncol = 64; return w; } }, T_L, lds, bid, nb);
}
__device__ __forceinline__ void ph_wconv_moe(const Prm& p, int l, unsigned char* lds, int rank, int nranks) {
  constexpr int T_GU = (DM / 64) * (1024 / 64), T_D = (DFF / 64) * (DM / 64), T_E = T_GU + T_D;
  wconv_run([&p, l](int it) __attribute__((always_inline)) -> WcItem { const int e = it / T_E; int r = it % T_E; WcItem w; w.nv = nullptr; w.ncol = 64;
    if (r < T_GU) { const int kt = r >> 4, nt = r & 15, n0 = nt * 64, t = n0 >> 8, wq = n0 & 255;
      const float* src = (wq < 128 ? p.w_gate : p.w_up) + ((size_t)l * NE + e) * DM * DFF;
      w.sp = src + (size_t)(kt * 64) * DFF + t * 128 + (wq & 127); w.ss = DFF; w.dp = WSP(bf16_t, OFF_WGU) + (size_t)e * 1024 * 1024 + (size_t)n0 * DM + kt * 64; w.dK = DM; }
    else { r -= T_GU; const int kt = r >> 4, nt = r & 15;
      w.sp = p.w_down + ((size_t)l * NE + e) * DFF * DM + (size_t)(kt * 64) * DM + nt * 64; w.ss = DM; w.dp = WSP(bf16_t, OFF_WD) + (size_t)e * 1024 * 512 + (size_t)(nt * 64) * DFF + kt * 64; w.dK = DFF; }
    return w; }, NE * T_E, lds, rank, nranks);
}

typedef int i32x4 __attribute__((ext_vector_type(4)));
__device__ __forceinline__ void y_acc(f32x4 (&s)[4], const u32x2 (&y)[4]) {
#pragma unroll
  for (int j = 0; j < 4; ++j) { s[j][0] += __uint_as_float(y[j].x << 16); s[j][1] += __uint_as_float(y[j].x & 0xffff0000u); s[j][2] += __uint_as_float(y[j].y << 16); s[j][3] += __uint_as_float(y[j].y & 0xffff0000u); }
}
struct RowLd { f32x4 x[4]; i32x4 q[4]; };
__device__ __forceinline__ void row_issue(const Prm& p, int l, int r, int lane, RowLd& R) {
  const int b = r / TT, t = r - b * TT;
  if (l == 0) { const float* src = t < LC ? p.ctx + ((size_t)b * LC + t) * DM : p.x + ((size_t)b * SEQ + (t - LC)) * DM;
#pragma unroll
    for (int j = 0; j < 4; ++j) R.x[j] = *(const f32x4*)(src + 4 * lane + 256 * j);
  } else { int zv = 0; asm volatile("" : "+v"(zv));
    const float* X = WSP(float, OFF_X) + (size_t)r * DM; const i32x4* inv = (const i32x4*)(WSP(int, OFF_INV) + (size_t)r * 16 + zv);
#pragma unroll
    for (int j = 0; j < 4; ++j) { R.x[j] = *(const f32x4*)(X + 4 * lane + 256 * j); R.q[j] = inv[j]; } }
}
__device__ __forceinline__ void row_finish(const Prm& p, int l, int r, int lane, RowLd& R, f32x4 (&v)[4]) {
  if (l == 0) {
#pragma unroll
    for (int j = 0; j < 4; ++j) v[j] = R.x[j];
    return; }
  const int b = r / TT, t = r - b * TT;
  const float* gf = WSP(float, OFF_MOD) + (size_t)((l - 1) * 5 + (t < LC ? 4 : b)) * 6144 + 5 * 1024;
  f32x4 gv[4];
#pragma unroll
  for (int j = 0; j < 4; ++j) gv[j] = *(const f32x4*)(gf + 4 * lane + 256 * j);
  const bf16_t* Y = (const bf16_t*)(p.ws + OFF_R + R_Y) + 4 * lane;
  int c0 = 0, c1 = 0, c2 = 0, c3 = 0, cnt = 0;
#pragma unroll
  for (int e = 0; e < 16; ++e) { const int sv = __builtin_amdgcn_readfirstlane(R.q[e >> 2][e & 3]);
    if (sv >= 0) { c0 = cnt == 0 ? sv : c0; c1 = cnt == 1 ? sv : c1; c2 = cnt == 2 ? sv : c2; c3 = cnt == 3 ? sv : c3; ++cnt; } }
  u32x2 y0[4], y1[4], y2[4], y3[4];
#pragma unroll
  for (int j = 0; j < 4; ++j) { y0[j] = (u32x2){0u, 0u}; y1[j] = y0[j]; y2[j] = y0[j]; y3[j] = y0[j]; }
  if (cnt > 0) {
#pragma unroll
    for (int j = 0; j < 4; ++j) y0[j] = *(const u32x2*)(Y + (size_t)c0 * DM + 256 * j); }
  if (cnt > 1) {
#pragma unroll
    for (int j = 0; j < 4; ++j) y1[j] = *(const u32x2*)(Y + (size_t)c1 * DM + 256 * j); }
  if (cnt > 2) {
#pragma unroll
    for (int j = 0; j < 4; ++j) y2[j] = *(const u32x2*)(Y + (size_t)c2 * DM + 256 * j); }
  if (cnt > 3) {
#pragma unroll
    for (int j = 0; j < 4; ++j) y3[j] = *(const u32x2*)(Y + (size_t)c3 * DM + 256 * j); }
  f32x4 s[4];
#pragma unroll
  for (int j = 0; j < 4; ++j) s[j] = (f32x4){0.f, 0.f, 0.f, 0.f};
  y_acc(s, y0); y_acc(s, y1); y_acc(s, y2); y_acc(s, y3);
  if (cnt > 4) { int k = 0;
#pragma unroll
    for (int e = 0; e < 16; ++e) { const int sv = __builtin_amdgcn_readfirstlane(R.q[e >> 2][e & 3]);
      if (sv >= 0) { if (k >= 4) { u32x2 yy[4];
#pragma unroll
          for (int j = 0; j < 4; ++j) yy[j] = *(const u32x2*)(Y + (size_t)sv * DM + 256 * j);
          y_acc(s, yy); }
        ++k; } } }
#pragma unroll
  for (int j = 0; j < 4; ++j) v[j] = R.x[j] + gv[j] * s[j];
}
__device__ __forceinline__ float row_ssq(const f32x4 (&v)[4]) { float ss = 0.f;
#pragma unroll
  for (int j = 0; j < 4; ++j) ss += v[j][0] * v[j][0] + v[j][1] * v[j][1] + v[j][2] * v[j][2] + v[j][3] * v[j][3];
  return wave_sum(ss); }
__device__ __forceinline__ void norm_a_store(const Prm& p, int l, int r, int lane, const f32x4 (&v)[4]) {
  const float* md = WSP(float, OFF_MOD) + (size_t)(l * 5 + row_mi(r)) * 6144;
  f32x4 nwv[4], shv[4], sclv[4];
#pragma unroll
  for (int j = 0; j < 4; ++j) { const int c = 4 * lane + 256 * j; nwv[j] = *(const f32x4*)(p.norm_attn + l * DM + c); shv[j] = *(const f32x4*)(md + c); sclv[j] = *(const f32x4*)(md + 1024 + c); }
  const float rs = rsqrtf(row_ssq(v) * (1.f / DM) + EPS);
  float* X = WSP(float, OFF_X) + (size_t)r * DM; bf16_t* H = (bf16_t*)(p.ws + OFF_R + R_H) + (size_t)r * DM;
  if (lane == 0) { WSP(float, OFF_SSQQ)[r] = 0.f; WSP(float, OFF_SSQK)[r] = 0.f; }
#pragma unroll
  for (int j = 0; j < 4; ++j) { const int c = 4 * lane + 256 * j;
    *(f32x4*)(X + c) = v[j];
    const f32x4 nw = nwv[j], sh = shv[j], scl = sclv[j];
    const f32x4 h = v[j] * rs * nw * (scl + 1.f) + sh;
    u32x2 o; o.x = pk2(h[0], h[1]); o.y = pk2(h[2], h[3]); *(u32x2*)(H + c) = o; }
}
constexpr int RPI = 4, RPA = 2;
#define ROWPIPE(R0, R1, ROWOF, LAYER, STORE) do { \
    RowLd A0, A1, B0, B1; f32x4 va[4], vb[4]; \
    int r = (R0); \
    if (r < (R1)) row_issue(p, LAYER, ROWOF(r), lane, A0); if (r + 1 < (R1)) row_issue(p, LAYER, ROWOF(r + 1), lane, A1); \
    for (; r < (R1); r += 4) { \
      if (r + 2 < (R1)) row_issue(p, LAYER, ROWOF(r + 2), lane, B0); if (r + 3 < (R1)) row_issue(p, LAYER, ROWOF(r + 3), lane, B1); \
      row_finish(p, LAYER, ROWOF(r), lane, A0, va); if (r + 1 < (R1)) row_finish(p, LAYER, ROWOF(r + 1), lane, A1, vb); \
      STORE(r, va); if (r + 1 < (R1)) STORE(r + 1, vb); \
      if (r + 2 >= (R1)) break; \
      if (r + 4 < (R1)) row_issue(p, LAYER, ROWOF(r + 4), lane, A0); if (r + 5 < (R1)) row_issue(p, LAYER, ROWOF(r + 5), lane, A1); \
      row_finish(p, LAYER, ROWOF(r + 2), lane, B0, va); if (r + 3 < (R1)) row_finish(p, LAYER, ROWOF(r + 3), lane, B1, vb); \
      STORE(r + 2, va); if (r + 3 < (R1)) STORE(r + 3, vb); \
    } } while (0)
__device__ __forceinline__ void ph_norm_a(const Prm& p, int l, int bid, int nb) {
  const int lane = TIDX & 63, wv = __builtin_amdgcn_readfirstlane(TIDX >> 6);
  const int nw = nb * NWAVE, rpw = (MR + nw - 1) / nw, gw = bid * NWAVE + wv;
  const int r0 = gw * rpw, r1 = min(MR, r0 + rpw);
#define ROWID(x) (x)
#define NA_STORE(x, v) norm_a_store(p, l, (x), lane, v)
  ROWPIPE(r0, r1, ROWID, l, NA_STORE);
#undef ROWID
#undef NA_STORE
}
__device__ __forceinline__ void final_store(const Prm& p, int q, int lane, const f32x4 (&v)[4]) {
  f32x4 nfv[4];
#pragma unroll
  for (int j = 0; j < 4; ++j) nfv[j] = *(const f32x4*)(p.norm_final + 4 * lane + 256 * j);
  const float rs = rsqrtf(row_ssq(v) * (1.f / DM) + EPS); float* o = p.out + (size_t)q * DM;
#pragma unroll
  for (int j = 0; j < 4; ++j) { const int c = 4 * lane + 256 * j; *(f32x4*)(o + c) = v[j] * rs * nfv[j]; }
}
__device__ __forceinline__ void ph_final(const Prm& p, int bid, int nb) {
  const int lane = TIDX & 63, wv = __builtin_amdgcn_readfirstlane(TIDX >> 6);
  const int nw = nb * NWAVE, NQ = NB * SEQ, rpw = (NQ + nw - 1) / nw, gw = bid * NWAVE + wv;
  const int q0 = gw * rpw, q1 = min(NQ, q0 + rpw);
#define ROWQ(x) (((x) / SEQ) * TT + LC + ((x) % SEQ))
#define FIN_STORE(x, v) final_store(p, (x), lane, v)
  ROWPIPE(q0, q1, ROWQ, DEPTH, FIN_STORE);
#undef ROWQ
#undef FIN_STORE
}
template <bool ROUTER>
__device__ __forceinline__ void norm_b_row(const Prm& p, int l, int r, int lane, const f32x4 (&v)[4], const float* wl) {
  const int b = r / TT, t = r - b * TT;
  const float* md = WSP(float, OFF_MOD) + (size_t)(l * 5 + (t < LC ? 4 : b)) * 6144;
  f32x4 nwv[4], shv[4], sclv[4];
#pragma unroll
  for (int j = 0; j < 4; ++j) { const int c = 4 * lane + 256 * j; nwv[j] = *(const f32x4*)(p.norm_ffn + l * DM + c); shv[j] = *(const f32x4*)(md + 3 * 1024 + c); sclv[j] = *(const f32x4*)(md + 4 * 1024 + c); }
  const float rs = rsqrtf(row_ssq(v) * (1.f / DM) + EPS);
  bf16_t* H = (bf16_t*)(p.ws + OFF_R + R_H) + (size_t)r * DM;
  float lg[NE];
#pragma unroll
  for (int e = 0; e < NE; ++e) lg[e] = 0.f;
#pragma unroll
  for (int j = 0; j < 4; ++j) { const int c = 4 * lane + 256 * j;
    const f32x4 nw = nwv[j], sh = shv[j], scl = sclv[j];
    const f32x4 h = v[j] * rs * nw * (scl + 1.f) + sh;
    u32x2 o; o.x = pk2(h[0], h[1]); o.y = pk2(h[2], h[3]); *(u32x2*)(H + c) = o;
    if (ROUTER)
#pragma unroll
    for (int ip = 0; ip < 2; ++ip) {
      f32x4 w8[2][4];
#pragma unroll
      for (int i2 = 0; i2 < 2; ++i2)
#pragma unroll
        for (int e4 = 0; e4 < 4; ++e4) w8[i2][e4] = *(const f32x4*)(wl + ((((j * 4 + ip * 2 + i2) * 4 + e4) * 64 + lane) << 2));
      __builtin_amdgcn_sched_barrier(0);
#pragma unroll
      for (int i2 = 0; i2 < 2; ++i2)
#pragma unroll
        for (int e4 = 0; e4 < 4; ++e4) { const float hv = h[ip * 2 + i2]; const f32x4 w4 = w8[i2][e4];
          lg[4 * e4] += hv * w4[0]; lg[4 * e4 + 1] += hv * w4[1]; lg[4 * e4 + 2] += hv * w4[2]; lg[4 * e4 + 3] += hv * w4[3]; }
      __builtin_amdgcn_sched_barrier(0);
    } }
  if (!ROUTER) return;
#pragma unroll
  for (int e = 0; e < NE; ++e) { lg[e] += xor1(lg[e]); lg[e] += xor2(lg[e]); }
  float t8[8], t4[4], t2[2], t1;
#pragma unroll
  for (int i = 0; i < 8; ++i) { auto rr = __builtin_amdgcn_permlane32_swap(__float_as_uint(lg[i]), __float_as_uint(lg[i + 8]), false, false); t8[i] = __uint_as_float(rr[0]) + __uint_as_float(rr[1]); }
#pragma unroll
  for (int i = 0; i < 4; ++i) { auto rr = __builtin_amdgcn_permlane16_swap(__float_as_uint(t8[i]), __float_as_uint(t8[i + 4]), false, false); t4[i] = __uint_as_float(rr[0]) + __uint_as_float(rr[1]); }
  { const bool hb = lane & 8;
#pragma unroll
    for (int i = 0; i < 2; ++i) { const float snd = hb ? t4[i] : t4[i + 2], kp = hb ? t4[i + 2] : t4[i]; t2[i] = kp + xor8(snd); } }
  { const bool hb = lane & 4; const float snd = hb ? t2[0] : t2[1], kp = hb ? t2[1] : t2[0]; t1 = kp + hmir(snd); }
  float mx = t1;
  mx = fmaxf(mx, hmir(mx)); mx = fmaxf(mx, xor8(mx)); mx = max16sw(mx); mx = max32sw(mx);
  const float ex = __expf(t1 - mx); float sm = ex;
  sm += hmir(sm); sm += xor8(sm); sm = sum16sw(sm); sm = sum32sw(sm);
  if ((lane & 3) == 0) WSP(float, OFF_AFF)[(size_t)r * NE + (lane >> 2)] = ex / sm;
}
template <bool ROUTER>
__device__ __forceinline__ void ph_norm_b(const Prm& p, int l, unsigned char* lds, int bid, int nb) {
  const int tid = TIDX, lane = tid & 63, wv = __builtin_amdgcn_readfirstlane(tid >> 6);
  float* wl = (float*)lds;
  { const float* wr = p.w_router + (size_t)l * DM * NE;
    float rv[DM * NE / NTHR];
#pragma unroll
    for (int q = 0; q < DM * NE / NTHR; ++q) rv[q] = wr[tid + q * NTHR];
#pragma unroll
    for (int q = 0; q < DM * NE / NTHR; ++q) { const int idx = tid + q * NTHR; const int d = idx >> 4, e = idx & 15, j = d >> 8, ln = (d >> 2) & 63, i = d & 3;
      wl[((((j * 4 + i) * 4 + (e >> 2)) * 64 + ln) << 2) + (e & 3)] = rv[q]; } }
  __syncthreads();
  const int nw = nb * NWAVE, rpw = (MR + nw - 1) / nw, gw = bid * NWAVE + wv;
  const int r0 = gw * rpw, r1 = min(MR, r0 + rpw);
  for (int r = r0; r < r1; r += RPI) {
    f32x4 v[RPI][4]; u32x2 mg[RPI][4]; bool sk[RPI];
#pragma unroll
    for (int i = 0; i < RPI; ++i) { sk[i] = (r + i >= r1) || ((l == DEPTH - 1) && ((r + i) % TT) < LC);
      if (!sk[i]) { const float* X = WSP(float, OFF_X) + (size_t)(r + i) * DM; const bf16_t* MG = (const bf16_t*)(p.ws + OFF_R + R_MIXG) + (size_t)(r + i) * DM;
#pragma unroll
        for (int j = 0; j < 4; ++j) { v[i][j] = *(const f32x4*)(X + 4 * lane + 256 * j); mg[i][j] = *(const u32x2*)(MG + 4 * lane + 256 * j); } } }
#pragma unroll
    for (int i = 0; i < RPI; ++i) if (!sk[i]) {
      float* X = WSP(float, OFF_X) + (size_t)(r + i) * DM;
#pragma unroll
      for (int j = 0; j < 4; ++j) { v[i][j][0] += __uint_as_float(mg[i][j].x << 16); v[i][j][1] += __uint_as_float(mg[i][j].x & 0xffff0000u); v[i][j][2] += __uint_as_float(mg[i][j].y << 16); v[i][j][3] += __uint_as_float(mg[i][j].y & 0xffff0000u);
        *(f32x4*)(X + 4 * lane + 256 * j) = v[i][j]; }
      norm_b_row<ROUTER>(p, l, r + i, lane, v[i], wl); }
  }
  __syncthreads();
}

__device__ __forceinline__ void ph_topk(const Prm& p, int l, unsigned char* lds, int bid, int nb) {
  unsigned* keys = (unsigned*)lds;
  unsigned* hist = keys + 8192;
  unsigned* scan = hist + 8 * 256;
  unsigned* misc = scan + 512;
  const int tid = TIDX;
  const float* AFF = WSP(float, OFF_AFF);
  int* IDX = WSP(int, OFF_IDX); float* VAL = WSP(float, OFF_VAL); int* INV = WSP(int, OFF_INV);
  const int ngroups = (l == DEPTH - 1) ? 64 : 128;
  for (int g = bid; g < ngroups; g += nb) {
    const bool isctx = g >= 64; const int b = (g & 63) >> 4, e = g & 15;
    const int n = isctx ? LC : SEQ, cap = isctx ? CAPC : CAPL, r0 = b * TT + (isctx ? 0 : LC);
    const int sbase = isctx ? (NB * NE * CAPL + e * 256 + b * 32) : ((b * NE + e) * CAPL);
#pragma unroll
    for (int j0 = 0; j0 < SEQ / NTHR; j0 += 8) { unsigned kreg[8];
#pragma unroll
      for (int j = 0; j < 8; ++j) { const int i = tid + (j0 + j) * NTHR; kreg[j] = i < n ? __float_as_uint(AFF[(size_t)(r0 + i) * NE + e]) : 0u; }
#pragma unroll
      for (int j = 0; j < 8; ++j) { const int i = tid + (j0 + j) * NTHR; if (i < n) keys[i] = kreg[j]; } }
    if (tid == 0) misc[2] = 0;
    __syncthreads();
    unsigned prefix = 0, kk = cap;
    for (int pass = 3; pass >= 0; --pass) {
      for (int i = tid; i < 8 * 256; i += NTHR) hist[i] = 0;
      __syncthreads();
      const int sh = pass * 8; const unsigned hm = pass == 3 ? 0u : (0xffffffffu << (sh + 8));
      unsigned* myh = hist + (tid >> 6) * 256;
      for (int i = tid; i < n; i += NTHR) { const unsigned k = keys[i]; if ((k & hm) == (prefix & hm)) atomicAdd(&myh[(k >> sh) & 255u], 1u); }
      __syncthreads();
      if (tid < 256) { unsigned t_ = 0;
#pragma unroll
        for (int w = 0; w < 8; ++w) t_ += hist[w * 256 + tid];
        hist[tid] = t_; }
      __syncthreads();
      if (tid < 256) { unsigned cum = 0; for (int bk = tid + 1; bk < 256; ++bk) cum += hist[bk];
        const unsigned mine = hist[tid]; if (cum < kk && kk <= cum + mine) { misc[0] = (unsigned)tid; misc[1] = kk - cum; } }
      __syncthreads();
      prefix |= misc[0] << sh; kk = misc[1];
      __syncthreads();
    }
    const int chunk = (n + NTHR - 1) / NTHR; const int i0 = tid * chunk, i1 = min(n, i0 + chunk);
    unsigned eq = 0; for (int i = i0; i < i1; ++i) eq += (keys[i] == prefix) ? 1u : 0u;
    scan[tid] = eq; __syncthreads();
    for (int o = 1; o < NTHR; o <<= 1) { const unsigned a = tid >= o ? scan[tid - o] : 0u; __syncthreads(); scan[tid] += a; __syncthreads(); }
    unsigned erank = scan[tid] - eq;
    const unsigned ngt = cap - kk;
    for (int i = i0; i < i1; ++i) { const unsigned k = keys[i]; int slot = -1;
      if (k > prefix) slot = (int)atomicAdd(&misc[2], 1u);
      else if (k == prefix) { if (erank < kk) slot = (int)(ngt + erank); ++erank; }
      const int row = r0 + i;
      if (slot >= 0) { IDX[sbase + slot] = row; VAL[sbase + slot] = __uint_as_float(k); INV[(size_t)row * NE + e] = sbase + slot; }
      else INV[(size_t)row * NE + e] = -1; }
    if (isctx && tid < 32) { IDX[NB * NE * CAPL + e * 256 + 128 + b * 32 + tid] = 0; VAL[NB * NE * CAPL + e * 256 + 128 + b * 32 + tid] = 0.f; }
    __syncthreads();
  }
}

template <int NF, class AP, class Epi>
__device__ __forceinline__ void sgemm_wave(const AP& ap, const bf16_t* __restrict__ Bt, int K, int m0, int n0, const Epi& epi) {
  const int lane = TIDX & 63, fr = lane & 15, fq = lane >> 4;
  f32x4 acc[4][NF];
#pragma unroll
  for (int i = 0; i < 4; ++i)
#pragma unroll
    for (int j = 0; j < NF; ++j) acc[i][j] = (f32x4){0.f, 0.f, 0.f, 0.f};
  const bf16_t* a_[4]; const bf16_t* b_[NF];
#pragma unroll
  for (int i = 0; i < 4; ++i) a_[i] = ap.row(m0 + 16 * i + fr) + fq * 8;
#pragma unroll
  for (int j = 0; j < NF; ++j) b_[j] = Bt + (size_t)(n0 + 16 * j + fr) * K + fq * 8;
#pragma unroll 2
  for (int k0 = 0; k0 < K; k0 += 32) {
    bf16x8 av[4], bv[NF];
#pragma unroll
    for (int i = 0; i < 4; ++i) av[i] = *(const bf16x8*)(a_[i] + k0);
#pragma unroll
    for (int j = 0; j < NF; ++j) bv[j] = *(const bf16x8*)(b_[j] + k0);
#pragma unroll
    for (int i = 0; i < 4; ++i)
#pragma unroll
      for (int j = 0; j < NF; ++j) acc[i][j] = __builtin_amdgcn_mfma_f32_16x16x32_bf16(av[i], bv[j], acc[i][j], 0, 0, 0);
  }
  epi(acc, m0, n0, fr, fq);
}
struct APDense { const bf16_t* A; int lda; __device__ __forceinline__ const bf16_t* row(int r) const { return A + (size_t)r * lda; } };
struct APGather { const bf16_t* A; const int* idx; __device__ __forceinline__ const bf16_t* row(int r) const { return A + (size_t)idx[r] * DM; } };

__device__ __forceinline__ void rope_pos(int row, bool& lat, int& rp, int& cp) { const int b = row / TT, t = row - b * TT; lat = t >= LC; const int pos = t - LC; rp = pos >> 6; cp = pos & 63; }

struct EpiIn {
  const Prm* pp;
  __device__ __forceinline__ void operator()(f32x4 (&acc)[4][4], int m0, int n0, int fr, int fq) const {
    const Prm& p = *pp; const float* RT = WSP(float, OFF_ROPE);
    if (n0 >= 1472) return;
#pragma unroll
    for (int mf = 0; mf < 4; ++mf)
#pragma unroll
      for (int j = 0; j < 4; ++j) {
        const int row = m0 + 16 * mf + 4 * fq + j; bool lat; int rp, cp; rope_pos(row, lat, rp, cp);
        float v[4] = {acc[mf][0][j], acc[mf][1][j], acc[mf][2][j], acc[mf][3][j]};
        if (n0 < 640) {
          if (lat) { const float c0 = RT[rp * 16 + fr], s0 = RT[2048 + rp * 16 + fr], c1 = RT[cp * 16 + fr], s1 = RT[2048 + cp * 16 + fr];
            const float a = v[0] * c0 - v[1] * s0, bq = v[0] * s0 + v[1] * c0, cq = v[2] * c1 - v[3] * s1, dq = v[2] * s1 + v[3] * c1; v[0] = a; v[1] = bq; v[2] = cq; v[3] = dq; }
          if (n0 < 512) { bf16_t* o = (bf16_t*)(p.ws + OFF_R + R_QA) + (size_t)row * 512 + n0 + fr;
#pragma unroll
            for (int nf = 0; nf < 4; ++nf) o[16 * nf] = f2bf(v[nf] * SCALE_A); }
          else { bf16_t* o = (bf16_t*)(p.ws + OFF_R + R_KA) + (size_t)row * 128 + (n0 - 512) + fr;
#pragma unroll
            for (int nf = 0; nf < 4; ++nf) o[16 * nf] = f2bf(v[nf]); }
        } else if (n0 < 768) { bf16_t* o = (bf16_t*)(p.ws + OFF_R + R_VA) + (size_t)row * 128 + (n0 - 640) + fr;
#pragma unroll
          for (int nf = 0; nf < 4; ++nf) o[16 * nf] = f2bf(v[nf]);
        } else if (n0 < 1152) { bf16_t* o = (bf16_t*)(p.ws + OFF_R + R_CQ) + (size_t)row * QRK + (n0 - 768) + fr;
#pragma unroll
          for (int nf = 0; nf < 4; ++nf) o[16 * nf] = f2bf(v[nf]);
        } else if (n0 < 1408) { bf16_t* o = (bf16_t*)(p.ws + OFF_R + R_CKV) + (size_t)row * KVRK + (n0 - 1152) + fr;
#pragma unroll
          for (int nf = 0; nf < 4; ++nf) o[16 * nf] = f2bf(v[nf]);
        } else {
          const float pr0 = __shfl_xor(v[0], 8), pr1 = __shfl_xor(v[1], 8);
          if (lat) { const int f = fr & 7; const float c0 = RT[4096 + rp * 8 + f], s0 = RT[5120 + rp * 8 + f], c1 = RT[4096 + cp * 8 + f], s1 = RT[5120 + cp * 8 + f];
            v[0] = fr < 8 ? v[0] * c0 - pr0 * s0 : pr0 * s0 + v[0] * c0; v[1] = fr < 8 ? v[1] * c1 - pr1 * s1 : pr1 * s1 + v[1] * c1; }
          bf16_t* o = WSP(bf16_t, OFF_KR) + (size_t)row * 32 + fr; o[0] = f2bf(v[0]); o[16] = f2bf(v[1]);
        }
      }
  }
};
struct EpiQup {
  const Prm* pp;
  __device__ __forceinline__ void operator()(f32x4 (&acc)[4][6], int m0, int n0, int fr, int fq) const {
    const Prm& p = *pp; const float* RT = WSP(float, OFF_ROPE); const float* ssq = WSP(float, OFF_SSQQ);
#pragma unroll
    for (int mf = 0; mf < 4; ++mf)
#pragma unroll
      for (int j = 0; j < 4; ++j) {
        const int row = m0 + 16 * mf + 4 * fq + j; bool lat; int rp, cp; rope_pos(row, lat, rp, cp);
        const float rs = rsqrtf(ssq[row] * (1.f / QRK) + EPS) * SCALE_B;
        float v[6];
#pragma unroll
        for (int nf = 0; nf < 6; ++nf) v[nf] = acc[mf][nf][j] * rs;
        const float pr0 = __shfl_xor(v[4], 8), pr1 = __shfl_xor(v[5], 8);
        if (lat) { const int f = fr & 7; const float c0 = RT[4096 + rp * 8 + f], s0 = RT[5120 + rp * 8 + f], c1 = RT[4096 + cp * 8 + f], s1 = RT[5120 + cp * 8 + f];
          v[4] = fr < 8 ? v[4] * c0 - pr0 * s0 : pr0 * s0 + v[4] * c0; v[5] = fr < 8 ? v[5] * c1 - pr1 * s1 : pr1 * s1 + v[5] * c1; }
        bf16_t* o = (bf16_t*)(p.ws + OFF_R + R_QB) + (size_t)row * NQB + n0 + fr;
#pragma unroll
        for (int nf = 0; nf < 6; ++nf) o[16 * nf] = f2bf(v[nf]);
      }
  }
};
struct EpiKVup {
  const Prm* pp;
  __device__ __forceinline__ void operator()(f32x4 (&acc)[4][4], int m0, int n0, int fr, int fq) const {
    const Prm& p = *pp; const float* ssq = WSP(float, OFF_SSQK);
    const int hd = n0 >> 7, part = (n0 >> 6) & 1;
    bf16_t* base = (bf16_t*)(p.ws + OFF_R + (part ? R_VB : R_KB));
#pragma unroll
    for (int mf = 0; mf < 4; ++mf)
#pragma unroll
      for (int j = 0; j < 4; ++j) {
        const int row = m0 + 16 * mf + 4 * fq + j; const float rs = rsqrtf(ssq[row] * (1.f / KVRK) + EPS);
        bf16_t* o = base + (size_t)row * 512 + hd * 64 + fr;
#pragma unroll
        for (int nf = 0; nf < 4; ++nf) o[16 * nf] = f2bf(acc[mf][nf][j] * rs);
      }
  }
};
struct EpiOut {
  const Prm* pp; int l;
  __device__ __forceinline__ void operator()(f32x4 (&acc)[4][4], int m0, int n0, int fr, int fq) const {
    const Prm& p = *pp; const float* MOD = WSP(float, OFF_MOD);
#pragma unroll
    for (int mf = 0; mf < 4; ++mf)
#pragma unroll
      for (int j = 0; j < 4; ++j) {
        const int row = m0 + 16 * mf + 4 * fq + j; const float* ga = MOD + (size_t)(l * 5 + row_mi(row)) * 6144 + 2 * 1024 + n0 + fr;
        float* X = WSP(float, OFF_X) + (size_t)row * DM + n0 + fr;
#pragma unroll
        for (int nf = 0; nf < 4; ++nf) X[16 * nf] += ga[16 * nf] * acc[mf][nf][j];
      }
  }
};
struct EpiMoeUp {
  const Prm* pp;
  __device__ __forceinline__ void operator()(f32x4 (&acc)[4][4], int m0, int n0, int fr, int fq) const {
    const Prm& p = *pp; const int j0 = n0 >> 1;
#pragma unroll
    for (int mf = 0; mf < 4; ++mf)
#pragma unroll
      for (int j = 0; j < 4; ++j) {
        const int slot = m0 + 16 * mf + 4 * fq + j;
        bf16_t* o = (bf16_t*)(p.ws + OFF_R + R_ACT) + (size_t)slot * DFF + j0 + fr;
        o[0] = f2bf(silu_f(acc[mf][0][j]) * acc[mf][2][j]); o[16] = f2bf(silu_f(acc[mf][1][j]) * acc[mf][3][j]);
      }
  }
};
struct EpiMoeDown {
  const Prm* pp;
  __device__ __forceinline__ void operator()(f32x4 (&acc)[4][4], int m0, int n0, int fr, int fq) const {
    const Prm& p = *pp; const float* VAL = WSP(float, OFF_VAL);
#pragma unroll
    for (int mf = 0; mf < 4; ++mf)
#pragma unroll
      for (int j = 0; j < 4; ++j) {
        const int slot = m0 + 16 * mf + 4 * fq + j; const float vv = VAL[slot];
        bf16_t* o = (bf16_t*)(p.ws + OFF_R + R_Y) + (size_t)slot * DM + n0 + fr;
#pragma unroll
        for (int nf = 0; nf < 4; ++nf) o[16 * nf] = f2bf(acc[mf][nf][j] * vv);
      }
  }
};

__device__ __forceinline__ void ph_gemm_in(const Prm& p, int l, int bid, int nb) {
  const int wv = TIDX >> 6, wm = wv >> 1, wn = wv & 1;
  const bf16_t* Bt = (const bf16_t*)(p.ws + OFF_W + (size_t)l * SZ_WL);
  APDense ap{(const bf16_t*)(p.ws + OFF_R + R_H), DM}; EpiIn epi{&p};
  constexpr int NCT = NINP / 128;
  for (int it = bid; it < (MR / 256) * NCT; it += nb) { const int rt = it / NCT, ct = it % NCT;
    sgemm_wave<4>(ap, Bt, DM, rt * 256 + wm * 64, ct * 128 + wn * 64, epi); }
}
__device__ __forceinline__ void ph_ssq(const Prm& p, int bid, int nb) {
  const int lane = TIDX & 63, wv = TIDX >> 6;
  for (int r = bid * NWAVE + wv; r < MR; r += nb * NWAVE) {
    const bf16_t* cq = (const bf16_t*)(p.ws + OFF_R + R_CQ) + (size_t)r * QRK; const bf16_t* ck = (const bf16_t*)(p.ws + OFF_R + R_CKV) + (size_t)r * KVRK;
    float s = 0.f; for (int i = lane; i < QRK; i += 64) { const float v = bf2f(cq[i]); s += v * v; }
    float s2 = 0.f; for (int i = lane; i < KVRK; i += 64) { const float v = bf2f(ck[i]); s2 += v * v; }
    s = wave_sum(s); s2 = wave_sum(s2);
    if (lane == 0) { WSP(float, OFF_SSQQ)[r] = s; WSP(float, OFF_SSQK)[r] = s2; }
  }
}
__device__ __forceinline__ void ph_gemm_up(const Prm& p, int l, int bid, int nb) {
  const int wv = TIDX >> 6, wm = wv >> 1, wn = wv & 1;
  const bf16_t* WQ = (const bf16_t*)(p.ws + OFF_W + (size_t)l * SZ_WL + SZ_WIN);
  const bf16_t* WKV = (const bf16_t*)(p.ws + OFF_W + (size_t)l * SZ_WL + SZ_WIN + SZ_WQ);
  constexpr int IQ = (MR / 256) * 4, IKV = (MR / 256) * 8;
  for (int it = bid; it < IQ + IKV; it += nb) {
    if (it < IQ) { const int rt = it / 4, ct = it % 4; APDense ap{(const bf16_t*)(p.ws + OFF_R + R_CQ), QRK}; EpiQup epi{&p};
      sgemm_wave<6>(ap, WQ, QRK, rt * 256 + wm * 64, ct * 192 + wn * 96, epi); }
    else { const int i2 = it - IQ, rt = i2 / 8, ct = i2 % 8; APDense ap{(const bf16_t*)(p.ws + OFF_R + R_CKV), KVRK}; EpiKVup epi{&p};
      sgemm_wave<4>(ap, WKV, KVRK, rt * 256 + wm * 64, ct * 128 + wn * 64, epi); }
  }
}
__device__ __forceinline__ void ph_gemm_out(const Prm& p, int l, int bid, int nb) {
  const int wv = TIDX >> 6, wm = wv >> 1, wn = wv & 1;
  const bf16_t* Bt = (const bf16_t*)(p.ws + OFF_W + (size_t)l * SZ_WL + SZ_WIN + SZ_WQ + SZ_WKV);
  APDense ap{(const bf16_t*)(p.ws + OFF_R + R_H), DM}; EpiOut epi{&p, l};
  for (int it = bid; it < (MR / 256) * 8; it += nb) { const int rt = it / 8, ct = it % 8;
    sgemm_wave<4>(ap, Bt, DM, rt * 256 + wm * 64, ct * 128 + wn * 64, epi); }
}
__device__ __forceinline__ void ph_moe_up(const Prm& p, int l, int bid, int nb) {
  const int wv = TIDX >> 6, wm = wv >> 1, wn = wv & 1;
  const int nrt = (l == DEPTH - 1) ? 256 : 272;
  APGather ap{(const bf16_t*)(p.ws + OFF_R + R_H), WSP(int, OFF_IDX)}; EpiMoeUp epi{&p};
  for (int it = bid; it < nrt * 8; it += nb) { const int rt = it / 8, ct = it % 8; const int e = rt < 256 ? ((rt >> 2) & 15) : rt - 256;
    sgemm_wave<4>(ap, WSP(bf16_t, OFF_WGU) + (size_t)e * 1024 * 1024, DM, rt * 256 + wm * 64, ct * 128 + wn * 64, epi); }
}
__device__ __forceinline__ void ph_moe_down(const Prm& p, int l, int bid, int nb) {
  const int wv = TIDX >> 6, wm = wv >> 1, wn = wv & 1;
  const int nrt = (l == DEPTH - 1) ? 256 : 272;
  APDense ap{(const bf16_t*)(p.ws + OFF_R + R_ACT), DFF}; EpiMoeDown epi{&p};
  for (int it = bid; it < nrt * 8; it += nb) { const int rt = it / 8, ct = it % 8; const int e = rt < 256 ? ((rt >> 2) & 15) : rt - 256;
    sgemm_wave<4>(ap, WSP(bf16_t, OFF_WD) + (size_t)e * 1024 * 512, DFF, rt * 256 + wm * 64, ct * 128 + wn * 64, epi); }
}

namespace pg8 {
#define PG8_LAS __attribute__((address_space(3)))
constexpr int BM = 256, BK = 64, HALF = 128, HTB = HALF * BK * 2, STAGE_BYTES = 8 * HTB;
__device__ __forceinline__ int lds_byte(int r, int c) { const int st = (r >> 4) * 2 + (c >> 5), rr = r & 15, cc = c & 31, ob = rr * 64 + cc * 2; return st * 1024 + (ob ^ (((ob >> 9) & 1) << 5)); }
__device__ __forceinline__ void stage_rc(int b, int& R, int& C) { const int st = b / 1024, sb = b % 1024, swz = sb ^ (((sb >> 9) & 1) << 5); R = (st >> 1) * 16 + swz / 64; C = (st & 1) * 32 + (swz % 64) / 2; }
struct Unit { int pm, pn; size_t boff; int r0; };
struct Gemm { const bf16_t* A; const bf16_t* Bt; int K; const int* idx; };
template <bool GATHER, bool HALFM = false, class Epi, class Sched>
__device__ __forceinline__ void gemm_phase(PG8_LAS unsigned char* lds, const Gemm g, const Sched& S, const Epi& E) {
    const int tid = TIDX, wid = __builtin_amdgcn_readfirstlane(tid >> 6), lane = tid & 63, wr = wid >> 2, wc = wid & 3, fr = lane & 15, fq = lane >> 4;
    const int K = g.K, nt = K / BK;
    int RA[2], CA[2]; unsigned voffB[2], voffA[2];
#pragma unroll
    for (int i = 0; i < 2; ++i) { int R, C; stage_rc(tid * 16 + i * 8192, R, C); RA[i] = R; CA[i] = C; voffA[i] = (unsigned)(R * K + C) * 2u; voffB[i] = voffA[i]; }
    const size_t kstep = (size_t)(BK * 2);
    const size_t hstep = (size_t)HALF * K * 2;
    const size_t tstep = 2 * hstep;
    const unsigned ldsw = (unsigned)wid * 1024u;
    const int aoff = lds_byte(wr * 64 + fr, fq * 8), boff = lds_byte(wc * 32 + fr, fq * 8);
#define PG8_SA(b, h) (((b) * 2 + (h)) * HTB)
#define PG8_SB(b, h) ((4 + (b) * 2 + (h)) * HTB)
#define PG8_STAGE(bufoff, gbase, voff) do { _Pragma("unroll") for (int _i = 0; _i < 2; ++_i) \
        __builtin_amdgcn_global_load_lds((const unsigned*)((const char*)(gbase) + (voff)[_i]), (PG8_LAS unsigned*)(lds + (bufoff) + ldsw + _i * 8192), 16, 0, 0); } while (0)
#define PG8_LDA(dst, b, h) do { _Pragma("unroll") for (int m = 0; m < 4; ++m) _Pragma("unroll") for (int k = 0; k < 2; ++k) dst[m][k] = *(const PG8_LAS bf16x8*)(lds + PG8_SA(b, h) + aoff + m * 2048 + k * 1024); } while (0)
#define PG8_LDB(dst, b, h) do { _Pragma("unroll") for (int n = 0; n < 2; ++n) _Pragma("unroll") for (int k = 0; k < 2; ++k) dst[n][k] = *(const PG8_LAS bf16x8*)(lds + PG8_SB(b, h) + boff + n * 2048 + k * 1024); } while (0)
#define PG8_MMA(ai, bj, At, Bt) do { __builtin_amdgcn_s_setprio(1); _Pragma("unroll") for (int m = 0; m < 4; ++m) _Pragma("unroll") for (int n = 0; n < 2; ++n) _Pragma("unroll") for (int k = 0; k < 2; ++k) \
        acc[ai][bj][m][n] = __builtin_amdgcn_mfma_f32_16x16x32_bf16(Bt[n][k], At[m][k], acc[ai][bj][m][n], 0, 0, 0); __builtin_amdgcn_s_setprio(0); } while (0)
#define PG8_WAIT_V(n) asm volatile("s_waitcnt vmcnt(" #n ")" ::: "memory")
#define PG8_WAIT_L(n) asm volatile("s_waitcnt lgkmcnt(" #n ")" ::: "memory")
#define PG8_BAR __builtin_amdgcn_s_barrier()
#define PG8_SCHED __builtin_amdgcn_sched_barrier(0)
    Unit cur, nxt; int ui = 0;
    if (!S.next(0, cur)) return;
    typename Epi::Ctx ectx; if constexpr (Epi::EARLY) E.begin(ectx, cur, wr, wc, fr, fq);
    f32x4 acc[2][2][4][2];
#pragma unroll
    for (int a = 0; a < 2; ++a)
#pragma unroll
        for (int b = 0; b < 2; ++b)
#pragma unroll
            for (int m = 0; m < 4; ++m)
#pragma unroll
                for (int n = 0; n < 2; ++n) acc[a][b][m][n] = (f32x4){0.f, 0.f, 0.f, 0.f};
    bf16x8 At[4][2], B0[2][2], B1[2][2];
    unsigned oc0[2], oc1[2], on0[2], on1[2];
    auto set_off = [&](const Unit& u, unsigned (&o0)[2], unsigned (&o1)[2]) {
        if constexpr (GATHER) {
#pragma unroll
            for (int i = 0; i < 2; ++i) { const int r0 = g.idx[u.r0 + RA[i]], r1 = g.idx[u.r0 + HALF + RA[i]]; o0[i] = (unsigned)(r0 * K + CA[i]) * 2u; o1[i] = (unsigned)(r1 * K + CA[i]) * 2u; }
        } else {
#pragma unroll
            for (int i = 0; i < 2; ++i) { o0[i] = voffA[i]; o1[i] = voffA[i] + (unsigned)hstep; }
        }
    };
    auto a_base = [&](const Unit& u) -> const char* { if constexpr (GATHER) return (const char*)g.A; else return (const char*)g.A + (size_t)u.r0 * (size_t)(K * 2); };
    const char* cA = a_base(cur); const char* cB = (const char*)g.Bt + cur.boff + (size_t)cur.pn * tstep;
    set_off(cur, oc0, oc1);
    PG8_STAGE(PG8_SB(0, 0), cB, voffB); PG8_STAGE(PG8_SB(0, 1), cB + hstep, voffB); PG8_STAGE(PG8_SA(0, 0), cA, oc0); PG8_STAGE(PG8_SA(0, 1), cA, oc1);
    if (wr == 1) PG8_BAR;
    PG8_WAIT_V(2); PG8_BAR;
    PG8_STAGE(PG8_SB(1, 0), cB + kstep, voffB); PG8_STAGE(PG8_SA(1, 0), cA + kstep, oc0); PG8_STAGE(PG8_SB(1, 1), cB + hstep + kstep, voffB);
    PG8_WAIT_V(6); PG8_BAR;
    for (;;) {
        const bool has_next = S.next(ui + 1, nxt);
        const char* nA = has_next ? a_base(nxt) : cA; const char* nB = has_next ? (const char*)g.Bt + nxt.boff + (size_t)nxt.pn * tstep : cB;
        if (has_next) set_off(nxt, on0, on1); else {
#pragma unroll
            for (int i = 0; i < 2; ++i) { on0[i] = oc0[i]; on1[i] = oc1[i]; } }
#pragma unroll 1
        for (int t = 0; t < nt; t += 2) {
            const bool last = (t == nt - 2);
            const char* a1 = cA + (size_t)(t + 1) * kstep;
            const char* a2 = last ? nA : cA + (size_t)(t + 2) * kstep; const char* b2 = last ? nB : cB + (size_t)(t + 2) * kstep;
            const char* a3 = a2 + kstep; const char* b3 = b2 + kstep;
            unsigned o20[2], o21[2];
#pragma unroll
            for (int i = 0; i < 2; ++i) { o20[i] = last ? on0[i] : oc0[i]; o21[i] = last ? on1[i] : oc1[i]; }
            PG8_LDB(B0, 0, 0); PG8_LDB(B1, 0, 1); PG8_SCHED; PG8_LDA(At, 0, 0); PG8_STAGE(PG8_SA(1, 1), a1, oc1);
            PG8_WAIT_V(8); PG8_WAIT_L(0); PG8_BAR; PG8_MMA(0, 0, At, B0); PG8_MMA(0, 1, At, B1); PG8_BAR; PG8_SCHED;
            if constexpr (!HALFM) { PG8_LDA(At, 0, 1); } PG8_STAGE(PG8_SB(0, 0), b2, voffB); PG8_STAGE(PG8_SB(0, 1), b2 + hstep, voffB); PG8_STAGE(PG8_SA(0, 0), a2, o20);
            PG8_WAIT_V(8); PG8_WAIT_L(0); PG8_BAR; if constexpr (!HALFM) { PG8_MMA(1, 0, At, B0); PG8_MMA(1, 1, At, B1); } PG8_BAR; PG8_SCHED;
            PG8_LDB(B0, 1, 0); PG8_LDB(B1, 1, 1); PG8_SCHED; PG8_LDA(At, 1, 0); PG8_STAGE(PG8_SA(0, 1), a2, o21);
            PG8_WAIT_V(8); PG8_WAIT_L(0); PG8_BAR; PG8_MMA(0, 0, At, B0); PG8_MMA(0, 1, At, B1); PG8_BAR; PG8_SCHED;
            if constexpr (!HALFM) { PG8_LDA(At, 1, 1); } PG8_STAGE(PG8_SB(1, 0), b3, voffB); PG8_STAGE(PG8_SB(1, 1), b3 + hstep, voffB); PG8_STAGE(PG8_SA(1, 0), a3, o20);
            PG8_WAIT_V(8); PG8_WAIT_L(0); PG8_BAR; if constexpr (!HALFM) { PG8_MMA(1, 0, At, B0); PG8_MMA(1, 1, At, B1); } PG8_BAR; PG8_SCHED;
        }
        if (wr == 0) PG8_BAR;
        if constexpr (!Epi::EARLY) E.begin(ectx, cur, wr, wc, fr, fq);
        E.template run<HALFM>(ectx, acc, cur, wr, wc, fr, fq, lds, tid);
        if (!has_next) break;
#pragma unroll
        for (int a = 0; a < 2; ++a)
#pragma unroll
            for (int b = 0; b < 2; ++b)
#pragma unroll
                for (int m = 0; m < 4; ++m)
#pragma unroll
                    for (int n = 0; n < 2; ++n) acc[a][b][m][n] = (f32x4){0.f, 0.f, 0.f, 0.f};
        cur = nxt; cA = nA; cB = nB; ++ui;
        if constexpr (Epi::EARLY) E.begin(ectx, cur, wr, wc, fr, fq);
#pragma unroll
        for (int i = 0; i < 2; ++i) { oc0[i] = on0[i]; oc1[i] = on1[i]; }
        if (wr == 1) PG8_BAR;
    }
    PG8_WAIT_V(0);
    PG8_BAR;
#undef PG8_SA
#undef PG8_SB
#undef PG8_STAGE
#undef PG8_LDA
#undef PG8_LDB
#undef PG8_MMA
#undef PG8_WAIT_V
#undef PG8_WAIT_L
#undef PG8_BAR
#undef PG8_SCHED
}
}

__device__ __forceinline__ int vcu_of(int bid, int nb) { return (nb % 8 == 0) ? (bid % 8) * (nb / 8) + bid / 8 : bid; }
struct SchedDense { int nM, nN, G, c; bool rev; bool skipctx; int lim;
  __device__ __forceinline__ bool next(int i, pg8::Unit& u) const { const int L = i * G + (rev ? G - 1 - c : c); if (L >= lim) return false; int pm = L / nN; u.pn = L % nN;
    if (skipctx) pm = pm + pm / 32 + 1; u.pm = pm; u.r0 = pm * 256; u.boff = 0; return true; } };
struct SchedDenseTail { int nN, base, nh, c;
  __device__ __forceinline__ bool next(int i, pg8::Unit& u) const { if (i > 0 || c >= nh) return false; const int L = base + (c >> 1); u.pm = L / nN; u.pn = L % nN;
    u.r0 = u.pm * 256 + (c & 1) * 128; u.boff = 0; return true; } };
struct SchedMoe { int nrt, G, c; size_t estride;
  __device__ __forceinline__ bool next(int i, pg8::Unit& u) const { const int L = i * G + c; if (L >= nrt * 4) return false; u.pm = L >> 2; u.pn = L & 3; u.r0 = u.pm * 256;
    const int e = u.pm < 256 ? ((u.pm >> 2) & 15) : u.pm - 256; u.boff = (size_t)e * estride; return true; } };
struct SchedMoeTail { int c; size_t estride;
  __device__ __forceinline__ bool next(int i, pg8::Unit& u) const { if (i > 0 || (c & 15) >= 4 || (c >> 4) >= NE) return false; const int e = c >> 4; u.pm = 256 + e; u.pn = c & 15;
    u.r0 = u.pm * 256; u.boff = (size_t)e * estride; return true; } };

__device__ __forceinline__ f32x4 shfl32(f32x4 v) { f32x4 r;
#pragma unroll
  for (int i = 0; i < 4; ++i) { auto x = __builtin_amdgcn_permlane32_swap(__float_as_uint(v[i]), __float_as_uint(v[i]), false, false); r[i] = __uint_as_float((TIDX & 32) ? x[0] : x[1]); }
  return r; }
__device__ __forceinline__ void rope32_grp(f32x4& v0, f32x4& v1, const float* RT, int rp, int cp, int fq) {
  const f32x4 p0 = shfl32(v0), p1 = shfl32(v1); const int f = 4 * (fq & 1);
  const f32x4 c0 = *(const f32x4*)(RT + 4096 + rp * 8 + f), s0 = *(const f32x4*)(RT + 5120 + rp * 8 + f), c1 = *(const f32x4*)(RT + 4096 + cp * 8 + f), s1 = *(const f32x4*)(RT + 5120 + cp * 8 + f);
  if (fq < 2) { v0 = v0 * c0 - p0 * s0; v1 = v1 * c1 - p1 * s1; } else { v0 = p0 * s0 + v0 * c0; v1 = p1 * s1 + v1 * c1; }
}
constexpr int ROPE_TAB_OFF = 131072 + 16384 + 128;
constexpr int STG_OFF = 131072, STG_OFF2 = 3 * 16384  , STG_RS = 512;
#define WSE(T, off) ((T*)(ws + (off)))
template <bool HM, class Epi>
__device__ __forceinline__ void epi_staged(const Epi& E, const typename Epi::Ctx& ctx, f32x4 (&acc)[2][2][4][2], const pg8::Unit& u, int wr, int wc, int fr, int fq, PG8_LAS unsigned char* lds, int tid) {
  constexpr int NCH = Epi::NCOL / 8, NPASS = 32 * NCH / NTHR;
  const PG8_LAS float* rtab = (const PG8_LAS float*)(lds + ROPE_TAB_OFF);
  unsigned wofs[2][2], rofs[NPASS], gofs[NPASS], gld[NPASS]; bool gval[NPASS];
#pragma unroll
  for (int bj = 0; bj < 2; ++bj)
#pragma unroll
    for (int n = 0; n < 2; ++n) { const unsigned chunk = bj * 16 + wc * 4 + n * 2 + (fq >> 1); wofs[bj][n] = Epi::LEAN ? 0u : (unsigned)(wr * 16 + fr) * STG_RS + ((chunk ^ (unsigned)fr) << 4) + (fq & 1) * 8; }
#pragma unroll
  for (int ps = 0; ps < NPASS; ++ps) { const unsigned c = (unsigned)tid + NTHR * ps, rl = c / NCH, ch = c % NCH;
    rofs[ps] = rl * STG_RS + ((ch ^ (rl & 15u)) << 4);
    E.dst(u, (int)((rl >> 4) * 64 + (rl & 15u)), (int)(ch * 8), gofs[ps], gld[ps], gval[ps]); }
#pragma unroll
  for (int ai = 0; ai < (HM ? 1 : 2); ++ai)
#pragma unroll
    for (int m = 0; m < 4; ++m) {
      PG8_LAS unsigned char* stg = lds + ((m & 1) ? STG_OFF2 : STG_OFF);
      f32x4 v[2][2] = {{acc[ai][0][m][0], acc[ai][0][m][1]}, {acc[ai][1][m][0], acc[ai][1][m][1]}};
      E.pre(v, ai * 128 + m * 16, ai, m, ctx, u, wc, fr, fq, rtab);
#pragma unroll
      for (int bj = 0; bj < Epi::NCOL / 128; ++bj)
#pragma unroll
        for (int n = 0; n < 2; ++n) { u32x2 w; w.x = cvtpk_e(v[bj][n][0], v[bj][n][1]); w.y = cvtpk_e(v[bj][n][2], v[bj][n][3]);
          unsigned wo = wofs[bj][n];
          if (Epi::LEAN) { int frl = fr; asm volatile("" : "+v"(frl)); const unsigned chunk = bj * 16 + wc * 4 + n * 2 + (fq >> 1); wo = (unsigned)(wr * 16 + frl) * STG_RS + ((chunk ^ (unsigned)frl) << 4) + (fq & 1) * 8; }
          *(PG8_LAS u32x2*)(stg + wo) = w; }
      asm volatile("s_waitcnt lgkmcnt(0)" ::: "memory"); __builtin_amdgcn_s_barrier(); asm volatile("" ::: "memory");
#pragma unroll
      for (int ps = 0; ps < NPASS; ++ps) {
        const u32x4 val = *(const PG8_LAS u32x4*)(stg + rofs[ps]);
        unsigned go = gofs[ps]; asm volatile("" : "+v"(go));
        if (gval[ps]) __builtin_nontemporal_store(val, (u32x4*)(E.ws + (size_t)(go + (unsigned)(ai * 128 + m * 16) * gld[ps]))); }
    }
  asm volatile("s_waitcnt lgkmcnt(0)" ::: "memory"); __builtin_amdgcn_s_barrier(); asm volatile("" ::: "memory");
}
#define EPI_RUN   template <bool HM, class C> __device__ __forceinline__ void run(const C& ctx, f32x4 (&acc)[2][2][4][2], const pg8::Unit& u, int wr, int wc, int fr, int fq, PG8_LAS unsigned char* lds, int tid) const { epi_staged<HM>(*this, ctx, acc, u, wr, wc, fr, fq, lds, tid); }
__device__ __forceinline__ void rot4(f32x4& x1, f32x4& x2, int pos, const f32x4& w) {
  f32x4 c, sn;
#pragma unroll
  for (int j = 0; j < 4; ++j) { const float a = __builtin_amdgcn_fractf((float)pos * w[j]); c[j] = __builtin_amdgcn_cosf(a); sn[j] = __builtin_amdgcn_sinf(a); }
  const f32x4 a = x1 * c - x2 * sn, b = x1 * sn + x2 * c; x1 = a; x2 = b;
}
__device__ __forceinline__ f32x4 rope_w(int i0, float nf) { f32x4 w;
#pragma unroll
  for (int j = 0; j < 4; ++j) w[j] = exp2f(-(float)(i0 + j) * (13.287712379549449f / nf)) * 0.15915494309189535f;
  return w; }
__device__ __forceinline__ void rope32_hw(f32x4& v0, f32x4& v1, int rp, int cp, int fq, const f32x4& w32) {
  const f32x4 p0 = shfl32(v0), p1 = shfl32(v1);
  f32x4 c0, s0, c1, s1;
#pragma unroll
  for (int j = 0; j < 4; ++j) { const float a = __builtin_amdgcn_fractf((float)rp * w32[j]), bq = __builtin_amdgcn_fractf((float)cp * w32[j]);
    c0[j] = __builtin_amdgcn_cosf(a); s0[j] = __builtin_amdgcn_sinf(a); c1[j] = __builtin_amdgcn_cosf(bq); s1[j] = __builtin_amdgcn_sinf(bq); }
  if (fq < 2) { v0 = v0 * c0 - p0 * s0; v1 = v1 * c1 - p1 * s1; } else { v0 = p0 * s0 + v0 * c0; v1 = p1 * s1 + v1 * c1; }
}
__device__ __forceinline__ void tile_pos(int pm, bool& lat, int& pos0) { const int tb = pm % 33; lat = tb != 0; pos0 = (tb - 1) * 256; }
struct Epi2In {
  static constexpr int NCOL = 256; static constexpr bool LEAN = true; static constexpr bool EARLY = false;
  EPI_RUN
  unsigned char* ws;
  struct Ctx { int pos0, rloc; bool lat; };
  __device__ __forceinline__ void begin(Ctx& c, const pg8::Unit& u, int wr, int wc, int fr, int fq) const {
    c.rloc = wr * 64 + fr; tile_pos(u.pm, c.lat, c.pos0); c.pos0 += c.rloc + (u.r0 - u.pm * 256); }
  __device__ __forceinline__ void dst(const pg8::Unit& u, int rsub, int col, unsigned& gofs, unsigned& gld, bool& gval) const {
    const int gc = u.pn * 256 + col; const unsigned row = (unsigned)(u.r0 + rsub);
    const unsigned ld = gc < 512 ? 512u : gc < 768 ? 128u : gc < 1152 ? (unsigned)QRK : gc < 1408 ? (unsigned)KVRK : 32u;
    const unsigned base = gc < 512 ? (unsigned)(OFF_R + R_QA) : gc < 640 ? (unsigned)(OFF_R + R_KA) : gc < 768 ? (unsigned)(OFF_R + R_VA) : gc < 1152 ? (unsigned)(OFF_R + R_CQ) : gc < 1408 ? (unsigned)(OFF_R + R_CKV) : (unsigned)OFF_KR;
    const unsigned c0 = gc < 512 ? 0u : gc < 640 ? 512u : gc < 768 ? 640u : gc < 1152 ? 768u : gc < 1408 ? 1152u : 1408u;
    gval = gc < 1440; gld = ld * 2; gofs = base + row * gld + ((unsigned)gc - c0) * 2;
  }
  __device__ __forceinline__ void pre(f32x4 (&v)[2][2], int rowstep, int ai, int m, const Ctx& c, const pg8::Unit& u, int wc, int fr, int fq, const PG8_LAS float* rtab) const {
    int pos = c.pos0 + rowstep; asm volatile("" : "+v"(pos));
    const int rp = pos >> 6, cp = pos & 63; const bool lat = c.lat;
#pragma unroll
    for (int bj = 0; bj < 2; ++bj) {
      const int cg = u.pn * 256 + bj * 128 + wc * 32, g32 = cg >> 5;
      f32x4& v0 = v[bj][0]; f32x4& v1 = v[bj][1];
      if (g32 < 20) {
        if (lat) { const f32x4 w64 = *(const PG8_LAS f32x4*)(rtab + 4 * fq); rot4(v0, v1, (g32 & 1) ? cp : rp, w64); }
        if (g32 < 16) { v0 = v0 * SCALE_A; v1 = v1 * SCALE_A; }
      } else if (g32 >= 24 && g32 < 44) {
        float sq = v0[0] * v0[0] + v0[1] * v0[1] + v0[2] * v0[2] + v0[3] * v0[3] + v1[0] * v1[0] + v1[1] * v1[1] + v1[2] * v1[2] + v1[3] * v1[3];
        sq = sum16sw(sq); sq = sum32sw(sq);
        if (fq == 0) atomicAdd(WSE(float, g32 < 36 ? OFF_SSQQ : OFF_SSQK) + (u.r0 + rowstep + c.rloc), sq);
      } else if (g32 == 44) { if (lat) { const f32x4 w32 = *(const PG8_LAS f32x4*)(rtab + 16 + 4 * (fq & 1)); rope32_hw(v0, v1, rp, cp, fq, w32); } }
    }
  }
};
struct Epi2Qup {
  static constexpr int NCOL = 256; static constexpr bool LEAN = false; static constexpr bool EARLY = true;
  EPI_RUN
  unsigned char* ws;
  struct Ctx { float rs[2][4]; int pos0; bool lat; };
  __device__ __forceinline__ void begin(Ctx& c, const pg8::Unit& u, int wr, int wc, int fr, int fq) const {
    tile_pos(u.pm, c.lat, c.pos0); c.pos0 += wr * 64 + fr + (u.r0 - u.pm * 256);
#pragma unroll
    for (int ai = 0; ai < 2; ++ai)
#pragma unroll
      for (int m = 0; m < 4; ++m) c.rs[ai][m] = WSE(float, OFF_SSQQ)[u.r0 + ai * 128 + wr * 64 + m * 16 + fr];
#pragma unroll
    for (int ai = 0; ai < 2; ++ai)
#pragma unroll
      for (int m = 0; m < 4; ++m) c.rs[ai][m] = rsqrtf(c.rs[ai][m] * (1.f / QRK) + EPS) * SCALE_B; }
  __device__ __forceinline__ void dst(const pg8::Unit& u, int rsub, int col, unsigned& gofs, unsigned& gld, bool& gval) const {
    gld = NQB * 2; gofs = (unsigned)(OFF_R + R_QB) + (unsigned)(u.r0 + rsub) * gld + (u.pn * 256 + col) * 2; gval = true; }
  __device__ __forceinline__ void pre(f32x4 (&v)[2][2], int rowstep, int ai, int m, const Ctx& c, const pg8::Unit& u, int wc, int fr, int fq, const PG8_LAS float* rtab) const {
    int pos = c.pos0 + rowstep; asm volatile("" : "+v"(pos));
    const int rp = pos >> 6, cp = pos & 63; const float rs = c.rs[ai][m];
#pragma unroll
    for (int bj = 0; bj < 2; ++bj) { const int g32 = (u.pn * 256 + bj * 128 + wc * 32) >> 5;
      v[bj][0] = v[bj][0] * rs; v[bj][1] = v[bj][1] * rs;
      if ((g32 % 3) == 2) { if (c.lat) { const f32x4 w32 = *(const PG8_LAS f32x4*)(rtab + 16 + 4 * (fq & 1)); rope32_hw(v[bj][0], v[bj][1], rp, cp, fq, w32); } } }
  }
};
struct Epi2KV {
  static constexpr int NCOL = 256; static constexpr bool LEAN = false; static constexpr bool EARLY = true;
  EPI_RUN
  unsigned char* ws;
  struct Ctx { float rs[2][4]; };
  __device__ __forceinline__ void begin(Ctx& c, const pg8::Unit& u, int wr, int wc, int fr, int fq) const {
#pragma unroll
    for (int ai = 0; ai < 2; ++ai)
#pragma unroll
      for (int m = 0; m < 4; ++m) c.rs[ai][m] = WSE(float, OFF_SSQK)[u.r0 + ai * 128 + wr * 64 + m * 16 + fr];
#pragma unroll
    for (int ai = 0; ai < 2; ++ai)
#pragma unroll
      for (int m = 0; m < 4; ++m) c.rs[ai][m] = rsqrtf(c.rs[ai][m] * (1.f / KVRK) + EPS); }
  __device__ __forceinline__ void dst(const pg8::Unit& u, int rsub, int col, unsigned& gofs, unsigned& gld, bool& gval) const {
    const int gc = u.pn * 256 + col, hd = gc >> 7, sub = (gc >> 6) & 1;
    gld = 512 * 2; gofs = (unsigned)(OFF_R + (sub ? R_VB : R_KB)) + (unsigned)(u.r0 + rsub) * gld + (hd * 64 + (gc & 63)) * 2; gval = true; }
  __device__ __forceinline__ void pre(f32x4 (&v)[2][2], int rowstep, int ai, int m, const Ctx& c, const pg8::Unit& u, int wc, int fr, int fq, const PG8_LAS float* rtab) const {
    const float rs = c.rs[ai][m];
#pragma unroll
    for (int bj = 0; bj < 2; ++bj) { v[bj][0] = v[bj][0] * rs; v[bj][1] = v[bj][1] * rs; }
  }
};
struct Epi2Out {
  static constexpr int NCOL = 256; static constexpr bool LEAN = false; static constexpr bool EARLY = false;
  EPI_RUN
  unsigned char* ws; int l;
  struct Ctx { f32x4 ga[2][2]; };
  __device__ __forceinline__ void begin(Ctx& c, const pg8::Unit& u, int wr, int wc, int fr, int fq) const {
    const float* ga = WSE(float, OFF_MOD) + (size_t)(l * 5 + row_mi(u.pm * 256)) * 6144 + 2 * 1024 + u.pn * 256 + wc * 32 + 4 * fq;
#pragma unroll
    for (int bj = 0; bj < 2; ++bj)
#pragma unroll
      for (int n = 0; n < 2; ++n) c.ga[bj][n] = *(const f32x4*)(ga + bj * 128 + n * 16); }
  __device__ __forceinline__ void dst(const pg8::Unit& u, int rsub, int col, unsigned& gofs, unsigned& gld, bool& gval) const {
    gld = DM * 2; gofs = (unsigned)(OFF_R + R_MIXG) + (unsigned)(u.r0 + rsub) * gld + (u.pn * 256 + col) * 2; gval = true; }
  __device__ __forceinline__ void pre(f32x4 (&v)[2][2], int rowstep, int ai, int m, const Ctx& c, const pg8::Unit& u, int wc, int fr, int fq, const PG8_LAS float* rtab) const {
#pragma unroll
    for (int bj = 0; bj < 2; ++bj)
#pragma unroll
      for (int n = 0; n < 2; ++n) v[bj][n] = v[bj][n] * c.ga[bj][n];
  }
};
struct Epi2MoeUp {
  static constexpr int NCOL = 128; static constexpr bool LEAN = false; static constexpr bool EARLY = false;
  EPI_RUN
  unsigned char* ws;
  struct Ctx { };
  __device__ __forceinline__ void begin(Ctx& c, const pg8::Unit& u, int wr, int wc, int fr, int fq) const { }
  __device__ __forceinline__ void dst(const pg8::Unit& u, int rsub, int col, unsigned& gofs, unsigned& gld, bool& gval) const {
    gld = DFF * 2; gofs = (unsigned)(OFF_R + R_ACT) + (unsigned)(u.r0 + rsub) * gld + (u.pn * 128 + col) * 2; gval = true; }
  __device__ __forceinline__ void pre(f32x4 (&v)[2][2], int rowstep, int ai, int m, const Ctx& c, const pg8::Unit& u, int wc, int fr, int fq, const PG8_LAS float* rtab) const {
#pragma unroll
    for (int n = 0; n < 2; ++n)
#pragma unroll
      for (int j = 0; j < 4; ++j) v[0][n][j] = silu_fast(v[0][n][j]) * v[1][n][j];
  }
};
struct Epi2MoeDown {
  static constexpr int NCOL = 256; static constexpr bool LEAN = false; static constexpr bool EARLY = true;
  EPI_RUN
  unsigned char* ws;
  struct Ctx { float vv[2][4]; };
  __device__ __forceinline__ void begin(Ctx& c, const pg8::Unit& u, int wr, int wc, int fr, int fq) const {
#pragma unroll
    for (int ai = 0; ai < 2; ++ai)
#pragma unroll
      for (int m = 0; m < 4; ++m) c.vv[ai][m] = WSE(float, OFF_VAL)[u.r0 + ai * 128 + wr * 64 + m * 16 + fr]; }
  __device__ __forceinline__ void dst(const pg8::Unit& u, int rsub, int col, unsigned& gofs, unsigned& gld, bool& gval) const {
    gld = DM * 2; gofs = (unsigned)(OFF_R + R_Y) + (unsigned)(u.r0 + rsub) * gld + (u.pn * 256 + col) * 2; gval = true; }
  __device__ __forceinline__ void pre(f32x4 (&v)[2][2], int rowstep, int ai, int m, const Ctx& c, const pg8::Unit& u, int wc, int fr, int fq, const PG8_LAS float* rtab) const {
    const float vv = c.vv[ai][m];
#pragma unroll
    for (int bj = 0; bj < 2; ++bj) { v[bj][0] = v[bj][0] * vv; v[bj][1] = v[bj][1] * vv; }
  }
};
#define LDS3 ((PG8_LAS unsigned char*)lds)
__device__ __forceinline__ void ph2_gemm_in(const Prm& p, int l, unsigned char* lds, int bid, int nb) {
  pg8::Gemm g{(const bf16_t*)(p.ws + OFF_R + R_H), (const bf16_t*)(p.ws + OFF_W + (size_t)l * SZ_WL), DM, nullptr};
  const int vcu = vcu_of(bid, nb);
  const int nun = (MR / 256) * (NINP / 256), extra = nun % nb;
  const bool halftail = extra > 0 && 2 * extra <= nb;
  SchedDense S{MR / 256, NINP / 256, nb, vcu, false, false, halftail ? nun - extra : nun}; Epi2In E{p.ws};
  pg8::gemm_phase<false>(LDS3, g, S, E);
  if (halftail) { SchedDenseTail T{NINP / 256, nun - extra, 2 * extra, vcu}; pg8::gemm_phase<false, true>(LDS3, g, T, E);
    if (vcu >= 2 * extra) ph_wconv_moe(p, l, lds, vcu - 2 * extra, nb - 2 * extra); }
  else if (extra == 0) ph_wconv_moe(p, l, lds, vcu, nb); else if (vcu >= extra) ph_wconv_moe(p, l, lds, vcu - extra, nb - extra);
}
__device__ __forceinline__ void ph2_gemm_qup(const Prm& p, int l, unsigned char* lds, int bid, int nb) {
  pg8::Gemm g{(const bf16_t*)(p.ws + OFF_R + R_CQ), (const bf16_t*)(p.ws + OFF_W + (size_t)l * SZ_WL + SZ_WIN), QRK, nullptr};
  const bool lastl = (l == DEPTH - 1); SchedDense S{lastl ? MR / 256 - NB : MR / 256, NQB / 256, nb, vcu_of(bid, nb), false, lastl, (lastl ? MR / 256 - NB : MR / 256) * (NQB / 256)}; Epi2Qup E{p.ws}; pg8::gemm_phase<false>(LDS3, g, S, E);
}
__device__ __forceinline__ void ph2_gemm_kvup(const Prm& p, int l, unsigned char* lds, int bid, int nb) {
  pg8::Gemm g{(const bf16_t*)(p.ws + OFF_R + R_CKV), (const bf16_t*)(p.ws + OFF_W + (size_t)l * SZ_WL + SZ_WIN + SZ_WQ), KVRK, nullptr};
  SchedDense S{MR / 256, NKVB / 256, nb, vcu_of(bid, nb), true, false, (MR / 256) * (NKVB / 256)}; Epi2KV E{p.ws}; pg8::gemm_phase<false>(LDS3, g, S, E);
}
__device__ __forceinline__ void ph2_gemm_out(const Prm& p, int l, unsigned char* lds, int bid, int nb) {
  pg8::Gemm g{(const bf16_t*)(p.ws + OFF_R + R_H), (const bf16_t*)(p.ws + OFF_W + (size_t)l * SZ_WL + SZ_WIN + SZ_WQ + SZ_WKV), DM, nullptr};
  const bool lastl = (l == DEPTH - 1); const int vcu = vcu_of(bid, nb);
  const int nun = (lastl ? MR / 256 - NB : MR / 256) * (DM / 256), extra = nun % nb;
  const bool halftail = !lastl && extra > 0 && 2 * extra <= nb;
  SchedDense S{lastl ? MR / 256 - NB : MR / 256, DM / 256, nb, vcu, false, lastl, halftail ? nun - extra : nun}; Epi2Out E{p.ws, l};
  pg8::gemm_phase<false>(LDS3, g, S, E);
  if (halftail) { SchedDenseTail T{DM / 256, nun - extra, 2 * extra, vcu}; pg8::gemm_phase<false, true>(LDS3, g, T, E); }
  if (l + 1 < DEPTH) {
    const int busy = halftail ? 2 * extra : extra;
    if (busy == 0) { ph_mod(p, l + 1, lds, vcu, nb); ph_wconv_dense(p, l + 1, lds, vcu, nb); }
    else if (vcu >= busy) { ph_mod(p, l + 1, lds, vcu - busy, nb - busy); ph_wconv_dense(p, l + 1, lds, vcu - busy, nb - busy); }
  }
}
__device__ __forceinline__ void ph2_moe_up(const Prm& p, int l, unsigned char* lds, int bid, int nb) {
  pg8::Gemm g{(const bf16_t*)(p.ws + OFF_R + R_H), WSP(bf16_t, OFF_WGU), DM, WSP(int, OFF_IDX)};
  const bool halftail = (l != DEPTH - 1) && nb >= 256;
  SchedMoe S{(l == DEPTH - 1 || halftail) ? 256 : 272, nb, vcu_of(bid, nb), (size_t)1024 * 1024 * 2}; Epi2MoeUp E{p.ws};
  pg8::gemm_phase<true>(LDS3, g, S, E);
  if (halftail) { SchedMoeTail T{vcu_of(bid, nb), (size_t)1024 * 1024 * 2}; pg8::gemm_phase<true, true>(LDS3, g, T, E); }
}
__device__ __forceinline__ void ph2_moe_down(const Prm& p, int l, unsigned char* lds, int bid, int nb) {
  pg8::Gemm g{(const bf16_t*)(p.ws + OFF_R + R_ACT), WSP(bf16_t, OFF_WD), DFF, nullptr};
  const bool halftail = (l != DEPTH - 1) && nb >= 256;
  SchedMoe S{(l == DEPTH - 1 || halftail) ? 256 : 272, nb, vcu_of(bid, nb), (size_t)1024 * 512 * 2}; Epi2MoeDown E{p.ws};
  pg8::gemm_phase<false>(LDS3, g, S, E);
  if (halftail) { SchedMoeTail T{vcu_of(bid, nb), (size_t)1024 * 512 * 2}; pg8::gemm_phase<false, true>(LDS3, g, T, E); }
}

template <int DQK>
__device__ __forceinline__ void attn_naive_unit(const Prm& p, int l, int kind, int b, int hd, int qblk, unsigned char* lds) {
  float* Ks = (float*)lds;
  float* Vs = Ks + 32 * DQK;
  const int tid = TIDX;
  const bool isB = (kind == 0 || kind == 2), isctx = kind >= 2;
  const int nq = isctx ? LC : SEQ; const int qi = qblk * NTHR + tid; const bool qvalid = qi < nq;
  const int qrow = b * TT + (isctx ? 0 : LC) + (qvalid ? qi : 0);
  float q[DQK];
  { const bf16_t* qp = isB ? (const bf16_t*)(p.ws + OFF_R + R_QB) + (size_t)qrow * NQB + hd * 96 : (const bf16_t*)(p.ws + OFF_R + R_QA) + (size_t)qrow * 512 + hd * 64;
#pragma unroll
    for (int d = 0; d < DQK; ++d) q[d] = bf2f(qp[d]); }
  float m = -1e30f, lsum = 0.f, o[64];
#pragma unroll
  for (int d = 0; d < 64; ++d) o[d] = 0.f;
  const int q0 = qblk * NTHR;
  int klo = 0, khi = LC;
  if (!isctx) { if (isB) khi = TT; else { klo = max(0, q0 - 128); khi = min(SEQ, q0 + NTHR + 128); } }
  const int kvh = hd >> 2;
  for (int seg = 0; seg < 2; ++seg) {
    int t0, t1; if (seg == 0) { t0 = 0; t1 = LC; } else { if (isctx) break; if (isB) { t0 = LC; t1 = TT; } else { t0 = LC + klo; t1 = LC + khi; } }
    for (int tb = t0; tb < t1; tb += 32) {
      __syncthreads();
      {
        for (int i = tid; i < 32 * DQK; i += NTHR) { const int kk = i / DQK, d = i % DQK; const size_t kr = (size_t)(b * TT + tb + kk);
          float v;
          if (isB) v = d < 64 ? bf2f(((const bf16_t*)(p.ws + OFF_R + R_KB))[kr * 512 + hd * 64 + d]) : bf2f(WSP(bf16_t, OFF_KR)[kr * 32 + d - 64]);
          else v = bf2f(((const bf16_t*)(p.ws + OFF_R + R_KA))[kr * 128 + kvh * 64 + d]);
          Ks[i] = v; }
        for (int i = tid; i < 32 * 64; i += NTHR) { const int kk = i >> 6, d = i & 63; const size_t kr = (size_t)(b * TT + tb + kk);
          Vs[i] = isB ? bf2f(((const bf16_t*)(p.ws + OFF_R + R_VB))[kr * 512 + hd * 64 + d]) : bf2f(((const bf16_t*)(p.ws + OFF_R + R_VA))[kr * 128 + kvh * 64 + d]); }
      }
      __syncthreads();
      if (qvalid) {
        for (int kk = 0; kk < 32; ++kk) {
          if (!isB && seg == 1) { const int ts = tb + kk - LC; const int dlt = qi - ts; if (dlt > 128 || dlt < -128) continue; }
          float s = 0.f;
#pragma unroll
          for (int d = 0; d < DQK; ++d) s += q[d] * Ks[kk * DQK + d];
          if (s > m) { const float al = exp2f(m - s); lsum *= al;
#pragma unroll
            for (int d = 0; d < 64; ++d) o[d] *= al;
            m = s; }
          const float pe = exp2f(s - m); lsum += pe;
#pragma unroll
          for (int d = 0; d < 64; ++d) o[d] += pe * Vs[kk * 64 + d];
        }
      }
    }
  }
  if (qvalid) {
    if (!isB) { const float sk = p.sink[l * 8 + hd] * LOG2E; if (sk > m) { const float al = exp2f(m - sk); lsum = lsum * al + 1.f;
#pragma unroll
        for (int d = 0; d < 64; ++d) o[d] *= al; } else lsum += exp2f(sk - m); }
    const float il = 1.f / lsum;
    bf16_t* op = (bf16_t*)(p.ws + OFF_R + R_H) + (size_t)qrow * DM + (isB ? 512 : 0) + hd * 64;
#pragma unroll
    for (int d = 0; d < 64; ++d) op[d] = f2bf(o[d] * il);
  }
}
__device__ __forceinline__ void ph_attn_naive(const Prm& p, int l, unsigned char* lds, int bid, int nb) {
  const int nun = 1024 + (l == DEPTH - 1 ? 0 : 64);
  for (int u = bid; u < nun; u += nb) {
    int kind, b, hd, qb;
    if (u < 1024) { kind = u & 1; int r = u >> 1; qb = r & 15; r >>= 4; hd = r & 7; b = r >> 3; }
    else { const int r = u - 1024; kind = 2 + (r & 1); hd = (r >> 1) & 7; b = r >> 4; qb = 0; }
    if (kind == 0 || kind == 2) attn_naive_unit<96>(p, l, kind, b, hd, qb, lds); else attn_naive_unit<64>(p, l, kind, b, hd, qb, lds);
    __syncthreads();
  }
}

#define SBAR() __builtin_amdgcn_sched_barrier(0)
typedef short s16x4 __attribute__((ext_vector_type(4)));
__device__ __forceinline__ int crow(int r, int hi) { return (r & 3) + 8 * (r >> 2) + 4 * hi; }
__device__ __forceinline__ unsigned cvtpk(float lo, float hi) { unsigned r; asm volatile("v_cvt_pk_bf16_f32 %0, %1, %2" : "=v"(r) : "v"(lo), "v"(hi)); return r; }
constexpr float ATHR = 8.f;
__device__ __forceinline__ void partialSM(f32x16& p0, f32x16& p1, float& m_reg, float& alpha) {
  float pmax = p0[0];
#pragma unroll
  for (int r = 1; r < 16; ++r) pmax = fmaxf(pmax, p0[r]);
#pragma unroll
  for (int r = 0; r < 16; ++r) pmax = fmaxf(pmax, p1[r]);
  { auto rr = __builtin_amdgcn_permlane32_swap(__float_as_uint(pmax), __float_as_uint(pmax), false, false); pmax = fmaxf(__uint_as_float(rr[0]), __uint_as_float(rr[1])); }
  float mn;
  if (__builtin_expect(__all(pmax - m_reg <= ATHR), 1)) { mn = m_reg; alpha = 1.f; }
  else { mn = fmaxf(m_reg, pmax); alpha = __builtin_amdgcn_exp2f(m_reg - mn); m_reg = mn; }
#pragma unroll
  for (int r = 0; r < 16; ++r) { p0[r] -= mn; p1[r] -= mn; }
#pragma unroll
  for (int r = 0; r < 16; ++r) p0[r] = __builtin_amdgcn_exp2f(p0[r]);
}
__device__ __forceinline__ void finishSM(f32x16& p0, f32x16& p1, float alpha, float& l_reg, bf16x8& pa0, bf16x8& pa1, bf16x8& pa2, bf16x8& pa3) {
#pragma unroll
  for (int r = 0; r < 16; ++r) p1[r] = __builtin_amdgcn_exp2f(p1[r]);
  float ps = 0.f;
#pragma unroll
  for (int r = 0; r < 16; ++r) ps += p0[r];
#pragma unroll
  for (int r = 0; r < 16; ++r) ps += p1[r];
  { auto rr = __builtin_amdgcn_permlane32_swap(__float_as_uint(ps), __float_as_uint(ps), false, false); ps = __uint_as_float(rr[0]) + __uint_as_float(rr[1]); }
  l_reg = l_reg * alpha + ps;
#define PK4(P, BASE, OUT) do { unsigned a0 = cvtpk(P[BASE + 0], P[BASE + 1]), a1 = cvtpk(P[BASE + 2], P[BASE + 3]);   \
    unsigned b0 = cvtpk(P[BASE + 4], P[BASE + 5]), b1 = cvtpk(P[BASE + 6], P[BASE + 7]);                              \
    auto r0 = __builtin_amdgcn_permlane32_swap(a0, b0, false, false); auto r1 = __builtin_amdgcn_permlane32_swap(a1, b1, false, false); \
    u32x4 w = {r0[0], r1[0], r0[1], r1[1]}; OUT = *reinterpret_cast<bf16x8*>(&w); } while (0)
  PK4(p0, 0, pa0); PK4(p0, 8, pa1); PK4(p1, 0, pa2); PK4(p1, 8, pa3);
#undef PK4
}
template <int DQK>
__device__ __forceinline__ void qkt(f32x16& p0, f32x16& p1, const char* Ks, const bf16x8* qr, int r32, int hi) {
  constexpr int KST = DQK * 2 + 16;
  p0 = f32x16{}; p1 = f32x16{};
#pragma unroll
  for (int d0 = 0; d0 < DQK / 16; ++d0) { const int cb = (d0 * 16 + hi * 8) * 2;
    const bf16x8 b0 = *reinterpret_cast<const bf16x8*>(Ks + r32 * KST + cb);
    const bf16x8 b1 = *reinterpret_cast<const bf16x8*>(Ks + (32 + r32) * KST + cb);
    p0 = __builtin_amdgcn_mfma_f32_32x32x16_bf16(b0, qr[d0], p0, 0, 0, 0);
    p1 = __builtin_amdgcn_mfma_f32_32x32x16_bf16(b1, qr[d0], p1, 0, 0, 0); }
}
__device__ __forceinline__ int v_st(int k, int c) { const int kk = (k & ~0xC) | ((k & 4) << 1) | ((k & 8) >> 1); return ((kk >> 3) * 2 + (c >> 5)) * 512 + ((kk & 7) * 32 + (c & 31)) * 2; }
__device__ __forceinline__ int v_rd_base(int lane) { return ((lane & 3) << 3) | (((lane >> 2) & 3) << 6) | (((lane >> 4) & 1) << 5) | (((lane >> 5) & 1) << 8); }
constexpr int v_rd_off(int d0, int ks, int half) { return d0 * 512 + ks * 2048 + half * 1024; }
template <int OFF> __device__ __forceinline__ s16x4 tr_read(int vb) { s16x4 r; asm volatile("ds_read_b64_tr_b16 %0, %1 offset:%2" : "=&v"(r) : "v"(vb), "i"(OFF) : "memory"); return r; }
template <int D0> __device__ __forceinline__ void pv_one(f32x16& od, int vb, bf16x8 pa0, bf16x8 pa1, bf16x8 pa2, bf16x8 pa3) {
  const s16x4 l0 = tr_read<v_rd_off(D0, 0, 0)>(vb), h0 = tr_read<v_rd_off(D0, 0, 1)>(vb), l1 = tr_read<v_rd_off(D0, 1, 0)>(vb), h1 = tr_read<v_rd_off(D0, 1, 1)>(vb);
  const s16x4 l2 = tr_read<v_rd_off(D0, 2, 0)>(vb), h2 = tr_read<v_rd_off(D0, 2, 1)>(vb), l3 = tr_read<v_rd_off(D0, 3, 0)>(vb), h3 = tr_read<v_rd_off(D0, 3, 1)>(vb);
  asm volatile("s_waitcnt lgkmcnt(0)" ::: "memory"); SBAR();
#define PK(L, H) (bf16x8){L[0], L[1], L[2], L[3], H[0], H[1], H[2], H[3]}
  od = __builtin_amdgcn_mfma_f32_32x32x16_bf16(pa0, PK(l0, h0), od, 0, 0, 0);
  od = __builtin_amdgcn_mfma_f32_32x32x16_bf16(pa1, PK(l1, h1), od, 0, 0, 0);
  od = __builtin_amdgcn_mfma_f32_32x32x16_bf16(pa2, PK(l2, h2), od, 0, 0, 0);
  od = __builtin_amdgcn_mfma_f32_32x32x16_bf16(pa3, PK(l3, h3), od, 0, 0, 0);
#undef PK
}
__device__ __forceinline__ void pv_all(f32x16* o, int vb, bf16x8 pa0, bf16x8 pa1, bf16x8 pa2, bf16x8 pa3) { pv_one<0>(o[0], vb, pa0, pa1, pa2, pa3); pv_one<1>(o[1], vb, pa0, pa1, pa2, pa3); }

template <int KIND>
__device__ __forceinline__ void attn_fast_unit(const Prm& p, int l, bool isctx, int b, int hd, int qb, unsigned char* ldsu) {
  constexpr int DQK = KIND == 0 ? 96 : 64, KST = DQK * 2 + 16, SHM_K = 64 * KST, SHM_V = 8192, LPT = KIND == 0 ? 3 : 2;
  char* lds = (char*)ldsu;
  const int tid = TIDX, wid = tid >> 6, lane = tid & 63, r32 = lane & 31, hi = lane >> 5;
  char* V_lds = lds; char* K_lds = lds + 2 * SHM_V;
  float* ws = (float*)(lds + 2 * SHM_V + 2 * SHM_K) + wid * 64; float* li_l = ws; float* al_l = ws + 32;
  const int q0 = qb * 256;
  const size_t rowq0 = (size_t)b * TT + (isctx ? 0 : LC) + q0;
  const bf16_t *Qp, *Kp, *Vp; const bf16_t* KRp = WSP(bf16_t, OFF_KR); int ldq, ldk; int ocol;
  if (KIND == 0) { Qp = (const bf16_t*)(p.ws + OFF_R + R_QB) + hd * 96; ldq = NQB; Kp = (const bf16_t*)(p.ws + OFF_R + R_KB) + hd * 64; Vp = (const bf16_t*)(p.ws + OFF_R + R_VB) + hd * 64; ldk = 512; ocol = 512 + hd * 64; }
  else { Qp = (const bf16_t*)(p.ws + OFF_R + R_QA) + hd * 64; ldq = 512; Kp = (const bf16_t*)(p.ws + OFF_R + R_KA) + (hd >> 2) * 64; Vp = (const bf16_t*)(p.ws + OFF_R + R_VA) + (hd >> 2) * 64; ldk = 128; ocol = hd * 64; }
  int NT, kshift = 0; bool domask = false;
  if (isctx) NT = 4; else if (KIND == 0) NT = TT / 64; else { const int ks = max(0, q0 - 128), ke = min(SEQ, q0 + 384); NT = 4 + (ke - ks) / 64; kshift = ks; domask = true; }
  const size_t kb0 = (size_t)b * TT;
  float m_reg = -1e30f, l_reg = 0.f; f32x16 o[2] = {}; bf16x8 qr[DQK / 16];
  { const bf16_t* Qw = Qp + (rowq0 + wid * 32 + r32) * ldq + hi * 8;
#pragma unroll
    for (int d0 = 0; d0 < DQK / 16; ++d0) qr[d0] = *reinterpret_cast<const bf16x8*>(Qw + d0 * 16); }
  const int sr = tid >> 3, sc = (tid & 7) * 8, vst = v_st(sr, sc), kst = sr * KST + sc * 2;
  const int rr_ = (tid & 255) >> 2, rc_ = (tid & 3) * 8, krst = rr_ * KST + 128 + rc_ * 2;
  const int vb0 = (int)(uintptr_t)V_lds + v_rd_base(lane);
  struct { bf16x8 v, k, kr; } st_[2];
#define KROW(j) (kb0 + (size_t)(j) * 64 + ((j) >= 4 ? kshift : 0))
#define SLOAD(i, j) do { const size_t kr0_ = KROW(j); st_[i].v = *reinterpret_cast<const bf16x8*>(Vp + (kr0_ + sr) * ldk + sc); st_[i].k = *reinterpret_cast<const bf16x8*>(Kp + (kr0_ + sr) * ldk + sc); \
    if (KIND == 0) st_[i].kr = *reinterpret_cast<const bf16x8*>(KRp + (kr0_ + rr_) * 32 + rc_); } while (0)
#define SWRITE(bf, i) do { *(bf16x8*)(V_lds + (bf) * SHM_V + vst) = st_[i].v; *(bf16x8*)(K_lds + (bf) * SHM_K + kst) = st_[i].k; \
    if (KIND == 0) { if (tid < 256) *(bf16x8*)(K_lds + (bf) * SHM_K + krst) = st_[i].kr; } } while (0)
#define SWAIT() do { if (LPT == 3) asm volatile("s_waitcnt vmcnt(3)" ::: "memory"); else asm volatile("s_waitcnt vmcnt(2)" ::: "memory"); } while (0)
#define RESC(a) do { if (__any((a) < 1.f)) { if (hi == 0) al_l[r32] = (a); asm volatile("s_waitcnt lgkmcnt(0)" ::: "memory"); \
    _Pragma("unroll") for (int d = 0; d < 2; ++d) _Pragma("unroll") for (int r = 0; r < 16; ++r) o[d][r] *= al_l[crow(r, hi)]; } } while (0)
#define AMASK(P0, P1, j) do { if (KIND == 1) { if (domask && (j) >= 4) { const int tq_ = q0 + wid * 32 + r32; const int tk_ = kshift + ((j) - 4) * 64 + 4 * hi; \
    _Pragma("unroll") for (int r = 0; r < 16; ++r) { const int d_ = tq_ - (tk_ + (r & 3) + 8 * (r >> 2)); if (d_ > 128 || d_ < -128) P0[r] = -INFINITY; if (d_ - 32 > 128 || d_ - 32 < -128) P1[r] = -INFINITY; } } } } while (0)
  f32x16 pA0, pA1, pB0, pB1; float alA, alB; bf16x8 pa0, pa1, pa2, pa3;
  SLOAD(0, 0); asm volatile("s_waitcnt vmcnt(0)" ::: "memory"); SWRITE(0, 0); __syncthreads();
  qkt<DQK>(pA0, pA1, K_lds, qr, r32, hi); AMASK(pA0, pA1, 0); partialSM(pA0, pA1, m_reg, alA);
  SLOAD(1, 1); if (2 < NT) SLOAD(0, 2);
  SWAIT(); SWRITE(1, 1); __syncthreads();
  for (int j = 1; j + 1 < NT; j += 2) {
    SBAR(); qkt<DQK>(pB0, pB1, K_lds + SHM_K, qr, r32, hi);
    finishSM(pA0, pA1, alA, l_reg, pa0, pa1, pa2, pa3); SBAR();
    SLOAD(1, j + 2); SBAR();
    pv_all(o, vb0, pa0, pa1, pa2, pa3); AMASK(pB0, pB1, j); partialSM(pB0, pB1, m_reg, alB);
    __syncthreads(); SWAIT(); SWRITE(0, 0);
    RESC(alB); __syncthreads();
    SBAR(); qkt<DQK>(pA0, pA1, K_lds, qr, r32, hi);
    finishSM(pB0, pB1, alB, l_reg, pa0, pa1, pa2, pa3); SBAR();
    if (j + 3 < NT) SLOAD(0, j + 3); SBAR();
    pv_all(o, vb0 + SHM_V, pa0, pa1, pa2, pa3); AMASK(pA0, pA1, j + 1); partialSM(pA0, pA1, m_reg, alA);
    __syncthreads(); SWAIT(); SWRITE(1, 1);
    RESC(alA); __syncthreads();
  }
  SBAR(); qkt<DQK>(pB0, pB1, K_lds + SHM_K, qr, r32, hi);
  finishSM(pA0, pA1, alA, l_reg, pa0, pa1, pa2, pa3); SBAR();
  pv_all(o, vb0, pa0, pa1, pa2, pa3); AMASK(pB0, pB1, NT - 1); partialSM(pB0, pB1, m_reg, alB);
  __syncthreads(); RESC(alB);
  finishSM(pB0, pB1, alB, l_reg, pa0, pa1, pa2, pa3); SBAR();
  pv_all(o, vb0 + SHM_V, pa0, pa1, pa2, pa3);
  if (KIND == 1) l_reg += __builtin_amdgcn_exp2f(p.sink[l * 8 + hd] * LOG2E - m_reg);
  if (hi == 0) li_l[r32] = l_reg; asm volatile("s_waitcnt lgkmcnt(0)" ::: "memory");
  float rli[16];
#pragma unroll
  for (int r = 0; r < 16; ++r) rli[r] = __builtin_amdgcn_rcpf(li_l[crow(r, hi)]);
  bf16_t* Ow = (bf16_t*)(p.ws + OFF_R + R_H) + (rowq0 + wid * 32) * DM + ocol;
#pragma unroll
  for (int r = 0; r < 16; ++r) { const int orow = crow(r, hi);
#pragma unroll
    for (int d0 = 0; d0 < 2; ++d0) Ow[(size_t)orow * DM + d0 * 32 + r32] = f2bf(o[d0][r] * rli[r]); }
  __syncthreads();
#undef KROW
#undef SLOAD
#undef SWRITE
#undef SWAIT
#undef RESC
#undef AMASK
}
__device__ __forceinline__ float max3f_(float a, float b, float c) { return fmaxf(fmaxf(a, b), c); }
template <bool FIRST>
__device__ __forceinline__ void psm2(f32x16& p0, f32x16& p1, float& mhat, f32x16& negm, float& alpha) {
  float a = max3f_(p0[0], p0[1], p1[0]), b = max3f_(p0[2], p0[3], p1[1]); a = max3f_(a, p1[2], p1[3]);
#pragma unroll
  for (int r = 4; r < 16; r += 4) { a = max3f_(a, p0[r], p0[r + 1]); b = max3f_(b, p0[r + 2], p0[r + 3]); a = max3f_(a, p1[r], p1[r + 1]); b = max3f_(b, p1[r + 2], p1[r + 3]); }
  float rm = fmaxf(a, b);
  { auto rr = __builtin_amdgcn_permlane32_swap(__float_as_uint(rm), __float_as_uint(rm), false, false); rm = fmaxf(__uint_as_float(rr[0]), __uint_as_float(rr[1])); }
  alpha = 1.f;
  if (FIRST || __builtin_expect(__any(rm > ATHR), 0)) {
    const float dl = FIRST ? rm : fmaxf(rm, 0.f);
    mhat += dl;
#pragma unroll
    for (int r = 0; r < 16; ++r) { p0[r] -= dl; p1[r] -= dl; }
    const float nm = -mhat;
#pragma unroll
    for (int r = 0; r < 16; ++r) negm[r] = nm;
    alpha = __builtin_amdgcn_exp2f(-dl);
  }
#pragma unroll
  for (int r = 0; r < 16; ++r) p0[r] = __builtin_amdgcn_exp2f(p0[r]);
}
template <bool FIRST>
__device__ __forceinline__ void psm2q(f32x16& p0, f32x16& p1, float& mhat, f32x16& negm, float& alpha, float& lsum) {
  float a = max3f_(p0[0], p0[1], p1[0]), b = max3f_(p0[2], p0[3], p1[1]); a = max3f_(a, p1[2], p1[3]);
#pragma unroll
  for (int r = 4; r < 16; r += 4) { a = max3f_(a, p0[r], p0[r + 1]); b = max3f_(b, p0[r + 2], p0[r + 3]); a = max3f_(a, p1[r], p1[r + 1]); b = max3f_(b, p1[r + 2], p1[r + 3]); }
  float rm = fmaxf(a, b);
  { auto rr = __builtin_amdgcn_permlane32_swap(__float_as_uint(rm), __float_as_uint(rm), false, false); rm = fmaxf(__uint_as_float(rr[0]), __uint_as_float(rr[1])); }
  alpha = 1.f;
  if (FIRST || __builtin_expect(__any(rm > ATHR), 0)) {
    const float dl = FIRST ? rm : fmaxf(rm, 0.f);
    mhat += dl;
#pragma unroll
    for (int r = 0; r < 16; ++r) { p0[r] -= dl; p1[r] -= dl; }
    const float nm = -mhat;
#pragma unroll
    for (int r = 0; r < 16; ++r) negm[r] = nm;
    alpha = __builtin_amdgcn_exp2f(-dl);
  }
  float s0 = 0.f, s1 = 0.f;
#pragma unroll
  for (int r = 0; r < 16; r += 2) { p0[r] = __builtin_amdgcn_exp2f(p0[r]); s0 += p0[r]; p0[r + 1] = __builtin_amdgcn_exp2f(p0[r + 1]); s1 += p0[r + 1]; }
  lsum = FIRST ? (s0 + s1) : lsum * alpha + (s0 + s1);
}
__device__ __forceinline__ void fsm2(f32x16& p0, f32x16& p1, bf16x8& pa0, bf16x8& pa1, bf16x8& pa2, bf16x8& pa3) {
#pragma unroll
  for (int r = 0; r < 16; ++r) p1[r] = __builtin_amdgcn_exp2f(p1[r]);
#define PK4(P, BASE, OUT) do { unsigned a0 = cvtpk(P[BASE + 0], P[BASE + 1]), a1 = cvtpk(P[BASE + 2], P[BASE + 3]);   \
    unsigned b0 = cvtpk(P[BASE + 4], P[BASE + 5]), b1 = cvtpk(P[BASE + 6], P[BASE + 7]);                              \
    auto r0 = __builtin_amdgcn_permlane32_swap(a0, b0, false, false); auto r1 = __builtin_amdgcn_permlane32_swap(a1, b1, false, false); \
    u32x4 w = {r0[0], r1[0], r0[1], r1[1]}; OUT = *reinterpret_cast<bf16x8*>(&w); } while (0)
  PK4(p0, 0, pa0); PK4(p0, 8, pa1); PK4(p1, 0, pa2); PK4(p1, 8, pa3);
#undef PK4
}
template <int DQK>
__device__ __forceinline__ void qkt2(f32x16& p0, f32x16& p1, const char* Ks, const bf16x8* qr, const f32x16& negm, int r32, int hi) {
  constexpr int KST = DQK * 2 + 16, ND = DQK / 16;
  bf16x8 kb0[ND], kb1[ND];
#pragma unroll
  for (int d0 = 0; d0 < ND; ++d0) { const int cb = (d0 * 16 + hi * 8) * 2;
    kb0[d0] = *reinterpret_cast<const bf16x8*>(Ks + r32 * KST + cb); kb1[d0] = *reinterpret_cast<const bf16x8*>(Ks + (32 + r32) * KST + cb); }
#pragma unroll
  for (int d0 = 0; d0 < ND; ++d0) {
    if (d0 == 0) { p0 = __builtin_amdgcn_mfma_f32_32x32x16_bf16(kb0[0], qr[0], negm, 0, 0, 0); p1 = __builtin_amdgcn_mfma_f32_32x32x16_bf16(kb1[0], qr[0], negm, 0, 0, 0); }
    else { p0 = __builtin_amdgcn_mfma_f32_32x32x16_bf16(kb0[d0], qr[d0], p0, 0, 0, 0); p1 = __builtin_amdgcn_mfma_f32_32x32x16_bf16(kb1[d0], qr[d0], p1, 0, 0, 0); } }
}
__device__ __forceinline__ void pv_all2(f32x16* o, int vb, bf16x8 pa0, bf16x8 pa1, bf16x8 pa2, bf16x8 pa3) {
  pv_one<0>(o[0], vb, pa0, pa1, pa2, pa3); pv_one<1>(o[1], vb, pa0, pa1, pa2, pa3);
  const bf16x8 ones = {16256, 16256, 16256, 16256, 16256, 16256, 16256, 16256};
  o[2] = __builtin_amdgcn_mfma_f32_32x32x16_bf16(pa0, ones, o[2], 0, 0, 0); o[2] = __builtin_amdgcn_mfma_f32_32x32x16_bf16(pa1, ones, o[2], 0, 0, 0);
  o[2] = __builtin_amdgcn_mfma_f32_32x32x16_bf16(pa2, ones, o[2], 0, 0, 0); o[2] = __builtin_amdgcn_mfma_f32_32x32x16_bf16(pa3, ones, o[2], 0, 0, 0);
}
template <int KIND>
__device__ __forceinline__ void attn_fast_unit2(const Prm& p, int l, bool isctx, int b, int hd, int qb, unsigned char* ldsu) {
  constexpr int DQK = KIND == 0 ? 96 : 64, KST = DQK * 2 + 16, SHM_K = 64 * KST, SHM_V = 8192, LPT = KIND == 0 ? 3 : 2;
  char* lds = (char*)ldsu;
  const int tid = TIDX, wid = tid >> 6, lane = tid & 63, r32 = lane & 31, hi = lane >> 5;
  char* V_lds = lds; char* K_lds = lds + 2 * SHM_V;
  float* ws = (float*)(lds + 2 * SHM_V + 2 * SHM_K) + wid * 64; float* li_l = ws; float* al_l = ws + 32;
  const int q0 = qb * 256;
  const size_t rowq0 = (size_t)b * TT + (isctx ? 0 : LC) + q0;
  const bf16_t *Qp, *Kp, *Vp; const bf16_t* KRp = WSP(bf16_t, OFF_KR); int ldq, ldk; int ocol;
  if (KIND == 0) { Qp = (const bf16_t*)(p.ws + OFF_R + R_QB) + hd * 96; ldq = NQB; Kp = (const bf16_t*)(p.ws + OFF_R + R_KB) + hd * 64; Vp = (const bf16_t*)(p.ws + OFF_R + R_VB) + hd * 64; ldk = 512; ocol = 512 + hd * 64; }
  else { Qp = (const bf16_t*)(p.ws + OFF_R + R_QA) + hd * 64; ldq = 512; Kp = (const bf16_t*)(p.ws + OFF_R + R_KA) + (hd >> 2) * 64; Vp = (const bf16_t*)(p.ws + OFF_R + R_VA) + (hd >> 2) * 64; ldk = 128; ocol = hd * 64; }
  int NT, kshift = 0; bool domask = false;
  if (isctx) NT = 4; else if (KIND == 0) NT = TT / 64; else { const int ks = max(0, q0 - 128), ke = min(SEQ, q0 + 384); NT = 4 + (ke - ks) / 64; kshift = ks; domask = true; }
  const size_t kb0 = (size_t)b * TT;
  float mhat = 0.f; f32x16 o[3] = {}; f32x16 negm = {}; bf16x8 qr[DQK / 16];
  { const bf16_t* Qw = Qp + (rowq0 + wid * 32 + r32) * ldq + hi * 8;
#pragma unroll
    for (int d0 = 0; d0 < DQK / 16; ++d0) qr[d0] = *reinterpret_cast<const bf16x8*>(Qw + d0 * 16); }
  const int sr = tid >> 3, sc = (tid & 7) * 8, vst = v_st(sr, sc), kst = sr * KST + sc * 2;
  const int rr_ = (tid & 255) >> 2, rc_ = (tid & 3) * 8, krst = rr_ * KST + 128 + rc_ * 2;
  const int vb0 = (int)(uintptr_t)V_lds + v_rd_base(lane);
  struct { bf16x8 v, k, kr; } st_[1];
#define KROW(j) (kb0 + (size_t)(j) * 64 + ((j) >= 4 ? kshift : 0))
  const unsigned voffs = (unsigned)(sr * ldk + sc) * 2u, kroffs = (unsigned)(rr_ * 32 + rc_) * 2u;
#define SLOAD(i, j) do { const size_t kr0_ = KROW(j); const char* vb_ = (const char*)(Vp + kr0_ * ldk); const char* kb_ = (const char*)(Kp + kr0_ * ldk); \
    st_[i].v = *reinterpret_cast<const bf16x8*>(vb_ + voffs); st_[i].k = *reinterpret_cast<const bf16x8*>(kb_ + voffs); \
    if (KIND == 0) { const char* rb_ = (const char*)(KRp + kr0_ * 32); st_[i].kr = *reinterpret_cast<const bf16x8*>(rb_ + kroffs); } } while (0)
#define SWRITE(bf, i) do { *(bf16x8*)(V_lds + (bf) * SHM_V + vst) = st_[i].v; *(bf16x8*)(K_lds + (bf) * SHM_K + kst) = st_[i].k; \
    if (KIND == 0) { if (tid < 256) *(bf16x8*)(K_lds + (bf) * SHM_K + krst) = st_[i].kr; } } while (0)
#define SWAIT() do { if (LPT == 3) asm volatile("s_waitcnt vmcnt(3)" ::: "memory"); else asm volatile("s_waitcnt vmcnt(2)" ::: "memory"); } while (0)
#define RESC(a) do { if (__any((a) < 1.f)) { if (hi == 0) al_l[r32] = (a); asm volatile("s_waitcnt lgkmcnt(0)" ::: "memory"); \
    _Pragma("unroll") for (int d = 0; d < 3; ++d) _Pragma("unroll") for (int r = 0; r < 16; ++r) o[d][r] *= al_l[crow(r, hi)]; } } while (0)
#define AMASK(P0, P1, j) do { if (KIND == 1) { if (domask && (j) >= 4) { const int tq_ = q0 + wid * 32 + r32; const int tk_ = kshift + ((j) - 4) * 64 + 4 * hi; \
    _Pragma("unroll") for (int r = 0; r < 16; ++r) { const int d_ = tq_ - (tk_ + (r & 3) + 8 * (r >> 2)); if (d_ > 128 || d_ < -128) P0[r] = -INFINITY; if (d_ - 32 > 128 || d_ - 32 < -128) P1[r] = -INFINITY; } } } } while (0)
  if (__builtin_amdgcn_readfirstlane(wid) >= 4) __builtin_amdgcn_s_setprio(1);
  f32x16 pA0, pA1, pB0, pB1; float alA, alB; bf16x8 pa0, pa1, pa2, pa3;
  const int wq0_ = q0 + __builtin_amdgcn_readfirstlane(wid) * 32;
#define TACT(j) (KIND != 1 || !domask || (j) < 4 || (kshift + ((j) - 4) * 64 + 63 >= wq0_ - 128 && kshift + ((j) - 4) * 64 <= wq0_ + 31 + 128))
  bool actA, actB;
  SLOAD(0, 0); asm volatile("s_waitcnt vmcnt(0)" ::: "memory"); SWRITE(0, 0); __syncthreads();
  actA = true; qkt2<DQK>(pA0, pA1, K_lds, qr, negm, r32, hi); AMASK(pA0, pA1, 0); psm2<true>(pA0, pA1, mhat, negm, alA);
  SLOAD(0, 1);
  SWRITE(1, 0); __syncthreads();
  for (int j = 1; j + 1 < NT; j += 2) {
    actB = TACT(j);
    SBAR(); if (actB) qkt2<DQK>(pB0, pB1, K_lds + SHM_K, qr, negm, r32, hi);
    if (actA) fsm2(pA0, pA1, pa0, pa1, pa2, pa3); SBAR();
    SLOAD(0, j + 1); SBAR();
    if (actA) pv_all2(o, vb0, pa0, pa1, pa2, pa3); if (actB) { AMASK(pB0, pB1, j); psm2<false>(pB0, pB1, mhat, negm, alB); } else alB = 1.f;
    __syncthreads(); SWRITE(0, 0);
    RESC(alB); __syncthreads();
    actA = TACT(j + 1);
    SBAR(); if (actA) qkt2<DQK>(pA0, pA1, K_lds, qr, negm, r32, hi);
    if (actB) fsm2(pB0, pB1, pa0, pa1, pa2, pa3); SBAR();
    SLOAD(0, j + 2); SBAR();
    if (actB) pv_all2(o, vb0 + SHM_V, pa0, pa1, pa2, pa3); if (actA) { AMASK(pA0, pA1, j + 1); psm2<false>(pA0, pA1, mhat, negm, alA); } else alA = 1.f;
    __syncthreads(); SWRITE(1, 0);
    RESC(alA); __syncthreads();
  }
  actB = TACT(NT - 1);
  SBAR(); if (actB) qkt2<DQK>(pB0, pB1, K_lds + SHM_K, qr, negm, r32, hi);
  if (actA) fsm2(pA0, pA1, pa0, pa1, pa2, pa3); SBAR();
  if (actA) pv_all2(o, vb0, pa0, pa1, pa2, pa3); if (actB) { AMASK(pB0, pB1, NT - 1); psm2<false>(pB0, pB1, mhat, negm, alB); } else alB = 1.f;
  __syncthreads(); RESC(alB);
  if (actB) { fsm2(pB0, pB1, pa0, pa1, pa2, pa3); SBAR();
    pv_all2(o, vb0 + SHM_V, pa0, pa1, pa2, pa3); }
  __builtin_amdgcn_s_setprio(0);
  float rli[16];
  if (KIND == 1) { if (hi == 0) li_l[r32] = mhat; asm volatile("s_waitcnt lgkmcnt(0)" ::: "memory"); const float sk2 = p.sink[l * 8 + hd] * LOG2E;
#pragma unroll
    for (int r = 0; r < 16; ++r) rli[r] = __builtin_amdgcn_rcpf(o[2][r] + __builtin_amdgcn_exp2f(sk2 - li_l[crow(r, hi)])); }
  else {
#pragma unroll
    for (int r = 0; r < 16; ++r) rli[r] = __builtin_amdgcn_rcpf(o[2][r]); }
  bf16_t* Ow = (bf16_t*)(p.ws + OFF_R + R_H) + (rowq0 + wid * 32) * DM + ocol;
#pragma unroll
  for (int r = 0; r < 16; ++r) { const int orow = crow(r, hi);
#pragma unroll
    for (int d0 = 0; d0 < 2; ++d0) Ow[(size_t)orow * DM + d0 * 32 + r32] = f2bf(o[d0][r] * rli[r]); }
  __syncthreads();
#undef KROW
#undef SLOAD
#undef SWRITE
#undef SWAIT
#undef RESC
#undef AMASK
#undef TACT
}
#ifdef DBG_ATTN_PROBE
template <int KIND, int VAR>
__device__ __forceinline__ void attn_probe_unit(const Prm& p, int l, bool isctx, int b, int hd, int qb, unsigned char* ldsu) {
  constexpr int DQK = KIND == 0 ? 96 : 64, KST = DQK * 2 + 16, SHM_K = 64 * KST, SHM_V = 8192, LPT = KIND == 0 ? 3 : 2;
  char* lds = (char*)ldsu;
  const int tid = TIDX, wid = tid >> 6, lane = tid & 63, r32 = lane & 31, hi = lane >> 5;
  char* V_lds = lds; char* K_lds = lds + 2 * SHM_V;
  float* ws = (float*)(lds + 2 * SHM_V + 2 * SHM_K) + wid * 64; float* li_l = ws; float* al_l = ws + 32;
  const int q0 = qb * 256;
  const size_t rowq0 = (size_t)b * TT + (isctx ? 0 : LC) + q0;
  const bf16_t *Qp, *Kp, *Vp; const bf16_t* KRp = WSP(bf16_t, OFF_KR); int ldq, ldk; int ocol;
  if (KIND == 0) { Qp = (const bf16_t*)(p.ws + OFF_R + R_QB) + hd * 96; ldq = NQB; Kp = (const bf16_t*)(p.ws + OFF_R + R_KB) + hd * 64; Vp = (const bf16_t*)(p.ws + OFF_R + R_VB) + hd * 64; ldk = 512; ocol = 512 + hd * 64; }
  else { Qp = (const bf16_t*)(p.ws + OFF_R + R_QA) + hd * 64; ldq = 512; Kp = (const bf16_t*)(p.ws + OFF_R + R_KA) + (hd >> 2) * 64; Vp = (const bf16_t*)(p.ws + OFF_R + R_VA) + (hd >> 2) * 64; ldk = 128; ocol = hd * 64; }
  int NT, kshift = 0; bool domask = false;
  if (isctx) NT = 4; else if (KIND == 0) NT = TT / 64; else { const int ks = max(0, q0 - 128), ke = min(SEQ, q0 + 384); NT = 4 + (ke - ks) / 64; kshift = ks; domask = true; }
  const size_t kb0 = (size_t)b * TT;
  float mhat = 0.f; f32x16 o[3] = {}; f32x16 negm = {}; bf16x8 qr[DQK / 16];
  { const bf16_t* Qw = Qp + (rowq0 + wid * 32 + r32) * ldq + hi * 8;
#pragma unroll
    for (int d0 = 0; d0 < DQK / 16; ++d0) qr[d0] = *reinterpret_cast<const bf16x8*>(Qw + d0 * 16); }
  const int sr = tid >> 3, sc = (tid & 7) * 8, vst = v_st(sr, sc), kst = sr * KST + sc * 2;
  const int rr_ = (tid & 255) >> 2, rc_ = (tid & 3) * 8, krst = rr_ * KST + 128 + rc_ * 2;
  const int vb0 = (int)(uintptr_t)V_lds + v_rd_base(lane);
  struct { bf16x8 v, k, kr; } st_[1];
#define KROW(j) (kb0 + (size_t)(j) * 64 + ((j) >= 4 ? kshift : 0))
#define SLOAD(i, j) do { if (VAR & 4) break; const size_t kr0_ = KROW(j); st_[i].v = *reinterpret_cast<const bf16x8*>(Vp + (kr0_ + sr) * ldk + sc); st_[i].k = *reinterpret_cast<const bf16x8*>(Kp + (kr0_ + sr) * ldk + sc); \
    if (KIND == 0) st_[i].kr = *reinterpret_cast<const bf16x8*>(KRp + (kr0_ + rr_) * 32 + rc_); } while (0)
#define SWRITE(bf, i) do { if (VAR & 4) break; *(bf16x8*)(V_lds + (bf) * SHM_V + vst) = st_[i].v; *(bf16x8*)(K_lds + (bf) * SHM_K + kst) = st_[i].k; \
    if (KIND == 0) { if (tid < 256) *(bf16x8*)(K_lds + (bf) * SHM_K + krst) = st_[i].kr; } } while (0)
#define SWAIT() do { if (LPT == 3) asm volatile("s_waitcnt vmcnt(3)" ::: "memory"); else asm volatile("s_waitcnt vmcnt(2)" ::: "memory"); } while (0)
#define RESC(a) do { if (__any((a) < 1.f)) { if (hi == 0) al_l[r32] = (a); asm volatile("s_waitcnt lgkmcnt(0)" ::: "memory"); \
    _Pragma("unroll") for (int d = 0; d < 3; ++d) _Pragma("unroll") for (int r = 0; r < 16; ++r) o[d][r] *= al_l[crow(r, hi)]; } } while (0)
#define AMASK(P0, P1, j) do { if (KIND == 1) { if (domask && (j) >= 4) { const int tq_ = q0 + wid * 32 + r32; const int tk_ = kshift + ((j) - 4) * 64 + 4 * hi; \
    _Pragma("unroll") for (int r = 0; r < 16; ++r) { const int d_ = tq_ - (tk_ + (r & 3) + 8 * (r >> 2)); if (d_ > 128 || d_ < -128) P0[r] = -INFINITY; if (d_ - 32 > 128 || d_ - 32 < -128) P1[r] = -INFINITY; } } } } while (0)
  f32x16 pA0, pA1, pB0, pB1; float alA, alB; bf16x8 pa0, pa1, pa2, pa3;
  const int wq0_ = q0 + __builtin_amdgcn_readfirstlane(wid) * 32;
#define TACT(j) (KIND != 1 || !domask || (j) < 4 || (kshift + ((j) - 4) * 64 + 63 >= wq0_ - 128 && kshift + ((j) - 4) * 64 <= wq0_ + 31 + 128))
  bool actA, actB;
  SLOAD(0, 0); asm volatile("s_waitcnt vmcnt(0)" ::: "memory"); SWRITE(0, 0); do { if (!(VAR & 1)) __syncthreads(); } while (0);
  do { if (!(VAR & 16)) qkt2<DQK>(pA0, pA1, K_lds, qr, negm, r32, hi); else { pA0 = negm; pA1 = negm; asm volatile("" : "+v"(pA0), "+v"(pA1)); } } while (0); AMASK(pA0, pA1, 0); do { if (!(VAR & 2)) psm2<true>(pA0, pA1, mhat, negm, alA); else alA = 1.f; } while (0);
  SLOAD(0, 1);
  SWRITE(1, 0); do { if (!(VAR & 1)) __syncthreads(); } while (0);
  for (int j = 1; j + 1 < NT; j += 2) {
    SBAR(); do { if (!(VAR & 16)) qkt2<DQK>(pB0, pB1, K_lds + SHM_K, qr, negm, r32, hi); else { pB0 = negm; pB1 = negm; asm volatile("" : "+v"(pB0), "+v"(pB1)); } } while (0);
    do { if (!(VAR & 2)) fsm2(pA0, pA1, pa0, pa1, pa2, pa3); else { pa0 = __builtin_bit_cast(bf16x8, (f32x4){pA0[0], pA0[1], pA0[2], pA0[3]}); pa1 = __builtin_bit_cast(bf16x8, (f32x4){pA0[4], pA0[5], pA0[6], pA0[7]}); pa2 = __builtin_bit_cast(bf16x8, (f32x4){pA1[0], pA1[1], pA1[2], pA1[3]}); pa3 = __builtin_bit_cast(bf16x8, (f32x4){pA1[4], pA1[5], pA1[6], pA1[7]}); } } while (0); SBAR();
    SLOAD(0, j + 1); SBAR();
    do { if (!(VAR & 8)) pv_all2(o, vb0, pa0, pa1, pa2, pa3); else { asm volatile("" :: "v"(pa0), "v"(pa1), "v"(pa2), "v"(pa3)); } } while (0); AMASK(pB0, pB1, j); do { if (!(VAR & 2)) psm2<false>(pB0, pB1, mhat, negm, alB); else alB = 1.f; } while (0);
    do { if (!(VAR & 1)) __syncthreads(); } while (0); SWRITE(0, 0);
    RESC(alB); do { if (!(VAR & 1)) __syncthreads(); } while (0);
    SBAR(); do { if (!(VAR & 16)) qkt2<DQK>(pA0, pA1, K_lds, qr, negm, r32, hi); else { pA0 = negm; pA1 = negm; asm volatile("" : "+v"(pA0), "+v"(pA1)); } } while (0);
    do { if (!(VAR & 2)) fsm2(pB0, pB1, pa0, pa1, pa2, pa3); else { pa0 = __builtin_bit_cast(bf16x8, (f32x4){pB0[0], pB0[1], pB0[2], pB0[3]}); pa1 = __builtin_bit_cast(bf16x8, (f32x4){pB0[4], pB0[5], pB0[6], pB0[7]}); pa2 = __builtin_bit_cast(bf16x8, (f32x4){pB1[0], pB1[1], pB1[2], pB1[3]}); pa3 = __builtin_bit_cast(bf16x8, (f32x4){pB1[4], pB1[5], pB1[6], pB1[7]}); } } while (0); SBAR();
    SLOAD(0, j + 2); SBAR();
    do { if (!(VAR & 8)) pv_all2(o, vb0 + SHM_V, pa0, pa1, pa2, pa3); else { asm volatile("" :: "v"(pa0), "v"(pa1), "v"(pa2), "v"(pa3)); } } while (0); AMASK(pA0, pA1, j + 1); do { if (!(VAR & 2)) psm2<false>(pA0, pA1, mhat, negm, alA); else alA = 1.f; } while (0);
    do { if (!(VAR & 1)) __syncthreads(); } while (0); SWRITE(1, 0);
    RESC(alA); do { if (!(VAR & 1)) __syncthreads(); } while (0);
  }
  SBAR(); do { if (!(VAR & 16)) qkt2<DQK>(pB0, pB1, K_lds + SHM_K, qr, negm, r32, hi); else { pB0 = negm; pB1 = negm; asm volatile("" : "+v"(pB0), "+v"(pB1)); } } while (0);
  do { if (!(VAR & 2)) fsm2(pA0, pA1, pa0, pa1, pa2, pa3); else { pa0 = __builtin_bit_cast(bf16x8, (f32x4){pA0[0], pA0[1], pA0[2], pA0[3]}); pa1 = __builtin_bit_cast(bf16x8, (f32x4){pA0[4], pA0[5], pA0[6], pA0[7]}); pa2 = __builtin_bit_cast(bf16x8, (f32x4){pA1[0], pA1[1], pA1[2], pA1[3]}); pa3 = __builtin_bit_cast(bf16x8, (f32x4){pA1[4], pA1[5], pA1[6], pA1[7]}); } } while (0); SBAR();
  do { if (!(VAR & 8)) pv_all2(o, vb0, pa0, pa1, pa2, pa3); else { asm volatile("" :: "v"(pa0), "v"(pa1), "v"(pa2), "v"(pa3)); } } while (0); AMASK(pB0, pB1, NT - 1); do { if (!(VAR & 2)) psm2<false>(pB0, pB1, mhat, negm, alB); else alB = 1.f; } while (0);
  do { if (!(VAR & 1)) __syncthreads(); } while (0); RESC(alB);
  do { if (!(VAR & 2)) fsm2(pB0, pB1, pa0, pa1, pa2, pa3); else { pa0 = __builtin_bit_cast(bf16x8, (f32x4){pB0[0], pB0[1], pB0[2], pB0[3]}); pa1 = __builtin_bit_cast(bf16x8, (f32x4){pB0[4], pB0[5], pB0[6], pB0[7]}); pa2 = __builtin_bit_cast(bf16x8, (f32x4){pB1[0], pB1[1], pB1[2], pB1[3]}); pa3 = __builtin_bit_cast(bf16x8, (f32x4){pB1[4], pB1[5], pB1[6], pB1[7]}); } } while (0); SBAR();
  do { if (!(VAR & 8)) pv_all2(o, vb0 + SHM_V, pa0, pa1, pa2, pa3); else { asm volatile("" :: "v"(pa0), "v"(pa1), "v"(pa2), "v"(pa3)); } } while (0);
  float rli[16];
  if (KIND == 1) { if (hi == 0) li_l[r32] = mhat; asm volatile("s_waitcnt lgkmcnt(0)" ::: "memory"); const float sk2 = p.sink[l * 8 + hd] * LOG2E;
#pragma unroll
    for (int r = 0; r < 16; ++r) rli[r] = __builtin_amdgcn_rcpf(o[2][r] + __builtin_amdgcn_exp2f(sk2 - li_l[crow(r, hi)])); }
  else {
#pragma unroll
    for (int r = 0; r < 16; ++r) rli[r] = __builtin_amdgcn_rcpf(o[2][r]); }
  bf16_t* Ow = (bf16_t*)(p.ws + OFF_R + R_CQ) + ((rowq0 + wid * 32) & 16383) * DM + ocol;
#pragma unroll
  for (int r = 0; r < 16; ++r) { const int orow = crow(r, hi);
#pragma unroll
    for (int d0 = 0; d0 < 2; ++d0) Ow[(size_t)orow * DM + d0 * 32 + r32] = f2bf(o[d0][r] * rli[r]); }
  do { if (!(VAR & 1)) __syncthreads(); } while (0);
#undef KROW
#undef SLOAD
#undef SWRITE
#undef SWAIT
#undef RESC
#undef AMASK
#undef TACT
}

template <int VAR>
__device__ __forceinline__ void ph_attn_probe(const Prm& p, int l, unsigned char* lds, int bid, int nb) {
  const int nrounds = (1024 + nb - 1) / nb;
  for (int rd = 0; rd < nrounds; ++rd) { const int pair = rd * 8 + (bid & 7), qb = bid >> 3, u = pair * 32 + qb;
    if (u < 1024) attn_probe_unit<0, VAR>(p, l, false, u >> 8, (u >> 5) & 7, u & 31, lds); }
}
#endif
__device__ __forceinline__ int v_st_p(int k, int c) { return (c >> 5) * 4096 + (k >> 4) * 1024 + (k & 15) * 64 + (c & 31) * 2; }
__device__ __forceinline__ int v_rd_base_p(int lane) { return ((lane >> 4) & 1) * 32 + (lane & 3) * 8 + (4 * (lane >> 5) + ((lane & 15) >> 2)) * 64; }
constexpr int v_rd_off_p(int d0, int ks, int half) { return d0 * 4096 + ks * 1024 + half * 512; }
template <int D0> __device__ __forceinline__ void pv_one_p(f32x16& od, int vb, bf16x8 pa0, bf16x8 pa1, bf16x8 pa2, bf16x8 pa3) {
  const s16x4 l0 = tr_read<v_rd_off_p(D0, 0, 0)>(vb), h0 = tr_read<v_rd_off_p(D0, 0, 1)>(vb), l1 = tr_read<v_rd_off_p(D0, 1, 0)>(vb), h1 = tr_read<v_rd_off_p(D0, 1, 1)>(vb);
  const s16x4 l2 = tr_read<v_rd_off_p(D0, 2, 0)>(vb), h2 = tr_read<v_rd_off_p(D0, 2, 1)>(vb), l3 = tr_read<v_rd_off_p(D0, 3, 0)>(vb), h3 = tr_read<v_rd_off_p(D0, 3, 1)>(vb);
  asm volatile("s_waitcnt lgkmcnt(0)" ::: "memory"); SBAR();
#define PK(L, H) (bf16x8){L[0], L[1], L[2], L[3], H[0], H[1], H[2], H[3]}
  od = __builtin_amdgcn_mfma_f32_32x32x16_bf16(pa0, PK(l0, h0), od, 0, 0, 0);
  od = __builtin_amdgcn_mfma_f32_32x32x16_bf16(pa1, PK(l1, h1), od, 0, 0, 0);
  od = __builtin_amdgcn_mfma_f32_32x32x16_bf16(pa2, PK(l2, h2), od, 0, 0, 0);
  od = __builtin_amdgcn_mfma_f32_32x32x16_bf16(pa3, PK(l3, h3), od, 0, 0, 0);
#undef PK
}
__device__ __forceinline__ void pv_all2p(f32x16* o, int vb, bf16x8 pa0, bf16x8 pa1, bf16x8 pa2, bf16x8 pa3) {
  const s16x4 a0 = tr_read<v_rd_off_p(0, 0, 0)>(vb), b0 = tr_read<v_rd_off_p(0, 0, 1)>(vb), a1 = tr_read<v_rd_off_p(0, 1, 0)>(vb), b1 = tr_read<v_rd_off_p(0, 1, 1)>(vb);
  const s16x4 a2 = tr_read<v_rd_off_p(0, 2, 0)>(vb), b2 = tr_read<v_rd_off_p(0, 2, 1)>(vb), a3 = tr_read<v_rd_off_p(0, 3, 0)>(vb), b3 = tr_read<v_rd_off_p(0, 3, 1)>(vb);
  const s16x4 c0 = tr_read<v_rd_off_p(1, 0, 0)>(vb), d0 = tr_read<v_rd_off_p(1, 0, 1)>(vb), c1 = tr_read<v_rd_off_p(1, 1, 0)>(vb), d1 = tr_read<v_rd_off_p(1, 1, 1)>(vb);
  const s16x4 c2 = tr_read<v_rd_off_p(1, 2, 0)>(vb), d2 = tr_read<v_rd_off_p(1, 2, 1)>(vb), c3 = tr_read<v_rd_off_p(1, 3, 0)>(vb), d3 = tr_read<v_rd_off_p(1, 3, 1)>(vb);
  asm volatile("s_waitcnt lgkmcnt(0)" ::: "memory"); SBAR();
#define PK(L, H) (bf16x8){L[0], L[1], L[2], L[3], H[0], H[1], H[2], H[3]}
  const bf16x8 ones = {16256, 16256, 16256, 16256, 16256, 16256, 16256, 16256};
  o[0] = __builtin_amdgcn_mfma_f32_32x32x16_bf16(pa0, PK(a0, b0), o[0], 0, 0, 0); o[1] = __builtin_amdgcn_mfma_f32_32x32x16_bf16(pa0, PK(c0, d0), o[1], 0, 0, 0); o[2] = __builtin_amdgcn_mfma_f32_32x32x16_bf16(pa0, ones, o[2], 0, 0, 0);
  o[0] = __builtin_amdgcn_mfma_f32_32x32x16_bf16(pa1, PK(a1, b1), o[0], 0, 0, 0); o[1] = __builtin_amdgcn_mfma_f32_32x32x16_bf16(pa1, PK(c1, d1), o[1], 0, 0, 0); o[2] = __builtin_amdgcn_mfma_f32_32x32x16_bf16(pa1, ones, o[2], 0, 0, 0);
  o[0] = __builtin_amdgcn_mfma_f32_32x32x16_bf16(pa2, PK(a2, b2), o[0], 0, 0, 0); o[1] = __builtin_amdgcn_mfma_f32_32x32x16_bf16(pa2, PK(c2, d2), o[1], 0, 0, 0); o[2] = __builtin_amdgcn_mfma_f32_32x32x16_bf16(pa2, ones, o[2], 0, 0, 0);
  o[0] = __builtin_amdgcn_mfma_f32_32x32x16_bf16(pa3, PK(a3, b3), o[0], 0, 0, 0); o[1] = __builtin_amdgcn_mfma_f32_32x32x16_bf16(pa3, PK(c3, d3), o[1], 0, 0, 0); o[2] = __builtin_amdgcn_mfma_f32_32x32x16_bf16(pa3, ones, o[2], 0, 0, 0);
#undef PK
}
__device__ __forceinline__ void fsm2p(f32x16& p0, f32x16& p1, bf16x8& pa0, bf16x8& pa1, bf16x8& pa2, bf16x8& pa3) {
#pragma unroll
  for (int r = 0; r < 16; ++r) p1[r] = __builtin_amdgcn_exp2f(p1[r]);
#define PK8(P, BASE, OUT) do { u32x4 w = {cvtpk(P[BASE + 0], P[BASE + 1]), cvtpk(P[BASE + 2], P[BASE + 3]), cvtpk(P[BASE + 4], P[BASE + 5]), cvtpk(P[BASE + 6], P[BASE + 7])}; OUT = *reinterpret_cast<bf16x8*>(&w); } while (0)
  PK8(p0, 0, pa0); PK8(p0, 8, pa1); PK8(p1, 0, pa2); PK8(p1, 8, pa3);
#undef PK8
}
__device__ __forceinline__ void pv_all2q(f32x16* o, int vb, bf16x8 pa0, bf16x8 pa1, bf16x8 pa2, bf16x8 pa3) {
  const s16x4 a0 = tr_read<v_rd_off_p(0, 0, 0)>(vb), b0 = tr_read<v_rd_off_p(0, 0, 1)>(vb), a1 = tr_read<v_rd_off_p(0, 1, 0)>(vb), b1 = tr_read<v_rd_off_p(0, 1, 1)>(vb);
  const s16x4 a2 = tr_read<v_rd_off_p(0, 2, 0)>(vb), b2 = tr_read<v_rd_off_p(0, 2, 1)>(vb), a3 = tr_read<v_rd_off_p(0, 3, 0)>(vb), b3 = tr_read<v_rd_off_p(0, 3, 1)>(vb);
  const s16x4 c0 = tr_read<v_rd_off_p(1, 0, 0)>(vb), d0 = tr_read<v_rd_off_p(1, 0, 1)>(vb), c1 = tr_read<v_rd_off_p(1, 1, 0)>(vb), d1 = tr_read<v_rd_off_p(1, 1, 1)>(vb);
  const s16x4 c2 = tr_read<v_rd_off_p(1, 2, 0)>(vb), d2 = tr_read<v_rd_off_p(1, 2, 1)>(vb), c3 = tr_read<v_rd_off_p(1, 3, 0)>(vb), d3 = tr_read<v_rd_off_p(1, 3, 1)>(vb);
  asm volatile("s_waitcnt lgkmcnt(0)" ::: "memory"); SBAR();
#define PK(L, H) (bf16x8){L[0], L[1], L[2], L[3], H[0], H[1], H[2], H[3]}
  o[0] = __builtin_amdgcn_mfma_f32_32x32x16_bf16(pa0, PK(a0, b0), o[0], 0, 0, 0); o[1] = __builtin_amdgcn_mfma_f32_32x32x16_bf16(pa0, PK(c0, d0), o[1], 0, 0, 0);
  o[0] = __builtin_amdgcn_mfma_f32_32x32x16_bf16(pa1, PK(a1, b1), o[0], 0, 0, 0); o[1] = __builtin_amdgcn_mfma_f32_32x32x16_bf16(pa1, PK(c1, d1), o[1], 0, 0, 0);
  o[0] = __builtin_amdgcn_mfma_f32_32x32x16_bf16(pa2, PK(a2, b2), o[0], 0, 0, 0); o[1] = __builtin_amdgcn_mfma_f32_32x32x16_bf16(pa2, PK(c2, d2), o[1], 0, 0, 0);
  o[0] = __builtin_amdgcn_mfma_f32_32x32x16_bf16(pa3, PK(a3, b3), o[0], 0, 0, 0); o[1] = __builtin_amdgcn_mfma_f32_32x32x16_bf16(pa3, PK(c3, d3), o[1], 0, 0, 0);
#undef PK
}
__device__ __forceinline__ void fsm2q(f32x16& p0, f32x16& p1, bf16x8& pa0, bf16x8& pa1, bf16x8& pa2, bf16x8& pa3, float& lsum) {
#pragma unroll
  for (int r = 0; r < 16; r += 2) { p1[r] = __builtin_amdgcn_exp2f(p1[r]); lsum += p1[r]; p1[r + 1] = __builtin_amdgcn_exp2f(p1[r + 1]); lsum += p1[r + 1]; }
#define PK8(P, BASE, OUT) do { u32x4 w = {cvtpk(P[BASE + 0], P[BASE + 1]), cvtpk(P[BASE + 2], P[BASE + 3]), cvtpk(P[BASE + 4], P[BASE + 5]), cvtpk(P[BASE + 6], P[BASE + 7])}; OUT = *reinterpret_cast<bf16x8*>(&w); } while (0)
  PK8(p0, 0, pa0); PK8(p0, 8, pa1); PK8(p1, 0, pa2); PK8(p1, 8, pa3);
#undef PK8
}
template <int KIND>
__device__ __forceinline__ void attn_fast_unit2p(const Prm& p, int l, bool isctx, int b, int hd, int qb, unsigned char* ldsu) {
  constexpr int DQK = KIND == 0 ? 96 : 64, KST = DQK * 2 + 16, SHM_K = 64 * KST, SHM_V = 8192, LPT = KIND == 0 ? 3 : 2;
  char* lds = (char*)ldsu;
  const int tid = TIDX, wid = tid >> 6, lane = tid & 63, r32 = lane & 31, hi = lane >> 5;
  char* V_lds = lds; char* K_lds = lds + 2 * SHM_V;
  float* ws = (float*)(lds + 2 * SHM_V + 2 * SHM_K) + wid * 64; float* li_l = ws; float* al_l = ws + 32;
  const int q0 = qb * 256;
  const size_t rowq0 = (size_t)b * TT + (isctx ? 0 : LC) + q0;
  const bf16_t *Qp, *Kp, *Vp; const bf16_t* KRp = WSP(bf16_t, OFF_KR); int ldq, ldk; int ocol;
  if (KIND == 0) { Qp = (const bf16_t*)(p.ws + OFF_R + R_QB) + hd * 96; ldq = NQB; Kp = (const bf16_t*)(p.ws + OFF_R + R_KB) + hd * 64; Vp = (const bf16_t*)(p.ws + OFF_R + R_VB) + hd * 64; ldk = 512; ocol = 512 + hd * 64; }
  else { Qp = (const bf16_t*)(p.ws + OFF_R + R_QA) + hd * 64; ldq = 512; Kp = (const bf16_t*)(p.ws + OFF_R + R_KA) + (hd >> 2) * 64; Vp = (const bf16_t*)(p.ws + OFF_R + R_VA) + (hd >> 2) * 64; ldk = 128; ocol = hd * 64; }
  int NT, kshift = 0; bool domask = false;
  if (isctx) NT = 4; else if (KIND == 0) NT = TT / 64; else { const int ks = max(0, q0 - 128), ke = min(SEQ, q0 + 384); NT = 4 + (ke - ks) / 64; kshift = ks; domask = true; }
  const size_t kb0 = (size_t)b * TT;
  float mhat = 0.f, lsum = 0.f; f32x16 o[2] = {}; f32x16 negm = {}; bf16x8 qr[DQK / 16];
  { const bf16_t* Qw = Qp + (rowq0 + wid * 32 + r32) * ldq + hi * 8;
#pragma unroll
    for (int d0 = 0; d0 < DQK / 16; ++d0) qr[d0] = *reinterpret_cast<const bf16x8*>(Qw + d0 * 16); }
  const int sr = tid >> 3, sc = (tid & 7) * 8, vst = v_st_p(sr, sc), kst = sr * KST + sc * 2;
  const int rr_ = (tid & 255) >> 2, rc_ = (tid & 3) * 8, krst = rr_ * KST + 128 + rc_ * 2;
  const int vb0 = (int)(uintptr_t)V_lds + v_rd_base_p(lane);
  struct { bf16x8 v, k, kr; } st_[1];
#define KROW(j) (kb0 + (size_t)(j) * 64 + ((j) >= 4 ? kshift : 0))
  const unsigned voffs = (unsigned)(sr * ldk + sc) * 2u, kroffs = (unsigned)(rr_ * 32 + rc_) * 2u;
#define SLOAD(i, j) do { const size_t kr0_ = KROW(j); const char* vb_ = (const char*)(Vp + kr0_ * ldk); const char* kb_ = (const char*)(Kp + kr0_ * ldk); \
    st_[i].v = *reinterpret_cast<const bf16x8*>(vb_ + voffs); st_[i].k = *reinterpret_cast<const bf16x8*>(kb_ + voffs); \
    if (KIND == 0) { const char* rb_ = (const char*)(KRp + kr0_ * 32); st_[i].kr = *reinterpret_cast<const bf16x8*>(rb_ + kroffs); } } while (0)
#define SWRITE(bf, i) do { *(bf16x8*)(V_lds + (bf) * SHM_V + vst) = st_[i].v; *(bf16x8*)(K_lds + (bf) * SHM_K + kst) = st_[i].k; \
    if (KIND == 0) { if (tid < 256) *(bf16x8*)(K_lds + (bf) * SHM_K + krst) = st_[i].kr; } } while (0)
#define SWAIT() do { if (LPT == 3) asm volatile("s_waitcnt vmcnt(3)" ::: "memory"); else asm volatile("s_waitcnt vmcnt(2)" ::: "memory"); } while (0)
#define RESC(a) do { if (__any((a) < 1.f)) { if (hi == 0) al_l[r32] = (a); asm volatile("s_waitcnt lgkmcnt(0)" ::: "memory"); \
    _Pragma("unroll") for (int d = 0; d < 2; ++d) _Pragma("unroll") for (int r = 0; r < 16; ++r) o[d][r] *= al_l[crow(r, hi)]; } } while (0)
#define AMASK(P0, P1, j) do { if (KIND == 1) { if (domask && (j) >= 4) { const int tq_ = q0 + wid * 32 + r32; const int tk_ = kshift + ((j) - 4) * 64 + 4 * hi; \
    _Pragma("unroll") for (int r = 0; r < 16; ++r) { const int d_ = tq_ - (tk_ + (r & 3) + 8 * (r >> 2)); if (d_ > 128 || d_ < -128) P0[r] = -INFINITY; if (d_ - 32 > 128 || d_ - 32 < -128) P1[r] = -INFINITY; } } } } while (0)
  if (__builtin_amdgcn_readfirstlane(wid) >= 4) __builtin_amdgcn_s_setprio(1);
  f32x16 pA0, pA1, pB0, pB1; float alA, alB; bf16x8 pa0, pa1, pa2, pa3;
  const int wq0_ = q0 + __builtin_amdgcn_readfirstlane(wid) * 32;
#define TACT(j) (KIND != 1 || !domask || (j) < 4 || (kshift + ((j) - 4) * 64 + 63 >= wq0_ - 128 && kshift + ((j) - 4) * 64 <= wq0_ + 31 + 128))
  bool actA, actB;
  SLOAD(0, 0); asm volatile("s_waitcnt vmcnt(0)" ::: "memory"); SWRITE(0, 0); __syncthreads();
  actA = true; qkt2<DQK>(pA0, pA1, K_lds, qr, negm, r32, hi); AMASK(pA0, pA1, 0); psm2q<true>(pA0, pA1, mhat, negm, alA, lsum);
  SLOAD(0, 1);
  SWRITE(1, 0); __syncthreads();
  for (int j = 1; j + 1 < NT; j += 2) {
    actB = TACT(j);
    SBAR(); if (actB) qkt2<DQK>(pB0, pB1, K_lds + SHM_K, qr, negm, r32, hi);
    if (actA) fsm2q(pA0, pA1, pa0, pa1, pa2, pa3, lsum); SBAR();
    SLOAD(0, j + 1); SBAR();
    if (actA) pv_all2q(o, vb0, pa0, pa1, pa2, pa3); if (actB) { AMASK(pB0, pB1, j); psm2q<false>(pB0, pB1, mhat, negm, alB, lsum); } else alB = 1.f;
    __syncthreads(); SWRITE(0, 0);
    RESC(alB); __syncthreads();
    actA = TACT(j + 1);
    SBAR(); if (actA) qkt2<DQK>(pA0, pA1, K_lds, qr, negm, r32, hi);
    if (actB) fsm2q(pB0, pB1, pa0, pa1, pa2, pa3, lsum); SBAR();
    SLOAD(0, j + 2); SBAR();
    if (actB) pv_all2q(o, vb0 + SHM_V, pa0, pa1, pa2, pa3); if (actA) { AMASK(pA0, pA1, j + 1); psm2q<false>(pA0, pA1, mhat, negm, alA, lsum); } else alA = 1.f;
    __syncthreads(); SWRITE(1, 0);
    RESC(alA); __syncthreads();
  }
  actB = TACT(NT - 1);
  SBAR(); if (actB) qkt2<DQK>(pB0, pB1, K_lds + SHM_K, qr, negm, r32, hi);
  if (actA) fsm2q(pA0, pA1, pa0, pa1, pa2, pa3, lsum); SBAR();
  if (actA) pv_all2q(o, vb0, pa0, pa1, pa2, pa3); if (actB) { AMASK(pB0, pB1, NT - 1); psm2q<false>(pB0, pB1, mhat, negm, alB, lsum); } else alB = 1.f;
  __syncthreads(); RESC(alB);
  if (actB) { fsm2q(pB0, pB1, pa0, pa1, pa2, pa3, lsum); SBAR();
    pv_all2q(o, vb0 + SHM_V, pa0, pa1, pa2, pa3); }
  __builtin_amdgcn_s_setprio(0);
  const int lanee = TIDX & 63, r32e = lanee & 31, hie = lanee >> 5;
  float rli[16];
  { auto rr = __builtin_amdgcn_permlane32_swap(__float_as_uint(lsum), __float_as_uint(lsum), false, false); lsum = __uint_as_float(rr[0]) + __uint_as_float(rr[1]); }
  if (hie == 0) { al_l[r32e] = lsum; if (KIND == 1) li_l[r32e] = mhat; } asm volatile("s_waitcnt lgkmcnt(0)" ::: "memory");
  if (KIND == 1) { const float sk2 = p.sink[l * 8 + hd] * LOG2E;
#pragma unroll
    for (int r = 0; r < 16; ++r) rli[r] = __builtin_amdgcn_rcpf(al_l[crow(r, hie)] + __builtin_amdgcn_exp2f(sk2 - li_l[crow(r, hie)])); }
  else {
#pragma unroll
    for (int r = 0; r < 16; ++r) rli[r] = __builtin_amdgcn_rcpf(al_l[crow(r, hie)]); }
  bf16_t* Ow = (bf16_t*)(p.ws + OFF_R + R_H) + (rowq0 + wid * 32) * DM + ocol;
#pragma unroll
  for (int r = 0; r < 16; ++r) { const int orow = crow(r, hie);
#pragma unroll
    for (int d0 = 0; d0 < 2; ++d0) Ow[(size_t)orow * DM + d0 * 32 + r32e] = f2bf(o[d0][r] * rli[r]); }
  __syncthreads();
#undef KROW
#undef SLOAD
#undef SWRITE
#undef SWAIT
#undef RESC
#undef AMASK
#undef TACT
}
#ifdef DBG_ATTN_PROBE
template <int KIND, int VAR>
__device__ __forceinline__ void attn_probe_unit(const Prm& p, int l, bool isctx, int b, int hd, int qb, unsigned char* ldsu) {
  constexpr int DQK = KIND == 0 ? 96 : 64, KST = DQK * 2 + 16, SHM_K = 64 * KST, SHM_V = 8192, LPT = KIND == 0 ? 3 : 2;
  char* lds = (char*)ldsu;
  const int tid = TIDX, wid = tid >> 6, lane = tid & 63, r32 = lane & 31, hi = lane >> 5;
  char* V_lds = lds; char* K_lds = lds + 2 * SHM_V;
  float* ws = (float*)(lds + 2 * SHM_V + 2 * SHM_K) + wid * 64; float* li_l = ws; float* al_l = ws + 32;
  const int q0 = qb * 256;
  const size_t rowq0 = (size_t)b * TT + (isctx ? 0 : LC) + q0;
  const bf16_t *Qp, *Kp, *Vp; const bf16_t* KRp = WSP(bf16_t, OFF_KR); int ldq, ldk; int ocol;
  if (KIND == 0) { Qp = (const bf16_t*)(p.ws + OFF_R + R_QB) + hd * 96; ldq = NQB; Kp = (const bf16_t*)(p.ws + OFF_R + R_KB) + hd * 64; Vp = (const bf16_t*)(p.ws + OFF_R + R_VB) + hd * 64; ldk = 512; ocol = 512 + hd * 64; }
  else { Qp = (const bf16_t*)(p.ws + OFF_R + R_QA) + hd * 64; ldq = 512; Kp = (const bf16_t*)(p.ws + OFF_R + R_KA) + (hd >> 2) * 64; Vp = (const bf16_t*)(p.ws + OFF_R + R_VA) + (hd >> 2) * 64; ldk = 128; ocol = hd * 64; }
  int NT, kshift = 0; bool domask = false;
  if (isctx) NT = 4; else if (KIND == 0) NT = TT / 64; else { const int ks = max(0, q0 - 128), ke = min(SEQ, q0 + 384); NT = 4 + (ke - ks) / 64; kshift = ks; domask = true; }
  const size_t kb0 = (size_t)b * TT;
  float mhat = 0.f; f32x16 o[3] = {}; f32x16 negm = {}; bf16x8 qr[DQK / 16];
  { const bf16_t* Qw = Qp + (rowq0 + wid * 32 + r32) * ldq + hi * 8;
#pragma unroll
    for (int d0 = 0; d0 < DQK / 16; ++d0) qr[d0] = *reinterpret_cast<const bf16x8*>(Qw + d0 * 16); }
  const int sr = tid >> 3, sc = (tid & 7) * 8, vst = v_st_p(sr, sc), kst = sr * KST + sc * 2;
  const int rr_ = (tid & 255) >> 2, rc_ = (tid & 3) * 8, krst = rr_ * KST + 128 + rc_ * 2;
  const int vb0 = (int)(uintptr_t)V_lds + v_rd_base_p(lane);
  struct { bf16x8 v, k, kr; } st_[1];
#define KROW(j) (kb0 + (size_t)(j) * 64 + ((j) >= 4 ? kshift : 0))
#define SLOAD(i, j) do { if (VAR & 4) break; const size_t kr0_ = KROW(j); st_[i].v = *reinterpret_cast<const bf16x8*>(Vp + (kr0_ + sr) * ldk + sc); st_[i].k = *reinterpret_cast<const bf16x8*>(Kp + (kr0_ + sr) * ldk + sc); \
    if (KIND == 0) st_[i].kr = *reinterpret_cast<const bf16x8*>(KRp + (kr0_ + rr_) * 32 + rc_); } while (0)
#define SWRITE(bf, i) do { if (VAR & 4) break; *(bf16x8*)(V_lds + (bf) * SHM_V + vst) = st_[i].v; *(bf16x8*)(K_lds + (bf) * SHM_K + kst) = st_[i].k; \
    if (KIND == 0) { if (tid < 256) *(bf16x8*)(K_lds + (bf) * SHM_K + krst) = st_[i].kr; } } while (0)
#define SWAIT() do { if (LPT == 3) asm volatile("s_waitcnt vmcnt(3)" ::: "memory"); else asm volatile("s_waitcnt vmcnt(2)" ::: "memory"); } while (0)
#define RESC(a) do { if (__any((a) < 1.f)) { if (hi == 0) al_l[r32] = (a); asm volatile("s_waitcnt lgkmcnt(0)" ::: "memory"); \
    _Pragma("unroll") for (int d = 0; d < 3; ++d) _Pragma("unroll") for (int r = 0; r < 16; ++r) o[d][r] *= al_l[crow(r, hi)]; } } while (0)
#define AMASK(P0, P1, j) do { if (KIND == 1) { if (domask && (j) >= 4) { const int tq_ = q0 + wid * 32 + r32; const int tk_ = kshift + ((j) - 4) * 64 + 4 * hi; \
    _Pragma("unroll") for (int r = 0; r < 16; ++r) { const int d_ = tq_ - (tk_ + (r & 3) + 8 * (r >> 2)); if (d_ > 128 || d_ < -128) P0[r] = -INFINITY; if (d_ - 32 > 128 || d_ - 32 < -128) P1[r] = -INFINITY; } } } } while (0)
  f32x16 pA0, pA1, pB0, pB1; float alA, alB; bf16x8 pa0, pa1, pa2, pa3;
  const int wq0_ = q0 + __builtin_amdgcn_readfirstlane(wid) * 32;
#define TACT(j) (KIND != 1 || !domask || (j) < 4 || (kshift + ((j) - 4) * 64 + 63 >= wq0_ - 128 && kshift + ((j) - 4) * 64 <= wq0_ + 31 + 128))
  bool actA, actB;
  SLOAD(0, 0); asm volatile("s_waitcnt vmcnt(0)" ::: "memory"); SWRITE(0, 0); do { if (!(VAR & 1)) __syncthreads(); } while (0);
  do { if (!(VAR & 16)) qkt2<DQK>(pA0, pA1, K_lds, qr, negm, r32, hi); else { pA0 = negm; pA1 = negm; asm volatile("" : "+v"(pA0), "+v"(pA1)); } } while (0); AMASK(pA0, pA1, 0); do { if (!(VAR & 2)) psm2<true>(pA0, pA1, mhat, negm, alA); else alA = 1.f; } while (0);
  SLOAD(0, 1);
  SWRITE(1, 0); do { if (!(VAR & 1)) __syncthreads(); } while (0);
  for (int j = 1; j + 1 < NT; j += 2) {
    SBAR(); do { if (!(VAR & 16)) qkt2<DQK>(pB0, pB1, K_lds + SHM_K, qr, negm, r32, hi); else { pB0 = negm; pB1 = negm; asm volatile("" : "+v"(pB0), "+v"(pB1)); } } while (0);
    do { if (!(VAR & 2)) fsm2p(pA0, pA1, pa0, pa1, pa2, pa3); else { pa0 = __builtin_bit_cast(bf16x8, (f32x4){pA0[0], pA0[1], pA0[2], pA0[3]}); pa1 = __builtin_bit_cast(bf16x8, (f32x4){pA0[4], pA0[5], pA0[6], pA0[7]}); pa2 = __builtin_bit_cast(bf16x8, (f32x4){pA1[0], pA1[1], pA1[2], pA1[3]}); pa3 = __builtin_bit_cast(bf16x8, (f32x4){pA1[4], pA1[5], pA1[6], pA1[7]}); } } while (0); SBAR();
    SLOAD(0, j + 1); SBAR();
    do { if (!(VAR & 8)) pv_all2p(o, vb0, pa0, pa1, pa2, pa3); else { asm volatile("" :: "v"(pa0), "v"(pa1), "v"(pa2), "v"(pa3)); } } while (0); AMASK(pB0, pB1, j); do { if (!(VAR & 2)) psm2<false>(pB0, pB1, mhat, negm, alB); else alB = 1.f; } while (0);
    do { if (!(VAR & 1)) __syncthreads(); } while (0); SWRITE(0, 0);
    RESC(alB); do { if (!(VAR & 1)) __syncthreads(); } while (0);
    SBAR(); do { if (!(VAR & 16)) qkt2<DQK>(pA0, pA1, K_lds, qr, negm, r32, hi); else { pA0 = negm; pA1 = negm; asm volatile("" : "+v"(pA0), "+v"(pA1)); } } while (0);
    do { if (!(VAR & 2)) fsm2p(pB0, pB1, pa0, pa1, pa2, pa3); else { pa0 = __builtin_bit_cast(bf16x8, (f32x4){pB0[0], pB0[1], pB0[2], pB0[3]}); pa1 = __builtin_bit_cast(bf16x8, (f32x4){pB0[4], pB0[5], pB0[6], pB0[7]}); pa2 = __builtin_bit_cast(bf16x8, (f32x4){pB1[0], pB1[1], pB1[2], pB1[3]}); pa3 = __builtin_bit_cast(bf16x8, (f32x4){pB1[4], pB1[5], pB1[6], pB1[7]}); } } while (0); SBAR();
    SLOAD(0, j + 2); SBAR();
    do { if (!(VAR & 8)) pv_all2p(o, vb0 + SHM_V, pa0, pa1, pa2, pa3); else { asm volatile("" :: "v"(pa0), "v"(pa1), "v"(pa2), "v"(pa3)); } } while (0); AMASK(pA0, pA1, j + 1); do { if (!(VAR & 2)) psm2<false>(pA0, pA1, mhat, negm, alA); else alA = 1.f; } while (0);
    do { if (!(VAR & 1)) __syncthreads(); } while (0); SWRITE(1, 0);
    RESC(alA); do { if (!(VAR & 1)) __syncthreads(); } while (0);
  }
  SBAR(); do { if (!(VAR & 16)) qkt2<DQK>(pB0, pB1, K_lds + SHM_K, qr, negm, r32, hi); else { pB0 = negm; pB1 = negm; asm volatile("" : "+v"(pB0), "+v"(pB1)); } } while (0);
  do { if (!(VAR & 2)) fsm2p(pA0, pA1, pa0, pa1, pa2, pa3); else { pa0 = __builtin_bit_cast(bf16x8, (f32x4){pA0[0], pA0[1], pA0[2], pA0[3]}); pa1 = __builtin_bit_cast(bf16x8, (f32x4){pA0[4], pA0[5], pA0[6], pA0[7]}); pa2 = __builtin_bit_cast(bf16x8, (f32x4){pA1[0], pA1[1], pA1[2], pA1[3]}); pa3 = __builtin_bit_cast(bf16x8, (f32x4){pA1[4], pA1[5], pA1[6], pA1[7]}); } } while (0); SBAR();
  do { if (!(VAR & 8)) pv_all2p(o, vb0, pa0, pa1, pa2, pa3); else { asm volatile("" :: "v"(pa0), "v"(pa1), "v"(pa2), "v"(pa3)); } } while (0); AMASK(pB0, pB1, NT - 1); do { if (!(VAR & 2)) psm2<false>(pB0, pB1, mhat, negm, alB); else alB = 1.f; } while (0);
  do { if (!(VAR & 1)) __syncthreads(); } while (0); RESC(alB);
  do { if (!(VAR & 2)) fsm2p(pB0, pB1, pa0, pa1, pa2, pa3); else { pa0 = __builtin_bit_cast(bf16x8, (f32x4){pB0[0], pB0[1], pB0[2], pB0[3]}); pa1 = __builtin_bit_cast(bf16x8, (f32x4){pB0[4], pB0[5], pB0[6], pB0[7]}); pa2 = __builtin_bit_cast(bf16x8, (f32x4){pB1[0], pB1[1], pB1[2], pB1[3]}); pa3 = __builtin_bit_cast(bf16x8, (f32x4){pB1[4], pB1[5], pB1[6], pB1[7]}); } } while (0); SBAR();
  do { if (!(VAR & 8)) pv_all2p(o, vb0 + SHM_V, pa0, pa1, pa2, pa3); else { asm volatile("" :: "v"(pa0), "v"(pa1), "v"(pa2), "v"(pa3)); } } while (0);
  float rli[16];
  if (KIND == 1) { if (hi == 0) li_l[r32] = mhat; asm volatile("s_waitcnt lgkmcnt(0)" ::: "memory"); const float sk2 = p.sink[l * 8 + hd] * LOG2E;
#pragma unroll
    for (int r = 0; r < 16; ++r) rli[r] = __builtin_amdgcn_rcpf(o[2][r] + __builtin_amdgcn_exp2f(sk2 - li_l[crow(r, hi)])); }
  else {
#pragma unroll
    for (int r = 0; r < 16; ++r) rli[r] = __builtin_amdgcn_rcpf(o[2][r]); }
  bf16_t* Ow = (bf16_t*)(p.ws + OFF_R + R_CQ) + ((rowq0 + wid * 32) & 16383) * DM + ocol;
#pragma unroll
  for (int r = 0; r < 16; ++r) { const int orow = crow(r, hi);
#pragma unroll
    for (int d0 = 0; d0 < 2; ++d0) Ow[(size_t)orow * DM + d0 * 32 + r32] = f2bf(o[d0][r] * rli[r]); }
  do { if (!(VAR & 1)) __syncthreads(); } while (0);
#undef KROW
#undef SLOAD
#undef SWRITE
#undef SWAIT
#undef RESC
#undef AMASK
#undef TACT
}

template <int VAR>
__device__ __forceinline__ void ph_attn_probe(const Prm& p, int l, unsigned char* lds, int bid, int nb) {
  const int nrounds = (1024 + nb - 1) / nb;
  for (int rd = 0; rd < nrounds; ++rd) { const int pair = rd * 8 + (bid & 7), qb = bid >> 3, u = pair * 32 + qb;
    if (u < 1024) attn_probe_unit<0, VAR>(p, l, false, u >> 8, (u >> 5) & 7, u & 31, lds); }
}
#endif
template <int KIND>
__device__ __forceinline__ void attn_fast_unit3(const Prm& p, int l, bool isctx, int b, int hd, int qb, unsigned char* ldsu) {
  constexpr int DQK = KIND == 0 ? 96 : 64, KST = DQK * 2 + 16, SHM_K = 64 * KST, SHM_V = 8192, LPT = KIND == 0 ? 3 : 2;
  char* lds = (char*)ldsu;
  const int tid = TIDX, wid = tid >> 6, lane = tid & 63, r32 = lane & 31, hi = lane >> 5;
  char* V_lds = lds; char* K_lds = lds + 3 * SHM_V;
  float* ws = (float*)(lds + 3 * SHM_V + 3 * SHM_K) + wid * 64; float* li_l = ws; float* al_l = ws + 32;
  const int q0 = qb * 256;
  const size_t rowq0 = (size_t)b * TT + (isctx ? 0 : LC) + q0;
  const bf16_t *Qp, *Kp, *Vp; const bf16_t* KRp = WSP(bf16_t, OFF_KR); int ldq, ldk; int ocol;
  if (KIND == 0) { Qp = (const bf16_t*)(p.ws + OFF_R + R_QB) + hd * 96; ldq = NQB; Kp = (const bf16_t*)(p.ws + OFF_R + R_KB) + hd * 64; Vp = (const bf16_t*)(p.ws + OFF_R + R_VB) + hd * 64; ldk = 512; ocol = 512 + hd * 64; }
  else { Qp = (const bf16_t*)(p.ws + OFF_R + R_QA) + hd * 64; ldq = 512; Kp = (const bf16_t*)(p.ws + OFF_R + R_KA) + (hd >> 2) * 64; Vp = (const bf16_t*)(p.ws + OFF_R + R_VA) + (hd >> 2) * 64; ldk = 128; ocol = hd * 64; }
  int NT, kshift = 0; bool domask = false;
  if (isctx) NT = 4; else if (KIND == 0) NT = TT / 64; else { const int ks = max(0, q0 - 128), ke = min(SEQ, q0 + 384); NT = 4 + (ke - ks) / 64; kshift = ks; domask = true; }
  const size_t kb0 = (size_t)b * TT;
  float mhat = 0.f; f32x16 o[3] = {}; f32x16 negm = {}; bf16x8 qr[DQK / 16];
  { const bf16_t* Qw = Qp + (rowq0 + wid * 32 + r32) * ldq + hi * 8;
#pragma unroll
    for (int d0 = 0; d0 < DQK / 16; ++d0) qr[d0] = *reinterpret_cast<const bf16x8*>(Qw + d0 * 16); }
  const int sr = tid >> 3, sc = (tid & 7) * 8, vst = v_st(sr, sc), kst = sr * KST + sc * 2;
  const int rr_ = (tid & 255) >> 2, rc_ = (tid & 3) * 8, krst = rr_ * KST + 128 + rc_ * 2;
  const int vb0 = (int)(uintptr_t)V_lds + v_rd_base(lane);
  struct { bf16x8 v, k, kr; } st_[1];
#define KROW(j) (kb0 + (size_t)(j) * 64 + ((j) >= 4 ? kshift : 0))
#define SLOAD(i, j) do { const size_t kr0_ = KROW(j); st_[i].v = *reinterpret_cast<const bf16x8*>(Vp + (kr0_ + sr) * ldk + sc); st_[i].k = *reinterpret_cast<const bf16x8*>(Kp + (kr0_ + sr) * ldk + sc); \
    if (KIND == 0) st_[i].kr = *reinterpret_cast<const bf16x8*>(KRp + (kr0_ + rr_) * 32 + rc_); } while (0)
#define SWRITE(bf, i) do { *(bf16x8*)(V_lds + (bf) * SHM_V + vst) = st_[i].v; *(bf16x8*)(K_lds + (bf) * SHM_K + kst) = st_[i].k; \
    if (KIND == 0) { if (tid < 256) *(bf16x8*)(K_lds + (bf) * SHM_K + krst) = st_[i].kr; } } while (0)
#define SWAIT() do { if (LPT == 3) asm volatile("s_waitcnt vmcnt(3)" ::: "memory"); else asm volatile("s_waitcnt vmcnt(2)" ::: "memory"); } while (0)
#define RESC(a) do { if (__any((a) < 1.f)) { if (hi == 0) al_l[r32] = (a); asm volatile("s_waitcnt lgkmcnt(0)" ::: "memory"); \
    _Pragma("unroll") for (int d = 0; d < 3; ++d) _Pragma("unroll") for (int r = 0; r < 16; ++r) o[d][r] *= al_l[crow(r, hi)]; } } while (0)
#define AMASK(P0, P1, j) do { if (KIND == 1) { if (domask && (j) >= 4) { const int tq_ = q0 + wid * 32 + r32; const int tk_ = kshift + ((j) - 4) * 64 + 4 * hi; \
    _Pragma("unroll") for (int r = 0; r < 16; ++r) { const int d_ = tq_ - (tk_ + (r & 3) + 8 * (r >> 2)); if (d_ > 128 || d_ < -128) P0[r] = -INFINITY; if (d_ - 32 > 128 || d_ - 32 < -128) P1[r] = -INFINITY; } } } } while (0)
  f32x16 pA0, pA1, pB0, pB1; float alA, alB; bf16x8 pa0, pa1, pa2, pa3;
  SLOAD(0, 0); SWRITE(0, 0); SLOAD(0, 1); SWRITE(1, 0); __syncthreads();
  qkt2<DQK>(pA0, pA1, K_lds, qr, negm, r32, hi); AMASK(pA0, pA1, 0); psm2<true>(pA0, pA1, mhat, negm, alA);
  int r0 = 0, r1 = 1, r2 = 2;
#define ITER(PP0, PP1, PC0, PC1, ALC, j) do { \
    if ((j) + 2 < NT) SLOAD(0, (j) + 2); \
    SBAR(); qkt2<DQK>(PC0, PC1, K_lds + r1 * SHM_K, qr, negm, r32, hi); \
    fsm2(PP0, PP1, pa0, pa1, pa2, pa3); SBAR(); \
    pv_all2(o, vb0 + r0 * SHM_V, pa0, pa1, pa2, pa3); AMASK(PC0, PC1, (j) + 1); psm2<false>(PC0, PC1, mhat, negm, ALC); \
    RESC(ALC); \
    if ((j) + 2 < NT) SWRITE(r2, 0); \
    __syncthreads(); \
    { const int t_ = r0; r0 = r1; r1 = r2; r2 = t_; } } while (0)
  int j = 0;
  for (; j + 2 < NT; j += 2) { ITER(pA0, pA1, pB0, pB1, alB, j); ITER(pB0, pB1, pA0, pA1, alA, j + 1); }
  ITER(pA0, pA1, pB0, pB1, alB, j);
  fsm2(pB0, pB1, pa0, pa1, pa2, pa3); SBAR();
  pv_all2(o, vb0 + r0 * SHM_V, pa0, pa1, pa2, pa3);
#undef ITER
  float rli[16];
  if (KIND == 1) { if (hi == 0) li_l[r32] = mhat; asm volatile("s_waitcnt lgkmcnt(0)" ::: "memory"); const float sk2 = p.sink[l * 8 + hd] * LOG2E;
#pragma unroll
    for (int r = 0; r < 16; ++r) rli[r] = __builtin_amdgcn_rcpf(o[2][r] + __builtin_amdgcn_exp2f(sk2 - li_l[crow(r, hi)])); }
  else {
#pragma unroll
    for (int r = 0; r < 16; ++r) rli[r] = __builtin_amdgcn_rcpf(o[2][r]); }
  bf16_t* Ow = (bf16_t*)(p.ws + OFF_R + R_H) + (rowq0 + wid * 32) * DM + ocol;
#pragma unroll
  for (int r = 0; r < 16; ++r) { const int orow = crow(r, hi);
#pragma unroll
    for (int d0 = 0; d0 < 2; ++d0) Ow[(size_t)orow * DM + d0 * 32 + r32] = f2bf(o[d0][r] * rli[r]); }
  __syncthreads();
#undef KROW
#undef SLOAD
#undef SWRITE
#undef SWAIT
#undef RESC
#undef AMASK
}
#ifndef ATTN_V2
#define ATTN_V2 1
#endif
#ifndef ATTN_V3
#define ATTN_V3 0
#endif
#ifndef ATTN_V2P
#define ATTN_V2P 1
#endif
#if ATTN_V2P
#define ATTN_UNIT attn_fast_unit2p
#elif ATTN_V3
#define ATTN_UNIT attn_fast_unit3
#elif ATTN_V2
#define ATTN_UNIT attn_fast_unit2
#else
#define ATTN_UNIT attn_fast_unit
#endif
__device__ __forceinline__ void ph_attn_fast(const Prm& p, int l, unsigned char* lds, int bid, int nb) {
  const int nrounds = (1024 + nb - 1) / nb;
  for (int rd = 0; rd < nrounds; ++rd) { int u;
    if ((nb & 7) == 0 && (nb >> 3) == 32) { const int pair = rd * 8 + (bid & 7), qb = bid >> 3; u = pair * 32 + qb; } else u = rd * nb + bid;
    if (u < 1024) ATTN_UNIT<0>(p, l, false, u >> 8, (u >> 5) & 7, u & 31, lds); }
  for (int rd = 0; rd < nrounds; ++rd) { int u;
    if ((nb & 7) == 0 && (nb >> 3) == 32) { const int pair = rd * 8 + (bid & 7), qb = bid >> 3; u = pair * 32 + qb; } else u = rd * nb + bid;
    if (u < 1024) ATTN_UNIT<1>(p, l, false, u >> 8, (u >> 5) & 7, u & 31, lds); }
  if (l != DEPTH - 1) for (int u = bid; u < 64; u += nb) { const int kind = u & 1, hd = (u >> 1) & 7, b = u >> 4;
      if (kind == 0) ATTN_UNIT<0>(p, l, true, b, hd, 0, lds); else ATTN_UNIT<1>(p, l, true, b, hd, 0, lds); }
}

#define XB_TMO      128
#define XB_XCNT(j)  (256  + 64 * (j))
#define XB_XSUB(j)  (1280 + 64 * (j))
#define XB_XGEN(j)  (2304 + 64 * (j))
#define XB_TOP      3328
#define XB_TOPGEN   3392
#define XCD_BAR_WORDS 3456
#define XB_SPIN_CAP (1u << 22)
#define LAS __attribute__((address_space(3)))
__device__ __forceinline__ unsigned xb_ld(unsigned* p)              { return __hip_atomic_load(p, __ATOMIC_RELAXED, __HIP_MEMORY_SCOPE_AGENT); }
__device__ __forceinline__ unsigned xb_add(unsigned* p, unsigned v) { return __hip_atomic_fetch_add(p, v, __ATOMIC_RELAXED, __HIP_MEMORY_SCOPE_AGENT); }
__device__ __forceinline__ unsigned xb_xcc_id() { return (unsigned)__builtin_amdgcn_s_getreg((3 << 11) | 20) & 0xFu; }
#define XB_SPIN(cond, bar) do { unsigned _sp = 0; while (cond) { __builtin_amdgcn_s_sleep(1); \
    if ((++_sp & 255u) == 0u) { if (xb_ld(&(bar)[XB_TMO])) break; if (_sp > XB_SPIN_CAP) { atomicAdd(&(bar)[XB_TMO], 1u); break; } } } } while (0)
struct XcdBarrier { unsigned* bar; unsigned x; volatile LAS unsigned* st; };
__device__ __forceinline__ XcdBarrier xcd_barrier_post(unsigned* bar, volatile LAS unsigned* st) {
    XcdBarrier b; b.bar = bar; b.x = xb_xcc_id(); b.st = st;
    if (TIDX == 0) (void)xb_add(&bar[XB_XCNT(b.x)], 1u);
    return b;
}
__device__ __forceinline__ void xcd_barrier_complete(unsigned* bar, unsigned x, unsigned& nloc, unsigned& nx) {
    const unsigned G = gridDim.x * gridDim.y * gridDim.z;
    unsigned sum, cnt, mine, sp = 0u;
    for (;;) {
        sum = 0u; cnt = 0u; mine = 0u;
#pragma unroll
        for (unsigned j = 0; j < 16; ++j) { const unsigned c = xb_ld(&bar[XB_XCNT(j)]); sum += c; cnt += (c > 0u) ? 1u : 0u; mine = (j == x) ? c : mine; }
        if (sum == G) break;
        __builtin_amdgcn_s_sleep(1);
        if ((++sp & 255u) == 0u) { if (xb_ld(&bar[XB_TMO])) break; if (sp > XB_SPIN_CAP) { atomicAdd(&bar[XB_TMO], 1u); break; } }
    }
    nloc = mine > 0u ? mine : 1u; nx = cnt > 0u ? cnt : 1u;
}
__device__ __forceinline__ void xcd_barrier(const XcdBarrier& b) {
    asm volatile("s_waitcnt vmcnt(0)" ::: "memory");
    __syncthreads();
    if (TIDX == 0) {
        unsigned* bar = b.bar;
        __builtin_amdgcn_s_waitcnt(0);
        unsigned nloc = b.st[0], nx = b.st[1];
        if (nloc == 0u) { xcd_barrier_complete(bar, b.x, nloc, nx); b.st[0] = nloc; b.st[1] = nx; }
        const unsigned old = xb_add(&bar[XB_XSUB(b.x)], 1u);
        const unsigned gen = old / nloc;
        if (old + 1u == (gen + 1u) * nloc) {
            __builtin_amdgcn_fence(__ATOMIC_RELEASE, "agent");
            asm volatile("s_waitcnt vmcnt(0)" ::: "memory");
            const unsigned og = xb_add(&bar[XB_TOP], 1u);
            const unsigned tg = og / nx;
            if (og + 1u == (tg + 1u) * nx) xb_add(&bar[XB_TOPGEN], 1u);
            else XB_SPIN(xb_ld(&bar[XB_TOPGEN]) == tg, bar);
            __builtin_amdgcn_fence(__ATOMIC_ACQUIRE, "agent");
            xb_add(&bar[XB_XGEN(b.x)], 1u);
            asm volatile("s_waitcnt vmcnt(0)" ::: "memory");
        } else {
            XB_SPIN(xb_ld(&bar[XB_XGEN(b.x)]) == gen, bar);
            __builtin_amdgcn_fence(__ATOMIC_ACQUIRE, "agent");
            asm volatile("s_waitcnt vmcnt(0)" ::: "memory");
        }
    }
    __syncthreads();
}

constexpr int NPHASE = 22;
__device__ __forceinline__ void run_phase1(const Prm& p, int ph, unsigned char* lds, int bid, int nb) {
  if (ph == 0) { ph_mod(p, 0, lds, bid, nb); ph_wconv_dense(p, 0, lds, bid, nb); return; }
  if (ph == 21) { ph_final(p, bid, nb); return; }
  const int alt = ph >= 100 ? 10 : 0; if (alt) ph -= 100;
  const int l = (ph - 1) / 10, s = (ph - 1) % 10 + alt;
  switch (s) {
    case 0: ph_norm_a(p, l, bid, nb); break;
#if FAST_GEMM
#if !defined(DBG_ONLY) || DBG_ONLY == 1
    case 1: ph2_gemm_in(p, l, lds, bid, nb); break;
#endif
#if !defined(DBG_ONLY) || DBG_ONLY == 2
    case 2: ph2_gemm_qup(p, l, lds, bid, nb); ph2_gemm_kvup(p, l, lds, bid, nb); break;
#endif
#if !defined(DBG_ONLY) || DBG_ONLY == 3
    case 3: break;
#endif
#else
    case 1: ph_gemm_in(p, l, bid, nb); break;
    case 2: ph_ssq(p, bid, nb); break;
    case 3: ph_gemm_up(p, l, bid, nb); break;
#endif
#if FAST_ATTN
    case 4: ph_attn_fast(p, l, lds, bid, nb); break;
#else
    case 4: ph_attn_naive(p, l, lds, bid, nb); break;
#endif
#if FAST_GEMM
#if !defined(DBG_ONLY) || DBG_ONLY == 5
    case 5: ph2_gemm_out(p, l, lds, bid, nb); break;
#endif
#else
    case 5: ph_gemm_out(p, l, bid, nb); break;
#endif
    case 6: ph_norm_b<true>(p, l, lds, bid, nb); break;
#ifdef DBG_NB
    case 16: ph_norm_b<false>(p, l, lds, bid, nb); break;
#endif
#ifdef DBG_ATTN_PROBE
    case 14: ph_attn_probe<DBG_ATTN_PROBE>(p, l, lds, bid, nb); break;
#endif
    case 7: ph_topk(p, l, lds, bid, nb); break;
#if FAST_GEMM
#if !defined(DBG_ONLY) || DBG_ONLY == 8
    case 8: ph2_moe_up(p, l, lds, bid, nb); break;
#endif
#if !defined(DBG_ONLY) || DBG_ONLY == 9
    case 9: ph2_moe_down(p, l, lds, bid, nb); break;
#endif
#else
    case 8: ph_moe_up(p, l, bid, nb); break;
    case 9: ph_moe_down(p, l, bid, nb); break;
#endif
  }
}

#ifndef DBG_TWICE
#define DBG_TWICE 0
#endif
#ifndef DBG_ALT
#define DBG_ALT 0
#endif
#ifndef DBG_PRE
#define DBG_PRE 0
#endif
__device__ __forceinline__ void run_phase(const Prm& p, int ph, unsigned char* lds, int bid, int nb) {
  if (DBG_PRE) { if (ph >= 1 && ph <= 20 && (ph - 1) % 10 == 0) { run_phase1(p, ph + DBG_PRE, lds, bid, nb); __syncthreads(); } }
  run_phase1(p, ph, lds, bid, nb);
  if (DBG_TWICE) { const int s = ph == 0 ? 10 : (ph == 21 ? 11 : (ph - 1) % 10); if ((DBG_TWICE >> s) & 1) { __syncthreads(); run_phase1(p, ph + DBG_ALT, lds, bid, nb); } }
}
constexpr int LDS_BYTES = FAST_GEMM ? 131072 + 16384 + 128 + 128 : 65536;
#if MK_SPLIT
__global__ void __launch_bounds__(NTHR, 2) k_phase(Prm p, int ph) {
  extern __shared__ __attribute__((aligned(16))) unsigned char lds[];
  run_phase(p, ph, lds, blockIdx.x, gridDim.x);
}
#endif
#if !MK_SPLIT
__global__ void __launch_bounds__(NTHR, 2) k_mega(Prm p) {
  extern __shared__ __attribute__((aligned(16))) unsigned char lds[];
  cg::grid_group grid = cg::this_grid();
  if (p.out == nullptr) grid.sync();
  volatile LAS unsigned* st = (volatile LAS unsigned*)((LAS unsigned char*)lds + 131072 + 16384 + 64);
  if (TIDX < 2) st[TIDX] = 0u;
  if (TIDX < 24) { const int i = TIDX; ((LAS float*)((LAS unsigned char*)lds + ROPE_TAB_OFF))[i] = (i < 16 ? exp2f(-(float)i * (13.287712379549449f / 16.f)) : exp2f(-(float)(i - 16) * (13.287712379549449f / 8.f))) * 0.15915494309189535f; }
  __syncthreads();
  XcdBarrier xb = xcd_barrier_post((unsigned*)(p.ws + OFF_CTL) + 1024, st);
#pragma unroll 1
  for (int ph = 0; ph < NPHASE; ++ph) { int phv = ph; asm volatile("" : "+s"(phv));
    run_phase(p, phv, lds, blockIdx.x, gridDim.x);
    if (ph + 1 < NPHASE && (ph % 10) != 4) xcd_barrier(xb); }
}
#define K_MAIN k_mega
#else
#define K_MAIN k_phase
#endif

extern "C" void kernel_launch(void* const* d_in, const int* in_sizes, int n_in, void* d_out, int out_size, void* d_ws, size_t ws_size, hipStream_t stream) {
  static int grid = 0;
  if (grid == 0) {
    if (n_in != 20 || ws_size < WS_END || out_size != NB * SEQ * DM) { fprintf(stderr, "kernel_launch: bad shapes n_in %d ws %zu (need %zu) out %d\n", n_in, ws_size, (size_t)WS_END, out_size); grid = -1; return; }
    int dev = 0, cus = 0, per = 0;
    (void)hipGetDevice(&dev); (void)hipDeviceGetAttribute(&cus, hipDeviceAttributeMultiprocessorCount, dev);
    (void)hipFuncSetAttribute((const void*)K_MAIN, hipFuncAttributeMaxDynamicSharedMemorySize, LDS_BYTES);
    (void)hipOccupancyMaxActiveBlocksPerMultiprocessor(&per, (const void*)K_MAIN, NTHR, LDS_BYTES);
    if (per < 1) per = 1;
    if (per > 1) per = 1;
    grid = cus * per;
    (void)hipGetLastError();
  }
  if (grid < 0) return;
  Prm p{};
  const float** pf = (const float**)&p;
  for (int i = 0; i < 20; ++i) pf[i] = (const float*)d_in[i];
  p.out = (float*)d_out; p.ws = (unsigned char*)d_ws;
#if MK_SPLIT
  for (int ph = 0; ph < NPHASE; ++ph) hipLaunchKernelGGL(k_phase, dim3(1024), dim3(NTHR), LDS_BYTES, stream, p, ph);
#else
  (void)hipMemsetAsync((char*)d_ws + OFF_CTL, 0, 65536, stream);
  void* args[] = {&p};
  hipError_t e = hipLaunchCooperativeKernel((const void*)k_mega, dim3(grid), dim3(NTHR), args, LDS_BYTES, stream);
  if (e != hipSuccess) fprintf(stderr, "cooperative launch failed: %s (grid %d)\n", hipGetErrorString(e), grid);
#endif
}
```
